# Optimizing an MI355X kernel written in HIP

```python
import jax
import jax.numpy as jnp
from jax import lax
import numpy as np

D_MODEL = 4096
BATCH = 2
SEQ = 8192
DEPTH = 4

GRID_W = 64
CTX_LEN = 256
EPS = 1e-6
MIX_EXPAND = 2
MIX_W = MIX_EXPAND * D_MODEL
A_WIDTH = MIX_W // 2
A_V_DIM = 128
A_HEADS = A_WIDTH // A_V_DIM
A_NOPE = 128
A_ROPE = 64
Q_LORA = 1024
KV_LORA = 512
ROPE_THETA = 10000.0
A_SCALE = (A_NOPE + A_ROPE) ** -0.5
Q_BLOCK = 128
B_WIDTH = MIX_W - A_WIDTH
B_GROUPS = 16
B_GROUP_CH = B_WIDTH // B_GROUPS
B_CHUNK = 128
C_WIDTH = MIX_W
C_KEY = 128
C_HEADS = C_WIDTH // C_KEY
C_FDIM = C_HEADS * C_KEY
C_VAL = C_WIDTH // C_HEADS
C_CHUNK = 16
N_AB = (DEPTH + 1) // 2
N_C = DEPTH // 2
IN_AB = Q_LORA + KV_LORA + A_ROPE + A_WIDTH + 3 * B_WIDTH
IN_C = 3 * C_FDIM + 2 * C_WIDTH

kernel_name = 'hybrid_mla_sgu_hgrn2_prefix_dit'


def rmsnorm(x, w):
    xf = x.astype(jnp.float32)
    y = xf * lax.rsqrt(jnp.mean(xf * xf, axis=-1, keepdims=True) + EPS)
    return (y * w.astype(jnp.float32)).astype(x.dtype)


def layernorm(x, w, b):
    xf = x.astype(jnp.float32)
    mu = jnp.mean(xf, axis=-1, keepdims=True)
    var = jnp.mean(jnp.square(xf - mu), axis=-1, keepdims=True)
    y = (xf - mu) * lax.rsqrt(var + EPS)
    return (y * w.astype(jnp.float32) + b.astype(jnp.float32)).astype(x.dtype)


def split_cols(p, sizes):
    out, start = [], 0
    for s in sizes:
        out.append(p[..., start:start + s])
        start += s
    return out


def axial_rope_tables(n_tokens, dtype):
    rows = n_tokens // GRID_W
    row = jnp.repeat(jnp.arange(rows), GRID_W)
    col = jnp.arange(rows * GRID_W) % GRID_W
    pos = jnp.stack([row, col], axis=-1).astype(jnp.float32)
    n_freq = A_ROPE // 4
    inv = ROPE_THETA ** (-jnp.arange(n_freq, dtype=jnp.float32) / n_freq)
    ang = pos[:, :, None] * inv
    cos = jnp.stack([jnp.cos(ang), jnp.cos(ang)], axis=-2).reshape(n_tokens, A_ROPE)
    sin = jnp.stack([jnp.sin(ang), jnp.sin(ang)], axis=-2).reshape(n_tokens, A_ROPE)
    return cos.astype(dtype), sin.astype(dtype)


def apply_rope(x, cos, sin):
    xs = x.reshape(x.shape[:-1] + (2, 2, A_ROPE // 4))
    rot = jnp.stack([-xs[..., 1, :], xs[..., 0, :]], axis=-2).reshape(x.shape)
    return x * cos + rot * sin


def mla_project(cq, ckv, k_rope, q_norm_w, kv_norm_w, w_q_up, w_kv_up):
    bsz, t, _ = cq.shape
    q = (rmsnorm(cq, q_norm_w) @ w_q_up).reshape(bsz, t, A_HEADS, A_NOPE + A_ROPE)
    kv = (rmsnorm(ckv, kv_norm_w) @ w_kv_up).reshape(bsz, t, A_HEADS, A_NOPE + A_V_DIM)
    return q[..., :A_NOPE], q[..., A_NOPE:], kv[..., :A_NOPE], k_rope, kv[..., A_NOPE:]


def mla_attend(qn, qr, kn, kr, v):
    s = jnp.einsum('bqhd,bkhd->bhqk', qn, kn) + jnp.einsum('bqhr,bkr->bhqk', qr, kr)
    p = jax.nn.softmax(s.astype(jnp.float32) * A_SCALE, axis=-1)
    return jnp.einsum('bhqk,bkhd->bqhd', p.astype(v.dtype), v)


def spatial_gating(u, v, ln_w, ln_b, w_s, b_s):
    bsz, t, _ = u.shape
    nc = t // B_CHUNK
    u = jax.nn.gelu(u, approximate=False)
    v = layernorm(jax.nn.gelu(v, approximate=False), ln_w, ln_b)
    v = v.reshape(bsz, nc, B_CHUNK, B_GROUPS, B_GROUP_CH)
    mixed = jnp.einsum('gts,bnsgc->bntgc', w_s, v) + b_s.T[:, :, None]
    return u * mixed.reshape(bsz, t, B_WIDTH)


def ab_mixer(h_lat, h_ctx, w_in, q_norm_w, kv_norm_w, w_q_up, w_kv_up, ln_w, ln_b, w_s, b_s, w_out,
             with_ctx_out):
    bsz, n_lat, _ = h_lat.shape
    sizes = [Q_LORA, KV_LORA, A_ROPE, A_WIDTH, B_WIDTH, B_WIDTH, B_WIDTH]
    cq_l, ckv_l, kr_l, za_l, ub_l, vb_l, zb_l = split_cols(h_lat @ w_in, sizes)
    cq_c, ckv_c, kr_c, za_c, ub_c, vb_c, zb_c = split_cols(h_ctx @ w_in, sizes)
    cos, sin = axial_rope_tables(n_lat, h_lat.dtype)
    qn_l, qr_l, kn_l, kr_l, v_l = mla_project(cq_l, ckv_l, kr_l, q_norm_w, kv_norm_w, w_q_up, w_kv_up)
    qr_l = apply_rope(qr_l, cos[:, None, :], sin[:, None, :])
    kr_l = apply_rope(kr_l, cos, sin)
    qn_c, qr_c, kn_c, kr_c, v_c = mla_project(cq_c, ckv_c, kr_c, q_norm_w, kv_norm_w, w_q_up, w_kv_up)
    kn_all = jnp.concatenate([kn_l, kn_c], axis=1)
    kr_all = jnp.concatenate([kr_l, kr_c], axis=1)
    v_all = jnp.concatenate([v_l, v_c], axis=1)
    nb = n_lat // Q_BLOCK

    def to_blocks(a):
        return a.reshape((bsz, nb, Q_BLOCK) + a.shape[2:]).swapaxes(0, 1)

    def attend_block(q_blk):
        return mla_attend(q_blk[0], q_blk[1], kn_all, kr_all, v_all)

    a_l = lax.map(attend_block, (to_blocks(qn_l), to_blocks(qr_l)))
    a_l = a_l.swapaxes(0, 1).reshape(bsz, n_lat, A_WIDTH)
    b_l = spatial_gating(ub_l, vb_l, ln_w, ln_b, w_s, b_s)
    y_l = jnp.concatenate([a_l * jax.nn.silu(za_l), b_l * jax.nn.silu(zb_l)], axis=-1) @ w_out
    y_c = None
    if with_ctx_out:
        a_c = mla_attend(qn_c, qr_c, kn_c, kr_c, v_c).reshape(bsz, h_ctx.shape[1], A_WIDTH)
        b_c = spatial_gating(ub_c, vb_c, ln_w, ln_b, w_s, b_s)
        y_c = jnp.concatenate([a_c * jax.nn.silu(za_c), b_c * jax.nn.silu(zb_c)], axis=-1) @ w_out
    return y_l, y_c


def hgrn2_gates(f_pre, lb):
    fp = f_pre.astype(jnp.float32)
    log_f = jnp.logaddexp(jnp.log(lb), jnp.log1p(-lb) + jax.nn.log_sigmoid(fp))
    k = (1.0 - lb) * jax.nn.sigmoid(-fp)
    return k, log_f


def chunk_scan(q, k, v, log_f, s0):
    n, t, h, _ = q.shape
    dv = v.shape[-1]
    nc = t // C_CHUNK

    def blocks(a):
        return a.reshape(n, nc, C_CHUNK, h, a.shape[-1]).transpose(1, 0, 3, 2, 4)

    mask = jnp.tril(jnp.ones((C_CHUNK, C_CHUNK), dtype=bool))

    def step(state, inp):
        qc, kc, vc, gc = inp
        b = jnp.cumsum(gc, axis=2)
        b_last = b[:, :, -1:, :]
        o = jnp.einsum('nhtk,nhkv->nhtv', qc * jnp.exp(b), state)
        diff = jnp.where(mask[:, :, None], b[:, :, :, None, :] - b[:, :, None, :, :], -jnp.inf)
        att = jnp.einsum('nhtk,nhsk,nhtsk->nhts', qc, kc, jnp.exp(diff))
        o = o + jnp.einsum('nhts,nhsv->nhtv', att, vc)
        state = (jnp.exp(b_last[:, :, 0, :])[..., None] * state
                 + jnp.einsum('nhsk,nhsv->nhkv', kc * jnp.exp(b_last - b), vc))
        return state, o

    s_final, o = lax.scan(step, s0, (blocks(q), blocks(k), blocks(v), blocks(log_f)))
    o = o.transpose(1, 0, 3, 2, 4).reshape(n, t, h, dv)
    return o, s_final


def bidir_hgrn2(q, f_fwd, f_bwd, i, lb, s0):
    k_f, g_f = hgrn2_gates(f_fwd, lb[0])
    k_b, g_b = hgrn2_gates(f_bwd, lb[1])
    qf = q.astype(jnp.float32)
    vf = i.astype(jnp.float32)

    def flip(a):
        return jnp.flip(a, axis=1)

    o, s = chunk_scan(jnp.concatenate([qf, flip(qf)], axis=0),
                      jnp.concatenate([k_f, flip(k_b)], axis=0),
                      jnp.concatenate([vf, flip(vf)], axis=0),
                      jnp.concatenate([g_f, flip(g_b)], axis=0), s0)
    bsz = q.shape[0]
    return o[:bsz] + flip(o[bsz:]), s


def c_mixer(h_lat, h_ctx, w_in, lb, g_norm_w, w_out, with_ctx_out):
    sizes = [C_FDIM, C_FDIM, C_FDIM, C_WIDTH, C_WIDTH]

    def prep(h):
        bsz, t, _ = h.shape
        q, ff, fb, i, g = split_cols(h @ w_in, sizes)

        def heads_k(a):
            return a.reshape(bsz, t, C_HEADS, C_KEY)

        return jax.nn.silu(heads_k(q)), heads_k(ff), heads_k(fb), i.reshape(bsz, t, C_HEADS, C_VAL), g

    def readout(o, g):
        o = rmsnorm(o, g_norm_w).astype(g.dtype)
        return (o.reshape(g.shape) * jax.nn.silu(g)) @ w_out

    q_c, ff_c, fb_c, i_c, g_c = prep(h_ctx)
    s0 = jnp.zeros((2 * h_ctx.shape[0], C_HEADS, C_KEY, C_VAL), jnp.float32)
    o_c, s_ctx = bidir_hgrn2(q_c, ff_c, fb_c, i_c, lb, s0)
    q_l, ff_l, fb_l, i_l, g_l = prep(h_lat)
    o_l, _ = bidir_hgrn2(q_l, ff_l, fb_l, i_l, lb, s_ctx)
    y_l = readout(o_l, g_l)
    y_c = readout(o_c, g_c) if with_ctx_out else None
    return y_l, y_c


def setup_inputs(seed: int = 0) -> dict:
    key = jax.random.key(seed)
    ks = jax.random.split(key, 24)

    def nrm(k, shape, scale):
        return jax.random.normal(k, shape, jnp.float32) * scale

    return {
        'x': nrm(ks[0], (BATCH, SEQ, D_MODEL), 1.0),
        'c': nrm(ks[1], (BATCH, D_MODEL), 1.0),
        'ctx': nrm(ks[2], (BATCH, CTX_LEN, D_MODEL), 1.0),
        'c_ctx': nrm(ks[3], (D_MODEL,), 1.0),
        'w_ada': nrm(ks[4], (DEPTH, D_MODEL, 3 * D_MODEL), 0.5 * D_MODEL ** -0.5),
        'b_ada': nrm(ks[5], (DEPTH, 3 * D_MODEL), 0.02),
        'norm_pre_w': 1.0 + nrm(ks[6], (DEPTH, D_MODEL), 0.02),
        'norm_post_w': 1.0 + nrm(ks[7], (DEPTH, D_MODEL), 0.02),
        'ab_w_in': nrm(ks[8], (N_AB, D_MODEL, IN_AB), D_MODEL ** -0.5),
        'ab_q_norm_w': 1.0 + nrm(ks[9], (N_AB, Q_LORA), 0.02),
        'ab_kv_norm_w': 1.0 + nrm(ks[10], (N_AB, KV_LORA), 0.02),
        'ab_w_q_up': nrm(ks[11], (N_AB, Q_LORA, A_HEADS * (A_NOPE + A_ROPE)), Q_LORA ** -0.5),
        'ab_w_kv_up': nrm(ks[12], (N_AB, KV_LORA, A_HEADS * (A_NOPE + A_V_DIM)), KV_LORA ** -0.5),
        'ab_sgu_ln_w': 1.0 + nrm(ks[13], (N_AB, B_WIDTH), 0.02),
        'ab_sgu_ln_b': nrm(ks[14], (N_AB, B_WIDTH), 0.02),
        'ab_w_s': nrm(ks[15], (N_AB, B_GROUPS, B_CHUNK, B_CHUNK), B_CHUNK ** -0.5),
        'ab_b_s': 1.0 + nrm(ks[16], (N_AB, B_GROUPS, B_CHUNK), 0.1),
        'ab_w_out': nrm(ks[17], (N_AB, MIX_W, D_MODEL), MIX_W ** -0.5),
        'c_w_in': nrm(ks[18], (N_C, D_MODEL, IN_C), D_MODEL ** -0.5),
        'c_lb_logits': nrm(ks[19], (DEPTH, 2, C_FDIM), 0.5),
        'c_g_norm_w': 1.0 + nrm(ks[20], (N_C, C_VAL), 0.02),
        'c_w_out': nrm(ks[21], (N_C, C_WIDTH, D_MODEL), C_WIDTH ** -0.5),
    }


def reference(x, c, ctx, c_ctx, w_ada, b_ada, norm_pre_w, norm_post_w, ab_w_in, ab_q_norm_w,
              ab_kv_norm_w, ab_w_q_up, ab_w_kv_up, ab_sgu_ln_w, ab_sgu_ln_b, ab_w_s, ab_b_s, ab_w_out,
              c_w_in, c_lb_logits, c_g_norm_w, c_w_out):
    sm = jax.nn.softmax(c_lb_logits.astype(jnp.float32), axis=0)
    lb_all = jnp.cumsum(sm, axis=0) - sm[:1]
    silu_c = jax.nn.silu(c)
    silu_cc = jax.nn.silu(c_ctx)
    ctx_s = ctx
    for layer in range(DEPTH):
        mod_l = silu_c @ w_ada[layer] + b_ada[layer]
        mod_c = silu_cc @ w_ada[layer] + b_ada[layer]
        shift_l, scale_l, gate_l = jnp.split(mod_l, 3, axis=-1)
        shift_c, scale_c, gate_c = jnp.split(mod_c, 3, axis=-1)
        h_l = rmsnorm(x, norm_pre_w[layer]) * (1.0 + scale_l[:, None, :]) + shift_l[:, None, :]
        h_c = rmsnorm(ctx_s, norm_pre_w[layer]) * (1.0 + scale_c) + shift_c
        with_ctx_out = layer < DEPTH - 1
        j = layer // 2
        if layer % 2 == 0:
            y_l, y_c = ab_mixer(h_l, h_c, ab_w_in[j], ab_q_norm_w[j], ab_kv_norm_w[j], ab_w_q_up[j],
                                ab_w_kv_up[j], ab_sgu_ln_w[j], ab_sgu_ln_b[j], ab_w_s[j], ab_b_s[j],
                                ab_w_out[j], with_ctx_out)
        else:
            lb = lb_all[layer].reshape(2, C_HEADS, C_KEY)
            y_l, y_c = c_mixer(h_l, h_c, c_w_in[j], lb, c_g_norm_w[j], c_w_out[j], with_ctx_out)
        x = x + gate_l[:, None, :] * rmsnorm(y_l, norm_post_w[layer])
        if with_ctx_out:
            ctx_s = ctx_s + gate_c * rmsnorm(y_c, norm_post_w[layer])
    return x
```

```cpp
#include <hip/hip_runtime.h>
#include <cstdio>
#include <cstdint>
namespace pg8 {
#define PG8_LAS __attribute__((address_space(3)))
typedef unsigned short bf16_t;
typedef short bf16x8 __attribute__((ext_vector_type(8)));
typedef float f32x4 __attribute__((ext_vector_type(4)));
typedef unsigned u32x4 __attribute__((ext_vector_type(4)));
constexpr int BM = 256, BK = 64, HALF = 128, HTB = HALF * BK * 2  , STAGE_BYTES = 8 * HTB, NXCD = 8, WGM = 8;

__host__ __device__ __forceinline__ int lds_byte(int r, int c) { const int st = (r >> 4) * 2 + (c >> 5), rr = r & 15, cc = c & 31, ob = rr * 64 + cc * 2; return st * 1024 + (ob ^ (((ob >> 9) & 1) << 5)); }
__host__ __device__ __forceinline__ void stage_rc(int b, int& R, int& C) { const int st = b / 1024, sb = b % 1024, swz = sb ^ (((sb >> 9) & 1) << 5); R = (st >> 1) * 16 + swz / 64; C = (st & 1) * 32 + (swz % 64) / 2; }
__host__ __device__ __forceinline__ int perm32(int rho) { const int n = rho >> 4, i = rho & 15; return 8 * (i >> 2) + 4 * n + (i & 3); }

struct Unit { int pm, pn; };
struct Gemm { const bf16_t* A; const bf16_t* Bt; int M, N, K; };

struct StaticOrder {
    int nM, nN, nwg, G, c;
    __host__ __device__ void init(int M, int N, int G_, int c_) { nM = M / BM; nN = N / BM; nwg = nM * nN; G = G_; c = c_; }
    __host__ __device__ bool next(int i, Unit& u) const {
        const long L = (long)i * G + c; if (L >= nwg) return false;
        int wgid = (int)L; { const int q = nwg / NXCD, r = nwg % NXCD, xcd = wgid % NXCD, off = wgid / NXCD; wgid = (xcd < r ? xcd * (q + 1) : r * (q + 1) + (xcd - r) * q) + off; }
        const int nig = WGM * nN, gid = wgid / nig, fm = gid * WGM, gsz = (nM - fm) < WGM ? (nM - fm) : WGM;
        u.pm = fm + ((wgid % nig) % gsz); u.pn = (wgid % nig) / gsz; return true;
    }
    __device__ __forceinline__ void a_ready(const Unit&) const {}
    __device__ __forceinline__ void done(const Unit&) const {}
};

__device__ __forceinline__ unsigned cvt_pk_bf16(float lo, float hi) { unsigned r; asm volatile("v_cvt_pk_bf16_f32 %0, %1, %2" : "=v"(r) : "v"(lo), "v"(hi)); return r; }
typedef float f32x2 __attribute__((ext_vector_type(2)));
__device__ __forceinline__ f32x2 gelu_pk(f32x2 v) {
    const f32x2 av = __builtin_elementwise_abs(v), d = av * 0.2316418882f + 1.0f;
    f32x2 t; t.x = __builtin_amdgcn_rcpf(d.x); t.y = __builtin_amdgcn_rcpf(d.y);
    f32x2 q = t * 0.5307027145f + (-0.7265760135f); q = q * t + 0.7107068705f; q = q * t + (-0.142248368f); q = q * t + 0.127414796f; q = q * t;
    const f32x2 s = (v * v) * (-0.72134752044f);
    f32x2 e; e.x = __builtin_amdgcn_exp2f(s.x); e.y = __builtin_amdgcn_exp2f(s.y);
    const f32x2 m = v * (q * e), r = v - m;
    f32x2 o; o.x = v.x < 0.f ? m.x : r.x; o.y = v.y < 0.f ? m.y : r.y; return o;
}

typedef unsigned u32x2 __attribute__((ext_vector_type(2)));
__device__ __forceinline__ float silu_f(float x) { return x * __builtin_amdgcn_rcpf(1.0f + __builtin_amdgcn_exp2f(-1.4426950408889634f * x)); }
__device__ __forceinline__ float sigmoid_neg_f(float x) { return __builtin_amdgcn_rcpf(1.0f + __builtin_amdgcn_exp2f(1.4426950408889634f * x)); }
__device__ __forceinline__ f32x4 act4(f32x4 v, int act) {
    if (act == 1) { v[0] = silu_f(v[0]); v[1] = silu_f(v[1]); v[2] = silu_f(v[2]); v[3] = silu_f(v[3]); }
    else if (act == 2) { const f32x2 a = gelu_pk((f32x2){v[0], v[1]}), b = gelu_pk((f32x2){v[2], v[3]}); v = (f32x4){a.x, a.y, b.x, b.y}; }
    return v;
}
struct EpiF32 {
    static constexpr bool PERM = false, AFTER_DRAIN = false;
    float* C; int ldc;
    __device__ __forceinline__ void operator()(const f32x4 (&acc)[2][2][4][2], const Unit& u, int wr, int wc, int fr, int fq) const {
        const int row0 = u.pm * BM + wr * 64 + fr, col0 = u.pn * BM + wc * 32 + 4 * fq;
#pragma unroll
        for (int ai = 0; ai < 2; ++ai)
#pragma unroll
            for (int m = 0; m < 4; ++m) { float* rowp = C + (size_t)(row0 + ai * HALF + m * 16) * ldc + col0;
#pragma unroll
                for (int bj = 0; bj < 2; ++bj)
#pragma unroll
                    for (int n = 0; n < 2; ++n) *(f32x4*)(rowp + bj * HALF + n * 16) = acc[ai][bj][m][n]; }
    }
};
struct EpiAB1 {
    static constexpr bool PERM = true, AFTER_DRAIN = false;
    bf16_t* O; int ldc;
    __device__ __forceinline__ void operator()(const f32x4 (&acc)[2][2][4][2], const Unit& u, int wr, int wc, int fr, int fq) const {
        const int act = u.pn < 7 ? 0 : ((u.pn < 23 || u.pn >= 55) ? 1 : 2);
        const int row0 = u.pm * BM + wr * 64 + fr, col0 = u.pn * BM + wc * 32 + 8 * fq;
#pragma unroll
        for (int ai = 0; ai < 2; ++ai)
#pragma unroll
            for (int m = 0; m < 4; ++m) { bf16_t* rowp = O + (size_t)(row0 + ai * HALF + m * 16) * ldc + col0;
#pragma unroll
                for (int bj = 0; bj < 2; ++bj) { const f32x4 v0 = act4(acc[ai][bj][m][0], act), v1 = act4(acc[ai][bj][m][1], act);
                    u32x4 w; w.x = cvt_pk_bf16(v0[0], v0[1]); w.y = cvt_pk_bf16(v0[2], v0[3]); w.z = cvt_pk_bf16(v1[0], v1[1]); w.w = cvt_pk_bf16(v1[2], v1[3]);
                    *(u32x4*)(rowp + bj * HALF) = w; } }
    }
};
struct EpiC1 {
    static constexpr bool PERM = true, AFTER_DRAIN = false;
    bf16_t* O; size_t stride; const float* oml;
    __device__ __forceinline__ void operator()(const f32x4 (&acc)[2][2][4][2], const Unit& u, int wr, int wc, int fr, int fq) const {
        const int region = u.pn >> 5; bf16_t* base = O + (size_t)region * stride;
        const int row0 = u.pm * BM + wr * 64 + fr, col0 = (u.pn & 31) * BM + wc * 32 + 8 * fq;
        const bool gate = (region == 1 || region == 2); const int act = (region == 0 || region == 4) ? 1 : 0;
        f32x4 gv[2][2];
#pragma unroll
        for (int bj = 0; bj < 2; ++bj)
#pragma unroll
            for (int n = 0; n < 2; ++n) gv[bj][n] = gate ? *(const f32x4*)(oml + (size_t)(region - 1) * 8192 + col0 + bj * HALF + 4 * n) : (f32x4){1.f, 1.f, 1.f, 1.f};
#pragma unroll
        for (int ai = 0; ai < 2; ++ai)
#pragma unroll
            for (int m = 0; m < 4; ++m) { bf16_t* rowp = base + (size_t)(row0 + ai * HALF + m * 16) * 8192 + col0;
#pragma unroll
                for (int bj = 0; bj < 2; ++bj) { f32x4 v0 = acc[ai][bj][m][0], v1 = acc[ai][bj][m][1];
                    if (gate) {
#pragma unroll
                        for (int j = 0; j < 4; ++j) { v0[j] = gv[bj][0][j] * sigmoid_neg_f(v0[j]); v1[j] = gv[bj][1][j] * sigmoid_neg_f(v1[j]); } }
                    else { v0 = act4(v0, act); v1 = act4(v1, act); }
                    u32x4 w; w.x = cvt_pk_bf16(v0[0], v0[1]); w.y = cvt_pk_bf16(v0[2], v0[3]); w.z = cvt_pk_bf16(v1[0], v1[1]); w.w = cvt_pk_bf16(v1[2], v1[3]);
                    *(u32x4*)(rowp + bj * HALF) = w; } }
    }
};
struct EpiQ {
    static constexpr bool PERM = false, AFTER_DRAIN = false;
    bf16_t* O; const f32x2* rope; int nlat;
    __device__ __forceinline__ void operator()(const f32x4 (&acc)[2][2][4][2], const Unit& u, int wr, int wc, int fr, int fq) const {
        const int row0 = u.pm * BM + wr * 64 + fr;
#pragma unroll
        for (int bj = 0; bj < 2; ++bj) {
            const int G = 8 * u.pn + 4 * bj + wc, hm = G % 6, col = u.pn * BM + bj * HALF + wc * 32 + 4 * fq;
#pragma unroll
            for (int ai = 0; ai < 2; ++ai)
#pragma unroll
                for (int m = 0; m < 4; ++m) { const int row = row0 + ai * HALF + m * 16; f32x4 x0 = acc[ai][bj][m][0], x1 = acc[ai][bj][m][1];
                    if (hm >= 4 && row < nlat) { const int t = row & 8191, pos = (hm == 4) ? (t >> 6) : (t & 63); const f32x2* cs = rope + pos * 16 + 4 * fq;
#pragma unroll
                        for (int j = 0; j < 4; ++j) { const f32x2 c = cs[j]; const float a = x0[j], b = x1[j]; x0[j] = a * c.x - b * c.y; x1[j] = b * c.x + a * c.y; } }
                    bf16_t* p = O + (size_t)row * 6144 + col;
                    u32x2 w0, w1; w0.x = cvt_pk_bf16(x0[0], x0[1]); w0.y = cvt_pk_bf16(x0[2], x0[3]); w1.x = cvt_pk_bf16(x1[0], x1[1]); w1.y = cvt_pk_bf16(x1[2], x1[3]);
                    *(u32x2*)p = w0; *(u32x2*)(p + 16) = w1; }
        }
    }
};
struct EpiKV {
    static constexpr bool PERM = true, AFTER_DRAIN = false;
    bf16_t* KN; bf16_t* V;
    __device__ __forceinline__ void operator()(const f32x4 (&acc)[2][2][4][2], const Unit& u, int wr, int wc, int fr, int fq) const {
        const int row0 = u.pm * BM + wr * 64 + fr, col0 = u.pn * HALF + wc * 32 + 8 * fq;
#pragma unroll
        for (int ai = 0; ai < 2; ++ai)
#pragma unroll
            for (int m = 0; m < 4; ++m) { const size_t off = (size_t)(row0 + ai * HALF + m * 16) * 4096 + col0;
#pragma unroll
                for (int bj = 0; bj < 2; ++bj) { const f32x4 v0 = acc[ai][bj][m][0], v1 = acc[ai][bj][m][1];
                    u32x4 w; w.x = cvt_pk_bf16(v0[0], v0[1]); w.y = cvt_pk_bf16(v0[2], v0[3]); w.z = cvt_pk_bf16(v1[0], v1[1]); w.w = cvt_pk_bf16(v1[2], v1[3]);
                    *(u32x4*)((bj ? V : KN) + off) = w; } }
    }
};

template <class Epi, class Sched, bool ALIGN_EPI = false, bool SP2 = false>
__device__ __forceinline__ void gemm_phase(PG8_LAS unsigned char* lds, const Gemm g, const Sched& S, const Epi& E) {
    int tid_l = threadIdx.x; asm volatile("" : "+v"(tid_l)); const int tid = tid_l, wid = __builtin_amdgcn_readfirstlane(tid >> 6), lane = tid & 63, wr = wid >> 2, wc = wid & 3, fr = lane & 15, fq = lane >> 4;
    const int K = g.K, nt = K / BK;
    unsigned voffA[2], voffB[2];
#pragma unroll
    for (int i = 0; i < 2; ++i) { int R, C; stage_rc(tid * 16 + i * 8192, R, C); const int Rb = Epi::PERM ? ((R & ~31) + perm32(R & 31)) : R;
        voffA[i] = (unsigned)(R * K + C) * 2u; voffB[i] = (unsigned)(Rb * K + C) * 2u; }
    const size_t kstep = (size_t)(BK * 2);
    const size_t hstep = (size_t)HALF * K * 2;
    const size_t tstep = 2 * hstep;
    const unsigned ldsw = (unsigned)wid * 1024u;
    const int aoff = lds_byte(wr * 64 + fr, fq * 8), boff = lds_byte(wc * 32 + fr, fq * 8);
#define PG8_SA(b, h) (((b) * 2 + (h)) * HTB)
#define PG8_SB(b, h) ((4 + (b) * 2 + (h)) * HTB)
#define PG8_STAGE(bufoff, gbase, voff) do { _Pragma("unroll") for (int _i = 0; _i < 2; ++_i) \
        __builtin_amdgcn_global_load_lds((const unsigned*)((const char*)(gbase) + (voff)[_i]), (PG8_LAS unsigned*)(lds + (bufoff) + ldsw + _i * 8192), 16, 0, 0); } while (0)
#define PG8_LDA(dst, b, h) do { _Pragma("unroll") for (int m = 0; m < 4; ++m) _Pragma("unroll") for (int k = 0; k < 2; ++k) dst[m][k] = *(const PG8_LAS bf16x8*)(lds + PG8_SA(b, h) + aoff + m * 2048 + k * 1024); } while (0)
#define PG8_LDB(dst, b, h) do { _Pragma("unroll") for (int n = 0; n < 2; ++n) _Pragma("unroll") for (int k = 0; k < 2; ++k) dst[n][k] = *(const PG8_LAS bf16x8*)(lds + PG8_SB(b, h) + boff + n * 2048 + k * 1024); } while (0)
#define PG8_MMA(ai, bj, At, Bt) do { __builtin_amdgcn_s_setprio(1); _Pragma("unroll") for (int m = 0; m < 4; ++m) _Pragma("unroll") for (int n = 0; n < 2; ++n) _Pragma("unroll") for (int k = 0; k < 2; ++k) \
        acc[ai][bj][m][n] = __builtin_amdgcn_mfma_f32_16x16x32_bf16(Bt[n][k], At[m][k], acc[ai][bj][m][n], 0, 0, 0); __builtin_amdgcn_s_setprio(0); } while (0)
#define PG8_WAIT_V(n) asm volatile("s_waitcnt vmcnt(" #n ")" ::: "memory")
#define PG8_WAIT_L(n) asm volatile("s_waitcnt lgkmcnt(" #n ")" ::: "memory")
#define PG8_BAR __builtin_amdgcn_s_barrier()
#define PG8_SCHED __builtin_amdgcn_sched_barrier(0)
    Unit cur, nxt; int ui = 0;
    if (!S.next(0, cur)) return;
    f32x4 acc[2][2][4][2];
#pragma unroll
    for (int a = 0; a < 2; ++a)
#pragma unroll
        for (int b = 0; b < 2; ++b)
#pragma unroll
            for (int m = 0; m < 4; ++m)
#pragma unroll
                for (int n = 0; n < 2; ++n) acc[a][b][m][n] = (f32x4){0.f, 0.f, 0.f, 0.f};
    bf16x8 At[4][2], B0[2][2], B1[2][2];
    const char* cA = (const char*)g.A + (size_t)cur.pm * tstep; const char* cB = (const char*)g.Bt + (size_t)cur.pn * tstep;
    S.a_ready(cur);
    if constexpr (SP2) {
        PG8_STAGE(PG8_SB(0, 0), cB, voffB); PG8_STAGE(PG8_SB(0, 1), cB + hstep, voffB); PG8_STAGE(PG8_SA(0, 0), cA, voffA); PG8_STAGE(PG8_SA(0, 1), cA + hstep, voffA);
        if (wr == 1) PG8_BAR;
        PG8_WAIT_V(2); PG8_BAR;
        PG8_STAGE(PG8_SB(1, 0), cB + kstep, voffB); PG8_STAGE(PG8_SA(1, 0), cA + kstep, voffA); PG8_STAGE(PG8_SB(1, 1), cB + hstep + kstep, voffB);
        PG8_WAIT_V(6); PG8_BAR;
    } else {
        PG8_STAGE(PG8_SB(0, 0), cB, voffB); PG8_STAGE(PG8_SA(0, 0), cA, voffA); PG8_STAGE(PG8_SB(0, 1), cB + hstep, voffB); PG8_STAGE(PG8_SA(0, 1), cA + hstep, voffA);
        if (wr == 1) PG8_BAR;
        PG8_WAIT_V(4); PG8_BAR;
        PG8_STAGE(PG8_SB(1, 0), cB + kstep, voffB); PG8_STAGE(PG8_SA(1, 0), cA + kstep, voffA); PG8_STAGE(PG8_SB(1, 1), cB + hstep + kstep, voffB);
        PG8_WAIT_V(6); PG8_BAR;
    }
    for (;;) {
        const bool has_next = S.next(ui + 1, nxt);
        const char* nA = has_next ? (const char*)g.A + (size_t)nxt.pm * tstep : cA; const char* nB = has_next ? (const char*)g.Bt + (size_t)nxt.pn * tstep : cB;
        for (int t = 0; t < nt; t += 2) {
            const bool last = (t == nt - 2);
            const char* a1 = cA + (size_t)(t + 1) * kstep;
            const char* a2 = last ? nA : cA + (size_t)(t + 2) * kstep; const char* b2 = last ? nB : cB + (size_t)(t + 2) * kstep;
            const char* a3 = a2 + kstep; const char* b3 = b2 + kstep;
            if (last && has_next) S.a_ready(nxt);
            if constexpr (SP2) {
            PG8_LDB(B0, 0, 0); PG8_LDB(B1, 0, 1); PG8_SCHED; PG8_LDA(At, 0, 0); PG8_STAGE(PG8_SA(1, 1), a1 + hstep, voffA);
            PG8_WAIT_V(8); PG8_WAIT_L(0); PG8_BAR; PG8_MMA(0, 0, At, B0); PG8_MMA(0, 1, At, B1); PG8_BAR; PG8_SCHED;
            PG8_LDA(At, 0, 1); PG8_STAGE(PG8_SB(0, 0), b2, voffB); PG8_STAGE(PG8_SB(0, 1), b2 + hstep, voffB); PG8_STAGE(PG8_SA(0, 0), a2, voffA);
            PG8_WAIT_V(8); PG8_WAIT_L(0); PG8_BAR; PG8_MMA(1, 0, At, B0); PG8_MMA(1, 1, At, B1); PG8_BAR; PG8_SCHED;
            PG8_LDB(B0, 1, 0); PG8_LDB(B1, 1, 1); PG8_SCHED; PG8_LDA(At, 1, 0); PG8_STAGE(PG8_SA(0, 1), a2 + hstep, voffA);
            PG8_WAIT_V(8); PG8_WAIT_L(0); PG8_BAR; PG8_MMA(0, 0, At, B0); PG8_MMA(0, 1, At, B1); PG8_BAR; PG8_SCHED;
            PG8_LDA(At, 1, 1); PG8_STAGE(PG8_SB(1, 0), b3, voffB); PG8_STAGE(PG8_SB(1, 1), b3 + hstep, voffB); PG8_STAGE(PG8_SA(1, 0), a3, voffA);
            PG8_WAIT_V(8); PG8_WAIT_L(0); PG8_BAR; PG8_MMA(1, 0, At, B0); PG8_MMA(1, 1, At, B1); PG8_BAR; PG8_SCHED;
            } else {
            PG8_LDB(B0, 0, 0); PG8_SCHED; PG8_LDA(At, 0, 0); PG8_STAGE(PG8_SA(1, 1), a1 + hstep, voffA);
            PG8_WAIT_L(8); PG8_BAR; PG8_WAIT_L(0); PG8_MMA(0, 0, At, B0); PG8_BAR; PG8_SCHED;
            PG8_LDB(B1, 0, 1); PG8_STAGE(PG8_SB(0, 0), b2, voffB);
            PG8_BAR; PG8_WAIT_L(0); PG8_MMA(0, 1, At, B1); PG8_BAR;
            PG8_LDA(At, 0, 1); PG8_STAGE(PG8_SA(0, 0), a2, voffA);
            PG8_BAR; PG8_WAIT_L(0); PG8_MMA(1, 0, At, B0); PG8_BAR; PG8_SCHED;
            PG8_STAGE(PG8_SB(0, 1), b2 + hstep, voffB);
            PG8_WAIT_V(6); PG8_BAR; PG8_MMA(1, 1, At, B1); PG8_BAR;
            PG8_LDB(B0, 1, 0); PG8_SCHED; PG8_LDA(At, 1, 0); PG8_STAGE(PG8_SA(0, 1), a2 + hstep, voffA);
            PG8_WAIT_L(8); PG8_BAR; PG8_WAIT_L(0); PG8_MMA(0, 0, At, B0); PG8_BAR; PG8_SCHED;
            PG8_LDB(B1, 1, 1); PG8_STAGE(PG8_SB(1, 0), b3, voffB);
            PG8_BAR; PG8_WAIT_L(0); PG8_MMA(0, 1, At, B1); PG8_BAR;
            PG8_LDA(At, 1, 1); PG8_STAGE(PG8_SA(1, 0), a3, voffA);
            PG8_BAR; PG8_WAIT_L(0); PG8_MMA(1, 0, At, B0); PG8_BAR; PG8_SCHED;
            PG8_STAGE(PG8_SB(1, 1), b3 + hstep, voffB);
            PG8_WAIT_V(6); PG8_BAR; PG8_MMA(1, 1, At, B1); PG8_BAR;
            }
        }
        if constexpr (ALIGN_EPI) { if (wr == 0) PG8_BAR; }
        if constexpr (!Epi::AFTER_DRAIN) { E(acc, cur, wr, wc, fr, fq); S.done(cur); }
        if (!has_next) break;
#pragma unroll
        for (int a = 0; a < 2; ++a)
#pragma unroll
            for (int b = 0; b < 2; ++b)
#pragma unroll
                for (int m = 0; m < 4; ++m)
#pragma unroll
                    for (int n = 0; n < 2; ++n) acc[a][b][m][n] = (f32x4){0.f, 0.f, 0.f, 0.f};
        cur = nxt; cA = nA; cB = nB; ++ui;
        if constexpr (ALIGN_EPI) { if (wr == 1) PG8_BAR; }
    }
    PG8_WAIT_V(0);
    if constexpr (!ALIGN_EPI) { if (wr == 0) PG8_BAR; }
    PG8_BAR;
    if constexpr (Epi::AFTER_DRAIN) { E.fused(acc, cur, wr, wc, fr, fq, lds, wid, lane); S.done(cur); }
#undef PG8_SA
#undef PG8_SB
#undef PG8_STAGE
#undef PG8_LDA
#undef PG8_LDB
#undef PG8_MMA
#undef PG8_WAIT_V
#undef PG8_WAIT_L
#undef PG8_BAR
#undef PG8_SCHED
}
}
#define GAS __attribute__((address_space(1)))
#define LAS __attribute__((address_space(3)))
typedef unsigned short bf16;
typedef unsigned v4u __attribute__((ext_vector_type(4)));
typedef float f32x4 __attribute__((ext_vector_type(4)));
typedef short bf16x8 __attribute__((ext_vector_type(8)));
typedef GAS unsigned gu32;
typedef GAS unsigned long long gu64;
#define RLX_AGENT __ATOMIC_RELAXED, __HIP_MEMORY_SCOPE_AGENT
#define LDS_WAIT() asm volatile("s_waitcnt lgkmcnt(0)" ::: "memory")
#define VM_WAIT() asm volatile("s_waitcnt vmcnt(0)" ::: "memory")
__device__ __forceinline__ unsigned long long rt() { return __builtin_amdgcn_s_memrealtime(); }
__device__ __forceinline__ unsigned f2bf(float f) { unsigned u = __builtin_bit_cast(unsigned, f); return (u + 0x7fffu + ((u >> 16) & 1u)) >> 16; }
__device__ __forceinline__ unsigned pk2(float lo, float hi) { return f2bf(lo) | (f2bf(hi) << 16); }

typedef unsigned u32x2 __attribute__((ext_vector_type(2)));
typedef float f32x2 __attribute__((ext_vector_type(2)));
#define XB_TMO      128
#define XB_XCNT(j)  (256  + 64 * (j))
#define XB_XSUB(j)  (1280 + 64 * (j))
#define XB_XGEN(j)  (2304 + 64 * (j))
#define XB_TOP      3328
#define XB_TOPGEN   3392
#define XCD_BAR_WORDS 3456
#define XB_SPIN_CAP (1u << 21)

__device__ __forceinline__ unsigned xb_ld(unsigned* p)              { return __hip_atomic_load(p, __ATOMIC_RELAXED, __HIP_MEMORY_SCOPE_AGENT); }
__device__ __forceinline__ unsigned xb_add(unsigned* p, unsigned v) { return __hip_atomic_fetch_add(p, v, __ATOMIC_RELAXED, __HIP_MEMORY_SCOPE_AGENT); }
__device__ __forceinline__ unsigned xb_xcc_id() { return (unsigned)__builtin_amdgcn_s_getreg((3 << 11) | 20) & 0xFu; }
#define XB_SPIN(cond, bar) do { unsigned _sp = 0; while (cond) { __builtin_amdgcn_s_sleep(1); \
    if ((++_sp & 255u) == 0u) { if (xb_ld(&(bar)[XB_TMO])) break; if (_sp > XB_SPIN_CAP) { atomicAdd(&(bar)[XB_TMO], 1u); break; } } } } while (0)

struct XcdBarrier {
    unsigned* bar; unsigned x;
    volatile LAS unsigned* st;
};

__device__ __forceinline__ XcdBarrier xcd_barrier_post(unsigned* bar, volatile LAS unsigned* st) {
    XcdBarrier b; b.bar = bar; b.x = xb_xcc_id(); b.st = st;
    if (threadIdx.x == 0) (void)xb_add(&bar[XB_XCNT(b.x)], 1u);
    return b;
}
__device__ __forceinline__ void xcd_barrier_complete(unsigned* bar, unsigned x, unsigned& nloc, unsigned& nx) {
    const unsigned G = gridDim.x * gridDim.y * gridDim.z;
    unsigned sum, cnt, mine, sp = 0u;
    for (;;) {
        sum = 0u; cnt = 0u; mine = 0u;
#pragma unroll
        for (unsigned j = 0; j < 16; ++j) { const unsigned c = xb_ld(&bar[XB_XCNT(j)]); sum += c; cnt += (c > 0u) ? 1u : 0u; mine = (j == x) ? c : mine; }
        if (sum == G) break;
        __builtin_amdgcn_s_sleep(1);
        if ((++sp & 255u) == 0u) { if (xb_ld(&bar[XB_TMO])) break; if (sp > XB_SPIN_CAP) { atomicAdd(&bar[XB_TMO], 1u); break; } }
    }
    nloc = mine > 0u ? mine : 1u; nx = cnt > 0u ? cnt : 1u;
}

__device__ __forceinline__ void xcd_barrier(const XcdBarrier& b) {
    asm volatile("s_waitcnt vmcnt(0)" ::: "memory");
    __syncthreads();
    if (threadIdx.x == 0) {
        unsigned* bar = b.bar;
        __builtin_amdgcn_s_waitcnt(0);
        unsigned nloc = b.st[0], nx = b.st[1];
        if (nloc == 0u) { xcd_barrier_complete(bar, b.x, nloc, nx); b.st[0] = nloc; b.st[1] = nx; }
        const unsigned old = xb_add(&bar[XB_XSUB(b.x)], 1u);
        const unsigned gen = old / nloc;
        if (old + 1u == (gen + 1u) * nloc) {
            __builtin_amdgcn_fence(__ATOMIC_RELEASE, "agent");
            asm volatile("s_waitcnt vmcnt(0)" ::: "memory");
            const unsigned og = xb_add(&bar[XB_TOP], 1u);
            const unsigned tg = og / nx;
            if (og + 1u == (tg + 1u) * nx) xb_add(&bar[XB_TOPGEN], 1u);
            else XB_SPIN(xb_ld(&bar[XB_TOPGEN]) == tg, bar);
            __builtin_amdgcn_fence(__ATOMIC_ACQUIRE, "agent");
            xb_add(&bar[XB_XGEN(b.x)], 1u);
            asm volatile("s_waitcnt vmcnt(0)" ::: "memory");
        } else {
            XB_SPIN(xb_ld(&bar[XB_XGEN(b.x)]) == gen, bar);
            __builtin_amdgcn_fence(__ATOMIC_ACQUIRE, "agent");
            asm volatile("s_waitcnt vmcnt(0)" ::: "memory");
        }
    }
    __syncthreads();
}


constexpr int NWAVES = 8;
constexpr int DM = 4096, NBATCH = 2, SEQ = 8192, NCTX = 256;
constexpr int MLAT = NBATCH * SEQ;
constexpr int MTOT = MLAT + NBATCH * NCTX;
constexpr int N_AB = 18176;
constexpr int N_ABSRC = 17984, N_C = 40960, MIXW = 8192;
constexpr int QL = 1024, KVL = 512, NQ = 6144, NKV = 8192;
constexpr int G1_CKV = 1024, G1_KR = 1536, G1_ZA = 1792, G1_UB = 5888, G1_VB = 9984, G1_ZB = 14080;
constexpr float EPS = 1e-6f;

constexpr size_t al256(size_t x) { return (x + 255) & ~(size_t)255; }
constexpr size_t WS_CTL = 0, CTL_ZERO_BYTES = 1u << 20;
constexpr size_t WS_MOD  = CTL_ZERO_BYTES;
constexpr size_t WS_OML  = WS_MOD  + al256((size_t)4 * 3 * 12288 * 4);
constexpr size_t WS_ROPE = WS_OML  + al256((size_t)2 * 2 * 8192 * 4);
constexpr size_t WS_STAT = WS_ROPE + al256((size_t)128 * 16 * 8);
constexpr size_t WS_WIN_AB = WS_STAT + al256((size_t)MTOT * 8);
constexpr size_t WS_WIN_C  = WS_WIN_AB + (size_t)2 * N_AB * DM * 2;
constexpr size_t WS_WO_AB  = WS_WIN_C + (size_t)2 * N_C * DM * 2;
constexpr size_t WS_WO_C   = WS_WO_AB + (size_t)2 * DM * MIXW * 2;
constexpr size_t WS_WQ     = WS_WO_C + (size_t)2 * DM * MIXW * 2;
constexpr size_t WS_WKV    = WS_WQ + (size_t)2 * NQ * QL * 2;
constexpr size_t WS_XS     = WS_WKV + (size_t)2 * NKV * KVL * 2;
constexpr size_t WS_H      = WS_XS + (size_t)MTOT * DM * 4;
constexpr size_t WS_Y      = WS_H + (size_t)MTOT * DM * 2;
constexpr size_t WS_G1     = WS_Y + (size_t)MTOT * DM * 4;
constexpr size_t WS_QN     = WS_G1 + (size_t)5 * MTOT * MIXW * 2;
constexpr size_t WS_KVN    = WS_QN + (size_t)MTOT * QL * 2;
constexpr size_t WS_KR     = WS_KVN + (size_t)MTOT * KVL * 2;
constexpr size_t WS_Q      = WS_KR + (size_t)MTOT * 64 * 2;
constexpr size_t WS_KN     = WS_Q + (size_t)MTOT * NQ * 2;
constexpr size_t WS_V      = WS_KN + (size_t)MTOT * DM * 2;
constexpr size_t WS_CC     = WS_V + (size_t)MTOT * DM * 2;
constexpr size_t WS_OF     = WS_CC + (size_t)MTOT * MIXW * 2;
constexpr size_t WS_END    = WS_OF + (size_t)2 * MTOT * MIXW * 2;
constexpr int CW_BAR = 4096;

constexpr int RING_BYTES = 135168;
constexpr int LDSCTL_OFF = RING_BYTES, MISC_OFF = LDSCTL_OFF + 64;
constexpr int LDS_BYTES = 147456;

struct Args { const float* in[22]; float* out; unsigned char* ws; int ph_lo, ph_hi; };
typedef const __attribute__((address_space(4))) Args* KArgs;
__device__ __forceinline__ KArgs kargs() { KArgs ap = (KArgs)__builtin_amdgcn_kernarg_segment_ptr(); asm volatile("" : "+s"(ap)); return ap; }

template <class T> __device__ __forceinline__ T* uni(T* p) {
    const unsigned long long v = (unsigned long long)p; const unsigned lo = __builtin_amdgcn_readfirstlane((unsigned)v), hi = __builtin_amdgcn_readfirstlane((unsigned)(v >> 32));
    return (T*)(((unsigned long long)hi << 32) | lo); }
__device__ __forceinline__ float wave_sum(float v) {
#pragma unroll
    for (int o = 1; o < 64; o <<= 1) v += __shfl_xor(v, o);
    return v;
}
__device__ __forceinline__ float bf_lo(unsigned w) { return __uint_as_float(w << 16); }
__device__ __forceinline__ float bf_hi(unsigned w) { return __uint_as_float(w & 0xffff0000u); }
__device__ __forceinline__ unsigned cvtpk(float lo, float hi) { unsigned r; asm volatile("v_cvt_pk_bf16_f32 %0, %1, %2" : "=v"(r) : "v"(lo), "v"(hi)); return r; }
__device__ __forceinline__ float silu_acc(float x) { return x / (1.0f + __expf(-x)); }

__device__ __forceinline__ void p0_gemv(KArgs a, LAS unsigned char* lds, int G) {
    int tid_l = threadIdx.x; asm volatile("" : "+v"(tid_l)); const int tid = tid_l, lane = tid & 63, wave = __builtin_amdgcn_readfirstlane(tid >> 6);
    LAS float* sc = (LAS float*)lds;
    LAS float* red = (LAS float*)(lds + 49152);
    const float* c = a->in[1]; const float* cctx = a->in[3]; const float* w_ada = a->in[4]; const float* b_ada = a->in[5];
    float* mod = (float*)(a->ws + WS_MOD);
    for (int i = tid; i < 3 * 4096; i += 512) { const int r = i >> 12, k = i & 4095; const float cv = r < 2 ? c[r * 4096 + k] : cctx[k]; sc[i] = silu_acc(cv); }
    __syncthreads();
    const int kr = lane >> 4, c4 = lane & 15;
    for (int item = blockIdx.x; item < 768; item += G) {
        const int l = item / 192, cg = item % 192;
        const float* W = w_ada + (size_t)l * 4096 * 12288 + cg * 64 + c4 * 4;
        float acc[3][4];
#pragma unroll
        for (int r = 0; r < 3; ++r)
#pragma unroll
            for (int j = 0; j < 4; ++j) acc[r][j] = 0.f;
        const int k0 = wave * 512 + kr;
#pragma unroll 8
        for (int i = 0; i < 128; ++i) { const int k = k0 + 4 * i; const f32x4 w = *(const f32x4*)(W + (size_t)k * 12288);
            const float s0 = sc[k], s1 = sc[4096 + k], s2 = sc[8192 + k];
#pragma unroll
            for (int j = 0; j < 4; ++j) { acc[0][j] += s0 * w[j]; acc[1][j] += s1 * w[j]; acc[2][j] += s2 * w[j]; } }
#pragma unroll
        for (int r = 0; r < 3; ++r)
#pragma unroll
            for (int j = 0; j < 4; ++j) { float v = acc[r][j]; v += __shfl_xor(v, 16); v += __shfl_xor(v, 32); acc[r][j] = v; }
        if (lane < 16) {
#pragma unroll
            for (int r = 0; r < 3; ++r)
#pragma unroll
                for (int j = 0; j < 4; ++j) red[(wave * 3 + r) * 64 + lane * 4 + j] = acc[r][j]; }
        __syncthreads();
        if (tid < 192) { const int r = tid >> 6, cc = tid & 63; float s = 0.f;
#pragma unroll
            for (int w = 0; w < 8; ++w) s += red[(w * 3 + r) * 64 + cc];
            const int col = cg * 64 + cc; mod[(size_t)(l * 3 + r) * 12288 + col] = s + b_ada[l * 12288 + col]; }
        __syncthreads();
    }
}
__device__ __forceinline__ void p0_tr_item(const float* W, int N, int K, bf16* WT, int n0s, int n0d, int k0, LAS float* scr, int lane) {
    const int kr = lane >> 4, c4 = lane & 15;
#pragma unroll 4
    for (int i = 0; i < 16; ++i) { const int k = 4 * i + kr; const f32x4 w = *(const f32x4*)(W + (size_t)(k0 + k) * N + n0s + 4 * c4);
        scr[(4 * c4 + 0) * 65 + k] = w[0]; scr[(4 * c4 + 1) * 65 + k] = w[1]; scr[(4 * c4 + 2) * 65 + k] = w[2]; scr[(4 * c4 + 3) * 65 + k] = w[3]; }
    LDS_WAIT(); asm volatile("" ::: "memory");
    const LAS float* s = scr + lane * 65; bf16* orow = WT + (size_t)(n0d + lane) * K + k0;
#pragma unroll
    for (int cch = 0; cch < 8; ++cch) { v4u o; o.x = cvtpk(s[8 * cch + 0], s[8 * cch + 1]); o.y = cvtpk(s[8 * cch + 2], s[8 * cch + 3]); o.z = cvtpk(s[8 * cch + 4], s[8 * cch + 5]); o.w = cvtpk(s[8 * cch + 6], s[8 * cch + 7]);
        *(v4u*)(orow + 8 * cch) = o; }
    LDS_WAIT(); asm volatile("" ::: "memory");
}
__device__ __forceinline__ void p0_prologue(KArgs a, LAS unsigned char* lds, int G) {
    int tid_l = threadIdx.x; asm volatile("" : "+v"(tid_l)); const int tid = tid_l, lane = tid & 63, wave = __builtin_amdgcn_readfirstlane(tid >> 6);
    p0_gemv(a, lds, G);
    __syncthreads();
    LAS float* scr = (LAS float*)(lds + wave * 16640);
    const int gw = blockIdx.x * NWAVES + wave, NGW = G * NWAVES;
    constexpr int I_IN_AB = 64 * 281, I_Q = 16 * 96, I_KV = 8 * 128, I_O = 128 * 64, I_IN_C = 64 * 640;
    constexpr int PER_J = I_IN_AB + I_Q + I_KV + I_O + I_IN_C + I_O;
    for (int it = gw; it < 2 * PER_J; it += NGW) {
        const int j = it / PER_J; int r = it % PER_J;
        if (r < I_IN_AB) { const int kb = r / 281, nb = r % 281, n0 = nb * 64;
            p0_tr_item(a->in[8] + (size_t)j * DM * N_ABSRC, N_ABSRC, DM, (bf16*)(a->ws + WS_WIN_AB) + (size_t)j * N_AB * DM, n0, n0 + (n0 >= 1600 ? 192 : 0), kb * 64, scr, lane); continue; } r -= I_IN_AB;
        if (r < I_Q) { const int kb = r / 96, nb = r % 96;
            p0_tr_item(a->in[11] + (size_t)j * QL * NQ, NQ, QL, (bf16*)(a->ws + WS_WQ) + (size_t)j * NQ * QL, nb * 64, nb * 64, kb * 64, scr, lane); continue; } r -= I_Q;
        if (r < I_KV) { const int kb = r / 128, nb = r % 128;
            p0_tr_item(a->in[12] + (size_t)j * KVL * NKV, NKV, KVL, (bf16*)(a->ws + WS_WKV) + (size_t)j * NKV * KVL, nb * 64, nb * 64, kb * 64, scr, lane); continue; } r -= I_KV;
        if (r < I_O) { const int kb = r / 64, nb = r % 64;
            p0_tr_item(a->in[17] + (size_t)j * MIXW * DM, DM, MIXW, (bf16*)(a->ws + WS_WO_AB) + (size_t)j * DM * MIXW, nb * 64, nb * 64, kb * 64, scr, lane); continue; } r -= I_O;
        if (r < I_IN_C) { const int kb = r / 640, nb = r % 640;
            p0_tr_item(a->in[18] + (size_t)j * DM * N_C, N_C, DM, (bf16*)(a->ws + WS_WIN_C) + (size_t)j * N_C * DM, nb * 64, nb * 64, kb * 64, scr, lane); continue; } r -= I_IN_C;
        { const int kb = r / 64, nb = r % 64;
            p0_tr_item(a->in[21] + (size_t)j * MIXW * DM, DM, MIXW, (bf16*)(a->ws + WS_WO_C) + (size_t)j * DM * MIXW, nb * 64, nb * 64, kb * 64, scr, lane); }
    }
    const size_t gt = (size_t)blockIdx.x * 512 + tid, NGT = (size_t)G * 512;
    for (size_t i = gt; i < (size_t)2 * 192 * DM / 8; i += NGT) { const size_t j = i / (192 * DM / 8), e = i % (192 * DM / 8);
        *(v4u*)((bf16*)(a->ws + WS_WIN_AB) + j * (size_t)N_AB * DM + (size_t)1600 * DM + e * 8) = (v4u){0u, 0u, 0u, 0u}; }
    { const float* lg = a->in[19]; float* oml = (float*)(a->ws + WS_OML);
      for (size_t i = gt; i < (size_t)2 * 2 * 8192; i += NGT) { const int jc = (int)(i >> 14), de = (int)(i & 16383);
          const float l0 = lg[0 * 16384 + de], l1 = lg[1 * 16384 + de], l2 = lg[2 * 16384 + de], l3 = lg[3 * 16384 + de];
          const float mx = fmaxf(fmaxf(l0, l1), fmaxf(l2, l3)); const float e0 = __expf(l0 - mx), e1 = __expf(l1 - mx), e2 = __expf(l2 - mx), e3 = __expf(l3 - mx);
          const float inv = 1.0f / (e0 + e1 + e2 + e3); const float lb = (jc == 0) ? e1 * inv : (e1 + e2 + e3) * inv;
          oml[i] = 1.0f - lb; } }
    { f32x2* rope = (f32x2*)(a->ws + WS_ROPE);
      for (size_t i = gt; i < 128 * 16; i += NGT) { const int pos = (int)(i >> 4), f = (int)(i & 15); const float inv = powf(10000.0f, -(float)f / 16.0f); const float ang = (float)pos * inv;
          rope[i] = (f32x2){cosf(ang), sinf(ang)}; } }
}

__device__ __forceinline__ void norm_phase(KArgs a, int lpost, int lpre, int G) {
    int tid_l = threadIdx.x; asm volatile("" : "+v"(tid_l)); const int tid = tid_l, lane = tid & 63, wave = __builtin_amdgcn_readfirstlane(tid >> 6);
    const int gw = blockIdx.x * NWAVES + wave, NGW = G * NWAVES;
    const float* mod = (const float*)(a->ws + WS_MOD);
    float* XS = (float*)(a->ws + WS_XS); const float* Y = (const float*)(a->ws + WS_Y); bf16* H = (bf16*)(a->ws + WS_H);
    const int nrows = (lpost == 3) ? MLAT : MTOT;
    for (int row = gw; row < nrows; row += NGW) {
        const int rt = row < SEQ ? 0 : (row < MLAT ? 1 : 2);
        const float* xin = uni((lpost <= 0) ? (row < MLAT ? a->in[0] + (size_t)row * DM : a->in[2] + (size_t)(row - MLAT) * DM) : XS + (size_t)row * DM);
        f32x4 xv[16];
#pragma unroll
        for (int j = 0; j < 16; ++j) xv[j] = *(const f32x4*)(xin + lane * 4 + 256 * j);
        if (lpost >= 0) {
            const float* yr = uni(Y + (size_t)row * DM); f32x4 yv[16]; float ss = 0.f;
#pragma unroll
            for (int j = 0; j < 16; ++j) { yv[j] = *(const f32x4*)(yr + lane * 4 + 256 * j); ss += (yv[j][0] * yv[j][0] + yv[j][1] * yv[j][1]) + (yv[j][2] * yv[j][2] + yv[j][3] * yv[j][3]); }
            const float r = 1.0f / sqrtf(wave_sum(ss) * (1.0f / DM) + EPS);
            const float* gate = uni(mod + (size_t)(lpost * 3 + rt) * 12288 + 8192); const float* pw = uni(a->in[7] + (size_t)lpost * DM);
            float* xout = uni((lpost == 3) ? a->out + (size_t)row * DM : XS + (size_t)row * DM);
#pragma unroll
            for (int j = 0; j < 16; ++j) { const int col = lane * 4 + 256 * j; const f32x4 g = *(const f32x4*)(gate + col), w = *(const f32x4*)(pw + col);
                xv[j] = xv[j] + g * ((yv[j] * r) * w); *(f32x4*)(xout + col) = xv[j];
                if ((j & 3) == 3) asm volatile("" ::: "memory"); }
        }
        if (lpre < 4) {
            float ss = 0.f;
#pragma unroll
            for (int j = 0; j < 16; ++j) ss += (xv[j][0] * xv[j][0] + xv[j][1] * xv[j][1]) + (xv[j][2] * xv[j][2] + xv[j][3] * xv[j][3]);
            const float r = 1.0f / sqrtf(wave_sum(ss) * (1.0f / DM) + EPS);
            const float* shift = uni(mod + (size_t)(lpre * 3 + rt) * 12288); const float* scale = shift + 4096; const float* pw = uni(a->in[6] + (size_t)lpre * DM);
            bf16* hr = uni(H + (size_t)row * DM);
#pragma unroll
            for (int j = 0; j < 16; ++j) { const int col = lane * 4 + 256 * j; const f32x4 sh = *(const f32x4*)(shift + col), sc = *(const f32x4*)(scale + col), w = *(const f32x4*)(pw + col);
                const f32x4 h = ((xv[j] * r) * w) * (sc + 1.0f) + sh; u32x2 o; o.x = cvtpk(h[0], h[1]); o.y = cvtpk(h[2], h[3]); *(u32x2*)(hr + col) = o;
                if ((j & 3) == 3) asm volatile("" ::: "memory"); }
        }
    }
}

__device__ __forceinline__ void a2_rows(KArgs a, int j, int G) {
    int tid_l = threadIdx.x; asm volatile("" : "+v"(tid_l)); const int tid = tid_l, lane = tid & 63, wave = __builtin_amdgcn_readfirstlane(tid >> 6);
    const int gw = blockIdx.x * NWAVES + wave, NGW = G * NWAVES;
    const bf16* G1 = (const bf16*)(a->ws + WS_G1); bf16* QN = (bf16*)(a->ws + WS_QN); bf16* KVN = (bf16*)(a->ws + WS_KVN); bf16* KR = (bf16*)(a->ws + WS_KR);
    f32x2* stat = (f32x2*)(a->ws + WS_STAT); const f32x2* rope = (const f32x2*)(a->ws + WS_ROPE);
    const float* qw = a->in[9] + (size_t)j * QL; const float* kvw = a->in[10] + (size_t)j * KVL;
    for (int row = gw; row < MTOT; row += NGW) {
        const bf16* g = uni(G1 + (size_t)row * N_AB);
        {
            v4u w[2]; float x[16]; float ss = 0.f;
#pragma unroll
            for (int i = 0; i < 2; ++i) { w[i] = *(const v4u*)(g + lane * 8 + 512 * i);
#pragma unroll
                for (int e = 0; e < 4; ++e) { x[8 * i + 2 * e] = bf_lo(w[i][e]); x[8 * i + 2 * e + 1] = bf_hi(w[i][e]); } }
#pragma unroll
            for (int e = 0; e < 16; ++e) ss += x[e] * x[e];
            const float r = 1.0f / sqrtf(wave_sum(ss) * (1.0f / QL) + EPS);
#pragma unroll
            for (int i = 0; i < 2; ++i) { const int col = lane * 8 + 512 * i; const f32x4 w0 = *(const f32x4*)(qw + col), w1 = *(const f32x4*)(qw + col + 4);
                v4u o; o.x = cvtpk(x[8 * i + 0] * r * w0[0], x[8 * i + 1] * r * w0[1]); o.y = cvtpk(x[8 * i + 2] * r * w0[2], x[8 * i + 3] * r * w0[3]);
                o.z = cvtpk(x[8 * i + 4] * r * w1[0], x[8 * i + 5] * r * w1[1]); o.w = cvtpk(x[8 * i + 6] * r * w1[2], x[8 * i + 7] * r * w1[3]);
                *(v4u*)(QN + (size_t)row * QL + col) = o; }
        }
        {
            const v4u w = *(const v4u*)(g + G1_CKV + lane * 8); float x[8]; float ss = 0.f;
#pragma unroll
            for (int e = 0; e < 4; ++e) { x[2 * e] = bf_lo(w[e]); x[2 * e + 1] = bf_hi(w[e]); }
#pragma unroll
            for (int e = 0; e < 8; ++e) ss += x[e] * x[e];
            const float r = 1.0f / sqrtf(wave_sum(ss) * (1.0f / KVL) + EPS);
            const int col = lane * 8; const f32x4 w0 = *(const f32x4*)(kvw + col), w1 = *(const f32x4*)(kvw + col + 4);
            v4u o; o.x = cvtpk(x[0] * r * w0[0], x[1] * r * w0[1]); o.y = cvtpk(x[2] * r * w0[2], x[3] * r * w0[3]); o.z = cvtpk(x[4] * r * w1[0], x[5] * r * w1[1]); o.w = cvtpk(x[6] * r * w1[2], x[7] * r * w1[3]);
            *(v4u*)(KVN + (size_t)row * KVL + col) = o;
        }
        {
            const float x = __uint_as_float((unsigned)g[G1_KR + lane] << 16); const float xp = __shfl_xor(x, 16); float o = x;
            if (row < MLAT) { const int t = row & (SEQ - 1), ax = lane >> 5, hh = (lane >> 4) & 1, f = lane & 15, pos = ax == 0 ? (t >> 6) : (t & 63); const f32x2 cs = rope[pos * 16 + f];
                o = hh == 0 ? x * cs.x - xp * cs.y : x * cs.x + xp * cs.y; }
            KR[(size_t)row * 64 + lane] = (bf16)(cvtpk(o, 0.f) & 0xffffu);
        }
        {
            float x[64]; float s = 0.f;
#pragma unroll
            for (int i = 0; i < 8; ++i) { const v4u w = *(const v4u*)(g + G1_VB + lane * 8 + 512 * i);
#pragma unroll
                for (int e = 0; e < 4; ++e) { x[8 * i + 2 * e] = bf_lo(w[e]); x[8 * i + 2 * e + 1] = bf_hi(w[e]); } }
#pragma unroll
            for (int e = 0; e < 64; ++e) s += x[e];
            const float mean = wave_sum(s) * (1.0f / 4096.0f); float q = 0.f;
#pragma unroll
            for (int e = 0; e < 64; ++e) { const float d = x[e] - mean; q += d * d; }
            const float rstd = 1.0f / sqrtf(wave_sum(q) * (1.0f / 4096.0f) + EPS);
            if (lane == 0) stat[row] = (f32x2){mean, rstd};
        }
    }
}

typedef short s16x4 __attribute__((ext_vector_type(4)));
typedef float f32x16 __attribute__((ext_vector_type(16)));
#define SBAR() __builtin_amdgcn_sched_barrier(0)
__device__ __forceinline__ int crow(int r, int hi) { return (r & 3) + 8 * (r >> 2) + 4 * hi; }
__device__ __forceinline__ int v_st(int k, int c) { const int kk = (k & ~0xC) | ((k & 4) << 1) | ((k & 8) >> 1); return ((kk >> 3) * 4 + (c >> 5)) * 512 + ((kk & 7) * 32 + (c & 31)) * 2; }
__device__ __forceinline__ int v_rd_base(int lane) { return ((lane & 3) << 3) | (((lane >> 2) & 3) << 6) | (((lane >> 4) & 1) << 5) | (((lane >> 5) & 1) << 8); }
constexpr int v_rd_off(int d0, int ks, int half) { return d0 * 512 + ks * 4096 + half * 2048; }
template <int OFF> __device__ __forceinline__ s16x4 tr_read(int vb) {
    s16x4 r; asm volatile("ds_read_b64_tr_b16 %0, %1 offset:%2" : "=&v"(r) : "v"(vb), "i"(OFF) : "memory"); return r;
}
template <int D0> __device__ __forceinline__ void pv_one(f32x16& od, int vb, bf16x8 pa0, bf16x8 pa1, bf16x8 pa2, bf16x8 pa3) {
    const s16x4 l0 = tr_read<v_rd_off(D0, 0, 0)>(vb), h0 = tr_read<v_rd_off(D0, 0, 1)>(vb), l1 = tr_read<v_rd_off(D0, 1, 0)>(vb), h1 = tr_read<v_rd_off(D0, 1, 1)>(vb);
    const s16x4 l2 = tr_read<v_rd_off(D0, 2, 0)>(vb), h2 = tr_read<v_rd_off(D0, 2, 1)>(vb), l3 = tr_read<v_rd_off(D0, 3, 0)>(vb), h3 = tr_read<v_rd_off(D0, 3, 1)>(vb);
    asm volatile("s_waitcnt lgkmcnt(0)" ::: "memory"); SBAR();
#define PKV(L, H) (bf16x8){L[0], L[1], L[2], L[3], H[0], H[1], H[2], H[3]}
    od = __builtin_amdgcn_mfma_f32_32x32x16_bf16(pa0, PKV(l0, h0), od, 0, 0, 0);
    od = __builtin_amdgcn_mfma_f32_32x32x16_bf16(pa1, PKV(l1, h1), od, 0, 0, 0);
    od = __builtin_amdgcn_mfma_f32_32x32x16_bf16(pa2, PKV(l2, h2), od, 0, 0, 0);
    od = __builtin_amdgcn_mfma_f32_32x32x16_bf16(pa3, PKV(l3, h3), od, 0, 0, 0);
#undef PKV
}
__device__ __forceinline__ void pv_d0(f32x16* o, int vb, bf16x8 pa0, bf16x8 pa1, bf16x8 pa2, bf16x8 pa3) {
    pv_one<0>(o[0], vb, pa0, pa1, pa2, pa3); pv_one<1>(o[1], vb, pa0, pa1, pa2, pa3); pv_one<2>(o[2], vb, pa0, pa1, pa2, pa3); pv_one<3>(o[3], vb, pa0, pa1, pa2, pa3);
}

__device__ __forceinline__ void sgu_phase(KArgs a, int j, LAS unsigned char* lds, int G) {
    int tid_l = threadIdx.x; asm volatile("" : "+v"(tid_l)); const int tid = tid_l, lane = tid & 63, wid = __builtin_amdgcn_readfirstlane(tid >> 6), r32 = lane & 31, hi = lane >> 5;
    const bf16* G1 = (const bf16*)(a->ws + WS_G1); bf16* CC = (bf16*)(a->ws + WS_CC); const f32x2* stat = (const f32x2*)(a->ws + WS_STAT);
    const float* lnw = a->in[13] + (size_t)j * 4096; const float* lnb = a->in[14] + (size_t)j * 4096; const float* ws_all = a->in[15] + (size_t)j * 16 * 128 * 128; const float* bs = a->in[16] + (size_t)j * 16 * 128;
    LAS float* st_mean = (LAS float*)(lds + 65536); LAS float* st_rstd = st_mean + 128;
    LAS float* m1s = (LAS float*)(lds + 65536 + 1024) + wid * 64; LAS float* rss = m1s + 32;
    const int sr = tid >> 4, sc = (tid & 15) * 8, vst0 = v_st(sr, sc), vst1 = v_st(32 + sr, sc);
    const int tb = wid >> 1, ch = wid & 1;
    const int vb0 = v_rd_base(lane);
    for (int item = blockIdx.x; item < 132 * 16; item += G) {
        const int chunk = item >> 4, g = item & 15, row0 = chunk * 128;
        __syncthreads();
#pragma unroll
        for (int st = 0; st < 2; ++st)
#pragma unroll
            for (int c2 = 0; c2 < 2; ++c2) { const bf16* src = G1 + (size_t)(row0 + 64 * st + sr) * N_AB + G1_VB + g * 256 + c2 * 128 + sc;
                const v4u x0 = *(const v4u*)src, x1 = *(const v4u*)(src + (size_t)32 * N_AB);
                *(LAS v4u*)(lds + (st * 2 + c2) * 16384 + vst0) = x0; *(LAS v4u*)(lds + (st * 2 + c2) * 16384 + vst1) = x1; }
        if (tid < 128) { const f32x2 s = stat[row0 + tid]; st_mean[tid] = s.x; st_rstd[tid] = s.y; }
        __syncthreads();
        const float* wrow = ws_all + ((size_t)g * 128 + 32 * tb + r32) * 128;
        bf16x8 pa[2][4]; float m1 = 0.f, rs = 0.f;
#pragma unroll
        for (int st = 0; st < 2; ++st)
#pragma unroll
            for (int ks = 0; ks < 4; ++ks) { const int s0 = 64 * st + 16 * ks + 8 * hi; const f32x4 w0 = *(const f32x4*)(wrow + s0), w1 = *(const f32x4*)(wrow + s0 + 4);
                const f32x4 r0 = *(const LAS f32x4*)(st_rstd + s0), r1 = *(const LAS f32x4*)(st_rstd + s0 + 4), mu0 = *(const LAS f32x4*)(st_mean + s0), mu1 = *(const LAS f32x4*)(st_mean + s0 + 4);
                rs += (w0[0] + w0[1]) + (w0[2] + w0[3]) + (w1[0] + w1[1]) + (w1[2] + w1[3]);
                v4u p; p.x = cvtpk(w0[0] * r0[0], w0[1] * r0[1]); p.y = cvtpk(w0[2] * r0[2], w0[3] * r0[3]); p.z = cvtpk(w1[0] * r1[0], w1[1] * r1[1]); p.w = cvtpk(w1[2] * r1[2], w1[3] * r1[3]);
                m1 += bf_lo(p.x) * mu0[0] + bf_hi(p.x) * mu0[1] + bf_lo(p.y) * mu0[2] + bf_hi(p.y) * mu0[3] + bf_lo(p.z) * mu1[0] + bf_hi(p.z) * mu1[1] + bf_lo(p.w) * mu1[2] + bf_hi(p.w) * mu1[3];
                pa[st][ks] = __builtin_bit_cast(bf16x8, p); }
        m1 += __shfl_xor(m1, 32); rs += __shfl_xor(rs, 32);
        if (hi == 0) { m1s[r32] = m1; rss[r32] = rs; }
        f32x16 o[4];
#pragma unroll
        for (int d = 0; d < 4; ++d)
#pragma unroll
            for (int r = 0; r < 16; ++r) o[d][r] = 0.f;
#pragma unroll
        for (int st = 0; st < 2; ++st) pv_d0(o, vb0 + (st * 2 + ch) * 16384, pa[st][0], pa[st][1], pa[st][2], pa[st][3]);
        asm volatile("s_waitcnt lgkmcnt(0)" ::: "memory");
        { const int cb = g * 256 + ch * 128;
          const bf16* Gu = uni(G1 + (size_t)(row0 + 32 * tb) * N_AB + G1_UB + cb); const bf16* Gzb = uni(G1 + (size_t)(row0 + 32 * tb) * N_AB + G1_ZB + cb); bf16* Co = uni(CC + (size_t)(row0 + 32 * tb) * MIXW + 4096 + cb);
          const float* lw = uni(lnw + cb); const float* lb = uni(lnb + cb); const float* bsg = uni(bs + g * 128 + 32 * tb);
          int r32e = r32, hie = hi; asm volatile("" : "+v"(r32e), "+v"(hie));
          float lwv[4], lbv[4];
#pragma unroll
          for (int d0 = 0; d0 < 4; ++d0) { lwv[d0] = lw[d0 * 32 + r32e]; lbv[d0] = lb[d0 * 32 + r32e]; }
#pragma unroll
          for (int r = 0; r < 16; ++r) { const int rr = crow(r, hie); const float m1t = m1s[rr], rst = rss[rr], bst = bsg[rr];
#pragma unroll
            for (int d0 = 0; d0 < 4; ++d0) { const int col = d0 * 32 + r32e;
                const float mix = lwv[d0] * (o[d0][r] - m1t) + lbv[d0] * rst + bst;
                const float u = __uint_as_float((unsigned)Gu[(unsigned)(rr * N_AB + col)] << 16), z = __uint_as_float((unsigned)Gzb[(unsigned)(rr * N_AB + col)] << 16);
                Co[(unsigned)(rr * MIXW + col)] = (bf16)(cvtpk(u * mix * z, 0.f) & 0xffffu); }
            if ((r & 3) == 3) asm volatile("" ::: "memory"); } }
    }
    __syncthreads();
}

namespace att {
constexpr int QBLK = 32, KVBLK = 64;
constexpr float SCALE = 0.07216878364870322f;
constexpr float THR = 8.f;
constexpr int SHM_V = KVBLK * 128 * 2, SHM_K = KVBLK * 192 * 2;
constexpr int OFF_V = 0, OFF_K = 2 * SHM_V, OFF_WS = OFF_K + 2 * SHM_K, ATT_LDS = OFF_WS + NWAVES * 64 * 4;
#ifndef ATT_SDEPTH
#define ATT_SDEPTH 1
#endif
constexpr int SDEPTH = ATT_SDEPTH;
__device__ __forceinline__ void partialSM(f32x16& p0, f32x16& p1, float& m_reg, float& mn, float& alpha) {
    constexpr float C = SCALE * 1.4426950408889634f;
    float pmax = p0[0];
#pragma unroll
    for (int r = 1; r < 16; ++r) pmax = fmaxf(pmax, p0[r]);
#pragma unroll
    for (int r = 0; r < 16; ++r) pmax = fmaxf(pmax, p1[r]);
    { auto rr = __builtin_amdgcn_permlane32_swap(__float_as_uint(pmax), __float_as_uint(pmax), false, false);
      pmax = fmaxf(__uint_as_float(rr[0]), __uint_as_float(rr[1])); }
    if (__builtin_expect(__all(pmax - m_reg <= THR / SCALE), 1)) { mn = m_reg; alpha = 1.f; }
    else { mn = fmaxf(m_reg, pmax); alpha = __builtin_amdgcn_exp2f((m_reg - mn) * C); m_reg = mn; }
    const float mnC = -mn * C;
#pragma unroll
    for (int r = 0; r < 16; ++r) p0[r] = fmaf(p0[r], C, mnC);
#pragma unroll
    for (int r = 0; r < 16; ++r) p1[r] = fmaf(p1[r], C, mnC);
#pragma unroll
    for (int r = 0; r < 16; ++r) p0[r] = __builtin_amdgcn_exp2f(p0[r]);
}
__device__ __forceinline__ void finishSM(f32x16& p0, f32x16& p1, float alpha, float& l_reg, bf16x8& pa0, bf16x8& pa1, bf16x8& pa2, bf16x8& pa3) {
#pragma unroll
    for (int r = 0; r < 16; ++r) p1[r] = __builtin_amdgcn_exp2f(p1[r]);
    float ps = 0;
#pragma unroll
    for (int r = 0; r < 16; ++r) ps += p0[r];
#pragma unroll
    for (int r = 0; r < 16; ++r) ps += p1[r];
    { auto rr = __builtin_amdgcn_permlane32_swap(__float_as_uint(ps), __float_as_uint(ps), false, false);
      ps = __uint_as_float(rr[0]) + __uint_as_float(rr[1]); }
    l_reg = l_reg * alpha + ps;
#define PK4(P, BASE, OUT) do { unsigned a0 = cvtpk(P[BASE + 0], P[BASE + 1]), a1 = cvtpk(P[BASE + 2], P[BASE + 3]);   \
    unsigned b0 = cvtpk(P[BASE + 4], P[BASE + 5]), b1 = cvtpk(P[BASE + 6], P[BASE + 7]);                              \
    auto r0 = __builtin_amdgcn_permlane32_swap(a0, b0, false, false); auto r1 = __builtin_amdgcn_permlane32_swap(a1, b1, false, false); \
    v4u w = {r0[0], r1[0], r0[1], r1[1]}; OUT = __builtin_bit_cast(bf16x8, w); } while (0)
    PK4(p0, 0, pa0); PK4(p0, 8, pa1); PK4(p1, 0, pa2); PK4(p1, 8, pa3);
#undef PK4
}
constexpr int OFF_KR = 16384;
constexpr int OFF_QR = ATT_LDS, ATT_LDS2 = OFF_QR + NWAVES * 4096;
__device__ __forceinline__ void qkt(f32x16& p0, f32x16& p1, const LAS unsigned char* Ks, const bf16x8* qr, const LAS unsigned char* qrl, int r32, int hi) {
#pragma unroll
    for (int r = 0; r < 16; ++r) { p0[r] = 0.f; p1[r] = 0.f; }
    const int swn = (r32 & 15) << 4, swr = ((r32 >> 1) & 7) << 4;
#pragma unroll
    for (int d0 = 0; d0 < 8; ++d0) { const int cb = (d0 * 16 + hi * 8) * 2;
        const bf16x8 b0 = *(const LAS bf16x8*)(Ks + r32 * 256 + (cb ^ swn));
        const bf16x8 b1 = *(const LAS bf16x8*)(Ks + (32 + r32) * 256 + (cb ^ swn));
        p0 = __builtin_amdgcn_mfma_f32_32x32x16_bf16(b0, qr[d0], p0, 0, 0, 0);
        p1 = __builtin_amdgcn_mfma_f32_32x32x16_bf16(b1, qr[d0], p1, 0, 0, 0); }
#pragma unroll
    for (int d0 = 0; d0 < 4; ++d0) { const int cb = (d0 * 16 + hi * 8) * 2;
        const bf16x8 b0 = *(const LAS bf16x8*)(Ks + OFF_KR + r32 * 128 + (cb ^ swr));
        const bf16x8 b1 = *(const LAS bf16x8*)(Ks + OFF_KR + (32 + r32) * 128 + (cb ^ swr));
        const bf16x8 q = *(const LAS bf16x8*)(qrl + d0 * 1024);
        p0 = __builtin_amdgcn_mfma_f32_32x32x16_bf16(b0, q, p0, 0, 0, 0);
        p1 = __builtin_amdgcn_mfma_f32_32x32x16_bf16(b1, q, p1, 0, 0, 0); }
}
__device__ __forceinline__ void attn_unit(const bf16* __restrict__ Q, const bf16* __restrict__ KN, const bf16* __restrict__ KR, const bf16* __restrict__ V, const bf16* __restrict__ G1, bf16* __restrict__ CC,
                                          int qrow0, int h, int nt_lat, int lat0, int ctx0, LAS unsigned char* lds) {
    int tid_l = threadIdx.x; asm volatile("" : "+v"(tid_l)); const int tid = tid_l, wid = __builtin_amdgcn_readfirstlane(tid >> 6), lane = tid & 63, r32 = lane & 31, hi = lane >> 5;
    LAS unsigned char* V_lds = lds + OFF_V; LAS unsigned char* K_lds = lds + OFF_K;
    LAS float* wsf = (LAS float*)(lds + OFF_WS) + wid * 64; LAS float* li_l = wsf; LAS float* al_l = wsf + 32;
    LAS unsigned char* qrl = lds + OFF_QR + wid * 4096 + lane * 16;
    float m_reg = -1e30f, l_reg = 0;
    f32x16 o[4];
#pragma unroll
    for (int d = 0; d < 4; ++d)
#pragma unroll
        for (int r = 0; r < 16; ++r) o[d][r] = 0.f;
    const unsigned ko = (unsigned)((tid >> 4) * 4096 + (((tid & 15) ^ ((tid >> 4) & 15)) * 8));
    const unsigned kro = (unsigned)((tid >> 3) * 64 + (((tid & 7) ^ ((tid >> 4) & 7)) * 8));
    unsigned vo; { const int sub = tid >> 5, kk = (sub >> 2) * 8 + ((tid & 31) >> 2), col = (sub & 3) * 32 + (tid & 3) * 8, key = (kk & ~0xC) | ((kk & 4) << 1) | ((kk & 8) >> 1); vo = (unsigned)(key * 4096 + col); }
    const int vb0 = (int)(unsigned)(unsigned long long)lds + OFF_V + v_rd_base(lane);
    const int NT = nt_lat + 4;
#define TROW(jt) ((jt) < nt_lat ? lat0 + 64 * (jt) : ctx0 + 64 * ((jt) - nt_lat))
#define GLDS(gp, lp) __builtin_amdgcn_global_load_lds((const unsigned*)(gp), (LAS unsigned*)(lp), 16, 0, 0)
#define ISSUE_K(jt, b) do { const int R0_ = TROW(jt); const bf16* Kb_ = uni(KN + (size_t)R0_ * 4096 + h * 128); const bf16* Rb_ = uni(KR + (size_t)R0_ * 64); \
    GLDS(Kb_ + ko, K_lds + (b) * SHM_K + wid * 1024); GLDS(Kb_ + ko + 32 * 4096, K_lds + (b) * SHM_K + (wid + 8) * 1024); GLDS(Rb_ + kro, K_lds + (b) * SHM_K + OFF_KR + wid * 1024); } while (0)
#define ISSUE_V(jt, b) do { const int R0_ = TROW(jt); const bf16* Vb_ = uni(V + (size_t)R0_ * 4096 + h * 128); \
    GLDS(Vb_ + vo, V_lds + (b) * SHM_V + wid * 1024); GLDS(Vb_ + vo + 32 * 4096, V_lds + (b) * SHM_V + (wid + 8) * 1024); } while (0)
#define STEP_END() asm volatile("s_waitcnt vmcnt(0) lgkmcnt(0)\n\ts_barrier" ::: "memory")
#define RESC(a_) do { if (__any((a_) < 1.f)) { if (hi == 0) al_l[r32] = (a_); asm volatile("s_waitcnt lgkmcnt(0)" ::: "memory"); \
    _Pragma("unroll") for (int d = 0; d < 4; ++d) _Pragma("unroll") for (int r = 0; r < 16; ++r) o[d][r] *= al_l[crow(r, hi)]; } } while (0)
    STEP_END();
    ISSUE_K(0, 0);
    bf16x8 qr[8];
    { const bf16* Qw = uni(Q + (size_t)(qrow0 + wid * QBLK) * NQ + h * 192); const unsigned qo = (unsigned)(r32 * NQ + hi * 8);
#pragma unroll
      for (int d0 = 0; d0 < 8; ++d0) qr[d0] = *(const bf16x8*)(Qw + qo + d0 * 16);
#pragma unroll
      for (int d0 = 8; d0 < 12; ++d0) { const bf16x8 t = *(const bf16x8*)(Qw + qo + d0 * 16); *(LAS bf16x8*)(qrl + (d0 - 8) * 1024) = t; } }
    f32x16 pA0, pA1, pB0, pB1; float mnA, mnB, alA, alB; bf16x8 pa0, pa1, pa2, pa3;
    STEP_END();
    ISSUE_K(1, 1); ISSUE_V(0, 0);
    qkt(pA0, pA1, K_lds, qr, qrl, r32, hi); partialSM(pA0, pA1, m_reg, mnA, alA);
    STEP_END();
    for (int j = 1; j + 1 < NT; j += 2) {
        ISSUE_K(j + 1, 0); ISSUE_V(j, 1);
        SBAR(); qkt(pB0, pB1, K_lds + SHM_K, qr, qrl, r32, hi);
        finishSM(pA0, pA1, alA, l_reg, pa0, pa1, pa2, pa3); SBAR();
        pv_d0(o, vb0, pa0, pa1, pa2, pa3); partialSM(pB0, pB1, m_reg, mnB, alB);
        RESC(alB); STEP_END();
        ISSUE_K(j + 2, 1); ISSUE_V(j + 1, 0);
        SBAR(); qkt(pA0, pA1, K_lds, qr, qrl, r32, hi);
        finishSM(pB0, pB1, alB, l_reg, pa0, pa1, pa2, pa3); SBAR();
        pv_d0(o, vb0 + SHM_V, pa0, pa1, pa2, pa3); partialSM(pA0, pA1, m_reg, mnA, alA);
        RESC(alA); STEP_END();
    }
    ISSUE_V(NT - 1, 1);
    SBAR(); qkt(pB0, pB1, K_lds + SHM_K, qr, qrl, r32, hi);
    finishSM(pA0, pA1, alA, l_reg, pa0, pa1, pa2, pa3); SBAR();
    pv_d0(o, vb0, pa0, pa1, pa2, pa3); partialSM(pB0, pB1, m_reg, mnB, alB);
    RESC(alB); STEP_END();
    finishSM(pB0, pB1, alB, l_reg, pa0, pa1, pa2, pa3); SBAR();
    pv_d0(o, vb0 + SHM_V, pa0, pa1, pa2, pa3);
    if (hi == 0) li_l[r32] = l_reg; asm volatile("s_waitcnt lgkmcnt(0)" ::: "memory");
    { const bf16* Gz = uni(G1 + (size_t)(qrow0 + wid * QBLK) * N_AB + G1_ZA + h * 128); bf16* Co = uni(CC + (size_t)(qrow0 + wid * QBLK) * MIXW + h * 128);
      int r32e = r32, hie = hi; asm volatile("" : "+v"(r32e), "+v"(hie));
#pragma unroll
      for (int r = 0; r < 16; ++r) { const int rr = crow(r, hie); const float rli = __builtin_amdgcn_rcpf(li_l[rr]);
#pragma unroll
        for (int d0 = 0; d0 < 4; ++d0) { const int col = d0 * 32 + r32e; const float z = __uint_as_float((unsigned)Gz[(unsigned)(rr * N_AB + col)] << 16);
            Co[(unsigned)(rr * MIXW + col)] = (bf16)(cvtpk(o[d0][r] * rli * z, 0.f) & 0xffffu); }
        if ((r & 3) == 3) asm volatile("" ::: "memory"); } }
#undef TROW
#undef GLDS
#undef ISSUE_K
#undef ISSUE_V
#undef STEP_END
#undef RESC
}
}
__device__ __forceinline__ void attn_phase(KArgs a, LAS unsigned char* lds, int G) {
    const bf16* Q = (const bf16*)(a->ws + WS_Q); const bf16* KN = (const bf16*)(a->ws + WS_KN); const bf16* KR = (const bf16*)(a->ws + WS_KR); const bf16* V = (const bf16*)(a->ws + WS_V);
    const bf16* G1 = (const bf16*)(a->ws + WS_G1); bf16* CC = (bf16*)(a->ws + WS_CC);
    const int bx = blockIdx.x; const int vcu = (G % 8 == 0) ? (bx % 8) * (G / 8) + bx / 8 : bx;
    for (int u = vcu; u < 2048 + 64; u += G) {
        if (u < 2048) { const int bh = u >> 5, qb = u & 31, b = bh >> 5, h = bh & 31;
            att::attn_unit(Q, KN, KR, V, G1, CC, b * SEQ + qb * 256, h, 128, b * SEQ, MLAT + b * NCTX, lds); }
        else { const int bh = u - 2048, b = bh >> 5, h = bh & 31;
            att::attn_unit(Q, KN, KR, V, G1, CC, MLAT + b * NCTX, h, 0, 0, MLAT + b * NCTX, lds); }
    }
    __syncthreads();
}

__device__ __forceinline__ void scan_phase(KArgs a, LAS unsigned char* lds, int G) {
    int tid_l = threadIdx.x; asm volatile("" : "+v"(tid_l)); const int tid = tid_l, lane = tid & 63, wid = __builtin_amdgcn_readfirstlane(tid >> 6), kg = lane >> 4, vl = lane & 15;
    const bf16* G1 = (const bf16*)(a->ws + WS_G1); const size_t TS = (size_t)MTOT * MIXW;
    constexpr int QF = 16 * 144, BUF = (QF * 2 + 16 * 128) * 4;
    LAS float* ost = (LAS float*)(lds + 2 * BUF);
    for (int sq = blockIdx.x; sq < 256; sq += G) {
        const int dir = sq >> 7, b = (sq >> 6) & 1, h = sq & 63;
        const bf16* Tq = G1 + h * 128; const bf16* Tk = G1 + (size_t)(1 + dir) * TS + h * 128; const bf16* Tv = G1 + (size_t)3 * TS + h * 128;
        bf16* Od = (bf16*)(a->ws + WS_OF) + (size_t)dir * TS + h * 128;
        float S[32];
#pragma unroll
        for (int i = 0; i < 32; ++i) S[i] = 0.f;
        const int stok = (tid & 255) >> 4, scol = (tid & 15) * 8;
        const bf16* T0 = (tid < 256) ? Tq : Tk;
        const int w0off = ((tid < 256) ? 0 : QF) + stok * 144 + (scol >> 5) * 36 + (scol & 31);
        const int w1off = 2 * QF + stok * 128 + scol;
#define SROW(n) ((n) < 256 ? MLAT + b * NCTX + (dir ? 255 - (n) : (n)) : b * SEQ + (dir ? 8447 - (n) : (n) - 256))
        v4u g0, g1;
        { const int n = stok; const size_t row = (size_t)SROW(n); g0 = *(const v4u*)(T0 + row * MIXW + scol); if (tid < 256) g1 = *(const v4u*)(Tv + row * MIXW + scol); else g1 = (v4u){0u, 0u, 0u, 0u}; }
        __syncthreads();
        { LAS float* B0 = (LAS float*)lds;
          *(LAS f32x4*)(B0 + w0off) = (f32x4){bf_lo(g0.x), bf_hi(g0.x), bf_lo(g0.y), bf_hi(g0.y)}; *(LAS f32x4*)(B0 + w0off + 4) = (f32x4){bf_lo(g0.z), bf_hi(g0.z), bf_lo(g0.w), bf_hi(g0.w)};
          if (tid < 256) { *(LAS f32x4*)(B0 + w1off) = (f32x4){bf_lo(g1.x), bf_hi(g1.x), bf_lo(g1.y), bf_hi(g1.y)}; *(LAS f32x4*)(B0 + w1off + 4) = (f32x4){bf_lo(g1.z), bf_hi(g1.z), bf_lo(g1.w), bf_hi(g1.w)}; } }
        __syncthreads();
        for (int c = 0; c < 528; ++c) {
            if (c + 1 < 528) { const int n = (c + 1) * 16 + stok; const size_t row = (size_t)SROW(n); g0 = *(const v4u*)(T0 + row * MIXW + scol); if (tid < 256) g1 = *(const v4u*)(Tv + row * MIXW + scol); }
            const LAS float* Bq = (const LAS float*)(lds + (c & 1) * BUF) + kg * 36; const LAS float* Bk = Bq + QF; const LAS float* Bv = (const LAS float*)(lds + (c & 1) * BUF) + 2 * QF + 16 * wid + vl;
#pragma unroll 2
            for (int t = 0; t < 16; ++t) {
                const float vv = Bv[t * 128]; float o = 0.f;
#pragma unroll
                for (int kq = 0; kq < 8; ++kq) { const f32x4 q4 = *(const LAS f32x4*)(Bq + t * 144 + 4 * kq), k4 = *(const LAS f32x4*)(Bk + t * 144 + 4 * kq);
#pragma unroll
                    for (int e = 0; e < 4; ++e) { float s = S[4 * kq + e]; s = fmaf(k4[e], vv - s, s); S[4 * kq + e] = s; o = fmaf(s, q4[e], o); } }
                o += __shfl_xor(o, 16); o += __shfl_xor(o, 32);
                if (lane < 16) ost[t * 128 + 16 * wid + lane] = o;
            }
            __syncthreads();
            { const int tok = tid >> 5, v4 = (tid & 31) * 4; const f32x4 ov = *(const LAS f32x4*)(ost + tok * 128 + v4); const int n = c * 16 + tok; const size_t row = (size_t)SROW(n);
              u32x2 w; w.x = cvtpk(ov[0], ov[1]); w.y = cvtpk(ov[2], ov[3]); *(u32x2*)(Od + row * MIXW + v4) = w; }
            if (c + 1 < 528) { LAS float* B1 = (LAS float*)(lds + ((c + 1) & 1) * BUF);
              *(LAS f32x4*)(B1 + w0off) = (f32x4){bf_lo(g0.x), bf_hi(g0.x), bf_lo(g0.y), bf_hi(g0.y)}; *(LAS f32x4*)(B1 + w0off + 4) = (f32x4){bf_lo(g0.z), bf_hi(g0.z), bf_lo(g0.w), bf_hi(g0.w)};
              if (tid < 256) { *(LAS f32x4*)(B1 + w1off) = (f32x4){bf_lo(g1.x), bf_hi(g1.x), bf_lo(g1.y), bf_hi(g1.y)}; *(LAS f32x4*)(B1 + w1off + 4) = (f32x4){bf_lo(g1.z), bf_hi(g1.z), bf_lo(g1.w), bf_hi(g1.w)}; } }
            __syncthreads();
        }
#undef SROW
    }
}

__device__ __forceinline__ void readout_phase(KArgs a, int jc, int nrows, int G) {
    int tid_l = threadIdx.x; asm volatile("" : "+v"(tid_l)); const int tid = tid_l, lane = tid & 63, wave = __builtin_amdgcn_readfirstlane(tid >> 6);
    const int gw = blockIdx.x * NWAVES + wave, NGW = G * NWAVES;
    const size_t TS = (size_t)MTOT * MIXW;
    const bf16* OFp = (const bf16*)(a->ws + WS_OF); const bf16* OBp = OFp + TS; const bf16* GS = (const bf16*)(a->ws + WS_G1) + 4 * TS; bf16* CC = (bf16*)(a->ws + WS_CC);
    const float* gnw = a->in[20] + (size_t)jc * 128 + (lane & 15) * 8;
    const f32x4 w0 = *(const f32x4*)gnw, w1 = *(const f32x4*)(gnw + 4);
    for (int it = gw; it < nrows * 16; it += NGW) {
        const size_t off = (size_t)(it >> 4) * MIXW + (it & 15) * 512 + lane * 8;
        const v4u f = *(const v4u*)(OFp + off), bq = *(const v4u*)(OBp + off), gq = *(const v4u*)(GS + off);
        float o[8], gg[8];
#pragma unroll
        for (int e = 0; e < 4; ++e) { o[2 * e] = bf_lo(f[e]) + bf_lo(bq[e]); o[2 * e + 1] = bf_hi(f[e]) + bf_hi(bq[e]); gg[2 * e] = bf_lo(gq[e]); gg[2 * e + 1] = bf_hi(gq[e]); }
        float ss = 0.f;
#pragma unroll
        for (int e = 0; e < 8; ++e) ss += o[e] * o[e];
        ss += __shfl_xor(ss, 1); ss += __shfl_xor(ss, 2); ss += __shfl_xor(ss, 4); ss += __shfl_xor(ss, 8);
        const float r = 1.0f / sqrtf(ss * (1.0f / 128.0f) + EPS);
        v4u w; w.x = cvtpk(o[0] * r * w0[0] * gg[0], o[1] * r * w0[1] * gg[1]); w.y = cvtpk(o[2] * r * w0[2] * gg[2], o[3] * r * w0[3] * gg[3]);
        w.z = cvtpk(o[4] * r * w1[0] * gg[4], o[5] * r * w1[1] * gg[5]); w.w = cvtpk(o[6] * r * w1[2] * gg[6], o[7] * r * w1[3] * gg[7]);
        *(v4u*)(CC + off) = w;
    }
}

#ifndef EN_P0
#define EN_P0 1
#endif
#ifndef EN_NORM
#define EN_NORM 1
#endif
#ifndef EN_A1
#define EN_A1 1
#endif
#ifndef EN_A2
#define EN_A2 1
#endif
#ifndef EN_A3
#define EN_A3 1
#endif
#ifndef EN_ATT
#define EN_ATT 1
#endif
#ifndef EN_A5
#define EN_A5 1
#endif
#ifndef EN_C1
#define EN_C1 1
#endif
#ifndef EN_SCAN
#define EN_SCAN 1
#endif
#ifndef EN_RO
#define EN_RO 1
#endif
#ifndef EN_C4
#define EN_C4 1
#endif
#ifndef EN_SGU
#define EN_SGU 1
#endif
#ifndef EN_QUP
#define EN_QUP 1
#endif
#ifndef EN_KVUP
#define EN_KVUP 1
#endif
#ifndef MK_ONE_LAUNCH
#define MK_ONE_LAUNCH 0
#endif
constexpr int N_PHASES = 28;
#define IN(k) (lo <= (k) && (k) < hi)
#define SEAM(k) do { if (IN(k) && IN((k) + 1)) xcd_barrier(bar); } while (0)
template <int p> __device__ __forceinline__ void layer_pair(LAS unsigned char* lds, const int G, const int lo, const int hi, const XcdBarrier& bar) {

        const int pb = 2 + 13 * p, lab = 2 * p, lc = 2 * p + 1;
        if (EN_A1 && IN(pb + 0)) {
            KArgs A = kargs(); unsigned char* const wsb = A->ws;
            pg8::Gemm g{(const pg8::bf16_t*)(wsb + WS_H), (const pg8::bf16_t*)(wsb + WS_WIN_AB) + (size_t)p * N_AB * DM, MTOT, N_AB, DM}; pg8::StaticOrder S; S.init(MTOT, N_AB, G, (int)blockIdx.x);
            pg8::EpiAB1 E{(pg8::bf16_t*)(wsb + WS_G1), N_AB};
            pg8::gemm_phase<pg8::EpiAB1, pg8::StaticOrder, true, true>(lds, g, S, E);
        } SEAM(pb + 0);
        if (EN_A2 && IN(pb + 1)) { a2_rows(kargs(), p, G); } SEAM(pb + 1);
        if (EN_QUP && IN(pb + 2)) {
            KArgs A = kargs(); unsigned char* const wsb = A->ws;
            pg8::Gemm g{(const pg8::bf16_t*)(wsb + WS_QN), (const pg8::bf16_t*)(wsb + WS_WQ) + (size_t)p * NQ * QL, MTOT, NQ, QL}; pg8::StaticOrder S; S.init(MTOT, NQ, G, (int)blockIdx.x);
            pg8::EpiQ E{(pg8::bf16_t*)(wsb + WS_Q), (const pg8::f32x2*)(wsb + WS_ROPE), MLAT};
            pg8::gemm_phase<pg8::EpiQ, pg8::StaticOrder, true, true>(lds, g, S, E);
        }
        if (EN_KVUP && IN(pb + 3)) {
            KArgs A = kargs(); unsigned char* const wsb = A->ws;
            pg8::Gemm g{(const pg8::bf16_t*)(wsb + WS_KVN), (const pg8::bf16_t*)(wsb + WS_WKV) + (size_t)p * NKV * KVL, MTOT, NKV, KVL}; pg8::StaticOrder S; S.init(MTOT, NKV, G, (int)blockIdx.x);
            pg8::EpiKV E{(pg8::bf16_t*)(wsb + WS_KN), (pg8::bf16_t*)(wsb + WS_V)};
            pg8::gemm_phase<pg8::EpiKV, pg8::StaticOrder, true, true>(lds, g, S, E);
        }
        if (EN_SGU && IN(pb + 4)) { sgu_phase(kargs(), p, lds, G); } SEAM(pb + 4);
        if (EN_ATT && IN(pb + 5)) { attn_phase(kargs(), lds, G); } SEAM(pb + 5);
        if (EN_A5 && IN(pb + 6)) {
            KArgs A = kargs(); unsigned char* const wsb = A->ws;
            pg8::Gemm g{(const pg8::bf16_t*)(wsb + WS_CC), (const pg8::bf16_t*)(wsb + WS_WO_AB) + (size_t)p * DM * MIXW, MTOT, DM, MIXW}; pg8::StaticOrder S; S.init(MTOT, DM, G, (int)blockIdx.x);
            pg8::EpiF32 E{(float*)(wsb + WS_Y), DM};
            pg8::gemm_phase<pg8::EpiF32, pg8::StaticOrder, true, true>(lds, g, S, E);
        } SEAM(pb + 6);
        if (EN_NORM && IN(pb + 7)) { norm_phase(kargs(), lab, lc, G); } SEAM(pb + 7);
        if (EN_C1 && IN(pb + 8)) {
            KArgs A = kargs(); unsigned char* const wsb = A->ws;
            pg8::Gemm g{(const pg8::bf16_t*)(wsb + WS_H), (const pg8::bf16_t*)(wsb + WS_WIN_C) + (size_t)p * N_C * DM, MTOT, N_C, DM}; pg8::StaticOrder S; S.init(MTOT, N_C, G, (int)blockIdx.x);
            pg8::EpiC1 E{(pg8::bf16_t*)(wsb + WS_G1), (size_t)MTOT * MIXW, (const float*)(wsb + WS_OML) + (size_t)p * 2 * 8192};
            pg8::gemm_phase<pg8::EpiC1, pg8::StaticOrder, true, true>(lds, g, S, E);
        } SEAM(pb + 8);
        if (EN_SCAN && IN(pb + 9)) { scan_phase(kargs(), lds, G); } SEAM(pb + 9);
        if (EN_RO && IN(pb + 10)) { readout_phase(kargs(), p, lc == 3 ? MLAT : MTOT, G); } SEAM(pb + 10);
        if (EN_C4 && IN(pb + 11)) {
            KArgs A = kargs(); unsigned char* const wsb = A->ws;
            const int Mr = lc == 3 ? MLAT : MTOT;
            pg8::Gemm g{(const pg8::bf16_t*)(wsb + WS_CC), (const pg8::bf16_t*)(wsb + WS_WO_C) + (size_t)p * DM * MIXW, Mr, DM, MIXW}; pg8::StaticOrder S; S.init(Mr, DM, G, (int)blockIdx.x);
            pg8::EpiF32 E{(float*)(wsb + WS_Y), DM};
            pg8::gemm_phase<pg8::EpiF32, pg8::StaticOrder, true, true>(lds, g, S, E);
        } SEAM(pb + 11);
        if (EN_NORM && IN(pb + 12)) { norm_phase(kargs(), lc, lc + 1, G); } SEAM(pb + 12);
    }
#undef IN
#undef SEAM
__global__ void __launch_bounds__(NWAVES * 64, 2) fwd(Args a) {
    extern __shared__ __attribute__((aligned(16))) unsigned char lds_raw[];
    LAS unsigned char* lds = (LAS unsigned char*)lds_raw;
    int tid_l = threadIdx.x; asm volatile("" : "+v"(tid_l)); const int tid = tid_l, G = gridDim.x;
    for (int u = tid; u < (LDS_BYTES - LDSCTL_OFF) / 4; u += NWAVES * 64) ((LAS unsigned*)(lds + LDSCTL_OFF))[u] = 0u;
    __syncthreads();
    XcdBarrier bar; bar.bar = (unsigned*)(a.ws + WS_CTL) + CW_BAR; bar.x = 0; bar.st = nullptr;
    if (MK_ONE_LAUNCH) bar = xcd_barrier_post((unsigned*)(a.ws + WS_CTL) + CW_BAR, (volatile LAS unsigned*)(lds + MISC_OFF));
    const int lo = a.ph_lo, hi = a.ph_hi;
#define IN(k) (lo <= (k) && (k) < hi)
#define SEAM(k) do { if (IN(k) && IN((k) + 1)) xcd_barrier(bar); } while (0)
    if (EN_P0 && IN(0)) { p0_prologue(kargs(), lds, G); } SEAM(0);
    if (EN_NORM && IN(1)) { norm_phase(kargs(), -1, 0, G); } SEAM(1);
    layer_pair<0>(lds, G, lo, hi, bar);
    layer_pair<1>(lds, G, lo, hi, bar);
#undef IN
#undef SEAM
}

extern "C" void kernel_launch(void* const* d_in, const int* in_sizes, int n_in, void* d_out, int out_size, void* d_ws, size_t ws_size, hipStream_t stream) {
    static int grid = 0;
    if (grid == 0) {
        if (n_in != 22 || out_size != MLAT * DM || ws_size < WS_END) { fprintf(stderr, "kernel_launch: unexpected shapes (n_in %d, out %d, ws %zu, need %zu)\n", n_in, out_size, ws_size, (size_t)WS_END); grid = -1; return; }
        int dev = 0, cus = 0, per_cu = 0;
        if (hipGetDevice(&dev) != hipSuccess || hipDeviceGetAttribute(&cus, hipDeviceAttributeMultiprocessorCount, dev) != hipSuccess) { grid = -1; return; }
        if (hipFuncSetAttribute((const void*)fwd, hipFuncAttributeMaxDynamicSharedMemorySize, LDS_BYTES) != hipSuccess) { fprintf(stderr, "kernel_launch: hipFuncSetAttribute failed\n"); grid = -1; return; }
        if (hipOccupancyMaxActiveBlocksPerMultiprocessor(&per_cu, (const void*)fwd, NWAVES * 64, LDS_BYTES) != hipSuccess || per_cu < 1) fprintf(stderr, "kernel_launch: occupancy query reports %d\n", per_cu);
        (void)hipGetLastError();
        grid = cus;
    }
    if (grid < 0) return;
    (void)hipMemsetAsync((char*)d_ws + WS_CTL, 0, CTL_ZERO_BYTES, stream);
    Args a{};
    for (int i = 0; i < 22; ++i) a.in[i] = (const float*)d_in[i];
    a.out = (float*)d_out; a.ws = (unsigned char*)d_ws;
#if MK_ONE_LAUNCH
    a.ph_lo = 0; a.ph_hi = N_PHASES;
    hipLaunchKernelGGL(fwd, dim3(grid), dim3(NWAVES * 64), LDS_BYTES, stream, a);
#else
    for (int p = 0; p < N_PHASES; ++p) { a.ph_lo = p; a.ph_hi = p + 1; hipLaunchKernelGGL(fwd, dim3(grid), dim3(NWAVES * 64), LDS_BYTES, stream, a); }
#endif
}
```

```cpp
#include <hip/hip_runtime.h>
#include <cstdio>
#include <cstdint>
namespace pg8 {
#define PG8_LAS __attribute__((address_space(3)))
typedef unsigned short bf16_t;
typedef short bf16x8 __attribute__((ext_vector_type(8)));
typedef float f32x4 __attribute__((ext_vector_type(4)));
typedef unsigned u32x4 __attribute__((ext_vector_type(4)));
constexpr int BM = 256, BK = 64, HALF = 128, HTB = HALF * BK * 2  , STAGE_BYTES = 8 * HTB, NXCD = 8, WGM = 4;

__host__ __device__ __forceinline__ int lds_byte(int r, int c) { const int st = (r >> 4) * 2 + (c >> 5), rr = r & 15, cc = c & 31, ob = rr * 64 + cc * 2; return st * 1024 + (ob ^ (((ob >> 9) & 1) << 5)); }
__host__ __device__ __forceinline__ void stage_rc(int b, int& R, int& C) { const int st = b / 1024, sb = b % 1024, swz = sb ^ (((sb >> 9) & 1) << 5); R = (st >> 1) * 16 + swz / 64; C = (st & 1) * 32 + (swz % 64) / 2; }
__host__ __device__ __forceinline__ int perm32(int rho) { const int n = rho >> 4, i = rho & 15; return 8 * (i >> 2) + 4 * n + (i & 3); }

struct Unit { int pm, pn, kc; };
struct Gemm { const bf16_t* A; const bf16_t* Bt; int M, N, K, ld; };

struct StaticOrder {
    int nM, nN, nwg, G, c;
    __host__ __device__ void init(int M, int N, int G_, int c_) { nM = M / BM; nN = N / BM; nwg = nM * nN; G = G_; c = c_; }
    __host__ __device__ bool next(int i, Unit& u) const {
        const long L = (long)i * G + c; if (L >= nwg) return false;
        int wgid = (int)L; { const int q = nwg / NXCD, r = nwg % NXCD, xcd = wgid % NXCD, off = wgid / NXCD; wgid = (xcd < r ? xcd * (q + 1) : r * (q + 1) + (xcd - r) * q) + off; }
        const int nig = WGM * nN, gid = wgid / nig, fm = gid * WGM, gsz = (nM - fm) < WGM ? (nM - fm) : WGM;
        u.pm = fm + ((wgid % nig) % gsz); u.pn = (wgid % nig) / gsz; u.kc = 0; return true;
    }
    __device__ __forceinline__ void a_ready(const Unit&) const {}
    __device__ __forceinline__ void done(const Unit&) const {}
};
struct LockstepOrder {
    static constexpr int LW = 4;
    int nM, nN, G, c, x, k, nk, PG, r0, gR, qR, rR, lenx;
    __host__ __device__ void init(int M, int N, int G_, int c_) { nM = M / BM; nN = N / BM; G = G_; c = c_; x = c_ % NXCD; k = c_ / NXCD; nk = G_ / NXCD; PG = (nM / LW) / NXCD; r0 = PG * NXCD * LW; gR = nM - r0;
        const int rem = gR * nN; qR = rem / NXCD; rR = rem % NXCD; lenx = PG * LW * nN + qR + (x < rR ? 1 : 0); }
    __host__ __device__ bool next(int i, Unit& u) const {
        if (G % NXCD != 0) { const long L = (long)i * G + c; if (L >= (long)nM * nN) return false; u.kc = 0; u.pm = (int)(L / nN); u.pn = (int)(L % nN); return true; }
        const int off = i * nk + k; if (off >= lenx) return false; u.kc = 0;
        const int lock = PG * LW * nN;
        if (off < lock) { const int j = off / (LW * nN), o2 = off % (LW * nN); u.pm = (j * NXCD + x) * LW + o2 % LW; u.pn = o2 / LW; }
        else { const int rho = (x < rR ? x * (qR + 1) : rR * (qR + 1) + (x - rR) * qR) + (off - lock); u.pm = r0 + rho % gR; u.pn = rho / gR; }
        return true;
    }
    __device__ __forceinline__ void a_ready(const Unit&) const {}
    __device__ __forceinline__ void done(const Unit&) const {}
};
struct SplitKOrder {
    int nM, nN, KS, nwg, G, c;
    __host__ __device__ void init(int M, int N, int KS_, int G_, int c_) { nM = M / BM; nN = N / BM; KS = KS_; nwg = nM * nN * KS; G = G_; c = c_; }
    __host__ __device__ bool next(int i, Unit& u) const { const long L = (long)i * G + c; if (L >= nwg) return false; const int l = (int)L; u.kc = l % KS; u.pn = (l / KS) % nN; u.pm = l / (KS * nN); return true; }
    __device__ __forceinline__ void a_ready(const Unit&) const {}
    __device__ __forceinline__ void done(const Unit&) const {}
};

typedef float f32x2 __attribute__((ext_vector_type(2)));
typedef __bf16 bf16x2_c __attribute__((ext_vector_type(2)));
__device__ __forceinline__ unsigned cvt_pk_bf16(float lo, float hi) { const f32x2 v = {lo, hi}; const bf16x2_c b = __builtin_convertvector(v, bf16x2_c); return __builtin_bit_cast(unsigned, b); }
__device__ __forceinline__ f32x2 gelu_pk(f32x2 v) {
    const f32x2 av = __builtin_elementwise_abs(v), d = av * 0.2316418882f + 1.0f;
    f32x2 t; t.x = __builtin_amdgcn_rcpf(d.x); t.y = __builtin_amdgcn_rcpf(d.y);
    f32x2 q = t * 0.5307027145f + (-0.7265760135f); q = q * t + 0.7107068705f; q = q * t + (-0.142248368f); q = q * t + 0.127414796f; q = q * t;
    const f32x2 s = (v * v) * (-0.72134752044f);
    f32x2 e; e.x = __builtin_amdgcn_exp2f(s.x); e.y = __builtin_amdgcn_exp2f(s.y);
    const f32x2 m = v * (q * e), r = v - m;
    f32x2 o; o.x = v.x < 0.f ? m.x : r.x; o.y = v.y < 0.f ? m.y : r.y; return o;
}

typedef unsigned u32x2 __attribute__((ext_vector_type(2)));
__device__ __forceinline__ float silu_f(float x) { return x * __builtin_amdgcn_rcpf(1.0f + __builtin_amdgcn_exp2f(-1.4426950408889634f * x)); }
__device__ __forceinline__ float sigmoid_neg_f(float x) { return __builtin_amdgcn_rcpf(1.0f + __builtin_amdgcn_exp2f(1.4426950408889634f * x)); }
__device__ __forceinline__ f32x4 act4(f32x4 v, int act) {
    if (act == 1) { v[0] = silu_f(v[0]); v[1] = silu_f(v[1]); v[2] = silu_f(v[2]); v[3] = silu_f(v[3]); }
    else if (act == 2) { const f32x2 a = gelu_pk((f32x2){v[0], v[1]}), b = gelu_pk((f32x2){v[2], v[3]}); v = (f32x4){a.x, a.y, b.x, b.y}; }
    return v;
}
struct EpiF32 {
    static constexpr bool PERM = false, AFTER_DRAIN = false;
    float* C0; int ldc; size_t kstride;
    __device__ __forceinline__ void operator()(const f32x4 (&acc)[2][2][4][2], const Unit& u, int wr, int wc, int fr, int fq) const {
        float* C = C0 + (size_t)u.kc * kstride;
        const int row0 = u.pm * BM + wr * 64 + fr, col0 = u.pn * BM + wc * 32 + 4 * fq;
#pragma unroll
        for (int ai = 0; ai < 2; ++ai)
#pragma unroll
            for (int m = 0; m < 4; ++m) { float* rowp = C + (size_t)(row0 + ai * HALF + m * 16) * ldc + col0;
#pragma unroll
                for (int bj = 0; bj < 2; ++bj)
#pragma unroll
                    for (int n = 0; n < 2; ++n) *(f32x4*)(rowp + bj * HALF + n * 16) = acc[ai][bj][m][n]; }
    }
};
struct EpiBf16P {
    static constexpr bool PERM = true, AFTER_DRAIN = false;
    bf16_t* O; int ldc;
    __device__ __forceinline__ void operator()(const f32x4 (&acc)[2][2][4][2], const Unit& u, int wr, int wc, int fr, int fq) const {
        const int row0 = u.pm * BM + wr * 64 + fr, col0 = u.pn * BM + wc * 32 + 8 * fq;
#pragma unroll
        for (int ai = 0; ai < 2; ++ai)
#pragma unroll
            for (int m = 0; m < 4; ++m) { bf16_t* rowp = O + (size_t)(row0 + ai * HALF + m * 16) * ldc + col0;
#pragma unroll
                for (int bj = 0; bj < 2; ++bj) { const f32x4 v0 = acc[ai][bj][m][0], v1 = acc[ai][bj][m][1];
                    u32x4 w; w.x = cvt_pk_bf16(v0[0], v0[1]); w.y = cvt_pk_bf16(v0[2], v0[3]); w.z = cvt_pk_bf16(v1[0], v1[1]); w.w = cvt_pk_bf16(v1[2], v1[3]);
                    *(u32x4*)(rowp + bj * HALF) = w; } }
    }
};
struct EpiAB1 {
    static constexpr bool PERM = true, AFTER_DRAIN = false;
    bf16_t* O; int ldc;
    __device__ __forceinline__ void operator()(const f32x4 (&acc)[2][2][4][2], const Unit& u, int wr, int wc, int fr, int fq) const {
        const int act = u.pn < 7 ? 0 : ((u.pn < 23 || u.pn >= 55) ? 1 : 2);
        const int row0 = u.pm * BM + wr * 64 + fr, col0 = u.pn * BM + wc * 32 + 8 * fq;
#pragma unroll
        for (int ai = 0; ai < 2; ++ai)
#pragma unroll
            for (int m = 0; m < 4; ++m) { bf16_t* rowp = O + (size_t)(row0 + ai * HALF + m * 16) * ldc + col0;
#pragma unroll
                for (int bj = 0; bj < 2; ++bj) { const f32x4 v0 = act4(acc[ai][bj][m][0], act), v1 = act4(acc[ai][bj][m][1], act);
                    u32x4 w; w.x = cvt_pk_bf16(v0[0], v0[1]); w.y = cvt_pk_bf16(v0[2], v0[3]); w.z = cvt_pk_bf16(v1[0], v1[1]); w.w = cvt_pk_bf16(v1[2], v1[3]);
                    *(u32x4*)(rowp + bj * HALF) = w; } }
    }
};
struct EpiC1 {
    static constexpr bool PERM = true, AFTER_DRAIN = false;
    bf16_t* O; size_t stride; const float* oml;
    __device__ __forceinline__ void operator()(const f32x4 (&acc)[2][2][4][2], const Unit& u, int wr, int wc, int fr, int fq) const {
        const int region = u.pn >> 5; bf16_t* base = O + (size_t)region * stride;
        const int row0 = u.pm * BM + wr * 64 + fr, col0 = (u.pn & 31) * BM + wc * 32 + 8 * fq;
        const bool gate = (region == 1 || region == 2); const int act = (region == 0 || region == 4) ? 1 : 0;
        f32x4 gv[2][2];
#pragma unroll
        for (int bj = 0; bj < 2; ++bj)
#pragma unroll
            for (int n = 0; n < 2; ++n) gv[bj][n] = gate ? *(const f32x4*)(oml + (size_t)(region - 1) * 8192 + col0 + bj * HALF + 4 * n) : (f32x4){1.f, 1.f, 1.f, 1.f};
#pragma unroll
        for (int ai = 0; ai < 2; ++ai)
#pragma unroll
            for (int m = 0; m < 4; ++m) { bf16_t* rowp = base + (size_t)(row0 + ai * HALF + m * 16) * 8192 + col0;
#pragma unroll
                for (int bj = 0; bj < 2; ++bj) { f32x4 v0 = acc[ai][bj][m][0], v1 = acc[ai][bj][m][1];
                    if (gate) {
#pragma unroll
                        for (int j = 0; j < 4; ++j) { v0[j] = gv[bj][0][j] * sigmoid_neg_f(v0[j]); v1[j] = gv[bj][1][j] * sigmoid_neg_f(v1[j]); } }
                    else { v0 = act4(v0, act); v1 = act4(v1, act); }
                    u32x4 w; w.x = cvt_pk_bf16(v0[0], v0[1]); w.y = cvt_pk_bf16(v0[2], v0[3]); w.z = cvt_pk_bf16(v1[0], v1[1]); w.w = cvt_pk_bf16(v1[2], v1[3]);
                    *(u32x4*)(rowp + bj * HALF) = w; } }
    }
};
struct EpiQ {
    static constexpr bool PERM = true, AFTER_DRAIN = false;
    bf16_t* O; const f32x2* rope; int nlat; float qscale;
    __device__ __forceinline__ void operator()(const f32x4 (&acc)[2][2][4][2], const Unit& u, int wr, int wc, int fr, int fq) const {
        const int row0 = u.pm * BM + wr * 64 + fr; const bool upper = fq >= 2;
#pragma unroll
        for (int bj = 0; bj < 2; ++bj) {
            const int G = 8 * u.pn + 4 * bj + wc, hm = G % 6, col = u.pn * BM + bj * HALF + wc * 32 + 8 * fq;
#pragma unroll
            for (int ai = 0; ai < 2; ++ai)
#pragma unroll
                for (int m = 0; m < 4; ++m) { const int row = row0 + ai * HALF + m * 16; f32x4 x0 = acc[ai][bj][m][0], x1 = acc[ai][bj][m][1];
                    if (hm >= 4 && u.pm * BM < nlat) {
                        const int t = row & 8191, pos = (hm == 4) ? (t >> 6) : (t & 63); const f32x2* cs = rope + pos * 16 + 8 * (fq & 1);
#pragma unroll
                        for (int j = 0; j < 4; ++j) {
                            { auto rr = __builtin_amdgcn_permlane32_swap(__float_as_uint(x0[j]), __float_as_uint(x0[j]), false, false); const float pv = __uint_as_float(upper ? rr[0] : rr[1]); const f32x2 c = cs[j];
                              x0[j] = upper ? x0[j] * c.x + pv * c.y : x0[j] * c.x - pv * c.y; }
                            { auto rr = __builtin_amdgcn_permlane32_swap(__float_as_uint(x1[j]), __float_as_uint(x1[j]), false, false); const float pv = __uint_as_float(upper ? rr[0] : rr[1]); const f32x2 c = cs[4 + j];
                              x1[j] = upper ? x1[j] * c.x + pv * c.y : x1[j] * c.x - pv * c.y; } } }
                    x0 = x0 * qscale; x1 = x1 * qscale;
                    u32x4 w; w.x = cvt_pk_bf16(x0[0], x0[1]); w.y = cvt_pk_bf16(x0[2], x0[3]); w.z = cvt_pk_bf16(x1[0], x1[1]); w.w = cvt_pk_bf16(x1[2], x1[3]);
                    *(u32x4*)(O + (size_t)row * 6144 + col) = w; }
        }
    }
};
struct EpiKV {
    static constexpr bool PERM = true, AFTER_DRAIN = false;
    bf16_t* KN; bf16_t* V; int mtot;
    __device__ __forceinline__ void operator()(const f32x4 (&acc)[2][2][4][2], const Unit& u, int wr, int wc, int fr, int fq) const {
        const int row0 = u.pm * BM + wr * 64 + fr, colh = wc * 32 + 8 * fq;
#pragma unroll
        for (int ai = 0; ai < 2; ++ai)
#pragma unroll
            for (int m = 0; m < 4; ++m) { const size_t off = ((size_t)u.pn * mtot + (size_t)(row0 + ai * HALF + m * 16)) * 128 + colh;
#pragma unroll
                for (int bj = 0; bj < 2; ++bj) { const f32x4 v0 = acc[ai][bj][m][0], v1 = acc[ai][bj][m][1];
                    u32x4 w; w.x = cvt_pk_bf16(v0[0], v0[1]); w.y = cvt_pk_bf16(v0[2], v0[3]); w.z = cvt_pk_bf16(v1[0], v1[1]); w.w = cvt_pk_bf16(v1[2], v1[3]);
                    *(u32x4*)((bj ? V : KN) + off) = w; } }
    }
};

template <class Epi, class Sched, bool ALIGN_EPI = false, bool SP2 = false>
__device__ __forceinline__ void gemm_phase(PG8_LAS unsigned char* lds, const Gemm g, const Sched& S, const Epi& E) {
    int tid_l = threadIdx.x; asm volatile("" : "+v"(tid_l)); const int tid = tid_l, wid = __builtin_amdgcn_readfirstlane(tid >> 6), lane = tid & 63, wr = wid >> 2, wc = wid & 3, fr = lane & 15, fq = lane >> 4;
    const int K = g.ld, nt = g.K / BK;
    unsigned voffA[2], voffB[2];
#pragma unroll
    for (int i = 0; i < 2; ++i) { int R, C; stage_rc(tid * 16 + i * 8192, R, C); const int Rb = Epi::PERM ? ((R & ~31) + perm32(R & 31)) : R;
        voffA[i] = (unsigned)(R * K + C) * 2u; voffB[i] = (unsigned)(Rb * K + C) * 2u; }
    const size_t kstep = (size_t)(BK * 2);
    const size_t hstep = (size_t)HALF * K * 2;
    const size_t tstep = 2 * hstep;
    const unsigned ldsw = (unsigned)wid * 1024u;
    const int aoff = lds_byte(wr * 64 + fr, fq * 8), boff = lds_byte(wc * 32 + fr, fq * 8);
#define PG8_SA(b, h) (((b) * 2 + (h)) * HTB)
#define PG8_SB(b, h) ((4 + (b) * 2 + (h)) * HTB)
#define PG8_STAGE(bufoff, gbase, voff) do { const char* gb_ = (const char*)(gbase); asm volatile("" : "+s"(gb_)); _Pragma("unroll") for (int _i = 0; _i < 2; ++_i) { unsigned vo_ = (voff)[_i]; asm volatile("" : "+v"(vo_)); \
        __builtin_amdgcn_global_load_lds((const unsigned*)(gb_ + vo_), (PG8_LAS unsigned*)(lds + (bufoff) + ldsw + _i * 8192), 16, 0, 0); } } while (0)
#define PG8_LDA(dst, b, h) do { _Pragma("unroll") for (int m = 0; m < 4; ++m) _Pragma("unroll") for (int k = 0; k < 2; ++k) dst[m][k] = *(const PG8_LAS bf16x8*)(lds + PG8_SA(b, h) + aoff + m * 2048 + k * 1024); } while (0)
#define PG8_LDB(dst, b, h) do { _Pragma("unroll") for (int n = 0; n < 2; ++n) _Pragma("unroll") for (int k = 0; k < 2; ++k) dst[n][k] = *(const PG8_LAS bf16x8*)(lds + PG8_SB(b, h) + boff + n * 2048 + k * 1024); } while (0)
#define PG8_MMA(ai, bj, At, Bt) do { __builtin_amdgcn_sched_barrier(0); _Pragma("unroll") for (int m = 0; m < 4; ++m) _Pragma("unroll") for (int n = 0; n < 2; ++n) _Pragma("unroll") for (int k = 0; k < 2; ++k) \
        acc[ai][bj][m][n] = __builtin_amdgcn_mfma_f32_16x16x32_bf16(Bt[n][k], At[m][k], acc[ai][bj][m][n], 0, 0, 0); __builtin_amdgcn_sched_barrier(0); } while (0)
#define PG8_WAIT_V(n) asm volatile("s_waitcnt vmcnt(" #n ")" ::: "memory")
#define PG8_WAIT_L(n) asm volatile("s_waitcnt lgkmcnt(" #n ")" ::: "memory")
#define PG8_BAR __builtin_amdgcn_s_barrier()
#define PG8_SCHED __builtin_amdgcn_sched_barrier(0)
    if (wr == 0) __builtin_amdgcn_s_setprio(1);
    Unit cur, nxt; int ui = 0;
    if (!S.next(0, cur)) { __builtin_amdgcn_s_setprio(0); return; }
    f32x4 acc[2][2][4][2];
#pragma unroll
    for (int a = 0; a < 2; ++a)
#pragma unroll
        for (int b = 0; b < 2; ++b)
#pragma unroll
            for (int m = 0; m < 4; ++m)
#pragma unroll
                for (int n = 0; n < 2; ++n) acc[a][b][m][n] = (f32x4){0.f, 0.f, 0.f, 0.f};
    bf16x8 At[4][2], B0[2][2], B1[2][2];
    const size_t kcb = (size_t)g.K * 2;
    const char* cA = (const char*)g.A + (size_t)cur.pm * tstep + cur.kc * kcb; const char* cB = (const char*)g.Bt + (size_t)cur.pn * tstep + cur.kc * kcb;
    S.a_ready(cur);
    if constexpr (SP2) {
        PG8_STAGE(PG8_SB(0, 0), cB, voffB); PG8_STAGE(PG8_SB(0, 1), cB + hstep, voffB); PG8_STAGE(PG8_SA(0, 0), cA, voffA); PG8_STAGE(PG8_SA(0, 1), cA + hstep, voffA);
        if (wr == 1) PG8_BAR;
        PG8_WAIT_V(2); PG8_BAR;
        PG8_STAGE(PG8_SB(1, 0), cB + kstep, voffB); PG8_STAGE(PG8_SA(1, 0), cA + kstep, voffA); PG8_STAGE(PG8_SB(1, 1), cB + hstep + kstep, voffB);
        PG8_WAIT_V(6); PG8_BAR;
    } else {
        PG8_STAGE(PG8_SB(0, 0), cB, voffB); PG8_STAGE(PG8_SA(0, 0), cA, voffA); PG8_STAGE(PG8_SB(0, 1), cB + hstep, voffB); PG8_STAGE(PG8_SA(0, 1), cA + hstep, voffA);
        if (wr == 1) PG8_BAR;
        PG8_WAIT_V(4); PG8_BAR;
        PG8_STAGE(PG8_SB(1, 0), cB + kstep, voffB); PG8_STAGE(PG8_SA(1, 0), cA + kstep, voffA); PG8_STAGE(PG8_SB(1, 1), cB + hstep + kstep, voffB);
        PG8_WAIT_V(6); PG8_BAR;
    }
    for (;;) {
        const bool has_next = S.next(ui + 1, nxt);
        const char* nA = has_next ? (const char*)g.A + (size_t)nxt.pm * tstep + nxt.kc * kcb : cA; const char* nB = has_next ? (const char*)g.Bt + (size_t)nxt.pn * tstep + nxt.kc * kcb : cB;
        for (int t = 0; t < nt; t += 2) {
            const bool last = (t == nt - 2);
            const char* a1 = cA + (size_t)(t + 1) * kstep;
            const char* a2 = last ? nA : cA + (size_t)(t + 2) * kstep; const char* b2 = last ? nB : cB + (size_t)(t + 2) * kstep;
            const char* a3 = a2 + kstep; const char* b3 = b2 + kstep;
            if (last && has_next) S.a_ready(nxt);
            if constexpr (SP2) {
            PG8_LDB(B0, 0, 0); PG8_LDB(B1, 0, 1); PG8_SCHED; PG8_LDA(At, 0, 0); PG8_STAGE(PG8_SA(1, 1), a1 + hstep, voffA);
            PG8_WAIT_V(8); PG8_WAIT_L(0); PG8_BAR; PG8_MMA(0, 0, At, B0); PG8_MMA(0, 1, At, B1); PG8_BAR; PG8_SCHED;
            PG8_LDA(At, 0, 1); PG8_STAGE(PG8_SB(0, 0), b2, voffB); PG8_STAGE(PG8_SB(0, 1), b2 + hstep, voffB); PG8_STAGE(PG8_SA(0, 0), a2, voffA);
            PG8_WAIT_V(8); PG8_WAIT_L(0); PG8_BAR; PG8_MMA(1, 0, At, B0); PG8_MMA(1, 1, At, B1); PG8_BAR; PG8_SCHED;
            PG8_LDB(B0, 1, 0); PG8_LDB(B1, 1, 1); PG8_SCHED; PG8_LDA(At, 1, 0); PG8_STAGE(PG8_SA(0, 1), a2 + hstep, voffA);
            PG8_WAIT_V(8); PG8_WAIT_L(0); PG8_BAR; PG8_MMA(0, 0, At, B0); PG8_MMA(0, 1, At, B1); PG8_BAR; PG8_SCHED;
            PG8_LDA(At, 1, 1); PG8_STAGE(PG8_SB(1, 0), b3, voffB); PG8_STAGE(PG8_SB(1, 1), b3 + hstep, voffB); PG8_STAGE(PG8_SA(1, 0), a3, voffA);
            PG8_WAIT_V(8); PG8_WAIT_L(0); PG8_BAR; PG8_MMA(1, 0, At, B0); PG8_MMA(1, 1, At, B1); PG8_BAR; PG8_SCHED;
            } else {
            PG8_LDB(B0, 0, 0); PG8_SCHED; PG8_LDA(At, 0, 0); PG8_STAGE(PG8_SA(1, 1), a1 + hstep, voffA);
            PG8_WAIT_L(8); PG8_BAR; PG8_WAIT_L(0); PG8_MMA(0, 0, At, B0); PG8_BAR; PG8_SCHED;
            PG8_LDB(B1, 0, 1); PG8_STAGE(PG8_SB(0, 0), b2, voffB);
            PG8_BAR; PG8_WAIT_L(0); PG8_MMA(0, 1, At, B1); PG8_BAR;
            PG8_LDA(At, 0, 1); PG8_STAGE(PG8_SA(0, 0), a2, voffA);
            PG8_BAR; PG8_WAIT_L(0); PG8_MMA(1, 0, At, B0); PG8_BAR; PG8_SCHED;
            PG8_STAGE(PG8_SB(0, 1), b2 + hstep, voffB);
            PG8_WAIT_V(6); PG8_BAR; PG8_MMA(1, 1, At, B1); PG8_BAR;
            PG8_LDB(B0, 1, 0); PG8_SCHED; PG8_LDA(At, 1, 0); PG8_STAGE(PG8_SA(0, 1), a2 + hstep, voffA);
            PG8_WAIT_L(8); PG8_BAR; PG8_WAIT_L(0); PG8_MMA(0, 0, At, B0); PG8_BAR; PG8_SCHED;
            PG8_LDB(B1, 1, 1); PG8_STAGE(PG8_SB(1, 0), b3, voffB);
            PG8_BAR; PG8_WAIT_L(0); PG8_MMA(0, 1, At, B1); PG8_BAR;
            PG8_LDA(At, 1, 1); PG8_STAGE(PG8_SA(1, 0), a3, voffA);
            PG8_BAR; PG8_WAIT_L(0); PG8_MMA(1, 0, At, B0); PG8_BAR; PG8_SCHED;
            PG8_STAGE(PG8_SB(1, 1), b3 + hstep, voffB);
            PG8_WAIT_V(6); PG8_BAR; PG8_MMA(1, 1, At, B1); PG8_BAR;
            }
        }
        if constexpr (ALIGN_EPI) { if (wr == 0) PG8_BAR; }
        if constexpr (!Epi::AFTER_DRAIN) { E(acc, cur, wr, wc, fr, fq); S.done(cur); }
        if (!has_next) break;
#pragma unroll
        for (int a = 0; a < 2; ++a)
#pragma unroll
            for (int b = 0; b < 2; ++b)
#pragma unroll
                for (int m = 0; m < 4; ++m)
#pragma unroll
                    for (int n = 0; n < 2; ++n) acc[a][b][m][n] = (f32x4){0.f, 0.f, 0.f, 0.f};
        cur = nxt; cA = nA; cB = nB; ++ui;
        if constexpr (ALIGN_EPI) { if (wr == 1) PG8_BAR; }
    }
    PG8_WAIT_V(0);
    if constexpr (!ALIGN_EPI) { if (wr == 0) PG8_BAR; }
    PG8_BAR;
    if constexpr (Epi::AFTER_DRAIN) { E.fused(acc, cur, wr, wc, fr, fq, lds, wid, lane); S.done(cur); }
    __builtin_amdgcn_s_setprio(0);
#undef PG8_SA
#undef PG8_SB
#undef PG8_STAGE
#undef PG8_LDA
#undef PG8_LDB
#undef PG8_MMA
#undef PG8_WAIT_V
#undef PG8_WAIT_L
#undef PG8_BAR
#undef PG8_SCHED
}
}
#define GAS __attribute__((address_space(1)))
#define LAS __attribute__((address_space(3)))
typedef unsigned short bf16;
typedef unsigned v4u __attribute__((ext_vector_type(4)));
typedef float f32x4 __attribute__((ext_vector_type(4)));
typedef short bf16x8 __attribute__((ext_vector_type(8)));
typedef GAS unsigned gu32;
typedef GAS unsigned long long gu64;
#define RLX_AGENT __ATOMIC_RELAXED, __HIP_MEMORY_SCOPE_AGENT
#define LDS_WAIT() asm volatile("s_waitcnt lgkmcnt(0)" ::: "memory")
#define VM_WAIT() asm volatile("s_waitcnt vmcnt(0)" ::: "memory")
__device__ __forceinline__ unsigned long long rt() { return __builtin_amdgcn_s_memrealtime(); }
__device__ __forceinline__ unsigned f2bf(float f) { unsigned u = __builtin_bit_cast(unsigned, f); return (u + 0x7fffu + ((u >> 16) & 1u)) >> 16; }
__device__ __forceinline__ unsigned pk2(float lo, float hi) { return f2bf(lo) | (f2bf(hi) << 16); }

typedef unsigned u32x2 __attribute__((ext_vector_type(2)));
typedef float f32x2 __attribute__((ext_vector_type(2)));
#define XB_TMO      128
#define XB_XCNT(j)  (256  + 64 * (j))
#define XB_XSUB(j)  (1280 + 64 * (j))
#define XB_XGEN(j)  (2304 + 64 * (j))
#define XB_TOP      3328
#define XB_TOPGEN   3392
#define XCD_BAR_WORDS 3456
#define XB_SPIN_CAP (1u << 21)

__device__ __forceinline__ unsigned xb_ld(unsigned* p)              { return __hip_atomic_load(p, __ATOMIC_RELAXED, __HIP_MEMORY_SCOPE_AGENT); }
__device__ __forceinline__ unsigned xb_add(unsigned* p, unsigned v) { return __hip_atomic_fetch_add(p, v, __ATOMIC_RELAXED, __HIP_MEMORY_SCOPE_AGENT); }
__device__ __forceinline__ unsigned xb_xcc_id() { return (unsigned)__builtin_amdgcn_s_getreg((3 << 11) | 20) & 0xFu; }
#define XB_SPIN(cond, bar) do { unsigned _sp = 0; while (cond) { __builtin_amdgcn_s_sleep(1); \
    if ((++_sp & 255u) == 0u) { if (xb_ld(&(bar)[XB_TMO])) break; if (_sp > XB_SPIN_CAP) { atomicAdd(&(bar)[XB_TMO], 1u); break; } } } } while (0)

struct XcdBarrier {
    unsigned* bar; unsigned x;
    volatile LAS unsigned* st;
};

__device__ __forceinline__ XcdBarrier xcd_barrier_post(unsigned* bar, volatile LAS unsigned* st) {
    XcdBarrier b; b.bar = bar; b.x = xb_xcc_id(); b.st = st;
    if (threadIdx.x == 0) (void)xb_add(&bar[XB_XCNT(b.x)], 1u);
    return b;
}
__device__ __forceinline__ void xcd_barrier_complete(unsigned* bar, unsigned x, unsigned& nloc, unsigned& nx) {
    const unsigned G = gridDim.x * gridDim.y * gridDim.z;
    unsigned sum, cnt, mine, sp = 0u;
    for (;;) {
        sum = 0u; cnt = 0u; mine = 0u;
#pragma unroll
        for (unsigned j = 0; j < 16; ++j) { const unsigned c = xb_ld(&bar[XB_XCNT(j)]); sum += c; cnt += (c > 0u) ? 1u : 0u; mine = (j == x) ? c : mine; }
        if (sum == G) break;
        __builtin_amdgcn_s_sleep(1);
        if ((++sp & 255u) == 0u) { if (xb_ld(&bar[XB_TMO])) break; if (sp > XB_SPIN_CAP) { atomicAdd(&bar[XB_TMO], 1u); break; } }
    }
    nloc = mine > 0u ? mine : 1u; nx = cnt > 0u ? cnt : 1u;
}

__device__ __forceinline__ void xcd_barrier(const XcdBarrier& b) {
    asm volatile("s_waitcnt vmcnt(0)" ::: "memory");
    __syncthreads();
    if (threadIdx.x == 0) {
        unsigned* bar = b.bar;
        __builtin_amdgcn_s_waitcnt(0);
        unsigned nloc = b.st[0], nx = b.st[1];
        if (nloc == 0u) { xcd_barrier_complete(bar, b.x, nloc, nx); b.st[0] = nloc; b.st[1] = nx; }
        const unsigned old = xb_add(&bar[XB_XSUB(b.x)], 1u);
        const unsigned gen = old / nloc;
        if (old + 1u == (gen + 1u) * nloc) {
            __builtin_amdgcn_fence(__ATOMIC_RELEASE, "agent");
            asm volatile("s_waitcnt vmcnt(0)" ::: "memory");
            const unsigned og = xb_add(&bar[XB_TOP], 1u);
            const unsigned tg = og / nx;
            if (og + 1u == (tg + 1u) * nx) xb_add(&bar[XB_TOPGEN], 1u);
            else XB_SPIN(xb_ld(&bar[XB_TOPGEN]) == tg, bar);
            __builtin_amdgcn_fence(__ATOMIC_ACQUIRE, "agent");
            xb_add(&bar[XB_XGEN(b.x)], 1u);
            asm volatile("s_waitcnt vmcnt(0)" ::: "memory");
        } else {
            XB_SPIN(xb_ld(&bar[XB_XGEN(b.x)]) == gen, bar);
            __builtin_amdgcn_fence(__ATOMIC_ACQUIRE, "agent");
            asm volatile("s_waitcnt vmcnt(0)" ::: "memory");
        }
    }
    __syncthreads();
}


#ifndef NT_STREAMS
#define NT_STREAMS 1
#endif
#if NT_STREAMS
#define LDNT(p) __builtin_nontemporal_load(p)
#define STNT(p, v) __builtin_nontemporal_store((v), (p))
#else
#define LDNT(p) (*(p))
#define STNT(p, v) (*(p) = (v))
#endif
constexpr int NWAVES = 8;
constexpr int DM = 4096, NBATCH = 2, SEQ = 8192, NCTX = 256;
constexpr int MLAT = NBATCH * SEQ;
constexpr int MTOT = MLAT + NBATCH * NCTX;
constexpr int N_AB = 18176;
constexpr int N_ABSRC = 17984, N_C = 40960, MIXW = 8192;
constexpr int QL = 1024, KVL = 512, NQ = 6144, NKV = 8192;
constexpr int G1_CKV = 1024, G1_KR = 1536, G1_ZA = 1792, G1_UB = 5888, G1_VB = 9984, G1_ZB = 14080;
constexpr float EPS = 1e-6f;

constexpr size_t al256(size_t x) { return (x + 255) & ~(size_t)255; }
constexpr size_t WS_CTL = 0, CTL_ZERO_BYTES = 1u << 20;
constexpr size_t WS_MOD  = CTL_ZERO_BYTES;
constexpr size_t WS_OML  = WS_MOD  + al256((size_t)4 * 3 * 12288 * 4);
constexpr size_t WS_ROPE = WS_OML  + al256((size_t)2 * 2 * 8192 * 4);
constexpr size_t WS_STAT = WS_ROPE + al256((size_t)128 * 16 * 8);
constexpr size_t WS_WIN_AB = WS_STAT + al256((size_t)MTOT * 8);
constexpr size_t WS_WIN_C  = WS_WIN_AB + (size_t)2 * N_AB * DM * 2;
constexpr size_t WS_WO_AB  = WS_WIN_C + (size_t)2 * N_C * DM * 2;
constexpr size_t WS_WO_C   = WS_WO_AB + (size_t)2 * DM * MIXW * 2;
constexpr size_t WS_WQ     = WS_WO_C + (size_t)2 * DM * MIXW * 2;
constexpr size_t WS_WKV    = WS_WQ + (size_t)2 * NQ * QL * 2;
constexpr size_t WS_XS     = WS_WKV + (size_t)2 * NKV * KVL * 2;
constexpr size_t WS_H      = WS_XS + (size_t)MTOT * DM * 4;
constexpr size_t WS_Y      = WS_H + (size_t)MTOT * DM * 2;
constexpr size_t WS_G1     = WS_Y + (size_t)MTOT * DM * 4;
constexpr size_t WS_QN     = WS_G1 + (size_t)5 * MTOT * MIXW * 2;
constexpr size_t WS_KVN    = WS_QN + (size_t)MTOT * QL * 2;
constexpr size_t WS_KR     = WS_KVN + (size_t)MTOT * KVL * 2;
constexpr size_t WS_Q      = WS_KR + (size_t)MTOT * 64 * 2;
constexpr size_t WS_KN     = WS_Q + (size_t)MTOT * NQ * 2;
constexpr size_t WS_V      = WS_KN + (size_t)MTOT * DM * 2;
constexpr size_t WS_CC     = WS_V + (size_t)MTOT * DM * 2;
constexpr size_t WS_OF     = WS_CC + (size_t)MTOT * MIXW * 2;
constexpr size_t WS_YP     = WS_OF + (size_t)2 * MTOT * MIXW * 2;
constexpr size_t WS_END    = WS_YP + (size_t)8 * (MTOT - MLAT) * DM * 4;
constexpr int CW_BAR = 4096;

constexpr int RING_BYTES = 135168;
constexpr int LDSCTL_OFF = RING_BYTES, MISC_OFF = LDSCTL_OFF + 64;
constexpr int LDS_BYTES = 147456;

struct Args { const float* in[22]; float* out; unsigned char* ws; int ph_lo, ph_hi; };
typedef const __attribute__((address_space(4))) Args* KArgs;
__device__ __forceinline__ KArgs kargs() { KArgs ap = (KArgs)__builtin_amdgcn_kernarg_segment_ptr(); asm volatile("" : "+s"(ap)); return ap; }

template <class T> __device__ __forceinline__ T* uni(T* p) {
    const unsigned long long v = (unsigned long long)p; const unsigned lo = __builtin_amdgcn_readfirstlane((unsigned)v), hi = __builtin_amdgcn_readfirstlane((unsigned)(v >> 32));
    return (T*)(((unsigned long long)hi << 32) | lo); }
__device__ __forceinline__ float wave_sum(float v) {
#pragma unroll
    for (int o = 1; o < 64; o <<= 1) v += __shfl_xor(v, o);
    return v;
}
__device__ __forceinline__ float bf_lo(unsigned w) { return __uint_as_float(w << 16); }
__device__ __forceinline__ float bf_hi(unsigned w) { return __uint_as_float(w & 0xffff0000u); }
typedef __bf16 bf16x2_t __attribute__((ext_vector_type(2)));
__device__ __forceinline__ unsigned cvtpk(float lo, float hi) { const f32x2 v = {lo, hi}; const bf16x2_t b = __builtin_convertvector(v, bf16x2_t); return __builtin_bit_cast(unsigned, b); }
__device__ __forceinline__ float silu_acc(float x) { return x / (1.0f + __expf(-x)); }

__device__ __forceinline__ void p0_gemv(KArgs a, LAS unsigned char* lds, int G) {
    int tid_l = threadIdx.x; asm volatile("" : "+v"(tid_l)); const int tid = tid_l, lane = tid & 63, wave = __builtin_amdgcn_readfirstlane(tid >> 6);
    LAS float* sc = (LAS float*)lds;
    LAS float* red = (LAS float*)(lds + 49152);
    const float* c = a->in[1]; const float* cctx = a->in[3]; const float* w_ada = a->in[4]; const float* b_ada = a->in[5];
    float* mod = (float*)(a->ws + WS_MOD);
    for (int i = tid; i < 3 * 4096; i += 512) { const int r = i >> 12, k = i & 4095; const float cv = r < 2 ? c[r * 4096 + k] : cctx[k]; sc[i] = silu_acc(cv); }
    __syncthreads();
    const int kr = lane >> 4, c4 = lane & 15;
    for (int item = blockIdx.x; item < 768; item += G) {
        const int l = item / 192, cg = item % 192;
        const float* W = w_ada + (size_t)l * 4096 * 12288 + cg * 64 + c4 * 4;
        float acc[3][4];
#pragma unroll
        for (int r = 0; r < 3; ++r)
#pragma unroll
            for (int j = 0; j < 4; ++j) acc[r][j] = 0.f;
        const int k0 = wave * 512 + kr;
#pragma unroll 8
        for (int i = 0; i < 128; ++i) { const int k = k0 + 4 * i; const f32x4 w = LDNT((const f32x4*)(W + (size_t)k * 12288));
            const float s0 = sc[k], s1 = sc[4096 + k], s2 = sc[8192 + k];
#pragma unroll
            for (int j = 0; j < 4; ++j) { acc[0][j] += s0 * w[j]; acc[1][j] += s1 * w[j]; acc[2][j] += s2 * w[j]; } }
#pragma unroll
        for (int r = 0; r < 3; ++r)
#pragma unroll
            for (int j = 0; j < 4; ++j) { float v = acc[r][j]; v += __shfl_xor(v, 16); v += __shfl_xor(v, 32); acc[r][j] = v; }
        if (lane < 16) {
#pragma unroll
            for (int r = 0; r < 3; ++r)
#pragma unroll
                for (int j = 0; j < 4; ++j) red[(wave * 3 + r) * 64 + lane * 4 + j] = acc[r][j]; }
        __syncthreads();
        if (tid < 192) { const int r = tid >> 6, cc = tid & 63; float s = 0.f;
#pragma unroll
            for (int w = 0; w < 8; ++w) s += red[(w * 3 + r) * 64 + cc];
            const int col = cg * 64 + cc; mod[(size_t)(l * 3 + r) * 12288 + col] = s + b_ada[l * 12288 + col]; }
        __syncthreads();
    }
}
__device__ __forceinline__ void p0_tr_item(const float* W, int N, int K, bf16* WT, int n0s, int n0d, int k0, LAS float* scr, int lane) {
    const int kr = lane >> 4, c4 = lane & 15;
    const float* Wb = uni(W + (size_t)k0 * N + n0s); const unsigned lo = (unsigned)(kr * N + 4 * c4);
    f32x4 w[16];
#pragma unroll
    for (int i = 0; i < 16; ++i) w[i] = LDNT((const f32x4*)(Wb + lo + (unsigned)(4 * i * N)));
#pragma unroll
    for (int i = 0; i < 16; ++i) { const int k = 4 * i + kr;
        scr[(4 * c4 + 0) * 65 + k] = w[i][0]; scr[(4 * c4 + 1) * 65 + k] = w[i][1]; scr[(4 * c4 + 2) * 65 + k] = w[i][2]; scr[(4 * c4 + 3) * 65 + k] = w[i][3]; }
    LDS_WAIT(); asm volatile("" ::: "memory");
    bf16* ob = uni(WT + (size_t)n0d * K + k0); const int nr = lane >> 3, cch = lane & 7;
#pragma unroll
    for (int i = 0; i < 8; ++i) { const int n = 8 * i + nr; const LAS float* s = scr + n * 65 + 8 * cch;
        v4u o; o.x = cvtpk(s[0], s[1]); o.y = cvtpk(s[2], s[3]); o.z = cvtpk(s[4], s[5]); o.w = cvtpk(s[6], s[7]);
        *(v4u*)(ob + (unsigned)(n * K + 8 * cch)) = o; }
    LDS_WAIT(); asm volatile("" ::: "memory");
}
#ifndef P0_DEFER
#define P0_DEFER 1
#endif
constexpr int P0_DEFER_ITEMS = 64 * 640, P0_DEFER_CH = (P0_DEFER_ITEMS + 2) / 3;
__device__ __forceinline__ bool p0_defer_on(int G) { return P0_DEFER && (G % pg8::NXCD == 0); }
__device__ __forceinline__ void p0_deferred(KArgs a, LAS unsigned char* lds, const pg8::LockstepOrder& S, int slot) {
    const int lenmax = S.PG * pg8::LockstepOrder::LW * S.nN + S.qR + (S.rR > 0 ? 1 : 0), R = (lenmax + S.nk - 1) / S.nk, kcut = lenmax - (R - 1) * S.nk;
    const bool all = kcut >= S.nk;
    if (!all && S.k < kcut) return;
    int tid_l = threadIdx.x; asm volatile("" : "+v"(tid_l)); const int lane = tid_l & 63, wave = __builtin_amdgcn_readfirstlane(tid_l >> 6);
    const int rank = all ? S.c : (S.k - kcut) * pg8::NXCD + S.x, nw = (all ? S.G : pg8::NXCD * (S.nk - kcut)) * NWAVES;
    __syncthreads();
    LAS float* scr = (LAS float*)(lds + wave * 16640);
    if (slot < 3) { const int hi_ = min((slot + 1) * P0_DEFER_CH, P0_DEFER_ITEMS);
        for (int it = slot * P0_DEFER_CH + rank * NWAVES + wave; it < hi_; it += nw) { const int kb = it / 640, nb = it % 640;
            p0_tr_item(a->in[18] + (size_t)DM * N_C, N_C, DM, (bf16*)(a->ws + WS_WIN_C) + (size_t)N_C * DM, nb * 64, nb * 64, kb * 64, scr, lane); } }
    else {
        for (int it = rank * NWAVES + wave; it < 128 * 64; it += nw) { const int kb = it / 64, nb = it % 64;
            p0_tr_item(a->in[21] + (size_t)MIXW * DM, DM, MIXW, (bf16*)(a->ws + WS_WO_C) + (size_t)DM * MIXW, nb * 64, nb * 64, kb * 64, scr, lane); } }
    __syncthreads();
}
__device__ __forceinline__ void p0_prologue(KArgs a, LAS unsigned char* lds, int G) {
    int tid_l = threadIdx.x; asm volatile("" : "+v"(tid_l)); const int tid = tid_l, lane = tid & 63, wave = __builtin_amdgcn_readfirstlane(tid >> 6);
    __syncthreads();
    p0_gemv(a, lds, G);
    __syncthreads();
    LAS float* scr = (LAS float*)(lds + wave * 16640);
    const int gw = blockIdx.x * NWAVES + wave, NGW = G * NWAVES;
    constexpr int I_IN_AB = 64 * 281, I_Q = 16 * 96, I_KV = 8 * 128, I_O = 128 * 64, I_IN_C = 64 * 640;
    constexpr int PER_J = I_IN_AB + I_Q + I_KV + I_O + I_IN_C + I_O;
    const bool defer = p0_defer_on(G);
    const int NIT = defer ? 2 * PER_J - I_IN_C - I_O : 2 * PER_J;
    for (int it = gw; it < NIT; it += NGW) {
        const int j = it / PER_J; int r = it % PER_J;
        if (r < I_IN_AB) { const int kb = r / 281, nb = r % 281, n0 = nb * 64;
            p0_tr_item(a->in[8] + (size_t)j * DM * N_ABSRC, N_ABSRC, DM, (bf16*)(a->ws + WS_WIN_AB) + (size_t)j * N_AB * DM, n0, n0 + (n0 >= 1600 ? 192 : 0), kb * 64, scr, lane); continue; } r -= I_IN_AB;
        if (r < I_Q) { const int kb = r / 96, nb = r % 96;
            p0_tr_item(a->in[11] + (size_t)j * QL * NQ, NQ, QL, (bf16*)(a->ws + WS_WQ) + (size_t)j * NQ * QL, nb * 64, nb * 64, kb * 64, scr, lane); continue; } r -= I_Q;
        if (r < I_KV) { const int kb = r / 128, nb = r % 128;
            p0_tr_item(a->in[12] + (size_t)j * KVL * NKV, NKV, KVL, (bf16*)(a->ws + WS_WKV) + (size_t)j * NKV * KVL, nb * 64, nb * 64, kb * 64, scr, lane); continue; } r -= I_KV;
        if (r < I_O) { const int kb = r / 64, nb = r % 64;
            p0_tr_item(a->in[17] + (size_t)j * MIXW * DM, DM, MIXW, (bf16*)(a->ws + WS_WO_AB) + (size_t)j * DM * MIXW, nb * 64, nb * 64, kb * 64, scr, lane); continue; } r -= I_O;
        if (r < I_IN_C) { const int kb = r / 640, nb = r % 640;
            p0_tr_item(a->in[18] + (size_t)j * DM * N_C, N_C, DM, (bf16*)(a->ws + WS_WIN_C) + (size_t)j * N_C * DM, nb * 64, nb * 64, kb * 64, scr, lane); continue; } r -= I_IN_C;
        { const int kb = r / 64, nb = r % 64;
            p0_tr_item(a->in[21] + (size_t)j * MIXW * DM, DM, MIXW, (bf16*)(a->ws + WS_WO_C) + (size_t)j * DM * MIXW, nb * 64, nb * 64, kb * 64, scr, lane); }
    }
    const size_t gt = (size_t)blockIdx.x * 512 + tid, NGT = (size_t)G * 512;
    for (size_t i = gt; i < (size_t)2 * 192 * DM / 8; i += NGT) { const size_t j = i / (192 * DM / 8), e = i % (192 * DM / 8);
        *(v4u*)((bf16*)(a->ws + WS_WIN_AB) + j * (size_t)N_AB * DM + (size_t)1600 * DM + e * 8) = (v4u){0u, 0u, 0u, 0u}; }
    { const float* lg = a->in[19]; float* oml = (float*)(a->ws + WS_OML);
      for (size_t i = gt; i < (size_t)2 * 2 * 8192; i += NGT) { const int jc = (int)(i >> 14), de = (int)(i & 16383);
          const float l0 = lg[0 * 16384 + de], l1 = lg[1 * 16384 + de], l2 = lg[2 * 16384 + de], l3 = lg[3 * 16384 + de];
          const float mx = fmaxf(fmaxf(l0, l1), fmaxf(l2, l3)); const float e0 = __expf(l0 - mx), e1 = __expf(l1 - mx), e2 = __expf(l2 - mx), e3 = __expf(l3 - mx);
          const float inv = 1.0f / (e0 + e1 + e2 + e3); const float lb = (jc == 0) ? e1 * inv : (e1 + e2 + e3) * inv;
          oml[i] = 1.0f - lb; } }
    { f32x2* rope = (f32x2*)(a->ws + WS_ROPE);
      for (size_t i = gt; i < 128 * 16; i += NGT) { const int pos = (int)(i >> 4), f = (int)(i & 15); const float inv = powf(10000.0f, -(float)f / 16.0f); const float ang = (float)pos * inv;
          rope[i] = (f32x2){cosf(ang), sinf(ang)}; } }
}

__device__ __forceinline__ void norm_phase(KArgs a, int lpost, int lpre, int G) {
    int tid_l = threadIdx.x; asm volatile("" : "+v"(tid_l)); const int tid = tid_l, lane = tid & 63, wave = __builtin_amdgcn_readfirstlane(tid >> 6);
    const int gw = blockIdx.x * NWAVES + wave, NGW = G * NWAVES;
    const float* mod = (const float*)(a->ws + WS_MOD);
    float* XS = (float*)(a->ws + WS_XS); const float* Y = (const float*)(a->ws + WS_Y); bf16* H = (bf16*)(a->ws + WS_H);
    const int nrows = (lpost == 3) ? MLAT : MTOT;
    for (int row = gw; row < nrows; row += NGW) {
        const int rt = row < SEQ ? 0 : (row < MLAT ? 1 : 2);
        const float* xin = uni((lpost <= 0) ? (row < MLAT ? a->in[0] + (size_t)row * DM : a->in[2] + (size_t)(row - MLAT) * DM) : XS + (size_t)row * DM);
        f32x4 xv[16];
#pragma unroll
        for (int j = 0; j < 16; ++j) xv[j] = LDNT((const f32x4*)(xin + lane * 4 + 256 * j));
        if (lpost >= 0) {
            f32x4 yv[16]; float ss = 0.f;
            if (row < MLAT) { const bf16* yr = uni((const bf16*)Y + (size_t)row * DM);
#pragma unroll
                for (int j = 0; j < 16; ++j) { const u32x2 w = LDNT((const u32x2*)(yr + lane * 4 + 256 * j)); yv[j] = (f32x4){bf_lo(w.x), bf_hi(w.x), bf_lo(w.y), bf_hi(w.y)}; } }
            else {
                const float* yr = uni((const float*)(a->ws + WS_YP) + (size_t)(row - MLAT) * DM);
#pragma unroll
                for (int j = 0; j < 16; ++j) yv[j] = *(const f32x4*)(yr + lane * 4 + 256 * j);
                for (int kc = 1; kc < 8; ++kc) { const float* yk = uni(yr + (size_t)kc * (MTOT - MLAT) * DM);
#pragma unroll
                    for (int j = 0; j < 16; ++j) { yv[j] = yv[j] + *(const f32x4*)(yk + lane * 4 + 256 * j); if ((j & 3) == 3) asm volatile("" ::: "memory"); } } }
#pragma unroll
            for (int j = 0; j < 16; ++j) ss += (yv[j][0] * yv[j][0] + yv[j][1] * yv[j][1]) + (yv[j][2] * yv[j][2] + yv[j][3] * yv[j][3]);
            const float r = 1.0f / sqrtf(wave_sum(ss) * (1.0f / DM) + EPS);
            const float* gate = uni(mod + (size_t)(lpost * 3 + rt) * 12288 + 8192); const float* pw = uni(a->in[7] + (size_t)lpost * DM);
            float* xout = uni((lpost == 3) ? a->out + (size_t)row * DM : XS + (size_t)row * DM);
#pragma unroll
            for (int j = 0; j < 16; ++j) { const int col = lane * 4 + 256 * j; const f32x4 g = *(const f32x4*)(gate + col), w = *(const f32x4*)(pw + col);
                xv[j] = xv[j] + g * ((yv[j] * r) * w); STNT((f32x4*)(xout + col), xv[j]);
                if ((j & 3) == 3) asm volatile("" ::: "memory"); }
        }
        if (lpre < 4) {
            float ss = 0.f;
#pragma unroll
            for (int j = 0; j < 16; ++j) ss += (xv[j][0] * xv[j][0] + xv[j][1] * xv[j][1]) + (xv[j][2] * xv[j][2] + xv[j][3] * xv[j][3]);
            const float r = 1.0f / sqrtf(wave_sum(ss) * (1.0f / DM) + EPS);
            const float* shift = uni(mod + (size_t)(lpre * 3 + rt) * 12288); const float* scale = shift + 4096; const float* pw = uni(a->in[6] + (size_t)lpre * DM);
            bf16* hr = uni(H + (size_t)row * DM);
#pragma unroll
            for (int j = 0; j < 16; ++j) { const int col = lane * 4 + 256 * j; const f32x4 sh = *(const f32x4*)(shift + col), sc = *(const f32x4*)(scale + col), w = *(const f32x4*)(pw + col);
                const f32x4 h = ((xv[j] * r) * w) * (sc + 1.0f) + sh; u32x2 o; o.x = cvtpk(h[0], h[1]); o.y = cvtpk(h[2], h[3]); *(u32x2*)(hr + col) = o;
                if ((j & 3) == 3) asm volatile("" ::: "memory"); }
        }
    }
}

__device__ __forceinline__ void a2_rows(KArgs a, int j, int G) {
    int tid_l = threadIdx.x; asm volatile("" : "+v"(tid_l)); const int tid = tid_l, lane = tid & 63, wave = __builtin_amdgcn_readfirstlane(tid >> 6);
    const int gw = blockIdx.x * NWAVES + wave, NGW = G * NWAVES;
    const bf16* G1 = (const bf16*)(a->ws + WS_G1); bf16* QN = (bf16*)(a->ws + WS_QN); bf16* KVN = (bf16*)(a->ws + WS_KVN); bf16* KR = (bf16*)(a->ws + WS_KR);
    f32x2* stat = (f32x2*)(a->ws + WS_STAT); const f32x2* rope = (const f32x2*)(a->ws + WS_ROPE);
    const float* qw = a->in[9] + (size_t)j * QL; const float* kvw = a->in[10] + (size_t)j * KVL;
    for (int row = gw; row < MTOT; row += NGW) {
        const bf16* g = uni(G1 + (size_t)row * N_AB);
        {
            v4u w[2]; float x[16]; float ss = 0.f;
#pragma unroll
            for (int i = 0; i < 2; ++i) { w[i] = LDNT((const v4u*)(g + lane * 8 + 512 * i));
#pragma unroll
                for (int e = 0; e < 4; ++e) { x[8 * i + 2 * e] = bf_lo(w[i][e]); x[8 * i + 2 * e + 1] = bf_hi(w[i][e]); } }
#pragma unroll
            for (int e = 0; e < 16; ++e) ss += x[e] * x[e];
            const float r = 1.0f / sqrtf(wave_sum(ss) * (1.0f / QL) + EPS);
#pragma unroll
            for (int i = 0; i < 2; ++i) { const int col = lane * 8 + 512 * i; const f32x4 w0 = *(const f32x4*)(qw + col), w1 = *(const f32x4*)(qw + col + 4);
                v4u o; o.x = cvtpk(x[8 * i + 0] * r * w0[0], x[8 * i + 1] * r * w0[1]); o.y = cvtpk(x[8 * i + 2] * r * w0[2], x[8 * i + 3] * r * w0[3]);
                o.z = cvtpk(x[8 * i + 4] * r * w1[0], x[8 * i + 5] * r * w1[1]); o.w = cvtpk(x[8 * i + 6] * r * w1[2], x[8 * i + 7] * r * w1[3]);
                *(v4u*)(QN + (size_t)row * QL + col) = o; }
        }
        {
            const v4u w = LDNT((const v4u*)(g + G1_CKV + lane * 8)); float x[8]; float ss = 0.f;
#pragma unroll
            for (int e = 0; e < 4; ++e) { x[2 * e] = bf_lo(w[e]); x[2 * e + 1] = bf_hi(w[e]); }
#pragma unroll
            for (int e = 0; e < 8; ++e) ss += x[e] * x[e];
            const float r = 1.0f / sqrtf(wave_sum(ss) * (1.0f / KVL) + EPS);
            const int col = lane * 8; const f32x4 w0 = *(const f32x4*)(kvw + col), w1 = *(const f32x4*)(kvw + col + 4);
            v4u o; o.x = cvtpk(x[0] * r * w0[0], x[1] * r * w0[1]); o.y = cvtpk(x[2] * r * w0[2], x[3] * r * w0[3]); o.z = cvtpk(x[4] * r * w1[0], x[5] * r * w1[1]); o.w = cvtpk(x[6] * r * w1[2], x[7] * r * w1[3]);
            *(v4u*)(KVN + (size_t)row * KVL + col) = o;
        }
        {
            const float x = __uint_as_float((unsigned)g[G1_KR + lane] << 16); const float xp = __shfl_xor(x, 16); float o = x;
            if (row < MLAT) { const int t = row & (SEQ - 1), ax = lane >> 5, hh = (lane >> 4) & 1, f = lane & 15, pos = ax == 0 ? (t >> 6) : (t & 63); const f32x2 cs = rope[pos * 16 + f];
                o = hh == 0 ? x * cs.x - xp * cs.y : x * cs.x + xp * cs.y; }
            KR[(size_t)row * 64 + lane] = (bf16)(cvtpk(o, 0.f) & 0xffffu);
        }
        {
            float x[64]; float s = 0.f;
#pragma unroll
            for (int i = 0; i < 8; ++i) { const v4u w = *(const v4u*)(g + G1_VB + lane * 8 + 512 * i);
#pragma unroll
                for (int e = 0; e < 4; ++e) { x[8 * i + 2 * e] = bf_lo(w[e]); x[8 * i + 2 * e + 1] = bf_hi(w[e]); } }
#pragma unroll
            for (int e = 0; e < 64; ++e) s += x[e];
            const float mean = wave_sum(s) * (1.0f / 4096.0f); float q = 0.f;
#pragma unroll
            for (int e = 0; e < 64; ++e) { const float d = x[e] - mean; q += d * d; }
            const float rstd = 1.0f / sqrtf(wave_sum(q) * (1.0f / 4096.0f) + EPS);
            if (lane == 0) stat[row] = (f32x2){mean, rstd};
        }
    }
}

typedef short s16x4 __attribute__((ext_vector_type(4)));
typedef float f32x16 __attribute__((ext_vector_type(16)));
#define SBAR() __builtin_amdgcn_sched_barrier(0)
__device__ __forceinline__ f32x4 mfma16(bf16x8 a, bf16x8 b, f32x4 c) { return __builtin_amdgcn_mfma_f32_16x16x32_bf16(a, b, c, 0, 0, 0); }
__device__ __forceinline__ int crow(int r, int hi) { return (r & 3) + 8 * (r >> 2) + 4 * hi; }
__device__ __forceinline__ int v_st(int k, int c) { const int kk = (k & ~0xC) | ((k & 4) << 1) | ((k & 8) >> 1); return ((kk >> 3) * 4 + (c >> 5)) * 512 + ((kk & 7) * 32 + (c & 31)) * 2; }
__device__ __forceinline__ int v_rd_base(int lane) { return ((lane & 3) << 3) | (((lane >> 2) & 3) << 6) | (((lane >> 4) & 1) << 5) | (((lane >> 5) & 1) << 8); }
constexpr int v_rd_off(int d0, int ks, int half) { return d0 * 512 + ks * 4096 + half * 2048; }
template <int OFF> __device__ __forceinline__ s16x4 tr_read(int vb) {
    s16x4 r; asm volatile("ds_read_b64_tr_b16 %0, %1 offset:%2" : "=&v"(r) : "v"(vb), "i"(OFF) : "memory"); return r;
}
template <int D0> __device__ __forceinline__ void pv_one(f32x16& od, int vb, bf16x8 pa0, bf16x8 pa1, bf16x8 pa2, bf16x8 pa3) {
    const s16x4 l0 = tr_read<v_rd_off(D0, 0, 0)>(vb), h0 = tr_read<v_rd_off(D0, 0, 1)>(vb), l1 = tr_read<v_rd_off(D0, 1, 0)>(vb), h1 = tr_read<v_rd_off(D0, 1, 1)>(vb);
    const s16x4 l2 = tr_read<v_rd_off(D0, 2, 0)>(vb), h2 = tr_read<v_rd_off(D0, 2, 1)>(vb), l3 = tr_read<v_rd_off(D0, 3, 0)>(vb), h3 = tr_read<v_rd_off(D0, 3, 1)>(vb);
    asm volatile("s_waitcnt lgkmcnt(0)" ::: "memory"); SBAR();
#define PKV(L, H) (bf16x8){L[0], L[1], L[2], L[3], H[0], H[1], H[2], H[3]}
    od = __builtin_amdgcn_mfma_f32_32x32x16_bf16(pa0, PKV(l0, h0), od, 0, 0, 0);
    od = __builtin_amdgcn_mfma_f32_32x32x16_bf16(pa1, PKV(l1, h1), od, 0, 0, 0);
    od = __builtin_amdgcn_mfma_f32_32x32x16_bf16(pa2, PKV(l2, h2), od, 0, 0, 0);
    od = __builtin_amdgcn_mfma_f32_32x32x16_bf16(pa3, PKV(l3, h3), od, 0, 0, 0);
#undef PKV
}
__device__ __forceinline__ void pv_d0(f32x16* o, int vb, bf16x8 pa0, bf16x8 pa1, bf16x8 pa2, bf16x8 pa3) {
    pv_one<0>(o[0], vb, pa0, pa1, pa2, pa3); pv_one<1>(o[1], vb, pa0, pa1, pa2, pa3); pv_one<2>(o[2], vb, pa0, pa1, pa2, pa3); pv_one<3>(o[3], vb, pa0, pa1, pa2, pa3);
}

template <int I> __device__ __forceinline__ void pv_rd(int vb, s16x4& l0, s16x4& h0, s16x4& l1, s16x4& h1) {
    l0 = tr_read<v_rd_off(I >> 1, 2 * (I & 1), 0)>(vb); h0 = tr_read<v_rd_off(I >> 1, 2 * (I & 1), 1)>(vb); l1 = tr_read<v_rd_off(I >> 1, 2 * (I & 1) + 1, 0)>(vb); h1 = tr_read<v_rd_off(I >> 1, 2 * (I & 1) + 1, 1)>(vb);
}
#define PKV2(L, H) (bf16x8){L[0], L[1], L[2], L[3], H[0], H[1], H[2], H[3]}
#define PV_MM(I, A0, A1, L0, H0, L1, H1) do { o[(I) >> 1] = __builtin_amdgcn_mfma_f32_32x32x16_bf16(A0, PKV2(L0, H0), o[(I) >> 1], 0, 0, 0); o[(I) >> 1] = __builtin_amdgcn_mfma_f32_32x32x16_bf16(A1, PKV2(L1, H1), o[(I) >> 1], 0, 0, 0); } while (0)
#define PV_WAIT4() do { asm volatile("s_waitcnt lgkmcnt(4)" ::: "memory"); SBAR(); } while (0)
#define PV_WAIT0() do { asm volatile("s_waitcnt lgkmcnt(0)" ::: "memory"); SBAR(); } while (0)
__device__ __forceinline__ void pv_pipe(f32x16* o, int vb, bf16x8 pa0, bf16x8 pa1, bf16x8 pa2, bf16x8 pa3) {
    s16x4 al0, ah0, al1, ah1, bl0, bh0, bl1, bh1;
    asm volatile("s_waitcnt lgkmcnt(0)" ::: "memory"); SBAR();
    pv_rd<0>(vb, al0, ah0, al1, ah1); pv_rd<1>(vb, bl0, bh0, bl1, bh1);
    PV_WAIT4(); PV_MM(0, pa0, pa1, al0, ah0, al1, ah1); SBAR(); pv_rd<2>(vb, al0, ah0, al1, ah1);
    PV_WAIT4(); PV_MM(1, pa2, pa3, bl0, bh0, bl1, bh1); SBAR(); pv_rd<3>(vb, bl0, bh0, bl1, bh1);
    PV_WAIT4(); PV_MM(2, pa0, pa1, al0, ah0, al1, ah1); SBAR(); pv_rd<4>(vb, al0, ah0, al1, ah1);
    PV_WAIT4(); PV_MM(3, pa2, pa3, bl0, bh0, bl1, bh1); SBAR(); pv_rd<5>(vb, bl0, bh0, bl1, bh1);
    PV_WAIT4(); PV_MM(4, pa0, pa1, al0, ah0, al1, ah1); SBAR(); pv_rd<6>(vb, al0, ah0, al1, ah1);
    PV_WAIT4(); PV_MM(5, pa2, pa3, bl0, bh0, bl1, bh1); SBAR(); pv_rd<7>(vb, bl0, bh0, bl1, bh1);
    PV_WAIT4(); PV_MM(6, pa0, pa1, al0, ah0, al1, ah1);
    PV_WAIT0(); PV_MM(7, pa2, pa3, bl0, bh0, bl1, bh1);
}

__device__ __forceinline__ void pv_seq(f32x16* o, int vb, bf16x8 pa0, bf16x8 pa1, bf16x8 pa2, bf16x8 pa3) {
    s16x4 al0, ah0, al1, ah1;
    pv_rd<0>(vb, al0, ah0, al1, ah1); PV_WAIT0(); PV_MM(0, pa0, pa1, al0, ah0, al1, ah1); SBAR();
    pv_rd<1>(vb, al0, ah0, al1, ah1); PV_WAIT0(); PV_MM(1, pa2, pa3, al0, ah0, al1, ah1); SBAR();
    pv_rd<2>(vb, al0, ah0, al1, ah1); PV_WAIT0(); PV_MM(2, pa0, pa1, al0, ah0, al1, ah1); SBAR();
    pv_rd<3>(vb, al0, ah0, al1, ah1); PV_WAIT0(); PV_MM(3, pa2, pa3, al0, ah0, al1, ah1); SBAR();
    pv_rd<4>(vb, al0, ah0, al1, ah1); PV_WAIT0(); PV_MM(4, pa0, pa1, al0, ah0, al1, ah1); SBAR();
    pv_rd<5>(vb, al0, ah0, al1, ah1); PV_WAIT0(); PV_MM(5, pa2, pa3, al0, ah0, al1, ah1); SBAR();
    pv_rd<6>(vb, al0, ah0, al1, ah1); PV_WAIT0(); PV_MM(6, pa0, pa1, al0, ah0, al1, ah1); SBAR();
    pv_rd<7>(vb, al0, ah0, al1, ah1); PV_WAIT0(); PV_MM(7, pa2, pa3, al0, ah0, al1, ah1);
}

__device__ __forceinline__ void sgu_phase(KArgs a, int j, LAS unsigned char* lds, int G) {
    int tid_l = threadIdx.x; asm volatile("" : "+v"(tid_l)); const int tid = tid_l, lane = tid & 63, wid = __builtin_amdgcn_readfirstlane(tid >> 6), r32 = lane & 31, hi = lane >> 5;
    const bf16* G1 = (const bf16*)(a->ws + WS_G1); bf16* CC = (bf16*)(a->ws + WS_CC); const f32x2* stat = (const f32x2*)(a->ws + WS_STAT);
    const float* lnw = a->in[13] + (size_t)j * 4096; const float* lnb = a->in[14] + (size_t)j * 4096; const float* ws_all = a->in[15] + (size_t)j * 16 * 128 * 128; const float* bs = a->in[16] + (size_t)j * 16 * 128;
    constexpr int MXP = 272, OFF_ST = 69632;
    LAS float* st_mean = (LAS float*)(lds + OFF_ST); LAS float* st_rstd = st_mean + 128;
    LAS float* m1s = (LAS float*)(lds + OFF_ST + 1024) + wid * 64; LAS float* rss = m1s + 32;
    LAS unsigned char* mx = lds + wid * (32 * MXP);
    const int sr = tid >> 4, sc = (tid & 15) * 8, vst0 = v_st(sr, sc), vst1 = v_st(32 + sr, sc);
    const int tb = wid >> 1, ch = wid & 1;
    const int vb0 = (int)(unsigned)(unsigned long long)lds + v_rd_base(lane);
    v4u vx[8];
#define SGU_LOADV(it_) do { const int ch_ = (it_) >> 4, g_ = (it_) & 15; const bf16* s0_ = uni(G1 + (size_t)(ch_ * 128) * N_AB + G1_VB + g_ * 256); const unsigned lo_ = (unsigned)(sr * N_AB + sc); \
    _Pragma("unroll") for (int st = 0; st < 2; ++st) _Pragma("unroll") for (int c2 = 0; c2 < 2; ++c2) { const unsigned o_ = lo_ + (unsigned)(64 * st * N_AB + c2 * 128); \
        vx[(st * 2 + c2) * 2] = LDNT((const v4u*)(s0_ + o_)); vx[(st * 2 + c2) * 2 + 1] = LDNT((const v4u*)(s0_ + o_ + 32 * N_AB)); } } while (0)
    const int item0 = (int)((blockIdx.x + 128u) % (unsigned)G);
    if (item0 < 132 * 16) SGU_LOADV(item0);
    for (int item = item0; item < 132 * 16; item += G) {
        const int chunk = item >> 4, g = item & 15, row0 = chunk * 128;
        __syncthreads();
#pragma unroll
        for (int q = 0; q < 4; ++q) { *(LAS v4u*)(lds + q * 16384 + vst0) = vx[2 * q]; *(LAS v4u*)(lds + q * 16384 + vst1) = vx[2 * q + 1]; }
        if (tid < 128) { const f32x2 s = stat[row0 + tid]; st_mean[tid] = s.x; st_rstd[tid] = s.y; }
        __syncthreads();
        if (item + G < 132 * 16) SGU_LOADV(item + G);
        const float* wrow = ws_all + ((size_t)g * 128 + 32 * tb + r32) * 128;
        bf16x8 pa[2][4]; float m1 = 0.f, rs = 0.f;
#pragma unroll
        for (int st = 0; st < 2; ++st)
#pragma unroll
            for (int ks = 0; ks < 4; ++ks) { const int s0 = 64 * st + 16 * ks + 8 * hi; const f32x4 w0 = *(const f32x4*)(wrow + s0), w1 = *(const f32x4*)(wrow + s0 + 4);
                const f32x4 r0 = *(const LAS f32x4*)(st_rstd + s0), r1 = *(const LAS f32x4*)(st_rstd + s0 + 4), mu0 = *(const LAS f32x4*)(st_mean + s0), mu1 = *(const LAS f32x4*)(st_mean + s0 + 4);
                rs += (w0[0] + w0[1]) + (w0[2] + w0[3]) + (w1[0] + w1[1]) + (w1[2] + w1[3]);
                v4u p; p.x = cvtpk(w0[0] * r0[0], w0[1] * r0[1]); p.y = cvtpk(w0[2] * r0[2], w0[3] * r0[3]); p.z = cvtpk(w1[0] * r1[0], w1[1] * r1[1]); p.w = cvtpk(w1[2] * r1[2], w1[3] * r1[3]);
                m1 += bf_lo(p.x) * mu0[0] + bf_hi(p.x) * mu0[1] + bf_lo(p.y) * mu0[2] + bf_hi(p.y) * mu0[3] + bf_lo(p.z) * mu1[0] + bf_hi(p.z) * mu1[1] + bf_lo(p.w) * mu1[2] + bf_hi(p.w) * mu1[3];
                pa[st][ks] = __builtin_bit_cast(bf16x8, p); }
        m1 += __shfl_xor(m1, 32); rs += __shfl_xor(rs, 32);
        if (hi == 0) { m1s[r32] = m1; rss[r32] = rs; }
        f32x16 o[4];
#pragma unroll
        for (int d = 0; d < 4; ++d)
#pragma unroll
            for (int r = 0; r < 16; ++r) o[d][r] = 0.f;
#pragma unroll
        for (int st = 0; st < 2; ++st) pv_d0(o, vb0 + (st * 2 + ch) * 16384, pa[st][0], pa[st][1], pa[st][2], pa[st][3]);
        asm volatile("s_waitcnt lgkmcnt(0)" ::: "memory");
        __syncthreads();
        { const int cb = g * 256 + ch * 128;
          const float* lw = uni(lnw + cb); const float* lb = uni(lnb + cb); const float* bsg = uni(bs + g * 128 + 32 * tb);
          int r32e = r32, hie = hi; asm volatile("" : "+v"(r32e), "+v"(hie));
          float lwv[4], lbv[4];
#pragma unroll
          for (int d0 = 0; d0 < 4; ++d0) { lwv[d0] = lw[d0 * 32 + r32e]; lbv[d0] = lb[d0 * 32 + r32e]; }
#pragma unroll
          for (int r = 0; r < 16; ++r) { const int rr = crow(r, hie); const float m1t = m1s[rr], rst = rss[rr], bst = bsg[rr];
#pragma unroll
            for (int d0 = 0; d0 < 4; ++d0) { const float mix = lwv[d0] * (o[d0][r] - m1t) + lbv[d0] * rst + bst;
                *(LAS bf16*)(mx + rr * MXP + (d0 * 32 + r32e) * 2) = (bf16)(cvtpk(mix, 0.f) & 0xffffu); } } }
        asm volatile("s_waitcnt lgkmcnt(0)" ::: "memory");
        { const int cb = g * 256 + ch * 128;
          const bf16* Gu = uni(G1 + (size_t)(row0 + 32 * tb) * N_AB + G1_UB + cb); const bf16* Gzb = uni(G1 + (size_t)(row0 + 32 * tb) * N_AB + G1_ZB + cb); bf16* Co = uni(CC + (size_t)(row0 + 32 * tb) * MIXW + 4096 + cb);
          int le = lane; asm volatile("" : "+v"(le));
#pragma unroll
          for (int i = 0; i < 8; ++i) { const int id = 64 * i + le, row = id >> 4, c8 = (id & 15) * 8;
              const v4u mq = *(const LAS v4u*)(mx + row * MXP + c8 * 2); const v4u uq = LDNT((const v4u*)(Gu + (unsigned)(row * N_AB + c8))), zq = LDNT((const v4u*)(Gzb + (unsigned)(row * N_AB + c8)));
              v4u oq;
#pragma unroll
              for (int e = 0; e < 4; ++e) oq[e] = cvtpk(bf_lo(uq[e]) * bf_lo(mq[e]) * bf_lo(zq[e]), bf_hi(uq[e]) * bf_hi(mq[e]) * bf_hi(zq[e]));
              *(v4u*)(Co + (unsigned)(row * MIXW + c8)) = oq;
              if ((i & 3) == 3) asm volatile("" ::: "memory"); } }
    }
#undef SGU_LOADV
    __syncthreads();
}

namespace att {
constexpr int QBLK = 32, KVBLK = 64;
constexpr float SCALE = 0.07216878364870322f;
constexpr float THR = 8.f;
constexpr int SHM_V = KVBLK * 128 * 2, SHM_K = KVBLK * 192 * 2;
#ifndef STG_SEL
#define STG_SEL 0
#endif
#ifndef ATT_STAGGER
#define ATT_STAGGER 1
#endif
constexpr int NVB = ATT_STAGGER ? 3 : 2;
constexpr int OFF_V = 0, OFF_K = NVB * SHM_V, OFF_WS = OFF_K + 2 * SHM_K, ATT_LDS = OFF_WS + NWAVES * 64 * 4;
#ifndef ATT_QR_LDS
#define ATT_QR_LDS 1
#endif
#ifndef ATT_SDEPTH
#define ATT_SDEPTH 1
#endif
constexpr int SDEPTH = ATT_SDEPTH;
constexpr float THRL = THR * 1.4426950408889634f;
__device__ __forceinline__ void partialSM_first(f32x16& p0, f32x16& p1, float& m_reg, float& alpha) {
    float pmax = p0[0];
#pragma unroll
    for (int r = 1; r < 16; ++r) pmax = fmaxf(pmax, p0[r]);
#pragma unroll
    for (int r = 0; r < 16; ++r) pmax = fmaxf(pmax, p1[r]);
    { auto rr = __builtin_amdgcn_permlane32_swap(__float_as_uint(pmax), __float_as_uint(pmax), false, false);
      pmax = fmaxf(__uint_as_float(rr[0]), __uint_as_float(rr[1])); }
    m_reg = pmax; alpha = 1.f;
#pragma unroll
    for (int r = 0; r < 16; ++r) p0[r] = p0[r] - pmax;
#pragma unroll
    for (int r = 0; r < 16; ++r) p1[r] = p1[r] - pmax;
#pragma unroll
    for (int r = 0; r < 16; ++r) p0[r] = __builtin_amdgcn_exp2f(p0[r]);
}
__device__ __forceinline__ void partialSM(f32x16& p0, f32x16& p1, float& m_reg, float& alpha) {
    float pmax = p0[0];
#pragma unroll
    for (int r = 1; r < 16; ++r) pmax = fmaxf(pmax, p0[r]);
#pragma unroll
    for (int r = 0; r < 16; ++r) pmax = fmaxf(pmax, p1[r]);
    { auto rr = __builtin_amdgcn_permlane32_swap(__float_as_uint(pmax), __float_as_uint(pmax), false, false);
      pmax = fmaxf(__uint_as_float(rr[0]), __uint_as_float(rr[1])); }
    if (__builtin_expect(__all(pmax <= THRL), 1)) { alpha = 1.f; }
    else { const float d = fmaxf(pmax, 0.f); alpha = __builtin_amdgcn_exp2f(-d); m_reg += d;
#pragma unroll
        for (int r = 0; r < 16; ++r) p0[r] = p0[r] - d;
#pragma unroll
        for (int r = 0; r < 16; ++r) p1[r] = p1[r] - d; }
#pragma unroll
    for (int r = 0; r < 16; ++r) p0[r] = __builtin_amdgcn_exp2f(p0[r]);
}
__device__ __forceinline__ void finishSM(f32x16& p0, f32x16& p1, float alpha, float& l_reg, bf16x8& pa0, bf16x8& pa1, bf16x8& pa2, bf16x8& pa3) {
#pragma unroll
    for (int r = 0; r < 16; ++r) p1[r] = __builtin_amdgcn_exp2f(p1[r]);
    float ps = 0;
#pragma unroll
    for (int r = 0; r < 16; ++r) ps += p0[r];
#pragma unroll
    for (int r = 0; r < 16; ++r) ps += p1[r];
    { auto rr = __builtin_amdgcn_permlane32_swap(__float_as_uint(ps), __float_as_uint(ps), false, false);
      ps = __uint_as_float(rr[0]) + __uint_as_float(rr[1]); }
    l_reg = l_reg * alpha + ps;
#define PK4(P, BASE, OUT) do { unsigned a0 = cvtpk(P[BASE + 0], P[BASE + 1]), a1 = cvtpk(P[BASE + 2], P[BASE + 3]);   \
    unsigned b0 = cvtpk(P[BASE + 4], P[BASE + 5]), b1 = cvtpk(P[BASE + 6], P[BASE + 7]);                              \
    auto r0 = __builtin_amdgcn_permlane32_swap(a0, b0, false, false); auto r1 = __builtin_amdgcn_permlane32_swap(a1, b1, false, false); \
    v4u w = {r0[0], r1[0], r0[1], r1[1]}; OUT = __builtin_bit_cast(bf16x8, w); } while (0)
    PK4(p0, 0, pa0); PK4(p0, 8, pa1); PK4(p1, 0, pa2); PK4(p1, 8, pa3);
#undef PK4
}
constexpr int OFF_KR = 16384;
constexpr int OFF_QR = ATT_LDS, ATT_LDS2 = OFF_QR + NWAVES * 4096;
__device__ __forceinline__ void qkt(f32x16& p0, f32x16& p1, const LAS unsigned char* Ks, const bf16x8* qr, const LAS unsigned char* qrl, int r32, int hi, float seed) {
#pragma unroll
    for (int r = 0; r < 16; ++r) { p0[r] = seed; p1[r] = seed; }
    const int swn = (r32 & 15) << 4, swr = ((r32 >> 1) & 7) << 4;
#pragma unroll
    for (int d0 = 0; d0 < 8; ++d0) { const int cb = (d0 * 16 + hi * 8) * 2;
        const bf16x8 b0 = *(const LAS bf16x8*)(Ks + r32 * 256 + (cb ^ swn));
        const bf16x8 b1 = *(const LAS bf16x8*)(Ks + (32 + r32) * 256 + (cb ^ swn));
        p0 = __builtin_amdgcn_mfma_f32_32x32x16_bf16(b0, qr[d0], p0, 0, 0, 0);
        p1 = __builtin_amdgcn_mfma_f32_32x32x16_bf16(b1, qr[d0], p1, 0, 0, 0); }
#pragma unroll
    for (int d0 = 0; d0 < 4; ++d0) { const int cb = (d0 * 16 + hi * 8) * 2;
        const bf16x8 b0 = *(const LAS bf16x8*)(Ks + OFF_KR + r32 * 128 + (cb ^ swr));
        const bf16x8 b1 = *(const LAS bf16x8*)(Ks + OFF_KR + (32 + r32) * 128 + (cb ^ swr));
#if ATT_QR_LDS
        const bf16x8 q = *(const LAS bf16x8*)(qrl + d0 * 1024);
#else
        const bf16x8 q = qr[8 + d0];
#endif
        p0 = __builtin_amdgcn_mfma_f32_32x32x16_bf16(b0, q, p0, 0, 0, 0);
        p1 = __builtin_amdgcn_mfma_f32_32x32x16_bf16(b1, q, p1, 0, 0, 0); }
}
__device__ __forceinline__ void attn_unit(const bf16* __restrict__ Q, const bf16* __restrict__ KN, const bf16* __restrict__ KR, const bf16* __restrict__ V, const bf16* __restrict__ G1, bf16* __restrict__ CC,
                                          int qrow0, int h, int nt_lat, int lat0, int ctx0, LAS unsigned char* lds) {
    int tid_l = threadIdx.x; asm volatile("" : "+v"(tid_l)); const int tid = tid_l, wid = __builtin_amdgcn_readfirstlane(tid >> 6), lane = tid & 63, r32 = lane & 31, hi = lane >> 5;
    LAS unsigned char* V_lds = lds + OFF_V; LAS unsigned char* K_lds = lds + OFF_K;
    LAS float* wsf = (LAS float*)(lds + OFF_WS) + wid * 64; LAS float* li_l = wsf; LAS float* al_l = wsf + 32;
    LAS unsigned char* qrl = lds + OFF_QR + wid * 4096 + lane * 16;
    float m_reg = -1e30f, l_reg = 0;
    f32x16 o[4];
#pragma unroll
    for (int d = 0; d < 4; ++d)
#pragma unroll
        for (int r = 0; r < 16; ++r) o[d][r] = 0.f;
    const unsigned ko = (unsigned)((tid >> 4) * 128 + (((tid & 15) ^ ((tid >> 4) & 15)) * 8));
    const unsigned kro = (unsigned)((tid >> 3) * 64 + (((tid & 7) ^ ((tid >> 4) & 7)) * 8));
    unsigned vo; { const int sub = tid >> 5, kk = (sub >> 2) * 8 + ((tid & 31) >> 2), col = (sub & 3) * 32 + (tid & 3) * 8, key = (kk & ~0xC) | ((kk & 4) << 1) | ((kk & 8) >> 1); vo = (unsigned)(key * 128 + col); }
    const int vb0 = (int)(unsigned)(unsigned long long)lds + OFF_V + v_rd_base(lane);
    const int NT = nt_lat + 4;
#define TROW(jt) ((jt) < nt_lat ? lat0 + 64 * (jt) : ctx0 + 64 * ((jt) - nt_lat))
#define GLDS(gp, lp) __builtin_amdgcn_global_load_lds((const unsigned*)(gp), (LAS unsigned*)(lp), 16, 0, 0)
#define ISSUE_K(jt, b) do { const int R0_ = TROW(jt); const bf16* Kb_ = uni(KN + ((size_t)h * MTOT + R0_) * 128); const bf16* Rb_ = uni(KR + (size_t)R0_ * 64); \
    GLDS(Kb_ + ko, K_lds + (b) * SHM_K + wid * 1024); GLDS(Kb_ + ko + 32 * 128, K_lds + (b) * SHM_K + (wid + 8) * 1024); GLDS(Rb_ + kro, K_lds + (b) * SHM_K + OFF_KR + wid * 1024); } while (0)
#define ISSUE_V(jt, b) do { const int R0_ = TROW(jt); const bf16* Vb_ = uni(V + ((size_t)h * MTOT + R0_) * 128); \
    GLDS(Vb_ + vo, V_lds + (b) * SHM_V + wid * 1024); GLDS(Vb_ + vo + 32 * 128, V_lds + (b) * SHM_V + (wid + 8) * 1024); } while (0)
#define STEP_END() asm volatile("s_waitcnt vmcnt(0) lgkmcnt(0)\n\ts_barrier" ::: "memory")
#define RESC(a_) do { if (__any((a_) < 1.f)) { if (hi == 0) al_l[r32] = (a_); asm volatile("s_waitcnt lgkmcnt(0)" ::: "memory"); \
    _Pragma("unroll") for (int d = 0; d < 4; ++d) _Pragma("unroll") for (int r = 0; r < 16; ++r) o[d][r] *= al_l[crow(r, hi)]; } } while (0)
    STEP_END();
    ISSUE_K(0, 0);
    bf16x8 qr[ATT_QR_LDS ? 8 : 12];
    { const bf16* Qw = uni(Q + (size_t)(qrow0 + wid * QBLK) * NQ + h * 192); const unsigned qo = (unsigned)(r32 * NQ + hi * 8);
#pragma unroll
      for (int d0 = 0; d0 < (ATT_QR_LDS ? 8 : 12); ++d0) qr[d0] = *(const bf16x8*)(Qw + qo + d0 * 16);
#if ATT_QR_LDS
#pragma unroll
      for (int d0 = 8; d0 < 12; ++d0) { const bf16x8 t = *(const bf16x8*)(Qw + qo + d0 * 16); *(LAS bf16x8*)(qrl + (d0 - 8) * 1024) = t; }
#endif
    }
    f32x16 pA0, pA1, pB0, pB1; float alA, alB; bf16x8 pa0, pa1, pa2, pa3;
    STEP_END();
#if !ATT_STAGGER
    ISSUE_K(1, 1); ISSUE_V(0, 0);
    qkt(pA0, pA1, K_lds, qr, qrl, r32, hi, 0.f); partialSM_first(pA0, pA1, m_reg, alA);
    STEP_END();
    for (int j = 1; j + 1 < NT; j += 2) {
        ISSUE_K(j + 1, 0); ISSUE_V(j, 1);
        SBAR(); qkt(pB0, pB1, K_lds + SHM_K, qr, qrl, r32, hi, -m_reg);
        finishSM(pA0, pA1, alA, l_reg, pa0, pa1, pa2, pa3); SBAR();
        pv_pipe(o, vb0, pa0, pa1, pa2, pa3); partialSM(pB0, pB1, m_reg, alB);
        RESC(alB); STEP_END();
        ISSUE_K(j + 2, 1); ISSUE_V(j + 1, 0);
        SBAR(); qkt(pA0, pA1, K_lds, qr, qrl, r32, hi, -m_reg);
        finishSM(pB0, pB1, alB, l_reg, pa0, pa1, pa2, pa3); SBAR();
        pv_pipe(o, vb0 + SHM_V, pa0, pa1, pa2, pa3); partialSM(pA0, pA1, m_reg, alA);
        RESC(alA); STEP_END();
    }
    ISSUE_V(NT - 1, 1);
    SBAR(); qkt(pB0, pB1, K_lds + SHM_K, qr, qrl, r32, hi, -m_reg);
    finishSM(pA0, pA1, alA, l_reg, pa0, pa1, pa2, pa3); SBAR();
    pv_pipe(o, vb0, pa0, pa1, pa2, pa3); partialSM(pB0, pB1, m_reg, alB);
    RESC(alB); STEP_END();
    finishSM(pB0, pB1, alB, l_reg, pa0, pa1, pa2, pa3); SBAR();
    pv_pipe(o, vb0 + SHM_V, pa0, pa1, pa2, pa3);
#else
#define VOFF(t) (__builtin_amdgcn_readfirstlane(((unsigned)(t) % 3u) * (unsigned)SHM_V))
    if (STG_SEL == 0 ? (wid < 4) : (STG_SEL == 1)) {
        ISSUE_K(1, 1); ISSUE_V(0, 0);
        qkt(pA0, pA1, K_lds, qr, qrl, r32, hi, 0.f); partialSM_first(pA0, pA1, m_reg, alA);
        STEP_END();
        for (int j = 1; j + 1 < NT; j += 2) {
            ISSUE_K(j + 1, 0); ISSUE_V(j, j % 3);
            SBAR(); qkt(pB0, pB1, K_lds + SHM_K, qr, qrl, r32, hi, -m_reg); SBAR();
            finishSM(pA0, pA1, alA, l_reg, pa0, pa1, pa2, pa3); SBAR();
            pv_pipe(o, vb0 + VOFF(j - 1), pa0, pa1, pa2, pa3); partialSM(pB0, pB1, m_reg, alB);
            RESC(alB); STEP_END();
            ISSUE_K(j + 2, 1); ISSUE_V(j + 1, (j + 1) % 3);
            SBAR(); qkt(pA0, pA1, K_lds, qr, qrl, r32, hi, -m_reg); SBAR();
            finishSM(pB0, pB1, alB, l_reg, pa0, pa1, pa2, pa3); SBAR();
            pv_pipe(o, vb0 + VOFF(j), pa0, pa1, pa2, pa3); partialSM(pA0, pA1, m_reg, alA);
            RESC(alA); STEP_END();
        }
        ISSUE_V(NT - 1, (NT - 1) % 3);
        SBAR(); qkt(pB0, pB1, K_lds + SHM_K, qr, qrl, r32, hi, -m_reg); SBAR();
        finishSM(pA0, pA1, alA, l_reg, pa0, pa1, pa2, pa3); SBAR();
        pv_pipe(o, vb0 + VOFF(NT - 2), pa0, pa1, pa2, pa3); partialSM(pB0, pB1, m_reg, alB);
        RESC(alB); STEP_END();
        finishSM(pB0, pB1, alB, l_reg, pa0, pa1, pa2, pa3); SBAR();
        pv_pipe(o, vb0 + VOFF(NT - 1), pa0, pa1, pa2, pa3);
        STEP_END();
        STEP_END();
    } else {
#define TR_EVEN(j_) do { finishSM(pA0, pA1, alA, l_reg, pa0, pa1, pa2, pa3); SBAR(); pv_pipe(o, vb0 + VOFF((j_) - 2), pa0, pa1, pa2, pa3); partialSM(pB0, pB1, m_reg, alB); RESC(alB); } while (0)
#define TR_ODD(j_)  do { finishSM(pB0, pB1, alB, l_reg, pa0, pa1, pa2, pa3); SBAR(); pv_pipe(o, vb0 + VOFF((j_) - 2), pa0, pa1, pa2, pa3); partialSM(pA0, pA1, m_reg, alA); RESC(alA); } while (0)
        ISSUE_K(1, 1); ISSUE_V(0, 0);
        qkt(pA0, pA1, K_lds, qr, qrl, r32, hi, 0.f);
        STEP_END();
        ISSUE_K(2, 0); ISSUE_V(1, 1);
        partialSM_first(pA0, pA1, m_reg, alA);
        SBAR(); qkt(pB0, pB1, K_lds + SHM_K, qr, qrl, r32, hi, -m_reg); SBAR();
        STEP_END();
        for (int j = 2; j + 1 < NT - 1; j += 2) {
            ISSUE_K(j + 1, 1); ISSUE_V(j, j % 3);
            TR_EVEN(j); SBAR(); qkt(pA0, pA1, K_lds, qr, qrl, r32, hi, -m_reg); SBAR();
            STEP_END();
            ISSUE_K(j + 2, 0); ISSUE_V(j + 1, (j + 1) % 3);
            TR_ODD(j + 1); SBAR(); qkt(pB0, pB1, K_lds + SHM_K, qr, qrl, r32, hi, -m_reg); SBAR();
            STEP_END();
        }
        ISSUE_K(NT - 1, 1); ISSUE_V(NT - 2, (NT - 2) % 3);
        TR_EVEN(NT - 2); SBAR(); qkt(pA0, pA1, K_lds, qr, qrl, r32, hi, -m_reg); SBAR();
        STEP_END();
        ISSUE_V(NT - 1, (NT - 1) % 3);
        TR_ODD(NT - 1); SBAR(); qkt(pB0, pB1, K_lds + SHM_K, qr, qrl, r32, hi, -m_reg); SBAR();
        STEP_END();
        TR_EVEN(NT);
        STEP_END();
        finishSM(pB0, pB1, alB, l_reg, pa0, pa1, pa2, pa3); SBAR();
        pv_pipe(o, vb0 + VOFF(NT - 1), pa0, pa1, pa2, pa3);
        STEP_END();
#undef TR_EVEN
#undef TR_ODD
    }
#undef VOFF
#endif
    if (hi == 0) li_l[r32] = l_reg;
    STEP_END();
    { LAS unsigned char* mx = lds + wid * (32 * 272);
      int r32e = r32, hie = hi; asm volatile("" : "+v"(r32e), "+v"(hie));
#pragma unroll
      for (int r = 0; r < 16; ++r) { const int rr = crow(r, hie); const float rli = __builtin_amdgcn_rcpf(li_l[rr]);
#pragma unroll
        for (int d0 = 0; d0 < 4; ++d0) *(LAS bf16*)(mx + rr * 272 + (d0 * 32 + r32e) * 2) = (bf16)(cvtpk(o[d0][r] * rli, 0.f) & 0xffffu); }
      asm volatile("s_waitcnt lgkmcnt(0)" ::: "memory");
      const bf16* Gz = uni(G1 + (size_t)(qrow0 + wid * QBLK) * N_AB + G1_ZA + h * 128); bf16* Co = uni(CC + (size_t)(qrow0 + wid * QBLK) * MIXW + h * 128);
      int le = lane; asm volatile("" : "+v"(le));
#pragma unroll
      for (int i = 0; i < 8; ++i) { const int id = 64 * i + le, row = id >> 4, c8 = (id & 15) * 8;
          const v4u oq = *(const LAS v4u*)(mx + row * 272 + c8 * 2); const v4u zq = LDNT((const v4u*)(Gz + (unsigned)(row * N_AB + c8)));
          v4u wq;
#pragma unroll
          for (int e = 0; e < 4; ++e) wq[e] = cvtpk(bf_lo(oq[e]) * bf_lo(zq[e]), bf_hi(oq[e]) * bf_hi(zq[e]));
          *(v4u*)(Co + (unsigned)(row * MIXW + c8)) = wq;
          if ((i & 3) == 3) asm volatile("" ::: "memory"); } }
#undef TROW
#undef GLDS
#undef ISSUE_K
#undef ISSUE_V
#undef STEP_END
#undef RESC
}
}
namespace att2 {
using namespace att;
struct P8 { f32x4 t[2][4]; };
__device__ __forceinline__ float x16(float x) { return __int_as_float(__builtin_amdgcn_ds_swizzle(__float_as_int(x), 0x401F)); }
__device__ __forceinline__ float rmax4(float x) { x = fmaxf(x, x16(x)); auto rr = __builtin_amdgcn_permlane32_swap(__float_as_uint(x), __float_as_uint(x), false, false); return fmaxf(__uint_as_float(rr[0]), __uint_as_float(rr[1])); }
__device__ __forceinline__ float rsum4(float x) { x = x + x16(x); auto rr = __builtin_amdgcn_permlane32_swap(__float_as_uint(x), __float_as_uint(x), false, false); return __uint_as_float(rr[0]) + __uint_as_float(rr[1]); }
__device__ __forceinline__ float tmax(const P8& p, int qt) { float m = p.t[qt][0][0];
#pragma unroll
    for (int kt = 0; kt < 4; ++kt)
#pragma unroll
        for (int r = 0; r < 4; ++r) m = fmaxf(m, p.t[qt][kt][r]);
    return m; }
__device__ __forceinline__ void qkt2(P8& p, const LAS unsigned char* Ks, const bf16x8 (&qf)[2][4], const LAS unsigned char* qrl, int l16, int g4, float seed0, float seed1) {
#pragma unroll
    for (int kt = 0; kt < 4; ++kt) { p.t[0][kt] = (f32x4){seed0, seed0, seed0, seed0}; p.t[1][kt] = (f32x4){seed1, seed1, seed1, seed1}; }
    const int swn = l16 << 4, swr = ((l16 >> 1) & 7) << 4;
#pragma unroll
    for (int ks = 0; ks < 4; ++ks) { const int cb = (32 * ks + 8 * g4) * 2;
#pragma unroll
        for (int kt = 0; kt < 4; ++kt) { const bf16x8 kf = *(const LAS bf16x8*)(Ks + (16 * kt + l16) * 256 + (cb ^ swn));
            p.t[0][kt] = mfma16(kf, qf[0][ks], p.t[0][kt]); p.t[1][kt] = mfma16(kf, qf[1][ks], p.t[1][kt]); } }
#pragma unroll
    for (int ks = 0; ks < 2; ++ks) { const int cb = (32 * ks + 8 * g4) * 2;
        const bf16x8 q0 = *(const LAS bf16x8*)(qrl + ks * 1024), q1 = *(const LAS bf16x8*)(qrl + (2 + ks) * 1024);
#pragma unroll
        for (int kt = 0; kt < 4; ++kt) { const bf16x8 kf = *(const LAS bf16x8*)(Ks + OFF_KR + (16 * kt + l16) * 128 + (cb ^ swr));
            p.t[0][kt] = mfma16(kf, q0, p.t[0][kt]); p.t[1][kt] = mfma16(kf, q1, p.t[1][kt]); } }
}
__device__ __forceinline__ void sub_all(P8& p, float d0, float d1) {
#pragma unroll
    for (int kt = 0; kt < 4; ++kt) { p.t[0][kt] = p.t[0][kt] - d0; p.t[1][kt] = p.t[1][kt] - d1; } }
__device__ __forceinline__ void exp_half(P8& p, int k0) {
#pragma unroll
    for (int qt = 0; qt < 2; ++qt)
#pragma unroll
        for (int kt = 0; kt < 2; ++kt)
#pragma unroll
            for (int r = 0; r < 4; ++r) p.t[qt][k0 + kt][r] = __builtin_amdgcn_exp2f(p.t[qt][k0 + kt][r]); }
__device__ __forceinline__ void partial2_first(P8& p, float& m0, float& m1, float& a0, float& a1) {
    m0 = rmax4(tmax(p, 0)); m1 = rmax4(tmax(p, 1)); a0 = 1.f; a1 = 1.f; sub_all(p, m0, m1); exp_half(p, 0); }
__device__ __forceinline__ void partial2(P8& p, float& m0, float& m1, float& a0, float& a1) {
    const float x0 = rmax4(tmax(p, 0)), x1 = rmax4(tmax(p, 1));
    if (__builtin_expect(__all(fmaxf(x0, x1) <= THRL), 1)) { a0 = 1.f; a1 = 1.f; }
    else { const float d0 = fmaxf(x0, 0.f), d1 = fmaxf(x1, 0.f); a0 = __builtin_amdgcn_exp2f(-d0); a1 = __builtin_amdgcn_exp2f(-d1); m0 += d0; m1 += d1; sub_all(p, d0, d1); }
    exp_half(p, 0); }
__device__ __forceinline__ void finish2(P8& p, float a0, float a1, float& l0, float& l1, bf16x8 (&pb)[2][2]) {
    exp_half(p, 2);
    float s0 = 0.f, s1 = 0.f;
#pragma unroll
    for (int kt = 0; kt < 4; ++kt)
#pragma unroll
        for (int r = 0; r < 4; ++r) { s0 += p.t[0][kt][r]; s1 += p.t[1][kt][r]; }
    l0 = l0 * a0 + rsum4(s0); l1 = l1 * a1 + rsum4(s1);
#pragma unroll
    for (int qt = 0; qt < 2; ++qt)
#pragma unroll
        for (int s2 = 0; s2 < 2; ++s2) { v4u w; w.x = cvtpk(p.t[qt][2 * s2][0], p.t[qt][2 * s2][1]); w.y = cvtpk(p.t[qt][2 * s2][2], p.t[qt][2 * s2][3]);
            w.z = cvtpk(p.t[qt][2 * s2 + 1][0], p.t[qt][2 * s2 + 1][1]); w.w = cvtpk(p.t[qt][2 * s2 + 1][2], p.t[qt][2 * s2 + 1][3]); pb[qt][s2] = __builtin_bit_cast(bf16x8, w); }
}
template <int B, int I> __device__ __forceinline__ void pv2_rd(const int (&vo)[8], s16x4& lo, s16x4& hi) { constexpr int s2 = I >> 3, vt = I & 7;
    lo = tr_read<B * SHM_V + s2 * 8192>(vo[vt]); hi = tr_read<B * SHM_V + s2 * 8192 + 4096>(vo[vt]); }
#define PV2_MM(I, L, H) do { const bf16x8 af_ = (bf16x8){L[0], L[1], L[2], L[3], H[0], H[1], H[2], H[3]}; \
    o[(I) & 7][0] = mfma16(af_, pb[0][(I) >> 3], o[(I) & 7][0]); o[(I) & 7][1] = mfma16(af_, pb[1][(I) >> 3], o[(I) & 7][1]); } while (0)
#define PV2_W(N) do { asm volatile("s_waitcnt lgkmcnt(" #N ")" ::: "memory"); SBAR(); } while (0)
template <int B> __device__ __forceinline__ void pv2(f32x4 (&o)[8][2], const int (&vo)[8], const bf16x8 (&pb)[2][2]) {
    s16x4 l0, h0, l1, h1, l2, h2;
    asm volatile("s_waitcnt lgkmcnt(0)" ::: "memory"); SBAR();
    pv2_rd<B, 0>(vo, l0, h0); pv2_rd<B, 1>(vo, l1, h1); pv2_rd<B, 2>(vo, l2, h2);
    PV2_W(4); PV2_MM(0, l0, h0); SBAR(); pv2_rd<B, 3>(vo, l0, h0);
    PV2_W(4); PV2_MM(1, l1, h1); SBAR(); pv2_rd<B, 4>(vo, l1, h1);
    PV2_W(4); PV2_MM(2, l2, h2); SBAR(); pv2_rd<B, 5>(vo, l2, h2);
    PV2_W(4); PV2_MM(3, l0, h0); SBAR(); pv2_rd<B, 6>(vo, l0, h0);
    PV2_W(4); PV2_MM(4, l1, h1); SBAR(); pv2_rd<B, 7>(vo, l1, h1);
    PV2_W(4); PV2_MM(5, l2, h2); SBAR(); pv2_rd<B, 8>(vo, l2, h2);
    PV2_W(4); PV2_MM(6, l0, h0); SBAR(); pv2_rd<B, 9>(vo, l0, h0);
    PV2_W(4); PV2_MM(7, l1, h1); SBAR(); pv2_rd<B, 10>(vo, l1, h1);
    PV2_W(4); PV2_MM(8, l2, h2); SBAR(); pv2_rd<B, 11>(vo, l2, h2);
    PV2_W(4); PV2_MM(9, l0, h0); SBAR(); pv2_rd<B, 12>(vo, l0, h0);
    PV2_W(4); PV2_MM(10, l1, h1); SBAR(); pv2_rd<B, 13>(vo, l1, h1);
    PV2_W(4); PV2_MM(11, l2, h2); SBAR(); pv2_rd<B, 14>(vo, l2, h2);
    PV2_W(4); PV2_MM(12, l0, h0); SBAR(); pv2_rd<B, 15>(vo, l0, h0);
    PV2_W(4); PV2_MM(13, l1, h1);
    PV2_W(2); PV2_MM(14, l2, h2);
    PV2_W(0); PV2_MM(15, l0, h0);
}
__device__ __forceinline__ void attn_unit2(const bf16* __restrict__ Q, const bf16* __restrict__ KN, const bf16* __restrict__ KR, const bf16* __restrict__ V, const bf16* __restrict__ G1, bf16* __restrict__ CC,
                                           int qrow0, int h, int nt_lat, int lat0, int ctx0, LAS unsigned char* lds) {
    int tid_l = threadIdx.x; asm volatile("" : "+v"(tid_l)); const int tid = tid_l, wid = __builtin_amdgcn_readfirstlane(tid >> 6), lane = tid & 63, l16 = lane & 15, g4 = lane >> 4;
    LAS unsigned char* V_lds = lds + OFF_V; LAS unsigned char* K_lds = lds + OFF_K;
    LAS unsigned char* qrl = lds + OFF_QR + wid * 4096 + lane * 16;
    float m0 = 0.f, m1 = 0.f, l0 = 0.f, l1 = 0.f;
    f32x4 o[8][2];
#pragma unroll
    for (int vt = 0; vt < 8; ++vt) { o[vt][0] = (f32x4){0.f, 0.f, 0.f, 0.f}; o[vt][1] = (f32x4){0.f, 0.f, 0.f, 0.f}; }
    const unsigned ko = (unsigned)((tid >> 4) * 128 + (((tid & 15) ^ ((tid >> 4) & 15)) * 8));
    const unsigned kro = (unsigned)((tid >> 3) * 64 + (((tid & 7) ^ ((tid >> 4) & 7)) * 8));
    const unsigned vo_g = (unsigned)((tid >> 4) * 128 + ((((((tid & 15) >> 1) ^ ((tid >> 4) & 7)) << 1) | (tid & 1)) * 8));
    int vo[8];
    { const int q = l16 >> 2, pp = l16 & 3, rr = 4 * g4 + q, sw = rr & 7, base = (int)(unsigned)(unsigned long long)lds + OFF_V + rr * 256 + 8 * pp;
#pragma unroll
      for (int vt = 0; vt < 8; ++vt) vo[vt] = base + ((vt ^ sw) << 5); }
    const int NT = nt_lat + 4;
#define TROW(jt) ((jt) < nt_lat ? lat0 + 64 * (jt) : ctx0 + 64 * ((jt) - nt_lat))
#define GLDS(gp, lp) __builtin_amdgcn_global_load_lds((const unsigned*)(gp), (LAS unsigned*)(lp), 16, 0, 0)
#define ISSUE_K(jt, b) do { const int R0_ = TROW(jt); const bf16* Kb_ = uni(KN + ((size_t)h * MTOT + R0_) * 128); const bf16* Rb_ = uni(KR + (size_t)R0_ * 64); \
    GLDS(Kb_ + ko, K_lds + (b) * SHM_K + wid * 1024); GLDS(Kb_ + ko + 32 * 128, K_lds + (b) * SHM_K + (wid + 8) * 1024); GLDS(Rb_ + kro, K_lds + (b) * SHM_K + OFF_KR + wid * 1024); } while (0)
#define ISSUE_V(jt, b) do { const int R0_ = TROW(jt); const bf16* Vb_ = uni(V + ((size_t)h * MTOT + R0_) * 128); \
    GLDS(Vb_ + vo_g, V_lds + (b) * SHM_V + wid * 1024); GLDS(Vb_ + vo_g + 32 * 128, V_lds + (b) * SHM_V + (wid + 8) * 1024); } while (0)
#define STEP_END() asm volatile("s_waitcnt vmcnt(0) lgkmcnt(0)\n\ts_barrier" ::: "memory")
#define RESC2(a0_, a1_) do { if (__any(fminf(a0_, a1_) < 1.f)) { _Pragma("unroll") for (int vt = 0; vt < 8; ++vt) { o[vt][0] = o[vt][0] * (a0_); o[vt][1] = o[vt][1] * (a1_); } } } while (0)
    STEP_END();
    ISSUE_K(0, 0);
    bf16x8 qf[2][4];
    { const bf16* Qw = uni(Q + (size_t)(qrow0 + wid * QBLK) * NQ + h * 192); const unsigned qo = (unsigned)(l16 * NQ + g4 * 8);
#pragma unroll
      for (int qt = 0; qt < 2; ++qt) {
#pragma unroll
        for (int ks = 0; ks < 4; ++ks) qf[qt][ks] = *(const bf16x8*)(Qw + qo + (unsigned)(qt * 16 * NQ + ks * 32));
#pragma unroll
        for (int ks = 4; ks < 6; ++ks) { const bf16x8 t = *(const bf16x8*)(Qw + qo + (unsigned)(qt * 16 * NQ + ks * 32)); *(LAS bf16x8*)(qrl + (qt * 2 + ks - 4) * 1024) = t; } } }
    P8 pA, pB; float aA0, aA1, aB0, aB1; bf16x8 pb[2][2];
    STEP_END();
    ISSUE_K(1, 1); ISSUE_V(0, 0);
    qkt2(pA, K_lds, qf, qrl, l16, g4, 0.f, 0.f); partial2_first(pA, m0, m1, aA0, aA1);
    STEP_END();
    for (int j = 1; j + 1 < NT; j += 2) {
        ISSUE_K(j + 1, 0); ISSUE_V(j, 1);
        SBAR(); qkt2(pB, K_lds + SHM_K, qf, qrl, l16, g4, -m0, -m1);
        finish2(pA, aA0, aA1, l0, l1, pb); SBAR();
        pv2<0>(o, vo, pb); partial2(pB, m0, m1, aB0, aB1);
        RESC2(aB0, aB1); STEP_END();
        ISSUE_K(j + 2, 1); ISSUE_V(j + 1, 0);
        SBAR(); qkt2(pA, K_lds, qf, qrl, l16, g4, -m0, -m1);
        finish2(pB, aB0, aB1, l0, l1, pb); SBAR();
        pv2<1>(o, vo, pb); partial2(pA, m0, m1, aA0, aA1);
        RESC2(aA0, aA1); STEP_END();
    }
    ISSUE_V(NT - 1, 1);
    SBAR(); qkt2(pB, K_lds + SHM_K, qf, qrl, l16, g4, -m0, -m1);
    finish2(pA, aA0, aA1, l0, l1, pb); SBAR();
    pv2<0>(o, vo, pb); partial2(pB, m0, m1, aB0, aB1);
    RESC2(aB0, aB1); STEP_END();
    finish2(pB, aB0, aB1, l0, l1, pb); SBAR();
    pv2<1>(o, vo, pb);
    STEP_END();
    { LAS unsigned char* mx = lds + wid * (32 * 272);
      const float r0 = __builtin_amdgcn_rcpf(l0), r1 = __builtin_amdgcn_rcpf(l1);
#pragma unroll
      for (int vt = 0; vt < 8; ++vt) { u32x2 w;
          w.x = cvtpk(o[vt][0][0] * r0, o[vt][0][1] * r0); w.y = cvtpk(o[vt][0][2] * r0, o[vt][0][3] * r0); *(LAS u32x2*)(mx + l16 * 272 + (16 * vt + 4 * g4) * 2) = w;
          w.x = cvtpk(o[vt][1][0] * r1, o[vt][1][1] * r1); w.y = cvtpk(o[vt][1][2] * r1, o[vt][1][3] * r1); *(LAS u32x2*)(mx + (16 + l16) * 272 + (16 * vt + 4 * g4) * 2) = w; }
      asm volatile("s_waitcnt lgkmcnt(0)" ::: "memory");
      const bf16* Gz = uni(G1 + (size_t)(qrow0 + wid * QBLK) * N_AB + G1_ZA + h * 128); bf16* Co = uni(CC + (size_t)(qrow0 + wid * QBLK) * MIXW + h * 128);
      int le = lane; asm volatile("" : "+v"(le));
#pragma unroll
      for (int i = 0; i < 8; ++i) { const int id = 64 * i + le, row = id >> 4, c8 = (id & 15) * 8;
          const v4u oq = *(const LAS v4u*)(mx + row * 272 + c8 * 2); const v4u zq = LDNT((const v4u*)(Gz + (unsigned)(row * N_AB + c8)));
          v4u wq;
#pragma unroll
          for (int e = 0; e < 4; ++e) wq[e] = cvtpk(bf_lo(oq[e]) * bf_lo(zq[e]), bf_hi(oq[e]) * bf_hi(zq[e]));
          *(v4u*)(Co + (unsigned)(row * MIXW + c8)) = wq;
          if ((i & 3) == 3) asm volatile("" ::: "memory"); } }
#undef TROW
#undef GLDS
#undef ISSUE_K
#undef ISSUE_V
#undef STEP_END
#undef RESC2
}
#undef PV2_MM
#undef PV2_W
}
#ifndef ATT_PRIO
#define ATT_PRIO 1
#endif
#ifndef ATT_BODY2
#define ATT_BODY2 0
#endif
__device__ __forceinline__ void attn_phase(KArgs a, LAS unsigned char* lds, int G) {
    const bf16* Q = (const bf16*)(a->ws + WS_Q); const bf16* KN = (const bf16*)(a->ws + WS_KN); const bf16* KR = (const bf16*)(a->ws + WS_KR); const bf16* V = (const bf16*)(a->ws + WS_V);
    const bf16* G1 = (const bf16*)(a->ws + WS_G1); bf16* CC = (bf16*)(a->ws + WS_CC);
    const int bx = blockIdx.x; const int vcu = (G % 8 == 0) ? (bx % 8) * (G / 8) + bx / 8 : bx;
    if (ATT_PRIO && __builtin_amdgcn_readfirstlane(threadIdx.x >> 6) >= 4) __builtin_amdgcn_s_setprio(1);
    for (int u = vcu; u < 2048 + 64; u += G) {
        if (u < 2048) { const int bh = u >> 5, qb = u & 31, b = bh >> 5, h = bh & 31;
            if (ATT_BODY2) att2::attn_unit2(Q, KN, KR, V, G1, CC, b * SEQ + qb * 256, h, 128, b * SEQ, MLAT + b * NCTX, lds); else att::attn_unit(Q, KN, KR, V, G1, CC, b * SEQ + qb * 256, h, 128, b * SEQ, MLAT + b * NCTX, lds); }
        else { const int bh = u - 2048, b = bh >> 5, h = bh & 31;
            if (ATT_BODY2) att2::attn_unit2(Q, KN, KR, V, G1, CC, MLAT + b * NCTX, h, 0, 0, MLAT + b * NCTX, lds); else att::attn_unit(Q, KN, KR, V, G1, CC, MLAT + b * NCTX, h, 0, 0, MLAT + b * NCTX, lds); }
    }
    if (ATT_PRIO) __builtin_amdgcn_s_setprio(0);
    __syncthreads();
}

__device__ __forceinline__ s16x4 tr_read_v(int addr) { s16x4 r; asm volatile("ds_read_b64_tr_b16 %0, %1" : "=&v"(r) : "v"(addr) : "memory"); return r; }
template <int CTRL> __device__ __forceinline__ float dpp_f(float x) { return __int_as_float(__builtin_amdgcn_update_dpp(0, __float_as_int(x), CTRL, 0xf, 0xf, true)); }
constexpr int SC_PITCH = 288;
constexpr int SC_QD = 0, SC_KD = 16 * SC_PITCH, SC_KE = 32 * SC_PITCH, SC_VV = 48 * SC_PITCH, SC_EB = 64 * SC_PITCH, SC_BUF = SC_EB + 512;
constexpr int SC_OST = 2 * SC_BUF;
__device__ __forceinline__ void scan_stage(LAS unsigned char* B, u32x2 rq, u32x2 rk, u32x2 rv, int wid, int lane, int tid) {
    const int t = lane & 15, kq = lane >> 4;
    float q[4], kk[4], x[4], tot[4];
    q[0] = bf_lo(rq.x); q[1] = bf_hi(rq.x); q[2] = bf_lo(rq.y); q[3] = bf_hi(rq.y); kk[0] = bf_lo(rk.x); kk[1] = bf_hi(rk.x); kk[2] = bf_lo(rk.y); kk[3] = bf_hi(rk.y);
#pragma unroll
    for (int e = 0; e < 4; ++e) { float g = __builtin_amdgcn_logf(fmaxf(1.0f - kk[e], 1e-30f)); float s = g;
        g += dpp_f<0x111>(g); g += dpp_f<0x112>(g); g += dpp_f<0x114>(g); g += dpp_f<0x118>(g);
        s += dpp_f<0x128>(s); s += dpp_f<0x124>(s); s += dpp_f<0x122>(s); s += dpp_f<0x121>(s);
        x[e] = g; tot[e] = s; }
    float qd[4], kd[4], ke[4];
#pragma unroll
    for (int e = 0; e < 4; ++e) { qd[e] = q[e] * __builtin_amdgcn_exp2f(x[e]); kd[e] = kk[e] * __builtin_amdgcn_exp2f(fminf(-x[e], 115.0f)); ke[e] = kk[e] * __builtin_amdgcn_exp2f(fminf(tot[e] - x[e], 0.0f)); }
    const int ppos = 32 * (wid >> 1) + 8 * kq + 4 * (wid & 1);
    u32x2 w;
    w.x = cvtpk(qd[0], qd[1]); w.y = cvtpk(qd[2], qd[3]); *(LAS u32x2*)(B + SC_QD + t * SC_PITCH + ppos * 2) = w;
    w.x = cvtpk(kd[0], kd[1]); w.y = cvtpk(kd[2], kd[3]); *(LAS u32x2*)(B + SC_KD + t * SC_PITCH + ppos * 2) = w;
    w.x = cvtpk(ke[0], ke[1]); w.y = cvtpk(ke[2], ke[3]); *(LAS u32x2*)(B + SC_KE + t * SC_PITCH + (16 * wid + 4 * kq) * 2) = w;
    if (t == 0) *(LAS f32x4*)(B + SC_EB + (16 * wid + 4 * kq) * 4) = (f32x4){__builtin_amdgcn_exp2f(tot[0]), __builtin_amdgcn_exp2f(tot[1]), __builtin_amdgcn_exp2f(tot[2]), __builtin_amdgcn_exp2f(tot[3])};
    *(LAS u32x2*)(B + SC_VV + (tid >> 5) * SC_PITCH + (tid & 31) * 8) = rv;
}
__device__ __forceinline__ void scan_phase(KArgs a, LAS unsigned char* lds, int G) {
    int tid_l = threadIdx.x; asm volatile("" : "+v"(tid_l)); const int tid = tid_l, lane = tid & 63, wid = __builtin_amdgcn_readfirstlane(tid >> 6), g4 = lane >> 4, l16 = lane & 15;
    const bf16* G1 = (const bf16*)(a->ws + WS_G1); const size_t TS = (size_t)MTOT * MIXW;
    const int ldsb = (int)(unsigned)(unsigned long long)lds;
    const int trq = l16 >> 2, trp = l16 & 3;
    const int st = lane & 15, sk = 16 * wid + 4 * (lane >> 4);
    const int vt_ = tid >> 5, vc = (tid & 31) * 4;
    for (int sq = blockIdx.x; sq < 256; sq += G) {
        const int dir = sq >> 7, b = (sq >> 6) & 1, h = sq & 63;
        const bf16* Tq = G1 + h * 128; const bf16* Tk = G1 + (size_t)(1 + dir) * TS + h * 128; const bf16* Tv = G1 + (size_t)3 * TS + h * 128;
        bf16* Od = (bf16*)(a->ws + WS_OF) + (size_t)dir * TS + h * 128;
        const unsigned oq = (unsigned)((dir ? 15 - st : st) * MIXW + sk), ovv = (unsigned)((dir ? 15 - vt_ : vt_) * MIXW + vc);
#define CLOW(c_) ((c_) < 16 ? MLAT + b * NCTX + (dir ? 240 - 16 * (c_) : 16 * (c_)) : b * SEQ + (dir ? 8432 - 16 * (c_) : 16 * (c_) - 256))
#define SLOADC(c_) do { const size_t lo_ = (size_t)CLOW(c_) * MIXW; rq = LDNT((const u32x2*)(uni(Tq + lo_) + oq)); rk = LDNT((const u32x2*)(uni(Tk + lo_) + oq)); rv = LDNT((const u32x2*)(uni(Tv + lo_) + ovv)); } while (0)
#define SBARRIER() do { asm volatile("s_waitcnt lgkmcnt(0)" ::: "memory"); __builtin_amdgcn_s_barrier(); asm volatile("" ::: "memory"); } while (0)
        f32x4 S[8];
#pragma unroll
        for (int i = 0; i < 8; ++i) S[i] = (f32x4){0.f, 0.f, 0.f, 0.f};
        u32x2 rq, rk, rv;
        SBARRIER();
        SLOADC(0); scan_stage(lds, rq, rk, rv, wid, lane, tid); SLOADC(1);
        SBARRIER();
        for (int c = 0; c < 528; ++c) {
            LAS unsigned char* Bc = lds + (c & 1) * SC_BUF;
            if (c > 0) { const u32x2 ov = *(const LAS u32x2*)(lds + SC_OST + ((c - 1) & 1) * 4096 + vt_ * 256 + vc * 2); *(u32x2*)(uni(Od + (size_t)CLOW(c - 1) * MIXW) + ovv) = ov; }
            if (c + 1 < 528) { scan_stage(lds + ((c + 1) & 1) * SC_BUF, rq, rk, rv, wid, lane, tid); if (c + 2 < 528) SLOADC(c + 2); }
            bf16x8 qf[4], kf[4]; f32x4 e4[8]; s16x4 kt4[8];
#pragma unroll
            for (int ks = 0; ks < 4; ++ks) { qf[ks] = *(const LAS bf16x8*)(Bc + SC_QD + l16 * SC_PITCH + (32 * ks + 8 * g4) * 2); kf[ks] = *(const LAS bf16x8*)(Bc + SC_KD + l16 * SC_PITCH + (32 * ks + 8 * g4) * 2); }
            const int trb = ldsb + (c & 1) * SC_BUF + (4 * g4 + trq) * SC_PITCH + 8 * trp;
            const s16x4 vt = tr_read_v(trb + SC_VV + 32 * wid);
#pragma unroll
            for (int kt = 0; kt < 8; ++kt) { e4[kt] = *(const LAS f32x4*)(Bc + SC_EB + (16 * kt + 4 * g4) * 4); kt4[kt] = tr_read_v(trb + SC_KE + 32 * kt); }
            f32x4 at = (f32x4){0.f, 0.f, 0.f, 0.f};
#pragma unroll
            for (int ks = 0; ks < 4; ++ks) at = mfma16(kf[ks], qf[ks], at);
#pragma unroll
            for (int r = 0; r < 4; ++r) at[r] = (4 * g4 + r <= l16) ? at[r] : 0.f;
            bf16x8 pa; { v4u w; w.x = cvtpk(at[0], at[1]); w.y = cvtpk(at[2], at[3]); w.z = 0u; w.w = 0u; pa = __builtin_bit_cast(bf16x8, w); }
            f32x4 o = (f32x4){0.f, 0.f, 0.f, 0.f};
#pragma unroll
            for (int ks = 0; ks < 4; ++ks) { v4u w; w.x = cvtpk(S[2 * ks][0], S[2 * ks][1]); w.y = cvtpk(S[2 * ks][2], S[2 * ks][3]); w.z = cvtpk(S[2 * ks + 1][0], S[2 * ks + 1][1]); w.w = cvtpk(S[2 * ks + 1][2], S[2 * ks + 1][3]);
                o = mfma16(qf[ks], __builtin_bit_cast(bf16x8, w), o); }
            asm volatile("s_waitcnt lgkmcnt(0)" ::: "memory"); SBAR();
            const bf16x8 vf = (bf16x8){vt[0], vt[1], vt[2], vt[3], 0, 0, 0, 0};
            o = mfma16(pa, vf, o);
#pragma unroll
            for (int kt = 0; kt < 8; ++kt) { const bf16x8 kef = (bf16x8){kt4[kt][0], kt4[kt][1], kt4[kt][2], kt4[kt][3], 0, 0, 0, 0};
                S[kt] = mfma16(kef, vf, S[kt] * e4[kt]); }
            { LAS bf16* ost = (LAS bf16*)(lds + SC_OST + (c & 1) * 4096);
#pragma unroll
              for (int r = 0; r < 4; ++r) ost[(4 * g4 + r) * 128 + 16 * wid + l16] = (bf16)(cvtpk(o[r], 0.f) & 0xffffu); }
            SBARRIER();
        }
        { const u32x2 ov = *(const LAS u32x2*)(lds + SC_OST + (527 & 1) * 4096 + vt_ * 256 + vc * 2); *(u32x2*)(uni(Od + (size_t)CLOW(527) * MIXW) + ovv) = ov; }
#undef CLOW
#undef SLOADC
#undef SBARRIER
    }
    asm volatile("s_waitcnt lgkmcnt(0)" ::: "memory"); __builtin_amdgcn_s_barrier(); asm volatile("" ::: "memory");
}

__device__ __forceinline__ void readout_phase(KArgs a, int jc, int nrows, int G) {
    int tid_l = threadIdx.x; asm volatile("" : "+v"(tid_l)); const int tid = tid_l, lane = tid & 63, wave = __builtin_amdgcn_readfirstlane(tid >> 6);
    const int gw = blockIdx.x * NWAVES + wave, NGW = G * NWAVES;
    const size_t TS = (size_t)MTOT * MIXW;
    const bf16* OFp = (const bf16*)(a->ws + WS_OF); const bf16* OBp = OFp + TS; const bf16* GS = (const bf16*)(a->ws + WS_G1) + 4 * TS; bf16* CC = (bf16*)(a->ws + WS_CC);
    const float* gnw = a->in[20] + (size_t)jc * 128 + (lane & 15) * 8;
    const f32x4 w0 = *(const f32x4*)gnw, w1 = *(const f32x4*)(gnw + 4);
    for (int it = gw; it < nrows * 16; it += NGW) {
        const size_t off = (size_t)(it >> 4) * MIXW + (it & 15) * 512 + lane * 8;
        const v4u f = LDNT((const v4u*)(OFp + off)), bq = LDNT((const v4u*)(OBp + off)), gq = LDNT((const v4u*)(GS + off));
        float o[8], gg[8];
#pragma unroll
        for (int e = 0; e < 4; ++e) { o[2 * e] = bf_lo(f[e]) + bf_lo(bq[e]); o[2 * e + 1] = bf_hi(f[e]) + bf_hi(bq[e]); gg[2 * e] = bf_lo(gq[e]); gg[2 * e + 1] = bf_hi(gq[e]); }
        float ss = 0.f;
#pragma unroll
        for (int e = 0; e < 8; ++e) ss += o[e] * o[e];
        ss += __shfl_xor(ss, 1); ss += __shfl_xor(ss, 2); ss += __shfl_xor(ss, 4); ss += __shfl_xor(ss, 8);
        const float r = 1.0f / sqrtf(ss * (1.0f / 128.0f) + EPS);
        v4u w; w.x = cvtpk(o[0] * r * w0[0] * gg[0], o[1] * r * w0[1] * gg[1]); w.y = cvtpk(o[2] * r * w0[2] * gg[2], o[3] * r * w0[3] * gg[3]);
        w.z = cvtpk(o[4] * r * w1[0] * gg[4], o[5] * r * w1[1] * gg[5]); w.w = cvtpk(o[6] * r * w1[2] * gg[6], o[7] * r * w1[3] * gg[7]);
        *(v4u*)(CC + off) = w;
    }
}

#ifndef EN_P0
#define EN_P0 1
#endif
#ifndef EN_NORM
#define EN_NORM 1
#endif
#ifndef EN_A1
#define EN_A1 1
#endif
#ifndef EN_A2
#define EN_A2 1
#endif
#ifndef EN_A3
#define EN_A3 1
#endif
#ifndef EN_ATT
#define EN_ATT 1
#endif
#ifndef EN_A5
#define EN_A5 1
#endif
#ifndef EN_C1
#define EN_C1 1
#endif
#ifndef EN_SCAN
#define EN_SCAN 1
#endif
#ifndef EN_RO
#define EN_RO 1
#endif
#ifndef EN_C4
#define EN_C4 1
#endif
#ifndef EN_SGU
#define EN_SGU 1
#endif
#ifndef EN_QUP
#define EN_QUP 1
#endif
#ifndef EN_KVUP
#define EN_KVUP 1
#endif
#ifndef PG8_ALIGNV
#define PG8_ALIGNV true
#endif
#ifndef PG8_SP2V
#define PG8_SP2V true
#endif
#ifndef PROBE_MASK
#define PROBE_MASK 0u
#endif
#define REPS(k) for (int rep_ = 0; rep_ < ((((PROBE_MASK) >> (k)) & 1u) ? 2 : 1); ++rep_)
#ifndef MK_ONE_LAUNCH
#define MK_ONE_LAUNCH 1
#endif
constexpr int N_PHASES = 28;
#define IN(k) (lo <= (k) && (k) < hi)
#define SEAM(k) do { if (IN(k) && IN((k) + 1)) xcd_barrier(bar); } while (0)
template <int p> __device__ __forceinline__ void layer_pair(LAS unsigned char* lds, const int G, const int lo, const int hi, const XcdBarrier& bar) {

        const int pb = 2 + 13 * p, lab = 2 * p, lc = 2 * p + 1;
        if (EN_A1 && IN(pb + 0)) REPS(pb + 0) {
            KArgs A = kargs(); unsigned char* const wsb = A->ws;
            pg8::Gemm g{(const pg8::bf16_t*)(wsb + WS_H), (const pg8::bf16_t*)(wsb + WS_WIN_AB) + (size_t)p * N_AB * DM, MTOT, N_AB, DM, DM}; pg8::LockstepOrder S; S.init(MTOT, N_AB, G, (int)blockIdx.x);
            pg8::EpiAB1 E{(pg8::bf16_t*)(wsb + WS_G1), N_AB};
            pg8::gemm_phase<pg8::EpiAB1, pg8::LockstepOrder, PG8_ALIGNV, PG8_SP2V>(lds, g, S, E);
            if (p0_defer_on(G)) { pg8::LockstepOrder S2; S2.init(MTOT, N_AB, G, (int)blockIdx.x); p0_deferred(kargs(), lds, S2, p == 0 ? 0 : 2); }
        } SEAM(pb + 0);
        if (EN_A2 && IN(pb + 1)) REPS(pb + 1) { a2_rows(kargs(), p, G); } SEAM(pb + 1);
        if (EN_SGU && IN(pb + 2)) REPS(pb + 2) { sgu_phase(kargs(), p, lds, G); }
        if (EN_QUP && IN(pb + 3)) REPS(pb + 3) {
            KArgs A = kargs(); unsigned char* const wsb = A->ws;
            pg8::Gemm g{(const pg8::bf16_t*)(wsb + WS_QN), (const pg8::bf16_t*)(wsb + WS_WQ) + (size_t)p * NQ * QL, MTOT, NQ, QL, QL}; pg8::LockstepOrder S; S.init(MTOT, NQ, G, (int)blockIdx.x);
            pg8::EpiQ E{(pg8::bf16_t*)(wsb + WS_Q), (const pg8::f32x2*)(wsb + WS_ROPE), MLAT, 0.07216878364870322f * 1.4426950408889634f};
            pg8::gemm_phase<pg8::EpiQ, pg8::LockstepOrder, PG8_ALIGNV, PG8_SP2V>(lds, g, S, E);
        }
        if (EN_KVUP && IN(pb + 4)) REPS(pb + 4) {
            KArgs A = kargs(); unsigned char* const wsb = A->ws;
            pg8::Gemm g{(const pg8::bf16_t*)(wsb + WS_KVN), (const pg8::bf16_t*)(wsb + WS_WKV) + (size_t)p * NKV * KVL, MTOT, NKV, KVL, KVL}; pg8::LockstepOrder S; S.init(MTOT, NKV, G, (int)((blockIdx.x + 64u) % (unsigned)G));
            pg8::EpiKV E{(pg8::bf16_t*)(wsb + WS_KN), (pg8::bf16_t*)(wsb + WS_V), MTOT};
            pg8::gemm_phase<pg8::EpiKV, pg8::LockstepOrder, PG8_ALIGNV, PG8_SP2V>(lds, g, S, E);
        } SEAM(pb + 4);
        if (EN_ATT && IN(pb + 5)) REPS(pb + 5) { attn_phase(kargs(), lds, G); } SEAM(pb + 5);
        if (EN_A5 && IN(pb + 6)) REPS(pb + 6) {
            KArgs A = kargs(); unsigned char* const wsb = A->ws;
            { pg8::Gemm g{(const pg8::bf16_t*)(wsb + WS_CC), (const pg8::bf16_t*)(wsb + WS_WO_AB) + (size_t)p * DM * MIXW, MLAT, DM, MIXW, MIXW}; pg8::LockstepOrder S; S.init(MLAT, DM, G, (int)blockIdx.x);
              pg8::EpiBf16P E{(pg8::bf16_t*)(wsb + WS_Y), DM};
              pg8::gemm_phase<pg8::EpiBf16P, pg8::LockstepOrder, PG8_ALIGNV, PG8_SP2V>(lds, g, S, E); }
            { pg8::Gemm g{(const pg8::bf16_t*)(wsb + WS_CC) + (size_t)MLAT * MIXW, (const pg8::bf16_t*)(wsb + WS_WO_AB) + (size_t)p * DM * MIXW, MTOT - MLAT, DM, MIXW / 8, MIXW}; pg8::SplitKOrder S; S.init(MTOT - MLAT, DM, 8, G, (int)blockIdx.x);
              pg8::EpiF32 E{(float*)(wsb + WS_YP), DM, (size_t)(MTOT - MLAT) * DM};
              pg8::gemm_phase<pg8::EpiF32, pg8::SplitKOrder, PG8_ALIGNV, PG8_SP2V>(lds, g, S, E); }
        } SEAM(pb + 6);
        if (EN_NORM && IN(pb + 7)) REPS(pb + 7) { norm_phase(kargs(), lab, lc, G); } SEAM(pb + 7);
        if (EN_C1 && IN(pb + 8)) REPS(pb + 8) {
            KArgs A = kargs(); unsigned char* const wsb = A->ws;
            pg8::Gemm g{(const pg8::bf16_t*)(wsb + WS_H), (const pg8::bf16_t*)(wsb + WS_WIN_C) + (size_t)p * N_C * DM, MTOT, N_C, DM, DM}; pg8::LockstepOrder S; S.init(MTOT, N_C, G, (int)blockIdx.x);
            pg8::EpiC1 E{(pg8::bf16_t*)(wsb + WS_G1), (size_t)MTOT * MIXW, (const float*)(wsb + WS_OML) + (size_t)p * 2 * 8192};
            pg8::gemm_phase<pg8::EpiC1, pg8::LockstepOrder, PG8_ALIGNV, PG8_SP2V>(lds, g, S, E);
            if (p0_defer_on(G)) { pg8::LockstepOrder S2; S2.init(MTOT, N_C, G, (int)blockIdx.x); p0_deferred(kargs(), lds, S2, p == 0 ? 1 : 3); }
        } SEAM(pb + 8);
        if (EN_SCAN && IN(pb + 9)) REPS(pb + 9) { scan_phase(kargs(), lds, G); } SEAM(pb + 9);
        if (EN_RO && IN(pb + 10)) REPS(pb + 10) { readout_phase(kargs(), p, lc == 3 ? MLAT : MTOT, G); } SEAM(pb + 10);
        if (EN_C4 && IN(pb + 11)) REPS(pb + 11) {
            KArgs A = kargs(); unsigned char* const wsb = A->ws;
            { pg8::Gemm g{(const pg8::bf16_t*)(wsb + WS_CC), (const pg8::bf16_t*)(wsb + WS_WO_C) + (size_t)p * DM * MIXW, MLAT, DM, MIXW, MIXW}; pg8::LockstepOrder S; S.init(MLAT, DM, G, (int)blockIdx.x);
              pg8::EpiBf16P E{(pg8::bf16_t*)(wsb + WS_Y), DM};
              pg8::gemm_phase<pg8::EpiBf16P, pg8::LockstepOrder, PG8_ALIGNV, PG8_SP2V>(lds, g, S, E); }
            if (lc != 3) { pg8::Gemm g{(const pg8::bf16_t*)(wsb + WS_CC) + (size_t)MLAT * MIXW, (const pg8::bf16_t*)(wsb + WS_WO_C) + (size_t)p * DM * MIXW, MTOT - MLAT, DM, MIXW / 8, MIXW}; pg8::SplitKOrder S; S.init(MTOT - MLAT, DM, 8, G, (int)blockIdx.x);
              pg8::EpiF32 E{(float*)(wsb + WS_YP), DM, (size_t)(MTOT - MLAT) * DM};
              pg8::gemm_phase<pg8::EpiF32, pg8::SplitKOrder, PG8_ALIGNV, PG8_SP2V>(lds, g, S, E); }
        } SEAM(pb + 11);
        if (EN_NORM && IN(pb + 12)) REPS(pb + 12) { norm_phase(kargs(), lc, lc + 1, G); } SEAM(pb + 12);
    }
#undef IN
#undef SEAM
__global__ void __launch_bounds__(NWAVES * 64, 2) fwd(Args a) {
    extern __shared__ __attribute__((aligned(16))) unsigned char lds_raw[];
    LAS unsigned char* lds = (LAS unsigned char*)lds_raw;
    int tid_l = threadIdx.x; asm volatile("" : "+v"(tid_l)); const int tid = tid_l, G = gridDim.x;
    for (int u = tid; u < (LDS_BYTES - LDSCTL_OFF) / 4; u += NWAVES * 64) ((LAS unsigned*)(lds + LDSCTL_OFF))[u] = 0u;
    __syncthreads();
    XcdBarrier bar; bar.bar = (unsigned*)(a.ws + WS_CTL) + CW_BAR; bar.x = 0; bar.st = nullptr;
    if (MK_ONE_LAUNCH) bar = xcd_barrier_post((unsigned*)(a.ws + WS_CTL) + CW_BAR, (volatile LAS unsigned*)(lds + MISC_OFF));
    const int lo = a.ph_lo, hi = a.ph_hi;
#define IN(k) (lo <= (k) && (k) < hi)
#define SEAM(k) do { if (IN(k) && IN((k) + 1)) xcd_barrier(bar); } while (0)
    if (EN_P0 && IN(0)) REPS(0) { p0_prologue(kargs(), lds, G); } SEAM(0);
    if (EN_NORM && IN(1)) REPS(1) { norm_phase(kargs(), -1, 0, G); } SEAM(1);
    layer_pair<0>(lds, G, lo, hi, bar);
    layer_pair<1>(lds, G, lo, hi, bar);
#undef IN
#undef SEAM
}

extern "C" void kernel_launch(void* const* d_in, const int* in_sizes, int n_in, void* d_out, int out_size, void* d_ws, size_t ws_size, hipStream_t stream) {
    static int grid = 0;
    if (grid == 0) {
        if (n_in != 22 || out_size != MLAT * DM || ws_size < WS_END) { fprintf(stderr, "kernel_launch: unexpected shapes (n_in %d, out %d, ws %zu, need %zu)\n", n_in, out_size, ws_size, (size_t)WS_END); grid = -1; return; }
        int dev = 0, cus = 0, per_cu = 0;
        if (hipGetDevice(&dev) != hipSuccess || hipDeviceGetAttribute(&cus, hipDeviceAttributeMultiprocessorCount, dev) != hipSuccess) { grid = -1; return; }
        if (hipFuncSetAttribute((const void*)fwd, hipFuncAttributeMaxDynamicSharedMemorySize, LDS_BYTES) != hipSuccess) { fprintf(stderr, "kernel_launch: hipFuncSetAttribute failed\n"); grid = -1; return; }
        if (hipOccupancyMaxActiveBlocksPerMultiprocessor(&per_cu, (const void*)fwd, NWAVES * 64, LDS_BYTES) != hipSuccess || per_cu < 1) fprintf(stderr, "kernel_launch: occupancy query reports %d\n", per_cu);
        (void)hipGetLastError();
        grid = cus;
    }
    if (grid < 0) return;
    (void)hipMemsetAsync((char*)d_ws + WS_CTL, 0, 65536, stream);
    Args a{};
    for (int i = 0; i < 22; ++i) a.in[i] = (const float*)d_in[i];
    a.out = (float*)d_out; a.ws = (unsigned char*)d_ws;
#if MK_ONE_LAUNCH
    a.ph_lo = 0; a.ph_hi = N_PHASES;
    hipLaunchKernelGGL(fwd, dim3(grid), dim3(NWAVES * 64), LDS_BYTES, stream, a);
#else
    for (int p = 0; p < N_PHASES; ++p) { a.ph_lo = p; a.ph_hi = p + 1; hipLaunchKernelGGL(fwd, dim3(grid), dim3(NWAVES * 64), LDS_BYTES, stream, a); }
#endif
}
```

```cpp
#include <hip/hip_runtime.h>
#include <cstdio>
#include <cstdint>
namespace pg8 {
#define PG8_LAS __attribute__((address_space(3)))
typedef unsigned short bf16_t;
typedef short bf16x8 __attribute__((ext_vector_type(8)));
typedef float f32x4 __attribute__((ext_vector_type(4)));
typedef unsigned u32x4 __attribute__((ext_vector_type(4)));
constexpr int BM = 256, BK = 64, HALF = 128, HTB = HALF * BK * 2  , STAGE_BYTES = 8 * HTB, NXCD = 8, WGM = 4;

__host__ __device__ __forceinline__ int lds_byte(int r, int c) { const int st = (r >> 4) * 2 + (c >> 5), rr = r & 15, cc = c & 31, ob = rr * 64 + cc * 2; return st * 1024 + (ob ^ (((ob >> 9) & 1) << 5)); }
__host__ __device__ __forceinline__ void stage_rc(int b, int& R, int& C) { const int st = b / 1024, sb = b % 1024, swz = sb ^ (((sb >> 9) & 1) << 5); R = (st >> 1) * 16 + swz / 64; C = (st & 1) * 32 + (swz % 64) / 2; }
__host__ __device__ __forceinline__ int perm32(int rho) { const int n = rho >> 4, i = rho & 15; return 8 * (i >> 2) + 4 * n + (i & 3); }

struct Unit { int pm, pn, kc; };
struct Gemm { const bf16_t* A; const bf16_t* Bt; int M, N, K, ld; };

struct StaticOrder {
    int nM, nN, nwg, G, c;
    __host__ __device__ void init(int M, int N, int G_, int c_) { nM = M / BM; nN = N / BM; nwg = nM * nN; G = G_; c = c_; }
    __host__ __device__ bool next(int i, Unit& u) const {
        const long L = (long)i * G + c; if (L >= nwg) return false;
        int wgid = (int)L; { const int q = nwg / NXCD, r = nwg % NXCD, xcd = wgid % NXCD, off = wgid / NXCD; wgid = (xcd < r ? xcd * (q + 1) : r * (q + 1) + (xcd - r) * q) + off; }
        const int nig = WGM * nN, gid = wgid / nig, fm = gid * WGM, gsz = (nM - fm) < WGM ? (nM - fm) : WGM;
        u.pm = fm + ((wgid % nig) % gsz); u.pn = (wgid % nig) / gsz; u.kc = 0; return true;
    }
    __device__ __forceinline__ void a_ready(const Unit&) const {}
    __device__ __forceinline__ void done(const Unit&) const {}
};
struct LockstepOrder {
    static constexpr int LW = 4;
    int nM, nN, G, c, x, k, nk, PG, r0, gR, qR, rR, lenx;
    __host__ __device__ void init(int M, int N, int G_, int c_) { nM = M / BM; nN = N / BM; G = G_; c = c_; x = c_ % NXCD; k = c_ / NXCD; nk = G_ / NXCD; PG = (nM / LW) / NXCD; r0 = PG * NXCD * LW; gR = nM - r0;
        const int rem = gR * nN; qR = rem / NXCD; rR = rem % NXCD; lenx = PG * LW * nN + qR + (x < rR ? 1 : 0); }
    __host__ __device__ bool next(int i, Unit& u) const {
        if (G % NXCD != 0) { const long L = (long)i * G + c; if (L >= (long)nM * nN) return false; u.kc = 0; u.pm = (int)(L / nN); u.pn = (int)(L % nN); return true; }
        const int off = i * nk + k; if (off >= lenx) return false; u.kc = 0;
        const int lock = PG * LW * nN;
        if (off < lock) { const int j = off / (LW * nN), o2 = off % (LW * nN); u.pm = (j * NXCD + x) * LW + o2 % LW; u.pn = o2 / LW; }
        else { const int rho = (x < rR ? x * (qR + 1) : rR * (qR + 1) + (x - rR) * qR) + (off - lock); u.pm = r0 + rho % gR; u.pn = rho / gR; }
        return true;
    }
    __device__ __forceinline__ void a_ready(const Unit&) const {}
    __device__ __forceinline__ void done(const Unit&) const {}
};
struct SplitKOrder {
    int nM, nN, KS, nwg, G, c;
    __host__ __device__ void init(int M, int N, int KS_, int G_, int c_) { nM = M / BM; nN = N / BM; KS = KS_; nwg = nM * nN * KS; G = G_; c = c_; }
    __host__ __device__ bool next(int i, Unit& u) const { const long L = (long)i * G + c; if (L >= nwg) return false; const int l = (int)L; u.kc = l % KS; u.pn = (l / KS) % nN; u.pm = l / (KS * nN); return true; }
    __device__ __forceinline__ void a_ready(const Unit&) const {}
    __device__ __forceinline__ void done(const Unit&) const {}
};

typedef float f32x2 __attribute__((ext_vector_type(2)));
typedef __bf16 bf16x2_c __attribute__((ext_vector_type(2)));
__device__ __forceinline__ unsigned cvt_pk_bf16(float lo, float hi) { const f32x2 v = {lo, hi}; const bf16x2_c b = __builtin_convertvector(v, bf16x2_c); return __builtin_bit_cast(unsigned, b); }
__device__ __forceinline__ f32x2 gelu_pk(f32x2 v) {
    const f32x2 av = __builtin_elementwise_abs(v), d = av * 0.2316418882f + 1.0f;
    f32x2 t; t.x = __builtin_amdgcn_rcpf(d.x); t.y = __builtin_amdgcn_rcpf(d.y);
    f32x2 q = t * 0.5307027145f + (-0.7265760135f); q = q * t + 0.7107068705f; q = q * t + (-0.142248368f); q = q * t + 0.127414796f; q = q * t;
    const f32x2 s = (v * v) * (-0.72134752044f);
    f32x2 e; e.x = __builtin_amdgcn_exp2f(s.x); e.y = __builtin_amdgcn_exp2f(s.y);
    const f32x2 m = v * (q * e), r = v - m;
    f32x2 o; o.x = v.x < 0.f ? m.x : r.x; o.y = v.y < 0.f ? m.y : r.y; return o;
}

typedef unsigned u32x2 __attribute__((ext_vector_type(2)));
__device__ __forceinline__ float silu_f(float x) { return x * __builtin_amdgcn_rcpf(1.0f + __builtin_amdgcn_exp2f(-1.4426950408889634f * x)); }
__device__ __forceinline__ float sigmoid_neg_f(float x) { return __builtin_amdgcn_rcpf(1.0f + __builtin_amdgcn_exp2f(1.4426950408889634f * x)); }
__device__ __forceinline__ f32x4 act4(f32x4 v, int act) {
    if (act == 1) { v[0] = silu_f(v[0]); v[1] = silu_f(v[1]); v[2] = silu_f(v[2]); v[3] = silu_f(v[3]); }
    else if (act == 2) { const f32x2 a = gelu_pk((f32x2){v[0], v[1]}), b = gelu_pk((f32x2){v[2], v[3]}); v = (f32x4){a.x, a.y, b.x, b.y}; }
    return v;
}
struct EpiF32 {
    static constexpr bool PERM = false, AFTER_DRAIN = false;
    float* C0; int ldc; size_t kstride;
    __device__ __forceinline__ void operator()(const f32x4 (&acc)[2][2][4][2], const Unit& u, int wr, int wc, int fr, int fq) const {
        float* C = C0 + (size_t)u.kc * kstride;
        const int row0 = u.pm * BM + wr * 64 + fr, col0 = u.pn * BM + wc * 32 + 4 * fq;
#pragma unroll
        for (int ai = 0; ai < 2; ++ai)
#pragma unroll
            for (int m = 0; m < 4; ++m) { float* rowp = C + (size_t)(row0 + ai * HALF + m * 16) * ldc + col0;
#pragma unroll
                for (int bj = 0; bj < 2; ++bj)
#pragma unroll
                    for (int n = 0; n < 2; ++n) *(f32x4*)(rowp + bj * HALF + n * 16) = acc[ai][bj][m][n]; }
    }
};
struct EpiBf16P {
    static constexpr bool PERM = true, AFTER_DRAIN = false;
    bf16_t* O; int ldc;
    __device__ __forceinline__ void operator()(const f32x4 (&acc)[2][2][4][2], const Unit& u, int wr, int wc, int fr, int fq) const {
        const int row0 = u.pm * BM + wr * 64 + fr, col0 = u.pn * BM + wc * 32 + 8 * fq;
#pragma unroll
        for (int ai = 0; ai < 2; ++ai)
#pragma unroll
            for (int m = 0; m < 4; ++m) { bf16_t* rowp = O + (size_t)(row0 + ai * HALF + m * 16) * ldc + col0;
#pragma unroll
                for (int bj = 0; bj < 2; ++bj) { const f32x4 v0 = acc[ai][bj][m][0], v1 = acc[ai][bj][m][1];
                    u32x4 w; w.x = cvt_pk_bf16(v0[0], v0[1]); w.y = cvt_pk_bf16(v0[2], v0[3]); w.z = cvt_pk_bf16(v1[0], v1[1]); w.w = cvt_pk_bf16(v1[2], v1[3]);
                    *(u32x4*)(rowp + bj * HALF) = w; } }
    }
};
struct EpiAB1 {
    static constexpr bool PERM = true, AFTER_DRAIN = false;
    bf16_t* O; int ldc;
    __device__ __forceinline__ void operator()(const f32x4 (&acc)[2][2][4][2], const Unit& u, int wr, int wc, int fr, int fq) const {
        const int act = u.pn < 7 ? 0 : ((u.pn < 23 || u.pn >= 55) ? 1 : 2);
        const int row0 = u.pm * BM + wr * 64 + fr, col0 = u.pn * BM + wc * 32 + 8 * fq;
#pragma unroll
        for (int ai = 0; ai < 2; ++ai)
#pragma unroll
            for (int m = 0; m < 4; ++m) { bf16_t* rowp = O + (size_t)(row0 + ai * HALF + m * 16) * ldc + col0;
#pragma unroll
                for (int bj = 0; bj < 2; ++bj) { const f32x4 v0 = act4(acc[ai][bj][m][0], act), v1 = act4(acc[ai][bj][m][1], act);
                    u32x4 w; w.x = cvt_pk_bf16(v0[0], v0[1]); w.y = cvt_pk_bf16(v0[2], v0[3]); w.z = cvt_pk_bf16(v1[0], v1[1]); w.w = cvt_pk_bf16(v1[2], v1[3]);
                    *(u32x4*)(rowp + bj * HALF) = w; } }
    }
};
struct EpiC1 {
    static constexpr bool PERM = true, AFTER_DRAIN = false;
    bf16_t* O; size_t stride; const float* oml;
    __device__ __forceinline__ void operator()(const f32x4 (&acc)[2][2][4][2], const Unit& u, int wr, int wc, int fr, int fq) const {
        const int region = u.pn >> 5; bf16_t* base = O + (size_t)region * stride;
        const int row0 = u.pm * BM + wr * 64 + fr, col0 = (u.pn & 31) * BM + wc * 32 + 8 * fq;
        const bool gate = (region == 1 || region == 2); const int act = (region == 0 || region == 4) ? 1 : 0;
        f32x4 gv[2][2];
#pragma unroll
        for (int bj = 0; bj < 2; ++bj)
#pragma unroll
            for (int n = 0; n < 2; ++n) gv[bj][n] = gate ? *(const f32x4*)(oml + (size_t)(region - 1) * 8192 + col0 + bj * HALF + 4 * n) : (f32x4){1.f, 1.f, 1.f, 1.f};
#pragma unroll
        for (int ai = 0; ai < 2; ++ai)
#pragma unroll
            for (int m = 0; m < 4; ++m) { bf16_t* rowp = base + (size_t)(row0 + ai * HALF + m * 16) * 8192 + col0;
#pragma unroll
                for (int bj = 0; bj < 2; ++bj) { f32x4 v0 = acc[ai][bj][m][0], v1 = acc[ai][bj][m][1];
                    if (gate) {
#pragma unroll
                        for (int j = 0; j < 4; ++j) { v0[j] = gv[bj][0][j] * sigmoid_neg_f(v0[j]); v1[j] = gv[bj][1][j] * sigmoid_neg_f(v1[j]); } }
                    else { v0 = act4(v0, act); v1 = act4(v1, act); }
                    u32x4 w; w.x = cvt_pk_bf16(v0[0], v0[1]); w.y = cvt_pk_bf16(v0[2], v0[3]); w.z = cvt_pk_bf16(v1[0], v1[1]); w.w = cvt_pk_bf16(v1[2], v1[3]);
                    *(u32x4*)(rowp + bj * HALF) = w; } }
    }
};
struct EpiQ {
    static constexpr bool PERM = true, AFTER_DRAIN = false;
    bf16_t* O; const f32x2* rope; int nlat; float qscale;
    __device__ __forceinline__ void operator()(const f32x4 (&acc)[2][2][4][2], const Unit& u, int wr, int wc, int fr, int fq) const {
        const int row0 = u.pm * BM + wr * 64 + fr; const bool upper = fq >= 2;
#pragma unroll
        for (int bj = 0; bj < 2; ++bj) {
            const int G = 8 * u.pn + 4 * bj + wc, hm = G % 6, col = u.pn * BM + bj * HALF + wc * 32 + 8 * fq;
#pragma unroll
            for (int ai = 0; ai < 2; ++ai)
#pragma unroll
                for (int m = 0; m < 4; ++m) { const int row = row0 + ai * HALF + m * 16; f32x4 x0 = acc[ai][bj][m][0], x1 = acc[ai][bj][m][1];
                    if (hm >= 4 && u.pm * BM < nlat) {
                        const int t = row & 8191, pos = (hm == 4) ? (t >> 6) : (t & 63); const f32x2* cs = rope + pos * 16 + 8 * (fq & 1);
#pragma unroll
                        for (int j = 0; j < 4; ++j) {
                            { auto rr = __builtin_amdgcn_permlane32_swap(__float_as_uint(x0[j]), __float_as_uint(x0[j]), false, false); const float pv = __uint_as_float(upper ? rr[0] : rr[1]); const f32x2 c = cs[j];
                              x0[j] = upper ? x0[j] * c.x + pv * c.y : x0[j] * c.x - pv * c.y; }
                            { auto rr = __builtin_amdgcn_permlane32_swap(__float_as_uint(x1[j]), __float_as_uint(x1[j]), false, false); const float pv = __uint_as_float(upper ? rr[0] : rr[1]); const f32x2 c = cs[4 + j];
                              x1[j] = upper ? x1[j] * c.x + pv * c.y : x1[j] * c.x - pv * c.y; } } }
                    x0 = x0 * qscale; x1 = x1 * qscale;
                    u32x4 w; w.x = cvt_pk_bf16(x0[0], x0[1]); w.y = cvt_pk_bf16(x0[2], x0[3]); w.z = cvt_pk_bf16(x1[0], x1[1]); w.w = cvt_pk_bf16(x1[2], x1[3]);
                    *(u32x4*)(O + (size_t)row * 6144 + col) = w; }
        }
    }
};
struct EpiKV {
    static constexpr bool PERM = true, AFTER_DRAIN = false;
    bf16_t* KN; bf16_t* V; int mtot;
    __device__ __forceinline__ void operator()(const f32x4 (&acc)[2][2][4][2], const Unit& u, int wr, int wc, int fr, int fq) const {
        const int row0 = u.pm * BM + wr * 64 + fr, colh = wc * 32 + 8 * fq;
#pragma unroll
        for (int ai = 0; ai < 2; ++ai)
#pragma unroll
            for (int m = 0; m < 4; ++m) { const size_t off = ((size_t)u.pn * mtot + (size_t)(row0 + ai * HALF + m * 16)) * 128 + colh;
#pragma unroll
                for (int bj = 0; bj < 2; ++bj) { const f32x4 v0 = acc[ai][bj][m][0], v1 = acc[ai][bj][m][1];
                    u32x4 w; w.x = cvt_pk_bf16(v0[0], v0[1]); w.y = cvt_pk_bf16(v0[2], v0[3]); w.z = cvt_pk_bf16(v1[0], v1[1]); w.w = cvt_pk_bf16(v1[2], v1[3]);
                    *(u32x4*)((bj ? V : KN) + off) = w; } }
    }
};

template <class Epi, class Sched, bool ALIGN_EPI = false, bool SP2 = false>
__device__ __forceinline__ void gemm_phase(PG8_LAS unsigned char* lds, const Gemm g, const Sched& S, const Epi& E) {
    int tid_l = threadIdx.x; asm volatile("" : "+v"(tid_l)); const int tid = tid_l, wid = __builtin_amdgcn_readfirstlane(tid >> 6), lane = tid & 63, wr = wid >> 2, wc = wid & 3, fr = lane & 15, fq = lane >> 4;
    const int K = g.ld, nt = g.K / BK;
    unsigned voffA[2], voffB[2];
#pragma unroll
    for (int i = 0; i < 2; ++i) { int R, C; stage_rc(tid * 16 + i * 8192, R, C); const int Rb = Epi::PERM ? ((R & ~31) + perm32(R & 31)) : R;
        voffA[i] = (unsigned)(R * K + C) * 2u; voffB[i] = (unsigned)(Rb * K + C) * 2u; }
    const size_t kstep = (size_t)(BK * 2);
    const size_t hstep = (size_t)HALF * K * 2;
    const size_t tstep = 2 * hstep;
    const unsigned ldsw = (unsigned)wid * 1024u;
    const int aoff = lds_byte(wr * 64 + fr, fq * 8), boff = lds_byte(wc * 32 + fr, fq * 8);
#define PG8_SA(b, h) (((b) * 2 + (h)) * HTB)
#define PG8_SB(b, h) ((4 + (b) * 2 + (h)) * HTB)
#define PG8_STAGE(bufoff, gbase, voff) do { const char* gb_ = (const char*)(gbase); asm volatile("" : "+s"(gb_)); _Pragma("unroll") for (int _i = 0; _i < 2; ++_i) { unsigned vo_ = (voff)[_i]; asm volatile("" : "+v"(vo_)); \
        __builtin_amdgcn_global_load_lds((const unsigned*)(gb_ + vo_), (PG8_LAS unsigned*)(lds + (bufoff) + ldsw + _i * 8192), 16, 0, 0); } } while (0)
#define PG8_LDA(dst, b, h) do { _Pragma("unroll") for (int m = 0; m < 4; ++m) _Pragma("unroll") for (int k = 0; k < 2; ++k) dst[m][k] = *(const PG8_LAS bf16x8*)(lds + PG8_SA(b, h) + aoff + m * 2048 + k * 1024); } while (0)
#define PG8_LDB(dst, b, h) do { _Pragma("unroll") for (int n = 0; n < 2; ++n) _Pragma("unroll") for (int k = 0; k < 2; ++k) dst[n][k] = *(const PG8_LAS bf16x8*)(lds + PG8_SB(b, h) + boff + n * 2048 + k * 1024); } while (0)
#define PG8_MMA(ai, bj, At, Bt) do { __builtin_amdgcn_sched_barrier(0); _Pragma("unroll") for (int m = 0; m < 4; ++m) _Pragma("unroll") for (int n = 0; n < 2; ++n) _Pragma("unroll") for (int k = 0; k < 2; ++k) \
        acc[ai][bj][m][n] = __builtin_amdgcn_mfma_f32_16x16x32_bf16(Bt[n][k], At[m][k], acc[ai][bj][m][n], 0, 0, 0); __builtin_amdgcn_sched_barrier(0); } while (0)
#define PG8_WAIT_V(n) asm volatile("s_waitcnt vmcnt(" #n ")" ::: "memory")
#define PG8_WAIT_L(n) asm volatile("s_waitcnt lgkmcnt(" #n ")" ::: "memory")
#define PG8_BAR __builtin_amdgcn_s_barrier()
#define PG8_SCHED __builtin_amdgcn_sched_barrier(0)
    if (wr == 0) __builtin_amdgcn_s_setprio(1);
    Unit cur, nxt; int ui = 0;
    if (!S.next(0, cur)) { __builtin_amdgcn_s_setprio(0); return; }
    f32x4 acc[2][2][4][2];
#pragma unroll
    for (int a = 0; a < 2; ++a)
#pragma unroll
        for (int b = 0; b < 2; ++b)
#pragma unroll
            for (int m = 0; m < 4; ++m)
#pragma unroll
                for (int n = 0; n < 2; ++n) acc[a][b][m][n] = (f32x4){0.f, 0.f, 0.f, 0.f};
    bf16x8 At[4][2], B0[2][2], B1[2][2];
    const size_t kcb = (size_t)g.K * 2;
    const char* cA = (const char*)g.A + (size_t)cur.pm * tstep + cur.kc * kcb; const char* cB = (const char*)g.Bt + (size_t)cur.pn * tstep + cur.kc * kcb;
    S.a_ready(cur);
    if constexpr (SP2) {
        PG8_STAGE(PG8_SB(0, 0), cB, voffB); PG8_STAGE(PG8_SB(0, 1), cB + hstep, voffB); PG8_STAGE(PG8_SA(0, 0), cA, voffA); PG8_STAGE(PG8_SA(0, 1), cA + hstep, voffA);
        if (wr == 1) PG8_BAR;
        PG8_WAIT_V(2); PG8_BAR;
        PG8_STAGE(PG8_SB(1, 0), cB + kstep, voffB); PG8_STAGE(PG8_SA(1, 0), cA + kstep, voffA); PG8_STAGE(PG8_SB(1, 1), cB + hstep + kstep, voffB);
        PG8_WAIT_V(6); PG8_BAR;
    } else {
        PG8_STAGE(PG8_SB(0, 0), cB, voffB); PG8_STAGE(PG8_SA(0, 0), cA, voffA); PG8_STAGE(PG8_SB(0, 1), cB + hstep, voffB); PG8_STAGE(PG8_SA(0, 1), cA + hstep, voffA);
        if (wr == 1) PG8_BAR;
        PG8_WAIT_V(4); PG8_BAR;
        PG8_STAGE(PG8_SB(1, 0), cB + kstep, voffB); PG8_STAGE(PG8_SA(1, 0), cA + kstep, voffA); PG8_STAGE(PG8_SB(1, 1), cB + hstep + kstep, voffB);
        PG8_WAIT_V(6); PG8_BAR;
    }
    for (;;) {
        const bool has_next = S.next(ui + 1, nxt);
        const char* nA = has_next ? (const char*)g.A + (size_t)nxt.pm * tstep + nxt.kc * kcb : cA; const char* nB = has_next ? (const char*)g.Bt + (size_t)nxt.pn * tstep + nxt.kc * kcb : cB;
        for (int t = 0; t < nt; t += 2) {
            const bool last = (t == nt - 2);
            const char* a1 = cA + (size_t)(t + 1) * kstep;
            const char* a2 = last ? nA : cA + (size_t)(t + 2) * kstep; const char* b2 = last ? nB : cB + (size_t)(t + 2) * kstep;
            const char* a3 = a2 + kstep; const char* b3 = b2 + kstep;
            if (last && has_next) S.a_ready(nxt);
            if constexpr (SP2) {
            PG8_LDB(B0, 0, 0); PG8_LDB(B1, 0, 1); PG8_SCHED; PG8_LDA(At, 0, 0); PG8_STAGE(PG8_SA(1, 1), a1 + hstep, voffA);
            PG8_WAIT_V(8); PG8_WAIT_L(0); PG8_BAR; PG8_MMA(0, 0, At, B0); PG8_MMA(0, 1, At, B1); PG8_BAR; PG8_SCHED;
            PG8_LDA(At, 0, 1); PG8_STAGE(PG8_SB(0, 0), b2, voffB); PG8_STAGE(PG8_SB(0, 1), b2 + hstep, voffB); PG8_STAGE(PG8_SA(0, 0), a2, voffA);
            PG8_WAIT_V(8); PG8_WAIT_L(0); PG8_BAR; PG8_MMA(1, 0, At, B0); PG8_MMA(1, 1, At, B1); PG8_BAR; PG8_SCHED;
            PG8_LDB(B0, 1, 0); PG8_LDB(B1, 1, 1); PG8_SCHED; PG8_LDA(At, 1, 0); PG8_STAGE(PG8_SA(0, 1), a2 + hstep, voffA);
            PG8_WAIT_V(8); PG8_WAIT_L(0); PG8_BAR; PG8_MMA(0, 0, At, B0); PG8_MMA(0, 1, At, B1); PG8_BAR; PG8_SCHED;
            PG8_LDA(At, 1, 1); PG8_STAGE(PG8_SB(1, 0), b3, voffB); PG8_STAGE(PG8_SB(1, 1), b3 + hstep, voffB); PG8_STAGE(PG8_SA(1, 0), a3, voffA);
            PG8_WAIT_V(8); PG8_WAIT_L(0); PG8_BAR; PG8_MMA(1, 0, At, B0); PG8_MMA(1, 1, At, B1); PG8_BAR; PG8_SCHED;
            } else {
            PG8_LDB(B0, 0, 0); PG8_SCHED; PG8_LDA(At, 0, 0); PG8_STAGE(PG8_SA(1, 1), a1 + hstep, voffA);
            PG8_WAIT_L(8); PG8_BAR; PG8_WAIT_L(0); PG8_MMA(0, 0, At, B0); PG8_BAR; PG8_SCHED;
            PG8_LDB(B1, 0, 1); PG8_STAGE(PG8_SB(0, 0), b2, voffB);
            PG8_BAR; PG8_WAIT_L(0); PG8_MMA(0, 1, At, B1); PG8_BAR;
            PG8_LDA(At, 0, 1); PG8_STAGE(PG8_SA(0, 0), a2, voffA);
            PG8_BAR; PG8_WAIT_L(0); PG8_MMA(1, 0, At, B0); PG8_BAR; PG8_SCHED;
            PG8_STAGE(PG8_SB(0, 1), b2 + hstep, voffB);
            PG8_WAIT_V(6); PG8_BAR; PG8_MMA(1, 1, At, B1); PG8_BAR;
            PG8_LDB(B0, 1, 0); PG8_SCHED; PG8_LDA(At, 1, 0); PG8_STAGE(PG8_SA(0, 1), a2 + hstep, voffA);
            PG8_WAIT_L(8); PG8_BAR; PG8_WAIT_L(0); PG8_MMA(0, 0, At, B0); PG8_BAR; PG8_SCHED;
            PG8_LDB(B1, 1, 1); PG8_STAGE(PG8_SB(1, 0), b3, voffB);
            PG8_BAR; PG8_WAIT_L(0); PG8_MMA(0, 1, At, B1); PG8_BAR;
            PG8_LDA(At, 1, 1); PG8_STAGE(PG8_SA(1, 0), a3, voffA);
            PG8_BAR; PG8_WAIT_L(0); PG8_MMA(1, 0, At, B0); PG8_BAR; PG8_SCHED;
            PG8_STAGE(PG8_SB(1, 1), b3 + hstep, voffB);
            PG8_WAIT_V(6); PG8_BAR; PG8_MMA(1, 1, At, B1); PG8_BAR;
            }
        }
        if constexpr (ALIGN_EPI) { if (wr == 0) PG8_BAR; }
        if constexpr (!Epi::AFTER_DRAIN) { E(acc, cur, wr, wc, fr, fq); S.done(cur); }
        if (!has_next) break;
#pragma unroll
        for (int a = 0; a < 2; ++a)
#pragma unroll
            for (int b = 0; b < 2; ++b)
#pragma unroll
                for (int m = 0; m < 4; ++m)
#pragma unroll
                    for (int n = 0; n < 2; ++n) acc[a][b][m][n] = (f32x4){0.f, 0.f, 0.f, 0.f};
        cur = nxt; cA = nA; cB = nB; ++ui;
        if constexpr (ALIGN_EPI) { if (wr == 1) PG8_BAR; }
    }
    PG8_WAIT_V(0);
    if constexpr (!ALIGN_EPI) { if (wr == 0) PG8_BAR; }
    PG8_BAR;
    if constexpr (Epi::AFTER_DRAIN) { E.fused(acc, cur, wr, wc, fr, fq, lds, wid, lane); S.done(cur); }
    __builtin_amdgcn_s_setprio(0);
#undef PG8_SA
#undef PG8_SB
#undef PG8_STAGE
#undef PG8_LDA
#undef PG8_LDB
#undef PG8_MMA
#undef PG8_WAIT_V
#undef PG8_WAIT_L
#undef PG8_BAR
#undef PG8_SCHED
}
}
#define GAS __attribute__((address_space(1)))
#define LAS __attribute__((address_space(3)))
typedef unsigned short bf16;
typedef unsigned v4u __attribute__((ext_vector_type(4)));
typedef float f32x4 __attribute__((ext_vector_type(4)));
typedef short bf16x8 __attribute__((ext_vector_type(8)));
typedef GAS unsigned gu32;
typedef GAS unsigned long long gu64;
#define RLX_AGENT __ATOMIC_RELAXED, __HIP_MEMORY_SCOPE_AGENT
#define LDS_WAIT() asm volatile("s_waitcnt lgkmcnt(0)" ::: "memory")
#define VM_WAIT() asm volatile("s_waitcnt vmcnt(0)" ::: "memory")
__device__ __forceinline__ unsigned long long rt() { return __builtin_amdgcn_s_memrealtime(); }
__device__ __forceinline__ unsigned f2bf(float f) { unsigned u = __builtin_bit_cast(unsigned, f); return (u + 0x7fffu + ((u >> 16) & 1u)) >> 16; }
__device__ __forceinline__ unsigned pk2(float lo, float hi) { return f2bf(lo) | (f2bf(hi) << 16); }

typedef unsigned u32x2 __attribute__((ext_vector_type(2)));
typedef float f32x2 __attribute__((ext_vector_type(2)));
#define XB_TMO      128
#define XB_XCNT(j)  (256  + 64 * (j))
#define XB_XSUB(j)  (1280 + 64 * (j))
#define XB_XGEN(j)  (2304 + 64 * (j))
#define XB_TOP      3328
#define XB_TOPGEN   3392
#define XCD_BAR_WORDS 3456
#define XB_SPIN_CAP (1u << 21)

__device__ __forceinline__ unsigned xb_ld(unsigned* p)              { return __hip_atomic_load(p, __ATOMIC_RELAXED, __HIP_MEMORY_SCOPE_AGENT); }
__device__ __forceinline__ unsigned xb_add(unsigned* p, unsigned v) { return __hip_atomic_fetch_add(p, v, __ATOMIC_RELAXED, __HIP_MEMORY_SCOPE_AGENT); }
__device__ __forceinline__ unsigned xb_xcc_id() { return (unsigned)__builtin_amdgcn_s_getreg((3 << 11) | 20) & 0xFu; }
#define XB_SPIN(cond, bar) do { unsigned _sp = 0; while (cond) { __builtin_amdgcn_s_sleep(1); \
    if ((++_sp & 255u) == 0u) { if (xb_ld(&(bar)[XB_TMO])) break; if (_sp > XB_SPIN_CAP) { atomicAdd(&(bar)[XB_TMO], 1u); break; } } } } while (0)

struct XcdBarrier {
    unsigned* bar; unsigned x;
    volatile LAS unsigned* st;
};

__device__ __forceinline__ XcdBarrier xcd_barrier_post(unsigned* bar, volatile LAS unsigned* st) {
    XcdBarrier b; b.bar = bar; b.x = xb_xcc_id(); b.st = st;
    if (threadIdx.x == 0) (void)xb_add(&bar[XB_XCNT(b.x)], 1u);
    return b;
}
__device__ __forceinline__ void xcd_barrier_complete(unsigned* bar, unsigned x, unsigned& nloc, unsigned& nx) {
    const unsigned G = gridDim.x * gridDim.y * gridDim.z;
    unsigned sum, cnt, mine, sp = 0u;
    for (;;) {
        sum = 0u; cnt = 0u; mine = 0u;
#pragma unroll
        for (unsigned j = 0; j < 16; ++j) { const unsigned c = xb_ld(&bar[XB_XCNT(j)]); sum += c; cnt += (c > 0u) ? 1u : 0u; mine = (j == x) ? c : mine; }
        if (sum == G) break;
        __builtin_amdgcn_s_sleep(1);
        if ((++sp & 255u) == 0u) { if (xb_ld(&bar[XB_TMO])) break; if (sp > XB_SPIN_CAP) { atomicAdd(&bar[XB_TMO], 1u); break; } }
    }
    nloc = mine > 0u ? mine : 1u; nx = cnt > 0u ? cnt : 1u;
}

__device__ __forceinline__ void xcd_barrier(const XcdBarrier& b) {
    asm volatile("s_waitcnt vmcnt(0)" ::: "memory");
    __syncthreads();
    if (threadIdx.x == 0) {
        unsigned* bar = b.bar;
        __builtin_amdgcn_s_waitcnt(0);
        unsigned nloc = b.st[0], nx = b.st[1];
        if (nloc == 0u) { xcd_barrier_complete(bar, b.x, nloc, nx); b.st[0] = nloc; b.st[1] = nx; }
        const unsigned old = xb_add(&bar[XB_XSUB(b.x)], 1u);
        const unsigned gen = old / nloc;
        if (old + 1u == (gen + 1u) * nloc) {
            __builtin_amdgcn_fence(__ATOMIC_RELEASE, "agent");
            asm volatile("s_waitcnt vmcnt(0)" ::: "memory");
            const unsigned og = xb_add(&bar[XB_TOP], 1u);
            const unsigned tg = og / nx;
            if (og + 1u == (tg + 1u) * nx) xb_add(&bar[XB_TOPGEN], 1u);
            else XB_SPIN(xb_ld(&bar[XB_TOPGEN]) == tg, bar);
            __builtin_amdgcn_fence(__ATOMIC_ACQUIRE, "agent");
            xb_add(&bar[XB_XGEN(b.x)], 1u);
            asm volatile("s_waitcnt vmcnt(0)" ::: "memory");
        } else {
            XB_SPIN(xb_ld(&bar[XB_XGEN(b.x)]) == gen, bar);
            __builtin_amdgcn_fence(__ATOMIC_ACQUIRE, "agent");
            asm volatile("s_waitcnt vmcnt(0)" ::: "memory");
        }
    }
    __syncthreads();
}


#ifndef NT_STREAMS
#define NT_STREAMS 1
#endif
#if NT_STREAMS
#define LDNT(p) __builtin_nontemporal_load(p)
#define STNT(p, v) __builtin_nontemporal_store((v), (p))
#else
#define LDNT(p) (*(p))
#define STNT(p, v) (*(p) = (v))
#endif
constexpr int NWAVES = 8;
constexpr int DM = 4096, NBATCH = 2, SEQ = 8192, NCTX = 256;
constexpr int MLAT = NBATCH * SEQ;
constexpr int MTOT = MLAT + NBATCH * NCTX;
constexpr int N_AB = 18176;
constexpr int N_ABSRC = 17984, N_C = 40960, MIXW = 8192;
constexpr int QL = 1024, KVL = 512, NQ = 6144, NKV = 8192;
constexpr int G1_CKV = 1024, G1_KR = 1536, G1_ZA = 1792, G1_UB = 5888, G1_VB = 9984, G1_ZB = 14080;
constexpr float EPS = 1e-6f;

constexpr size_t al256(size_t x) { return (x + 255) & ~(size_t)255; }
constexpr size_t WS_CTL = 0, CTL_ZERO_BYTES = 1u << 20;
constexpr size_t WS_MOD  = CTL_ZERO_BYTES;
constexpr size_t WS_OML  = WS_MOD  + al256((size_t)4 * 3 * 12288 * 4);
constexpr size_t WS_ROPE = WS_OML  + al256((size_t)2 * 2 * 8192 * 4);
constexpr size_t WS_STAT = WS_ROPE + al256((size_t)128 * 16 * 8);
constexpr size_t WS_WIN_AB = WS_STAT + al256((size_t)MTOT * 8);
constexpr size_t WS_WIN_C  = WS_WIN_AB + (size_t)2 * N_AB * DM * 2;
constexpr size_t WS_WO_AB  = WS_WIN_C + (size_t)2 * N_C * DM * 2;
constexpr size_t WS_WO_C   = WS_WO_AB + (size_t)2 * DM * MIXW * 2;
constexpr size_t WS_WQ     = WS_WO_C + (size_t)2 * DM * MIXW * 2;
constexpr size_t WS_WKV    = WS_WQ + (size_t)2 * NQ * QL * 2;
constexpr size_t WS_XS     = WS_WKV + (size_t)2 * NKV * KVL * 2;
constexpr size_t WS_H      = WS_XS + (size_t)MTOT * DM * 4;
constexpr size_t WS_Y      = WS_H + (size_t)MTOT * DM * 2;
constexpr size_t WS_G1     = WS_Y + (size_t)MTOT * DM * 4;
constexpr size_t WS_QN     = WS_G1 + (size_t)5 * MTOT * MIXW * 2;
constexpr size_t WS_KVN    = WS_QN + (size_t)MTOT * QL * 2;
constexpr size_t WS_KR     = WS_KVN + (size_t)MTOT * KVL * 2;
constexpr size_t WS_Q      = WS_KR + (size_t)MTOT * 64 * 2;
constexpr size_t WS_KN     = WS_Q + (size_t)MTOT * NQ * 2;
constexpr size_t WS_V      = WS_KN + (size_t)MTOT * DM * 2;
constexpr size_t WS_CC     = WS_V + (size_t)MTOT * DM * 2;
constexpr size_t WS_OF     = WS_CC + (size_t)MTOT * MIXW * 2;
constexpr size_t WS_YP     = WS_OF + (size_t)2 * MTOT * MIXW * 2;
constexpr size_t WS_END    = WS_YP + (size_t)8 * (MTOT - MLAT) * DM * 4;
constexpr int CW_BAR = 4096;

constexpr int RING_BYTES = 135168;
constexpr int LDSCTL_OFF = RING_BYTES, MISC_OFF = LDSCTL_OFF + 64;
constexpr int LDS_BYTES = 147456;

struct Args { const float* in[22]; float* out; unsigned char* ws; int ph_lo, ph_hi; };
typedef const __attribute__((address_space(4))) Args* KArgs;
__device__ __forceinline__ KArgs kargs() { KArgs ap = (KArgs)__builtin_amdgcn_kernarg_segment_ptr(); asm volatile("" : "+s"(ap)); return ap; }

template <class T> __device__ __forceinline__ T* uni(T* p) {
    const unsigned long long v = (unsigned long long)p; const unsigned lo = __builtin_amdgcn_readfirstlane((unsigned)v), hi = __builtin_amdgcn_readfirstlane((unsigned)(v >> 32));
    return (T*)(((unsigned long long)hi << 32) | lo); }
__device__ __forceinline__ float wave_sum(float v) {
#pragma unroll
    for (int o = 1; o < 64; o <<= 1) v += __shfl_xor(v, o);
    return v;
}
__device__ __forceinline__ float bf_lo(unsigned w) { return __uint_as_float(w << 16); }
__device__ __forceinline__ float bf_hi(unsigned w) { return __uint_as_float(w & 0xffff0000u); }
typedef __bf16 bf16x2_t __attribute__((ext_vector_type(2)));
__device__ __forceinline__ unsigned cvtpk(float lo, float hi) { const f32x2 v = {lo, hi}; const bf16x2_t b = __builtin_convertvector(v, bf16x2_t); return __builtin_bit_cast(unsigned, b); }
__device__ __forceinline__ float silu_acc(float x) { return x / (1.0f + __expf(-x)); }

__device__ __forceinline__ void p0_gemv(KArgs a, LAS unsigned char* lds, int G) {
    int tid_l = threadIdx.x; asm volatile("" : "+v"(tid_l)); const int tid = tid_l, lane = tid & 63, wave = __builtin_amdgcn_readfirstlane(tid >> 6);
    LAS float* sc = (LAS float*)lds;
    LAS float* red = (LAS float*)(lds + 49152);
    const float* c = a->in[1]; const float* cctx = a->in[3]; const float* w_ada = a->in[4]; const float* b_ada = a->in[5];
    float* mod = (float*)(a->ws + WS_MOD);
    for (int i = tid; i < 3 * 4096; i += 512) { const int r = i >> 12, k = i & 4095; const float cv = r < 2 ? c[r * 4096 + k] : cctx[k]; sc[i] = silu_acc(cv); }
    __syncthreads();
    const int kr = lane >> 4, c4 = lane & 15;
    for (int item = blockIdx.x; item < 768; item += G) {
        const int l = item / 192, cg = item % 192;
        const float* W = w_ada + (size_t)l * 4096 * 12288 + cg * 64 + c4 * 4;
        float acc[3][4];
#pragma unroll
        for (int r = 0; r < 3; ++r)
#pragma unroll
            for (int j = 0; j < 4; ++j) acc[r][j] = 0.f;
        const int k0 = wave * 512 + kr;
#pragma unroll 8
        for (int i = 0; i < 128; ++i) { const int k = k0 + 4 * i; const f32x4 w = LDNT((const f32x4*)(W + (size_t)k * 12288));
            const float s0 = sc[k], s1 = sc[4096 + k], s2 = sc[8192 + k];
#pragma unroll
            for (int j = 0; j < 4; ++j) { acc[0][j] += s0 * w[j]; acc[1][j] += s1 * w[j]; acc[2][j] += s2 * w[j]; } }
#pragma unroll
        for (int r = 0; r < 3; ++r)
#pragma unroll
            for (int j = 0; j < 4; ++j) { float v = acc[r][j]; v += __shfl_xor(v, 16); v += __shfl_xor(v, 32); acc[r][j] = v; }
        if (lane < 16) {
#pragma unroll
            for (int r = 0; r < 3; ++r)
#pragma unroll
                for (int j = 0; j < 4; ++j) red[(wave * 3 + r) * 64 + lane * 4 + j] = acc[r][j]; }
        __syncthreads();
        if (tid < 192) { const int r = tid >> 6, cc = tid & 63; float s = 0.f;
#pragma unroll
            for (int w = 0; w < 8; ++w) s += red[(w * 3 + r) * 64 + cc];
            const int col = cg * 64 + cc; mod[(size_t)(l * 3 + r) * 12288 + col] = s + b_ada[l * 12288 + col]; }
        __syncthreads();
    }
}
__device__ __forceinline__ void p0_tr_item(const float* W, int N, int K, bf16* WT, int n0s, int n0d, int k0, LAS float* scr, int lane) {
    const int kr = lane >> 4, c4 = lane & 15;
    const float* Wb = uni(W + (size_t)k0 * N + n0s); const unsigned lo = (unsigned)(kr * N + 4 * c4);
    f32x4 w[16];
#pragma unroll
    for (int i = 0; i < 16; ++i) w[i] = LDNT((const f32x4*)(Wb + lo + (unsigned)(4 * i * N)));
#pragma unroll
    for (int i = 0; i < 16; ++i) { const int k = 4 * i + kr;
        scr[(4 * c4 + 0) * 65 + k] = w[i][0]; scr[(4 * c4 + 1) * 65 + k] = w[i][1]; scr[(4 * c4 + 2) * 65 + k] = w[i][2]; scr[(4 * c4 + 3) * 65 + k] = w[i][3]; }
    LDS_WAIT(); asm volatile("" ::: "memory");
    bf16* ob = uni(WT + (size_t)n0d * K + k0); const int nr = lane >> 3, cch = lane & 7;
#pragma unroll
    for (int i = 0; i < 8; ++i) { const int n = 8 * i + nr; const LAS float* s = scr + n * 65 + 8 * cch;
        v4u o; o.x = cvtpk(s[0], s[1]); o.y = cvtpk(s[2], s[3]); o.z = cvtpk(s[4], s[5]); o.w = cvtpk(s[6], s[7]);
        *(v4u*)(ob + (unsigned)(n * K + 8 * cch)) = o; }
    LDS_WAIT(); asm volatile("" ::: "memory");
}
#ifndef P0_DEFER
#define P0_DEFER 1
#endif
constexpr int P0_DEFER_ITEMS = 64 * 640, P0_DEFER_CH = (P0_DEFER_ITEMS + 2) / 3;
__device__ __forceinline__ bool p0_defer_on(int G) { return P0_DEFER && (G % pg8::NXCD == 0); }
__device__ __forceinline__ void p0_deferred(KArgs a, LAS unsigned char* lds, const pg8::LockstepOrder& S, int slot) {
    const int lenmax = S.PG * pg8::LockstepOrder::LW * S.nN + S.qR + (S.rR > 0 ? 1 : 0), R = (lenmax + S.nk - 1) / S.nk, kcut = lenmax - (R - 1) * S.nk;
    const bool all = kcut >= S.nk;
    if (!all && S.k < kcut) return;
    int tid_l = threadIdx.x; asm volatile("" : "+v"(tid_l)); const int lane = tid_l & 63, wave = __builtin_amdgcn_readfirstlane(tid_l >> 6);
    const int rank = all ? S.c : (S.k - kcut) * pg8::NXCD + S.x, nw = (all ? S.G : pg8::NXCD * (S.nk - kcut)) * NWAVES;
    __syncthreads();
    LAS float* scr = (LAS float*)(lds + wave * 16640);
    if (slot < 3) { const int hi_ = min((slot + 1) * P0_DEFER_CH, P0_DEFER_ITEMS);
        for (int it = slot * P0_DEFER_CH + rank * NWAVES + wave; it < hi_; it += nw) { const int kb = it / 640, nb = it % 640;
            p0_tr_item(a->in[18] + (size_t)DM * N_C, N_C, DM, (bf16*)(a->ws + WS_WIN_C) + (size_t)N_C * DM, nb * 64, nb * 64, kb * 64, scr, lane); } }
    else {
        for (int it = rank * NWAVES + wave; it < 128 * 64; it += nw) { const int kb = it / 64, nb = it % 64;
            p0_tr_item(a->in[21] + (size_t)MIXW * DM, DM, MIXW, (bf16*)(a->ws + WS_WO_C) + (size_t)DM * MIXW, nb * 64, nb * 64, kb * 64, scr, lane); } }
    __syncthreads();
}
__device__ __forceinline__ void p0_prologue(KArgs a, LAS unsigned char* lds, int G) {
    int tid_l = threadIdx.x; asm volatile("" : "+v"(tid_l)); const int tid = tid_l, lane = tid & 63, wave = __builtin_amdgcn_readfirstlane(tid >> 6);
    __syncthreads();
    p0_gemv(a, lds, G);
    __syncthreads();
    LAS float* scr = (LAS float*)(lds + wave * 16640);
    const int gw = blockIdx.x * NWAVES + wave, NGW = G * NWAVES;
    constexpr int I_IN_AB = 64 * 281, I_Q = 16 * 96, I_KV = 8 * 128, I_O = 128 * 64, I_IN_C = 64 * 640;
    constexpr int PER_J = I_IN_AB + I_Q + I_KV + I_O + I_IN_C + I_O;
    const bool defer = p0_defer_on(G);
    const int NIT = defer ? 2 * PER_J - I_IN_C - I_O : 2 * PER_J;
    for (int it = gw; it < NIT; it += NGW) {
        const int j = it / PER_J; int r = it % PER_J;
        if (r < I_IN_AB) { const int kb = r / 281, nb = r % 281, n0 = nb * 64;
            p0_tr_item(a->in[8] + (size_t)j * DM * N_ABSRC, N_ABSRC, DM, (bf16*)(a->ws + WS_WIN_AB) + (size_t)j * N_AB * DM, n0, n0 + (n0 >= 1600 ? 192 : 0), kb * 64, scr, lane); continue; } r -= I_IN_AB;
        if (r < I_Q) { const int kb = r / 96, nb = r % 96;
            p0_tr_item(a->in[11] + (size_t)j * QL * NQ, NQ, QL, (bf16*)(a->ws + WS_WQ) + (size_t)j * NQ * QL, nb * 64, nb * 64, kb * 64, scr, lane); continue; } r -= I_Q;
        if (r < I_KV) { const int kb = r / 128, nb = r % 128;
            p0_tr_item(a->in[12] + (size_t)j * KVL * NKV, NKV, KVL, (bf16*)(a->ws + WS_WKV) + (size_t)j * NKV * KVL, nb * 64, nb * 64, kb * 64, scr, lane); continue; } r -= I_KV;
        if (r < I_O) { const int kb = r / 64, nb = r % 64;
            p0_tr_item(a->in[17] + (size_t)j * MIXW * DM, DM, MIXW, (bf16*)(a->ws + WS_WO_AB) + (size_t)j * DM * MIXW, nb * 64, nb * 64, kb * 64, scr, lane); continue; } r -= I_O;
        if (r < I_IN_C) { const int kb = r / 640, nb = r % 640;
            p0_tr_item(a->in[18] + (size_t)j * DM * N_C, N_C, DM, (bf16*)(a->ws + WS_WIN_C) + (size_t)j * N_C * DM, nb * 64, nb * 64, kb * 64, scr, lane); continue; } r -= I_IN_C;
        { const int kb = r / 64, nb = r % 64;
            p0_tr_item(a->in[21] + (size_t)j * MIXW * DM, DM, MIXW, (bf16*)(a->ws + WS_WO_C) + (size_t)j * DM * MIXW, nb * 64, nb * 64, kb * 64, scr, lane); }
    }
    const size_t gt = (size_t)blockIdx.x * 512 + tid, NGT = (size_t)G * 512;
    for (size_t i = gt; i < (size_t)2 * 192 * DM / 8; i += NGT) { const size_t j = i / (192 * DM / 8), e = i % (192 * DM / 8);
        *(v4u*)((bf16*)(a->ws + WS_WIN_AB) + j * (size_t)N_AB * DM + (size_t)1600 * DM + e * 8) = (v4u){0u, 0u, 0u, 0u}; }
    { const float* lg = a->in[19]; float* oml = (float*)(a->ws + WS_OML);
      for (size_t i = gt; i < (size_t)2 * 2 * 8192; i += NGT) { const int jc = (int)(i >> 14), de = (int)(i & 16383);
          const float l0 = lg[0 * 16384 + de], l1 = lg[1 * 16384 + de], l2 = lg[2 * 16384 + de], l3 = lg[3 * 16384 + de];
          const float mx = fmaxf(fmaxf(l0, l1), fmaxf(l2, l3)); const float e0 = __expf(l0 - mx), e1 = __expf(l1 - mx), e2 = __expf(l2 - mx), e3 = __expf(l3 - mx);
          const float inv = 1.0f / (e0 + e1 + e2 + e3); const float lb = (jc == 0) ? e1 * inv : (e1 + e2 + e3) * inv;
          oml[i] = 1.0f - lb; } }
    { f32x2* rope = (f32x2*)(a->ws + WS_ROPE);
      for (size_t i = gt; i < 128 * 16; i += NGT) { const int pos = (int)(i >> 4), f = (int)(i & 15); const float inv = powf(10000.0f, -(float)f / 16.0f); const float ang = (float)pos * inv;
          rope[i] = (f32x2){cosf(ang), sinf(ang)}; } }
}

__device__ __forceinline__ void norm_phase(KArgs a, int lpost, int lpre, int G) {
    int tid_l = threadIdx.x; asm volatile("" : "+v"(tid_l)); const int tid = tid_l, lane = tid & 63, wave = __builtin_amdgcn_readfirstlane(tid >> 6);
    const int gw = blockIdx.x * NWAVES + wave, NGW = G * NWAVES;
    const float* mod = (const float*)(a->ws + WS_MOD);
    float* XS = (float*)(a->ws + WS_XS); const float* Y = (const float*)(a->ws + WS_Y); bf16* H = (bf16*)(a->ws + WS_H);
    const int nrows = (lpost == 3) ? MLAT : MTOT;
    for (int row = gw; row < nrows; row += NGW) {
        const int rt = row < SEQ ? 0 : (row < MLAT ? 1 : 2);
        const float* xin = uni((lpost <= 0) ? (row < MLAT ? a->in[0] + (size_t)row * DM : a->in[2] + (size_t)(row - MLAT) * DM) : XS + (size_t)row * DM);
        f32x4 xv[16];
#pragma unroll
        for (int j = 0; j < 16; ++j) xv[j] = LDNT((const f32x4*)(xin + lane * 4 + 256 * j));
        if (lpost >= 0) {
            f32x4 yv[16]; float ss = 0.f;
            if (row < MLAT) { const bf16* yr = uni((const bf16*)Y + (size_t)row * DM);
#pragma unroll
                for (int j = 0; j < 16; ++j) { const u32x2 w = LDNT((const u32x2*)(yr + lane * 4 + 256 * j)); yv[j] = (f32x4){bf_lo(w.x), bf_hi(w.x), bf_lo(w.y), bf_hi(w.y)}; } }
            else {
                const float* yr = uni((const float*)(a->ws + WS_YP) + (size_t)(row - MLAT) * DM);
#pragma unroll
                for (int j = 0; j < 16; ++j) yv[j] = *(const f32x4*)(yr + lane * 4 + 256 * j);
                for (int kc = 1; kc < 8; ++kc) { const float* yk = uni(yr + (size_t)kc * (MTOT - MLAT) * DM);
#pragma unroll
                    for (int j = 0; j < 16; ++j) { yv[j] = yv[j] + *(const f32x4*)(yk + lane * 4 + 256 * j); if ((j & 3) == 3) asm volatile("" ::: "memory"); } } }
#pragma unroll
            for (int j = 0; j < 16; ++j) ss += (yv[j][0] * yv[j][0] + yv[j][1] * yv[j][1]) + (yv[j][2] * yv[j][2] + yv[j][3] * yv[j][3]);
            const float r = 1.0f / sqrtf(wave_sum(ss) * (1.0f / DM) + EPS);
            const float* gate = uni(mod + (size_t)(lpost * 3 + rt) * 12288 + 8192); const float* pw = uni(a->in[7] + (size_t)lpost * DM);
            float* xout = uni((lpost == 3) ? a->out + (size_t)row * DM : XS + (size_t)row * DM);
#pragma unroll
            for (int j = 0; j < 16; ++j) { const int col = lane * 4 + 256 * j; const f32x4 g = *(const f32x4*)(gate + col), w = *(const f32x4*)(pw + col);
                xv[j] = xv[j] + g * ((yv[j] * r) * w); STNT((f32x4*)(xout + col), xv[j]);
                if ((j & 3) == 3) asm volatile("" ::: "memory"); }
        }
        if (lpre < 4) {
            float ss = 0.f;
#pragma unroll
            for (int j = 0; j < 16; ++j) ss += (xv[j][0] * xv[j][0] + xv[j][1] * xv[j][1]) + (xv[j][2] * xv[j][2] + xv[j][3] * xv[j][3]);
            const float r = 1.0f / sqrtf(wave_sum(ss) * (1.0f / DM) + EPS);
            const float* shift = uni(mod + (size_t)(lpre * 3 + rt) * 12288); const float* scale = shift + 4096; const float* pw = uni(a->in[6] + (size_t)lpre * DM);
            bf16* hr = uni(H + (size_t)row * DM);
#pragma unroll
            for (int j = 0; j < 16; ++j) { const int col = lane * 4 + 256 * j; const f32x4 sh = *(const f32x4*)(shift + col), sc = *(const f32x4*)(scale + col), w = *(const f32x4*)(pw + col);
                const f32x4 h = ((xv[j] * r) * w) * (sc + 1.0f) + sh; u32x2 o; o.x = cvtpk(h[0], h[1]); o.y = cvtpk(h[2], h[3]); *(u32x2*)(hr + col) = o;
                if ((j & 3) == 3) asm volatile("" ::: "memory"); }
        }
    }
}

__device__ __forceinline__ void a2_rows(KArgs a, int j, int G) {
    int tid_l = threadIdx.x; asm volatile("" : "+v"(tid_l)); const int tid = tid_l, lane = tid & 63, wave = __builtin_amdgcn_readfirstlane(tid >> 6);
    const int gw = blockIdx.x * NWAVES + wave, NGW = G * NWAVES;
    const bf16* G1 = (const bf16*)(a->ws + WS_G1); bf16* QN = (bf16*)(a->ws + WS_QN); bf16* KVN = (bf16*)(a->ws + WS_KVN); bf16* KR = (bf16*)(a->ws + WS_KR);
    f32x2* stat = (f32x2*)(a->ws + WS_STAT); const f32x2* rope = (const f32x2*)(a->ws + WS_ROPE);
    const float* qw = a->in[9] + (size_t)j * QL; const float* kvw = a->in[10] + (size_t)j * KVL;
    for (int row = gw; row < MTOT; row += NGW) {
        const bf16* g = uni(G1 + (size_t)row * N_AB);
        {
            v4u w[2]; float x[16]; float ss = 0.f;
#pragma unroll
            for (int i = 0; i < 2; ++i) { w[i] = LDNT((const v4u*)(g + lane * 8 + 512 * i));
#pragma unroll
                for (int e = 0; e < 4; ++e) { x[8 * i + 2 * e] = bf_lo(w[i][e]); x[8 * i + 2 * e + 1] = bf_hi(w[i][e]); } }
#pragma unroll
            for (int e = 0; e < 16; ++e) ss += x[e] * x[e];
            const float r = 1.0f / sqrtf(wave_sum(ss) * (1.0f / QL) + EPS);
#pragma unroll
            for (int i = 0; i < 2; ++i) { const int col = lane * 8 + 512 * i; const f32x4 w0 = *(const f32x4*)(qw + col), w1 = *(const f32x4*)(qw + col + 4);
                v4u o; o.x = cvtpk(x[8 * i + 0] * r * w0[0], x[8 * i + 1] * r * w0[1]); o.y = cvtpk(x[8 * i + 2] * r * w0[2], x[8 * i + 3] * r * w0[3]);
                o.z = cvtpk(x[8 * i + 4] * r * w1[0], x[8 * i + 5] * r * w1[1]); o.w = cvtpk(x[8 * i + 6] * r * w1[2], x[8 * i + 7] * r * w1[3]);
                *(v4u*)(QN + (size_t)row * QL + col) = o; }
        }
        {
            const v4u w = LDNT((const v4u*)(g + G1_CKV + lane * 8)); float x[8]; float ss = 0.f;
#pragma unroll
            for (int e = 0; e < 4; ++e) { x[2 * e] = bf_lo(w[e]); x[2 * e + 1] = bf_hi(w[e]); }
#pragma unroll
            for (int e = 0; e < 8; ++e) ss += x[e] * x[e];
            const float r = 1.0f / sqrtf(wave_sum(ss) * (1.0f / KVL) + EPS);
            const int col = lane * 8; const f32x4 w0 = *(const f32x4*)(kvw + col), w1 = *(const f32x4*)(kvw + col + 4);
            v4u o; o.x = cvtpk(x[0] * r * w0[0], x[1] * r * w0[1]); o.y = cvtpk(x[2] * r * w0[2], x[3] * r * w0[3]); o.z = cvtpk(x[4] * r * w1[0], x[5] * r * w1[1]); o.w = cvtpk(x[6] * r * w1[2], x[7] * r * w1[3]);
            *(v4u*)(KVN + (size_t)row * KVL + col) = o;
        }
        {
            const float x = __uint_as_float((unsigned)g[G1_KR + lane] << 16); const float xp = __shfl_xor(x, 16); float o = x;
            if (row < MLAT) { const int t = row & (SEQ - 1), ax = lane >> 5, hh = (lane >> 4) & 1, f = lane & 15, pos = ax == 0 ? (t >> 6) : (t & 63); const f32x2 cs = rope[pos * 16 + f];
                o = hh == 0 ? x * cs.x - xp * cs.y : x * cs.x + xp * cs.y; }
            KR[(size_t)row * 64 + lane] = (bf16)(cvtpk(o, 0.f) & 0xffffu);
        }
        {
            float x[64]; float s = 0.f;
#pragma unroll
            for (int i = 0; i < 8; ++i) { const v4u w = *(const v4u*)(g + G1_VB + lane * 8 + 512 * i);
#pragma unroll
                for (int e = 0; e < 4; ++e) { x[8 * i + 2 * e] = bf_lo(w[e]); x[8 * i + 2 * e + 1] = bf_hi(w[e]); } }
#pragma unroll
            for (int e = 0; e < 64; ++e) s += x[e];
            const float mean = wave_sum(s) * (1.0f / 4096.0f); float q = 0.f;
#pragma unroll
            for (int e = 0; e < 64; ++e) { const float d = x[e] - mean; q += d * d; }
            const float rstd = 1.0f / sqrtf(wave_sum(q) * (1.0f / 4096.0f) + EPS);
            if (lane == 0) stat[row] = (f32x2){mean, rstd};
        }
    }
}

typedef short s16x4 __attribute__((ext_vector_type(4)));
typedef float f32x16 __attribute__((ext_vector_type(16)));
#define SBAR() __builtin_amdgcn_sched_barrier(0)
__device__ __forceinline__ f32x4 mfma16(bf16x8 a, bf16x8 b, f32x4 c) { return __builtin_amdgcn_mfma_f32_16x16x32_bf16(a, b, c, 0, 0, 0); }
__device__ __forceinline__ int crow(int r, int hi) { return (r & 3) + 8 * (r >> 2) + 4 * hi; }
__device__ __forceinline__ int v_st(int k, int c) { const int kk = (k & ~0xC) | ((k & 4) << 1) | ((k & 8) >> 1); return ((kk >> 3) * 4 + (c >> 5)) * 512 + ((kk & 7) * 32 + (c & 31)) * 2; }
__device__ __forceinline__ int v_rd_base(int lane) { return ((lane & 3) << 3) | (((lane >> 2) & 3) << 6) | (((lane >> 4) & 1) << 5) | (((lane >> 5) & 1) << 8); }
constexpr int v_rd_off(int d0, int ks, int half) { return d0 * 512 + ks * 4096 + half * 2048; }
template <int OFF> __device__ __forceinline__ s16x4 tr_read(int vb) {
    s16x4 r; asm volatile("ds_read_b64_tr_b16 %0, %1 offset:%2" : "=&v"(r) : "v"(vb), "i"(OFF) : "memory"); return r;
}
template <int D0> __device__ __forceinline__ void pv_one(f32x16& od, int vb, bf16x8 pa0, bf16x8 pa1, bf16x8 pa2, bf16x8 pa3) {
    const s16x4 l0 = tr_read<v_rd_off(D0, 0, 0)>(vb), h0 = tr_read<v_rd_off(D0, 0, 1)>(vb), l1 = tr_read<v_rd_off(D0, 1, 0)>(vb), h1 = tr_read<v_rd_off(D0, 1, 1)>(vb);
    const s16x4 l2 = tr_read<v_rd_off(D0, 2, 0)>(vb), h2 = tr_read<v_rd_off(D0, 2, 1)>(vb), l3 = tr_read<v_rd_off(D0, 3, 0)>(vb), h3 = tr_read<v_rd_off(D0, 3, 1)>(vb);
    asm volatile("s_waitcnt lgkmcnt(0)" ::: "memory"); SBAR();
#define PKV(L, H) (bf16x8){L[0], L[1], L[2], L[3], H[0], H[1], H[2], H[3]}
    od = __builtin_amdgcn_mfma_f32_32x32x16_bf16(pa0, PKV(l0, h0), od, 0, 0, 0);
    od = __builtin_amdgcn_mfma_f32_32x32x16_bf16(pa1, PKV(l1, h1), od, 0, 0, 0);
    od = __builtin_amdgcn_mfma_f32_32x32x16_bf16(pa2, PKV(l2, h2), od, 0, 0, 0);
    od = __builtin_amdgcn_mfma_f32_32x32x16_bf16(pa3, PKV(l3, h3), od, 0, 0, 0);
#undef PKV
}
__device__ __forceinline__ void pv_d0(f32x16* o, int vb, bf16x8 pa0, bf16x8 pa1, bf16x8 pa2, bf16x8 pa3) {
    pv_one<0>(o[0], vb, pa0, pa1, pa2, pa3); pv_one<1>(o[1], vb, pa0, pa1, pa2, pa3); pv_one<2>(o[2], vb, pa0, pa1, pa2, pa3); pv_one<3>(o[3], vb, pa0, pa1, pa2, pa3);
}

template <int I> __device__ __forceinline__ void pv_rd(int vb, s16x4& l0, s16x4& h0, s16x4& l1, s16x4& h1) {
    l0 = tr_read<v_rd_off(I >> 1, 2 * (I & 1), 0)>(vb); h0 = tr_read<v_rd_off(I >> 1, 2 * (I & 1), 1)>(vb); l1 = tr_read<v_rd_off(I >> 1, 2 * (I & 1) + 1, 0)>(vb); h1 = tr_read<v_rd_off(I >> 1, 2 * (I & 1) + 1, 1)>(vb);
}
#define PKV2(L, H) (bf16x8){L[0], L[1], L[2], L[3], H[0], H[1], H[2], H[3]}
#define PV_MM(I, A0, A1, L0, H0, L1, H1) do { o[(I) >> 1] = __builtin_amdgcn_mfma_f32_32x32x16_bf16(A0, PKV2(L0, H0), o[(I) >> 1], 0, 0, 0); o[(I) >> 1] = __builtin_amdgcn_mfma_f32_32x32x16_bf16(A1, PKV2(L1, H1), o[(I) >> 1], 0, 0, 0); } while (0)
#define PV_WAIT4() do { asm volatile("s_waitcnt lgkmcnt(4)" ::: "memory"); SBAR(); } while (0)
#define PV_WAIT0() do { asm volatile("s_waitcnt lgkmcnt(0)" ::: "memory"); SBAR(); } while (0)
__device__ __forceinline__ void pv_pipe(f32x16* o, int vb, bf16x8 pa0, bf16x8 pa1, bf16x8 pa2, bf16x8 pa3) {
    s16x4 al0, ah0, al1, ah1, bl0, bh0, bl1, bh1;
    asm volatile("s_waitcnt lgkmcnt(0)" ::: "memory"); SBAR();
    pv_rd<0>(vb, al0, ah0, al1, ah1); pv_rd<1>(vb, bl0, bh0, bl1, bh1);
    PV_WAIT4(); PV_MM(0, pa0, pa1, al0, ah0, al1, ah1); SBAR(); pv_rd<2>(vb, al0, ah0, al1, ah1);
    PV_WAIT4(); PV_MM(1, pa2, pa3, bl0, bh0, bl1, bh1); SBAR(); pv_rd<3>(vb, bl0, bh0, bl1, bh1);
    PV_WAIT4(); PV_MM(2, pa0, pa1, al0, ah0, al1, ah1); SBAR(); pv_rd<4>(vb, al0, ah0, al1, ah1);
    PV_WAIT4(); PV_MM(3, pa2, pa3, bl0, bh0, bl1, bh1); SBAR(); pv_rd<5>(vb, bl0, bh0, bl1, bh1);
    PV_WAIT4(); PV_MM(4, pa0, pa1, al0, ah0, al1, ah1); SBAR(); pv_rd<6>(vb, al0, ah0, al1, ah1);
    PV_WAIT4(); PV_MM(5, pa2, pa3, bl0, bh0, bl1, bh1); SBAR(); pv_rd<7>(vb, bl0, bh0, bl1, bh1);
    PV_WAIT4(); PV_MM(6, pa0, pa1, al0, ah0, al1, ah1);
    PV_WAIT0(); PV_MM(7, pa2, pa3, bl0, bh0, bl1, bh1);
}

__device__ __forceinline__ void pv_seq(f32x16* o, int vb, bf16x8 pa0, bf16x8 pa1, bf16x8 pa2, bf16x8 pa3) {
    s16x4 al0, ah0, al1, ah1;
    pv_rd<0>(vb, al0, ah0, al1, ah1); PV_WAIT0(); PV_MM(0, pa0, pa1, al0, ah0, al1, ah1); SBAR();
    pv_rd<1>(vb, al0, ah0, al1, ah1); PV_WAIT0(); PV_MM(1, pa2, pa3, al0, ah0, al1, ah1); SBAR();
    pv_rd<2>(vb, al0, ah0, al1, ah1); PV_WAIT0(); PV_MM(2, pa0, pa1, al0, ah0, al1, ah1); SBAR();
    pv_rd<3>(vb, al0, ah0, al1, ah1); PV_WAIT0(); PV_MM(3, pa2, pa3, al0, ah0, al1, ah1); SBAR();
    pv_rd<4>(vb, al0, ah0, al1, ah1); PV_WAIT0(); PV_MM(4, pa0, pa1, al0, ah0, al1, ah1); SBAR();
    pv_rd<5>(vb, al0, ah0, al1, ah1); PV_WAIT0(); PV_MM(5, pa2, pa3, al0, ah0, al1, ah1); SBAR();
    pv_rd<6>(vb, al0, ah0, al1, ah1); PV_WAIT0(); PV_MM(6, pa0, pa1, al0, ah0, al1, ah1); SBAR();
    pv_rd<7>(vb, al0, ah0, al1, ah1); PV_WAIT0(); PV_MM(7, pa2, pa3, al0, ah0, al1, ah1);
}

__device__ __forceinline__ void sgu_phase(KArgs a, int j, LAS unsigned char* lds, int G) {
    int tid_l = threadIdx.x; asm volatile("" : "+v"(tid_l)); const int tid = tid_l, lane = tid & 63, wid = __builtin_amdgcn_readfirstlane(tid >> 6), r32 = lane & 31, hi = lane >> 5;
    const bf16* G1 = (const bf16*)(a->ws + WS_G1); bf16* CC = (bf16*)(a->ws + WS_CC); const f32x2* stat = (const f32x2*)(a->ws + WS_STAT);
    const float* lnw = a->in[13] + (size_t)j * 4096; const float* lnb = a->in[14] + (size_t)j * 4096; const float* ws_all = a->in[15] + (size_t)j * 16 * 128 * 128; const float* bs = a->in[16] + (size_t)j * 16 * 128;
    constexpr int MXP = 272, OFF_ST = 69632;
    LAS float* st_mean = (LAS float*)(lds + OFF_ST); LAS float* st_rstd = st_mean + 128;
    LAS float* m1s = (LAS float*)(lds + OFF_ST + 1024) + wid * 64; LAS float* rss = m1s + 32;
    LAS unsigned char* mx = lds + wid * (32 * MXP);
    const int sr = tid >> 4, sc = (tid & 15) * 8, vst0 = v_st(sr, sc), vst1 = v_st(32 + sr, sc);
    const int tb = wid >> 1, ch = wid & 1;
    const int vb0 = (int)(unsigned)(unsigned long long)lds + v_rd_base(lane);
    v4u vx[8];
#define SGU_LOADV(it_) do { const int ch_ = (it_) >> 4, g_ = (it_) & 15; const bf16* s0_ = uni(G1 + (size_t)(ch_ * 128) * N_AB + G1_VB + g_ * 256); const unsigned lo_ = (unsigned)(sr * N_AB + sc); \
    _Pragma("unroll") for (int st = 0; st < 2; ++st) _Pragma("unroll") for (int c2 = 0; c2 < 2; ++c2) { const unsigned o_ = lo_ + (unsigned)(64 * st * N_AB + c2 * 128); \
        vx[(st * 2 + c2) * 2] = LDNT((const v4u*)(s0_ + o_)); vx[(st * 2 + c2) * 2 + 1] = LDNT((const v4u*)(s0_ + o_ + 32 * N_AB)); } } while (0)
    const int item0 = (int)((blockIdx.x + 128u) % (unsigned)G);
    if (item0 < 132 * 16) SGU_LOADV(item0);
    for (int item = item0; item < 132 * 16; item += G) {
        const int chunk = item >> 4, g = item & 15, row0 = chunk * 128;
        __syncthreads();
#pragma unroll
        for (int q = 0; q < 4; ++q) { *(LAS v4u*)(lds + q * 16384 + vst0) = vx[2 * q]; *(LAS v4u*)(lds + q * 16384 + vst1) = vx[2 * q + 1]; }
        if (tid < 128) { const f32x2 s = stat[row0 + tid]; st_mean[tid] = s.x; st_rstd[tid] = s.y; }
        __syncthreads();
        if (item + G < 132 * 16) SGU_LOADV(item + G);
        const float* wrow = ws_all + ((size_t)g * 128 + 32 * tb + r32) * 128;
        bf16x8 pa[2][4]; float m1 = 0.f, rs = 0.f;
#pragma unroll
        for (int st = 0; st < 2; ++st)
#pragma unroll
            for (int ks = 0; ks < 4; ++ks) { const int s0 = 64 * st + 16 * ks + 8 * hi; const f32x4 w0 = *(const f32x4*)(wrow + s0), w1 = *(const f32x4*)(wrow + s0 + 4);
                const f32x4 r0 = *(const LAS f32x4*)(st_rstd + s0), r1 = *(const LAS f32x4*)(st_rstd + s0 + 4), mu0 = *(const LAS f32x4*)(st_mean + s0), mu1 = *(const LAS f32x4*)(st_mean + s0 + 4);
                rs += (w0[0] + w0[1]) + (w0[2] + w0[3]) + (w1[0] + w1[1]) + (w1[2] + w1[3]);
                v4u p; p.x = cvtpk(w0[0] * r0[0], w0[1] * r0[1]); p.y = cvtpk(w0[2] * r0[2], w0[3] * r0[3]); p.z = cvtpk(w1[0] * r1[0], w1[1] * r1[1]); p.w = cvtpk(w1[2] * r1[2], w1[3] * r1[3]);
                m1 += bf_lo(p.x) * mu0[0] + bf_hi(p.x) * mu0[1] + bf_lo(p.y) * mu0[2] + bf_hi(p.y) * mu0[3] + bf_lo(p.z) * mu1[0] + bf_hi(p.z) * mu1[1] + bf_lo(p.w) * mu1[2] + bf_hi(p.w) * mu1[3];
                pa[st][ks] = __builtin_bit_cast(bf16x8, p); }
        m1 += __shfl_xor(m1, 32); rs += __shfl_xor(rs, 32);
        if (hi == 0) { m1s[r32] = m1; rss[r32] = rs; }
        f32x16 o[4];
#pragma unroll
        for (int d = 0; d < 4; ++d)
#pragma unroll
            for (int r = 0; r < 16; ++r) o[d][r] = 0.f;
#pragma unroll
        for (int st = 0; st < 2; ++st) pv_d0(o, vb0 + (st * 2 + ch) * 16384, pa[st][0], pa[st][1], pa[st][2], pa[st][3]);
        asm volatile("s_waitcnt lgkmcnt(0)" ::: "memory");
        __syncthreads();
        { const int cb = g * 256 + ch * 128;
          const float* lw = uni(lnw + cb); const float* lb = uni(lnb + cb); const float* bsg = uni(bs + g * 128 + 32 * tb);
          int r32e = r32, hie = hi; asm volatile("" : "+v"(r32e), "+v"(hie));
          float lwv[4], lbv[4];
#pragma unroll
          for (int d0 = 0; d0 < 4; ++d0) { lwv[d0] = lw[d0 * 32 + r32e]; lbv[d0] = lb[d0 * 32 + r32e]; }
#pragma unroll
          for (int r = 0; r < 16; ++r) { const int rr = crow(r, hie); const float m1t = m1s[rr], rst = rss[rr], bst = bsg[rr];
#pragma unroll
            for (int d0 = 0; d0 < 4; ++d0) { const float mix = lwv[d0] * (o[d0][r] - m1t) + lbv[d0] * rst + bst;
                *(LAS bf16*)(mx + rr * MXP + (d0 * 32 + r32e) * 2) = (bf16)(cvtpk(mix, 0.f) & 0xffffu); } } }
        asm volatile("s_waitcnt lgkmcnt(0)" ::: "memory");
        { const int cb = g * 256 + ch * 128;
          const bf16* Gu = uni(G1 + (size_t)(row0 + 32 * tb) * N_AB + G1_UB + cb); const bf16* Gzb = uni(G1 + (size_t)(row0 + 32 * tb) * N_AB + G1_ZB + cb); bf16* Co = uni(CC + (size_t)(row0 + 32 * tb) * MIXW + 4096 + cb);
          int le = lane; asm volatile("" : "+v"(le));
#pragma unroll
          for (int i = 0; i < 8; ++i) { const int id = 64 * i + le, row = id >> 4, c8 = (id & 15) * 8;
              const v4u mq = *(const LAS v4u*)(mx + row * MXP + c8 * 2); const v4u uq = LDNT((const v4u*)(Gu + (unsigned)(row * N_AB + c8))), zq = LDNT((const v4u*)(Gzb + (unsigned)(row * N_AB + c8)));
              v4u oq;
#pragma unroll
              for (int e = 0; e < 4; ++e) oq[e] = cvtpk(bf_lo(uq[e]) * bf_lo(mq[e]) * bf_lo(zq[e]), bf_hi(uq[e]) * bf_hi(mq[e]) * bf_hi(zq[e]));
              *(v4u*)(Co + (unsigned)(row * MIXW + c8)) = oq;
              if ((i & 3) == 3) asm volatile("" ::: "memory"); } }
    }
#undef SGU_LOADV
    __syncthreads();
}

namespace att {
constexpr int QBLK = 32, KVBLK = 64;
constexpr float SCALE = 0.07216878364870322f;
constexpr float THR = 8.f;
constexpr int SHM_V = KVBLK * 128 * 2, SHM_K = KVBLK * 192 * 2;
#ifndef STG_SEL
#define STG_SEL 0
#endif
#ifndef ATT_STAGGER
#define ATT_STAGGER 1
#endif
constexpr int NVB = ATT_STAGGER ? 3 : 2;
constexpr int OFF_V = 0, OFF_K = NVB * SHM_V, OFF_WS = OFF_K + 2 * SHM_K, ATT_LDS = OFF_WS + NWAVES * 64 * 4;
#ifndef ATT_QR_LDS
#define ATT_QR_LDS 1
#endif
#ifndef ATT_SDEPTH
#define ATT_SDEPTH 1
#endif
constexpr int SDEPTH = ATT_SDEPTH;
constexpr float THRL = THR * 1.4426950408889634f;
__device__ __forceinline__ void partialSM_first(f32x16& p0, f32x16& p1, float& m_reg, float& alpha) {
    float pmax = p0[0];
#pragma unroll
    for (int r = 1; r < 16; ++r) pmax = fmaxf(pmax, p0[r]);
#pragma unroll
    for (int r = 0; r < 16; ++r) pmax = fmaxf(pmax, p1[r]);
    { auto rr = __builtin_amdgcn_permlane32_swap(__float_as_uint(pmax), __float_as_uint(pmax), false, false);
      pmax = fmaxf(__uint_as_float(rr[0]), __uint_as_float(rr[1])); }
    m_reg = pmax; alpha = 1.f;
#pragma unroll
    for (int r = 0; r < 16; ++r) p0[r] = p0[r] - pmax;
#pragma unroll
    for (int r = 0; r < 16; ++r) p1[r] = p1[r] - pmax;
#pragma unroll
    for (int r = 0; r < 16; ++r) p0[r] = __builtin_amdgcn_exp2f(p0[r]);
}
__device__ __forceinline__ void partialSM(f32x16& p0, f32x16& p1, float& m_reg, float& alpha) {
    float pmax = p0[0];
#pragma unroll
    for (int r = 1; r < 16; ++r) pmax = fmaxf(pmax, p0[r]);
#pragma unroll
    for (int r = 0; r < 16; ++r) pmax = fmaxf(pmax, p1[r]);
    { auto rr = __builtin_amdgcn_permlane32_swap(__float_as_uint(pmax), __float_as_uint(pmax), false, false);
      pmax = fmaxf(__uint_as_float(rr[0]), __uint_as_float(rr[1])); }
    if (__builtin_expect(__all(pmax <= THRL), 1)) { alpha = 1.f; }
    else { const float d = fmaxf(pmax, 0.f); alpha = __builtin_amdgcn_exp2f(-d); m_reg += d;
#pragma unroll
        for (int r = 0; r < 16; ++r) p0[r] = p0[r] - d;
#pragma unroll
        for (int r = 0; r < 16; ++r) p1[r] = p1[r] - d; }
#pragma unroll
    for (int r = 0; r < 16; ++r) p0[r] = __builtin_amdgcn_exp2f(p0[r]);
}
__device__ __forceinline__ void finishSM(f32x16& p0, f32x16& p1, float alpha, float& l_reg, bf16x8& pa0, bf16x8& pa1, bf16x8& pa2, bf16x8& pa3) {
#pragma unroll
    for (int r = 0; r < 16; ++r) p1[r] = __builtin_amdgcn_exp2f(p1[r]);
    float ps = 0;
#pragma unroll
    for (int r = 0; r < 16; ++r) ps += p0[r];
#pragma unroll
    for (int r = 0; r < 16; ++r) ps += p1[r];
    { auto rr = __builtin_amdgcn_permlane32_swap(__float_as_uint(ps), __float_as_uint(ps), false, false);
      ps = __uint_as_float(rr[0]) + __uint_as_float(rr[1]); }
    l_reg = l_reg * alpha + ps;
#define PK4(P, BASE, OUT) do { unsigned a0 = cvtpk(P[BASE + 0], P[BASE + 1]), a1 = cvtpk(P[BASE + 2], P[BASE + 3]);   \
    unsigned b0 = cvtpk(P[BASE + 4], P[BASE + 5]), b1 = cvtpk(P[BASE + 6], P[BASE + 7]);                              \
    auto r0 = __builtin_amdgcn_permlane32_swap(a0, b0, false, false); auto r1 = __builtin_amdgcn_permlane32_swap(a1, b1, false, false); \
    v4u w = {r0[0], r1[0], r0[1], r1[1]}; OUT = __builtin_bit_cast(bf16x8, w); } while (0)
    PK4(p0, 0, pa0); PK4(p0, 8, pa1); PK4(p1, 0, pa2); PK4(p1, 8, pa3);
#undef PK4
}
constexpr int OFF_KR = 16384;
constexpr int OFF_QR = ATT_LDS, ATT_LDS2 = OFF_QR + NWAVES * 4096;
__device__ __forceinline__ void qkt(f32x16& p0, f32x16& p1, const LAS unsigned char* Ks, const bf16x8* qr, const LAS unsigned char* qrl, int r32, int hi, float seed) {
#pragma unroll
    for (int r = 0; r < 16; ++r) { p0[r] = seed; p1[r] = seed; }
    const int swn = (r32 & 15) << 4, swr = ((r32 >> 1) & 7) << 4;
#pragma unroll
    for (int d0 = 0; d0 < 8; ++d0) { const int cb = (d0 * 16 + hi * 8) * 2;
        const bf16x8 b0 = *(const LAS bf16x8*)(Ks + r32 * 256 + (cb ^ swn));
        const bf16x8 b1 = *(const LAS bf16x8*)(Ks + (32 + r32) * 256 + (cb ^ swn));
        p0 = __builtin_amdgcn_mfma_f32_32x32x16_bf16(b0, qr[d0], p0, 0, 0, 0);
        p1 = __builtin_amdgcn_mfma_f32_32x32x16_bf16(b1, qr[d0], p1, 0, 0, 0); }
#pragma unroll
    for (int d0 = 0; d0 < 4; ++d0) { const int cb = (d0 * 16 + hi * 8) * 2;
        const bf16x8 b0 = *(const LAS bf16x8*)(Ks + OFF_KR + r32 * 128 + (cb ^ swr));
        const bf16x8 b1 = *(const LAS bf16x8*)(Ks + OFF_KR + (32 + r32) * 128 + (cb ^ swr));
#if ATT_QR_LDS
        const bf16x8 q = *(const LAS bf16x8*)(qrl + d0 * 1024);
#else
        const bf16x8 q = qr[8 + d0];
#endif
        p0 = __builtin_amdgcn_mfma_f32_32x32x16_bf16(b0, q, p0, 0, 0, 0);
        p1 = __builtin_amdgcn_mfma_f32_32x32x16_bf16(b1, q, p1, 0, 0, 0); }
}
__device__ __forceinline__ void attn_unit(const bf16* __restrict__ Q, const bf16* __restrict__ KN, const bf16* __restrict__ KR, const bf16* __restrict__ V, const bf16* __restrict__ G1, bf16* __restrict__ CC,
                                          int qrow0, int h, int nt_lat, int lat0, int ctx0, LAS unsigned char* lds) {
    int tid_l = threadIdx.x; asm volatile("" : "+v"(tid_l)); const int tid = tid_l, wid = __builtin_amdgcn_readfirstlane(tid >> 6), lane = tid & 63, r32 = lane & 31, hi = lane >> 5;
    LAS unsigned char* V_lds = lds + OFF_V; LAS unsigned char* K_lds = lds + OFF_K;
    LAS float* wsf = (LAS float*)(lds + OFF_WS) + wid * 64; LAS float* li_l = wsf; LAS float* al_l = wsf + 32;
    LAS unsigned char* qrl = lds + OFF_QR + wid * 4096 + lane * 16;
    float m_reg = -1e30f, l_reg = 0;
    f32x16 o[4];
#pragma unroll
    for (int d = 0; d < 4; ++d)
#pragma unroll
        for (int r = 0; r < 16; ++r) o[d][r] = 0.f;
    const unsigned ko = (unsigned)((tid >> 4) * 128 + (((tid & 15) ^ ((tid >> 4) & 15)) * 8));
    const unsigned kro = (unsigned)((tid >> 3) * 64 + (((tid & 7) ^ ((tid >> 4) & 7)) * 8));
    unsigned vo; { const int sub = tid >> 5, kk = (sub >> 2) * 8 + ((tid & 31) >> 2), col = (sub & 3) * 32 + (tid & 3) * 8, key = (kk & ~0xC) | ((kk & 4) << 1) | ((kk & 8) >> 1); vo = (unsigned)(key * 128 + col); }
    const int vb0 = (int)(unsigned)(unsigned long long)lds + OFF_V + v_rd_base(lane);
    const int NT = nt_lat + 4;
#define TROW(jt) ((jt) < nt_lat ? lat0 + 64 * (jt) : ctx0 + 64 * ((jt) - nt_lat))
#define GLDS(gp, lp) __builtin_amdgcn_global_load_lds((const unsigned*)(gp), (LAS unsigned*)(lp), 16, 0, 0)
#define GLDS_S(gbase, boff, lp) do { const char* gb_ = (const char*)(gbase); asm volatile("" : "+s"(gb_)); unsigned bo_ = (boff); asm volatile("" : "+v"(bo_)); GLDS(gb_ + bo_, lp); } while (0)
#define ISSUE_K(jt, b) do { const int R0_ = TROW(jt); const bf16* Kb_ = uni(KN + ((size_t)h * MTOT + R0_) * 128); const bf16* Rb_ = uni(KR + (size_t)R0_ * 64); \
    GLDS_S(Kb_, ko * 2u, K_lds + (b) * SHM_K + wid * 1024); GLDS_S(Kb_ + 32 * 128, ko * 2u, K_lds + (b) * SHM_K + (wid + 8) * 1024); GLDS_S(Rb_, kro * 2u, K_lds + (b) * SHM_K + OFF_KR + wid * 1024); } while (0)
#define ISSUE_V(jt, b) do { const int R0_ = TROW(jt); const bf16* Vb_ = uni(V + ((size_t)h * MTOT + R0_) * 128); \
    GLDS_S(Vb_, vo * 2u, V_lds + (b) * SHM_V + wid * 1024); GLDS_S(Vb_ + 32 * 128, vo * 2u, V_lds + (b) * SHM_V + (wid + 8) * 1024); } while (0)
#define STEP_END() asm volatile("s_waitcnt vmcnt(0) lgkmcnt(0)\n\ts_barrier" ::: "memory")
#define RESC(a_) do { if (__any((a_) < 1.f)) { if (hi == 0) al_l[r32] = (a_); asm volatile("s_waitcnt lgkmcnt(0)" ::: "memory"); \
    _Pragma("unroll") for (int d = 0; d < 4; ++d) _Pragma("unroll") for (int r = 0; r < 16; ++r) o[d][r] *= al_l[crow(r, hi)]; } } while (0)
    STEP_END();
    ISSUE_K(0, 0);
    bf16x8 qr[ATT_QR_LDS ? 8 : 12];
    { const bf16* Qw = uni(Q + (size_t)(qrow0 + wid * QBLK) * NQ + h * 192); const unsigned qo = (unsigned)(r32 * NQ + hi * 8);
#pragma unroll
      for (int d0 = 0; d0 < (ATT_QR_LDS ? 8 : 12); ++d0) qr[d0] = *(const bf16x8*)(Qw + qo + d0 * 16);
#if ATT_QR_LDS
#pragma unroll
      for (int d0 = 8; d0 < 12; ++d0) { const bf16x8 t = *(const bf16x8*)(Qw + qo + d0 * 16); *(LAS bf16x8*)(qrl + (d0 - 8) * 1024) = t; }
#endif
    }
    f32x16 pA0, pA1, pB0, pB1; float alA, alB; bf16x8 pa0, pa1, pa2, pa3;
    STEP_END();
#if !ATT_STAGGER
    ISSUE_K(1, 1); ISSUE_V(0, 0);
    qkt(pA0, pA1, K_lds, qr, qrl, r32, hi, 0.f); partialSM_first(pA0, pA1, m_reg, alA);
    STEP_END();
    for (int j = 1; j + 1 < NT; j += 2) {
        ISSUE_K(j + 1, 0); ISSUE_V(j, 1);
        SBAR(); qkt(pB0, pB1, K_lds + SHM_K, qr, qrl, r32, hi, -m_reg);
        finishSM(pA0, pA1, alA, l_reg, pa0, pa1, pa2, pa3); SBAR();
        pv_pipe(o, vb0, pa0, pa1, pa2, pa3); partialSM(pB0, pB1, m_reg, alB);
        RESC(alB); STEP_END();
        ISSUE_K(j + 2, 1); ISSUE_V(j + 1, 0);
        SBAR(); qkt(pA0, pA1, K_lds, qr, qrl, r32, hi, -m_reg);
        finishSM(pB0, pB1, alB, l_reg, pa0, pa1, pa2, pa3); SBAR();
        pv_pipe(o, vb0 + SHM_V, pa0, pa1, pa2, pa3); partialSM(pA0, pA1, m_reg, alA);
        RESC(alA); STEP_END();
    }
    ISSUE_V(NT - 1, 1);
    SBAR(); qkt(pB0, pB1, K_lds + SHM_K, qr, qrl, r32, hi, -m_reg);
    finishSM(pA0, pA1, alA, l_reg, pa0, pa1, pa2, pa3); SBAR();
    pv_pipe(o, vb0, pa0, pa1, pa2, pa3); partialSM(pB0, pB1, m_reg, alB);
    RESC(alB); STEP_END();
    finishSM(pB0, pB1, alB, l_reg, pa0, pa1, pa2, pa3); SBAR();
    pv_pipe(o, vb0 + SHM_V, pa0, pa1, pa2, pa3);
#else
#define VOFF(t) (__builtin_amdgcn_readfirstlane(((unsigned)(t) % 3u) * (unsigned)SHM_V))
    if (STG_SEL == 0 ? (wid < 4) : (STG_SEL == 1)) {
        ISSUE_K(1, 1); ISSUE_V(0, 0);
        qkt(pA0, pA1, K_lds, qr, qrl, r32, hi, 0.f); partialSM_first(pA0, pA1, m_reg, alA);
        STEP_END();
        for (int j = 1; j + 1 < NT; j += 2) {
            ISSUE_K(j + 1, 0); ISSUE_V(j, j % 3);
            SBAR(); qkt(pB0, pB1, K_lds + SHM_K, qr, qrl, r32, hi, -m_reg); SBAR();
            finishSM(pA0, pA1, alA, l_reg, pa0, pa1, pa2, pa3); SBAR();
            pv_pipe(o, vb0 + VOFF(j - 1), pa0, pa1, pa2, pa3); partialSM(pB0, pB1, m_reg, alB);
            RESC(alB); STEP_END();
            ISSUE_K(j + 2, 1); ISSUE_V(j + 1, (j + 1) % 3);
            SBAR(); qkt(pA0, pA1, K_lds, qr, qrl, r32, hi, -m_reg); SBAR();
            finishSM(pB0, pB1, alB, l_reg, pa0, pa1, pa2, pa3); SBAR();
            pv_pipe(o, vb0 + VOFF(j), pa0, pa1, pa2, pa3); partialSM(pA0, pA1, m_reg, alA);
            RESC(alA); STEP_END();
        }
        ISSUE_V(NT - 1, (NT - 1) % 3);
        SBAR(); qkt(pB0, pB1, K_lds + SHM_K, qr, qrl, r32, hi, -m_reg); SBAR();
        finishSM(pA0, pA1, alA, l_reg, pa0, pa1, pa2, pa3); SBAR();
        pv_pipe(o, vb0 + VOFF(NT - 2), pa0, pa1, pa2, pa3); partialSM(pB0, pB1, m_reg, alB);
        RESC(alB); STEP_END();
        finishSM(pB0, pB1, alB, l_reg, pa0, pa1, pa2, pa3); SBAR();
        pv_pipe(o, vb0 + VOFF(NT - 1), pa0, pa1, pa2, pa3);
        STEP_END();
        STEP_END();
    } else {
#define TR_EVEN(j_) do { finishSM(pA0, pA1, alA, l_reg, pa0, pa1, pa2, pa3); SBAR(); pv_pipe(o, vb0 + VOFF((j_) - 2), pa0, pa1, pa2, pa3); partialSM(pB0, pB1, m_reg, alB); RESC(alB); } while (0)
#define TR_ODD(j_)  do { finishSM(pB0, pB1, alB, l_reg, pa0, pa1, pa2, pa3); SBAR(); pv_pipe(o, vb0 + VOFF((j_) - 2), pa0, pa1, pa2, pa3); partialSM(pA0, pA1, m_reg, alA); RESC(alA); } while (0)
        ISSUE_K(1, 1); ISSUE_V(0, 0);
        qkt(pA0, pA1, K_lds, qr, qrl, r32, hi, 0.f);
        STEP_END();
        ISSUE_K(2, 0); ISSUE_V(1, 1);
        partialSM_first(pA0, pA1, m_reg, alA);
        SBAR(); qkt(pB0, pB1, K_lds + SHM_K, qr, qrl, r32, hi, -m_reg); SBAR();
        STEP_END();
        for (int j = 2; j + 1 < NT - 1; j += 2) {
            ISSUE_K(j + 1, 1); ISSUE_V(j, j % 3);
            TR_EVEN(j); SBAR(); qkt(pA0, pA1, K_lds, qr, qrl, r32, hi, -m_reg); SBAR();
            STEP_END();
            ISSUE_K(j + 2, 0); ISSUE_V(j + 1, (j + 1) % 3);
            TR_ODD(j + 1); SBAR(); qkt(pB0, pB1, K_lds + SHM_K, qr, qrl, r32, hi, -m_reg); SBAR();
            STEP_END();
        }
        ISSUE_K(NT - 1, 1); ISSUE_V(NT - 2, (NT - 2) % 3);
        TR_EVEN(NT - 2); SBAR(); qkt(pA0, pA1, K_lds, qr, qrl, r32, hi, -m_reg); SBAR();
        STEP_END();
        ISSUE_V(NT - 1, (NT - 1) % 3);
        TR_ODD(NT - 1); SBAR(); qkt(pB0, pB1, K_lds + SHM_K, qr, qrl, r32, hi, -m_reg); SBAR();
        STEP_END();
        TR_EVEN(NT);
        STEP_END();
        finishSM(pB0, pB1, alB, l_reg, pa0, pa1, pa2, pa3); SBAR();
        pv_pipe(o, vb0 + VOFF(NT - 1), pa0, pa1, pa2, pa3);
        STEP_END();
#undef TR_EVEN
#undef TR_ODD
    }
#undef VOFF
#endif
    if (hi == 0) li_l[r32] = l_reg;
    STEP_END();
    { LAS unsigned char* mx = lds + wid * (32 * 272);
      int r32e = r32, hie = hi; asm volatile("" : "+v"(r32e), "+v"(hie));
#pragma unroll
      for (int r = 0; r < 16; ++r) { const int rr = crow(r, hie); const float rli = __builtin_amdgcn_rcpf(li_l[rr]);
#pragma unroll
        for (int d0 = 0; d0 < 4; ++d0) *(LAS bf16*)(mx + rr * 272 + (d0 * 32 + r32e) * 2) = (bf16)(cvtpk(o[d0][r] * rli, 0.f) & 0xffffu); }
      asm volatile("s_waitcnt lgkmcnt(0)" ::: "memory");
      const bf16* Gz = uni(G1 + (size_t)(qrow0 + wid * QBLK) * N_AB + G1_ZA + h * 128); bf16* Co = uni(CC + (size_t)(qrow0 + wid * QBLK) * MIXW + h * 128);
      int le = lane; asm volatile("" : "+v"(le));
#pragma unroll
      for (int i = 0; i < 8; ++i) { const int id = 64 * i + le, row = id >> 4, c8 = (id & 15) * 8;
          const v4u oq = *(const LAS v4u*)(mx + row * 272 + c8 * 2); const v4u zq = LDNT((const v4u*)(Gz + (unsigned)(row * N_AB + c8)));
          v4u wq;
#pragma unroll
          for (int e = 0; e < 4; ++e) wq[e] = cvtpk(bf_lo(oq[e]) * bf_lo(zq[e]), bf_hi(oq[e]) * bf_hi(zq[e]));
          *(v4u*)(Co + (unsigned)(row * MIXW + c8)) = wq;
          if ((i & 3) == 3) asm volatile("" ::: "memory"); } }
#undef TROW
#undef GLDS
#undef ISSUE_K
#undef ISSUE_V
#undef STEP_END
#undef RESC
}
}
namespace att2 {
using namespace att;
struct P8 { f32x4 t[2][4]; };
__device__ __forceinline__ float x16(float x) { return __int_as_float(__builtin_amdgcn_ds_swizzle(__float_as_int(x), 0x401F)); }
__device__ __forceinline__ float rmax4(float x) { x = fmaxf(x, x16(x)); auto rr = __builtin_amdgcn_permlane32_swap(__float_as_uint(x), __float_as_uint(x), false, false); return fmaxf(__uint_as_float(rr[0]), __uint_as_float(rr[1])); }
__device__ __forceinline__ float rsum4(float x) { x = x + x16(x); auto rr = __builtin_amdgcn_permlane32_swap(__float_as_uint(x), __float_as_uint(x), false, false); return __uint_as_float(rr[0]) + __uint_as_float(rr[1]); }
__device__ __forceinline__ float tmax(const P8& p, int qt) { float m = p.t[qt][0][0];
#pragma unroll
    for (int kt = 0; kt < 4; ++kt)
#pragma unroll
        for (int r = 0; r < 4; ++r) m = fmaxf(m, p.t[qt][kt][r]);
    return m; }
__device__ __forceinline__ void qkt2(P8& p, const LAS unsigned char* Ks, const bf16x8 (&qf)[2][4], const LAS unsigned char* qrl, int l16, int g4, float seed0, float seed1) {
#pragma unroll
    for (int kt = 0; kt < 4; ++kt) { p.t[0][kt] = (f32x4){seed0, seed0, seed0, seed0}; p.t[1][kt] = (f32x4){seed1, seed1, seed1, seed1}; }
    const int swn = l16 << 4, swr = ((l16 >> 1) & 7) << 4;
#pragma unroll
    for (int ks = 0; ks < 4; ++ks) { const int cb = (32 * ks + 8 * g4) * 2;
#pragma unroll
        for (int kt = 0; kt < 4; ++kt) { const bf16x8 kf = *(const LAS bf16x8*)(Ks + (16 * kt + l16) * 256 + (cb ^ swn));
            p.t[0][kt] = mfma16(kf, qf[0][ks], p.t[0][kt]); p.t[1][kt] = mfma16(kf, qf[1][ks], p.t[1][kt]); } }
#pragma unroll
    for (int ks = 0; ks < 2; ++ks) { const int cb = (32 * ks + 8 * g4) * 2;
        const bf16x8 q0 = *(const LAS bf16x8*)(qrl + ks * 1024), q1 = *(const LAS bf16x8*)(qrl + (2 + ks) * 1024);
#pragma unroll
        for (int kt = 0; kt < 4; ++kt) { const bf16x8 kf = *(const LAS bf16x8*)(Ks + OFF_KR + (16 * kt + l16) * 128 + (cb ^ swr));
            p.t[0][kt] = mfma16(kf, q0, p.t[0][kt]); p.t[1][kt] = mfma16(kf, q1, p.t[1][kt]); } }
}
__device__ __forceinline__ void sub_all(P8& p, float d0, float d1) {
#pragma unroll
    for (int kt = 0; kt < 4; ++kt) { p.t[0][kt] = p.t[0][kt] - d0; p.t[1][kt] = p.t[1][kt] - d1; } }
__device__ __forceinline__ void exp_half(P8& p, int k0) {
#pragma unroll
    for (int qt = 0; qt < 2; ++qt)
#pragma unroll
        for (int kt = 0; kt < 2; ++kt)
#pragma unroll
            for (int r = 0; r < 4; ++r) p.t[qt][k0 + kt][r] = __builtin_amdgcn_exp2f(p.t[qt][k0 + kt][r]); }
__device__ __forceinline__ void partial2_first(P8& p, float& m0, float& m1, float& a0, float& a1) {
    m0 = rmax4(tmax(p, 0)); m1 = rmax4(tmax(p, 1)); a0 = 1.f; a1 = 1.f; sub_all(p, m0, m1); exp_half(p, 0); }
__device__ __forceinline__ void partial2(P8& p, float& m0, float& m1, float& a0, float& a1) {
    const float x0 = rmax4(tmax(p, 0)), x1 = rmax4(tmax(p, 1));
    if (__builtin_expect(__all(fmaxf(x0, x1) <= THRL), 1)) { a0 = 1.f; a1 = 1.f; }
    else { const float d0 = fmaxf(x0, 0.f), d1 = fmaxf(x1, 0.f); a0 = __builtin_amdgcn_exp2f(-d0); a1 = __builtin_amdgcn_exp2f(-d1); m0 += d0; m1 += d1; sub_all(p, d0, d1); }
    exp_half(p, 0); }
__device__ __forceinline__ void finish2(P8& p, float a0, float a1, float& l0, float& l1, bf16x8 (&pb)[2][2]) {
    exp_half(p, 2);
    float s0 = 0.f, s1 = 0.f;
#pragma unroll
    for (int kt = 0; kt < 4; ++kt)
#pragma unroll
        for (int r = 0; r < 4; ++r) { s0 += p.t[0][kt][r]; s1 += p.t[1][kt][r]; }
    l0 = l0 * a0 + rsum4(s0); l1 = l1 * a1 + rsum4(s1);
#pragma unroll
    for (int qt = 0; qt < 2; ++qt)
#pragma unroll
        for (int s2 = 0; s2 < 2; ++s2) { v4u w; w.x = cvtpk(p.t[qt][2 * s2][0], p.t[qt][2 * s2][1]); w.y = cvtpk(p.t[qt][2 * s2][2], p.t[qt][2 * s2][3]);
            w.z = cvtpk(p.t[qt][2 * s2 + 1][0], p.t[qt][2 * s2 + 1][1]); w.w = cvtpk(p.t[qt][2 * s2 + 1][2], p.t[qt][2 * s2 + 1][3]); pb[qt][s2] = __builtin_bit_cast(bf16x8, w); }
}
template <int B, int I> __device__ __forceinline__ void pv2_rd(const int (&vo)[8], s16x4& lo, s16x4& hi) { constexpr int s2 = I >> 3, vt = I & 7;
    lo = tr_read<B * SHM_V + s2 * 8192>(vo[vt]); hi = tr_read<B * SHM_V + s2 * 8192 + 4096>(vo[vt]); }
#define PV2_MM(I, L, H) do { const bf16x8 af_ = (bf16x8){L[0], L[1], L[2], L[3], H[0], H[1], H[2], H[3]}; \
    o[(I) & 7][0] = mfma16(af_, pb[0][(I) >> 3], o[(I) & 7][0]); o[(I) & 7][1] = mfma16(af_, pb[1][(I) >> 3], o[(I) & 7][1]); } while (0)
#define PV2_W(N) do { asm volatile("s_waitcnt lgkmcnt(" #N ")" ::: "memory"); SBAR(); } while (0)
template <int B> __device__ __forceinline__ void pv2(f32x4 (&o)[8][2], const int (&vo)[8], const bf16x8 (&pb)[2][2]) {
    s16x4 l0, h0, l1, h1, l2, h2;
    asm volatile("s_waitcnt lgkmcnt(0)" ::: "memory"); SBAR();
    pv2_rd<B, 0>(vo, l0, h0); pv2_rd<B, 1>(vo, l1, h1); pv2_rd<B, 2>(vo, l2, h2);
    PV2_W(4); PV2_MM(0, l0, h0); SBAR(); pv2_rd<B, 3>(vo, l0, h0);
    PV2_W(4); PV2_MM(1, l1, h1); SBAR(); pv2_rd<B, 4>(vo, l1, h1);
    PV2_W(4); PV2_MM(2, l2, h2); SBAR(); pv2_rd<B, 5>(vo, l2, h2);
    PV2_W(4); PV2_MM(3, l0, h0); SBAR(); pv2_rd<B, 6>(vo, l0, h0);
    PV2_W(4); PV2_MM(4, l1, h1); SBAR(); pv2_rd<B, 7>(vo, l1, h1);
    PV2_W(4); PV2_MM(5, l2, h2); SBAR(); pv2_rd<B, 8>(vo, l2, h2);
    PV2_W(4); PV2_MM(6, l0, h0); SBAR(); pv2_rd<B, 9>(vo, l0, h0);
    PV2_W(4); PV2_MM(7, l1, h1); SBAR(); pv2_rd<B, 10>(vo, l1, h1);
    PV2_W(4); PV2_MM(8, l2, h2); SBAR(); pv2_rd<B, 11>(vo, l2, h2);
    PV2_W(4); PV2_MM(9, l0, h0); SBAR(); pv2_rd<B, 12>(vo, l0, h0);
    PV2_W(4); PV2_MM(10, l1, h1); SBAR(); pv2_rd<B, 13>(vo, l1, h1);
    PV2_W(4); PV2_MM(11, l2, h2); SBAR(); pv2_rd<B, 14>(vo, l2, h2);
    PV2_W(4); PV2_MM(12, l0, h0); SBAR(); pv2_rd<B, 15>(vo, l0, h0);
    PV2_W(4); PV2_MM(13, l1, h1);
    PV2_W(2); PV2_MM(14, l2, h2);
    PV2_W(0); PV2_MM(15, l0, h0);
}
__device__ __forceinline__ void attn_unit2(const bf16* __restrict__ Q, const bf16* __restrict__ KN, const bf16* __restrict__ KR, const bf16* __restrict__ V, const bf16* __restrict__ G1, bf16* __restrict__ CC,
                                           int qrow0, int h, int nt_lat, int lat0, int ctx0, LAS unsigned char* lds) {
    int tid_l = threadIdx.x; asm volatile("" : "+v"(tid_l)); const int tid = tid_l, wid = __builtin_amdgcn_readfirstlane(tid >> 6), lane = tid & 63, l16 = lane & 15, g4 = lane >> 4;
    LAS unsigned char* V_lds = lds + OFF_V; LAS unsigned char* K_lds = lds + OFF_K;
    LAS unsigned char* qrl = lds + OFF_QR + wid * 4096 + lane * 16;
    float m0 = 0.f, m1 = 0.f, l0 = 0.f, l1 = 0.f;
    f32x4 o[8][2];
#pragma unroll
    for (int vt = 0; vt < 8; ++vt) { o[vt][0] = (f32x4){0.f, 0.f, 0.f, 0.f}; o[vt][1] = (f32x4){0.f, 0.f, 0.f, 0.f}; }
    const unsigned ko = (unsigned)((tid >> 4) * 128 + (((tid & 15) ^ ((tid >> 4) & 15)) * 8));
    const unsigned kro = (unsigned)((tid >> 3) * 64 + (((tid & 7) ^ ((tid >> 4) & 7)) * 8));
    const unsigned vo_g = (unsigned)((tid >> 4) * 128 + ((((((tid & 15) >> 1) ^ ((tid >> 4) & 7)) << 1) | (tid & 1)) * 8));
    int vo[8];
    { const int q = l16 >> 2, pp = l16 & 3, rr = 4 * g4 + q, sw = rr & 7, base = (int)(unsigned)(unsigned long long)lds + OFF_V + rr * 256 + 8 * pp;
#pragma unroll
      for (int vt = 0; vt < 8; ++vt) vo[vt] = base + ((vt ^ sw) << 5); }
    const int NT = nt_lat + 4;
#define TROW(jt) ((jt) < nt_lat ? lat0 + 64 * (jt) : ctx0 + 64 * ((jt) - nt_lat))
#define GLDS(gp, lp) __builtin_amdgcn_global_load_lds((const unsigned*)(gp), (LAS unsigned*)(lp), 16, 0, 0)
#define ISSUE_K(jt, b) do { const int R0_ = TROW(jt); const bf16* Kb_ = uni(KN + ((size_t)h * MTOT + R0_) * 128); const bf16* Rb_ = uni(KR + (size_t)R0_ * 64); \
    GLDS(Kb_ + ko, K_lds + (b) * SHM_K + wid * 1024); GLDS(Kb_ + ko + 32 * 128, K_lds + (b) * SHM_K + (wid + 8) * 1024); GLDS(Rb_ + kro, K_lds + (b) * SHM_K + OFF_KR + wid * 1024); } while (0)
#define ISSUE_V(jt, b) do { const int R0_ = TROW(jt); const bf16* Vb_ = uni(V + ((size_t)h * MTOT + R0_) * 128); \
    GLDS(Vb_ + vo_g, V_lds + (b) * SHM_V + wid * 1024); GLDS(Vb_ + vo_g + 32 * 128, V_lds + (b) * SHM_V + (wid + 8) * 1024); } while (0)
#define STEP_END() asm volatile("s_waitcnt vmcnt(0) lgkmcnt(0)\n\ts_barrier" ::: "memory")
#define RESC2(a0_, a1_) do { if (__any(fminf(a0_, a1_) < 1.f)) { _Pragma("unroll") for (int vt = 0; vt < 8; ++vt) { o[vt][0] = o[vt][0] * (a0_); o[vt][1] = o[vt][1] * (a1_); } } } while (0)
    STEP_END();
    ISSUE_K(0, 0);
    bf16x8 qf[2][4];
    { const bf16* Qw = uni(Q + (size_t)(qrow0 + wid * QBLK) * NQ + h * 192); const unsigned qo = (unsigned)(l16 * NQ + g4 * 8);
#pragma unroll
      for (int qt = 0; qt < 2; ++qt) {
#pragma unroll
        for (int ks = 0; ks < 4; ++ks) qf[qt][ks] = *(const bf16x8*)(Qw + qo + (unsigned)(qt * 16 * NQ + ks * 32));
#pragma unroll
        for (int ks = 4; ks < 6; ++ks) { const bf16x8 t = *(const bf16x8*)(Qw + qo + (unsigned)(qt * 16 * NQ + ks * 32)); *(LAS bf16x8*)(qrl + (qt * 2 + ks - 4) * 1024) = t; } } }
    P8 pA, pB; float aA0, aA1, aB0, aB1; bf16x8 pb[2][2];
    STEP_END();
    ISSUE_K(1, 1); ISSUE_V(0, 0);
    qkt2(pA, K_lds, qf, qrl, l16, g4, 0.f, 0.f); partial2_first(pA, m0, m1, aA0, aA1);
    STEP_END();
    for (int j = 1; j + 1 < NT; j += 2) {
        ISSUE_K(j + 1, 0); ISSUE_V(j, 1);
        SBAR(); qkt2(pB, K_lds + SHM_K, qf, qrl, l16, g4, -m0, -m1);
        finish2(pA, aA0, aA1, l0, l1, pb); SBAR();
        pv2<0>(o, vo, pb); partial2(pB, m0, m1, aB0, aB1);
        RESC2(aB0, aB1); STEP_END();
        ISSUE_K(j + 2, 1); ISSUE_V(j + 1, 0);
        SBAR(); qkt2(pA, K_lds, qf, qrl, l16, g4, -m0, -m1);
        finish2(pB, aB0, aB1, l0, l1, pb); SBAR();
        pv2<1>(o, vo, pb); partial2(pA, m0, m1, aA0, aA1);
        RESC2(aA0, aA1); STEP_END();
    }
    ISSUE_V(NT - 1, 1);
    SBAR(); qkt2(pB, K_lds + SHM_K, qf, qrl, l16, g4, -m0, -m1);
    finish2(pA, aA0, aA1, l0, l1, pb); SBAR();
    pv2<0>(o, vo, pb); partial2(pB, m0, m1, aB0, aB1);
    RESC2(aB0, aB1); STEP_END();
    finish2(pB, aB0, aB1, l0, l1, pb); SBAR();
    pv2<1>(o, vo, pb);
    STEP_END();
    { LAS unsigned char* mx = lds + wid * (32 * 272);
      const float r0 = __builtin_amdgcn_rcpf(l0), r1 = __builtin_amdgcn_rcpf(l1);
#pragma unroll
      for (int vt = 0; vt < 8; ++vt) { u32x2 w;
          w.x = cvtpk(o[vt][0][0] * r0, o[vt][0][1] * r0); w.y = cvtpk(o[vt][0][2] * r0, o[vt][0][3] * r0); *(LAS u32x2*)(mx + l16 * 272 + (16 * vt + 4 * g4) * 2) = w;
          w.x = cvtpk(o[vt][1][0] * r1, o[vt][1][1] * r1); w.y = cvtpk(o[vt][1][2] * r1, o[vt][1][3] * r1); *(LAS u32x2*)(mx + (16 + l16) * 272 + (16 * vt + 4 * g4) * 2) = w; }
      asm volatile("s_waitcnt lgkmcnt(0)" ::: "memory");
      const bf16* Gz = uni(G1 + (size_t)(qrow0 + wid * QBLK) * N_AB + G1_ZA + h * 128); bf16* Co = uni(CC + (size_t)(qrow0 + wid * QBLK) * MIXW + h * 128);
      int le = lane; asm volatile("" : "+v"(le));
#pragma unroll
      for (int i = 0; i < 8; ++i) { const int id = 64 * i + le, row = id >> 4, c8 = (id & 15) * 8;
          const v4u oq = *(const LAS v4u*)(mx + row * 272 + c8 * 2); const v4u zq = LDNT((const v4u*)(Gz + (unsigned)(row * N_AB + c8)));
          v4u wq;
#pragma unroll
          for (int e = 0; e < 4; ++e) wq[e] = cvtpk(bf_lo(oq[e]) * bf_lo(zq[e]), bf_hi(oq[e]) * bf_hi(zq[e]));
          *(v4u*)(Co + (unsigned)(row * MIXW + c8)) = wq;
          if ((i & 3) == 3) asm volatile("" ::: "memory"); } }
#undef TROW
#undef GLDS
#undef ISSUE_K
#undef ISSUE_V
#undef STEP_END
#undef RESC2
}
#undef PV2_MM
#undef PV2_W
}
#ifndef ATT_PRIO
#define ATT_PRIO 1
#endif
#ifndef ATT_BODY2
#define ATT_BODY2 0
#endif
__device__ __forceinline__ void attn_phase(KArgs a, LAS unsigned char* lds, int G) {
    const bf16* Q = (const bf16*)(a->ws + WS_Q); const bf16* KN = (const bf16*)(a->ws + WS_KN); const bf16* KR = (const bf16*)(a->ws + WS_KR); const bf16* V = (const bf16*)(a->ws + WS_V);
    const bf16* G1 = (const bf16*)(a->ws + WS_G1); bf16* CC = (bf16*)(a->ws + WS_CC);
    const int bx = blockIdx.x; const int vcu = (G % 8 == 0) ? (bx % 8) * (G / 8) + bx / 8 : bx;
    if (ATT_PRIO && __builtin_amdgcn_readfirstlane(threadIdx.x >> 6) >= 4) __builtin_amdgcn_s_setprio(1);
    for (int u = vcu; u < 2048 + 64; u += G) {
        if (u < 2048) { const int bh = u >> 5, qb = u & 31, b = bh >> 5, h = bh & 31;
            if (ATT_BODY2) att2::attn_unit2(Q, KN, KR, V, G1, CC, b * SEQ + qb * 256, h, 128, b * SEQ, MLAT + b * NCTX, lds); else att::attn_unit(Q, KN, KR, V, G1, CC, b * SEQ + qb * 256, h, 128, b * SEQ, MLAT + b * NCTX, lds); }
        else { const int bh = u - 2048, b = bh >> 5, h = bh & 31;
            if (ATT_BODY2) att2::attn_unit2(Q, KN, KR, V, G1, CC, MLAT + b * NCTX, h, 0, 0, MLAT + b * NCTX, lds); else att::attn_unit(Q, KN, KR, V, G1, CC, MLAT + b * NCTX, h, 0, 0, MLAT + b * NCTX, lds); }
    }
    if (ATT_PRIO) __builtin_amdgcn_s_setprio(0);
    __syncthreads();
}

__device__ __forceinline__ s16x4 tr_read_v(int addr) { s16x4 r; asm volatile("ds_read_b64_tr_b16 %0, %1" : "=&v"(r) : "v"(addr) : "memory"); return r; }
template <int CTRL> __device__ __forceinline__ float dpp_f(float x) { return __int_as_float(__builtin_amdgcn_update_dpp(0, __float_as_int(x), CTRL, 0xf, 0xf, true)); }
constexpr int SC_PITCH = 288;
constexpr int SC_QD = 0, SC_KD = 16 * SC_PITCH, SC_KE = 32 * SC_PITCH, SC_VV = 48 * SC_PITCH, SC_EB = 64 * SC_PITCH, SC_BUF = SC_EB + 512;
constexpr int SC_OST = 2 * SC_BUF;
__device__ __forceinline__ void scan_stage(LAS unsigned char* B, u32x2 rq, u32x2 rk, u32x2 rv, int wid, int lane, int tid) {
    const int t = lane & 15, kq = lane >> 4;
    float q[4], kk[4], x[4], tot[4];
    q[0] = bf_lo(rq.x); q[1] = bf_hi(rq.x); q[2] = bf_lo(rq.y); q[3] = bf_hi(rq.y); kk[0] = bf_lo(rk.x); kk[1] = bf_hi(rk.x); kk[2] = bf_lo(rk.y); kk[3] = bf_hi(rk.y);
#pragma unroll
    for (int e = 0; e < 4; ++e) { float g = __builtin_amdgcn_logf(fmaxf(1.0f - kk[e], 1e-30f)); float s = g;
        g += dpp_f<0x111>(g); g += dpp_f<0x112>(g); g += dpp_f<0x114>(g); g += dpp_f<0x118>(g);
        s += dpp_f<0x128>(s); s += dpp_f<0x124>(s); s += dpp_f<0x122>(s); s += dpp_f<0x121>(s);
        x[e] = g; tot[e] = s; }
    float qd[4], kd[4], ke[4];
#pragma unroll
    for (int e = 0; e < 4; ++e) { qd[e] = q[e] * __builtin_amdgcn_exp2f(x[e]); kd[e] = kk[e] * __builtin_amdgcn_exp2f(fminf(-x[e], 115.0f)); ke[e] = kk[e] * __builtin_amdgcn_exp2f(fminf(tot[e] - x[e], 0.0f)); }
    const int ppos = 32 * (wid >> 1) + 8 * kq + 4 * (wid & 1);
    u32x2 w;
    w.x = cvtpk(qd[0], qd[1]); w.y = cvtpk(qd[2], qd[3]); *(LAS u32x2*)(B + SC_QD + t * SC_PITCH + ppos * 2) = w;
    w.x = cvtpk(kd[0], kd[1]); w.y = cvtpk(kd[2], kd[3]); *(LAS u32x2*)(B + SC_KD + t * SC_PITCH + ppos * 2) = w;
    w.x = cvtpk(ke[0], ke[1]); w.y = cvtpk(ke[2], ke[3]); *(LAS u32x2*)(B + SC_KE + t * SC_PITCH + (16 * wid + 4 * kq) * 2) = w;
    if (t == 0) *(LAS f32x4*)(B + SC_EB + (16 * wid + 4 * kq) * 4) = (f32x4){__builtin_amdgcn_exp2f(tot[0]), __builtin_amdgcn_exp2f(tot[1]), __builtin_amdgcn_exp2f(tot[2]), __builtin_amdgcn_exp2f(tot[3])};
    *(LAS u32x2*)(B + SC_VV + (tid >> 5) * SC_PITCH + (tid & 31) * 8) = rv;
}
__device__ __forceinline__ void scan_phase(KArgs a, LAS unsigned char* lds, int G) {
    int tid_l = threadIdx.x; asm volatile("" : "+v"(tid_l)); const int tid = tid_l, lane = tid & 63, wid = __builtin_amdgcn_readfirstlane(tid >> 6), g4 = lane >> 4, l16 = lane & 15;
    const bf16* G1 = (const bf16*)(a->ws + WS_G1); const size_t TS = (size_t)MTOT * MIXW;
    const int ldsb = (int)(unsigned)(unsigned long long)lds;
    const int trq = l16 >> 2, trp = l16 & 3;
    const int st = lane & 15, sk = 16 * wid + 4 * (lane >> 4);
    const int vt_ = tid >> 5, vc = (tid & 31) * 4;
    for (int sq = blockIdx.x; sq < 256; sq += G) {
        const int dir = sq >> 7, b = (sq >> 6) & 1, h = sq & 63;
        const bf16* Tq = G1 + h * 128; const bf16* Tk = G1 + (size_t)(1 + dir) * TS + h * 128; const bf16* Tv = G1 + (size_t)3 * TS + h * 128;
        bf16* Od = (bf16*)(a->ws + WS_OF) + (size_t)dir * TS + h * 128;
        const unsigned oq = (unsigned)((dir ? 15 - st : st) * MIXW + sk), ovv = (unsigned)((dir ? 15 - vt_ : vt_) * MIXW + vc);
#define CLOW(c_) ((c_) < 16 ? MLAT + b * NCTX + (dir ? 240 - 16 * (c_) : 16 * (c_)) : b * SEQ + (dir ? 8432 - 16 * (c_) : 16 * (c_) - 256))
#define SLOADC(c_) do { const size_t lo_ = (size_t)CLOW(c_) * MIXW; rq = LDNT((const u32x2*)(uni(Tq + lo_) + oq)); rk = LDNT((const u32x2*)(uni(Tk + lo_) + oq)); rv = LDNT((const u32x2*)(uni(Tv + lo_) + ovv)); } while (0)
#define SBARRIER() do { asm volatile("s_waitcnt lgkmcnt(0)" ::: "memory"); __builtin_amdgcn_s_barrier(); asm volatile("" ::: "memory"); } while (0)
        f32x4 S[8];
#pragma unroll
        for (int i = 0; i < 8; ++i) S[i] = (f32x4){0.f, 0.f, 0.f, 0.f};
        u32x2 rq, rk, rv;
        SBARRIER();
        SLOADC(0); scan_stage(lds, rq, rk, rv, wid, lane, tid); SLOADC(1);
        SBARRIER();
        for (int c = 0; c < 528; ++c) {
            LAS unsigned char* Bc = lds + (c & 1) * SC_BUF;
            if (c > 0) { const u32x2 ov = *(const LAS u32x2*)(lds + SC_OST + ((c - 1) & 1) * 4096 + vt_ * 256 + vc * 2); *(u32x2*)(uni(Od + (size_t)CLOW(c - 1) * MIXW) + ovv) = ov; }
            if (c + 1 < 528) { scan_stage(lds + ((c + 1) & 1) * SC_BUF, rq, rk, rv, wid, lane, tid); if (c + 2 < 528) SLOADC(c + 2); }
            bf16x8 qf[4], kf[4]; f32x4 e4[8]; s16x4 kt4[8];
#pragma unroll
            for (int ks = 0; ks < 4; ++ks) { qf[ks] = *(const LAS bf16x8*)(Bc + SC_QD + l16 * SC_PITCH + (32 * ks + 8 * g4) * 2); kf[ks] = *(const LAS bf16x8*)(Bc + SC_KD + l16 * SC_PITCH + (32 * ks + 8 * g4) * 2); }
            const int trb = ldsb + (c & 1) * SC_BUF + (4 * g4 + trq) * SC_PITCH + 8 * trp;
            const s16x4 vt = tr_read_v(trb + SC_VV + 32 * wid);
#pragma unroll
            for (int kt = 0; kt < 8; ++kt) { e4[kt] = *(const LAS f32x4*)(Bc + SC_EB + (16 * kt + 4 * g4) * 4); kt4[kt] = tr_read_v(trb + SC_KE + 32 * kt); }
            f32x4 at = (f32x4){0.f, 0.f, 0.f, 0.f};
#pragma unroll
            for (int ks = 0; ks < 4; ++ks) at = mfma16(kf[ks], qf[ks], at);
#pragma unroll
            for (int r = 0; r < 4; ++r) at[r] = (4 * g4 + r <= l16) ? at[r] : 0.f;
            bf16x8 pa; { v4u w; w.x = cvtpk(at[0], at[1]); w.y = cvtpk(at[2], at[3]); w.z = 0u; w.w = 0u; pa = __builtin_bit_cast(bf16x8, w); }
            f32x4 o = (f32x4){0.f, 0.f, 0.f, 0.f};
#pragma unroll
            for (int ks = 0; ks < 4; ++ks) { v4u w; w.x = cvtpk(S[2 * ks][0], S[2 * ks][1]); w.y = cvtpk(S[2 * ks][2], S[2 * ks][3]); w.z = cvtpk(S[2 * ks + 1][0], S[2 * ks + 1][1]); w.w = cvtpk(S[2 * ks + 1][2], S[2 * ks + 1][3]);
                o = mfma16(qf[ks], __builtin_bit_cast(bf16x8, w), o); }
            asm volatile("s_waitcnt lgkmcnt(0)" ::: "memory"); SBAR();
            const bf16x8 vf = (bf16x8){vt[0], vt[1], vt[2], vt[3], 0, 0, 0, 0};
            o = mfma16(pa, vf, o);
#pragma unroll
            for (int kt = 0; kt < 8; ++kt) { const bf16x8 kef = (bf16x8){kt4[kt][0], kt4[kt][1], kt4[kt][2], kt4[kt][3], 0, 0, 0, 0};
                S[kt] = mfma16(kef, vf, S[kt] * e4[kt]); }
            { LAS bf16* ost = (LAS bf16*)(lds + SC_OST + (c & 1) * 4096);
#pragma unroll
              for (int r = 0; r < 4; ++r) ost[(4 * g4 + r) * 128 + 16 * wid + l16] = (bf16)(cvtpk(o[r], 0.f) & 0xffffu); }
            SBARRIER();
        }
        { const u32x2 ov = *(const LAS u32x2*)(lds + SC_OST + (527 & 1) * 4096 + vt_ * 256 + vc * 2); *(u32x2*)(uni(Od + (size_t)CLOW(527) * MIXW) + ovv) = ov; }
#undef CLOW
#undef SLOADC
#undef SBARRIER
    }
    asm volatile("s_waitcnt lgkmcnt(0)" ::: "memory"); __builtin_amdgcn_s_barrier(); asm volatile("" ::: "memory");
}

__device__ __forceinline__ void readout_phase(KArgs a, int jc, int nrows, int G) {
    int tid_l = threadIdx.x; asm volatile("" : "+v"(tid_l)); const int tid = tid_l, lane = tid & 63, wave = __builtin_amdgcn_readfirstlane(tid >> 6);
    const int gw = blockIdx.x * NWAVES + wave, NGW = G * NWAVES;
    const size_t TS = (size_t)MTOT * MIXW;
    const bf16* OFp = (const bf16*)(a->ws + WS_OF); const bf16* OBp = OFp + TS; const bf16* GS = (const bf16*)(a->ws + WS_G1) + 4 * TS; bf16* CC = (bf16*)(a->ws + WS_CC);
    const float* gnw = a->in[20] + (size_t)jc * 128 + (lane & 15) * 8;
    const f32x4 w0 = *(const f32x4*)gnw, w1 = *(const f32x4*)(gnw + 4);
    for (int it = gw; it < nrows * 16; it += NGW) {
        const size_t off = (size_t)(it >> 4) * MIXW + (it & 15) * 512 + lane * 8;
        const v4u f = LDNT((const v4u*)(OFp + off)), bq = LDNT((const v4u*)(OBp + off)), gq = LDNT((const v4u*)(GS + off));
        float o[8], gg[8];
#pragma unroll
        for (int e = 0; e < 4; ++e) { o[2 * e] = bf_lo(f[e]) + bf_lo(bq[e]); o[2 * e + 1] = bf_hi(f[e]) + bf_hi(bq[e]); gg[2 * e] = bf_lo(gq[e]); gg[2 * e + 1] = bf_hi(gq[e]); }
        float ss = 0.f;
#pragma unroll
        for (int e = 0; e < 8; ++e) ss += o[e] * o[e];
        ss += __shfl_xor(ss, 1); ss += __shfl_xor(ss, 2); ss += __shfl_xor(ss, 4); ss += __shfl_xor(ss, 8);
        const float r = 1.0f / sqrtf(ss * (1.0f / 128.0f) + EPS);
        v4u w; w.x = cvtpk(o[0] * r * w0[0] * gg[0], o[1] * r * w0[1] * gg[1]); w.y = cvtpk(o[2] * r * w0[2] * gg[2], o[3] * r * w0[3] * gg[3]);
        w.z = cvtpk(o[4] * r * w1[0] * gg[4], o[5] * r * w1[1] * gg[5]); w.w = cvtpk(o[6] * r * w1[2] * gg[6], o[7] * r * w1[3] * gg[7]);
        *(v4u*)(CC + off) = w;
    }
}

#ifndef EN_P0
#define EN_P0 1
#endif
#ifndef EN_NORM
#define EN_NORM 1
#endif
#ifndef EN_A1
#define EN_A1 1
#endif
#ifndef EN_A2
#define EN_A2 1
#endif
#ifndef EN_A3
#define EN_A3 1
#endif
#ifndef EN_ATT
#define EN_ATT 1
#endif
#ifndef EN_A5
#define EN_A5 1
#endif
#ifndef EN_C1
#define EN_C1 1
#endif
#ifndef EN_SCAN
#define EN_SCAN 1
#endif
#ifndef EN_RO
#define EN_RO 1
#endif
#ifndef EN_C4
#define EN_C4 1
#endif
#ifndef EN_SGU
#define EN_SGU 1
#endif
#ifndef EN_QUP
#define EN_QUP 1
#endif
#ifndef EN_KVUP
#define EN_KVUP 1
#endif
#ifndef PG8_ALIGNV
#define PG8_ALIGNV true
#endif
#ifndef PG8_SP2V
#define PG8_SP2V true
#endif
#ifndef PROBE_MASK
#define PROBE_MASK 0u
#endif
#define REPS(k) for (int rep_ = 0; rep_ < ((((PROBE_MASK) >> (k)) & 1u) ? 2 : 1); ++rep_)
#ifndef MK_ONE_LAUNCH
#define MK_ONE_LAUNCH 1
#endif
constexpr int N_PHASES = 28;
#define IN(k) (lo <= (k) && (k) < hi)
#define SEAM(k) do { if (IN(k) && IN((k) + 1)) xcd_barrier(bar); } while (0)
template <int p> __device__ __forceinline__ void layer_pair(LAS unsigned char* lds, const int G, const int lo, const int hi, const XcdBarrier& bar) {

        const int pb = 2 + 13 * p, lab = 2 * p, lc = 2 * p + 1;
        if (EN_A1 && IN(pb + 0)) REPS(pb + 0) {
            KArgs A = kargs(); unsigned char* const wsb = A->ws;
            pg8::Gemm g{(const pg8::bf16_t*)(wsb + WS_H), (const pg8::bf16_t*)(wsb + WS_WIN_AB) + (size_t)p * N_AB * DM, MTOT, N_AB, DM, DM}; pg8::LockstepOrder S; S.init(MTOT, N_AB, G, (int)blockIdx.x);
            pg8::EpiAB1 E{(pg8::bf16_t*)(wsb + WS_G1), N_AB};
            pg8::gemm_phase<pg8::EpiAB1, pg8::LockstepOrder, PG8_ALIGNV, PG8_SP2V>(lds, g, S, E);
            if (p0_defer_on(G)) { pg8::LockstepOrder S2; S2.init(MTOT, N_AB, G, (int)blockIdx.x); p0_deferred(kargs(), lds, S2, p == 0 ? 0 : 2); }
        } SEAM(pb + 0);
        if (EN_A2 && IN(pb + 1)) REPS(pb + 1) { a2_rows(kargs(), p, G); } SEAM(pb + 1);
        if (EN_SGU && IN(pb + 2)) REPS(pb + 2) { sgu_phase(kargs(), p, lds, G); }
        if (EN_QUP && IN(pb + 3)) REPS(pb + 3) {
            KArgs A = kargs(); unsigned char* const wsb = A->ws;
            pg8::Gemm g{(const pg8::bf16_t*)(wsb + WS_QN), (const pg8::bf16_t*)(wsb + WS_WQ) + (size_t)p * NQ * QL, MTOT, NQ, QL, QL}; pg8::LockstepOrder S; S.init(MTOT, NQ, G, (int)blockIdx.x);
            pg8::EpiQ E{(pg8::bf16_t*)(wsb + WS_Q), (const pg8::f32x2*)(wsb + WS_ROPE), MLAT, 0.07216878364870322f * 1.4426950408889634f};
            pg8::gemm_phase<pg8::EpiQ, pg8::LockstepOrder, PG8_ALIGNV, PG8_SP2V>(lds, g, S, E);
        }
        if (EN_KVUP && IN(pb + 4)) REPS(pb + 4) {
            KArgs A = kargs(); unsigned char* const wsb = A->ws;
            pg8::Gemm g{(const pg8::bf16_t*)(wsb + WS_KVN), (const pg8::bf16_t*)(wsb + WS_WKV) + (size_t)p * NKV * KVL, MTOT, NKV, KVL, KVL}; pg8::LockstepOrder S; S.init(MTOT, NKV, G, (int)((blockIdx.x + 64u) % (unsigned)G));
            pg8::EpiKV E{(pg8::bf16_t*)(wsb + WS_KN), (pg8::bf16_t*)(wsb + WS_V), MTOT};
            pg8::gemm_phase<pg8::EpiKV, pg8::LockstepOrder, PG8_ALIGNV, PG8_SP2V>(lds, g, S, E);
        } SEAM(pb + 4);
        if (EN_ATT && IN(pb + 5)) REPS(pb + 5) { attn_phase(kargs(), lds, G); } SEAM(pb + 5);
        if (EN_A5 && IN(pb + 6)) REPS(pb + 6) {
            KArgs A = kargs(); unsigned char* const wsb = A->ws;
            { pg8::Gemm g{(const pg8::bf16_t*)(wsb + WS_CC), (const pg8::bf16_t*)(wsb + WS_WO_AB) + (size_t)p * DM * MIXW, MLAT, DM, MIXW, MIXW}; pg8::LockstepOrder S; S.init(MLAT, DM, G, (int)blockIdx.x);
              pg8::EpiBf16P E{(pg8::bf16_t*)(wsb + WS_Y), DM};
              pg8::gemm_phase<pg8::EpiBf16P, pg8::LockstepOrder, PG8_ALIGNV, PG8_SP2V>(lds, g, S, E); }
            { pg8::Gemm g{(const pg8::bf16_t*)(wsb + WS_CC) + (size_t)MLAT * MIXW, (const pg8::bf16_t*)(wsb + WS_WO_AB) + (size_t)p * DM * MIXW, MTOT - MLAT, DM, MIXW / 8, MIXW}; pg8::SplitKOrder S; S.init(MTOT - MLAT, DM, 8, G, (int)blockIdx.x);
              pg8::EpiF32 E{(float*)(wsb + WS_YP), DM, (size_t)(MTOT - MLAT) * DM};
              pg8::gemm_phase<pg8::EpiF32, pg8::SplitKOrder, PG8_ALIGNV, PG8_SP2V>(lds, g, S, E); }
        } SEAM(pb + 6);
        if (EN_NORM && IN(pb + 7)) REPS(pb + 7) { norm_phase(kargs(), lab, lc, G); } SEAM(pb + 7);
        if (EN_C1 && IN(pb + 8)) REPS(pb + 8) {
            KArgs A = kargs(); unsigned char* const wsb = A->ws;
            pg8::Gemm g{(const pg8::bf16_t*)(wsb + WS_H), (const pg8::bf16_t*)(wsb + WS_WIN_C) + (size_t)p * N_C * DM, MTOT, N_C, DM, DM}; pg8::LockstepOrder S; S.init(MTOT, N_C, G, (int)blockIdx.x);
            pg8::EpiC1 E{(pg8::bf16_t*)(wsb + WS_G1), (size_t)MTOT * MIXW, (const float*)(wsb + WS_OML) + (size_t)p * 2 * 8192};
            pg8::gemm_phase<pg8::EpiC1, pg8::LockstepOrder, PG8_ALIGNV, PG8_SP2V>(lds, g, S, E);
            if (p0_defer_on(G)) { pg8::LockstepOrder S2; S2.init(MTOT, N_C, G, (int)blockIdx.x); p0_deferred(kargs(), lds, S2, p == 0 ? 1 : 3); }
        } SEAM(pb + 8);
        if (EN_SCAN && IN(pb + 9)) REPS(pb + 9) { scan_phase(kargs(), lds, G); } SEAM(pb + 9);
        if (EN_RO && IN(pb + 10)) REPS(pb + 10) { readout_phase(kargs(), p, lc == 3 ? MLAT : MTOT, G); } SEAM(pb + 10);
        if (EN_C4 && IN(pb + 11)) REPS(pb + 11) {
            KArgs A = kargs(); unsigned char* const wsb = A->ws;
            { pg8::Gemm g{(const pg8::bf16_t*)(wsb + WS_CC), (const pg8::bf16_t*)(wsb + WS_WO_C) + (size_t)p * DM * MIXW, MLAT, DM, MIXW, MIXW}; pg8::LockstepOrder S; S.init(MLAT, DM, G, (int)blockIdx.x);
              pg8::EpiBf16P E{(pg8::bf16_t*)(wsb + WS_Y), DM};
              pg8::gemm_phase<pg8::EpiBf16P, pg8::LockstepOrder, PG8_ALIGNV, PG8_SP2V>(lds, g, S, E); }
            if (lc != 3) { pg8::Gemm g{(const pg8::bf16_t*)(wsb + WS_CC) + (size_t)MLAT * MIXW, (const pg8::bf16_t*)(wsb + WS_WO_C) + (size_t)p * DM * MIXW, MTOT - MLAT, DM, MIXW / 8, MIXW}; pg8::SplitKOrder S; S.init(MTOT - MLAT, DM, 8, G, (int)blockIdx.x);
              pg8::EpiF32 E{(float*)(wsb + WS_YP), DM, (size_t)(MTOT - MLAT) * DM};
              pg8::gemm_phase<pg8::EpiF32, pg8::SplitKOrder, PG8_ALIGNV, PG8_SP2V>(lds, g, S, E); }
        } SEAM(pb + 11);
        if (EN_NORM && IN(pb + 12)) REPS(pb + 12) { norm_phase(kargs(), lc, lc + 1, G); } SEAM(pb + 12);
    }
#undef IN
#undef SEAM
__global__ void __launch_bounds__(NWAVES * 64, 2) fwd(Args a) {
    extern __shared__ __attribute__((aligned(16))) unsigned char lds_raw[];
    LAS unsigned char* lds = (LAS unsigned char*)lds_raw;
    int tid_l = threadIdx.x; asm volatile("" : "+v"(tid_l)); const int tid = tid_l, G = gridDim.x;
    for (int u = tid; u < (LDS_BYTES - LDSCTL_OFF) / 4; u += NWAVES * 64) ((LAS unsigned*)(lds + LDSCTL_OFF))[u] = 0u;
    __syncthreads();
    XcdBarrier bar; bar.bar = (unsigned*)(a.ws + WS_CTL) + CW_BAR; bar.x = 0; bar.st = nullptr;
    if (MK_ONE_LAUNCH) bar = xcd_barrier_post((unsigned*)(a.ws + WS_CTL) + CW_BAR, (volatile LAS unsigned*)(lds + MISC_OFF));
    const int lo = a.ph_lo, hi = a.ph_hi;
#define IN(k) (lo <= (k) && (k) < hi)
#define SEAM(k) do { if (IN(k) && IN((k) + 1)) xcd_barrier(bar); } while (0)
    if (EN_P0 && IN(0)) REPS(0) { p0_prologue(kargs(), lds, G); } SEAM(0);
    if (EN_NORM && IN(1)) REPS(1) { norm_phase(kargs(), -1, 0, G); } SEAM(1);
    layer_pair<0>(lds, G, lo, hi, bar);
    layer_pair<1>(lds, G, lo, hi, bar);
#undef IN
#undef SEAM
}

extern "C" void kernel_launch(void* const* d_in, const int* in_sizes, int n_in, void* d_out, int out_size, void* d_ws, size_t ws_size, hipStream_t stream) {
    static int grid = 0;
    if (grid == 0) {
        if (n_in != 22 || out_size != MLAT * DM || ws_size < WS_END) { fprintf(stderr, "kernel_launch: unexpected shapes (n_in %d, out %d, ws %zu, need %zu)\n", n_in, out_size, ws_size, (size_t)WS_END); grid = -1; return; }
        int dev = 0, cus = 0, per_cu = 0;
        if (hipGetDevice(&dev) != hipSuccess || hipDeviceGetAttribute(&cus, hipDeviceAttributeMultiprocessorCount, dev) != hipSuccess) { grid = -1; return; }
        if (hipFuncSetAttribute((const void*)fwd, hipFuncAttributeMaxDynamicSharedMemorySize, LDS_BYTES) != hipSuccess) { fprintf(stderr, "kernel_launch: hipFuncSetAttribute failed\n"); grid = -1; return; }
        if (hipOccupancyMaxActiveBlocksPerMultiprocessor(&per_cu, (const void*)fwd, NWAVES * 64, LDS_BYTES) != hipSuccess || per_cu < 1) fprintf(stderr, "kernel_launch: occupancy query reports %d\n", per_cu);
        (void)hipGetLastError();
        grid = cus;
    }
    if (grid < 0) return;
    (void)hipMemsetAsync((char*)d_ws + WS_CTL, 0, 65536, stream);
    Args a{};
    for (int i = 0; i < 22; ++i) a.in[i] = (const float*)d_in[i];
    a.out = (float*)d_out; a.ws = (unsigned char*)d_ws;
#if MK_ONE_LAUNCH
    a.ph_lo = 0; a.ph_hi = N_PHASES;
    hipLaunchKernelGGL(fwd, dim3(grid), dim3(NWAVES * 64), LDS_BYTES, stream, a);
#else
    for (int p = 0; p < N_PHASES; ++p) { a.ph_lo = p; a.ph_hi = p + 1; hipLaunchKernelGGL(fwd, dim3(grid), dim3(NWAVES * 64), LDS_BYTES, stream, a); }
#endif
}
```

```cpp
#include <hip/hip_runtime.h>
#include <cstdio>
#include <cstdint>
namespace pg8 {
#define PG8_LAS __attribute__((address_space(3)))
typedef unsigned short bf16_t;
typedef short bf16x8 __attribute__((ext_vector_type(8)));
typedef float f32x4 __attribute__((ext_vector_type(4)));
typedef unsigned u32x4 __attribute__((ext_vector_type(4)));
constexpr int BM = 256, BK = 64, HALF = 128, HTB = HALF * BK * 2  , STAGE_BYTES = 8 * HTB, NXCD = 8, WGM = 4;

__host__ __device__ __forceinline__ int lds_byte(int r, int c) { const int st = (r >> 4) * 2 + (c >> 5), rr = r & 15, cc = c & 31, ob = rr * 64 + cc * 2; return st * 1024 + (ob ^ (((ob >> 9) & 1) << 5)); }
__host__ __device__ __forceinline__ void stage_rc(int b, int& R, int& C) { const int st = b / 1024, sb = b % 1024, swz = sb ^ (((sb >> 9) & 1) << 5); R = (st >> 1) * 16 + swz / 64; C = (st & 1) * 32 + (swz % 64) / 2; }
__host__ __device__ __forceinline__ int perm32(int rho) { const int n = rho >> 4, i = rho & 15; return 8 * (i >> 2) + 4 * n + (i & 3); }

struct Unit { int pm, pn, kc; };
struct Gemm { const bf16_t* A; const bf16_t* Bt; int M, N, K, ld; };

struct StaticOrder {
    int nM, nN, nwg, G, c;
    __host__ __device__ void init(int M, int N, int G_, int c_) { nM = M / BM; nN = N / BM; nwg = nM * nN; G = G_; c = c_; }
    __host__ __device__ bool next(int i, Unit& u) const {
        const long L = (long)i * G + c; if (L >= nwg) return false;
        int wgid = (int)L; { const int q = nwg / NXCD, r = nwg % NXCD, xcd = wgid % NXCD, off = wgid / NXCD; wgid = (xcd < r ? xcd * (q + 1) : r * (q + 1) + (xcd - r) * q) + off; }
        const int nig = WGM * nN, gid = wgid / nig, fm = gid * WGM, gsz = (nM - fm) < WGM ? (nM - fm) : WGM;
        u.pm = fm + ((wgid % nig) % gsz); u.pn = (wgid % nig) / gsz; u.kc = 0; return true;
    }
    __device__ __forceinline__ void a_ready(const Unit&) const {}
    __device__ __forceinline__ void done(const Unit&) const {}
};
struct LockstepOrder {
    static constexpr int LW = 4;
    int nM, nN, G, c, x, k, nk, PG, r0, gR, qR, rR, lenx;
    __host__ __device__ void init(int M, int N, int G_, int c_) { nM = M / BM; nN = N / BM; G = G_; c = c_; x = c_ % NXCD; k = c_ / NXCD; nk = G_ / NXCD; PG = (nM / LW) / NXCD; r0 = PG * NXCD * LW; gR = nM - r0;
        const int rem = gR * nN; qR = rem / NXCD; rR = rem % NXCD; lenx = PG * LW * nN + qR + (x < rR ? 1 : 0); }
    __host__ __device__ bool next(int i, Unit& u) const {
        if (G % NXCD != 0) { const long L = (long)i * G + c; if (L >= (long)nM * nN) return false; u.kc = 0; u.pm = (int)(L / nN); u.pn = (int)(L % nN); return true; }
        const int off = i * nk + k; if (off >= lenx) return false; u.kc = 0;
        const int lock = PG * LW * nN;
        if (off < lock) { const int j = off / (LW * nN), o2 = off % (LW * nN); u.pm = (j * NXCD + x) * LW + o2 % LW; u.pn = o2 / LW; }
        else { const int rho = (x < rR ? x * (qR + 1) : rR * (qR + 1) + (x - rR) * qR) + (off - lock); u.pm = r0 + rho % gR; u.pn = rho / gR; }
        return true;
    }
    __device__ __forceinline__ void a_ready(const Unit&) const {}
    __device__ __forceinline__ void done(const Unit&) const {}
};
struct SplitKOrder {
    int nM, nN, KS, nwg, G, c;
    __host__ __device__ void init(int M, int N, int KS_, int G_, int c_) { nM = M / BM; nN = N / BM; KS = KS_; nwg = nM * nN * KS; G = G_; c = c_; }
    __host__ __device__ bool next(int i, Unit& u) const { const long L = (long)i * G + c; if (L >= nwg) return false; const int l = (int)L; u.kc = l % KS; u.pn = (l / KS) % nN; u.pm = l / (KS * nN); return true; }
    __device__ __forceinline__ void a_ready(const Unit&) const {}
    __device__ __forceinline__ void done(const Unit&) const {}
};

typedef float f32x2 __attribute__((ext_vector_type(2)));
typedef __bf16 bf16x2_c __attribute__((ext_vector_type(2)));
__device__ __forceinline__ unsigned cvt_pk_bf16(float lo, float hi) { const f32x2 v = {lo, hi}; const bf16x2_c b = __builtin_convertvector(v, bf16x2_c); return __builtin_bit_cast(unsigned, b); }
__device__ __forceinline__ f32x2 gelu_pk(f32x2 v) {
    const f32x2 av = __builtin_elementwise_abs(v), d = av * 0.2316418882f + 1.0f;
    f32x2 t; t.x = __builtin_amdgcn_rcpf(d.x); t.y = __builtin_amdgcn_rcpf(d.y);
    f32x2 q = t * 0.5307027145f + (-0.7265760135f); q = q * t + 0.7107068705f; q = q * t + (-0.142248368f); q = q * t + 0.127414796f; q = q * t;
    const f32x2 s = (v * v) * (-0.72134752044f);
    f32x2 e; e.x = __builtin_amdgcn_exp2f(s.x); e.y = __builtin_amdgcn_exp2f(s.y);
    const f32x2 m = v * (q * e), r = v - m;
    f32x2 o; o.x = v.x < 0.f ? m.x : r.x; o.y = v.y < 0.f ? m.y : r.y; return o;
}

typedef unsigned u32x2 __attribute__((ext_vector_type(2)));
__device__ __forceinline__ float silu_f(float x) { return x * __builtin_amdgcn_rcpf(1.0f + __builtin_amdgcn_exp2f(-1.4426950408889634f * x)); }
__device__ __forceinline__ float sigmoid_neg_f(float x) { return __builtin_amdgcn_rcpf(1.0f + __builtin_amdgcn_exp2f(1.4426950408889634f * x)); }
__device__ __forceinline__ f32x4 act4(f32x4 v, int act) {
    if (act == 1) { v[0] = silu_f(v[0]); v[1] = silu_f(v[1]); v[2] = silu_f(v[2]); v[3] = silu_f(v[3]); }
    else if (act == 2) { const f32x2 a = gelu_pk((f32x2){v[0], v[1]}), b = gelu_pk((f32x2){v[2], v[3]}); v = (f32x4){a.x, a.y, b.x, b.y}; }
    return v;
}
struct EpiF32 {
    static constexpr bool PERM = false, AFTER_DRAIN = false;
    float* C0; int ldc; size_t kstride;
    __device__ __forceinline__ void operator()(const f32x4 (&acc)[2][2][4][2], const Unit& u, int wr, int wc, int fr, int fq) const {
        float* C = C0 + (size_t)u.kc * kstride;
        const int row0 = u.pm * BM + wr * 64 + fr, col0 = u.pn * BM + wc * 32 + 4 * fq;
#pragma unroll
        for (int ai = 0; ai < 2; ++ai)
#pragma unroll
            for (int m = 0; m < 4; ++m) { float* rowp = C + (size_t)(row0 + ai * HALF + m * 16) * ldc + col0;
#pragma unroll
                for (int bj = 0; bj < 2; ++bj)
#pragma unroll
                    for (int n = 0; n < 2; ++n) *(f32x4*)(rowp + bj * HALF + n * 16) = acc[ai][bj][m][n]; }
    }
};
struct EpiBf16P {
    static constexpr bool PERM = true, AFTER_DRAIN = false;
    bf16_t* O; int ldc;
    __device__ __forceinline__ void operator()(const f32x4 (&acc)[2][2][4][2], const Unit& u, int wr, int wc, int fr, int fq) const {
        const int row0 = u.pm * BM + wr * 64 + fr, col0 = u.pn * BM + wc * 32 + 8 * fq;
#pragma unroll
        for (int ai = 0; ai < 2; ++ai)
#pragma unroll
            for (int m = 0; m < 4; ++m) { bf16_t* rowp = O + (size_t)(row0 + ai * HALF + m * 16) * ldc + col0;
#pragma unroll
                for (int bj = 0; bj < 2; ++bj) { const f32x4 v0 = acc[ai][bj][m][0], v1 = acc[ai][bj][m][1];
                    u32x4 w; w.x = cvt_pk_bf16(v0[0], v0[1]); w.y = cvt_pk_bf16(v0[2], v0[3]); w.z = cvt_pk_bf16(v1[0], v1[1]); w.w = cvt_pk_bf16(v1[2], v1[3]);
                    *(u32x4*)(rowp + bj * HALF) = w; } }
    }
};
struct EpiAB1 {
    static constexpr bool PERM = true, AFTER_DRAIN = false;
    bf16_t* O; int ldc;
    __device__ __forceinline__ void operator()(const f32x4 (&acc)[2][2][4][2], const Unit& u, int wr, int wc, int fr, int fq) const {
        const int act = u.pn < 7 ? 0 : ((u.pn < 23 || u.pn >= 55) ? 1 : 2);
        const int row0 = u.pm * BM + wr * 64 + fr, col0 = u.pn * BM + wc * 32 + 8 * fq;
#pragma unroll
        for (int ai = 0; ai < 2; ++ai)
#pragma unroll
            for (int m = 0; m < 4; ++m) { bf16_t* rowp = O + (size_t)(row0 + ai * HALF + m * 16) * ldc + col0;
#pragma unroll
                for (int bj = 0; bj < 2; ++bj) { const f32x4 v0 = act4(acc[ai][bj][m][0], act), v1 = act4(acc[ai][bj][m][1], act);
                    u32x4 w; w.x = cvt_pk_bf16(v0[0], v0[1]); w.y = cvt_pk_bf16(v0[2], v0[3]); w.z = cvt_pk_bf16(v1[0], v1[1]); w.w = cvt_pk_bf16(v1[2], v1[3]);
                    *(u32x4*)(rowp + bj * HALF) = w; } }
    }
};
struct EpiC1 {
    static constexpr bool PERM = true, AFTER_DRAIN = false;
    bf16_t* O; size_t stride; const float* oml;
    __device__ __forceinline__ void operator()(const f32x4 (&acc)[2][2][4][2], const Unit& u, int wr, int wc, int fr, int fq) const {
        const int region = u.pn >> 5; bf16_t* base = O + (size_t)region * stride;
        const int row0 = u.pm * BM + wr * 64 + fr, col0 = (u.pn & 31) * BM + wc * 32 + 8 * fq;
        const bool gate = (region == 1 || region == 2); const int act = (region == 0 || region == 4) ? 1 : 0;
        f32x4 gv[2][2];
#pragma unroll
        for (int bj = 0; bj < 2; ++bj)
#pragma unroll
            for (int n = 0; n < 2; ++n) gv[bj][n] = gate ? *(const f32x4*)(oml + (size_t)(region - 1) * 8192 + col0 + bj * HALF + 4 * n) : (f32x4){1.f, 1.f, 1.f, 1.f};
#pragma unroll
        for (int ai = 0; ai < 2; ++ai)
#pragma unroll
            for (int m = 0; m < 4; ++m) { bf16_t* rowp = base + (size_t)(row0 + ai * HALF + m * 16) * 8192 + col0;
#pragma unroll
                for (int bj = 0; bj < 2; ++bj) { f32x4 v0 = acc[ai][bj][m][0], v1 = acc[ai][bj][m][1];
                    if (gate) {
#pragma unroll
                        for (int j = 0; j < 4; ++j) { v0[j] = gv[bj][0][j] * sigmoid_neg_f(v0[j]); v1[j] = gv[bj][1][j] * sigmoid_neg_f(v1[j]); } }
                    else { v0 = act4(v0, act); v1 = act4(v1, act); }
                    u32x4 w; w.x = cvt_pk_bf16(v0[0], v0[1]); w.y = cvt_pk_bf16(v0[2], v0[3]); w.z = cvt_pk_bf16(v1[0], v1[1]); w.w = cvt_pk_bf16(v1[2], v1[3]);
                    *(u32x4*)(rowp + bj * HALF) = w; } }
    }
};
struct EpiQ {
    static constexpr bool PERM = true, AFTER_DRAIN = false;
    bf16_t* O; const f32x2* rope; int nlat; float qscale;
    __device__ __forceinline__ void operator()(const f32x4 (&acc)[2][2][4][2], const Unit& u, int wr, int wc, int fr, int fq) const {
        const int row0 = u.pm * BM + wr * 64 + fr; const bool upper = fq >= 2;
#pragma unroll
        for (int bj = 0; bj < 2; ++bj) {
            const int G = 8 * u.pn + 4 * bj + wc, hm = G % 6, col = u.pn * BM + bj * HALF + wc * 32 + 8 * fq;
#pragma unroll
            for (int ai = 0; ai < 2; ++ai)
#pragma unroll
                for (int m = 0; m < 4; ++m) { const int row = row0 + ai * HALF + m * 16; f32x4 x0 = acc[ai][bj][m][0], x1 = acc[ai][bj][m][1];
                    if (hm >= 4 && u.pm * BM < nlat) {
                        const int t = row & 8191, pos = (hm == 4) ? (t >> 6) : (t & 63); const f32x2* cs = rope + pos * 16 + 8 * (fq & 1);
#pragma unroll
                        for (int j = 0; j < 4; ++j) {
                            { auto rr = __builtin_amdgcn_permlane32_swap(__float_as_uint(x0[j]), __float_as_uint(x0[j]), false, false); const float pv = __uint_as_float(upper ? rr[0] : rr[1]); const f32x2 c = cs[j];
                              x0[j] = upper ? x0[j] * c.x + pv * c.y : x0[j] * c.x - pv * c.y; }
                            { auto rr = __builtin_amdgcn_permlane32_swap(__float_as_uint(x1[j]), __float_as_uint(x1[j]), false, false); const float pv = __uint_as_float(upper ? rr[0] : rr[1]); const f32x2 c = cs[4 + j];
                              x1[j] = upper ? x1[j] * c.x + pv * c.y : x1[j] * c.x - pv * c.y; } } }
                    x0 = x0 * qscale; x1 = x1 * qscale;
                    u32x4 w; w.x = cvt_pk_bf16(x0[0], x0[1]); w.y = cvt_pk_bf16(x0[2], x0[3]); w.z = cvt_pk_bf16(x1[0], x1[1]); w.w = cvt_pk_bf16(x1[2], x1[3]);
                    *(u32x4*)(O + (size_t)row * 6144 + col) = w; }
        }
    }
};
struct EpiKV {
    static constexpr bool PERM = true, AFTER_DRAIN = false;
    bf16_t* KN; bf16_t* V; int mtot;
    __device__ __forceinline__ void operator()(const f32x4 (&acc)[2][2][4][2], const Unit& u, int wr, int wc, int fr, int fq) const {
        const int row0 = u.pm * BM + wr * 64 + fr, colh = wc * 32 + 8 * fq;
#pragma unroll
        for (int ai = 0; ai < 2; ++ai)
#pragma unroll
            for (int m = 0; m < 4; ++m) { const size_t off = ((size_t)u.pn * mtot + (size_t)(row0 + ai * HALF + m * 16)) * 128 + colh;
#pragma unroll
                for (int bj = 0; bj < 2; ++bj) { const f32x4 v0 = acc[ai][bj][m][0], v1 = acc[ai][bj][m][1];
                    u32x4 w; w.x = cvt_pk_bf16(v0[0], v0[1]); w.y = cvt_pk_bf16(v0[2], v0[3]); w.z = cvt_pk_bf16(v1[0], v1[1]); w.w = cvt_pk_bf16(v1[2], v1[3]);
                    *(u32x4*)((bj ? V : KN) + off) = w; } }
    }
};

template <class Epi, class Sched, bool ALIGN_EPI = false, bool SP2 = false>
__device__ __forceinline__ void gemm_phase(PG8_LAS unsigned char* lds, const Gemm g, const Sched& S, const Epi& E) {
    int tid_l = threadIdx.x; asm volatile("" : "+v"(tid_l)); const int tid = tid_l, wid = __builtin_amdgcn_readfirstlane(tid >> 6), lane = tid & 63, wr = wid >> 2, wc = wid & 3, fr = lane & 15, fq = lane >> 4;
    const int K = g.ld, nt = g.K / BK;
    unsigned voffA[2], voffB[2];
#pragma unroll
    for (int i = 0; i < 2; ++i) { int R, C; stage_rc(tid * 16 + i * 8192, R, C); const int Rb = Epi::PERM ? ((R & ~31) + perm32(R & 31)) : R;
        voffA[i] = (unsigned)(R * K + C) * 2u; voffB[i] = (unsigned)(Rb * K + C) * 2u; }
    const size_t kstep = (size_t)(BK * 2);
    const size_t hstep = (size_t)HALF * K * 2;
    const size_t tstep = 2 * hstep;
    const unsigned ldsw = (unsigned)wid * 1024u;
    const int aoff = lds_byte(wr * 64 + fr, fq * 8), boff = lds_byte(wc * 32 + fr, fq * 8);
#define PG8_SA(b, h) (((b) * 2 + (h)) * HTB)
#define PG8_SB(b, h) ((4 + (b) * 2 + (h)) * HTB)
#define PG8_STAGE(bufoff, gbase, voff) do { const char* gb_ = (const char*)(gbase); asm volatile("" : "+s"(gb_)); _Pragma("unroll") for (int _i = 0; _i < 2; ++_i) { unsigned vo_ = (voff)[_i]; asm volatile("" : "+v"(vo_)); \
        __builtin_amdgcn_global_load_lds((const unsigned*)(gb_ + vo_), (PG8_LAS unsigned*)(lds + (bufoff) + ldsw + _i * 8192), 16, 0, 0); } } while (0)
#define PG8_LDA(dst, b, h) do { _Pragma("unroll") for (int m = 0; m < 4; ++m) _Pragma("unroll") for (int k = 0; k < 2; ++k) dst[m][k] = *(const PG8_LAS bf16x8*)(lds + PG8_SA(b, h) + aoff + m * 2048 + k * 1024); } while (0)
#define PG8_LDB(dst, b, h) do { _Pragma("unroll") for (int n = 0; n < 2; ++n) _Pragma("unroll") for (int k = 0; k < 2; ++k) dst[n][k] = *(const PG8_LAS bf16x8*)(lds + PG8_SB(b, h) + boff + n * 2048 + k * 1024); } while (0)
#define PG8_MMA(ai, bj, At, Bt) do { __builtin_amdgcn_sched_barrier(0); _Pragma("unroll") for (int m = 0; m < 4; ++m) _Pragma("unroll") for (int n = 0; n < 2; ++n) _Pragma("unroll") for (int k = 0; k < 2; ++k) \
        acc[ai][bj][m][n] = __builtin_amdgcn_mfma_f32_16x16x32_bf16(Bt[n][k], At[m][k], acc[ai][bj][m][n], 0, 0, 0); __builtin_amdgcn_sched_barrier(0); } while (0)
#define PG8_WAIT_V(n) asm volatile("s_waitcnt vmcnt(" #n ")" ::: "memory")
#define PG8_WAIT_L(n) asm volatile("s_waitcnt lgkmcnt(" #n ")" ::: "memory")
#define PG8_BAR __builtin_amdgcn_s_barrier()
#define PG8_SCHED __builtin_amdgcn_sched_barrier(0)
    if (wr == 0) __builtin_amdgcn_s_setprio(1);
    Unit cur, nxt; int ui = 0;
    if (!S.next(0, cur)) { __builtin_amdgcn_s_setprio(0); return; }
    f32x4 acc[2][2][4][2];
#pragma unroll
    for (int a = 0; a < 2; ++a)
#pragma unroll
        for (int b = 0; b < 2; ++b)
#pragma unroll
            for (int m = 0; m < 4; ++m)
#pragma unroll
                for (int n = 0; n < 2; ++n) acc[a][b][m][n] = (f32x4){0.f, 0.f, 0.f, 0.f};
    bf16x8 At[4][2], B0[2][2], B1[2][2];
    const size_t kcb = (size_t)g.K * 2;
    const char* cA = (const char*)g.A + (size_t)cur.pm * tstep + cur.kc * kcb; const char* cB = (const char*)g.Bt + (size_t)cur.pn * tstep + cur.kc * kcb;
    S.a_ready(cur);
    if constexpr (SP2) {
        PG8_STAGE(PG8_SB(0, 0), cB, voffB); PG8_STAGE(PG8_SB(0, 1), cB + hstep, voffB); PG8_STAGE(PG8_SA(0, 0), cA, voffA); PG8_STAGE(PG8_SA(0, 1), cA + hstep, voffA);
        if (wr == 1) PG8_BAR;
        PG8_WAIT_V(2); PG8_BAR;
        PG8_STAGE(PG8_SB(1, 0), cB + kstep, voffB); PG8_STAGE(PG8_SA(1, 0), cA + kstep, voffA); PG8_STAGE(PG8_SB(1, 1), cB + hstep + kstep, voffB);
        PG8_WAIT_V(6); PG8_BAR;
    } else {
        PG8_STAGE(PG8_SB(0, 0), cB, voffB); PG8_STAGE(PG8_SA(0, 0), cA, voffA); PG8_STAGE(PG8_SB(0, 1), cB + hstep, voffB); PG8_STAGE(PG8_SA(0, 1), cA + hstep, voffA);
        if (wr == 1) PG8_BAR;
        PG8_WAIT_V(4); PG8_BAR;
        PG8_STAGE(PG8_SB(1, 0), cB + kstep, voffB); PG8_STAGE(PG8_SA(1, 0), cA + kstep, voffA); PG8_STAGE(PG8_SB(1, 1), cB + hstep + kstep, voffB);
        PG8_WAIT_V(6); PG8_BAR;
    }
    for (;;) {
        const bool has_next = S.next(ui + 1, nxt);
        const char* nA = has_next ? (const char*)g.A + (size_t)nxt.pm * tstep + nxt.kc * kcb : cA; const char* nB = has_next ? (const char*)g.Bt + (size_t)nxt.pn * tstep + nxt.kc * kcb : cB;
        for (int t = 0; t < nt; t += 2) {
            const bool last = (t == nt - 2);
            const char* a1 = cA + (size_t)(t + 1) * kstep;
            const char* a2 = last ? nA : cA + (size_t)(t + 2) * kstep; const char* b2 = last ? nB : cB + (size_t)(t + 2) * kstep;
            const char* a3 = a2 + kstep; const char* b3 = b2 + kstep;
            if (last && has_next) S.a_ready(nxt);
            if constexpr (SP2) {
            PG8_LDB(B0, 0, 0); PG8_LDB(B1, 0, 1); PG8_SCHED; PG8_LDA(At, 0, 0); PG8_STAGE(PG8_SA(1, 1), a1 + hstep, voffA);
            PG8_WAIT_V(8); PG8_WAIT_L(0); PG8_BAR; PG8_MMA(0, 0, At, B0); PG8_MMA(0, 1, At, B1); PG8_BAR; PG8_SCHED;
            PG8_LDA(At, 0, 1); PG8_STAGE(PG8_SB(0, 0), b2, voffB); PG8_STAGE(PG8_SB(0, 1), b2 + hstep, voffB); PG8_STAGE(PG8_SA(0, 0), a2, voffA);
            PG8_WAIT_V(8); PG8_WAIT_L(0); PG8_BAR; PG8_MMA(1, 0, At, B0); PG8_MMA(1, 1, At, B1); PG8_BAR; PG8_SCHED;
            PG8_LDB(B0, 1, 0); PG8_LDB(B1, 1, 1); PG8_SCHED; PG8_LDA(At, 1, 0); PG8_STAGE(PG8_SA(0, 1), a2 + hstep, voffA);
            PG8_WAIT_V(8); PG8_WAIT_L(0); PG8_BAR; PG8_MMA(0, 0, At, B0); PG8_MMA(0, 1, At, B1); PG8_BAR; PG8_SCHED;
            PG8_LDA(At, 1, 1); PG8_STAGE(PG8_SB(1, 0), b3, voffB); PG8_STAGE(PG8_SB(1, 1), b3 + hstep, voffB); PG8_STAGE(PG8_SA(1, 0), a3, voffA);
            PG8_WAIT_V(8); PG8_WAIT_L(0); PG8_BAR; PG8_MMA(1, 0, At, B0); PG8_MMA(1, 1, At, B1); PG8_BAR; PG8_SCHED;
            } else {
            PG8_LDB(B0, 0, 0); PG8_SCHED; PG8_LDA(At, 0, 0); PG8_STAGE(PG8_SA(1, 1), a1 + hstep, voffA);
            PG8_WAIT_L(8); PG8_BAR; PG8_WAIT_L(0); PG8_MMA(0, 0, At, B0); PG8_BAR; PG8_SCHED;
            PG8_LDB(B1, 0, 1); PG8_STAGE(PG8_SB(0, 0), b2, voffB);
            PG8_BAR; PG8_WAIT_L(0); PG8_MMA(0, 1, At, B1); PG8_BAR;
            PG8_LDA(At, 0, 1); PG8_STAGE(PG8_SA(0, 0), a2, voffA);
            PG8_BAR; PG8_WAIT_L(0); PG8_MMA(1, 0, At, B0); PG8_BAR; PG8_SCHED;
            PG8_STAGE(PG8_SB(0, 1), b2 + hstep, voffB);
            PG8_WAIT_V(6); PG8_BAR; PG8_MMA(1, 1, At, B1); PG8_BAR;
            PG8_LDB(B0, 1, 0); PG8_SCHED; PG8_LDA(At, 1, 0); PG8_STAGE(PG8_SA(0, 1), a2 + hstep, voffA);
            PG8_WAIT_L(8); PG8_BAR; PG8_WAIT_L(0); PG8_MMA(0, 0, At, B0); PG8_BAR; PG8_SCHED;
            PG8_LDB(B1, 1, 1); PG8_STAGE(PG8_SB(1, 0), b3, voffB);
            PG8_BAR; PG8_WAIT_L(0); PG8_MMA(0, 1, At, B1); PG8_BAR;
            PG8_LDA(At, 1, 1); PG8_STAGE(PG8_SA(1, 0), a3, voffA);
            PG8_BAR; PG8_WAIT_L(0); PG8_MMA(1, 0, At, B0); PG8_BAR; PG8_SCHED;
            PG8_STAGE(PG8_SB(1, 1), b3 + hstep, voffB);
            PG8_WAIT_V(6); PG8_BAR; PG8_MMA(1, 1, At, B1); PG8_BAR;
            }
        }
        if constexpr (ALIGN_EPI) { if (wr == 0) PG8_BAR; }
        if constexpr (!Epi::AFTER_DRAIN) { E(acc, cur, wr, wc, fr, fq); S.done(cur); }
        if (!has_next) break;
#pragma unroll
        for (int a = 0; a < 2; ++a)
#pragma unroll
            for (int b = 0; b < 2; ++b)
#pragma unroll
                for (int m = 0; m < 4; ++m)
#pragma unroll
                    for (int n = 0; n < 2; ++n) acc[a][b][m][n] = (f32x4){0.f, 0.f, 0.f, 0.f};
        cur = nxt; cA = nA; cB = nB; ++ui;
        if constexpr (ALIGN_EPI) { if (wr == 1) PG8_BAR; }
    }
    PG8_WAIT_V(0);
    if constexpr (!ALIGN_EPI) { if (wr == 0) PG8_BAR; }
    PG8_BAR;
    if constexpr (Epi::AFTER_DRAIN) { E.fused(acc, cur, wr, wc, fr, fq, lds, wid, lane); S.done(cur); }
    __builtin_amdgcn_s_setprio(0);
#undef PG8_SA
#undef PG8_SB
#undef PG8_STAGE
#undef PG8_LDA
#undef PG8_LDB
#undef PG8_MMA
#undef PG8_WAIT_V
#undef PG8_WAIT_L
#undef PG8_BAR
#undef PG8_SCHED
}
}
#define GAS __attribute__((address_space(1)))
#define LAS __attribute__((address_space(3)))
typedef unsigned short bf16;
typedef unsigned v4u __attribute__((ext_vector_type(4)));
typedef float f32x4 __attribute__((ext_vector_type(4)));
typedef short bf16x8 __attribute__((ext_vector_type(8)));
typedef GAS unsigned gu32;
typedef GAS unsigned long long gu64;
#define RLX_AGENT __ATOMIC_RELAXED, __HIP_MEMORY_SCOPE_AGENT
#define LDS_WAIT() asm volatile("s_waitcnt lgkmcnt(0)" ::: "memory")
#define VM_WAIT() asm volatile("s_waitcnt vmcnt(0)" ::: "memory")
__device__ __forceinline__ unsigned long long rt() { return __builtin_amdgcn_s_memrealtime(); }
__device__ __forceinline__ unsigned f2bf(float f) { unsigned u = __builtin_bit_cast(unsigned, f); return (u + 0x7fffu + ((u >> 16) & 1u)) >> 16; }
__device__ __forceinline__ unsigned pk2(float lo, float hi) { return f2bf(lo) | (f2bf(hi) << 16); }

typedef unsigned u32x2 __attribute__((ext_vector_type(2)));
typedef float f32x2 __attribute__((ext_vector_type(2)));
#define XB_TMO      128
#define XB_XCNT(j)  (256  + 64 * (j))
#define XB_XSUB(j)  (1280 + 64 * (j))
#define XB_XGEN(j)  (2304 + 64 * (j))
#define XB_TOP      3328
#define XB_TOPGEN   3392
#define XCD_BAR_WORDS 3456
#define XB_SPIN_CAP (1u << 21)

__device__ __forceinline__ unsigned xb_ld(unsigned* p)              { return __hip_atomic_load(p, __ATOMIC_RELAXED, __HIP_MEMORY_SCOPE_AGENT); }
__device__ __forceinline__ unsigned xb_add(unsigned* p, unsigned v) { return __hip_atomic_fetch_add(p, v, __ATOMIC_RELAXED, __HIP_MEMORY_SCOPE_AGENT); }
__device__ __forceinline__ unsigned xb_xcc_id() { return (unsigned)__builtin_amdgcn_s_getreg((3 << 11) | 20) & 0xFu; }
#define XB_SPIN(cond, bar) do { unsigned _sp = 0; while (cond) { __builtin_amdgcn_s_sleep(1); \
    if ((++_sp & 255u) == 0u) { if (xb_ld(&(bar)[XB_TMO])) break; if (_sp > XB_SPIN_CAP) { atomicAdd(&(bar)[XB_TMO], 1u); break; } } } } while (0)

struct XcdBarrier {
    unsigned* bar; unsigned x;
    volatile LAS unsigned* st;
};

__device__ __forceinline__ XcdBarrier xcd_barrier_post(unsigned* bar, volatile LAS unsigned* st) {
    XcdBarrier b; b.bar = bar; b.x = xb_xcc_id(); b.st = st;
    if (threadIdx.x == 0) (void)xb_add(&bar[XB_XCNT(b.x)], 1u);
    return b;
}
__device__ __forceinline__ void xcd_barrier_complete(unsigned* bar, unsigned x, unsigned& nloc, unsigned& nx) {
    const unsigned G = gridDim.x * gridDim.y * gridDim.z;
    unsigned sum, cnt, mine, sp = 0u;
    for (;;) {
        sum = 0u; cnt = 0u; mine = 0u;
#pragma unroll
        for (unsigned j = 0; j < 16; ++j) { const unsigned c = xb_ld(&bar[XB_XCNT(j)]); sum += c; cnt += (c > 0u) ? 1u : 0u; mine = (j == x) ? c : mine; }
        if (sum == G) break;
        __builtin_amdgcn_s_sleep(1);
        if ((++sp & 255u) == 0u) { if (xb_ld(&bar[XB_TMO])) break; if (sp > XB_SPIN_CAP) { atomicAdd(&bar[XB_TMO], 1u); break; } }
    }
    nloc = mine > 0u ? mine : 1u; nx = cnt > 0u ? cnt : 1u;
}

__device__ __forceinline__ void xcd_barrier(const XcdBarrier& b) {
    asm volatile("s_waitcnt vmcnt(0)" ::: "memory");
    __syncthreads();
    if (threadIdx.x == 0) {
        unsigned* bar = b.bar;
        __builtin_amdgcn_s_waitcnt(0);
        unsigned nloc = b.st[0], nx = b.st[1];
        if (nloc == 0u) { xcd_barrier_complete(bar, b.x, nloc, nx); b.st[0] = nloc; b.st[1] = nx; }
        const unsigned old = xb_add(&bar[XB_XSUB(b.x)], 1u);
        const unsigned gen = old / nloc;
        if (old + 1u == (gen + 1u) * nloc) {
            __builtin_amdgcn_fence(__ATOMIC_RELEASE, "agent");
            asm volatile("s_waitcnt vmcnt(0)" ::: "memory");
            const unsigned og = xb_add(&bar[XB_TOP], 1u);
            const unsigned tg = og / nx;
            if (og + 1u == (tg + 1u) * nx) xb_add(&bar[XB_TOPGEN], 1u);
            else XB_SPIN(xb_ld(&bar[XB_TOPGEN]) == tg, bar);
            __builtin_amdgcn_fence(__ATOMIC_ACQUIRE, "agent");
            xb_add(&bar[XB_XGEN(b.x)], 1u);
            asm volatile("s_waitcnt vmcnt(0)" ::: "memory");
        } else {
            XB_SPIN(xb_ld(&bar[XB_XGEN(b.x)]) == gen, bar);
            __builtin_amdgcn_fence(__ATOMIC_ACQUIRE, "agent");
            asm volatile("s_waitcnt vmcnt(0)" ::: "memory");
        }
    }
    __syncthreads();
}


#ifndef NT_STREAMS
#define NT_STREAMS 1
#endif
#if NT_STREAMS
#define LDNT(p) __builtin_nontemporal_load(p)
#define STNT(p, v) __builtin_nontemporal_store((v), (p))
#else
#define LDNT(p) (*(p))
#define STNT(p, v) (*(p) = (v))
#endif
constexpr int NWAVES = 8;
constexpr int DM = 4096, NBATCH = 2, SEQ = 8192, NCTX = 256;
constexpr int MLAT = NBATCH * SEQ;
constexpr int MTOT = MLAT + NBATCH * NCTX;
constexpr int N_AB = 18176;
constexpr int N_ABSRC = 17984, N_C = 40960, MIXW = 8192;
constexpr int QL = 1024, KVL = 512, NQ = 6144, NKV = 8192;
constexpr int G1_CKV = 1024, G1_KR = 1536, G1_ZA = 1792, G1_UB = 5888, G1_VB = 9984, G1_ZB = 14080;
constexpr float EPS = 1e-6f;

constexpr size_t al256(size_t x) { return (x + 255) & ~(size_t)255; }
constexpr size_t WS_CTL = 0, CTL_ZERO_BYTES = 1u << 20;
constexpr size_t WS_MOD  = CTL_ZERO_BYTES;
constexpr size_t WS_OML  = WS_MOD  + al256((size_t)4 * 3 * 12288 * 4);
constexpr size_t WS_ROPE = WS_OML  + al256((size_t)2 * 2 * 8192 * 4);
constexpr size_t WS_STAT = WS_ROPE + al256((size_t)128 * 16 * 8);
constexpr size_t WS_WIN_AB = WS_STAT + al256((size_t)MTOT * 8);
constexpr size_t WS_WIN_C  = WS_WIN_AB + (size_t)2 * N_AB * DM * 2;
constexpr size_t WS_WO_AB  = WS_WIN_C + (size_t)2 * N_C * DM * 2;
constexpr size_t WS_WO_C   = WS_WO_AB + (size_t)2 * DM * MIXW * 2;
constexpr size_t WS_WQ     = WS_WO_C + (size_t)2 * DM * MIXW * 2;
constexpr size_t WS_WKV    = WS_WQ + (size_t)2 * NQ * QL * 2;
constexpr size_t WS_XS     = WS_WKV + (size_t)2 * NKV * KVL * 2;
constexpr size_t WS_H      = WS_XS + (size_t)MTOT * DM * 4;
constexpr size_t WS_Y      = WS_H + (size_t)MTOT * DM * 2;
constexpr size_t WS_G1     = WS_Y + (size_t)MTOT * DM * 4;
constexpr size_t WS_QN     = WS_G1 + (size_t)5 * MTOT * MIXW * 2;
constexpr size_t WS_KVN    = WS_QN + (size_t)MTOT * QL * 2;
constexpr size_t WS_KR     = WS_KVN + (size_t)MTOT * KVL * 2;
constexpr size_t WS_Q      = WS_KR + (size_t)MTOT * 64 * 2;
constexpr size_t WS_KN     = WS_Q + (size_t)MTOT * NQ * 2;
constexpr size_t WS_V      = WS_KN + (size_t)MTOT * DM * 2;
constexpr size_t WS_CC     = WS_V + (size_t)MTOT * DM * 2;
constexpr size_t WS_OF     = WS_CC + (size_t)MTOT * MIXW * 2;
constexpr size_t WS_YP     = WS_OF + (size_t)2 * MTOT * MIXW * 2;
constexpr size_t WS_END    = WS_YP + (size_t)8 * (MTOT - MLAT) * DM * 4;
constexpr int CW_BAR = 4096;

constexpr int RING_BYTES = 135168;
constexpr int LDSCTL_OFF = RING_BYTES, MISC_OFF = LDSCTL_OFF + 64;
constexpr int LDS_BYTES = 147456;

struct Args { const float* in[22]; float* out; unsigned char* ws; int ph_lo, ph_hi; };
typedef const __attribute__((address_space(4))) Args* KArgs;
__device__ __forceinline__ KArgs kargs() { KArgs ap = (KArgs)__builtin_amdgcn_kernarg_segment_ptr(); asm volatile("" : "+s"(ap)); return ap; }

template <class T> __device__ __forceinline__ T* uni(T* p) {
    const unsigned long long v = (unsigned long long)p; const unsigned lo = __builtin_amdgcn_readfirstlane((unsigned)v), hi = __builtin_amdgcn_readfirstlane((unsigned)(v >> 32));
    return (T*)(((unsigned long long)hi << 32) | lo); }
__device__ __forceinline__ float wave_sum(float v) {
#pragma unroll
    for (int o = 1; o < 64; o <<= 1) v += __shfl_xor(v, o);
    return v;
}
__device__ __forceinline__ float bf_lo(unsigned w) { return __uint_as_float(w << 16); }
__device__ __forceinline__ float bf_hi(unsigned w) { return __uint_as_float(w & 0xffff0000u); }
typedef __bf16 bf16x2_t __attribute__((ext_vector_type(2)));
__device__ __forceinline__ unsigned cvtpk(float lo, float hi) { const f32x2 v = {lo, hi}; const bf16x2_t b = __builtin_convertvector(v, bf16x2_t); return __builtin_bit_cast(unsigned, b); }
__device__ __forceinline__ float silu_acc(float x) { return x / (1.0f + __expf(-x)); }

__device__ __forceinline__ void p0_gemv(KArgs a, LAS unsigned char* lds, int G) {
    int tid_l = threadIdx.x; asm volatile("" : "+v"(tid_l)); const int tid = tid_l, lane = tid & 63, wave = __builtin_amdgcn_readfirstlane(tid >> 6);
    LAS float* sc = (LAS float*)lds;
    LAS float* red = (LAS float*)(lds + 49152);
    const float* c = a->in[1]; const float* cctx = a->in[3]; const float* w_ada = a->in[4]; const float* b_ada = a->in[5];
    float* mod = (float*)(a->ws + WS_MOD);
    for (int i = tid; i < 3 * 4096; i += 512) { const int r = i >> 12, k = i & 4095; const float cv = r < 2 ? c[r * 4096 + k] : cctx[k]; sc[i] = silu_acc(cv); }
    __syncthreads();
    const int kr = lane >> 4, c4 = lane & 15;
    for (int item = blockIdx.x; item < 768; item += G) {
        const int l = item / 192, cg = item % 192;
        const float* W = w_ada + (size_t)l * 4096 * 12288 + cg * 64 + c4 * 4;
        float acc[3][4];
#pragma unroll
        for (int r = 0; r < 3; ++r)
#pragma unroll
            for (int j = 0; j < 4; ++j) acc[r][j] = 0.f;
        const int k0 = wave * 512 + kr;
#pragma unroll 8
        for (int i = 0; i < 128; ++i) { const int k = k0 + 4 * i; const f32x4 w = LDNT((const f32x4*)(W + (size_t)k * 12288));
            const float s0 = sc[k], s1 = sc[4096 + k], s2 = sc[8192 + k];
#pragma unroll
            for (int j = 0; j < 4; ++j) { acc[0][j] += s0 * w[j]; acc[1][j] += s1 * w[j]; acc[2][j] += s2 * w[j]; } }
#pragma unroll
        for (int r = 0; r < 3; ++r)
#pragma unroll
            for (int j = 0; j < 4; ++j) { float v = acc[r][j]; v += __shfl_xor(v, 16); v += __shfl_xor(v, 32); acc[r][j] = v; }
        if (lane < 16) {
#pragma unroll
            for (int r = 0; r < 3; ++r)
#pragma unroll
                for (int j = 0; j < 4; ++j) red[(wave * 3 + r) * 64 + lane * 4 + j] = acc[r][j]; }
        __syncthreads();
        if (tid < 192) { const int r = tid >> 6, cc = tid & 63; float s = 0.f;
#pragma unroll
            for (int w = 0; w < 8; ++w) s += red[(w * 3 + r) * 64 + cc];
            const int col = cg * 64 + cc; mod[(size_t)(l * 3 + r) * 12288 + col] = s + b_ada[l * 12288 + col]; }
        __syncthreads();
    }
}
__device__ __forceinline__ void p0_tr_item(const float* W, int N, int K, bf16* WT, int n0s, int n0d, int k0, LAS float* scr, int lane) {
    const int kr = lane >> 4, c4 = lane & 15;
    const float* Wb = uni(W + (size_t)k0 * N + n0s); const unsigned lo = (unsigned)(kr * N + 4 * c4);
    f32x4 w[16];
#pragma unroll
    for (int i = 0; i < 16; ++i) w[i] = LDNT((const f32x4*)(Wb + lo + (unsigned)(4 * i * N)));
#pragma unroll
    for (int i = 0; i < 16; ++i) { const int k = 4 * i + kr;
        scr[(4 * c4 + 0) * 65 + k] = w[i][0]; scr[(4 * c4 + 1) * 65 + k] = w[i][1]; scr[(4 * c4 + 2) * 65 + k] = w[i][2]; scr[(4 * c4 + 3) * 65 + k] = w[i][3]; }
    LDS_WAIT(); asm volatile("" ::: "memory");
    bf16* ob = uni(WT + (size_t)n0d * K + k0); const int nr = lane >> 3, cch = lane & 7;
#pragma unroll
    for (int i = 0; i < 8; ++i) { const int n = 8 * i + nr; const LAS float* s = scr + n * 65 + 8 * cch;
        v4u o; o.x = cvtpk(s[0], s[1]); o.y = cvtpk(s[2], s[3]); o.z = cvtpk(s[4], s[5]); o.w = cvtpk(s[6], s[7]);
        *(v4u*)(ob + (unsigned)(n * K + 8 * cch)) = o; }
    LDS_WAIT(); asm volatile("" ::: "memory");
}
#ifndef P0_DEFER
#define P0_DEFER 1
#endif
constexpr int I_IN_AB = 64 * 281, I_Q = 16 * 96, I_KV = 8 * 128, I_O = 128 * 64, I_IN_C = 64 * 640, PER_J = I_IN_AB + I_Q + I_KV + I_O + I_IN_C + I_O;
__device__ __forceinline__ void p0_item(KArgs a, int j, int r, LAS float* scr, int lane) {
    if (r < I_IN_AB) { const int kb = r / 281, nb = r % 281, n0 = nb * 64;
        p0_tr_item(a->in[8] + (size_t)j * DM * N_ABSRC, N_ABSRC, DM, (bf16*)(a->ws + WS_WIN_AB) + (size_t)j * N_AB * DM, n0, n0 + (n0 >= 1600 ? 192 : 0), kb * 64, scr, lane); return; } r -= I_IN_AB;
    if (r < I_Q) { const int kb = r / 96, nb = r % 96;
        p0_tr_item(a->in[11] + (size_t)j * QL * NQ, NQ, QL, (bf16*)(a->ws + WS_WQ) + (size_t)j * NQ * QL, nb * 64, nb * 64, kb * 64, scr, lane); return; } r -= I_Q;
    if (r < I_KV) { const int kb = r / 128, nb = r % 128;
        p0_tr_item(a->in[12] + (size_t)j * KVL * NKV, NKV, KVL, (bf16*)(a->ws + WS_WKV) + (size_t)j * NKV * KVL, nb * 64, nb * 64, kb * 64, scr, lane); return; } r -= I_KV;
    if (r < I_O) { const int kb = r / 64, nb = r % 64;
        p0_tr_item(a->in[17] + (size_t)j * MIXW * DM, DM, MIXW, (bf16*)(a->ws + WS_WO_AB) + (size_t)j * DM * MIXW, nb * 64, nb * 64, kb * 64, scr, lane); return; } r -= I_O;
    if (r < I_IN_C) { const int kb = r / 640, nb = r % 640;
        p0_tr_item(a->in[18] + (size_t)j * DM * N_C, N_C, DM, (bf16*)(a->ws + WS_WIN_C) + (size_t)j * N_C * DM, nb * 64, nb * 64, kb * 64, scr, lane); return; } r -= I_IN_C;
    { const int kb = r / 64, nb = r % 64;
        p0_tr_item(a->in[21] + (size_t)j * MIXW * DM, DM, MIXW, (bf16*)(a->ws + WS_WO_C) + (size_t)j * DM * MIXW, nb * 64, nb * 64, kb * 64, scr, lane); }
}
constexpr int P0_ND = I_O + (PER_J - I_IN_AB);
#ifndef P0_B1
#define P0_B1 19968
#endif
#ifndef P0_B2
#define P0_B2 39936
#endif
constexpr int P0_B3 = P0_ND - I_O;
static_assert(P0_B1 >= I_O && P0_B1 <= P0_B2 && P0_B2 <= P0_B3, "deferred-slot deadlines");
__device__ __forceinline__ bool p0_defer_on(int G) { return P0_DEFER && (G % pg8::NXCD == 0); }
__device__ __forceinline__ void p0_deferred(KArgs a, LAS unsigned char* lds, const pg8::LockstepOrder& S, int slot) {
    const int lenmax = S.PG * pg8::LockstepOrder::LW * S.nN + S.qR + (S.rR > 0 ? 1 : 0), R = (lenmax + S.nk - 1) / S.nk, kcut = lenmax - (R - 1) * S.nk;
    const bool all = kcut >= S.nk;
    if (!all && S.k < kcut) return;
    int tid_l = threadIdx.x; asm volatile("" : "+v"(tid_l)); const int lane = tid_l & 63, wave = __builtin_amdgcn_readfirstlane(tid_l >> 6);
    const int rank = all ? S.c : (S.k - kcut) * pg8::NXCD + S.x, nw = (all ? S.G : pg8::NXCD * (S.nk - kcut)) * NWAVES;
    __syncthreads();
    LAS float* scr = (LAS float*)(lds + wave * 16640);
    const int lo_ = slot == 0 ? 0 : slot == 1 ? P0_B1 : slot == 2 ? P0_B2 : P0_B3, hi_ = slot == 0 ? P0_B1 : slot == 1 ? P0_B2 : slot == 2 ? P0_B3 : P0_ND;
    for (int d = lo_ + rank * NWAVES + wave; d < hi_; d += nw) {
        const int j = d < I_O ? 0 : 1, r = d < I_O ? PER_J - I_O + d : I_IN_AB + (d - I_O); p0_item(a, j, r, scr, lane); }
    __syncthreads();
}
__device__ __forceinline__ void p0_prologue(KArgs a, LAS unsigned char* lds, int G) {
    int tid_l = threadIdx.x; asm volatile("" : "+v"(tid_l)); const int tid = tid_l, lane = tid & 63, wave = __builtin_amdgcn_readfirstlane(tid >> 6);
    __syncthreads();
    p0_gemv(a, lds, G);
    __syncthreads();
    LAS float* scr = (LAS float*)(lds + wave * 16640);
    const int gw = blockIdx.x * NWAVES + wave, NGW = G * NWAVES;
    const bool defer = p0_defer_on(G);
    const int NIT = defer ? (PER_J - I_O) + I_IN_AB : 2 * PER_J;
    for (int it = gw; it < NIT; it += NGW) {
        const int j = defer ? (it < PER_J - I_O ? 0 : 1) : it / PER_J, r = defer ? (it < PER_J - I_O ? it : it - (PER_J - I_O)) : it % PER_J;
        p0_item(a, j, r, scr, lane);
    }
    const size_t gt = (size_t)blockIdx.x * 512 + tid, NGT = (size_t)G * 512;
    for (size_t i = gt; i < (size_t)2 * 192 * DM / 8; i += NGT) { const size_t j = i / (192 * DM / 8), e = i % (192 * DM / 8);
        *(v4u*)((bf16*)(a->ws + WS_WIN_AB) + j * (size_t)N_AB * DM + (size_t)1600 * DM + e * 8) = (v4u){0u, 0u, 0u, 0u}; }
    { const float* lg = a->in[19]; float* oml = (float*)(a->ws + WS_OML);
      for (size_t i = gt; i < (size_t)2 * 2 * 8192; i += NGT) { const int jc = (int)(i >> 14), de = (int)(i & 16383);
          const float l0 = lg[0 * 16384 + de], l1 = lg[1 * 16384 + de], l2 = lg[2 * 16384 + de], l3 = lg[3 * 16384 + de];
          const float mx = fmaxf(fmaxf(l0, l1), fmaxf(l2, l3)); const float e0 = __expf(l0 - mx), e1 = __expf(l1 - mx), e2 = __expf(l2 - mx), e3 = __expf(l3 - mx);
          const float inv = 1.0f / (e0 + e1 + e2 + e3); const float lb = (jc == 0) ? e1 * inv : (e1 + e2 + e3) * inv;
          oml[i] = 1.0f - lb; } }
    { f32x2* rope = (f32x2*)(a->ws + WS_ROPE);
      for (size_t i = gt; i < 128 * 16; i += NGT) { const int pos = (int)(i >> 4), f = (int)(i & 15); const float inv = powf(10000.0f, -(float)f / 16.0f); const float ang = (float)pos * inv;
          rope[i] = (f32x2){cosf(ang), sinf(ang)}; } }
}

__device__ __forceinline__ void norm_phase(KArgs a, int lpost, int lpre, int G) {
    int tid_l = threadIdx.x; asm volatile("" : "+v"(tid_l)); const int tid = tid_l, lane = tid & 63, wave = __builtin_amdgcn_readfirstlane(tid >> 6);
    const int gw = blockIdx.x * NWAVES + wave, NGW = G * NWAVES;
    const float* mod = (const float*)(a->ws + WS_MOD);
    float* XS = (float*)(a->ws + WS_XS); const float* Y = (const float*)(a->ws + WS_Y); bf16* H = (bf16*)(a->ws + WS_H);
    const int nrows = (lpost == 3) ? MLAT : MTOT;
    for (int row = gw; row < nrows; row += NGW) {
        const int rt = row < SEQ ? 0 : (row < MLAT ? 1 : 2);
        const float* xin = uni((lpost <= 0) ? (row < MLAT ? a->in[0] + (size_t)row * DM : a->in[2] + (size_t)(row - MLAT) * DM) : XS + (size_t)row * DM);
        f32x4 xv[16];
#pragma unroll
        for (int j = 0; j < 16; ++j) xv[j] = LDNT((const f32x4*)(xin + lane * 4 + 256 * j));
        if (lpost >= 0) {
            f32x4 yv[16]; float ss = 0.f;
            if (row < MLAT) { const bf16* yr = uni((const bf16*)Y + (size_t)row * DM);
#pragma unroll
                for (int j = 0; j < 16; ++j) { const u32x2 w = LDNT((const u32x2*)(yr + lane * 4 + 256 * j)); yv[j] = (f32x4){bf_lo(w.x), bf_hi(w.x), bf_lo(w.y), bf_hi(w.y)}; } }
            else {
                const float* yr = uni((const float*)(a->ws + WS_YP) + (size_t)(row - MLAT) * DM);
#pragma unroll
                for (int j = 0; j < 16; ++j) yv[j] = *(const f32x4*)(yr + lane * 4 + 256 * j);
                for (int kc = 1; kc < 8; ++kc) { const float* yk = uni(yr + (size_t)kc * (MTOT - MLAT) * DM);
#pragma unroll
                    for (int j = 0; j < 16; ++j) { yv[j] = yv[j] + *(const f32x4*)(yk + lane * 4 + 256 * j); if ((j & 3) == 3) asm volatile("" ::: "memory"); } } }
#pragma unroll
            for (int j = 0; j < 16; ++j) ss += (yv[j][0] * yv[j][0] + yv[j][1] * yv[j][1]) + (yv[j][2] * yv[j][2] + yv[j][3] * yv[j][3]);
            const float r = 1.0f / sqrtf(wave_sum(ss) * (1.0f / DM) + EPS);
            const float* gate = uni(mod + (size_t)(lpost * 3 + rt) * 12288 + 8192); const float* pw = uni(a->in[7] + (size_t)lpost * DM);
            float* xout = uni((lpost == 3) ? a->out + (size_t)row * DM : XS + (size_t)row * DM);
#pragma unroll
            for (int j = 0; j < 16; ++j) { const int col = lane * 4 + 256 * j; const f32x4 g = *(const f32x4*)(gate + col), w = *(const f32x4*)(pw + col);
                xv[j] = xv[j] + g * ((yv[j] * r) * w); STNT((f32x4*)(xout + col), xv[j]);
                if ((j & 3) == 3) asm volatile("" ::: "memory"); }
        }
        if (lpre < 4) {
            float ss = 0.f;
#pragma unroll
            for (int j = 0; j < 16; ++j) ss += (xv[j][0] * xv[j][0] + xv[j][1] * xv[j][1]) + (xv[j][2] * xv[j][2] + xv[j][3] * xv[j][3]);
            const float r = 1.0f / sqrtf(wave_sum(ss) * (1.0f / DM) + EPS);
            const float* shift = uni(mod + (size_t)(lpre * 3 + rt) * 12288); const float* scale = shift + 4096; const float* pw = uni(a->in[6] + (size_t)lpre * DM);
            bf16* hr = uni(H + (size_t)row * DM);
#pragma unroll
            for (int j = 0; j < 16; ++j) { const int col = lane * 4 + 256 * j; const f32x4 sh = *(const f32x4*)(shift + col), sc = *(const f32x4*)(scale + col), w = *(const f32x4*)(pw + col);
                const f32x4 h = ((xv[j] * r) * w) * (sc + 1.0f) + sh; u32x2 o; o.x = cvtpk(h[0], h[1]); o.y = cvtpk(h[2], h[3]); *(u32x2*)(hr + col) = o;
                if ((j & 3) == 3) asm volatile("" ::: "memory"); }
        }
    }
}

__device__ __forceinline__ void a2_rows(KArgs a, int j, int G) {
    int tid_l = threadIdx.x; asm volatile("" : "+v"(tid_l)); const int tid = tid_l, lane = tid & 63, wave = __builtin_amdgcn_readfirstlane(tid >> 6);
    const int gw = blockIdx.x * NWAVES + wave, NGW = G * NWAVES;
    const bf16* G1 = (const bf16*)(a->ws + WS_G1); bf16* QN = (bf16*)(a->ws + WS_QN); bf16* KVN = (bf16*)(a->ws + WS_KVN); bf16* KR = (bf16*)(a->ws + WS_KR);
    f32x2* stat = (f32x2*)(a->ws + WS_STAT); const f32x2* rope = (const f32x2*)(a->ws + WS_ROPE);
    const float* qw = a->in[9] + (size_t)j * QL; const float* kvw = a->in[10] + (size_t)j * KVL;
    for (int row = gw; row < MTOT; row += NGW) {
        const bf16* g = uni(G1 + (size_t)row * N_AB);
        {
            v4u w[2]; float x[16]; float ss = 0.f;
#pragma unroll
            for (int i = 0; i < 2; ++i) { w[i] = LDNT((const v4u*)(g + lane * 8 + 512 * i));
#pragma unroll
                for (int e = 0; e < 4; ++e) { x[8 * i + 2 * e] = bf_lo(w[i][e]); x[8 * i + 2 * e + 1] = bf_hi(w[i][e]); } }
#pragma unroll
            for (int e = 0; e < 16; ++e) ss += x[e] * x[e];
            const float r = 1.0f / sqrtf(wave_sum(ss) * (1.0f / QL) + EPS);
#pragma unroll
            for (int i = 0; i < 2; ++i) { const int col = lane * 8 + 512 * i; const f32x4 w0 = *(const f32x4*)(qw + col), w1 = *(const f32x4*)(qw + col + 4);
                v4u o; o.x = cvtpk(x[8 * i + 0] * r * w0[0], x[8 * i + 1] * r * w0[1]); o.y = cvtpk(x[8 * i + 2] * r * w0[2], x[8 * i + 3] * r * w0[3]);
                o.z = cvtpk(x[8 * i + 4] * r * w1[0], x[8 * i + 5] * r * w1[1]); o.w = cvtpk(x[8 * i + 6] * r * w1[2], x[8 * i + 7] * r * w1[3]);
                *(v4u*)(QN + (size_t)row * QL + col) = o; }
        }
        {
            const v4u w = LDNT((const v4u*)(g + G1_CKV + lane * 8)); float x[8]; float ss = 0.f;
#pragma unroll
            for (int e = 0; e < 4; ++e) { x[2 * e] = bf_lo(w[e]); x[2 * e + 1] = bf_hi(w[e]); }
#pragma unroll
            for (int e = 0; e < 8; ++e) ss += x[e] * x[e];
            const float r = 1.0f / sqrtf(wave_sum(ss) * (1.0f / KVL) + EPS);
            const int col = lane * 8; const f32x4 w0 = *(const f32x4*)(kvw + col), w1 = *(const f32x4*)(kvw + col + 4);
            v4u o; o.x = cvtpk(x[0] * r * w0[0], x[1] * r * w0[1]); o.y = cvtpk(x[2] * r * w0[2], x[3] * r * w0[3]); o.z = cvtpk(x[4] * r * w1[0], x[5] * r * w1[1]); o.w = cvtpk(x[6] * r * w1[2], x[7] * r * w1[3]);
            *(v4u*)(KVN + (size_t)row * KVL + col) = o;
        }
        {
            const float x = __uint_as_float((unsigned)g[G1_KR + lane] << 16); const float xp = __shfl_xor(x, 16); float o = x;
            if (row < MLAT) { const int t = row & (SEQ - 1), ax = lane >> 5, hh = (lane >> 4) & 1, f = lane & 15, pos = ax == 0 ? (t >> 6) : (t & 63); const f32x2 cs = rope[pos * 16 + f];
                o = hh == 0 ? x * cs.x - xp * cs.y : x * cs.x + xp * cs.y; }
            KR[(size_t)row * 64 + lane] = (bf16)(cvtpk(o, 0.f) & 0xffffu);
        }
        {
            float x[64]; float s = 0.f;
#pragma unroll
            for (int i = 0; i < 8; ++i) { const v4u w = *(const v4u*)(g + G1_VB + lane * 8 + 512 * i);
#pragma unroll
                for (int e = 0; e < 4; ++e) { x[8 * i + 2 * e] = bf_lo(w[e]); x[8 * i + 2 * e + 1] = bf_hi(w[e]); } }
#pragma unroll
            for (int e = 0; e < 64; ++e) s += x[e];
            const float mean = wave_sum(s) * (1.0f / 4096.0f); float q = 0.f;
#pragma unroll
            for (int e = 0; e < 64; ++e) { const float d = x[e] - mean; q += d * d; }
            const float rstd = 1.0f / sqrtf(wave_sum(q) * (1.0f / 4096.0f) + EPS);
            if (lane == 0) stat[row] = (f32x2){mean, rstd};
        }
    }
}

typedef short s16x4 __attribute__((ext_vector_type(4)));
typedef float f32x16 __attribute__((ext_vector_type(16)));
#define SBAR() __builtin_amdgcn_sched_barrier(0)
__device__ __forceinline__ f32x4 mfma16(bf16x8 a, bf16x8 b, f32x4 c) { return __builtin_amdgcn_mfma_f32_16x16x32_bf16(a, b, c, 0, 0, 0); }
__device__ __forceinline__ int crow(int r, int hi) { return (r & 3) + 8 * (r >> 2) + 4 * hi; }
__device__ __forceinline__ int v_st(int k, int c) { const int kk = (k & ~0xC) | ((k & 4) << 1) | ((k & 8) >> 1); return ((kk >> 3) * 4 + (c >> 5)) * 512 + ((kk & 7) * 32 + (c & 31)) * 2; }
__device__ __forceinline__ int v_rd_base(int lane) { return ((lane & 3) << 3) | (((lane >> 2) & 3) << 6) | (((lane >> 4) & 1) << 5) | (((lane >> 5) & 1) << 8); }
constexpr int v_rd_off(int d0, int ks, int half) { return d0 * 512 + ks * 4096 + half * 2048; }
template <int OFF> __device__ __forceinline__ s16x4 tr_read(int vb) {
    s16x4 r; asm volatile("ds_read_b64_tr_b16 %0, %1 offset:%2" : "=&v"(r) : "v"(vb), "i"(OFF) : "memory"); return r;
}
template <int D0> __device__ __forceinline__ void pv_one(f32x16& od, int vb, bf16x8 pa0, bf16x8 pa1, bf16x8 pa2, bf16x8 pa3) {
    const s16x4 l0 = tr_read<v_rd_off(D0, 0, 0)>(vb), h0 = tr_read<v_rd_off(D0, 0, 1)>(vb), l1 = tr_read<v_rd_off(D0, 1, 0)>(vb), h1 = tr_read<v_rd_off(D0, 1, 1)>(vb);
    const s16x4 l2 = tr_read<v_rd_off(D0, 2, 0)>(vb), h2 = tr_read<v_rd_off(D0, 2, 1)>(vb), l3 = tr_read<v_rd_off(D0, 3, 0)>(vb), h3 = tr_read<v_rd_off(D0, 3, 1)>(vb);
    asm volatile("s_waitcnt lgkmcnt(0)" ::: "memory"); SBAR();
#define PKV(L, H) (bf16x8){L[0], L[1], L[2], L[3], H[0], H[1], H[2], H[3]}
    od = __builtin_amdgcn_mfma_f32_32x32x16_bf16(pa0, PKV(l0, h0), od, 0, 0, 0);
    od = __builtin_amdgcn_mfma_f32_32x32x16_bf16(pa1, PKV(l1, h1), od, 0, 0, 0);
    od = __builtin_amdgcn_mfma_f32_32x32x16_bf16(pa2, PKV(l2, h2), od, 0, 0, 0);
    od = __builtin_amdgcn_mfma_f32_32x32x16_bf16(pa3, PKV(l3, h3), od, 0, 0, 0);
#undef PKV
}
__device__ __forceinline__ void pv_d0(f32x16* o, int vb, bf16x8 pa0, bf16x8 pa1, bf16x8 pa2, bf16x8 pa3) {
    pv_one<0>(o[0], vb, pa0, pa1, pa2, pa3); pv_one<1>(o[1], vb, pa0, pa1, pa2, pa3); pv_one<2>(o[2], vb, pa0, pa1, pa2, pa3); pv_one<3>(o[3], vb, pa0, pa1, pa2, pa3);
}

template <int I> __device__ __forceinline__ void pv_rd(int vb, s16x4& l0, s16x4& h0, s16x4& l1, s16x4& h1) {
    l0 = tr_read<v_rd_off(I >> 1, 2 * (I & 1), 0)>(vb); h0 = tr_read<v_rd_off(I >> 1, 2 * (I & 1), 1)>(vb); l1 = tr_read<v_rd_off(I >> 1, 2 * (I & 1) + 1, 0)>(vb); h1 = tr_read<v_rd_off(I >> 1, 2 * (I & 1) + 1, 1)>(vb);
}
#define PKV2(L, H) (bf16x8){L[0], L[1], L[2], L[3], H[0], H[1], H[2], H[3]}
#define PV_MM(I, A0, A1, L0, H0, L1, H1) do { o[(I) >> 1] = __builtin_amdgcn_mfma_f32_32x32x16_bf16(A0, PKV2(L0, H0), o[(I) >> 1], 0, 0, 0); o[(I) >> 1] = __builtin_amdgcn_mfma_f32_32x32x16_bf16(A1, PKV2(L1, H1), o[(I) >> 1], 0, 0, 0); } while (0)
#define PV_WAIT4() do { asm volatile("s_waitcnt lgkmcnt(4)" ::: "memory"); SBAR(); } while (0)
#define PV_WAIT0() do { asm volatile("s_waitcnt lgkmcnt(0)" ::: "memory"); SBAR(); } while (0)
__device__ __forceinline__ void pv_pipe(f32x16* o, int vb, bf16x8 pa0, bf16x8 pa1, bf16x8 pa2, bf16x8 pa3) {
    s16x4 al0, ah0, al1, ah1, bl0, bh0, bl1, bh1;
    asm volatile("s_waitcnt lgkmcnt(0)" ::: "memory"); SBAR();
    pv_rd<0>(vb, al0, ah0, al1, ah1); pv_rd<1>(vb, bl0, bh0, bl1, bh1);
    PV_WAIT4(); PV_MM(0, pa0, pa1, al0, ah0, al1, ah1); SBAR(); pv_rd<2>(vb, al0, ah0, al1, ah1);
    PV_WAIT4(); PV_MM(1, pa2, pa3, bl0, bh0, bl1, bh1); SBAR(); pv_rd<3>(vb, bl0, bh0, bl1, bh1);
    PV_WAIT4(); PV_MM(2, pa0, pa1, al0, ah0, al1, ah1); SBAR(); pv_rd<4>(vb, al0, ah0, al1, ah1);
    PV_WAIT4(); PV_MM(3, pa2, pa3, bl0, bh0, bl1, bh1); SBAR(); pv_rd<5>(vb, bl0, bh0, bl1, bh1);
    PV_WAIT4(); PV_MM(4, pa0, pa1, al0, ah0, al1, ah1); SBAR(); pv_rd<6>(vb, al0, ah0, al1, ah1);
    PV_WAIT4(); PV_MM(5, pa2, pa3, bl0, bh0, bl1, bh1); SBAR(); pv_rd<7>(vb, bl0, bh0, bl1, bh1);
    PV_WAIT4(); PV_MM(6, pa0, pa1, al0, ah0, al1, ah1);
    PV_WAIT0(); PV_MM(7, pa2, pa3, bl0, bh0, bl1, bh1);
}

__device__ __forceinline__ void pv_seq(f32x16* o, int vb, bf16x8 pa0, bf16x8 pa1, bf16x8 pa2, bf16x8 pa3) {
    s16x4 al0, ah0, al1, ah1;
    pv_rd<0>(vb, al0, ah0, al1, ah1); PV_WAIT0(); PV_MM(0, pa0, pa1, al0, ah0, al1, ah1); SBAR();
    pv_rd<1>(vb, al0, ah0, al1, ah1); PV_WAIT0(); PV_MM(1, pa2, pa3, al0, ah0, al1, ah1); SBAR();
    pv_rd<2>(vb, al0, ah0, al1, ah1); PV_WAIT0(); PV_MM(2, pa0, pa1, al0, ah0, al1, ah1); SBAR();
    pv_rd<3>(vb, al0, ah0, al1, ah1); PV_WAIT0(); PV_MM(3, pa2, pa3, al0, ah0, al1, ah1); SBAR();
    pv_rd<4>(vb, al0, ah0, al1, ah1); PV_WAIT0(); PV_MM(4, pa0, pa1, al0, ah0, al1, ah1); SBAR();
    pv_rd<5>(vb, al0, ah0, al1, ah1); PV_WAIT0(); PV_MM(5, pa2, pa3, al0, ah0, al1, ah1); SBAR();
    pv_rd<6>(vb, al0, ah0, al1, ah1); PV_WAIT0(); PV_MM(6, pa0, pa1, al0, ah0, al1, ah1); SBAR();
    pv_rd<7>(vb, al0, ah0, al1, ah1); PV_WAIT0(); PV_MM(7, pa2, pa3, al0, ah0, al1, ah1);
}

__device__ __forceinline__ void sgu_phase(KArgs a, int j, LAS unsigned char* lds, int G) {
    int tid_l = threadIdx.x; asm volatile("" : "+v"(tid_l)); const int tid = tid_l, lane = tid & 63, wid = __builtin_amdgcn_readfirstlane(tid >> 6), r32 = lane & 31, hi = lane >> 5;
    const bf16* G1 = (const bf16*)(a->ws + WS_G1); bf16* CC = (bf16*)(a->ws + WS_CC); const f32x2* stat = (const f32x2*)(a->ws + WS_STAT);
    const float* lnw = a->in[13] + (size_t)j * 4096; const float* lnb = a->in[14] + (size_t)j * 4096; const float* ws_all = a->in[15] + (size_t)j * 16 * 128 * 128; const float* bs = a->in[16] + (size_t)j * 16 * 128;
    constexpr int MXP = 272, OFF_ST = 69632;
    LAS float* st_mean = (LAS float*)(lds + OFF_ST); LAS float* st_rstd = st_mean + 128;
    LAS float* m1s = (LAS float*)(lds + OFF_ST + 1024) + wid * 64; LAS float* rss = m1s + 32;
    LAS unsigned char* mx = lds + wid * (32 * MXP);
    const int sr = tid >> 4, sc = (tid & 15) * 8, vst0 = v_st(sr, sc), vst1 = v_st(32 + sr, sc);
    const int tb = wid >> 1, ch = wid & 1;
    const int vb0 = (int)(unsigned)(unsigned long long)lds + v_rd_base(lane);
    v4u vx[8];
#define SGU_LOADV(it_) do { const int ch_ = (it_) >> 4, g_ = (it_) & 15; const bf16* s0_ = uni(G1 + (size_t)(ch_ * 128) * N_AB + G1_VB + g_ * 256); const unsigned lo_ = (unsigned)(sr * N_AB + sc); \
    _Pragma("unroll") for (int st = 0; st < 2; ++st) _Pragma("unroll") for (int c2 = 0; c2 < 2; ++c2) { const unsigned o_ = lo_ + (unsigned)(64 * st * N_AB + c2 * 128); \
        vx[(st * 2 + c2) * 2] = LDNT((const v4u*)(s0_ + o_)); vx[(st * 2 + c2) * 2 + 1] = LDNT((const v4u*)(s0_ + o_ + 32 * N_AB)); } } while (0)
    const int item0 = (int)((blockIdx.x + 128u) % (unsigned)G);
    if (item0 < 132 * 16) SGU_LOADV(item0);
    for (int item = item0; item < 132 * 16; item += G) {
        const int chunk = item >> 4, g = item & 15, row0 = chunk * 128;
        __syncthreads();
#pragma unroll
        for (int q = 0; q < 4; ++q) { *(LAS v4u*)(lds + q * 16384 + vst0) = vx[2 * q]; *(LAS v4u*)(lds + q * 16384 + vst1) = vx[2 * q + 1]; }
        if (tid < 128) { const f32x2 s = stat[row0 + tid]; st_mean[tid] = s.x; st_rstd[tid] = s.y; }
        __syncthreads();
        if (item + G < 132 * 16) SGU_LOADV(item + G);
        const float* wrow = ws_all + ((size_t)g * 128 + 32 * tb + r32) * 128;
        bf16x8 pa[2][4]; float m1 = 0.f, rs = 0.f;
#pragma unroll
        for (int st = 0; st < 2; ++st)
#pragma unroll
            for (int ks = 0; ks < 4; ++ks) { const int s0 = 64 * st + 16 * ks + 8 * hi; const f32x4 w0 = *(const f32x4*)(wrow + s0), w1 = *(const f32x4*)(wrow + s0 + 4);
                const f32x4 r0 = *(const LAS f32x4*)(st_rstd + s0), r1 = *(const LAS f32x4*)(st_rstd + s0 + 4), mu0 = *(const LAS f32x4*)(st_mean + s0), mu1 = *(const LAS f32x4*)(st_mean + s0 + 4);
                rs += (w0[0] + w0[1]) + (w0[2] + w0[3]) + (w1[0] + w1[1]) + (w1[2] + w1[3]);
                v4u p; p.x = cvtpk(w0[0] * r0[0], w0[1] * r0[1]); p.y = cvtpk(w0[2] * r0[2], w0[3] * r0[3]); p.z = cvtpk(w1[0] * r1[0], w1[1] * r1[1]); p.w = cvtpk(w1[2] * r1[2], w1[3] * r1[3]);
                m1 += bf_lo(p.x) * mu0[0] + bf_hi(p.x) * mu0[1] + bf_lo(p.y) * mu0[2] + bf_hi(p.y) * mu0[3] + bf_lo(p.z) * mu1[0] + bf_hi(p.z) * mu1[1] + bf_lo(p.w) * mu1[2] + bf_hi(p.w) * mu1[3];
                pa[st][ks] = __builtin_bit_cast(bf16x8, p); }
        m1 += __shfl_xor(m1, 32); rs += __shfl_xor(rs, 32);
        if (hi == 0) { m1s[r32] = m1; rss[r32] = rs; }
        f32x16 o[4];
#pragma unroll
        for (int d = 0; d < 4; ++d)
#pragma unroll
            for (int r = 0; r < 16; ++r) o[d][r] = 0.f;
#pragma unroll
        for (int st = 0; st < 2; ++st) pv_d0(o, vb0 + (st * 2 + ch) * 16384, pa[st][0], pa[st][1], pa[st][2], pa[st][3]);
        asm volatile("s_waitcnt lgkmcnt(0)" ::: "memory");
        __syncthreads();
        { const int cb = g * 256 + ch * 128;
          const float* lw = uni(lnw + cb); const float* lb = uni(lnb + cb); const float* bsg = uni(bs + g * 128 + 32 * tb);
          int r32e = r32, hie = hi; asm volatile("" : "+v"(r32e), "+v"(hie));
          float lwv[4], lbv[4];
#pragma unroll
          for (int d0 = 0; d0 < 4; ++d0) { lwv[d0] = lw[d0 * 32 + r32e]; lbv[d0] = lb[d0 * 32 + r32e]; }
#pragma unroll
          for (int r = 0; r < 16; ++r) { const int rr = crow(r, hie); const float m1t = m1s[rr], rst = rss[rr], bst = bsg[rr];
#pragma unroll
            for (int d0 = 0; d0 < 4; ++d0) { const float mix = lwv[d0] * (o[d0][r] - m1t) + lbv[d0] * rst + bst;
                *(LAS bf16*)(mx + rr * MXP + (d0 * 32 + r32e) * 2) = (bf16)(cvtpk(mix, 0.f) & 0xffffu); } } }
        asm volatile("s_waitcnt lgkmcnt(0)" ::: "memory");
        { const int cb = g * 256 + ch * 128;
          const bf16* Gu = uni(G1 + (size_t)(row0 + 32 * tb) * N_AB + G1_UB + cb); const bf16* Gzb = uni(G1 + (size_t)(row0 + 32 * tb) * N_AB + G1_ZB + cb); bf16* Co = uni(CC + (size_t)(row0 + 32 * tb) * MIXW + 4096 + cb);
          int le = lane; asm volatile("" : "+v"(le));
#pragma unroll
          for (int i = 0; i < 8; ++i) { const int id = 64 * i + le, row = id >> 4, c8 = (id & 15) * 8;
              const v4u mq = *(const LAS v4u*)(mx + row * MXP + c8 * 2); const v4u uq = LDNT((const v4u*)(Gu + (unsigned)(row * N_AB + c8))), zq = LDNT((const v4u*)(Gzb + (unsigned)(row * N_AB + c8)));
              v4u oq;
#pragma unroll
              for (int e = 0; e < 4; ++e) oq[e] = cvtpk(bf_lo(uq[e]) * bf_lo(mq[e]) * bf_lo(zq[e]), bf_hi(uq[e]) * bf_hi(mq[e]) * bf_hi(zq[e]));
              *(v4u*)(Co + (unsigned)(row * MIXW + c8)) = oq;
              if ((i & 3) == 3) asm volatile("" ::: "memory"); } }
    }
#undef SGU_LOADV
    __syncthreads();
}

namespace att {
constexpr int QBLK = 32, KVBLK = 64;
constexpr float SCALE = 0.07216878364870322f;
constexpr float THR = 8.f;
constexpr int SHM_V = KVBLK * 128 * 2, SHM_K = KVBLK * 192 * 2;
#ifndef STG_SEL
#define STG_SEL 0
#endif
#ifndef ATT_STAGGER
#define ATT_STAGGER 1
#endif
constexpr int NVB = ATT_STAGGER ? 3 : 2;
constexpr int OFF_V = 0, OFF_K = NVB * SHM_V, OFF_WS = OFF_K + 2 * SHM_K, ATT_LDS = OFF_WS + NWAVES * 64 * 4;
#ifndef ATT_QR_LDS
#define ATT_QR_LDS 1
#endif
#ifndef ATT_SDEPTH
#define ATT_SDEPTH 1
#endif
constexpr int SDEPTH = ATT_SDEPTH;
constexpr float THRL = THR * 1.4426950408889634f;
__device__ __forceinline__ void partialSM_first(f32x16& p0, f32x16& p1, float& m_reg, float& alpha) {
    float pmax = p0[0];
#pragma unroll
    for (int r = 1; r < 16; ++r) pmax = fmaxf(pmax, p0[r]);
#pragma unroll
    for (int r = 0; r < 16; ++r) pmax = fmaxf(pmax, p1[r]);
    { auto rr = __builtin_amdgcn_permlane32_swap(__float_as_uint(pmax), __float_as_uint(pmax), false, false);
      pmax = fmaxf(__uint_as_float(rr[0]), __uint_as_float(rr[1])); }
    m_reg = pmax; alpha = 1.f;
#pragma unroll
    for (int r = 0; r < 16; ++r) p0[r] = p0[r] - pmax;
#pragma unroll
    for (int r = 0; r < 16; ++r) p1[r] = p1[r] - pmax;
#pragma unroll
    for (int r = 0; r < 16; ++r) p0[r] = __builtin_amdgcn_exp2f(p0[r]);
}
__device__ __forceinline__ void partialSM(f32x16& p0, f32x16& p1, float& m_reg, float& alpha) {
    float pmax = p0[0];
#pragma unroll
    for (int r = 1; r < 16; ++r) pmax = fmaxf(pmax, p0[r]);
#pragma unroll
    for (int r = 0; r < 16; ++r) pmax = fmaxf(pmax, p1[r]);
    { auto rr = __builtin_amdgcn_permlane32_swap(__float_as_uint(pmax), __float_as_uint(pmax), false, false);
      pmax = fmaxf(__uint_as_float(rr[0]), __uint_as_float(rr[1])); }
    if (__builtin_expect(__all(pmax <= THRL), 1)) { alpha = 1.f; }
    else { const float d = fmaxf(pmax, 0.f); alpha = __builtin_amdgcn_exp2f(-d); m_reg += d;
#pragma unroll
        for (int r = 0; r < 16; ++r) p0[r] = p0[r] - d;
#pragma unroll
        for (int r = 0; r < 16; ++r) p1[r] = p1[r] - d; }
#pragma unroll
    for (int r = 0; r < 16; ++r) p0[r] = __builtin_amdgcn_exp2f(p0[r]);
}
__device__ __forceinline__ void finishSM(f32x16& p0, f32x16& p1, float alpha, float& l_reg, bf16x8& pa0, bf16x8& pa1, bf16x8& pa2, bf16x8& pa3) {
#pragma unroll
    for (int r = 0; r < 16; ++r) p1[r] = __builtin_amdgcn_exp2f(p1[r]);
    float ps = 0;
#pragma unroll
    for (int r = 0; r < 16; ++r) ps += p0[r];
#pragma unroll
    for (int r = 0; r < 16; ++r) ps += p1[r];
    { auto rr = __builtin_amdgcn_permlane32_swap(__float_as_uint(ps), __float_as_uint(ps), false, false);
      ps = __uint_as_float(rr[0]) + __uint_as_float(rr[1]); }
    l_reg = l_reg * alpha + ps;
#define PK4(P, BASE, OUT) do { unsigned a0 = cvtpk(P[BASE + 0], P[BASE + 1]), a1 = cvtpk(P[BASE + 2], P[BASE + 3]);   \
    unsigned b0 = cvtpk(P[BASE + 4], P[BASE + 5]), b1 = cvtpk(P[BASE + 6], P[BASE + 7]);                              \
    auto r0 = __builtin_amdgcn_permlane32_swap(a0, b0, false, false); auto r1 = __builtin_amdgcn_permlane32_swap(a1, b1, false, false); \
    v4u w = {r0[0], r1[0], r0[1], r1[1]}; OUT = __builtin_bit_cast(bf16x8, w); } while (0)
    PK4(p0, 0, pa0); PK4(p0, 8, pa1); PK4(p1, 0, pa2); PK4(p1, 8, pa3);
#undef PK4
}
constexpr int OFF_KR = 16384;
constexpr int OFF_QR = ATT_LDS, ATT_LDS2 = OFF_QR + NWAVES * 4096;
__device__ __forceinline__ void qkt(f32x16& p0, f32x16& p1, const LAS unsigned char* Ks, const bf16x8* qr, const LAS unsigned char* qrl, int r32, int hi, float seed) {
#pragma unroll
    for (int r = 0; r < 16; ++r) { p0[r] = seed; p1[r] = seed; }
    const int swn = (r32 & 15) << 4, swr = ((r32 >> 1) & 7) << 4;
#pragma unroll
    for (int d0 = 0; d0 < 8; ++d0) { const int cb = (d0 * 16 + hi * 8) * 2;
        const bf16x8 b0 = *(const LAS bf16x8*)(Ks + r32 * 256 + (cb ^ swn));
        const bf16x8 b1 = *(const LAS bf16x8*)(Ks + (32 + r32) * 256 + (cb ^ swn));
        p0 = __builtin_amdgcn_mfma_f32_32x32x16_bf16(b0, qr[d0], p0, 0, 0, 0);
        p1 = __builtin_amdgcn_mfma_f32_32x32x16_bf16(b1, qr[d0], p1, 0, 0, 0); }
#pragma unroll
    for (int d0 = 0; d0 < 4; ++d0) { const int cb = (d0 * 16 + hi * 8) * 2;
        const bf16x8 b0 = *(const LAS bf16x8*)(Ks + OFF_KR + r32 * 128 + (cb ^ swr));
        const bf16x8 b1 = *(const LAS bf16x8*)(Ks + OFF_KR + (32 + r32) * 128 + (cb ^ swr));
#if ATT_QR_LDS
        const bf16x8 q = *(const LAS bf16x8*)(qrl + d0 * 1024);
#else
        const bf16x8 q = qr[8 + d0];
#endif
        p0 = __builtin_amdgcn_mfma_f32_32x32x16_bf16(b0, q, p0, 0, 0, 0);
        p1 = __builtin_amdgcn_mfma_f32_32x32x16_bf16(b1, q, p1, 0, 0, 0); }
}
__device__ __forceinline__ void attn_unit(const bf16* __restrict__ Q, const bf16* __restrict__ KN, const bf16* __restrict__ KR, const bf16* __restrict__ V, const bf16* __restrict__ G1, bf16* __restrict__ CC,
                                          int qrow0, int h, int nt_lat, int lat0, int ctx0, LAS unsigned char* lds) {
    int tid_l = threadIdx.x; asm volatile("" : "+v"(tid_l)); const int tid = tid_l, wid = __builtin_amdgcn_readfirstlane(tid >> 6), lane = tid & 63, r32 = lane & 31, hi = lane >> 5;
    LAS unsigned char* V_lds = lds + OFF_V; LAS unsigned char* K_lds = lds + OFF_K;
    LAS float* wsf = (LAS float*)(lds + OFF_WS) + wid * 64; LAS float* li_l = wsf; LAS float* al_l = wsf + 32;
    LAS unsigned char* qrl = lds + OFF_QR + wid * 4096 + lane * 16;
    float m_reg = -1e30f, l_reg = 0;
    f32x16 o[4];
#pragma unroll
    for (int d = 0; d < 4; ++d)
#pragma unroll
        for (int r = 0; r < 16; ++r) o[d][r] = 0.f;
    const unsigned ko = (unsigned)((tid >> 4) * 128 + (((tid & 15) ^ ((tid >> 4) & 15)) * 8));
    const unsigned kro = (unsigned)((tid >> 3) * 64 + (((tid & 7) ^ ((tid >> 4) & 7)) * 8));
    unsigned vo; { const int sub = tid >> 5, kk = (sub >> 2) * 8 + ((tid & 31) >> 2), col = (sub & 3) * 32 + (tid & 3) * 8, key = (kk & ~0xC) | ((kk & 4) << 1) | ((kk & 8) >> 1); vo = (unsigned)(key * 128 + col); }
    const int vb0 = (int)(unsigned)(unsigned long long)lds + OFF_V + v_rd_base(lane);
    const int NT = nt_lat + 4;
#define TROW(jt) ((jt) < nt_lat ? lat0 + 64 * (jt) : ctx0 + 64 * ((jt) - nt_lat))
#define GLDS(gp, lp) __builtin_amdgcn_global_load_lds((const unsigned*)(gp), (LAS unsigned*)(lp), 16, 0, 0)
#define GLDS_S(gbase, boff, lp) do { const char* gb_ = (const char*)(gbase); asm volatile("" : "+s"(gb_)); unsigned bo_ = (boff); asm volatile("" : "+v"(bo_)); GLDS(gb_ + bo_, lp); } while (0)
#define ISSUE_K(jt, b) do { const int R0_ = TROW(jt); const bf16* Kb_ = uni(KN + ((size_t)h * MTOT + R0_) * 128); const bf16* Rb_ = uni(KR + (size_t)R0_ * 64); \
    GLDS_S(Kb_, ko * 2u, K_lds + (b) * SHM_K + wid * 1024); GLDS_S(Kb_ + 32 * 128, ko * 2u, K_lds + (b) * SHM_K + (wid + 8) * 1024); GLDS_S(Rb_, kro * 2u, K_lds + (b) * SHM_K + OFF_KR + wid * 1024); } while (0)
#define ISSUE_V(jt, b) do { const int R0_ = TROW(jt); const bf16* Vb_ = uni(V + ((size_t)h * MTOT + R0_) * 128); \
    GLDS_S(Vb_, vo * 2u, V_lds + (b) * SHM_V + wid * 1024); GLDS_S(Vb_ + 32 * 128, vo * 2u, V_lds + (b) * SHM_V + (wid + 8) * 1024); } while (0)
#define STEP_END() asm volatile("s_waitcnt vmcnt(0) lgkmcnt(0)\n\ts_barrier" ::: "memory")
#define RESC(a_) do { if (__any((a_) < 1.f)) { if (hi == 0) al_l[r32] = (a_); asm volatile("s_waitcnt lgkmcnt(0)" ::: "memory"); \
    _Pragma("unroll") for (int d = 0; d < 4; ++d) _Pragma("unroll") for (int r = 0; r < 16; ++r) o[d][r] *= al_l[crow(r, hi)]; } } while (0)
    STEP_END();
    ISSUE_K(0, 0);
    bf16x8 qr[ATT_QR_LDS ? 8 : 12];
    { const bf16* Qw = uni(Q + (size_t)(qrow0 + wid * QBLK) * NQ + h * 192); const unsigned qo = (unsigned)(r32 * NQ + hi * 8);
#pragma unroll
      for (int d0 = 0; d0 < (ATT_QR_LDS ? 8 : 12); ++d0) qr[d0] = *(const bf16x8*)(Qw + qo + d0 * 16);
#if ATT_QR_LDS
#pragma unroll
      for (int d0 = 8; d0 < 12; ++d0) { const bf16x8 t = *(const bf16x8*)(Qw + qo + d0 * 16); *(LAS bf16x8*)(qrl + (d0 - 8) * 1024) = t; }
#endif
    }
    f32x16 pA0, pA1, pB0, pB1; float alA, alB; bf16x8 pa0, pa1, pa2, pa3;
    STEP_END();
#if !ATT_STAGGER
    ISSUE_K(1, 1); ISSUE_V(0, 0);
    qkt(pA0, pA1, K_lds, qr, qrl, r32, hi, 0.f); partialSM_first(pA0, pA1, m_reg, alA);
    STEP_END();
    for (int j = 1; j + 1 < NT; j += 2) {
        ISSUE_K(j + 1, 0); ISSUE_V(j, 1);
        SBAR(); qkt(pB0, pB1, K_lds + SHM_K, qr, qrl, r32, hi, -m_reg);
        finishSM(pA0, pA1, alA, l_reg, pa0, pa1, pa2, pa3); SBAR();
        pv_pipe(o, vb0, pa0, pa1, pa2, pa3); partialSM(pB0, pB1, m_reg, alB);
        RESC(alB); STEP_END();
        ISSUE_K(j + 2, 1); ISSUE_V(j + 1, 0);
        SBAR(); qkt(pA0, pA1, K_lds, qr, qrl, r32, hi, -m_reg);
        finishSM(pB0, pB1, alB, l_reg, pa0, pa1, pa2, pa3); SBAR();
        pv_pipe(o, vb0 + SHM_V, pa0, pa1, pa2, pa3); partialSM(pA0, pA1, m_reg, alA);
        RESC(alA); STEP_END();
    }
    ISSUE_V(NT - 1, 1);
    SBAR(); qkt(pB0, pB1, K_lds + SHM_K, qr, qrl, r32, hi, -m_reg);
    finishSM(pA0, pA1, alA, l_reg, pa0, pa1, pa2, pa3); SBAR();
    pv_pipe(o, vb0, pa0, pa1, pa2, pa3); partialSM(pB0, pB1, m_reg, alB);
    RESC(alB); STEP_END();
    finishSM(pB0, pB1, alB, l_reg, pa0, pa1, pa2, pa3); SBAR();
    pv_pipe(o, vb0 + SHM_V, pa0, pa1, pa2, pa3);
#else
#define VOFF(t) (__builtin_amdgcn_readfirstlane(((unsigned)(t) % 3u) * (unsigned)SHM_V))
    if (STG_SEL == 0 ? (wid < 4) : (STG_SEL == 1)) {
        ISSUE_K(1, 1); ISSUE_V(0, 0);
        qkt(pA0, pA1, K_lds, qr, qrl, r32, hi, 0.f); partialSM_first(pA0, pA1, m_reg, alA);
        STEP_END();
        for (int j = 1; j + 1 < NT; j += 2) {
            ISSUE_K(j + 1, 0); ISSUE_V(j, j % 3);
            SBAR(); qkt(pB0, pB1, K_lds + SHM_K, qr, qrl, r32, hi, -m_reg); SBAR();
            finishSM(pA0, pA1, alA, l_reg, pa0, pa1, pa2, pa3); SBAR();
            pv_pipe(o, vb0 + VOFF(j - 1), pa0, pa1, pa2, pa3); partialSM(pB0, pB1, m_reg, alB);
            RESC(alB); STEP_END();
            ISSUE_K(j + 2, 1); ISSUE_V(j + 1, (j + 1) % 3);
            SBAR(); qkt(pA0, pA1, K_lds, qr, qrl, r32, hi, -m_reg); SBAR();
            finishSM(pB0, pB1, alB, l_reg, pa0, pa1, pa2, pa3); SBAR();
            pv_pipe(o, vb0 + VOFF(j), pa0, pa1, pa2, pa3); partialSM(pA0, pA1, m_reg, alA);
            RESC(alA); STEP_END();
        }
        ISSUE_V(NT - 1, (NT - 1) % 3);
        SBAR(); qkt(pB0, pB1, K_lds + SHM_K, qr, qrl, r32, hi, -m_reg); SBAR();
        finishSM(pA0, pA1, alA, l_reg, pa0, pa1, pa2, pa3); SBAR();
        pv_pipe(o, vb0 + VOFF(NT - 2), pa0, pa1, pa2, pa3); partialSM(pB0, pB1, m_reg, alB);
        RESC(alB); STEP_END();
        finishSM(pB0, pB1, alB, l_reg, pa0, pa1, pa2, pa3); SBAR();
        pv_pipe(o, vb0 + VOFF(NT - 1), pa0, pa1, pa2, pa3);
        STEP_END();
        STEP_END();
    } else {
#define TR_EVEN(j_) do { finishSM(pA0, pA1, alA, l_reg, pa0, pa1, pa2, pa3); SBAR(); pv_pipe(o, vb0 + VOFF((j_) - 2), pa0, pa1, pa2, pa3); partialSM(pB0, pB1, m_reg, alB); RESC(alB); } while (0)
#define TR_ODD(j_)  do { finishSM(pB0, pB1, alB, l_reg, pa0, pa1, pa2, pa3); SBAR(); pv_pipe(o, vb0 + VOFF((j_) - 2), pa0, pa1, pa2, pa3); partialSM(pA0, pA1, m_reg, alA); RESC(alA); } while (0)
        ISSUE_K(1, 1); ISSUE_V(0, 0);
        qkt(pA0, pA1, K_lds, qr, qrl, r32, hi, 0.f);
        STEP_END();
        ISSUE_K(2, 0); ISSUE_V(1, 1);
        partialSM_first(pA0, pA1, m_reg, alA);
        SBAR(); qkt(pB0, pB1, K_lds + SHM_K, qr, qrl, r32, hi, -m_reg); SBAR();
        STEP_END();
        for (int j = 2; j + 1 < NT - 1; j += 2) {
            ISSUE_K(j + 1, 1); ISSUE_V(j, j % 3);
            TR_EVEN(j); SBAR(); qkt(pA0, pA1, K_lds, qr, qrl, r32, hi, -m_reg); SBAR();
            STEP_END();
            ISSUE_K(j + 2, 0); ISSUE_V(j + 1, (j + 1) % 3);
            TR_ODD(j + 1); SBAR(); qkt(pB0, pB1, K_lds + SHM_K, qr, qrl, r32, hi, -m_reg); SBAR();
            STEP_END();
        }
        ISSUE_K(NT - 1, 1); ISSUE_V(NT - 2, (NT - 2) % 3);
        TR_EVEN(NT - 2); SBAR(); qkt(pA0, pA1, K_lds, qr, qrl, r32, hi, -m_reg); SBAR();
        STEP_END();
        ISSUE_V(NT - 1, (NT - 1) % 3);
        TR_ODD(NT - 1); SBAR(); qkt(pB0, pB1, K_lds + SHM_K, qr, qrl, r32, hi, -m_reg); SBAR();
        STEP_END();
        TR_EVEN(NT);
        STEP_END();
        finishSM(pB0, pB1, alB, l_reg, pa0, pa1, pa2, pa3); SBAR();
        pv_pipe(o, vb0 + VOFF(NT - 1), pa0, pa1, pa2, pa3);
        STEP_END();
#undef TR_EVEN
#undef TR_ODD
    }
#undef VOFF
#endif
    if (hi == 0) li_l[r32] = l_reg;
    STEP_END();
    { LAS unsigned char* mx = lds + wid * (32 * 272);
      int r32e = r32, hie = hi; asm volatile("" : "+v"(r32e), "+v"(hie));
#pragma unroll
      for (int r = 0; r < 16; ++r) { const int rr = crow(r, hie); const float rli = __builtin_amdgcn_rcpf(li_l[rr]);
#pragma unroll
        for (int d0 = 0; d0 < 4; ++d0) *(LAS bf16*)(mx + rr * 272 + (d0 * 32 + r32e) * 2) = (bf16)(cvtpk(o[d0][r] * rli, 0.f) & 0xffffu); }
      asm volatile("s_waitcnt lgkmcnt(0)" ::: "memory");
      const bf16* Gz = uni(G1 + (size_t)(qrow0 + wid * QBLK) * N_AB + G1_ZA + h * 128); bf16* Co = uni(CC + (size_t)(qrow0 + wid * QBLK) * MIXW + h * 128);
      int le = lane; asm volatile("" : "+v"(le));
#pragma unroll
      for (int i = 0; i < 8; ++i) { const int id = 64 * i + le, row = id >> 4, c8 = (id & 15) * 8;
          const v4u oq = *(const LAS v4u*)(mx + row * 272 + c8 * 2); const v4u zq = LDNT((const v4u*)(Gz + (unsigned)(row * N_AB + c8)));
          v4u wq;
#pragma unroll
          for (int e = 0; e < 4; ++e) wq[e] = cvtpk(bf_lo(oq[e]) * bf_lo(zq[e]), bf_hi(oq[e]) * bf_hi(zq[e]));
          *(v4u*)(Co + (unsigned)(row * MIXW + c8)) = wq;
          if ((i & 3) == 3) asm volatile("" ::: "memory"); } }
#undef TROW
#undef GLDS
#undef ISSUE_K
#undef ISSUE_V
#undef STEP_END
#undef RESC
}
}
namespace att2 {
using namespace att;
struct P8 { f32x4 t[2][4]; };
__device__ __forceinline__ float x16(float x) { return __int_as_float(__builtin_amdgcn_ds_swizzle(__float_as_int(x), 0x401F)); }
__device__ __forceinline__ float rmax4(float x) { x = fmaxf(x, x16(x)); auto rr = __builtin_amdgcn_permlane32_swap(__float_as_uint(x), __float_as_uint(x), false, false); return fmaxf(__uint_as_float(rr[0]), __uint_as_float(rr[1])); }
__device__ __forceinline__ float rsum4(float x) { x = x + x16(x); auto rr = __builtin_amdgcn_permlane32_swap(__float_as_uint(x), __float_as_uint(x), false, false); return __uint_as_float(rr[0]) + __uint_as_float(rr[1]); }
__device__ __forceinline__ float tmax(const P8& p, int qt) { float m = p.t[qt][0][0];
#pragma unroll
    for (int kt = 0; kt < 4; ++kt)
#pragma unroll
        for (int r = 0; r < 4; ++r) m = fmaxf(m, p.t[qt][kt][r]);
    return m; }
__device__ __forceinline__ void qkt2(P8& p, const LAS unsigned char* Ks, const bf16x8 (&qf)[2][4], const LAS unsigned char* qrl, int l16, int g4, float seed0, float seed1) {
#pragma unroll
    for (int kt = 0; kt < 4; ++kt) { p.t[0][kt] = (f32x4){seed0, seed0, seed0, seed0}; p.t[1][kt] = (f32x4){seed1, seed1, seed1, seed1}; }
    const int swn = l16 << 4, swr = ((l16 >> 1) & 7) << 4;
#pragma unroll
    for (int ks = 0; ks < 4; ++ks) { const int cb = (32 * ks + 8 * g4) * 2;
#pragma unroll
        for (int kt = 0; kt < 4; ++kt) { const bf16x8 kf = *(const LAS bf16x8*)(Ks + (16 * kt + l16) * 256 + (cb ^ swn));
            p.t[0][kt] = mfma16(kf, qf[0][ks], p.t[0][kt]); p.t[1][kt] = mfma16(kf, qf[1][ks], p.t[1][kt]); } }
#pragma unroll
    for (int ks = 0; ks < 2; ++ks) { const int cb = (32 * ks + 8 * g4) * 2;
        const bf16x8 q0 = *(const LAS bf16x8*)(qrl + ks * 1024), q1 = *(const LAS bf16x8*)(qrl + (2 + ks) * 1024);
#pragma unroll
        for (int kt = 0; kt < 4; ++kt) { const bf16x8 kf = *(const LAS bf16x8*)(Ks + OFF_KR + (16 * kt + l16) * 128 + (cb ^ swr));
            p.t[0][kt] = mfma16(kf, q0, p.t[0][kt]); p.t[1][kt] = mfma16(kf, q1, p.t[1][kt]); } }
}
__device__ __forceinline__ void sub_all(P8& p, float d0, float d1) {
#pragma unroll
    for (int kt = 0; kt < 4; ++kt) { p.t[0][kt] = p.t[0][kt] - d0; p.t[1][kt] = p.t[1][kt] - d1; } }
__device__ __forceinline__ void exp_half(P8& p, int k0) {
#pragma unroll
    for (int qt = 0; qt < 2; ++qt)
#pragma unroll
        for (int kt = 0; kt < 2; ++kt)
#pragma unroll
            for (int r = 0; r < 4; ++r) p.t[qt][k0 + kt][r] = __builtin_amdgcn_exp2f(p.t[qt][k0 + kt][r]); }
__device__ __forceinline__ void partial2_first(P8& p, float& m0, float& m1, float& a0, float& a1) {
    m0 = rmax4(tmax(p, 0)); m1 = rmax4(tmax(p, 1)); a0 = 1.f; a1 = 1.f; sub_all(p, m0, m1); exp_half(p, 0); }
__device__ __forceinline__ void partial2(P8& p, float& m0, float& m1, float& a0, float& a1) {
    const float x0 = rmax4(tmax(p, 0)), x1 = rmax4(tmax(p, 1));
    if (__builtin_expect(__all(fmaxf(x0, x1) <= THRL), 1)) { a0 = 1.f; a1 = 1.f; }
    else { const float d0 = fmaxf(x0, 0.f), d1 = fmaxf(x1, 0.f); a0 = __builtin_amdgcn_exp2f(-d0); a1 = __builtin_amdgcn_exp2f(-d1); m0 += d0; m1 += d1; sub_all(p, d0, d1); }
    exp_half(p, 0); }
__device__ __forceinline__ void finish2(P8& p, float a0, float a1, float& l0, float& l1, bf16x8 (&pb)[2][2]) {
    exp_half(p, 2);
    float s0 = 0.f, s1 = 0.f;
#pragma unroll
    for (int kt = 0; kt < 4; ++kt)
#pragma unroll
        for (int r = 0; r < 4; ++r) { s0 += p.t[0][kt][r]; s1 += p.t[1][kt][r]; }
    l0 = l0 * a0 + rsum4(s0); l1 = l1 * a1 + rsum4(s1);
#pragma unroll
    for (int qt = 0; qt < 2; ++qt)
#pragma unroll
        for (int s2 = 0; s2 < 2; ++s2) { v4u w; w.x = cvtpk(p.t[qt][2 * s2][0], p.t[qt][2 * s2][1]); w.y = cvtpk(p.t[qt][2 * s2][2], p.t[qt][2 * s2][3]);
            w.z = cvtpk(p.t[qt][2 * s2 + 1][0], p.t[qt][2 * s2 + 1][1]); w.w = cvtpk(p.t[qt][2 * s2 + 1][2], p.t[qt][2 * s2 + 1][3]); pb[qt][s2] = __builtin_bit_cast(bf16x8, w); }
}
template <int B, int I> __device__ __forceinline__ void pv2_rd(const int (&vo)[8], s16x4& lo, s16x4& hi) { constexpr int s2 = I >> 3, vt = I & 7;
    lo = tr_read<B * SHM_V + s2 * 8192>(vo[vt]); hi = tr_read<B * SHM_V + s2 * 8192 + 4096>(vo[vt]); }
#define PV2_MM(I, L, H) do { const bf16x8 af_ = (bf16x8){L[0], L[1], L[2], L[3], H[0], H[1], H[2], H[3]}; \
    o[(I) & 7][0] = mfma16(af_, pb[0][(I) >> 3], o[(I) & 7][0]); o[(I) & 7][1] = mfma16(af_, pb[1][(I) >> 3], o[(I) & 7][1]); } while (0)
#define PV2_W(N) do { asm volatile("s_waitcnt lgkmcnt(" #N ")" ::: "memory"); SBAR(); } while (0)
template <int B> __device__ __forceinline__ void pv2(f32x4 (&o)[8][2], const int (&vo)[8], const bf16x8 (&pb)[2][2]) {
    s16x4 l0, h0, l1, h1, l2, h2;
    asm volatile("s_waitcnt lgkmcnt(0)" ::: "memory"); SBAR();
    pv2_rd<B, 0>(vo, l0, h0); pv2_rd<B, 1>(vo, l1, h1); pv2_rd<B, 2>(vo, l2, h2);
    PV2_W(4); PV2_MM(0, l0, h0); SBAR(); pv2_rd<B, 3>(vo, l0, h0);
    PV2_W(4); PV2_MM(1, l1, h1); SBAR(); pv2_rd<B, 4>(vo, l1, h1);
    PV2_W(4); PV2_MM(2, l2, h2); SBAR(); pv2_rd<B, 5>(vo, l2, h2);
    PV2_W(4); PV2_MM(3, l0, h0); SBAR(); pv2_rd<B, 6>(vo, l0, h0);
    PV2_W(4); PV2_MM(4, l1, h1); SBAR(); pv2_rd<B, 7>(vo, l1, h1);
    PV2_W(4); PV2_MM(5, l2, h2); SBAR(); pv2_rd<B, 8>(vo, l2, h2);
    PV2_W(4); PV2_MM(6, l0, h0); SBAR(); pv2_rd<B, 9>(vo, l0, h0);
    PV2_W(4); PV2_MM(7, l1, h1); SBAR(); pv2_rd<B, 10>(vo, l1, h1);
    PV2_W(4); PV2_MM(8, l2, h2); SBAR(); pv2_rd<B, 11>(vo, l2, h2);
    PV2_W(4); PV2_MM(9, l0, h0); SBAR(); pv2_rd<B, 12>(vo, l0, h0);
    PV2_W(4); PV2_MM(10, l1, h1); SBAR(); pv2_rd<B, 13>(vo, l1, h1);
    PV2_W(4); PV2_MM(11, l2, h2); SBAR(); pv2_rd<B, 14>(vo, l2, h2);
    PV2_W(4); PV2_MM(12, l0, h0); SBAR(); pv2_rd<B, 15>(vo, l0, h0);
    PV2_W(4); PV2_MM(13, l1, h1);
    PV2_W(2); PV2_MM(14, l2, h2);
    PV2_W(0); PV2_MM(15, l0, h0);
}
__device__ __forceinline__ void attn_unit2(const bf16* __restrict__ Q, const bf16* __restrict__ KN, const bf16* __restrict__ KR, const bf16* __restrict__ V, const bf16* __restrict__ G1, bf16* __restrict__ CC,
                                           int qrow0, int h, int nt_lat, int lat0, int ctx0, LAS unsigned char* lds) {
    int tid_l = threadIdx.x; asm volatile("" : "+v"(tid_l)); const int tid = tid_l, wid = __builtin_amdgcn_readfirstlane(tid >> 6), lane = tid & 63, l16 = lane & 15, g4 = lane >> 4;
    LAS unsigned char* V_lds = lds + OFF_V; LAS unsigned char* K_lds = lds + OFF_K;
    LAS unsigned char* qrl = lds + OFF_QR + wid * 4096 + lane * 16;
    float m0 = 0.f, m1 = 0.f, l0 = 0.f, l1 = 0.f;
    f32x4 o[8][2];
#pragma unroll
    for (int vt = 0; vt < 8; ++vt) { o[vt][0] = (f32x4){0.f, 0.f, 0.f, 0.f}; o[vt][1] = (f32x4){0.f, 0.f, 0.f, 0.f}; }
    const unsigned ko = (unsigned)((tid >> 4) * 128 + (((tid & 15) ^ ((tid >> 4) & 15)) * 8));
    const unsigned kro = (unsigned)((tid >> 3) * 64 + (((tid & 7) ^ ((tid >> 4) & 7)) * 8));
    const unsigned vo_g = (unsigned)((tid >> 4) * 128 + ((((((tid & 15) >> 1) ^ ((tid >> 4) & 7)) << 1) | (tid & 1)) * 8));
    int vo[8];
    { const int q = l16 >> 2, pp = l16 & 3, rr = 4 * g4 + q, sw = rr & 7, base = (int)(unsigned)(unsigned long long)lds + OFF_V + rr * 256 + 8 * pp;
#pragma unroll
      for (int vt = 0; vt < 8; ++vt) vo[vt] = base + ((vt ^ sw) << 5); }
    const int NT = nt_lat + 4;
#define TROW(jt) ((jt) < nt_lat ? lat0 + 64 * (jt) : ctx0 + 64 * ((jt) - nt_lat))
#define GLDS(gp, lp) __builtin_amdgcn_global_load_lds((const unsigned*)(gp), (LAS unsigned*)(lp), 16, 0, 0)
#define ISSUE_K(jt, b) do { const int R0_ = TROW(jt); const bf16* Kb_ = uni(KN + ((size_t)h * MTOT + R0_) * 128); const bf16* Rb_ = uni(KR + (size_t)R0_ * 64); \
    GLDS(Kb_ + ko, K_lds + (b) * SHM_K + wid * 1024); GLDS(Kb_ + ko + 32 * 128, K_lds + (b) * SHM_K + (wid + 8) * 1024); GLDS(Rb_ + kro, K_lds + (b) * SHM_K + OFF_KR + wid * 1024); } while (0)
#define ISSUE_V(jt, b) do { const int R0_ = TROW(jt); const bf16* Vb_ = uni(V + ((size_t)h * MTOT + R0_) * 128); \
    GLDS(Vb_ + vo_g, V_lds + (b) * SHM_V + wid * 1024); GLDS(Vb_ + vo_g + 32 * 128, V_lds + (b) * SHM_V + (wid + 8) * 1024); } while (0)
#define STEP_END() asm volatile("s_waitcnt vmcnt(0) lgkmcnt(0)\n\ts_barrier" ::: "memory")
#define RESC2(a0_, a1_) do { if (__any(fminf(a0_, a1_) < 1.f)) { _Pragma("unroll") for (int vt = 0; vt < 8; ++vt) { o[vt][0] = o[vt][0] * (a0_); o[vt][1] = o[vt][1] * (a1_); } } } while (0)
    STEP_END();
    ISSUE_K(0, 0);
    bf16x8 qf[2][4];
    { const bf16* Qw = uni(Q + (size_t)(qrow0 + wid * QBLK) * NQ + h * 192); const unsigned qo = (unsigned)(l16 * NQ + g4 * 8);
#pragma unroll
      for (int qt = 0; qt < 2; ++qt) {
#pragma unroll
        for (int ks = 0; ks < 4; ++ks) qf[qt][ks] = *(const bf16x8*)(Qw + qo + (unsigned)(qt * 16 * NQ + ks * 32));
#pragma unroll
        for (int ks = 4; ks < 6; ++ks) { const bf16x8 t = *(const bf16x8*)(Qw + qo + (unsigned)(qt * 16 * NQ + ks * 32)); *(LAS bf16x8*)(qrl + (qt * 2 + ks - 4) * 1024) = t; } } }
    P8 pA, pB; float aA0, aA1, aB0, aB1; bf16x8 pb[2][2];
    STEP_END();
    ISSUE_K(1, 1); ISSUE_V(0, 0);
    qkt2(pA, K_lds, qf, qrl, l16, g4, 0.f, 0.f); partial2_first(pA, m0, m1, aA0, aA1);
    STEP_END();
    for (int j = 1; j + 1 < NT; j += 2) {
        ISSUE_K(j + 1, 0); ISSUE_V(j, 1);
        SBAR(); qkt2(pB, K_lds + SHM_K, qf, qrl, l16, g4, -m0, -m1);
        finish2(pA, aA0, aA1, l0, l1, pb); SBAR();
        pv2<0>(o, vo, pb); partial2(pB, m0, m1, aB0, aB1);
        RESC2(aB0, aB1); STEP_END();
        ISSUE_K(j + 2, 1); ISSUE_V(j + 1, 0);
        SBAR(); qkt2(pA, K_lds, qf, qrl, l16, g4, -m0, -m1);
        finish2(pB, aB0, aB1, l0, l1, pb); SBAR();
        pv2<1>(o, vo, pb); partial2(pA, m0, m1, aA0, aA1);
        RESC2(aA0, aA1); STEP_END();
    }
    ISSUE_V(NT - 1, 1);
    SBAR(); qkt2(pB, K_lds + SHM_K, qf, qrl, l16, g4, -m0, -m1);
    finish2(pA, aA0, aA1, l0, l1, pb); SBAR();
    pv2<0>(o, vo, pb); partial2(pB, m0, m1, aB0, aB1);
    RESC2(aB0, aB1); STEP_END();
    finish2(pB, aB0, aB1, l0, l1, pb); SBAR();
    pv2<1>(o, vo, pb);
    STEP_END();
    { LAS unsigned char* mx = lds + wid * (32 * 272);
      const float r0 = __builtin_amdgcn_rcpf(l0), r1 = __builtin_amdgcn_rcpf(l1);
#pragma unroll
      for (int vt = 0; vt < 8; ++vt) { u32x2 w;
          w.x = cvtpk(o[vt][0][0] * r0, o[vt][0][1] * r0); w.y = cvtpk(o[vt][0][2] * r0, o[vt][0][3] * r0); *(LAS u32x2*)(mx + l16 * 272 + (16 * vt + 4 * g4) * 2) = w;
          w.x = cvtpk(o[vt][1][0] * r1, o[vt][1][1] * r1); w.y = cvtpk(o[vt][1][2] * r1, o[vt][1][3] * r1); *(LAS u32x2*)(mx + (16 + l16) * 272 + (16 * vt + 4 * g4) * 2) = w; }
      asm volatile("s_waitcnt lgkmcnt(0)" ::: "memory");
      const bf16* Gz = uni(G1 + (size_t)(qrow0 + wid * QBLK) * N_AB + G1_ZA + h * 128); bf16* Co = uni(CC + (size_t)(qrow0 + wid * QBLK) * MIXW + h * 128);
      int le = lane; asm volatile("" : "+v"(le));
#pragma unroll
      for (int i = 0; i < 8; ++i) { const int id = 64 * i + le, row = id >> 4, c8 = (id & 15) * 8;
          const v4u oq = *(const LAS v4u*)(mx + row * 272 + c8 * 2); const v4u zq = LDNT((const v4u*)(Gz + (unsigned)(row * N_AB + c8)));
          v4u wq;
#pragma unroll
          for (int e = 0; e < 4; ++e) wq[e] = cvtpk(bf_lo(oq[e]) * bf_lo(zq[e]), bf_hi(oq[e]) * bf_hi(zq[e]));
          *(v4u*)(Co + (unsigned)(row * MIXW + c8)) = wq;
          if ((i & 3) == 3) asm volatile("" ::: "memory"); } }
#undef TROW
#undef GLDS
#undef ISSUE_K
#undef ISSUE_V
#undef STEP_END
#undef RESC2
}
#undef PV2_MM
#undef PV2_W
}
#ifndef ATT_PRIO
#define ATT_PRIO 1
#endif
#ifndef ATT_BODY2
#define ATT_BODY2 0
#endif
__device__ __forceinline__ void attn_phase(KArgs a, LAS unsigned char* lds, int G) {
    const bf16* Q = (const bf16*)(a->ws + WS_Q); const bf16* KN = (const bf16*)(a->ws + WS_KN); const bf16* KR = (const bf16*)(a->ws + WS_KR); const bf16* V = (const bf16*)(a->ws + WS_V);
    const bf16* G1 = (const bf16*)(a->ws + WS_G1); bf16* CC = (bf16*)(a->ws + WS_CC);
    const int bx = blockIdx.x; const int vcu = (G % 8 == 0) ? (bx % 8) * (G / 8) + bx / 8 : bx;
    if (ATT_PRIO && __builtin_amdgcn_readfirstlane(threadIdx.x >> 6) >= 4) __builtin_amdgcn_s_setprio(1);
    for (int u = vcu; u < 2048 + 64; u += G) {
        if (u < 2048) { const int bh = u >> 5, qb = u & 31, b = bh >> 5, h = bh & 31;
            if (ATT_BODY2) att2::attn_unit2(Q, KN, KR, V, G1, CC, b * SEQ + qb * 256, h, 128, b * SEQ, MLAT + b * NCTX, lds); else att::attn_unit(Q, KN, KR, V, G1, CC, b * SEQ + qb * 256, h, 128, b * SEQ, MLAT + b * NCTX, lds); }
        else { const int bh = u - 2048, b = bh >> 5, h = bh & 31;
            if (ATT_BODY2) att2::attn_unit2(Q, KN, KR, V, G1, CC, MLAT + b * NCTX, h, 0, 0, MLAT + b * NCTX, lds); else att::attn_unit(Q, KN, KR, V, G1, CC, MLAT + b * NCTX, h, 0, 0, MLAT + b * NCTX, lds); }
    }
    if (ATT_PRIO) __builtin_amdgcn_s_setprio(0);
    __syncthreads();
}

__device__ __forceinline__ s16x4 tr_read_v(int addr) { s16x4 r; asm volatile("ds_read_b64_tr_b16 %0, %1" : "=&v"(r) : "v"(addr) : "memory"); return r; }
template <int CTRL> __device__ __forceinline__ float dpp_f(float x) { return __int_as_float(__builtin_amdgcn_update_dpp(0, __float_as_int(x), CTRL, 0xf, 0xf, true)); }
constexpr int SC_PITCH = 288;
constexpr int SC_QD = 0, SC_KD = 16 * SC_PITCH, SC_KE = 32 * SC_PITCH, SC_VV = 48 * SC_PITCH, SC_EB = 64 * SC_PITCH, SC_BUF = SC_EB + 512;
constexpr int SC_OST = 2 * SC_BUF;
__device__ __forceinline__ void scan_stage(LAS unsigned char* B, u32x2 rq, u32x2 rk, u32x2 rv, int wid, int lane, int tid) {
    const int t = lane & 15, kq = lane >> 4;
    float q[4], kk[4], x[4], tot[4];
    q[0] = bf_lo(rq.x); q[1] = bf_hi(rq.x); q[2] = bf_lo(rq.y); q[3] = bf_hi(rq.y); kk[0] = bf_lo(rk.x); kk[1] = bf_hi(rk.x); kk[2] = bf_lo(rk.y); kk[3] = bf_hi(rk.y);
#pragma unroll
    for (int e = 0; e < 4; ++e) { float g = __builtin_amdgcn_logf(fmaxf(1.0f - kk[e], 1e-30f)); float s = g;
        g += dpp_f<0x111>(g); g += dpp_f<0x112>(g); g += dpp_f<0x114>(g); g += dpp_f<0x118>(g);
        s += dpp_f<0x128>(s); s += dpp_f<0x124>(s); s += dpp_f<0x122>(s); s += dpp_f<0x121>(s);
        x[e] = g; tot[e] = s; }
    float qd[4], kd[4], ke[4];
#pragma unroll
    for (int e = 0; e < 4; ++e) { qd[e] = q[e] * __builtin_amdgcn_exp2f(x[e]); kd[e] = kk[e] * __builtin_amdgcn_exp2f(fminf(-x[e], 115.0f)); ke[e] = kk[e] * __builtin_amdgcn_exp2f(fminf(tot[e] - x[e], 0.0f)); }
    const int ppos = 32 * (wid >> 1) + 8 * kq + 4 * (wid & 1);
    u32x2 w;
    w.x = cvtpk(qd[0], qd[1]); w.y = cvtpk(qd[2], qd[3]); *(LAS u32x2*)(B + SC_QD + t * SC_PITCH + ppos * 2) = w;
    w.x = cvtpk(kd[0], kd[1]); w.y = cvtpk(kd[2], kd[3]); *(LAS u32x2*)(B + SC_KD + t * SC_PITCH + ppos * 2) = w;
    w.x = cvtpk(ke[0], ke[1]); w.y = cvtpk(ke[2], ke[3]); *(LAS u32x2*)(B + SC_KE + t * SC_PITCH + (16 * wid + 4 * kq) * 2) = w;
    if (t == 0) *(LAS f32x4*)(B + SC_EB + (16 * wid + 4 * kq) * 4) = (f32x4){__builtin_amdgcn_exp2f(tot[0]), __builtin_amdgcn_exp2f(tot[1]), __builtin_amdgcn_exp2f(tot[2]), __builtin_amdgcn_exp2f(tot[3])};
    *(LAS u32x2*)(B + SC_VV + (tid >> 5) * SC_PITCH + (tid & 31) * 8) = rv;
}
__device__ __forceinline__ void scan_phase(KArgs a, LAS unsigned char* lds, int G) {
    int tid_l = threadIdx.x; asm volatile("" : "+v"(tid_l)); const int tid = tid_l, lane = tid & 63, wid = __builtin_amdgcn_readfirstlane(tid >> 6), g4 = lane >> 4, l16 = lane & 15;
    const bf16* G1 = (const bf16*)(a->ws + WS_G1); const size_t TS = (size_t)MTOT * MIXW;
    const int ldsb = (int)(unsigned)(unsigned long long)lds;
    const int trq = l16 >> 2, trp = l16 & 3;
    const int st = lane & 15, sk = 16 * wid + 4 * (lane >> 4);
    const int vt_ = tid >> 5, vc = (tid & 31) * 4;
    for (int sq = blockIdx.x; sq < 256; sq += G) {
        const int dir = sq >> 7, b = (sq >> 6) & 1, h = sq & 63;
        const bf16* Tq = G1 + h * 128; const bf16* Tk = G1 + (size_t)(1 + dir) * TS + h * 128; const bf16* Tv = G1 + (size_t)3 * TS + h * 128;
        bf16* Od = (bf16*)(a->ws + WS_OF) + (size_t)dir * TS + h * 128;
        const unsigned oq = (unsigned)((dir ? 15 - st : st) * MIXW + sk), ovv = (unsigned)((dir ? 15 - vt_ : vt_) * MIXW + vc);
#define CLOW(c_) ((c_) < 16 ? MLAT + b * NCTX + (dir ? 240 - 16 * (c_) : 16 * (c_)) : b * SEQ + (dir ? 8432 - 16 * (c_) : 16 * (c_) - 256))
#define SLOADC(c_) do { const size_t lo_ = (size_t)CLOW(c_) * MIXW; rq = LDNT((const u32x2*)(uni(Tq + lo_) + oq)); rk = LDNT((const u32x2*)(uni(Tk + lo_) + oq)); rv = LDNT((const u32x2*)(uni(Tv + lo_) + ovv)); } while (0)
#define SBARRIER() do { asm volatile("s_waitcnt lgkmcnt(0)" ::: "memory"); __builtin_amdgcn_s_barrier(); asm volatile("" ::: "memory"); } while (0)
        f32x4 S[8];
#pragma unroll
        for (int i = 0; i < 8; ++i) S[i] = (f32x4){0.f, 0.f, 0.f, 0.f};
        u32x2 rq, rk, rv;
        SBARRIER();
        SLOADC(0); scan_stage(lds, rq, rk, rv, wid, lane, tid); SLOADC(1);
        SBARRIER();
        for (int c = 0; c < 528; ++c) {
            LAS unsigned char* Bc = lds + (c & 1) * SC_BUF;
            if (c > 0) { const u32x2 ov = *(const LAS u32x2*)(lds + SC_OST + ((c - 1) & 1) * 4096 + vt_ * 256 + vc * 2); *(u32x2*)(uni(Od + (size_t)CLOW(c - 1) * MIXW) + ovv) = ov; }
            if (c + 1 < 528) { scan_stage(lds + ((c + 1) & 1) * SC_BUF, rq, rk, rv, wid, lane, tid); if (c + 2 < 528) SLOADC(c + 2); }
            bf16x8 qf[4], kf[4]; f32x4 e4[8]; s16x4 kt4[8];
#pragma unroll
            for (int ks = 0; ks < 4; ++ks) { qf[ks] = *(const LAS bf16x8*)(Bc + SC_QD + l16 * SC_PITCH + (32 * ks + 8 * g4) * 2); kf[ks] = *(const LAS bf16x8*)(Bc + SC_KD + l16 * SC_PITCH + (32 * ks + 8 * g4) * 2); }
            const int trb = ldsb + (c & 1) * SC_BUF + (4 * g4 + trq) * SC_PITCH + 8 * trp;
            const s16x4 vt = tr_read_v(trb + SC_VV + 32 * wid);
#pragma unroll
            for (int kt = 0; kt < 8; ++kt) { e4[kt] = *(const LAS f32x4*)(Bc + SC_EB + (16 * kt + 4 * g4) * 4); kt4[kt] = tr_read_v(trb + SC_KE + 32 * kt); }
            f32x4 at = (f32x4){0.f, 0.f, 0.f, 0.f};
#pragma unroll
            for (int ks = 0; ks < 4; ++ks) at = mfma16(kf[ks], qf[ks], at);
#pragma unroll
            for (int r = 0; r < 4; ++r) at[r] = (4 * g4 + r <= l16) ? at[r] : 0.f;
            bf16x8 pa; { v4u w; w.x = cvtpk(at[0], at[1]); w.y = cvtpk(at[2], at[3]); w.z = 0u; w.w = 0u; pa = __builtin_bit_cast(bf16x8, w); }
            f32x4 o = (f32x4){0.f, 0.f, 0.f, 0.f};
#pragma unroll
            for (int ks = 0; ks < 4; ++ks) { v4u w; w.x = cvtpk(S[2 * ks][0], S[2 * ks][1]); w.y = cvtpk(S[2 * ks][2], S[2 * ks][3]); w.z = cvtpk(S[2 * ks + 1][0], S[2 * ks + 1][1]); w.w = cvtpk(S[2 * ks + 1][2], S[2 * ks + 1][3]);
                o = mfma16(qf[ks], __builtin_bit_cast(bf16x8, w), o); }
            asm volatile("s_waitcnt lgkmcnt(0)" ::: "memory"); SBAR();
            const bf16x8 vf = (bf16x8){vt[0], vt[1], vt[2], vt[3], 0, 0, 0, 0};
            o = mfma16(pa, vf, o);
#pragma unroll
            for (int kt = 0; kt < 8; ++kt) { const bf16x8 kef = (bf16x8){kt4[kt][0], kt4[kt][1], kt4[kt][2], kt4[kt][3], 0, 0, 0, 0};
                S[kt] = mfma16(kef, vf, S[kt] * e4[kt]); }
            { LAS bf16* ost = (LAS bf16*)(lds + SC_OST + (c & 1) * 4096);
#pragma unroll
              for (int r = 0; r < 4; ++r) ost[(4 * g4 + r) * 128 + 16 * wid + l16] = (bf16)(cvtpk(o[r], 0.f) & 0xffffu); }
            SBARRIER();
        }
        { const u32x2 ov = *(const LAS u32x2*)(lds + SC_OST + (527 & 1) * 4096 + vt_ * 256 + vc * 2); *(u32x2*)(uni(Od + (size_t)CLOW(527) * MIXW) + ovv) = ov; }
#undef CLOW
#undef SLOADC
#undef SBARRIER
    }
    asm volatile("s_waitcnt lgkmcnt(0)" ::: "memory"); __builtin_amdgcn_s_barrier(); asm volatile("" ::: "memory");
}

__device__ __forceinline__ void readout_phase(KArgs a, int jc, int nrows, int G) {
    int tid_l = threadIdx.x; asm volatile("" : "+v"(tid_l)); const int tid = tid_l, lane = tid & 63, wave = __builtin_amdgcn_readfirstlane(tid >> 6);
    const int gw = blockIdx.x * NWAVES + wave, NGW = G * NWAVES;
    const size_t TS = (size_t)MTOT * MIXW;
    const bf16* OFp = (const bf16*)(a->ws + WS_OF); const bf16* OBp = OFp + TS; const bf16* GS = (const bf16*)(a->ws + WS_G1) + 4 * TS; bf16* CC = (bf16*)(a->ws + WS_CC);
    const float* gnw = a->in[20] + (size_t)jc * 128 + (lane & 15) * 8;
    const f32x4 w0 = *(const f32x4*)gnw, w1 = *(const f32x4*)(gnw + 4);
    for (int it = gw; it < nrows * 16; it += NGW) {
        const size_t off = (size_t)(it >> 4) * MIXW + (it & 15) * 512 + lane * 8;
        const v4u f = LDNT((const v4u*)(OFp + off)), bq = LDNT((const v4u*)(OBp + off)), gq = LDNT((const v4u*)(GS + off));
        float o[8], gg[8];
#pragma unroll
        for (int e = 0; e < 4; ++e) { o[2 * e] = bf_lo(f[e]) + bf_lo(bq[e]); o[2 * e + 1] = bf_hi(f[e]) + bf_hi(bq[e]); gg[2 * e] = bf_lo(gq[e]); gg[2 * e + 1] = bf_hi(gq[e]); }
        float ss = 0.f;
#pragma unroll
        for (int e = 0; e < 8; ++e) ss += o[e] * o[e];
        ss += __shfl_xor(ss, 1); ss += __shfl_xor(ss, 2); ss += __shfl_xor(ss, 4); ss += __shfl_xor(ss, 8);
        const float r = 1.0f / sqrtf(ss * (1.0f / 128.0f) + EPS);
        v4u w; w.x = cvtpk(o[0] * r * w0[0] * gg[0], o[1] * r * w0[1] * gg[1]); w.y = cvtpk(o[2] * r * w0[2] * gg[2], o[3] * r * w0[3] * gg[3]);
        w.z = cvtpk(o[4] * r * w1[0] * gg[4], o[5] * r * w1[1] * gg[5]); w.w = cvtpk(o[6] * r * w1[2] * gg[6], o[7] * r * w1[3] * gg[7]);
        *(v4u*)(CC + off) = w;
    }
}

#ifndef EN_P0
#define EN_P0 1
#endif
#ifndef EN_NORM
#define EN_NORM 1
#endif
#ifndef EN_A1
#define EN_A1 1
#endif
#ifndef EN_A2
#define EN_A2 1
#endif
#ifndef EN_A3
#define EN_A3 1
#endif
#ifndef EN_ATT
#define EN_ATT 1
#endif
#ifndef EN_A5
#define EN_A5 1
#endif
#ifndef EN_C1
#define EN_C1 1
#endif
#ifndef EN_SCAN
#define EN_SCAN 1
#endif
#ifndef EN_RO
#define EN_RO 1
#endif
#ifndef EN_C4
#define EN_C4 1
#endif
#ifndef EN_SGU
#define EN_SGU 1
#endif
#ifndef EN_QUP
#define EN_QUP 1
#endif
#ifndef EN_KVUP
#define EN_KVUP 1
#endif
#ifndef PG8_ALIGNV
#define PG8_ALIGNV true
#endif
#ifndef PG8_SP2V
#define PG8_SP2V true
#endif
#ifndef PROBE_MASK
#define PROBE_MASK 0u
#endif
#define REPS(k) for (int rep_ = 0; rep_ < ((((PROBE_MASK) >> (k)) & 1u) ? 2 : 1); ++rep_)
#ifndef MK_ONE_LAUNCH
#define MK_ONE_LAUNCH 1
#endif
constexpr int N_PHASES = 28;
#define IN(k) (lo <= (k) && (k) < hi)
#define SEAM(k) do { if (IN(k) && IN((k) + 1)) xcd_barrier(bar); } while (0)
template <int p> __device__ __forceinline__ void layer_pair(LAS unsigned char* lds, const int G, const int lo, const int hi, const XcdBarrier& bar) {

        const int pb = 2 + 13 * p, lab = 2 * p, lc = 2 * p + 1;
        if (EN_A1 && IN(pb + 0)) REPS(pb + 0) {
            KArgs A = kargs(); unsigned char* const wsb = A->ws;
            pg8::Gemm g{(const pg8::bf16_t*)(wsb + WS_H), (const pg8::bf16_t*)(wsb + WS_WIN_AB) + (size_t)p * N_AB * DM, MTOT, N_AB, DM, DM}; pg8::LockstepOrder S; S.init(MTOT, N_AB, G, (int)blockIdx.x);
            pg8::EpiAB1 E{(pg8::bf16_t*)(wsb + WS_G1), N_AB};
            pg8::gemm_phase<pg8::EpiAB1, pg8::LockstepOrder, PG8_ALIGNV, PG8_SP2V>(lds, g, S, E);
            if (p0_defer_on(G)) { pg8::LockstepOrder S2; S2.init(MTOT, N_AB, G, (int)blockIdx.x); p0_deferred(kargs(), lds, S2, p == 0 ? 0 : 2); }
        } SEAM(pb + 0);
        if (EN_A2 && IN(pb + 1)) REPS(pb + 1) { a2_rows(kargs(), p, G); } SEAM(pb + 1);
        if (EN_SGU && IN(pb + 2)) REPS(pb + 2) { sgu_phase(kargs(), p, lds, G); }
        if (EN_QUP && IN(pb + 3)) REPS(pb + 3) {
            KArgs A = kargs(); unsigned char* const wsb = A->ws;
            pg8::Gemm g{(const pg8::bf16_t*)(wsb + WS_QN), (const pg8::bf16_t*)(wsb + WS_WQ) + (size_t)p * NQ * QL, MTOT, NQ, QL, QL}; pg8::LockstepOrder S; S.init(MTOT, NQ, G, (int)blockIdx.x);
            pg8::EpiQ E{(pg8::bf16_t*)(wsb + WS_Q), (const pg8::f32x2*)(wsb + WS_ROPE), MLAT, 0.07216878364870322f * 1.4426950408889634f};
            pg8::gemm_phase<pg8::EpiQ, pg8::LockstepOrder, PG8_ALIGNV, PG8_SP2V>(lds, g, S, E);
        }
        if (EN_KVUP && IN(pb + 4)) REPS(pb + 4) {
            KArgs A = kargs(); unsigned char* const wsb = A->ws;
            pg8::Gemm g{(const pg8::bf16_t*)(wsb + WS_KVN), (const pg8::bf16_t*)(wsb + WS_WKV) + (size_t)p * NKV * KVL, MTOT, NKV, KVL, KVL}; pg8::LockstepOrder S; S.init(MTOT, NKV, G, (int)((blockIdx.x + 64u) % (unsigned)G));
            pg8::EpiKV E{(pg8::bf16_t*)(wsb + WS_KN), (pg8::bf16_t*)(wsb + WS_V), MTOT};
            pg8::gemm_phase<pg8::EpiKV, pg8::LockstepOrder, PG8_ALIGNV, PG8_SP2V>(lds, g, S, E);
        } SEAM(pb + 4);
        if (EN_ATT && IN(pb + 5)) REPS(pb + 5) { attn_phase(kargs(), lds, G); } SEAM(pb + 5);
        if (EN_A5 && IN(pb + 6)) REPS(pb + 6) {
            KArgs A = kargs(); unsigned char* const wsb = A->ws;
            { pg8::Gemm g{(const pg8::bf16_t*)(wsb + WS_CC), (const pg8::bf16_t*)(wsb + WS_WO_AB) + (size_t)p * DM * MIXW, MLAT, DM, MIXW, MIXW}; pg8::LockstepOrder S; S.init(MLAT, DM, G, (int)blockIdx.x);
              pg8::EpiBf16P E{(pg8::bf16_t*)(wsb + WS_Y), DM};
              pg8::gemm_phase<pg8::EpiBf16P, pg8::LockstepOrder, PG8_ALIGNV, PG8_SP2V>(lds, g, S, E); }
            { pg8::Gemm g{(const pg8::bf16_t*)(wsb + WS_CC) + (size_t)MLAT * MIXW, (const pg8::bf16_t*)(wsb + WS_WO_AB) + (size_t)p * DM * MIXW, MTOT - MLAT, DM, MIXW / 8, MIXW}; pg8::SplitKOrder S; S.init(MTOT - MLAT, DM, 8, G, (int)blockIdx.x);
              pg8::EpiF32 E{(float*)(wsb + WS_YP), DM, (size_t)(MTOT - MLAT) * DM};
              pg8::gemm_phase<pg8::EpiF32, pg8::SplitKOrder, PG8_ALIGNV, PG8_SP2V>(lds, g, S, E); }
        } SEAM(pb + 6);
        if (EN_NORM && IN(pb + 7)) REPS(pb + 7) { norm_phase(kargs(), lab, lc, G); } SEAM(pb + 7);
        if (EN_C1 && IN(pb + 8)) REPS(pb + 8) {
            KArgs A = kargs(); unsigned char* const wsb = A->ws;
            pg8::Gemm g{(const pg8::bf16_t*)(wsb + WS_H), (const pg8::bf16_t*)(wsb + WS_WIN_C) + (size_t)p * N_C * DM, MTOT, N_C, DM, DM}; pg8::LockstepOrder S; S.init(MTOT, N_C, G, (int)blockIdx.x);
            pg8::EpiC1 E{(pg8::bf16_t*)(wsb + WS_G1), (size_t)MTOT * MIXW, (const float*)(wsb + WS_OML) + (size_t)p * 2 * 8192};
            pg8::gemm_phase<pg8::EpiC1, pg8::LockstepOrder, PG8_ALIGNV, PG8_SP2V>(lds, g, S, E);
            if (p0_defer_on(G)) { pg8::LockstepOrder S2; S2.init(MTOT, N_C, G, (int)blockIdx.x); p0_deferred(kargs(), lds, S2, p == 0 ? 1 : 3); }
        } SEAM(pb + 8);
        if (EN_SCAN && IN(pb + 9)) REPS(pb + 9) { scan_phase(kargs(), lds, G); } SEAM(pb + 9);
        if (EN_RO && IN(pb + 10)) REPS(pb + 10) { readout_phase(kargs(), p, lc == 3 ? MLAT : MTOT, G); } SEAM(pb + 10);
        if (EN_C4 && IN(pb + 11)) REPS(pb + 11) {
            KArgs A = kargs(); unsigned char* const wsb = A->ws;
            { pg8::Gemm g{(const pg8::bf16_t*)(wsb + WS_CC), (const pg8::bf16_t*)(wsb + WS_WO_C) + (size_t)p * DM * MIXW, MLAT, DM, MIXW, MIXW}; pg8::LockstepOrder S; S.init(MLAT, DM, G, (int)blockIdx.x);
              pg8::EpiBf16P E{(pg8::bf16_t*)(wsb + WS_Y), DM};
              pg8::gemm_phase<pg8::EpiBf16P, pg8::LockstepOrder, PG8_ALIGNV, PG8_SP2V>(lds, g, S, E); }
            if (lc != 3) { pg8::Gemm g{(const pg8::bf16_t*)(wsb + WS_CC) + (size_t)MLAT * MIXW, (const pg8::bf16_t*)(wsb + WS_WO_C) + (size_t)p * DM * MIXW, MTOT - MLAT, DM, MIXW / 8, MIXW}; pg8::SplitKOrder S; S.init(MTOT - MLAT, DM, 8, G, (int)blockIdx.x);
              pg8::EpiF32 E{(float*)(wsb + WS_YP), DM, (size_t)(MTOT - MLAT) * DM};
              pg8::gemm_phase<pg8::EpiF32, pg8::SplitKOrder, PG8_ALIGNV, PG8_SP2V>(lds, g, S, E); }
        } SEAM(pb + 11);
        if (EN_NORM && IN(pb + 12)) REPS(pb + 12) { norm_phase(kargs(), lc, lc + 1, G); } SEAM(pb + 12);
    }
#undef IN
#undef SEAM
__global__ void __launch_bounds__(NWAVES * 64, 2) fwd(Args a) {
    extern __shared__ __attribute__((aligned(16))) unsigned char lds_raw[];
    LAS unsigned char* lds = (LAS unsigned char*)lds_raw;
    int tid_l = threadIdx.x; asm volatile("" : "+v"(tid_l)); const int tid = tid_l, G = gridDim.x;
    for (int u = tid; u < (LDS_BYTES - LDSCTL_OFF) / 4; u += NWAVES * 64) ((LAS unsigned*)(lds + LDSCTL_OFF))[u] = 0u;
    __syncthreads();
    XcdBarrier bar; bar.bar = (unsigned*)(a.ws + WS_CTL) + CW_BAR; bar.x = 0; bar.st = nullptr;
    if (MK_ONE_LAUNCH) bar = xcd_barrier_post((unsigned*)(a.ws + WS_CTL) + CW_BAR, (volatile LAS unsigned*)(lds + MISC_OFF));
    const int lo = a.ph_lo, hi = a.ph_hi;
#define IN(k) (lo <= (k) && (k) < hi)
#define SEAM(k) do { if (IN(k) && IN((k) + 1)) xcd_barrier(bar); } while (0)
    if (EN_P0 && IN(0)) REPS(0) { p0_prologue(kargs(), lds, G); } SEAM(0);
    if (EN_NORM && IN(1)) REPS(1) { norm_phase(kargs(), -1, 0, G); } SEAM(1);
    layer_pair<0>(lds, G, lo, hi, bar);
    layer_pair<1>(lds, G, lo, hi, bar);
#undef IN
#undef SEAM
}

extern "C" void kernel_launch(void* const* d_in, const int* in_sizes, int n_in, void* d_out, int out_size, void* d_ws, size_t ws_size, hipStream_t stream) {
    static int grid = 0;
    if (grid == 0) {
        if (n_in != 22 || out_size != MLAT * DM || ws_size < WS_END) { fprintf(stderr, "kernel_launch: unexpected shapes (n_in %d, out %d, ws %zu, need %zu)\n", n_in, out_size, ws_size, (size_t)WS_END); grid = -1; return; }
        int dev = 0, cus = 0, per_cu = 0;
        if (hipGetDevice(&dev) != hipSuccess || hipDeviceGetAttribute(&cus, hipDeviceAttributeMultiprocessorCount, dev) != hipSuccess) { grid = -1; return; }
        if (hipFuncSetAttribute((const void*)fwd, hipFuncAttributeMaxDynamicSharedMemorySize, LDS_BYTES) != hipSuccess) { fprintf(stderr, "kernel_launch: hipFuncSetAttribute failed\n"); grid = -1; return; }
        if (hipOccupancyMaxActiveBlocksPerMultiprocessor(&per_cu, (const void*)fwd, NWAVES * 64, LDS_BYTES) != hipSuccess || per_cu < 1) fprintf(stderr, "kernel_launch: occupancy query reports %d\n", per_cu);
        (void)hipGetLastError();
        grid = cus;
    }
    if (grid < 0) return;
    (void)hipMemsetAsync((char*)d_ws + WS_CTL, 0, 65536, stream);
    Args a{};
    for (int i = 0; i < 22; ++i) a.in[i] = (const float*)d_in[i];
    a.out = (float*)d_out; a.ws = (unsigned char*)d_ws;
#if MK_ONE_LAUNCH
    a.ph_lo = 0; a.ph_hi = N_PHASES;
    hipLaunchKernelGGL(fwd, dim3(grid), dim3(NWAVES * 64), LDS_BYTES, stream, a);
#else
    for (int p = 0; p < N_PHASES; ++p) { a.ph_lo = p; a.ph_hi = p + 1; hipLaunchKernelGGL(fwd, dim3(grid), dim3(NWAVES * 64), LDS_BYTES, stream, a); }
#endif
}
```

```cpp
#include <hip/hip_runtime.h>
#include <cstdio>
#include <cstdint>
namespace pg8 {
#define PG8_LAS __attribute__((address_space(3)))
typedef unsigned short bf16_t;
typedef short bf16x8 __attribute__((ext_vector_type(8)));
typedef float f32x4 __attribute__((ext_vector_type(4)));
typedef unsigned u32x4 __attribute__((ext_vector_type(4)));
constexpr int BM = 256, BK = 64, HALF = 128, HTB = HALF * BK * 2  , STAGE_BYTES = 8 * HTB, NXCD = 8, WGM = 4;

__host__ __device__ __forceinline__ int lds_byte(int r, int c) { const int st = (r >> 4) * 2 + (c >> 5), rr = r & 15, cc = c & 31, ob = rr * 64 + cc * 2; return st * 1024 + (ob ^ (((ob >> 9) & 1) << 5)); }
__host__ __device__ __forceinline__ void stage_rc(int b, int& R, int& C) { const int st = b / 1024, sb = b % 1024, swz = sb ^ (((sb >> 9) & 1) << 5); R = (st >> 1) * 16 + swz / 64; C = (st & 1) * 32 + (swz % 64) / 2; }
__host__ __device__ __forceinline__ int perm32(int rho) { const int n = rho >> 4, i = rho & 15; return 8 * (i >> 2) + 4 * n + (i & 3); }

struct Unit { int pm, pn, kc; };
struct Gemm { const bf16_t* A; const bf16_t* Bt; int M, N, K, ld; };

struct StaticOrder {
    int nM, nN, nwg, G, c;
    __host__ __device__ void init(int M, int N, int G_, int c_) { nM = M / BM; nN = N / BM; nwg = nM * nN; G = G_; c = c_; }
    __host__ __device__ bool next(int i, Unit& u) const {
        const long L = (long)i * G + c; if (L >= nwg) return false;
        int wgid = (int)L; { const int q = nwg / NXCD, r = nwg % NXCD, xcd = wgid % NXCD, off = wgid / NXCD; wgid = (xcd < r ? xcd * (q + 1) : r * (q + 1) + (xcd - r) * q) + off; }
        const int nig = WGM * nN, gid = wgid / nig, fm = gid * WGM, gsz = (nM - fm) < WGM ? (nM - fm) : WGM;
        u.pm = fm + ((wgid % nig) % gsz); u.pn = (wgid % nig) / gsz; u.kc = 0; return true;
    }
    __device__ __forceinline__ void a_ready(const Unit&) const {}
    __device__ __forceinline__ void done(const Unit&) const {}
};
struct LockstepOrder {
    static constexpr int LW = 4;
    int nM, nN, G, c, x, k, nk, PG, r0, gR, qR, rR, lenx;
    __host__ __device__ void init(int M, int N, int G_, int c_) { nM = M / BM; nN = N / BM; G = G_; c = c_; x = c_ % NXCD; k = c_ / NXCD; nk = G_ / NXCD; PG = (nM / LW) / NXCD; r0 = PG * NXCD * LW; gR = nM - r0;
        const int rem = gR * nN; qR = rem / NXCD; rR = rem % NXCD; lenx = PG * LW * nN + qR + (x < rR ? 1 : 0); }
    __host__ __device__ bool next(int i, Unit& u) const {
        if (G % NXCD != 0) { const long L = (long)i * G + c; if (L >= (long)nM * nN) return false; u.kc = 0; u.pm = (int)(L / nN); u.pn = (int)(L % nN); return true; }
        const int off = i * nk + k; if (off >= lenx) return false; u.kc = 0;
        const int lock = PG * LW * nN;
        if (off < lock) { const int j = off / (LW * nN), o2 = off % (LW * nN); u.pm = (j * NXCD + x) * LW + o2 % LW; u.pn = o2 / LW; }
        else { const int rho = (x < rR ? x * (qR + 1) : rR * (qR + 1) + (x - rR) * qR) + (off - lock); u.pm = r0 + rho % gR; u.pn = rho / gR; }
        return true;
    }
    __device__ __forceinline__ void a_ready(const Unit&) const {}
    __device__ __forceinline__ void done(const Unit&) const {}
};
struct SplitKOrder {
    int nM, nN, KS, nwg, G, c;
    __host__ __device__ void init(int M, int N, int KS_, int G_, int c_) { nM = M / BM; nN = N / BM; KS = KS_; nwg = nM * nN * KS; G = G_; c = c_; }
    __host__ __device__ bool next(int i, Unit& u) const { const long L = (long)i * G + c; if (L >= nwg) return false; const int l = (int)L; u.kc = l % KS; u.pn = (l / KS) % nN; u.pm = l / (KS * nN); return true; }
    __device__ __forceinline__ void a_ready(const Unit&) const {}
    __device__ __forceinline__ void done(const Unit&) const {}
};

typedef float f32x2 __attribute__((ext_vector_type(2)));
typedef __bf16 bf16x2_c __attribute__((ext_vector_type(2)));
__device__ __forceinline__ unsigned cvt_pk_bf16(float lo, float hi) { const f32x2 v = {lo, hi}; const bf16x2_c b = __builtin_convertvector(v, bf16x2_c); return __builtin_bit_cast(unsigned, b); }
__device__ __forceinline__ f32x2 gelu_pk(f32x2 v) {
    const f32x2 av = __builtin_elementwise_abs(v), d = av * 0.2316418882f + 1.0f;
    f32x2 t; t.x = __builtin_amdgcn_rcpf(d.x); t.y = __builtin_amdgcn_rcpf(d.y);
    f32x2 q = t * 0.5307027145f + (-0.7265760135f); q = q * t + 0.7107068705f; q = q * t + (-0.142248368f); q = q * t + 0.127414796f; q = q * t;
    const f32x2 s = (v * v) * (-0.72134752044f);
    f32x2 e; e.x = __builtin_amdgcn_exp2f(s.x); e.y = __builtin_amdgcn_exp2f(s.y);
    const f32x2 m = v * (q * e), r = v - m;
    f32x2 o; o.x = v.x < 0.f ? m.x : r.x; o.y = v.y < 0.f ? m.y : r.y; return o;
}

typedef unsigned u32x2 __attribute__((ext_vector_type(2)));
__device__ __forceinline__ float silu_f(float x) { return x * __builtin_amdgcn_rcpf(1.0f + __builtin_amdgcn_exp2f(-1.4426950408889634f * x)); }
__device__ __forceinline__ float sigmoid_neg_f(float x) { return __builtin_amdgcn_rcpf(1.0f + __builtin_amdgcn_exp2f(1.4426950408889634f * x)); }
__device__ __forceinline__ f32x4 act4(f32x4 v, int act) {
    if (act == 1) { v[0] = silu_f(v[0]); v[1] = silu_f(v[1]); v[2] = silu_f(v[2]); v[3] = silu_f(v[3]); }
    else if (act == 2) { const f32x2 a = gelu_pk((f32x2){v[0], v[1]}), b = gelu_pk((f32x2){v[2], v[3]}); v = (f32x4){a.x, a.y, b.x, b.y}; }
    return v;
}
struct EpiF32 {
    static constexpr bool PERM = false, AFTER_DRAIN = false;
    float* C0; int ldc; size_t kstride;
    __device__ __forceinline__ void operator()(const f32x4 (&acc)[2][2][4][2], const Unit& u, int wr, int wc, int fr, int fq) const {
        float* C = C0 + (size_t)u.kc * kstride;
        const int row0 = u.pm * BM + wr * 64 + fr, col0 = u.pn * BM + wc * 32 + 4 * fq;
#pragma unroll
        for (int ai = 0; ai < 2; ++ai)
#pragma unroll
            for (int m = 0; m < 4; ++m) { float* rowp = C + (size_t)(row0 + ai * HALF + m * 16) * ldc + col0;
#pragma unroll
                for (int bj = 0; bj < 2; ++bj)
#pragma unroll
                    for (int n = 0; n < 2; ++n) *(f32x4*)(rowp + bj * HALF + n * 16) = acc[ai][bj][m][n]; }
    }
};
struct EpiBf16P {
    static constexpr bool PERM = true, AFTER_DRAIN = false;
    bf16_t* O; int ldc;
    __device__ __forceinline__ void operator()(const f32x4 (&acc)[2][2][4][2], const Unit& u, int wr, int wc, int fr, int fq) const {
        const int row0 = u.pm * BM + wr * 64 + fr, col0 = u.pn * BM + wc * 32 + 8 * fq;
#pragma unroll
        for (int ai = 0; ai < 2; ++ai)
#pragma unroll
            for (int m = 0; m < 4; ++m) { bf16_t* rowp = O + (size_t)(row0 + ai * HALF + m * 16) * ldc + col0;
#pragma unroll
                for (int bj = 0; bj < 2; ++bj) { const f32x4 v0 = acc[ai][bj][m][0], v1 = acc[ai][bj][m][1];
                    u32x4 w; w.x = cvt_pk_bf16(v0[0], v0[1]); w.y = cvt_pk_bf16(v0[2], v0[3]); w.z = cvt_pk_bf16(v1[0], v1[1]); w.w = cvt_pk_bf16(v1[2], v1[3]);
                    *(u32x4*)(rowp + bj * HALF) = w; } }
    }
};
struct EpiAB1 {
    static constexpr bool PERM = true, AFTER_DRAIN = false;
    bf16_t* O; int ldc;
    __device__ __forceinline__ void operator()(const f32x4 (&acc)[2][2][4][2], const Unit& u, int wr, int wc, int fr, int fq) const {
        const int act = u.pn < 7 ? 0 : ((u.pn < 23 || u.pn >= 55) ? 1 : 2);
        const int row0 = u.pm * BM + wr * 64 + fr, col0 = u.pn * BM + wc * 32 + 8 * fq;
#pragma unroll
        for (int ai = 0; ai < 2; ++ai)
#pragma unroll
            for (int m = 0; m < 4; ++m) { bf16_t* rowp = O + (size_t)(row0 + ai * HALF + m * 16) * ldc + col0;
#pragma unroll
                for (int bj = 0; bj < 2; ++bj) { const f32x4 v0 = act4(acc[ai][bj][m][0], act), v1 = act4(acc[ai][bj][m][1], act);
                    u32x4 w; w.x = cvt_pk_bf16(v0[0], v0[1]); w.y = cvt_pk_bf16(v0[2], v0[3]); w.z = cvt_pk_bf16(v1[0], v1[1]); w.w = cvt_pk_bf16(v1[2], v1[3]);
                    *(u32x4*)(rowp + bj * HALF) = w; } }
    }
};
struct EpiC1 {
    static constexpr bool PERM = true, AFTER_DRAIN = false;
    bf16_t* O; size_t stride; const float* oml;
    __device__ __forceinline__ void operator()(const f32x4 (&acc)[2][2][4][2], const Unit& u, int wr, int wc, int fr, int fq) const {
        const int region = u.pn >> 5; bf16_t* base = O + (size_t)region * stride;
        const int row0 = u.pm * BM + wr * 64 + fr, col0 = (u.pn & 31) * BM + wc * 32 + 8 * fq;
        const bool gate = (region == 1 || region == 2); const int act = (region == 0 || region == 4) ? 1 : 0;
        f32x4 gv[2][2];
#pragma unroll
        for (int bj = 0; bj < 2; ++bj)
#pragma unroll
            for (int n = 0; n < 2; ++n) gv[bj][n] = gate ? *(const f32x4*)(oml + (size_t)(region - 1) * 8192 + col0 + bj * HALF + 4 * n) : (f32x4){1.f, 1.f, 1.f, 1.f};
#pragma unroll
        for (int ai = 0; ai < 2; ++ai)
#pragma unroll
            for (int m = 0; m < 4; ++m) { bf16_t* rowp = base + (size_t)(row0 + ai * HALF + m * 16) * 8192 + col0;
#pragma unroll
                for (int bj = 0; bj < 2; ++bj) { f32x4 v0 = acc[ai][bj][m][0], v1 = acc[ai][bj][m][1];
                    if (gate) {
#pragma unroll
                        for (int j = 0; j < 4; ++j) { v0[j] = gv[bj][0][j] * sigmoid_neg_f(v0[j]); v1[j] = gv[bj][1][j] * sigmoid_neg_f(v1[j]); } }
                    else { v0 = act4(v0, act); v1 = act4(v1, act); }
                    u32x4 w; w.x = cvt_pk_bf16(v0[0], v0[1]); w.y = cvt_pk_bf16(v0[2], v0[3]); w.z = cvt_pk_bf16(v1[0], v1[1]); w.w = cvt_pk_bf16(v1[2], v1[3]);
                    *(u32x4*)(rowp + bj * HALF) = w; } }
    }
};
struct EpiQ {
    static constexpr bool PERM = true, AFTER_DRAIN = false;
    bf16_t* O; const f32x2* rope; int nlat; float qscale;
    __device__ __forceinline__ void operator()(const f32x4 (&acc)[2][2][4][2], const Unit& u, int wr, int wc, int fr, int fq) const {
        const int row0 = u.pm * BM + wr * 64 + fr; const bool upper = fq >= 2;
#pragma unroll
        for (int bj = 0; bj < 2; ++bj) {
            const int G = 8 * u.pn + 4 * bj + wc, hm = G % 6, col = u.pn * BM + bj * HALF + wc * 32 + 8 * fq;
#pragma unroll
            for (int ai = 0; ai < 2; ++ai)
#pragma unroll
                for (int m = 0; m < 4; ++m) { const int row = row0 + ai * HALF + m * 16; f32x4 x0 = acc[ai][bj][m][0], x1 = acc[ai][bj][m][1];
                    if (hm >= 4 && u.pm * BM < nlat) {
                        const int t = row & 8191, pos = (hm == 4) ? (t >> 6) : (t & 63); const f32x2* cs = rope + pos * 16 + 8 * (fq & 1);
#pragma unroll
                        for (int j = 0; j < 4; ++j) {
                            { auto rr = __builtin_amdgcn_permlane32_swap(__float_as_uint(x0[j]), __float_as_uint(x0[j]), false, false); const float pv = __uint_as_float(upper ? rr[0] : rr[1]); const f32x2 c = cs[j];
                              x0[j] = upper ? x0[j] * c.x + pv * c.y : x0[j] * c.x - pv * c.y; }
                            { auto rr = __builtin_amdgcn_permlane32_swap(__float_as_uint(x1[j]), __float_as_uint(x1[j]), false, false); const float pv = __uint_as_float(upper ? rr[0] : rr[1]); const f32x2 c = cs[4 + j];
                              x1[j] = upper ? x1[j] * c.x + pv * c.y : x1[j] * c.x - pv * c.y; } } }
                    x0 = x0 * qscale; x1 = x1 * qscale;
                    u32x4 w; w.x = cvt_pk_bf16(x0[0], x0[1]); w.y = cvt_pk_bf16(x0[2], x0[3]); w.z = cvt_pk_bf16(x1[0], x1[1]); w.w = cvt_pk_bf16(x1[2], x1[3]);
                    *(u32x4*)(O + (size_t)row * 6144 + col) = w; }
        }
    }
};
struct EpiKV {
    static constexpr bool PERM = true, AFTER_DRAIN = false;
    bf16_t* KN; bf16_t* V; int mtot;
    __device__ __forceinline__ void operator()(const f32x4 (&acc)[2][2][4][2], const Unit& u, int wr, int wc, int fr, int fq) const {
        const int row0 = u.pm * BM + wr * 64 + fr, colh = wc * 32 + 8 * fq;
#pragma unroll
        for (int ai = 0; ai < 2; ++ai)
#pragma unroll
            for (int m = 0; m < 4; ++m) { const size_t off = ((size_t)u.pn * mtot + (size_t)(row0 + ai * HALF + m * 16)) * 128 + colh;
#pragma unroll
                for (int bj = 0; bj < 2; ++bj) { const f32x4 v0 = acc[ai][bj][m][0], v1 = acc[ai][bj][m][1];
                    u32x4 w; w.x = cvt_pk_bf16(v0[0], v0[1]); w.y = cvt_pk_bf16(v0[2], v0[3]); w.z = cvt_pk_bf16(v1[0], v1[1]); w.w = cvt_pk_bf16(v1[2], v1[3]);
                    *(u32x4*)((bj ? V : KN) + off) = w; } }
    }
};

template <class Epi, class Sched, bool ALIGN_EPI = false, bool SP2 = false>
__device__ __forceinline__ void gemm_phase(PG8_LAS unsigned char* lds, const Gemm g, const Sched& S, const Epi& E) {
    int tid_l = threadIdx.x; asm volatile("" : "+v"(tid_l)); const int tid = tid_l, wid = __builtin_amdgcn_readfirstlane(tid >> 6), lane = tid & 63, wr = wid >> 2, wc = wid & 3, fr = lane & 15, fq = lane >> 4;
    const int K = g.ld, nt = g.K / BK;
    unsigned voffA[2], voffB[2];
#pragma unroll
    for (int i = 0; i < 2; ++i) { int R, C; stage_rc(tid * 16 + i * 8192, R, C); const int Rb = Epi::PERM ? ((R & ~31) + perm32(R & 31)) : R;
        voffA[i] = (unsigned)(R * K + C) * 2u; voffB[i] = (unsigned)(Rb * K + C) * 2u; }
    const size_t kstep = (size_t)(BK * 2);
    const size_t hstep = (size_t)HALF * K * 2;
    const size_t tstep = 2 * hstep;
    const unsigned ldsw = (unsigned)wid * 1024u;
    const int aoff = lds_byte(wr * 64 + fr, fq * 8), boff = lds_byte(wc * 32 + fr, fq * 8);
#define PG8_SA(b, h) (((b) * 2 + (h)) * HTB)
#define PG8_SB(b, h) ((4 + (b) * 2 + (h)) * HTB)
#define PG8_STAGE(bufoff, gbase, voff) do { const char* gb_ = (const char*)(gbase); asm volatile("" : "+s"(gb_)); _Pragma("unroll") for (int _i = 0; _i < 2; ++_i) { unsigned vo_ = (voff)[_i]; asm volatile("" : "+v"(vo_)); \
        __builtin_amdgcn_global_load_lds((const unsigned*)(gb_ + vo_), (PG8_LAS unsigned*)(lds + (bufoff) + ldsw + _i * 8192), 16, 0, 0); } } while (0)
#define PG8_LDA(dst, b, h) do { _Pragma("unroll") for (int m = 0; m < 4; ++m) _Pragma("unroll") for (int k = 0; k < 2; ++k) dst[m][k] = *(const PG8_LAS bf16x8*)(lds + PG8_SA(b, h) + aoff + m * 2048 + k * 1024); } while (0)
#define PG8_LDB(dst, b, h) do { _Pragma("unroll") for (int n = 0; n < 2; ++n) _Pragma("unroll") for (int k = 0; k < 2; ++k) dst[n][k] = *(const PG8_LAS bf16x8*)(lds + PG8_SB(b, h) + boff + n * 2048 + k * 1024); } while (0)
#define PG8_MMA(ai, bj, At, Bt) do { __builtin_amdgcn_sched_barrier(0); _Pragma("unroll") for (int m = 0; m < 4; ++m) _Pragma("unroll") for (int n = 0; n < 2; ++n) _Pragma("unroll") for (int k = 0; k < 2; ++k) \
        acc[ai][bj][m][n] = __builtin_amdgcn_mfma_f32_16x16x32_bf16(Bt[n][k], At[m][k], acc[ai][bj][m][n], 0, 0, 0); __builtin_amdgcn_sched_barrier(0); } while (0)
#define PG8_WAIT_V(n) asm volatile("s_waitcnt vmcnt(" #n ")" ::: "memory")
#define PG8_WAIT_L(n) asm volatile("s_waitcnt lgkmcnt(" #n ")" ::: "memory")
#define PG8_BAR __builtin_amdgcn_s_barrier()
#define PG8_SCHED __builtin_amdgcn_sched_barrier(0)
    if (wr == 0) __builtin_amdgcn_s_setprio(1);
    Unit cur, nxt; int ui = 0;
    if (!S.next(0, cur)) { __builtin_amdgcn_s_setprio(0); return; }
    f32x4 acc[2][2][4][2];
#pragma unroll
    for (int a = 0; a < 2; ++a)
#pragma unroll
        for (int b = 0; b < 2; ++b)
#pragma unroll
            for (int m = 0; m < 4; ++m)
#pragma unroll
                for (int n = 0; n < 2; ++n) acc[a][b][m][n] = (f32x4){0.f, 0.f, 0.f, 0.f};
    bf16x8 At[4][2], B0[2][2], B1[2][2];
    const size_t kcb = (size_t)g.K * 2;
    const char* cA = (const char*)g.A + (size_t)cur.pm * tstep + cur.kc * kcb; const char* cB = (const char*)g.Bt + (size_t)cur.pn * tstep + cur.kc * kcb;
    S.a_ready(cur);
    if constexpr (SP2) {
        PG8_STAGE(PG8_SB(0, 0), cB, voffB); PG8_STAGE(PG8_SB(0, 1), cB + hstep, voffB); PG8_STAGE(PG8_SA(0, 0), cA, voffA); PG8_STAGE(PG8_SA(0, 1), cA + hstep, voffA);
        if (wr == 1) PG8_BAR;
        PG8_WAIT_V(2); PG8_BAR;
        PG8_STAGE(PG8_SB(1, 0), cB + kstep, voffB); PG8_STAGE(PG8_SA(1, 0), cA + kstep, voffA); PG8_STAGE(PG8_SB(1, 1), cB + hstep + kstep, voffB);
        PG8_WAIT_V(6); PG8_BAR;
    } else {
        PG8_STAGE(PG8_SB(0, 0), cB, voffB); PG8_STAGE(PG8_SA(0, 0), cA, voffA); PG8_STAGE(PG8_SB(0, 1), cB + hstep, voffB); PG8_STAGE(PG8_SA(0, 1), cA + hstep, voffA);
        if (wr == 1) PG8_BAR;
        PG8_WAIT_V(4); PG8_BAR;
        PG8_STAGE(PG8_SB(1, 0), cB + kstep, voffB); PG8_STAGE(PG8_SA(1, 0), cA + kstep, voffA); PG8_STAGE(PG8_SB(1, 1), cB + hstep + kstep, voffB);
        PG8_WAIT_V(6); PG8_BAR;
    }
    for (;;) {
        const bool has_next = S.next(ui + 1, nxt);
        const char* nA = has_next ? (const char*)g.A + (size_t)nxt.pm * tstep + nxt.kc * kcb : cA; const char* nB = has_next ? (const char*)g.Bt + (size_t)nxt.pn * tstep + nxt.kc * kcb : cB;
        for (int t = 0; t < nt; t += 2) {
            const bool last = (t == nt - 2);
            const char* a1 = cA + (size_t)(t + 1) * kstep;
            const char* a2 = last ? nA : cA + (size_t)(t + 2) * kstep; const char* b2 = last ? nB : cB + (size_t)(t + 2) * kstep;
            const char* a3 = a2 + kstep; const char* b3 = b2 + kstep;
            if (last && has_next) S.a_ready(nxt);
            if constexpr (SP2) {
            PG8_LDB(B0, 0, 0); PG8_LDB(B1, 0, 1); PG8_SCHED; PG8_LDA(At, 0, 0); PG8_STAGE(PG8_SA(1, 1), a1 + hstep, voffA);
            PG8_WAIT_V(8); PG8_WAIT_L(0); PG8_BAR; PG8_MMA(0, 0, At, B0); PG8_MMA(0, 1, At, B1); PG8_BAR; PG8_SCHED;
            PG8_LDA(At, 0, 1); PG8_STAGE(PG8_SB(0, 0), b2, voffB); PG8_STAGE(PG8_SB(0, 1), b2 + hstep, voffB); PG8_STAGE(PG8_SA(0, 0), a2, voffA);
            PG8_WAIT_V(8); PG8_WAIT_L(0); PG8_BAR; PG8_MMA(1, 0, At, B0); PG8_MMA(1, 1, At, B1); PG8_BAR; PG8_SCHED;
            PG8_LDB(B0, 1, 0); PG8_LDB(B1, 1, 1); PG8_SCHED; PG8_LDA(At, 1, 0); PG8_STAGE(PG8_SA(0, 1), a2 + hstep, voffA);
            PG8_WAIT_V(8); PG8_WAIT_L(0); PG8_BAR; PG8_MMA(0, 0, At, B0); PG8_MMA(0, 1, At, B1); PG8_BAR; PG8_SCHED;
            PG8_LDA(At, 1, 1); PG8_STAGE(PG8_SB(1, 0), b3, voffB); PG8_STAGE(PG8_SB(1, 1), b3 + hstep, voffB); PG8_STAGE(PG8_SA(1, 0), a3, voffA);
            PG8_WAIT_V(8); PG8_WAIT_L(0); PG8_BAR; PG8_MMA(1, 0, At, B0); PG8_MMA(1, 1, At, B1); PG8_BAR; PG8_SCHED;
            } else {
            PG8_LDB(B0, 0, 0); PG8_SCHED; PG8_LDA(At, 0, 0); PG8_STAGE(PG8_SA(1, 1), a1 + hstep, voffA);
            PG8_WAIT_L(8); PG8_BAR; PG8_WAIT_L(0); PG8_MMA(0, 0, At, B0); PG8_BAR; PG8_SCHED;
            PG8_LDB(B1, 0, 1); PG8_STAGE(PG8_SB(0, 0), b2, voffB);
            PG8_BAR; PG8_WAIT_L(0); PG8_MMA(0, 1, At, B1); PG8_BAR;
            PG8_LDA(At, 0, 1); PG8_STAGE(PG8_SA(0, 0), a2, voffA);
            PG8_BAR; PG8_WAIT_L(0); PG8_MMA(1, 0, At, B0); PG8_BAR; PG8_SCHED;
            PG8_STAGE(PG8_SB(0, 1), b2 + hstep, voffB);
            PG8_WAIT_V(6); PG8_BAR; PG8_MMA(1, 1, At, B1); PG8_BAR;
            PG8_LDB(B0, 1, 0); PG8_SCHED; PG8_LDA(At, 1, 0); PG8_STAGE(PG8_SA(0, 1), a2 + hstep, voffA);
            PG8_WAIT_L(8); PG8_BAR; PG8_WAIT_L(0); PG8_MMA(0, 0, At, B0); PG8_BAR; PG8_SCHED;
            PG8_LDB(B1, 1, 1); PG8_STAGE(PG8_SB(1, 0), b3, voffB);
            PG8_BAR; PG8_WAIT_L(0); PG8_MMA(0, 1, At, B1); PG8_BAR;
            PG8_LDA(At, 1, 1); PG8_STAGE(PG8_SA(1, 0), a3, voffA);
            PG8_BAR; PG8_WAIT_L(0); PG8_MMA(1, 0, At, B0); PG8_BAR; PG8_SCHED;
            PG8_STAGE(PG8_SB(1, 1), b3 + hstep, voffB);
            PG8_WAIT_V(6); PG8_BAR; PG8_MMA(1, 1, At, B1); PG8_BAR;
            }
        }
        if constexpr (ALIGN_EPI) { if (wr == 0) PG8_BAR; }
        if constexpr (!Epi::AFTER_DRAIN) { E(acc, cur, wr, wc, fr, fq); S.done(cur); }
        if (!has_next) break;
#pragma unroll
        for (int a = 0; a < 2; ++a)
#pragma unroll
            for (int b = 0; b < 2; ++b)
#pragma unroll
                for (int m = 0; m < 4; ++m)
#pragma unroll
                    for (int n = 0; n < 2; ++n) acc[a][b][m][n] = (f32x4){0.f, 0.f, 0.f, 0.f};
        cur = nxt; cA = nA; cB = nB; ++ui;
        if constexpr (ALIGN_EPI) { if (wr == 1) PG8_BAR; }
    }
    PG8_WAIT_V(0);
    if constexpr (!ALIGN_EPI) { if (wr == 0) PG8_BAR; }
    PG8_BAR;
    if constexpr (Epi::AFTER_DRAIN) { E.fused(acc, cur, wr, wc, fr, fq, lds, wid, lane); S.done(cur); }
    __builtin_amdgcn_s_setprio(0);
#undef PG8_SA
#undef PG8_SB
#undef PG8_STAGE
#undef PG8_LDA
#undef PG8_LDB
#undef PG8_MMA
#undef PG8_WAIT_V
#undef PG8_WAIT_L
#undef PG8_BAR
#undef PG8_SCHED
}
}
#define GAS __attribute__((address_space(1)))
#define LAS __attribute__((address_space(3)))
typedef unsigned short bf16;
typedef unsigned v4u __attribute__((ext_vector_type(4)));
typedef float f32x4 __attribute__((ext_vector_type(4)));
typedef short bf16x8 __attribute__((ext_vector_type(8)));
typedef GAS unsigned gu32;
typedef GAS unsigned long long gu64;
#define RLX_AGENT __ATOMIC_RELAXED, __HIP_MEMORY_SCOPE_AGENT
#define LDS_WAIT() asm volatile("s_waitcnt lgkmcnt(0)" ::: "memory")
#define VM_WAIT() asm volatile("s_waitcnt vmcnt(0)" ::: "memory")
__device__ __forceinline__ unsigned long long rt() { return __builtin_amdgcn_s_memrealtime(); }
__device__ __forceinline__ unsigned f2bf(float f) { unsigned u = __builtin_bit_cast(unsigned, f); return (u + 0x7fffu + ((u >> 16) & 1u)) >> 16; }
__device__ __forceinline__ unsigned pk2(float lo, float hi) { return f2bf(lo) | (f2bf(hi) << 16); }

typedef unsigned u32x2 __attribute__((ext_vector_type(2)));
typedef float f32x2 __attribute__((ext_vector_type(2)));
#define XB_TMO      128
#define XB_XCNT(j)  (256  + 64 * (j))
#define XB_XSUB(j)  (1280 + 64 * (j))
#define XB_XGEN(j)  (2304 + 64 * (j))
#define XB_TOP      3328
#define XB_TOPGEN   3392
#define XCD_BAR_WORDS 3456
#define XB_SPIN_CAP (1u << 21)

__device__ __forceinline__ unsigned xb_ld(unsigned* p)              { return __hip_atomic_load(p, __ATOMIC_RELAXED, __HIP_MEMORY_SCOPE_AGENT); }
__device__ __forceinline__ unsigned xb_add(unsigned* p, unsigned v) { return __hip_atomic_fetch_add(p, v, __ATOMIC_RELAXED, __HIP_MEMORY_SCOPE_AGENT); }
__device__ __forceinline__ unsigned xb_xcc_id() { return (unsigned)__builtin_amdgcn_s_getreg((3 << 11) | 20) & 0xFu; }
#define XB_SPIN(cond, bar) do { unsigned _sp = 0; while (cond) { __builtin_amdgcn_s_sleep(1); \
    if ((++_sp & 255u) == 0u) { if (xb_ld(&(bar)[XB_TMO])) break; if (_sp > XB_SPIN_CAP) { atomicAdd(&(bar)[XB_TMO], 1u); break; } } } } while (0)

struct XcdBarrier {
    unsigned* bar; unsigned x;
    volatile LAS unsigned* st;
};

__device__ __forceinline__ XcdBarrier xcd_barrier_post(unsigned* bar, volatile LAS unsigned* st) {
    XcdBarrier b; b.bar = bar; b.x = xb_xcc_id(); b.st = st;
    if (threadIdx.x == 0) (void)xb_add(&bar[XB_XCNT(b.x)], 1u);
    return b;
}
__device__ __forceinline__ void xcd_barrier_complete(unsigned* bar, unsigned x, unsigned& nloc, unsigned& nx) {
    const unsigned G = gridDim.x * gridDim.y * gridDim.z;
    unsigned sum, cnt, mine, sp = 0u;
    for (;;) {
        sum = 0u; cnt = 0u; mine = 0u;
#pragma unroll
        for (unsigned j = 0; j < 16; ++j) { const unsigned c = xb_ld(&bar[XB_XCNT(j)]); sum += c; cnt += (c > 0u) ? 1u : 0u; mine = (j == x) ? c : mine; }
        if (sum == G) break;
        __builtin_amdgcn_s_sleep(1);
        if ((++sp & 255u) == 0u) { if (xb_ld(&bar[XB_TMO])) break; if (sp > XB_SPIN_CAP) { atomicAdd(&bar[XB_TMO], 1u); break; } }
    }
    nloc = mine > 0u ? mine : 1u; nx = cnt > 0u ? cnt : 1u;
}

__device__ __forceinline__ void xcd_barrier(const XcdBarrier& b) {
    asm volatile("s_waitcnt vmcnt(0)" ::: "memory");
    __syncthreads();
    if (threadIdx.x == 0) {
        unsigned* bar = b.bar;
        __builtin_amdgcn_s_waitcnt(0);
        unsigned nloc = b.st[0], nx = b.st[1];
        if (nloc == 0u) { xcd_barrier_complete(bar, b.x, nloc, nx); b.st[0] = nloc; b.st[1] = nx; }
        const unsigned old = xb_add(&bar[XB_XSUB(b.x)], 1u);
        const unsigned gen = old / nloc;
        if (old + 1u == (gen + 1u) * nloc) {
            __builtin_amdgcn_fence(__ATOMIC_RELEASE, "agent");
            asm volatile("s_waitcnt vmcnt(0)" ::: "memory");
            const unsigned og = xb_add(&bar[XB_TOP], 1u);
            const unsigned tg = og / nx;
            if (og + 1u == (tg + 1u) * nx) xb_add(&bar[XB_TOPGEN], 1u);
            else XB_SPIN(xb_ld(&bar[XB_TOPGEN]) == tg, bar);
            __builtin_amdgcn_fence(__ATOMIC_ACQUIRE, "agent");
            xb_add(&bar[XB_XGEN(b.x)], 1u);
            asm volatile("s_waitcnt vmcnt(0)" ::: "memory");
        } else {
            XB_SPIN(xb_ld(&bar[XB_XGEN(b.x)]) == gen, bar);
            __builtin_amdgcn_fence(__ATOMIC_ACQUIRE, "agent");
            asm volatile("s_waitcnt vmcnt(0)" ::: "memory");
        }
    }
    __syncthreads();
}


#ifndef NT_STREAMS
#define NT_STREAMS 1
#endif
#if NT_STREAMS
#define LDNT(p) __builtin_nontemporal_load(p)
#define STNT(p, v) __builtin_nontemporal_store((v), (p))
#else
#define LDNT(p) (*(p))
#define STNT(p, v) (*(p) = (v))
#endif
constexpr int NWAVES = 8;
constexpr int DM = 4096, NBATCH = 2, SEQ = 8192, NCTX = 256;
constexpr int MLAT = NBATCH * SEQ;
constexpr int MTOT = MLAT + NBATCH * NCTX;
constexpr int N_AB = 18176;
constexpr int N_ABSRC = 17984, N_C = 40960, MIXW = 8192;
constexpr int QL = 1024, KVL = 512, NQ = 6144, NKV = 8192;
constexpr int G1_CKV = 1024, G1_KR = 1536, G1_ZA = 1792, G1_UB = 5888, G1_VB = 9984, G1_ZB = 14080;
constexpr float EPS = 1e-6f;

constexpr size_t al256(size_t x) { return (x + 255) & ~(size_t)255; }
constexpr size_t WS_CTL = 0, CTL_ZERO_BYTES = 1u << 20;
constexpr size_t WS_MOD  = CTL_ZERO_BYTES;
constexpr size_t WS_OML  = WS_MOD  + al256((size_t)4 * 3 * 12288 * 4);
constexpr size_t WS_ROPE = WS_OML  + al256((size_t)2 * 2 * 8192 * 4);
constexpr size_t WS_STAT = WS_ROPE + al256((size_t)128 * 16 * 8);
constexpr size_t WS_WIN_AB = WS_STAT + al256((size_t)MTOT * 8);
constexpr size_t WS_WIN_C  = WS_WIN_AB + (size_t)2 * N_AB * DM * 2;
constexpr size_t WS_WO_AB  = WS_WIN_C + (size_t)2 * N_C * DM * 2;
constexpr size_t WS_WO_C   = WS_WO_AB + (size_t)2 * DM * MIXW * 2;
constexpr size_t WS_WQ     = WS_WO_C + (size_t)2 * DM * MIXW * 2;
constexpr size_t WS_WKV    = WS_WQ + (size_t)2 * NQ * QL * 2;
constexpr size_t WS_XS     = WS_WKV + (size_t)2 * NKV * KVL * 2;
constexpr size_t WS_H      = WS_XS + (size_t)MTOT * DM * 4;
constexpr size_t WS_Y      = WS_H + (size_t)MTOT * DM * 2;
constexpr size_t WS_G1     = WS_Y + (size_t)MTOT * DM * 4;
constexpr size_t WS_QN     = WS_G1 + (size_t)5 * MTOT * MIXW * 2;
constexpr size_t WS_KVN    = WS_QN + (size_t)MTOT * QL * 2;
constexpr size_t WS_KR     = WS_KVN + (size_t)MTOT * KVL * 2;
constexpr size_t WS_Q      = WS_KR + (size_t)MTOT * 64 * 2;
constexpr size_t WS_KN     = WS_Q + (size_t)MTOT * NQ * 2;
constexpr size_t WS_V      = WS_KN + (size_t)MTOT * DM * 2;
constexpr size_t WS_CC     = WS_V + (size_t)MTOT * DM * 2;
constexpr size_t WS_OF     = WS_CC + (size_t)MTOT * MIXW * 2;
constexpr size_t WS_YP     = WS_OF + (size_t)2 * MTOT * MIXW * 2;
constexpr size_t WS_END    = WS_YP + (size_t)8 * (MTOT - MLAT) * DM * 4;
constexpr int CW_BAR = 4096;

constexpr int RING_BYTES = 135168;
constexpr int LDSCTL_OFF = RING_BYTES, MISC_OFF = LDSCTL_OFF + 64;
constexpr int LDS_BYTES = 147456;

struct Args { const float* in[22]; float* out; unsigned char* ws; int ph_lo, ph_hi; };
typedef const __attribute__((address_space(4))) Args* KArgs;
__device__ __forceinline__ KArgs kargs() { KArgs ap = (KArgs)__builtin_amdgcn_kernarg_segment_ptr(); asm volatile("" : "+s"(ap)); return ap; }

template <class T> __device__ __forceinline__ T* uni(T* p) {
    const unsigned long long v = (unsigned long long)p; const unsigned lo = __builtin_amdgcn_readfirstlane((unsigned)v), hi = __builtin_amdgcn_readfirstlane((unsigned)(v >> 32));
    return (T*)(((unsigned long long)hi << 32) | lo); }
__device__ __forceinline__ float wave_sum(float v) {
#pragma unroll
    for (int o = 1; o < 64; o <<= 1) v += __shfl_xor(v, o);
    return v;
}
__device__ __forceinline__ float bf_lo(unsigned w) { return __uint_as_float(w << 16); }
__device__ __forceinline__ float bf_hi(unsigned w) { return __uint_as_float(w & 0xffff0000u); }
typedef __bf16 bf16x2_t __attribute__((ext_vector_type(2)));
__device__ __forceinline__ unsigned cvtpk(float lo, float hi) { const f32x2 v = {lo, hi}; const bf16x2_t b = __builtin_convertvector(v, bf16x2_t); return __builtin_bit_cast(unsigned, b); }
__device__ __forceinline__ float silu_acc(float x) { return x / (1.0f + __expf(-x)); }

__device__ __forceinline__ void p0_gemv(KArgs a, LAS unsigned char* lds, int G) {
    int tid_l = threadIdx.x; asm volatile("" : "+v"(tid_l)); const int tid = tid_l, lane = tid & 63, wave = __builtin_amdgcn_readfirstlane(tid >> 6);
    LAS float* sc = (LAS float*)lds;
    LAS float* red = (LAS float*)(lds + 49152);
    const float* c = a->in[1]; const float* cctx = a->in[3]; const float* w_ada = a->in[4]; const float* b_ada = a->in[5];
    float* mod = (float*)(a->ws + WS_MOD);
    for (int i = tid; i < 3 * 4096; i += 512) { const int r = i >> 12, k = i & 4095; const float cv = r < 2 ? c[r * 4096 + k] : cctx[k]; sc[i] = silu_acc(cv); }
    __syncthreads();
    const int kr = lane >> 4, c4 = lane & 15;
    for (int item = blockIdx.x; item < 768; item += G) {
        const int l = item / 192, cg = item % 192;
        const float* W = w_ada + (size_t)l * 4096 * 12288 + cg * 64 + c4 * 4;
        float acc[3][4];
#pragma unroll
        for (int r = 0; r < 3; ++r)
#pragma unroll
            for (int j = 0; j < 4; ++j) acc[r][j] = 0.f;
        const int k0 = wave * 512 + kr;
#pragma unroll 8
        for (int i = 0; i < 128; ++i) { const int k = k0 + 4 * i; const f32x4 w = LDNT((const f32x4*)(W + (size_t)k * 12288));
            const float s0 = sc[k], s1 = sc[4096 + k], s2 = sc[8192 + k];
#pragma unroll
            for (int j = 0; j < 4; ++j) { acc[0][j] += s0 * w[j]; acc[1][j] += s1 * w[j]; acc[2][j] += s2 * w[j]; } }
#pragma unroll
        for (int r = 0; r < 3; ++r)
#pragma unroll
            for (int j = 0; j < 4; ++j) { float v = acc[r][j]; v += __shfl_xor(v, 16); v += __shfl_xor(v, 32); acc[r][j] = v; }
        if (lane < 16) {
#pragma unroll
            for (int r = 0; r < 3; ++r)
#pragma unroll
                for (int j = 0; j < 4; ++j) red[(wave * 3 + r) * 64 + lane * 4 + j] = acc[r][j]; }
        __syncthreads();
        if (tid < 192) { const int r = tid >> 6, cc = tid & 63; float s = 0.f;
#pragma unroll
            for (int w = 0; w < 8; ++w) s += red[(w * 3 + r) * 64 + cc];
            const int col = cg * 64 + cc; mod[(size_t)(l * 3 + r) * 12288 + col] = s + b_ada[l * 12288 + col]; }
        __syncthreads();
    }
}
__device__ __forceinline__ void p0_tr_item(const float* W, int N, int K, bf16* WT, int n0s, int n0d, int k0, LAS float* scr, int lane) {
    const int kr = lane >> 4, c4 = lane & 15;
    const float* Wb = uni(W + (size_t)k0 * N + n0s); const unsigned lo = (unsigned)(kr * N + 4 * c4);
    f32x4 w[16];
#pragma unroll
    for (int i = 0; i < 16; ++i) w[i] = LDNT((const f32x4*)(Wb + lo + (unsigned)(4 * i * N)));
#pragma unroll
    for (int i = 0; i < 16; ++i) { const int k = 4 * i + kr;
        scr[(4 * c4 + 0) * 65 + k] = w[i][0]; scr[(4 * c4 + 1) * 65 + k] = w[i][1]; scr[(4 * c4 + 2) * 65 + k] = w[i][2]; scr[(4 * c4 + 3) * 65 + k] = w[i][3]; }
    LDS_WAIT(); asm volatile("" ::: "memory");
    bf16* ob = uni(WT + (size_t)n0d * K + k0); const int nr = lane >> 3, cch = lane & 7;
#pragma unroll
    for (int i = 0; i < 8; ++i) { const int n = 8 * i + nr; const LAS float* s = scr + n * 65 + 8 * cch;
        v4u o; o.x = cvtpk(s[0], s[1]); o.y = cvtpk(s[2], s[3]); o.z = cvtpk(s[4], s[5]); o.w = cvtpk(s[6], s[7]);
        *(v4u*)(ob + (unsigned)(n * K + 8 * cch)) = o; }
    LDS_WAIT(); asm volatile("" ::: "memory");
}
#ifndef P0_DEFER
#define P0_DEFER 1
#endif
constexpr int I_IN_AB = 64 * 281, I_Q = 16 * 96, I_KV = 8 * 128, I_O = 128 * 64, I_IN_C = 64 * 640, PER_J = I_IN_AB + I_Q + I_KV + I_O + I_IN_C + I_O;
__device__ __forceinline__ void p0_item(KArgs a, int j, int r, LAS float* scr, int lane) {
    if (r < I_IN_AB) { const int kb = r / 281, nb = r % 281, n0 = nb * 64;
        p0_tr_item(a->in[8] + (size_t)j * DM * N_ABSRC, N_ABSRC, DM, (bf16*)(a->ws + WS_WIN_AB) + (size_t)j * N_AB * DM, n0, n0 + (n0 >= 1600 ? 192 : 0), kb * 64, scr, lane); return; } r -= I_IN_AB;
    if (r < I_Q) { const int kb = r / 96, nb = r % 96;
        p0_tr_item(a->in[11] + (size_t)j * QL * NQ, NQ, QL, (bf16*)(a->ws + WS_WQ) + (size_t)j * NQ * QL, nb * 64, nb * 64, kb * 64, scr, lane); return; } r -= I_Q;
    if (r < I_KV) { const int kb = r / 128, nb = r % 128;
        p0_tr_item(a->in[12] + (size_t)j * KVL * NKV, NKV, KVL, (bf16*)(a->ws + WS_WKV) + (size_t)j * NKV * KVL, nb * 64, nb * 64, kb * 64, scr, lane); return; } r -= I_KV;
    if (r < I_O) { const int kb = r / 64, nb = r % 64;
        p0_tr_item(a->in[17] + (size_t)j * MIXW * DM, DM, MIXW, (bf16*)(a->ws + WS_WO_AB) + (size_t)j * DM * MIXW, nb * 64, nb * 64, kb * 64, scr, lane); return; } r -= I_O;
    if (r < I_IN_C) { const int kb = r / 640, nb = r % 640;
        p0_tr_item(a->in[18] + (size_t)j * DM * N_C, N_C, DM, (bf16*)(a->ws + WS_WIN_C) + (size_t)j * N_C * DM, nb * 64, nb * 64, kb * 64, scr, lane); return; } r -= I_IN_C;
    { const int kb = r / 64, nb = r % 64;
        p0_tr_item(a->in[21] + (size_t)j * MIXW * DM, DM, MIXW, (bf16*)(a->ws + WS_WO_C) + (size_t)j * DM * MIXW, nb * 64, nb * 64, kb * 64, scr, lane); }
}
constexpr int P0_ND = I_O + PER_J;
#ifndef P0_B1
#define P0_B1 25984
#endif
#ifndef P0_B2
#define P0_B2 51936
#endif
constexpr int P0_B3 = P0_ND - I_O;
static_assert(P0_B1 >= I_O && P0_B1 <= P0_B2 && P0_B2 >= I_O + I_IN_AB && P0_B2 <= P0_B3, "deferred-slot deadlines");
__device__ __forceinline__ bool p0_defer_on(int G) { return P0_DEFER && (G % pg8::NXCD == 0); }
__device__ __forceinline__ void p0_deferred(KArgs a, LAS unsigned char* lds, const pg8::LockstepOrder& S, int slot) {
    const int lenmax = S.PG * pg8::LockstepOrder::LW * S.nN + S.qR + (S.rR > 0 ? 1 : 0), R = (lenmax + S.nk - 1) / S.nk, kcut = lenmax - (R - 1) * S.nk;
    const bool all = kcut >= S.nk;
    if (!all && S.k < kcut) return;
    int tid_l = threadIdx.x; asm volatile("" : "+v"(tid_l)); const int lane = tid_l & 63, wave = __builtin_amdgcn_readfirstlane(tid_l >> 6);
    const int rank = all ? S.c : (S.k - kcut) * pg8::NXCD + S.x, nw = (all ? S.G : pg8::NXCD * (S.nk - kcut)) * NWAVES;
    __syncthreads();
    LAS float* scr = (LAS float*)(lds + wave * 16640);
    const int lo_ = slot == 0 ? 0 : slot == 1 ? P0_B1 : slot == 2 ? P0_B2 : P0_B3, hi_ = slot == 0 ? P0_B1 : slot == 1 ? P0_B2 : slot == 2 ? P0_B3 : P0_ND;
    for (int d = lo_ + rank * NWAVES + wave; d < hi_; d += nw) {
        const int j = d < I_O ? 0 : 1, r = d < I_O ? PER_J - I_O + d : d - I_O; p0_item(a, j, r, scr, lane); }
    __syncthreads();
}
__device__ __forceinline__ void p0_prologue(KArgs a, LAS unsigned char* lds, int G) {
    int tid_l = threadIdx.x; asm volatile("" : "+v"(tid_l)); const int tid = tid_l, lane = tid & 63, wave = __builtin_amdgcn_readfirstlane(tid >> 6);
    __syncthreads();
    p0_gemv(a, lds, G);
    __syncthreads();
    LAS float* scr = (LAS float*)(lds + wave * 16640);
    const int gw = blockIdx.x * NWAVES + wave, NGW = G * NWAVES;
    const bool defer = p0_defer_on(G);
    const int NIT = defer ? PER_J - I_O : 2 * PER_J;
    for (int it = gw; it < NIT; it += NGW) {
        const int j = defer ? (it < PER_J - I_O ? 0 : 1) : it / PER_J, r = defer ? (it < PER_J - I_O ? it : it - (PER_J - I_O)) : it % PER_J;
        p0_item(a, j, r, scr, lane);
    }
    const size_t gt = (size_t)blockIdx.x * 512 + tid, NGT = (size_t)G * 512;
    for (size_t i = gt; i < (size_t)2 * 192 * DM / 8; i += NGT) { const size_t j = i / (192 * DM / 8), e = i % (192 * DM / 8);
        *(v4u*)((bf16*)(a->ws + WS_WIN_AB) + j * (size_t)N_AB * DM + (size_t)1600 * DM + e * 8) = (v4u){0u, 0u, 0u, 0u}; }
    { const float* lg = a->in[19]; float* oml = (float*)(a->ws + WS_OML);
      for (size_t i = gt; i < (size_t)2 * 2 * 8192; i += NGT) { const int jc = (int)(i >> 14), de = (int)(i & 16383);
          const float l0 = lg[0 * 16384 + de], l1 = lg[1 * 16384 + de], l2 = lg[2 * 16384 + de], l3 = lg[3 * 16384 + de];
          const float mx = fmaxf(fmaxf(l0, l1), fmaxf(l2, l3)); const float e0 = __expf(l0 - mx), e1 = __expf(l1 - mx), e2 = __expf(l2 - mx), e3 = __expf(l3 - mx);
          const float inv = 1.0f / (e0 + e1 + e2 + e3); const float lb = (jc == 0) ? e1 * inv : (e1 + e2 + e3) * inv;
          oml[i] = 1.0f - lb; } }
    { f32x2* rope = (f32x2*)(a->ws + WS_ROPE);
      for (size_t i = gt; i < 128 * 16; i += NGT) { const int pos = (int)(i >> 4), f = (int)(i & 15); const float inv = powf(10000.0f, -(float)f / 16.0f); const float ang = (float)pos * inv;
          rope[i] = (f32x2){cosf(ang), sinf(ang)}; } }
}

__device__ __forceinline__ void norm_phase(KArgs a, int lpost, int lpre, int G) {
    int tid_l = threadIdx.x; asm volatile("" : "+v"(tid_l)); const int tid = tid_l, lane = tid & 63, wave = __builtin_amdgcn_readfirstlane(tid >> 6);
    const int gw = blockIdx.x * NWAVES + wave, NGW = G * NWAVES;
    const float* mod = (const float*)(a->ws + WS_MOD);
    float* XS = (float*)(a->ws + WS_XS); const float* Y = (const float*)(a->ws + WS_Y); bf16* H = (bf16*)(a->ws + WS_H);
    const int nrows = (lpost == 3) ? MLAT : MTOT;
    for (int row = gw; row < nrows; row += NGW) {
        const int rt = row < SEQ ? 0 : (row < MLAT ? 1 : 2);
        const float* xin = uni((lpost <= 0) ? (row < MLAT ? a->in[0] + (size_t)row * DM : a->in[2] + (size_t)(row - MLAT) * DM) : XS + (size_t)row * DM);
        f32x4 xv[16];
#pragma unroll
        for (int j = 0; j < 16; ++j) xv[j] = LDNT((const f32x4*)(xin + lane * 4 + 256 * j));
        if (lpost >= 0) {
            f32x4 yv[16]; float ss = 0.f;
            if (row < MLAT) { const bf16* yr = uni((const bf16*)Y + (size_t)row * DM);
#pragma unroll
                for (int j = 0; j < 16; ++j) { const u32x2 w = LDNT((const u32x2*)(yr + lane * 4 + 256 * j)); yv[j] = (f32x4){bf_lo(w.x), bf_hi(w.x), bf_lo(w.y), bf_hi(w.y)}; } }
            else {
                const float* yr = uni((const float*)(a->ws + WS_YP) + (size_t)(row - MLAT) * DM);
#pragma unroll
                for (int j = 0; j < 16; ++j) yv[j] = *(const f32x4*)(yr + lane * 4 + 256 * j);
                for (int kc = 1; kc < 8; ++kc) { const float* yk = uni(yr + (size_t)kc * (MTOT - MLAT) * DM);
#pragma unroll
                    for (int j = 0; j < 16; ++j) { yv[j] = yv[j] + *(const f32x4*)(yk + lane * 4 + 256 * j); if ((j & 3) == 3) asm volatile("" ::: "memory"); } } }
#pragma unroll
            for (int j = 0; j < 16; ++j) ss += (yv[j][0] * yv[j][0] + yv[j][1] * yv[j][1]) + (yv[j][2] * yv[j][2] + yv[j][3] * yv[j][3]);
            const float r = 1.0f / sqrtf(wave_sum(ss) * (1.0f / DM) + EPS);
            const float* gate = uni(mod + (size_t)(lpost * 3 + rt) * 12288 + 8192); const float* pw = uni(a->in[7] + (size_t)lpost * DM);
            float* xout = uni((lpost == 3) ? a->out + (size_t)row * DM : XS + (size_t)row * DM);
#pragma unroll
            for (int j = 0; j < 16; ++j) { const int col = lane * 4 + 256 * j; const f32x4 g = *(const f32x4*)(gate + col), w = *(const f32x4*)(pw + col);
                xv[j] = xv[j] + g * ((yv[j] * r) * w); STNT((f32x4*)(xout + col), xv[j]);
                if ((j & 3) == 3) asm volatile("" ::: "memory"); }
        }
        if (lpre < 4) {
            float ss = 0.f;
#pragma unroll
            for (int j = 0; j < 16; ++j) ss += (xv[j][0] * xv[j][0] + xv[j][1] * xv[j][1]) + (xv[j][2] * xv[j][2] + xv[j][3] * xv[j][3]);
            const float r = 1.0f / sqrtf(wave_sum(ss) * (1.0f / DM) + EPS);
            const float* shift = uni(mod + (size_t)(lpre * 3 + rt) * 12288); const float* scale = shift + 4096; const float* pw = uni(a->in[6] + (size_t)lpre * DM);
            bf16* hr = uni(H + (size_t)row * DM);
#pragma unroll
            for (int j = 0; j < 16; ++j) { const int col = lane * 4 + 256 * j; const f32x4 sh = *(const f32x4*)(shift + col), sc = *(const f32x4*)(scale + col), w = *(const f32x4*)(pw + col);
                const f32x4 h = ((xv[j] * r) * w) * (sc + 1.0f) + sh; u32x2 o; o.x = cvtpk(h[0], h[1]); o.y = cvtpk(h[2], h[3]); *(u32x2*)(hr + col) = o;
                if ((j & 3) == 3) asm volatile("" ::: "memory"); }
        }
    }
}

__device__ __forceinline__ void a2_rows(KArgs a, int j, int G) {
    int tid_l = threadIdx.x; asm volatile("" : "+v"(tid_l)); const int tid = tid_l, lane = tid & 63, wave = __builtin_amdgcn_readfirstlane(tid >> 6);
    const int gw = blockIdx.x * NWAVES + wave, NGW = G * NWAVES;
    const bf16* G1 = (const bf16*)(a->ws + WS_G1); bf16* QN = (bf16*)(a->ws + WS_QN); bf16* KVN = (bf16*)(a->ws + WS_KVN); bf16* KR = (bf16*)(a->ws + WS_KR);
    f32x2* stat = (f32x2*)(a->ws + WS_STAT); const f32x2* rope = (const f32x2*)(a->ws + WS_ROPE);
    const float* qw = a->in[9] + (size_t)j * QL; const float* kvw = a->in[10] + (size_t)j * KVL;
    for (int row = gw; row < MTOT; row += NGW) {
        const bf16* g = uni(G1 + (size_t)row * N_AB);
        {
            v4u w[2]; float x[16]; float ss = 0.f;
#pragma unroll
            for (int i = 0; i < 2; ++i) { w[i] = LDNT((const v4u*)(g + lane * 8 + 512 * i));
#pragma unroll
                for (int e = 0; e < 4; ++e) { x[8 * i + 2 * e] = bf_lo(w[i][e]); x[8 * i + 2 * e + 1] = bf_hi(w[i][e]); } }
#pragma unroll
            for (int e = 0; e < 16; ++e) ss += x[e] * x[e];
            const float r = 1.0f / sqrtf(wave_sum(ss) * (1.0f / QL) + EPS);
#pragma unroll
            for (int i = 0; i < 2; ++i) { const int col = lane * 8 + 512 * i; const f32x4 w0 = *(const f32x4*)(qw + col), w1 = *(const f32x4*)(qw + col + 4);
                v4u o; o.x = cvtpk(x[8 * i + 0] * r * w0[0], x[8 * i + 1] * r * w0[1]); o.y = cvtpk(x[8 * i + 2] * r * w0[2], x[8 * i + 3] * r * w0[3]);
                o.z = cvtpk(x[8 * i + 4] * r * w1[0], x[8 * i + 5] * r * w1[1]); o.w = cvtpk(x[8 * i + 6] * r * w1[2], x[8 * i + 7] * r * w1[3]);
                *(v4u*)(QN + (size_t)row * QL + col) = o; }
        }
        {
            const v4u w = LDNT((const v4u*)(g + G1_CKV + lane * 8)); float x[8]; float ss = 0.f;
#pragma unroll
            for (int e = 0; e < 4; ++e) { x[2 * e] = bf_lo(w[e]); x[2 * e + 1] = bf_hi(w[e]); }
#pragma unroll
            for (int e = 0; e < 8; ++e) ss += x[e] * x[e];
            const float r = 1.0f / sqrtf(wave_sum(ss) * (1.0f / KVL) + EPS);
            const int col = lane * 8; const f32x4 w0 = *(const f32x4*)(kvw + col), w1 = *(const f32x4*)(kvw + col + 4);
            v4u o; o.x = cvtpk(x[0] * r * w0[0], x[1] * r * w0[1]); o.y = cvtpk(x[2] * r * w0[2], x[3] * r * w0[3]); o.z = cvtpk(x[4] * r * w1[0], x[5] * r * w1[1]); o.w = cvtpk(x[6] * r * w1[2], x[7] * r * w1[3]);
            *(v4u*)(KVN + (size_t)row * KVL + col) = o;
        }
        {
            const float x = __uint_as_float((unsigned)g[G1_KR + lane] << 16); const float xp = __shfl_xor(x, 16); float o = x;
            if (row < MLAT) { const int t = row & (SEQ - 1), ax = lane >> 5, hh = (lane >> 4) & 1, f = lane & 15, pos = ax == 0 ? (t >> 6) : (t & 63); const f32x2 cs = rope[pos * 16 + f];
                o = hh == 0 ? x * cs.x - xp * cs.y : x * cs.x + xp * cs.y; }
            KR[(size_t)row * 64 + lane] = (bf16)(cvtpk(o, 0.f) & 0xffffu);
        }
        {
            float x[64]; float s = 0.f;
#pragma unroll
            for (int i = 0; i < 8; ++i) { const v4u w = *(const v4u*)(g + G1_VB + lane * 8 + 512 * i);
#pragma unroll
                for (int e = 0; e < 4; ++e) { x[8 * i + 2 * e] = bf_lo(w[e]); x[8 * i + 2 * e + 1] = bf_hi(w[e]); } }
#pragma unroll
            for (int e = 0; e < 64; ++e) s += x[e];
            const float mean = wave_sum(s) * (1.0f / 4096.0f); float q = 0.f;
#pragma unroll
            for (int e = 0; e < 64; ++e) { const float d = x[e] - mean; q += d * d; }
            const float rstd = 1.0f / sqrtf(wave_sum(q) * (1.0f / 4096.0f) + EPS);
            if (lane == 0) stat[row] = (f32x2){mean, rstd};
        }
    }
}

typedef short s16x4 __attribute__((ext_vector_type(4)));
typedef float f32x16 __attribute__((ext_vector_type(16)));
#define SBAR() __builtin_amdgcn_sched_barrier(0)
__device__ __forceinline__ f32x4 mfma16(bf16x8 a, bf16x8 b, f32x4 c) { return __builtin_amdgcn_mfma_f32_16x16x32_bf16(a, b, c, 0, 0, 0); }
__device__ __forceinline__ int crow(int r, int hi) { return (r & 3) + 8 * (r >> 2) + 4 * hi; }
__device__ __forceinline__ int v_st(int k, int c) { const int kk = (k & ~0xC) | ((k & 4) << 1) | ((k & 8) >> 1); return ((kk >> 3) * 4 + (c >> 5)) * 512 + ((kk & 7) * 32 + (c & 31)) * 2; }
__device__ __forceinline__ int v_rd_base(int lane) { return ((lane & 3) << 3) | (((lane >> 2) & 3) << 6) | (((lane >> 4) & 1) << 5) | (((lane >> 5) & 1) << 8); }
constexpr int v_rd_off(int d0, int ks, int half) { return d0 * 512 + ks * 4096 + half * 2048; }
template <int OFF> __device__ __forceinline__ s16x4 tr_read(int vb) {
    s16x4 r; asm volatile("ds_read_b64_tr_b16 %0, %1 offset:%2" : "=&v"(r) : "v"(vb), "i"(OFF) : "memory"); return r;
}
template <int D0> __device__ __forceinline__ void pv_one(f32x16& od, int vb, bf16x8 pa0, bf16x8 pa1, bf16x8 pa2, bf16x8 pa3) {
    const s16x4 l0 = tr_read<v_rd_off(D0, 0, 0)>(vb), h0 = tr_read<v_rd_off(D0, 0, 1)>(vb), l1 = tr_read<v_rd_off(D0, 1, 0)>(vb), h1 = tr_read<v_rd_off(D0, 1, 1)>(vb);
    const s16x4 l2 = tr_read<v_rd_off(D0, 2, 0)>(vb), h2 = tr_read<v_rd_off(D0, 2, 1)>(vb), l3 = tr_read<v_rd_off(D0, 3, 0)>(vb), h3 = tr_read<v_rd_off(D0, 3, 1)>(vb);
    asm volatile("s_waitcnt lgkmcnt(0)" ::: "memory"); SBAR();
#define PKV(L, H) (bf16x8){L[0], L[1], L[2], L[3], H[0], H[1], H[2], H[3]}
    od = __builtin_amdgcn_mfma_f32_32x32x16_bf16(pa0, PKV(l0, h0), od, 0, 0, 0);
    od = __builtin_amdgcn_mfma_f32_32x32x16_bf16(pa1, PKV(l1, h1), od, 0, 0, 0);
    od = __builtin_amdgcn_mfma_f32_32x32x16_bf16(pa2, PKV(l2, h2), od, 0, 0, 0);
    od = __builtin_amdgcn_mfma_f32_32x32x16_bf16(pa3, PKV(l3, h3), od, 0, 0, 0);
#undef PKV
}
__device__ __forceinline__ void pv_d0(f32x16* o, int vb, bf16x8 pa0, bf16x8 pa1, bf16x8 pa2, bf16x8 pa3) {
    pv_one<0>(o[0], vb, pa0, pa1, pa2, pa3); pv_one<1>(o[1], vb, pa0, pa1, pa2, pa3); pv_one<2>(o[2], vb, pa0, pa1, pa2, pa3); pv_one<3>(o[3], vb, pa0, pa1, pa2, pa3);
}

template <int I> __device__ __forceinline__ void pv_rd(int vb, s16x4& l0, s16x4& h0, s16x4& l1, s16x4& h1) {
    l0 = tr_read<v_rd_off(I >> 1, 2 * (I & 1), 0)>(vb); h0 = tr_read<v_rd_off(I >> 1, 2 * (I & 1), 1)>(vb); l1 = tr_read<v_rd_off(I >> 1, 2 * (I & 1) + 1, 0)>(vb); h1 = tr_read<v_rd_off(I >> 1, 2 * (I & 1) + 1, 1)>(vb);
}
#define PKV2(L, H) (bf16x8){L[0], L[1], L[2], L[3], H[0], H[1], H[2], H[3]}
#define PV_MM(I, A0, A1, L0, H0, L1, H1) do { o[(I) >> 1] = __builtin_amdgcn_mfma_f32_32x32x16_bf16(A0, PKV2(L0, H0), o[(I) >> 1], 0, 0, 0); o[(I) >> 1] = __builtin_amdgcn_mfma_f32_32x32x16_bf16(A1, PKV2(L1, H1), o[(I) >> 1], 0, 0, 0); } while (0)
#define PV_WAIT4() do { asm volatile("s_waitcnt lgkmcnt(4)" ::: "memory"); SBAR(); } while (0)
#define PV_WAIT0() do { asm volatile("s_waitcnt lgkmcnt(0)" ::: "memory"); SBAR(); } while (0)
__device__ __forceinline__ void pv_pipe(f32x16* o, int vb, bf16x8 pa0, bf16x8 pa1, bf16x8 pa2, bf16x8 pa3) {
    s16x4 al0, ah0, al1, ah1, bl0, bh0, bl1, bh1;
    asm volatile("s_waitcnt lgkmcnt(0)" ::: "memory"); SBAR();
    pv_rd<0>(vb, al0, ah0, al1, ah1); pv_rd<1>(vb, bl0, bh0, bl1, bh1);
    PV_WAIT4(); PV_MM(0, pa0, pa1, al0, ah0, al1, ah1); SBAR(); pv_rd<2>(vb, al0, ah0, al1, ah1);
    PV_WAIT4(); PV_MM(1, pa2, pa3, bl0, bh0, bl1, bh1); SBAR(); pv_rd<3>(vb, bl0, bh0, bl1, bh1);
    PV_WAIT4(); PV_MM(2, pa0, pa1, al0, ah0, al1, ah1); SBAR(); pv_rd<4>(vb, al0, ah0, al1, ah1);
    PV_WAIT4(); PV_MM(3, pa2, pa3, bl0, bh0, bl1, bh1); SBAR(); pv_rd<5>(vb, bl0, bh0, bl1, bh1);
    PV_WAIT4(); PV_MM(4, pa0, pa1, al0, ah0, al1, ah1); SBAR(); pv_rd<6>(vb, al0, ah0, al1, ah1);
    PV_WAIT4(); PV_MM(5, pa2, pa3, bl0, bh0, bl1, bh1); SBAR(); pv_rd<7>(vb, bl0, bh0, bl1, bh1);
    PV_WAIT4(); PV_MM(6, pa0, pa1, al0, ah0, al1, ah1);
    PV_WAIT0(); PV_MM(7, pa2, pa3, bl0, bh0, bl1, bh1);
}

__device__ __forceinline__ void pv_seq(f32x16* o, int vb, bf16x8 pa0, bf16x8 pa1, bf16x8 pa2, bf16x8 pa3) {
    s16x4 al0, ah0, al1, ah1;
    pv_rd<0>(vb, al0, ah0, al1, ah1); PV_WAIT0(); PV_MM(0, pa0, pa1, al0, ah0, al1, ah1); SBAR();
    pv_rd<1>(vb, al0, ah0, al1, ah1); PV_WAIT0(); PV_MM(1, pa2, pa3, al0, ah0, al1, ah1); SBAR();
    pv_rd<2>(vb, al0, ah0, al1, ah1); PV_WAIT0(); PV_MM(2, pa0, pa1, al0, ah0, al1, ah1); SBAR();
    pv_rd<3>(vb, al0, ah0, al1, ah1); PV_WAIT0(); PV_MM(3, pa2, pa3, al0, ah0, al1, ah1); SBAR();
    pv_rd<4>(vb, al0, ah0, al1, ah1); PV_WAIT0(); PV_MM(4, pa0, pa1, al0, ah0, al1, ah1); SBAR();
    pv_rd<5>(vb, al0, ah0, al1, ah1); PV_WAIT0(); PV_MM(5, pa2, pa3, al0, ah0, al1, ah1); SBAR();
    pv_rd<6>(vb, al0, ah0, al1, ah1); PV_WAIT0(); PV_MM(6, pa0, pa1, al0, ah0, al1, ah1); SBAR();
    pv_rd<7>(vb, al0, ah0, al1, ah1); PV_WAIT0(); PV_MM(7, pa2, pa3, al0, ah0, al1, ah1);
}

__device__ __forceinline__ void sgu_phase(KArgs a, int j, LAS unsigned char* lds, int G) {
    int tid_l = threadIdx.x; asm volatile("" : "+v"(tid_l)); const int tid = tid_l, lane = tid & 63, wid = __builtin_amdgcn_readfirstlane(tid >> 6), r32 = lane & 31, hi = lane >> 5;
    const bf16* G1 = (const bf16*)(a->ws + WS_G1); bf16* CC = (bf16*)(a->ws + WS_CC); const f32x2* stat = (const f32x2*)(a->ws + WS_STAT);
    const float* lnw = a->in[13] + (size_t)j * 4096; const float* lnb = a->in[14] + (size_t)j * 4096; const float* ws_all = a->in[15] + (size_t)j * 16 * 128 * 128; const float* bs = a->in[16] + (size_t)j * 16 * 128;
    constexpr int MXP = 272, OFF_ST = 69632;
    LAS float* st_mean = (LAS float*)(lds + OFF_ST); LAS float* st_rstd = st_mean + 128;
    LAS float* m1s = (LAS float*)(lds + OFF_ST + 1024) + wid * 64; LAS float* rss = m1s + 32;
    LAS unsigned char* mx = lds + wid * (32 * MXP);
    const int sr = tid >> 4, sc = (tid & 15) * 8, vst0 = v_st(sr, sc), vst1 = v_st(32 + sr, sc);
    const int tb = wid >> 1, ch = wid & 1;
    const int vb0 = (int)(unsigned)(unsigned long long)lds + v_rd_base(lane);
    v4u vx[8];
#define SGU_LOADV(it_) do { const int ch_ = (it_) >> 4, g_ = (it_) & 15; const bf16* s0_ = uni(G1 + (size_t)(ch_ * 128) * N_AB + G1_VB + g_ * 256); const unsigned lo_ = (unsigned)(sr * N_AB + sc); \
    _Pragma("unroll") for (int st = 0; st < 2; ++st) _Pragma("unroll") for (int c2 = 0; c2 < 2; ++c2) { const unsigned o_ = lo_ + (unsigned)(64 * st * N_AB + c2 * 128); \
        vx[(st * 2 + c2) * 2] = LDNT((const v4u*)(s0_ + o_)); vx[(st * 2 + c2) * 2 + 1] = LDNT((const v4u*)(s0_ + o_ + 32 * N_AB)); } } while (0)
    const int item0 = (int)((blockIdx.x + 128u) % (unsigned)G);
    if (item0 < 132 * 16) SGU_LOADV(item0);
    for (int item = item0; item < 132 * 16; item += G) {
        const int chunk = item >> 4, g = item & 15, row0 = chunk * 128;
        __syncthreads();
#pragma unroll
        for (int q = 0; q < 4; ++q) { *(LAS v4u*)(lds + q * 16384 + vst0) = vx[2 * q]; *(LAS v4u*)(lds + q * 16384 + vst1) = vx[2 * q + 1]; }
        if (tid < 128) { const f32x2 s = stat[row0 + tid]; st_mean[tid] = s.x; st_rstd[tid] = s.y; }
        __syncthreads();
        if (item + G < 132 * 16) SGU_LOADV(item + G);
        const float* wrow = ws_all + ((size_t)g * 128 + 32 * tb + r32) * 128;
        bf16x8 pa[2][4]; float m1 = 0.f, rs = 0.f;
#pragma unroll
        for (int st = 0; st < 2; ++st)
#pragma unroll
            for (int ks = 0; ks < 4; ++ks) { const int s0 = 64 * st + 16 * ks + 8 * hi; const f32x4 w0 = *(const f32x4*)(wrow + s0), w1 = *(const f32x4*)(wrow + s0 + 4);
                const f32x4 r0 = *(const LAS f32x4*)(st_rstd + s0), r1 = *(const LAS f32x4*)(st_rstd + s0 + 4), mu0 = *(const LAS f32x4*)(st_mean + s0), mu1 = *(const LAS f32x4*)(st_mean + s0 + 4);
                rs += (w0[0] + w0[1]) + (w0[2] + w0[3]) + (w1[0] + w1[1]) + (w1[2] + w1[3]);
                v4u p; p.x = cvtpk(w0[0] * r0[0], w0[1] * r0[1]); p.y = cvtpk(w0[2] * r0[2], w0[3] * r0[3]); p.z = cvtpk(w1[0] * r1[0], w1[1] * r1[1]); p.w = cvtpk(w1[2] * r1[2], w1[3] * r1[3]);
                m1 += bf_lo(p.x) * mu0[0] + bf_hi(p.x) * mu0[1] + bf_lo(p.y) * mu0[2] + bf_hi(p.y) * mu0[3] + bf_lo(p.z) * mu1[0] + bf_hi(p.z) * mu1[1] + bf_lo(p.w) * mu1[2] + bf_hi(p.w) * mu1[3];
                pa[st][ks] = __builtin_bit_cast(bf16x8, p); }
        m1 += __shfl_xor(m1, 32); rs += __shfl_xor(rs, 32);
        if (hi == 0) { m1s[r32] = m1; rss[r32] = rs; }
        f32x16 o[4];
#pragma unroll
        for (int d = 0; d < 4; ++d)
#pragma unroll
            for (int r = 0; r < 16; ++r) o[d][r] = 0.f;
#pragma unroll
        for (int st = 0; st < 2; ++st) pv_d0(o, vb0 + (st * 2 + ch) * 16384, pa[st][0], pa[st][1], pa[st][2], pa[st][3]);
        asm volatile("s_waitcnt lgkmcnt(0)" ::: "memory");
        __syncthreads();
        { const int cb = g * 256 + ch * 128;
          const float* lw = uni(lnw + cb); const float* lb = uni(lnb + cb); const float* bsg = uni(bs + g * 128 + 32 * tb);
          int r32e = r32, hie = hi; asm volatile("" : "+v"(r32e), "+v"(hie));
          float lwv[4], lbv[4];
#pragma unroll
          for (int d0 = 0; d0 < 4; ++d0) { lwv[d0] = lw[d0 * 32 + r32e]; lbv[d0] = lb[d0 * 32 + r32e]; }
#pragma unroll
          for (int r = 0; r < 16; ++r) { const int rr = crow(r, hie); const float m1t = m1s[rr], rst = rss[rr], bst = bsg[rr];
#pragma unroll
            for (int d0 = 0; d0 < 4; ++d0) { const float mix = lwv[d0] * (o[d0][r] - m1t) + lbv[d0] * rst + bst;
                *(LAS bf16*)(mx + rr * MXP + (d0 * 32 + r32e) * 2) = (bf16)(cvtpk(mix, 0.f) & 0xffffu); } } }
        asm volatile("s_waitcnt lgkmcnt(0)" ::: "memory");
        { const int cb = g * 256 + ch * 128;
          const bf16* Gu = uni(G1 + (size_t)(row0 + 32 * tb) * N_AB + G1_UB + cb); const bf16* Gzb = uni(G1 + (size_t)(row0 + 32 * tb) * N_AB + G1_ZB + cb); bf16* Co = uni(CC + (size_t)(row0 + 32 * tb) * MIXW + 4096 + cb);
          int le = lane; asm volatile("" : "+v"(le));
#pragma unroll
          for (int i = 0; i < 8; ++i) { const int id = 64 * i + le, row = id >> 4, c8 = (id & 15) * 8;
              const v4u mq = *(const LAS v4u*)(mx + row * MXP + c8 * 2); const v4u uq = LDNT((const v4u*)(Gu + (unsigned)(row * N_AB + c8))), zq = LDNT((const v4u*)(Gzb + (unsigned)(row * N_AB + c8)));
              v4u oq;
#pragma unroll
              for (int e = 0; e < 4; ++e) oq[e] = cvtpk(bf_lo(uq[e]) * bf_lo(mq[e]) * bf_lo(zq[e]), bf_hi(uq[e]) * bf_hi(mq[e]) * bf_hi(zq[e]));
              *(v4u*)(Co + (unsigned)(row * MIXW + c8)) = oq;
              if ((i & 3) == 3) asm volatile("" ::: "memory"); } }
    }
#undef SGU_LOADV
    __syncthreads();
}

namespace att {
constexpr int QBLK = 32, KVBLK = 64;
constexpr float SCALE = 0.07216878364870322f;
constexpr float THR = 8.f;
constexpr int SHM_V = KVBLK * 128 * 2, SHM_K = KVBLK * 192 * 2;
#ifndef STG_SEL
#define STG_SEL 0
#endif
#ifndef ATT_STAGGER
#define ATT_STAGGER 1
#endif
constexpr int NVB = ATT_STAGGER ? 3 : 2;
constexpr int OFF_V = 0, OFF_K = NVB * SHM_V, OFF_WS = OFF_K + 2 * SHM_K, ATT_LDS = OFF_WS + NWAVES * 64 * 4;
#ifndef ATT_QR_LDS
#define ATT_QR_LDS 1
#endif
#ifndef ATT_SDEPTH
#define ATT_SDEPTH 1
#endif
constexpr int SDEPTH = ATT_SDEPTH;
constexpr float THRL = THR * 1.4426950408889634f;
__device__ __forceinline__ void partialSM_first(f32x16& p0, f32x16& p1, float& m_reg, float& alpha) {
    float pmax = p0[0];
#pragma unroll
    for (int r = 1; r < 16; ++r) pmax = fmaxf(pmax, p0[r]);
#pragma unroll
    for (int r = 0; r < 16; ++r) pmax = fmaxf(pmax, p1[r]);
    { auto rr = __builtin_amdgcn_permlane32_swap(__float_as_uint(pmax), __float_as_uint(pmax), false, false);
      pmax = fmaxf(__uint_as_float(rr[0]), __uint_as_float(rr[1])); }
    m_reg = pmax; alpha = 1.f;
#pragma unroll
    for (int r = 0; r < 16; ++r) p0[r] = p0[r] - pmax;
#pragma unroll
    for (int r = 0; r < 16; ++r) p1[r] = p1[r] - pmax;
#pragma unroll
    for (int r = 0; r < 16; ++r) p0[r] = __builtin_amdgcn_exp2f(p0[r]);
}
__device__ __forceinline__ void partialSM(f32x16& p0, f32x16& p1, float& m_reg, float& alpha) {
    float pmax = p0[0];
#pragma unroll
    for (int r = 1; r < 16; ++r) pmax = fmaxf(pmax, p0[r]);
#pragma unroll
    for (int r = 0; r < 16; ++r) pmax = fmaxf(pmax, p1[r]);
    { auto rr = __builtin_amdgcn_permlane32_swap(__float_as_uint(pmax), __float_as_uint(pmax), false, false);
      pmax = fmaxf(__uint_as_float(rr[0]), __uint_as_float(rr[1])); }
    if (__builtin_expect(__all(pmax <= THRL), 1)) { alpha = 1.f; }
    else { const float d = fmaxf(pmax, 0.f); alpha = __builtin_amdgcn_exp2f(-d); m_reg += d;
#pragma unroll
        for (int r = 0; r < 16; ++r) p0[r] = p0[r] - d;
#pragma unroll
        for (int r = 0; r < 16; ++r) p1[r] = p1[r] - d; }
#pragma unroll
    for (int r = 0; r < 16; ++r) p0[r] = __builtin_amdgcn_exp2f(p0[r]);
}
__device__ __forceinline__ void finishSM(f32x16& p0, f32x16& p1, float alpha, float& l_reg, bf16x8& pa0, bf16x8& pa1, bf16x8& pa2, bf16x8& pa3) {
#pragma unroll
    for (int r = 0; r < 16; ++r) p1[r] = __builtin_amdgcn_exp2f(p1[r]);
    float ps = 0;
#pragma unroll
    for (int r = 0; r < 16; ++r) ps += p0[r];
#pragma unroll
    for (int r = 0; r < 16; ++r) ps += p1[r];
    { auto rr = __builtin_amdgcn_permlane32_swap(__float_as_uint(ps), __float_as_uint(ps), false, false);
      ps = __uint_as_float(rr[0]) + __uint_as_float(rr[1]); }
    l_reg = l_reg * alpha + ps;
#define PK4(P, BASE, OUT) do { unsigned a0 = cvtpk(P[BASE + 0], P[BASE + 1]), a1 = cvtpk(P[BASE + 2], P[BASE + 3]);   \
    unsigned b0 = cvtpk(P[BASE + 4], P[BASE + 5]), b1 = cvtpk(P[BASE + 6], P[BASE + 7]);                              \
    auto r0 = __builtin_amdgcn_permlane32_swap(a0, b0, false, false); auto r1 = __builtin_amdgcn_permlane32_swap(a1, b1, false, false); \
    v4u w = {r0[0], r1[0], r0[1], r1[1]}; OUT = __builtin_bit_cast(bf16x8, w); } while (0)
    PK4(p0, 0, pa0); PK4(p0, 8, pa1); PK4(p1, 0, pa2); PK4(p1, 8, pa3);
#undef PK4
}
constexpr int OFF_KR = 16384;
constexpr int OFF_QR = ATT_LDS, ATT_LDS2 = OFF_QR + NWAVES * 4096;
__device__ __forceinline__ void qkt(f32x16& p0, f32x16& p1, const LAS unsigned char* Ks, const bf16x8* qr, const LAS unsigned char* qrl, int r32, int hi, float seed) {
#pragma unroll
    for (int r = 0; r < 16; ++r) { p0[r] = seed; p1[r] = seed; }
    const int swn = (r32 & 15) << 4, swr = ((r32 >> 1) & 7) << 4;
#pragma unroll
    for (int d0 = 0; d0 < 8; ++d0) { const int cb = (d0 * 16 + hi * 8) * 2;
        const bf16x8 b0 = *(const LAS bf16x8*)(Ks + r32 * 256 + (cb ^ swn));
        const bf16x8 b1 = *(const LAS bf16x8*)(Ks + (32 + r32) * 256 + (cb ^ swn));
        p0 = __builtin_amdgcn_mfma_f32_32x32x16_bf16(b0, qr[d0], p0, 0, 0, 0);
        p1 = __builtin_amdgcn_mfma_f32_32x32x16_bf16(b1, qr[d0], p1, 0, 0, 0); }
#pragma unroll
    for (int d0 = 0; d0 < 4; ++d0) { const int cb = (d0 * 16 + hi * 8) * 2;
        const bf16x8 b0 = *(const LAS bf16x8*)(Ks + OFF_KR + r32 * 128 + (cb ^ swr));
        const bf16x8 b1 = *(const LAS bf16x8*)(Ks + OFF_KR + (32 + r32) * 128 + (cb ^ swr));
#if ATT_QR_LDS
        const bf16x8 q = *(const LAS bf16x8*)(qrl + d0 * 1024);
#else
        const bf16x8 q = qr[8 + d0];
#endif
        p0 = __builtin_amdgcn_mfma_f32_32x32x16_bf16(b0, q, p0, 0, 0, 0);
        p1 = __builtin_amdgcn_mfma_f32_32x32x16_bf16(b1, q, p1, 0, 0, 0); }
}
__device__ __forceinline__ void attn_unit(const bf16* __restrict__ Q, const bf16* __restrict__ KN, const bf16* __restrict__ KR, const bf16* __restrict__ V, const bf16* __restrict__ G1, bf16* __restrict__ CC,
                                          int qrow0, int h, int nt_lat, int lat0, int ctx0, LAS unsigned char* lds) {
    int tid_l = threadIdx.x; asm volatile("" : "+v"(tid_l)); const int tid = tid_l, wid = __builtin_amdgcn_readfirstlane(tid >> 6), lane = tid & 63, r32 = lane & 31, hi = lane >> 5;
    LAS unsigned char* V_lds = lds + OFF_V; LAS unsigned char* K_lds = lds + OFF_K;
    LAS float* wsf = (LAS float*)(lds + OFF_WS) + wid * 64; LAS float* li_l = wsf; LAS float* al_l = wsf + 32;
    LAS unsigned char* qrl = lds + OFF_QR + wid * 4096 + lane * 16;
    float m_reg = -1e30f, l_reg = 0;
    f32x16 o[4];
#pragma unroll
    for (int d = 0; d < 4; ++d)
#pragma unroll
        for (int r = 0; r < 16; ++r) o[d][r] = 0.f;
    const unsigned ko = (unsigned)((tid >> 4) * 128 + (((tid & 15) ^ ((tid >> 4) & 15)) * 8));
    const unsigned kro = (unsigned)((tid >> 3) * 64 + (((tid & 7) ^ ((tid >> 4) & 7)) * 8));
    unsigned vo; { const int sub = tid >> 5, kk = (sub >> 2) * 8 + ((tid & 31) >> 2), col = (sub & 3) * 32 + (tid & 3) * 8, key = (kk & ~0xC) | ((kk & 4) << 1) | ((kk & 8) >> 1); vo = (unsigned)(key * 128 + col); }
    const int vb0 = (int)(unsigned)(unsigned long long)lds + OFF_V + v_rd_base(lane);
    const int NT = nt_lat + 4;
#define TROW(jt) ((jt) < nt_lat ? lat0 + 64 * (jt) : ctx0 + 64 * ((jt) - nt_lat))
#define GLDS(gp, lp) __builtin_amdgcn_global_load_lds((const unsigned*)(gp), (LAS unsigned*)(lp), 16, 0, 0)
#define GLDS_S(gbase, boff, lp) do { const char* gb_ = (const char*)(gbase); asm volatile("" : "+s"(gb_)); unsigned bo_ = (boff); asm volatile("" : "+v"(bo_)); GLDS(gb_ + bo_, lp); } while (0)
#define ISSUE_K(jt, b) do { const int R0_ = TROW(jt); const bf16* Kb_ = uni(KN + ((size_t)h * MTOT + R0_) * 128); const bf16* Rb_ = uni(KR + (size_t)R0_ * 64); \
    GLDS_S(Kb_, ko * 2u, K_lds + (b) * SHM_K + wid * 1024); GLDS_S(Kb_ + 32 * 128, ko * 2u, K_lds + (b) * SHM_K + (wid + 8) * 1024); GLDS_S(Rb_, kro * 2u, K_lds + (b) * SHM_K + OFF_KR + wid * 1024); } while (0)
#define ISSUE_V(jt, b) do { const int R0_ = TROW(jt); const bf16* Vb_ = uni(V + ((size_t)h * MTOT + R0_) * 128); \
    GLDS_S(Vb_, vo * 2u, V_lds + (b) * SHM_V + wid * 1024); GLDS_S(Vb_ + 32 * 128, vo * 2u, V_lds + (b) * SHM_V + (wid + 8) * 1024); } while (0)
#define STEP_END() asm volatile("s_waitcnt vmcnt(0) lgkmcnt(0)\n\ts_barrier" ::: "memory")
#define RESC(a_) do { if (__any((a_) < 1.f)) { if (hi == 0) al_l[r32] = (a_); asm volatile("s_waitcnt lgkmcnt(0)" ::: "memory"); \
    _Pragma("unroll") for (int d = 0; d < 4; ++d) _Pragma("unroll") for (int r = 0; r < 16; ++r) o[d][r] *= al_l[crow(r, hi)]; } } while (0)
    STEP_END();
    ISSUE_K(0, 0);
    bf16x8 qr[ATT_QR_LDS ? 8 : 12];
    { const bf16* Qw = uni(Q + (size_t)(qrow0 + wid * QBLK) * NQ + h * 192); const unsigned qo = (unsigned)(r32 * NQ + hi * 8);
#pragma unroll
      for (int d0 = 0; d0 < (ATT_QR_LDS ? 8 : 12); ++d0) qr[d0] = *(const bf16x8*)(Qw + qo + d0 * 16);
#if ATT_QR_LDS
#pragma unroll
      for (int d0 = 8; d0 < 12; ++d0) { const bf16x8 t = *(const bf16x8*)(Qw + qo + d0 * 16); *(LAS bf16x8*)(qrl + (d0 - 8) * 1024) = t; }
#endif
    }
    f32x16 pA0, pA1, pB0, pB1; float alA, alB; bf16x8 pa0, pa1, pa2, pa3;
    STEP_END();
#if !ATT_STAGGER
    ISSUE_K(1, 1); ISSUE_V(0, 0);
    qkt(pA0, pA1, K_lds, qr, qrl, r32, hi, 0.f); partialSM_first(pA0, pA1, m_reg, alA);
    STEP_END();
    for (int j = 1; j + 1 < NT; j += 2) {
        ISSUE_K(j + 1, 0); ISSUE_V(j, 1);
        SBAR(); qkt(pB0, pB1, K_lds + SHM_K, qr, qrl, r32, hi, -m_reg);
        finishSM(pA0, pA1, alA, l_reg, pa0, pa1, pa2, pa3); SBAR();
        pv_pipe(o, vb0, pa0, pa1, pa2, pa3); partialSM(pB0, pB1, m_reg, alB);
        RESC(alB); STEP_END();
        ISSUE_K(j + 2, 1); ISSUE_V(j + 1, 0);
        SBAR(); qkt(pA0, pA1, K_lds, qr, qrl, r32, hi, -m_reg);
        finishSM(pB0, pB1, alB, l_reg, pa0, pa1, pa2, pa3); SBAR();
        pv_pipe(o, vb0 + SHM_V, pa0, pa1, pa2, pa3); partialSM(pA0, pA1, m_reg, alA);
        RESC(alA); STEP_END();
    }
    ISSUE_V(NT - 1, 1);
    SBAR(); qkt(pB0, pB1, K_lds + SHM_K, qr, qrl, r32, hi, -m_reg);
    finishSM(pA0, pA1, alA, l_reg, pa0, pa1, pa2, pa3); SBAR();
    pv_pipe(o, vb0, pa0, pa1, pa2, pa3); partialSM(pB0, pB1, m_reg, alB);
    RESC(alB); STEP_END();
    finishSM(pB0, pB1, alB, l_reg, pa0, pa1, pa2, pa3); SBAR();
    pv_pipe(o, vb0 + SHM_V, pa0, pa1, pa2, pa3);
#else
#define VOFF(t) (__builtin_amdgcn_readfirstlane(((unsigned)(t) % 3u) * (unsigned)SHM_V))
    if (STG_SEL == 0 ? (wid < 4) : (STG_SEL == 1)) {
        ISSUE_K(1, 1); ISSUE_V(0, 0);
        qkt(pA0, pA1, K_lds, qr, qrl, r32, hi, 0.f); partialSM_first(pA0, pA1, m_reg, alA);
        STEP_END();
        for (int j = 1; j + 1 < NT; j += 2) {
            ISSUE_K(j + 1, 0); ISSUE_V(j, j % 3);
            SBAR(); qkt(pB0, pB1, K_lds + SHM_K, qr, qrl, r32, hi, -m_reg); SBAR();
            finishSM(pA0, pA1, alA, l_reg, pa0, pa1, pa2, pa3); SBAR();
            pv_pipe(o, vb0 + VOFF(j - 1), pa0, pa1, pa2, pa3); partialSM(pB0, pB1, m_reg, alB);
            RESC(alB); STEP_END();
            ISSUE_K(j + 2, 1); ISSUE_V(j + 1, (j + 1) % 3);
            SBAR(); qkt(pA0, pA1, K_lds, qr, qrl, r32, hi, -m_reg); SBAR();
            finishSM(pB0, pB1, alB, l_reg, pa0, pa1, pa2, pa3); SBAR();
            pv_pipe(o, vb0 + VOFF(j), pa0, pa1, pa2, pa3); partialSM(pA0, pA1, m_reg, alA);
            RESC(alA); STEP_END();
        }
        ISSUE_V(NT - 1, (NT - 1) % 3);
        SBAR(); qkt(pB0, pB1, K_lds + SHM_K, qr, qrl, r32, hi, -m_reg); SBAR();
        finishSM(pA0, pA1, alA, l_reg, pa0, pa1, pa2, pa3); SBAR();
        pv_pipe(o, vb0 + VOFF(NT - 2), pa0, pa1, pa2, pa3); partialSM(pB0, pB1, m_reg, alB);
        RESC(alB); STEP_END();
        finishSM(pB0, pB1, alB, l_reg, pa0, pa1, pa2, pa3); SBAR();
        pv_pipe(o, vb0 + VOFF(NT - 1), pa0, pa1, pa2, pa3);
        STEP_END();
        STEP_END();
    } else {
#define TR_EVEN(j_) do { finishSM(pA0, pA1, alA, l_reg, pa0, pa1, pa2, pa3); SBAR(); pv_pipe(o, vb0 + VOFF((j_) - 2), pa0, pa1, pa2, pa3); partialSM(pB0, pB1, m_reg, alB); RESC(alB); } while (0)
#define TR_ODD(j_)  do { finishSM(pB0, pB1, alB, l_reg, pa0, pa1, pa2, pa3); SBAR(); pv_pipe(o, vb0 + VOFF((j_) - 2), pa0, pa1, pa2, pa3); partialSM(pA0, pA1, m_reg, alA); RESC(alA); } while (0)
        ISSUE_K(1, 1); ISSUE_V(0, 0);
        qkt(pA0, pA1, K_lds, qr, qrl, r32, hi, 0.f);
        STEP_END();
        ISSUE_K(2, 0); ISSUE_V(1, 1);
        partialSM_first(pA0, pA1, m_reg, alA);
        SBAR(); qkt(pB0, pB1, K_lds + SHM_K, qr, qrl, r32, hi, -m_reg); SBAR();
        STEP_END();
        for (int j = 2; j + 1 < NT - 1; j += 2) {
            ISSUE_K(j + 1, 1); ISSUE_V(j, j % 3);
            TR_EVEN(j); SBAR(); qkt(pA0, pA1, K_lds, qr, qrl, r32, hi, -m_reg); SBAR();
            STEP_END();
            ISSUE_K(j + 2, 0); ISSUE_V(j + 1, (j + 1) % 3);
            TR_ODD(j + 1); SBAR(); qkt(pB0, pB1, K_lds + SHM_K, qr, qrl, r32, hi, -m_reg); SBAR();
            STEP_END();
        }
        ISSUE_K(NT - 1, 1); ISSUE_V(NT - 2, (NT - 2) % 3);
        TR_EVEN(NT - 2); SBAR(); qkt(pA0, pA1, K_lds, qr, qrl, r32, hi, -m_reg); SBAR();
        STEP_END();
        ISSUE_V(NT - 1, (NT - 1) % 3);
        TR_ODD(NT - 1); SBAR(); qkt(pB0, pB1, K_lds + SHM_K, qr, qrl, r32, hi, -m_reg); SBAR();
        STEP_END();
        TR_EVEN(NT);
        STEP_END();
        finishSM(pB0, pB1, alB, l_reg, pa0, pa1, pa2, pa3); SBAR();
        pv_pipe(o, vb0 + VOFF(NT - 1), pa0, pa1, pa2, pa3);
        STEP_END();
#undef TR_EVEN
#undef TR_ODD
    }
#undef VOFF
#endif
    if (hi == 0) li_l[r32] = l_reg;
    STEP_END();
    { LAS unsigned char* mx = lds + wid * (32 * 272);
      int r32e = r32, hie = hi; asm volatile("" : "+v"(r32e), "+v"(hie));
#pragma unroll
      for (int r = 0; r < 16; ++r) { const int rr = crow(r, hie); const float rli = __builtin_amdgcn_rcpf(li_l[rr]);
#pragma unroll
        for (int d0 = 0; d0 < 4; ++d0) *(LAS bf16*)(mx + rr * 272 + (d0 * 32 + r32e) * 2) = (bf16)(cvtpk(o[d0][r] * rli, 0.f) & 0xffffu); }
      asm volatile("s_waitcnt lgkmcnt(0)" ::: "memory");
      const bf16* Gz = uni(G1 + (size_t)(qrow0 + wid * QBLK) * N_AB + G1_ZA + h * 128); bf16* Co = uni(CC + (size_t)(qrow0 + wid * QBLK) * MIXW + h * 128);
      int le = lane; asm volatile("" : "+v"(le));
#pragma unroll
      for (int i = 0; i < 8; ++i) { const int id = 64 * i + le, row = id >> 4, c8 = (id & 15) * 8;
          const v4u oq = *(const LAS v4u*)(mx + row * 272 + c8 * 2); const v4u zq = LDNT((const v4u*)(Gz + (unsigned)(row * N_AB + c8)));
          v4u wq;
#pragma unroll
          for (int e = 0; e < 4; ++e) wq[e] = cvtpk(bf_lo(oq[e]) * bf_lo(zq[e]), bf_hi(oq[e]) * bf_hi(zq[e]));
          *(v4u*)(Co + (unsigned)(row * MIXW + c8)) = wq;
          if ((i & 3) == 3) asm volatile("" ::: "memory"); } }
#undef TROW
#undef GLDS
#undef ISSUE_K
#undef ISSUE_V
#undef STEP_END
#undef RESC
}
}
namespace att2 {
using namespace att;
struct P8 { f32x4 t[2][4]; };
__device__ __forceinline__ float x16(float x) { return __int_as_float(__builtin_amdgcn_ds_swizzle(__float_as_int(x), 0x401F)); }
__device__ __forceinline__ float rmax4(float x) { x = fmaxf(x, x16(x)); auto rr = __builtin_amdgcn_permlane32_swap(__float_as_uint(x), __float_as_uint(x), false, false); return fmaxf(__uint_as_float(rr[0]), __uint_as_float(rr[1])); }
__device__ __forceinline__ float rsum4(float x) { x = x + x16(x); auto rr = __builtin_amdgcn_permlane32_swap(__float_as_uint(x), __float_as_uint(x), false, false); return __uint_as_float(rr[0]) + __uint_as_float(rr[1]); }
__device__ __forceinline__ float tmax(const P8& p, int qt) { float m = p.t[qt][0][0];
#pragma unroll
    for (int kt = 0; kt < 4; ++kt)
#pragma unroll
        for (int r = 0; r < 4; ++r) m = fmaxf(m, p.t[qt][kt][r]);
    return m; }
__device__ __forceinline__ void qkt2(P8& p, const LAS unsigned char* Ks, const bf16x8 (&qf)[2][4], const LAS unsigned char* qrl, int l16, int g4, float seed0, float seed1) {
#pragma unroll
    for (int kt = 0; kt < 4; ++kt) { p.t[0][kt] = (f32x4){seed0, seed0, seed0, seed0}; p.t[1][kt] = (f32x4){seed1, seed1, seed1, seed1}; }
    const int swn = l16 << 4, swr = ((l16 >> 1) & 7) << 4;
#pragma unroll
    for (int ks = 0; ks < 4; ++ks) { const int cb = (32 * ks + 8 * g4) * 2;
#pragma unroll
        for (int kt = 0; kt < 4; ++kt) { const bf16x8 kf = *(const LAS bf16x8*)(Ks + (16 * kt + l16) * 256 + (cb ^ swn));
            p.t[0][kt] = mfma16(kf, qf[0][ks], p.t[0][kt]); p.t[1][kt] = mfma16(kf, qf[1][ks], p.t[1][kt]); } }
#pragma unroll
    for (int ks = 0; ks < 2; ++ks) { const int cb = (32 * ks + 8 * g4) * 2;
        const bf16x8 q0 = *(const LAS bf16x8*)(qrl + ks * 1024), q1 = *(const LAS bf16x8*)(qrl + (2 + ks) * 1024);
#pragma unroll
        for (int kt = 0; kt < 4; ++kt) { const bf16x8 kf = *(const LAS bf16x8*)(Ks + OFF_KR + (16 * kt + l16) * 128 + (cb ^ swr));
            p.t[0][kt] = mfma16(kf, q0, p.t[0][kt]); p.t[1][kt] = mfma16(kf, q1, p.t[1][kt]); } }
}
__device__ __forceinline__ void sub_all(P8& p, float d0, float d1) {
#pragma unroll
    for (int kt = 0; kt < 4; ++kt) { p.t[0][kt] = p.t[0][kt] - d0; p.t[1][kt] = p.t[1][kt] - d1; } }
__device__ __forceinline__ void exp_half(P8& p, int k0) {
#pragma unroll
    for (int qt = 0; qt < 2; ++qt)
#pragma unroll
        for (int kt = 0; kt < 2; ++kt)
#pragma unroll
            for (int r = 0; r < 4; ++r) p.t[qt][k0 + kt][r] = __builtin_amdgcn_exp2f(p.t[qt][k0 + kt][r]); }
__device__ __forceinline__ void partial2_first(P8& p, float& m0, float& m1, float& a0, float& a1) {
    m0 = rmax4(tmax(p, 0)); m1 = rmax4(tmax(p, 1)); a0 = 1.f; a1 = 1.f; sub_all(p, m0, m1); exp_half(p, 0); }
__device__ __forceinline__ void partial2(P8& p, float& m0, float& m1, float& a0, float& a1) {
    const float x0 = rmax4(tmax(p, 0)), x1 = rmax4(tmax(p, 1));
    if (__builtin_expect(__all(fmaxf(x0, x1) <= THRL), 1)) { a0 = 1.f; a1 = 1.f; }
    else { const float d0 = fmaxf(x0, 0.f), d1 = fmaxf(x1, 0.f); a0 = __builtin_amdgcn_exp2f(-d0); a1 = __builtin_amdgcn_exp2f(-d1); m0 += d0; m1 += d1; sub_all(p, d0, d1); }
    exp_half(p, 0); }
__device__ __forceinline__ void finish2(P8& p, float a0, float a1, float& l0, float& l1, bf16x8 (&pb)[2][2]) {
    exp_half(p, 2);
    float s0 = 0.f, s1 = 0.f;
#pragma unroll
    for (int kt = 0; kt < 4; ++kt)
#pragma unroll
        for (int r = 0; r < 4; ++r) { s0 += p.t[0][kt][r]; s1 += p.t[1][kt][r]; }
    l0 = l0 * a0 + rsum4(s0); l1 = l1 * a1 + rsum4(s1);
#pragma unroll
    for (int qt = 0; qt < 2; ++qt)
#pragma unroll
        for (int s2 = 0; s2 < 2; ++s2) { v4u w; w.x = cvtpk(p.t[qt][2 * s2][0], p.t[qt][2 * s2][1]); w.y = cvtpk(p.t[qt][2 * s2][2], p.t[qt][2 * s2][3]);
            w.z = cvtpk(p.t[qt][2 * s2 + 1][0], p.t[qt][2 * s2 + 1][1]); w.w = cvtpk(p.t[qt][2 * s2 + 1][2], p.t[qt][2 * s2 + 1][3]); pb[qt][s2] = __builtin_bit_cast(bf16x8, w); }
}
template <int B, int I> __device__ __forceinline__ void pv2_rd(const int (&vo)[8], s16x4& lo, s16x4& hi) { constexpr int s2 = I >> 3, vt = I & 7;
    lo = tr_read<B * SHM_V + s2 * 8192>(vo[vt]); hi = tr_read<B * SHM_V + s2 * 8192 + 4096>(vo[vt]); }
#define PV2_MM(I, L, H) do { const bf16x8 af_ = (bf16x8){L[0], L[1], L[2], L[3], H[0], H[1], H[2], H[3]}; \
    o[(I) & 7][0] = mfma16(af_, pb[0][(I) >> 3], o[(I) & 7][0]); o[(I) & 7][1] = mfma16(af_, pb[1][(I) >> 3], o[(I) & 7][1]); } while (0)
#define PV2_W(N) do { asm volatile("s_waitcnt lgkmcnt(" #N ")" ::: "memory"); SBAR(); } while (0)
template <int B> __device__ __forceinline__ void pv2(f32x4 (&o)[8][2], const int (&vo)[8], const bf16x8 (&pb)[2][2]) {
    s16x4 l0, h0, l1, h1, l2, h2;
    asm volatile("s_waitcnt lgkmcnt(0)" ::: "memory"); SBAR();
    pv2_rd<B, 0>(vo, l0, h0); pv2_rd<B, 1>(vo, l1, h1); pv2_rd<B, 2>(vo, l2, h2);
    PV2_W(4); PV2_MM(0, l0, h0); SBAR(); pv2_rd<B, 3>(vo, l0, h0);
    PV2_W(4); PV2_MM(1, l1, h1); SBAR(); pv2_rd<B, 4>(vo, l1, h1);
    PV2_W(4); PV2_MM(2, l2, h2); SBAR(); pv2_rd<B, 5>(vo, l2, h2);
    PV2_W(4); PV2_MM(3, l0, h0); SBAR(); pv2_rd<B, 6>(vo, l0, h0);
    PV2_W(4); PV2_MM(4, l1, h1); SBAR(); pv2_rd<B, 7>(vo, l1, h1);
    PV2_W(4); PV2_MM(5, l2, h2); SBAR(); pv2_rd<B, 8>(vo, l2, h2);
    PV2_W(4); PV2_MM(6, l0, h0); SBAR(); pv2_rd<B, 9>(vo, l0, h0);
    PV2_W(4); PV2_MM(7, l1, h1); SBAR(); pv2_rd<B, 10>(vo, l1, h1);
    PV2_W(4); PV2_MM(8, l2, h2); SBAR(); pv2_rd<B, 11>(vo, l2, h2);
    PV2_W(4); PV2_MM(9, l0, h0); SBAR(); pv2_rd<B, 12>(vo, l0, h0);
    PV2_W(4); PV2_MM(10, l1, h1); SBAR(); pv2_rd<B, 13>(vo, l1, h1);
    PV2_W(4); PV2_MM(11, l2, h2); SBAR(); pv2_rd<B, 14>(vo, l2, h2);
    PV2_W(4); PV2_MM(12, l0, h0); SBAR(); pv2_rd<B, 15>(vo, l0, h0);
    PV2_W(4); PV2_MM(13, l1, h1);
    PV2_W(2); PV2_MM(14, l2, h2);
    PV2_W(0); PV2_MM(15, l0, h0);
}
__device__ __forceinline__ void attn_unit2(const bf16* __restrict__ Q, const bf16* __restrict__ KN, const bf16* __restrict__ KR, const bf16* __restrict__ V, const bf16* __restrict__ G1, bf16* __restrict__ CC,
                                           int qrow0, int h, int nt_lat, int lat0, int ctx0, LAS unsigned char* lds) {
    int tid_l = threadIdx.x; asm volatile("" : "+v"(tid_l)); const int tid = tid_l, wid = __builtin_amdgcn_readfirstlane(tid >> 6), lane = tid & 63, l16 = lane & 15, g4 = lane >> 4;
    LAS unsigned char* V_lds = lds + OFF_V; LAS unsigned char* K_lds = lds + OFF_K;
    LAS unsigned char* qrl = lds + OFF_QR + wid * 4096 + lane * 16;
    float m0 = 0.f, m1 = 0.f, l0 = 0.f, l1 = 0.f;
    f32x4 o[8][2];
#pragma unroll
    for (int vt = 0; vt < 8; ++vt) { o[vt][0] = (f32x4){0.f, 0.f, 0.f, 0.f}; o[vt][1] = (f32x4){0.f, 0.f, 0.f, 0.f}; }
    const unsigned ko = (unsigned)((tid >> 4) * 128 + (((tid & 15) ^ ((tid >> 4) & 15)) * 8));
    const unsigned kro = (unsigned)((tid >> 3) * 64 + (((tid & 7) ^ ((tid >> 4) & 7)) * 8));
    const unsigned vo_g = (unsigned)((tid >> 4) * 128 + ((((((tid & 15) >> 1) ^ ((tid >> 4) & 7)) << 1) | (tid & 1)) * 8));
    int vo[8];
    { const int q = l16 >> 2, pp = l16 & 3, rr = 4 * g4 + q, sw = rr & 7, base = (int)(unsigned)(unsigned long long)lds + OFF_V + rr * 256 + 8 * pp;
#pragma unroll
      for (int vt = 0; vt < 8; ++vt) vo[vt] = base + ((vt ^ sw) << 5); }
    const int NT = nt_lat + 4;
#define TROW(jt) ((jt) < nt_lat ? lat0 + 64 * (jt) : ctx0 + 64 * ((jt) - nt_lat))
#define GLDS(gp, lp) __builtin_amdgcn_global_load_lds((const unsigned*)(gp), (LAS unsigned*)(lp), 16, 0, 0)
#define ISSUE_K(jt, b) do { const int R0_ = TROW(jt); const bf16* Kb_ = uni(KN + ((size_t)h * MTOT + R0_) * 128); const bf16* Rb_ = uni(KR + (size_t)R0_ * 64); \
    GLDS(Kb_ + ko, K_lds + (b) * SHM_K + wid * 1024); GLDS(Kb_ + ko + 32 * 128, K_lds + (b) * SHM_K + (wid + 8) * 1024); GLDS(Rb_ + kro, K_lds + (b) * SHM_K + OFF_KR + wid * 1024); } while (0)
#define ISSUE_V(jt, b) do { const int R0_ = TROW(jt); const bf16* Vb_ = uni(V + ((size_t)h * MTOT + R0_) * 128); \
    GLDS(Vb_ + vo_g, V_lds + (b) * SHM_V + wid * 1024); GLDS(Vb_ + vo_g + 32 * 128, V_lds + (b) * SHM_V + (wid + 8) * 1024); } while (0)
#define STEP_END() asm volatile("s_waitcnt vmcnt(0) lgkmcnt(0)\n\ts_barrier" ::: "memory")
#define RESC2(a0_, a1_) do { if (__any(fminf(a0_, a1_) < 1.f)) { _Pragma("unroll") for (int vt = 0; vt < 8; ++vt) { o[vt][0] = o[vt][0] * (a0_); o[vt][1] = o[vt][1] * (a1_); } } } while (0)
    STEP_END();
    ISSUE_K(0, 0);
    bf16x8 qf[2][4];
    { const bf16* Qw = uni(Q + (size_t)(qrow0 + wid * QBLK) * NQ + h * 192); const unsigned qo = (unsigned)(l16 * NQ + g4 * 8);
#pragma unroll
      for (int qt = 0; qt < 2; ++qt) {
#pragma unroll
        for (int ks = 0; ks < 4; ++ks) qf[qt][ks] = *(const bf16x8*)(Qw + qo + (unsigned)(qt * 16 * NQ + ks * 32));
#pragma unroll
        for (int ks = 4; ks < 6; ++ks) { const bf16x8 t = *(const bf16x8*)(Qw + qo + (unsigned)(qt * 16 * NQ + ks * 32)); *(LAS bf16x8*)(qrl + (qt * 2 + ks - 4) * 1024) = t; } } }
    P8 pA, pB; float aA0, aA1, aB0, aB1; bf16x8 pb[2][2];
    STEP_END();
    ISSUE_K(1, 1); ISSUE_V(0, 0);
    qkt2(pA, K_lds, qf, qrl, l16, g4, 0.f, 0.f); partial2_first(pA, m0, m1, aA0, aA1);
    STEP_END();
    for (int j = 1; j + 1 < NT; j += 2) {
        ISSUE_K(j + 1, 0); ISSUE_V(j, 1);
        SBAR(); qkt2(pB, K_lds + SHM_K, qf, qrl, l16, g4, -m0, -m1);
        finish2(pA, aA0, aA1, l0, l1, pb); SBAR();
        pv2<0>(o, vo, pb); partial2(pB, m0, m1, aB0, aB1);
        RESC2(aB0, aB1); STEP_END();
        ISSUE_K(j + 2, 1); ISSUE_V(j + 1, 0);
        SBAR(); qkt2(pA, K_lds, qf, qrl, l16, g4, -m0, -m1);
        finish2(pB, aB0, aB1, l0, l1, pb); SBAR();
        pv2<1>(o, vo, pb); partial2(pA, m0, m1, aA0, aA1);
        RESC2(aA0, aA1); STEP_END();
    }
    ISSUE_V(NT - 1, 1);
    SBAR(); qkt2(pB, K_lds + SHM_K, qf, qrl, l16, g4, -m0, -m1);
    finish2(pA, aA0, aA1, l0, l1, pb); SBAR();
    pv2<0>(o, vo, pb); partial2(pB, m0, m1, aB0, aB1);
    RESC2(aB0, aB1); STEP_END();
    finish2(pB, aB0, aB1, l0, l1, pb); SBAR();
    pv2<1>(o, vo, pb);
    STEP_END();
    { LAS unsigned char* mx = lds + wid * (32 * 272);
      const float r0 = __builtin_amdgcn_rcpf(l0), r1 = __builtin_amdgcn_rcpf(l1);
#pragma unroll
      for (int vt = 0; vt < 8; ++vt) { u32x2 w;
          w.x = cvtpk(o[vt][0][0] * r0, o[vt][0][1] * r0); w.y = cvtpk(o[vt][0][2] * r0, o[vt][0][3] * r0); *(LAS u32x2*)(mx + l16 * 272 + (16 * vt + 4 * g4) * 2) = w;
          w.x = cvtpk(o[vt][1][0] * r1, o[vt][1][1] * r1); w.y = cvtpk(o[vt][1][2] * r1, o[vt][1][3] * r1); *(LAS u32x2*)(mx + (16 + l16) * 272 + (16 * vt + 4 * g4) * 2) = w; }
      asm volatile("s_waitcnt lgkmcnt(0)" ::: "memory");
      const bf16* Gz = uni(G1 + (size_t)(qrow0 + wid * QBLK) * N_AB + G1_ZA + h * 128); bf16* Co = uni(CC + (size_t)(qrow0 + wid * QBLK) * MIXW + h * 128);
      int le = lane; asm volatile("" : "+v"(le));
#pragma unroll
      for (int i = 0; i < 8; ++i) { const int id = 64 * i + le, row = id >> 4, c8 = (id & 15) * 8;
          const v4u oq = *(const LAS v4u*)(mx + row * 272 + c8 * 2); const v4u zq = LDNT((const v4u*)(Gz + (unsigned)(row * N_AB + c8)));
          v4u wq;
#pragma unroll
          for (int e = 0; e < 4; ++e) wq[e] = cvtpk(bf_lo(oq[e]) * bf_lo(zq[e]), bf_hi(oq[e]) * bf_hi(zq[e]));
          *(v4u*)(Co + (unsigned)(row * MIXW + c8)) = wq;
          if ((i & 3) == 3) asm volatile("" ::: "memory"); } }
#undef TROW
#undef GLDS
#undef ISSUE_K
#undef ISSUE_V
#undef STEP_END
#undef RESC2
}
#undef PV2_MM
#undef PV2_W
}
#ifndef ATT_PRIO
#define ATT_PRIO 1
#endif
#ifndef ATT_BODY2
#define ATT_BODY2 0
#endif
__device__ __forceinline__ void attn_phase(KArgs a, LAS unsigned char* lds, int G) {
    const bf16* Q = (const bf16*)(a->ws + WS_Q); const bf16* KN = (const bf16*)(a->ws + WS_KN); const bf16* KR = (const bf16*)(a->ws + WS_KR); const bf16* V = (const bf16*)(a->ws + WS_V);
    const bf16* G1 = (const bf16*)(a->ws + WS_G1); bf16* CC = (bf16*)(a->ws + WS_CC);
    const int bx = blockIdx.x; const int vcu = (G % 8 == 0) ? (bx % 8) * (G / 8) + bx / 8 : bx;
    if (ATT_PRIO && __builtin_amdgcn_readfirstlane(threadIdx.x >> 6) >= 4) __builtin_amdgcn_s_setprio(1);
    for (int u = vcu; u < 2048 + 64; u += G) {
        if (u < 2048) { const int bh = u >> 5, qb = u & 31, b = bh >> 5, h = bh & 31;
            if (ATT_BODY2) att2::attn_unit2(Q, KN, KR, V, G1, CC, b * SEQ + qb * 256, h, 128, b * SEQ, MLAT + b * NCTX, lds); else att::attn_unit(Q, KN, KR, V, G1, CC, b * SEQ + qb * 256, h, 128, b * SEQ, MLAT + b * NCTX, lds); }
        else { const int bh = u - 2048, b = bh >> 5, h = bh & 31;
            if (ATT_BODY2) att2::attn_unit2(Q, KN, KR, V, G1, CC, MLAT + b * NCTX, h, 0, 0, MLAT + b * NCTX, lds); else att::attn_unit(Q, KN, KR, V, G1, CC, MLAT + b * NCTX, h, 0, 0, MLAT + b * NCTX, lds); }
    }
    if (ATT_PRIO) __builtin_amdgcn_s_setprio(0);
    __syncthreads();
}

__device__ __forceinline__ s16x4 tr_read_v(int addr) { s16x4 r; asm volatile("ds_read_b64_tr_b16 %0, %1" : "=&v"(r) : "v"(addr) : "memory"); return r; }
template <int CTRL> __device__ __forceinline__ float dpp_f(float x) { return __int_as_float(__builtin_amdgcn_update_dpp(0, __float_as_int(x), CTRL, 0xf, 0xf, true)); }
constexpr int SC_PITCH = 288;
constexpr int SC_QD = 0, SC_KD = 16 * SC_PITCH, SC_KE = 32 * SC_PITCH, SC_VV = 48 * SC_PITCH, SC_EB = 64 * SC_PITCH, SC_BUF = SC_EB + 512;
constexpr int SC_OST = 2 * SC_BUF;
__device__ __forceinline__ void scan_stage(LAS unsigned char* B, u32x2 rq, u32x2 rk, u32x2 rv, int wid, int lane, int tid) {
    const int t = lane & 15, kq = lane >> 4;
    float q[4], kk[4], x[4], tot[4];
    q[0] = bf_lo(rq.x); q[1] = bf_hi(rq.x); q[2] = bf_lo(rq.y); q[3] = bf_hi(rq.y); kk[0] = bf_lo(rk.x); kk[1] = bf_hi(rk.x); kk[2] = bf_lo(rk.y); kk[3] = bf_hi(rk.y);
#pragma unroll
    for (int e = 0; e < 4; ++e) { float g = __builtin_amdgcn_logf(fmaxf(1.0f - kk[e], 1e-30f)); float s = g;
        g += dpp_f<0x111>(g); g += dpp_f<0x112>(g); g += dpp_f<0x114>(g); g += dpp_f<0x118>(g);
        s += dpp_f<0x128>(s); s += dpp_f<0x124>(s); s += dpp_f<0x122>(s); s += dpp_f<0x121>(s);
        x[e] = g; tot[e] = s; }
    float qd[4], kd[4], ke[4];
#pragma unroll
    for (int e = 0; e < 4; ++e) { qd[e] = q[e] * __builtin_amdgcn_exp2f(x[e]); kd[e] = kk[e] * __builtin_amdgcn_exp2f(fminf(-x[e], 115.0f)); ke[e] = kk[e] * __builtin_amdgcn_exp2f(fminf(tot[e] - x[e], 0.0f)); }
    const int ppos = 32 * (wid >> 1) + 8 * kq + 4 * (wid & 1);
    u32x2 w;
    w.x = cvtpk(qd[0], qd[1]); w.y = cvtpk(qd[2], qd[3]); *(LAS u32x2*)(B + SC_QD + t * SC_PITCH + ppos * 2) = w;
    w.x = cvtpk(kd[0], kd[1]); w.y = cvtpk(kd[2], kd[3]); *(LAS u32x2*)(B + SC_KD + t * SC_PITCH + ppos * 2) = w;
    w.x = cvtpk(ke[0], ke[1]); w.y = cvtpk(ke[2], ke[3]); *(LAS u32x2*)(B + SC_KE + t * SC_PITCH + (16 * wid + 4 * kq) * 2) = w;
    if (t == 0) *(LAS f32x4*)(B + SC_EB + (16 * wid + 4 * kq) * 4) = (f32x4){__builtin_amdgcn_exp2f(tot[0]), __builtin_amdgcn_exp2f(tot[1]), __builtin_amdgcn_exp2f(tot[2]), __builtin_amdgcn_exp2f(tot[3])};
    *(LAS u32x2*)(B + SC_VV + (tid >> 5) * SC_PITCH + (tid & 31) * 8) = rv;
}
__device__ __forceinline__ void scan_phase(KArgs a, LAS unsigned char* lds, int G) {
    int tid_l = threadIdx.x; asm volatile("" : "+v"(tid_l)); const int tid = tid_l, lane = tid & 63, wid = __builtin_amdgcn_readfirstlane(tid >> 6), g4 = lane >> 4, l16 = lane & 15;
    const bf16* G1 = (const bf16*)(a->ws + WS_G1); const size_t TS = (size_t)MTOT * MIXW;
    const int ldsb = (int)(unsigned)(unsigned long long)lds;
    const int trq = l16 >> 2, trp = l16 & 3;
    const int st = lane & 15, sk = 16 * wid + 4 * (lane >> 4);
    const int vt_ = tid >> 5, vc = (tid & 31) * 4;
    for (int sq = blockIdx.x; sq < 256; sq += G) {
        const int dir = sq >> 7, b = (sq >> 6) & 1, h = sq & 63;
        const bf16* Tq = G1 + h * 128; const bf16* Tk = G1 + (size_t)(1 + dir) * TS + h * 128; const bf16* Tv = G1 + (size_t)3 * TS + h * 128;
        bf16* Od = (bf16*)(a->ws + WS_OF) + (size_t)dir * TS + h * 128;
        const unsigned oq = (unsigned)((dir ? 15 - st : st) * MIXW + sk), ovv = (unsigned)((dir ? 15 - vt_ : vt_) * MIXW + vc);
#define CLOW(c_) ((c_) < 16 ? MLAT + b * NCTX + (dir ? 240 - 16 * (c_) : 16 * (c_)) : b * SEQ + (dir ? 8432 - 16 * (c_) : 16 * (c_) - 256))
#define SLOADC(c_) do { const size_t lo_ = (size_t)CLOW(c_) * MIXW; rq = LDNT((const u32x2*)(uni(Tq + lo_) + oq)); rk = LDNT((const u32x2*)(uni(Tk + lo_) + oq)); rv = LDNT((const u32x2*)(uni(Tv + lo_) + ovv)); } while (0)
#define SBARRIER() do { asm volatile("s_waitcnt lgkmcnt(0)" ::: "memory"); __builtin_amdgcn_s_barrier(); asm volatile("" ::: "memory"); } while (0)
        f32x4 S[8];
#pragma unroll
        for (int i = 0; i < 8; ++i) S[i] = (f32x4){0.f, 0.f, 0.f, 0.f};
        u32x2 rq, rk, rv;
        SBARRIER();
        SLOADC(0); scan_stage(lds, rq, rk, rv, wid, lane, tid); SLOADC(1);
        SBARRIER();
        for (int c = 0; c < 528; ++c) {
            LAS unsigned char* Bc = lds + (c & 1) * SC_BUF;
            if (c > 0) { const u32x2 ov = *(const LAS u32x2*)(lds + SC_OST + ((c - 1) & 1) * 4096 + vt_ * 256 + vc * 2); *(u32x2*)(uni(Od + (size_t)CLOW(c - 1) * MIXW) + ovv) = ov; }
            if (c + 1 < 528) { scan_stage(lds + ((c + 1) & 1) * SC_BUF, rq, rk, rv, wid, lane, tid); if (c + 2 < 528) SLOADC(c + 2); }
            bf16x8 qf[4], kf[4]; f32x4 e4[8]; s16x4 kt4[8];
#pragma unroll
            for (int ks = 0; ks < 4; ++ks) { qf[ks] = *(const LAS bf16x8*)(Bc + SC_QD + l16 * SC_PITCH + (32 * ks + 8 * g4) * 2); kf[ks] = *(const LAS bf16x8*)(Bc + SC_KD + l16 * SC_PITCH + (32 * ks + 8 * g4) * 2); }
            const int trb = ldsb + (c & 1) * SC_BUF + (4 * g4 + trq) * SC_PITCH + 8 * trp;
            const s16x4 vt = tr_read_v(trb + SC_VV + 32 * wid);
#pragma unroll
            for (int kt = 0; kt < 8; ++kt) { e4[kt] = *(const LAS f32x4*)(Bc + SC_EB + (16 * kt + 4 * g4) * 4); kt4[kt] = tr_read_v(trb + SC_KE + 32 * kt); }
            f32x4 at = (f32x4){0.f, 0.f, 0.f, 0.f};
#pragma unroll
            for (int ks = 0; ks < 4; ++ks) at = mfma16(kf[ks], qf[ks], at);
#pragma unroll
            for (int r = 0; r < 4; ++r) at[r] = (4 * g4 + r <= l16) ? at[r] : 0.f;
            bf16x8 pa; { v4u w; w.x = cvtpk(at[0], at[1]); w.y = cvtpk(at[2], at[3]); w.z = 0u; w.w = 0u; pa = __builtin_bit_cast(bf16x8, w); }
            f32x4 o = (f32x4){0.f, 0.f, 0.f, 0.f};
#pragma unroll
            for (int ks = 0; ks < 4; ++ks) { v4u w; w.x = cvtpk(S[2 * ks][0], S[2 * ks][1]); w.y = cvtpk(S[2 * ks][2], S[2 * ks][3]); w.z = cvtpk(S[2 * ks + 1][0], S[2 * ks + 1][1]); w.w = cvtpk(S[2 * ks + 1][2], S[2 * ks + 1][3]);
                o = mfma16(qf[ks], __builtin_bit_cast(bf16x8, w), o); }
            asm volatile("s_waitcnt lgkmcnt(0)" ::: "memory"); SBAR();
            const bf16x8 vf = (bf16x8){vt[0], vt[1], vt[2], vt[3], 0, 0, 0, 0};
            o = mfma16(pa, vf, o);
#pragma unroll
            for (int kt = 0; kt < 8; ++kt) { const bf16x8 kef = (bf16x8){kt4[kt][0], kt4[kt][1], kt4[kt][2], kt4[kt][3], 0, 0, 0, 0};
                S[kt] = mfma16(kef, vf, S[kt] * e4[kt]); }
            { LAS bf16* ost = (LAS bf16*)(lds + SC_OST + (c & 1) * 4096);
#pragma unroll
              for (int r = 0; r < 4; ++r) ost[(4 * g4 + r) * 128 + 16 * wid + l16] = (bf16)(cvtpk(o[r], 0.f) & 0xffffu); }
            SBARRIER();
        }
        { const u32x2 ov = *(const LAS u32x2*)(lds + SC_OST + (527 & 1) * 4096 + vt_ * 256 + vc * 2); *(u32x2*)(uni(Od + (size_t)CLOW(527) * MIXW) + ovv) = ov; }
#undef CLOW
#undef SLOADC
#undef SBARRIER
    }
    asm volatile("s_waitcnt lgkmcnt(0)" ::: "memory"); __builtin_amdgcn_s_barrier(); asm volatile("" ::: "memory");
}

__device__ __forceinline__ void readout_phase(KArgs a, int jc, int nrows, int G) {
    int tid_l = threadIdx.x; asm volatile("" : "+v"(tid_l)); const int tid = tid_l, lane = tid & 63, wave = __builtin_amdgcn_readfirstlane(tid >> 6);
    const int gw = blockIdx.x * NWAVES + wave, NGW = G * NWAVES;
    const size_t TS = (size_t)MTOT * MIXW;
    const bf16* OFp = (const bf16*)(a->ws + WS_OF); const bf16* OBp = OFp + TS; const bf16* GS = (const bf16*)(a->ws + WS_G1) + 4 * TS; bf16* CC = (bf16*)(a->ws + WS_CC);
    const float* gnw = a->in[20] + (size_t)jc * 128 + (lane & 15) * 8;
    const f32x4 w0 = *(const f32x4*)gnw, w1 = *(const f32x4*)(gnw + 4);
    for (int it = gw; it < nrows * 16; it += NGW) {
        const size_t off = (size_t)(it >> 4) * MIXW + (it & 15) * 512 + lane * 8;
        const v4u f = LDNT((const v4u*)(OFp + off)), bq = LDNT((const v4u*)(OBp + off)), gq = LDNT((const v4u*)(GS + off));
        float o[8], gg[8];
#pragma unroll
        for (int e = 0; e < 4; ++e) { o[2 * e] = bf_lo(f[e]) + bf_lo(bq[e]); o[2 * e + 1] = bf_hi(f[e]) + bf_hi(bq[e]); gg[2 * e] = bf_lo(gq[e]); gg[2 * e + 1] = bf_hi(gq[e]); }
        float ss = 0.f;
#pragma unroll
        for (int e = 0; e < 8; ++e) ss += o[e] * o[e];
        ss += __shfl_xor(ss, 1); ss += __shfl_xor(ss, 2); ss += __shfl_xor(ss, 4); ss += __shfl_xor(ss, 8);
        const float r = 1.0f / sqrtf(ss * (1.0f / 128.0f) + EPS);
        v4u w; w.x = cvtpk(o[0] * r * w0[0] * gg[0], o[1] * r * w0[1] * gg[1]); w.y = cvtpk(o[2] * r * w0[2] * gg[2], o[3] * r * w0[3] * gg[3]);
        w.z = cvtpk(o[4] * r * w1[0] * gg[4], o[5] * r * w1[1] * gg[5]); w.w = cvtpk(o[6] * r * w1[2] * gg[6], o[7] * r * w1[3] * gg[7]);
        *(v4u*)(CC + off) = w;
    }
}

#ifndef EN_P0
#define EN_P0 1
#endif
#ifndef EN_NORM
#define EN_NORM 1
#endif
#ifndef EN_A1
#define EN_A1 1
#endif
#ifndef EN_A2
#define EN_A2 1
#endif
#ifndef EN_A3
#define EN_A3 1
#endif
#ifndef EN_ATT
#define EN_ATT 1
#endif
#ifndef EN_A5
#define EN_A5 1
#endif
#ifndef EN_C1
#define EN_C1 1
#endif
#ifndef EN_SCAN
#define EN_SCAN 1
#endif
#ifndef EN_RO
#define EN_RO 1
#endif
#ifndef EN_C4
#define EN_C4 1
#endif
#ifndef EN_SGU
#define EN_SGU 1
#endif
#ifndef EN_QUP
#define EN_QUP 1
#endif
#ifndef EN_KVUP
#define EN_KVUP 1
#endif
#ifndef PG8_ALIGNV
#define PG8_ALIGNV true
#endif
#ifndef PG8_SP2V
#define PG8_SP2V true
#endif
#ifndef PROBE_MASK
#define PROBE_MASK 0u
#endif
#define REPS(k) for (int rep_ = 0; rep_ < ((((PROBE_MASK) >> (k)) & 1u) ? 2 : 1); ++rep_)
#ifndef MK_ONE_LAUNCH
#define MK_ONE_LAUNCH 1
#endif
constexpr int N_PHASES = 28;
#define IN(k) (lo <= (k) && (k) < hi)
#define SEAM(k) do { if (IN(k) && IN((k) + 1)) xcd_barrier(bar); } while (0)
template <int p> __device__ __forceinline__ void layer_pair(LAS unsigned char* lds, const int G, const int lo, const int hi, const XcdBarrier& bar) {

        const int pb = 2 + 13 * p, lab = 2 * p, lc = 2 * p + 1;
        if (EN_A1 && IN(pb + 0)) REPS(pb + 0) {
            KArgs A = kargs(); unsigned char* const wsb = A->ws;
            pg8::Gemm g{(const pg8::bf16_t*)(wsb + WS_H), (const pg8::bf16_t*)(wsb + WS_WIN_AB) + (size_t)p * N_AB * DM, MTOT, N_AB, DM, DM}; pg8::LockstepOrder S; S.init(MTOT, N_AB, G, (int)blockIdx.x);
            pg8::EpiAB1 E{(pg8::bf16_t*)(wsb + WS_G1), N_AB};
            pg8::gemm_phase<pg8::EpiAB1, pg8::LockstepOrder, PG8_ALIGNV, PG8_SP2V>(lds, g, S, E);
            if (p0_defer_on(G)) { pg8::LockstepOrder S2; S2.init(MTOT, N_AB, G, (int)blockIdx.x); p0_deferred(kargs(), lds, S2, p == 0 ? 0 : 2); }
        } SEAM(pb + 0);
        if (EN_A2 && IN(pb + 1)) REPS(pb + 1) { a2_rows(kargs(), p, G); } SEAM(pb + 1);
        if (EN_SGU && IN(pb + 2)) REPS(pb + 2) { sgu_phase(kargs(), p, lds, G); }
        if (EN_QUP && IN(pb + 3)) REPS(pb + 3) {
            KArgs A = kargs(); unsigned char* const wsb = A->ws;
            pg8::Gemm g{(const pg8::bf16_t*)(wsb + WS_QN), (const pg8::bf16_t*)(wsb + WS_WQ) + (size_t)p * NQ * QL, MTOT, NQ, QL, QL}; pg8::LockstepOrder S; S.init(MTOT, NQ, G, (int)blockIdx.x);
            pg8::EpiQ E{(pg8::bf16_t*)(wsb + WS_Q), (const pg8::f32x2*)(wsb + WS_ROPE), MLAT, 0.07216878364870322f * 1.4426950408889634f};
            pg8::gemm_phase<pg8::EpiQ, pg8::LockstepOrder, PG8_ALIGNV, PG8_SP2V>(lds, g, S, E);
        }
        if (EN_KVUP && IN(pb + 4)) REPS(pb + 4) {
            KArgs A = kargs(); unsigned char* const wsb = A->ws;
            pg8::Gemm g{(const pg8::bf16_t*)(wsb + WS_KVN), (const pg8::bf16_t*)(wsb + WS_WKV) + (size_t)p * NKV * KVL, MTOT, NKV, KVL, KVL}; pg8::LockstepOrder S; S.init(MTOT, NKV, G, (int)((blockIdx.x + 64u) % (unsigned)G));
            pg8::EpiKV E{(pg8::bf16_t*)(wsb + WS_KN), (pg8::bf16_t*)(wsb + WS_V), MTOT};
            pg8::gemm_phase<pg8::EpiKV, pg8::LockstepOrder, PG8_ALIGNV, PG8_SP2V>(lds, g, S, E);
        } SEAM(pb + 4);
        if (EN_ATT && IN(pb + 5)) REPS(pb + 5) { attn_phase(kargs(), lds, G); } SEAM(pb + 5);
        if (EN_A5 && IN(pb + 6)) REPS(pb + 6) {
            KArgs A = kargs(); unsigned char* const wsb = A->ws;
            { pg8::Gemm g{(const pg8::bf16_t*)(wsb + WS_CC), (const pg8::bf16_t*)(wsb + WS_WO_AB) + (size_t)p * DM * MIXW, MLAT, DM, MIXW, MIXW}; pg8::LockstepOrder S; S.init(MLAT, DM, G, (int)blockIdx.x);
              pg8::EpiBf16P E{(pg8::bf16_t*)(wsb + WS_Y), DM};
              pg8::gemm_phase<pg8::EpiBf16P, pg8::LockstepOrder, PG8_ALIGNV, PG8_SP2V>(lds, g, S, E); }
            { pg8::Gemm g{(const pg8::bf16_t*)(wsb + WS_CC) + (size_t)MLAT * MIXW, (const pg8::bf16_t*)(wsb + WS_WO_AB) + (size_t)p * DM * MIXW, MTOT - MLAT, DM, MIXW / 8, MIXW}; pg8::SplitKOrder S; S.init(MTOT - MLAT, DM, 8, G, (int)blockIdx.x);
              pg8::EpiF32 E{(float*)(wsb + WS_YP), DM, (size_t)(MTOT - MLAT) * DM};
              pg8::gemm_phase<pg8::EpiF32, pg8::SplitKOrder, PG8_ALIGNV, PG8_SP2V>(lds, g, S, E); }
        } SEAM(pb + 6);
        if (EN_NORM && IN(pb + 7)) REPS(pb + 7) { norm_phase(kargs(), lab, lc, G); } SEAM(pb + 7);
        if (EN_C1 && IN(pb + 8)) REPS(pb + 8) {
            KArgs A = kargs(); unsigned char* const wsb = A->ws;
            pg8::Gemm g{(const pg8::bf16_t*)(wsb + WS_H), (const pg8::bf16_t*)(wsb + WS_WIN_C) + (size_t)p * N_C * DM, MTOT, N_C, DM, DM}; pg8::LockstepOrder S; S.init(MTOT, N_C, G, (int)blockIdx.x);
            pg8::EpiC1 E{(pg8::bf16_t*)(wsb + WS_G1), (size_t)MTOT * MIXW, (const float*)(wsb + WS_OML) + (size_t)p * 2 * 8192};
            pg8::gemm_phase<pg8::EpiC1, pg8::LockstepOrder, PG8_ALIGNV, PG8_SP2V>(lds, g, S, E);
            if (p0_defer_on(G)) { pg8::LockstepOrder S2; S2.init(MTOT, N_C, G, (int)blockIdx.x); p0_deferred(kargs(), lds, S2, p == 0 ? 1 : 3); }
        } SEAM(pb + 8);
        if (EN_SCAN && IN(pb + 9)) REPS(pb + 9) { scan_phase(kargs(), lds, G); } SEAM(pb + 9);
        if (EN_RO && IN(pb + 10)) REPS(pb + 10) { readout_phase(kargs(), p, lc == 3 ? MLAT : MTOT, G); } SEAM(pb + 10);
        if (EN_C4 && IN(pb + 11)) REPS(pb + 11) {
            KArgs A = kargs(); unsigned char* const wsb = A->ws;
            { pg8::Gemm g{(const pg8::bf16_t*)(wsb + WS_CC), (const pg8::bf16_t*)(wsb + WS_WO_C) + (size_t)p * DM * MIXW, MLAT, DM, MIXW, MIXW}; pg8::LockstepOrder S; S.init(MLAT, DM, G, (int)blockIdx.x);
              pg8::EpiBf16P E{(pg8::bf16_t*)(wsb + WS_Y), DM};
              pg8::gemm_phase<pg8::EpiBf16P, pg8::LockstepOrder, PG8_ALIGNV, PG8_SP2V>(lds, g, S, E); }
            if (lc != 3) { pg8::Gemm g{(const pg8::bf16_t*)(wsb + WS_CC) + (size_t)MLAT * MIXW, (const pg8::bf16_t*)(wsb + WS_WO_C) + (size_t)p * DM * MIXW, MTOT - MLAT, DM, MIXW / 8, MIXW}; pg8::SplitKOrder S; S.init(MTOT - MLAT, DM, 8, G, (int)blockIdx.x);
              pg8::EpiF32 E{(float*)(wsb + WS_YP), DM, (size_t)(MTOT - MLAT) * DM};
              pg8::gemm_phase<pg8::EpiF32, pg8::SplitKOrder, PG8_ALIGNV, PG8_SP2V>(lds, g, S, E); }
        } SEAM(pb + 11);
        if (EN_NORM && IN(pb + 12)) REPS(pb + 12) { norm_phase(kargs(), lc, lc + 1, G); } SEAM(pb + 12);
    }
#undef IN
#undef SEAM
__global__ void __launch_bounds__(NWAVES * 64, 2) fwd(Args a) {
    extern __shared__ __attribute__((aligned(16))) unsigned char lds_raw[];
    LAS unsigned char* lds = (LAS unsigned char*)lds_raw;
    int tid_l = threadIdx.x; asm volatile("" : "+v"(tid_l)); const int tid = tid_l, G = gridDim.x;
    for (int u = tid; u < (LDS_BYTES - LDSCTL_OFF) / 4; u += NWAVES * 64) ((LAS unsigned*)(lds + LDSCTL_OFF))[u] = 0u;
    __syncthreads();
    XcdBarrier bar; bar.bar = (unsigned*)(a.ws + WS_CTL) + CW_BAR; bar.x = 0; bar.st = nullptr;
    if (MK_ONE_LAUNCH) bar = xcd_barrier_post((unsigned*)(a.ws + WS_CTL) + CW_BAR, (volatile LAS unsigned*)(lds + MISC_OFF));
    const int lo = a.ph_lo, hi = a.ph_hi;
#define IN(k) (lo <= (k) && (k) < hi)
#define SEAM(k) do { if (IN(k) && IN((k) + 1)) xcd_barrier(bar); } while (0)
    if (EN_P0 && IN(0)) REPS(0) { p0_prologue(kargs(), lds, G); } SEAM(0);
    if (EN_NORM && IN(1)) REPS(1) { norm_phase(kargs(), -1, 0, G); } SEAM(1);
    layer_pair<0>(lds, G, lo, hi, bar);
    layer_pair<1>(lds, G, lo, hi, bar);
#undef IN
#undef SEAM
}

extern "C" void kernel_launch(void* const* d_in, const int* in_sizes, int n_in, void* d_out, int out_size, void* d_ws, size_t ws_size, hipStream_t stream) {
    static int grid = 0;
    if (grid == 0) {
        if (n_in != 22 || out_size != MLAT * DM || ws_size < WS_END) { fprintf(stderr, "kernel_launch: unexpected shapes (n_in %d, out %d, ws %zu, need %zu)\n", n_in, out_size, ws_size, (size_t)WS_END); grid = -1; return; }
        int dev = 0, cus = 0, per_cu = 0;
        if (hipGetDevice(&dev) != hipSuccess || hipDeviceGetAttribute(&cus, hipDeviceAttributeMultiprocessorCount, dev) != hipSuccess) { grid = -1; return; }
        if (hipFuncSetAttribute((const void*)fwd, hipFuncAttributeMaxDynamicSharedMemorySize, LDS_BYTES) != hipSuccess) { fprintf(stderr, "kernel_launch: hipFuncSetAttribute failed\n"); grid = -1; return; }
        if (hipOccupancyMaxActiveBlocksPerMultiprocessor(&per_cu, (const void*)fwd, NWAVES * 64, LDS_BYTES) != hipSuccess || per_cu < 1) fprintf(stderr, "kernel_launch: occupancy query reports %d\n", per_cu);
        (void)hipGetLastError();
        grid = cus;
    }
    if (grid < 0) return;
    (void)hipMemsetAsync((char*)d_ws + WS_CTL, 0, 65536, stream);
    Args a{};
    for (int i = 0; i < 22; ++i) a.in[i] = (const float*)d_in[i];
    a.out = (float*)d_out; a.ws = (unsigned char*)d_ws;
#if MK_ONE_LAUNCH
    a.ph_lo = 0; a.ph_hi = N_PHASES;
    hipLaunchKernelGGL(fwd, dim3(grid), dim3(NWAVES * 64), LDS_BYTES, stream, a);
#else
    for (int p = 0; p < N_PHASES; ++p) { a.ph_lo = p; a.ph_hi = p + 1; hipLaunchKernelGGL(fwd, dim3(grid), dim3(NWAVES * 64), LDS_BYTES, stream, a); }
#endif
}
```

```cpp
#include <hip/hip_runtime.h>
#include <cstdio>
#include <cstdint>
namespace pg8 {
#define PG8_LAS __attribute__((address_space(3)))
typedef unsigned short bf16_t;
typedef short bf16x8 __attribute__((ext_vector_type(8)));
typedef float f32x4 __attribute__((ext_vector_type(4)));
typedef unsigned u32x4 __attribute__((ext_vector_type(4)));
constexpr int BM = 256, BK = 64, HALF = 128, HTB = HALF * BK * 2  , STAGE_BYTES = 8 * HTB, NXCD = 8, WGM = 4;

__host__ __device__ __forceinline__ int lds_byte(int r, int c) { const int st = (r >> 4) * 2 + (c >> 5), rr = r & 15, cc = c & 31, ob = rr * 64 + cc * 2; return st * 1024 + (ob ^ (((ob >> 9) & 1) << 5)); }
__host__ __device__ __forceinline__ void stage_rc(int b, int& R, int& C) { const int st = b / 1024, sb = b % 1024, swz = sb ^ (((sb >> 9) & 1) << 5); R = (st >> 1) * 16 + swz / 64; C = (st & 1) * 32 + (swz % 64) / 2; }
__host__ __device__ __forceinline__ int perm32(int rho) { const int n = rho >> 4, i = rho & 15; return 8 * (i >> 2) + 4 * n + (i & 3); }

struct Unit { int pm, pn, kc; };
struct Gemm { const bf16_t* A; const bf16_t* Bt; int M, N, K, ld; };

struct StaticOrder {
    int nM, nN, nwg, G, c;
    __host__ __device__ void init(int M, int N, int G_, int c_) { nM = M / BM; nN = N / BM; nwg = nM * nN; G = G_; c = c_; }
    __host__ __device__ bool next(int i, Unit& u) const {
        const long L = (long)i * G + c; if (L >= nwg) return false;
        int wgid = (int)L; { const int q = nwg / NXCD, r = nwg % NXCD, xcd = wgid % NXCD, off = wgid / NXCD; wgid = (xcd < r ? xcd * (q + 1) : r * (q + 1) + (xcd - r) * q) + off; }
        const int nig = WGM * nN, gid = wgid / nig, fm = gid * WGM, gsz = (nM - fm) < WGM ? (nM - fm) : WGM;
        u.pm = fm + ((wgid % nig) % gsz); u.pn = (wgid % nig) / gsz; u.kc = 0; return true;
    }
    __device__ __forceinline__ void a_ready(const Unit&) const {}
    __device__ __forceinline__ void done(const Unit&) const {}
};
struct LockstepOrder {
    static constexpr int LW = 4;
    int nM, nN, G, c, x, k, nk, PG, r0, gR, qR, rR, lenx;
    __host__ __device__ void init(int M, int N, int G_, int c_) { nM = M / BM; nN = N / BM; G = G_; c = c_; x = c_ % NXCD; k = c_ / NXCD; nk = G_ / NXCD; PG = (nM / LW) / NXCD; r0 = PG * NXCD * LW; gR = nM - r0;
        const int rem = gR * nN; qR = rem / NXCD; rR = rem % NXCD; lenx = PG * LW * nN + qR + (x < rR ? 1 : 0); }
    __host__ __device__ bool next(int i, Unit& u) const {
        if (G % NXCD != 0) { const long L = (long)i * G + c; if (L >= (long)nM * nN) return false; u.kc = 0; u.pm = (int)(L / nN); u.pn = (int)(L % nN); return true; }
        const int off = i * nk + k; if (off >= lenx) return false; u.kc = 0;
        const int lock = PG * LW * nN;
        if (off < lock) { const int j = off / (LW * nN), o2 = off % (LW * nN); u.pm = (j * NXCD + x) * LW + o2 % LW; u.pn = o2 / LW; }
        else { const int rho = (x < rR ? x * (qR + 1) : rR * (qR + 1) + (x - rR) * qR) + (off - lock); u.pm = r0 + rho % gR; u.pn = rho / gR; }
        return true;
    }
    __device__ __forceinline__ void a_ready(const Unit&) const {}
    __device__ __forceinline__ void done(const Unit&) const {}
};
struct SplitKOrder {
    int nM, nN, KS, nwg, G, c;
    __host__ __device__ void init(int M, int N, int KS_, int G_, int c_) { nM = M / BM; nN = N / BM; KS = KS_; nwg = nM * nN * KS; G = G_; c = c_; }
    __host__ __device__ bool next(int i, Unit& u) const { const long L = (long)i * G + c; if (L >= nwg) return false; const int l = (int)L; u.kc = l % KS; u.pn = (l / KS) % nN; u.pm = l / (KS * nN); return true; }
    __device__ __forceinline__ void a_ready(const Unit&) const {}
    __device__ __forceinline__ void done(const Unit&) const {}
};

typedef float f32x2 __attribute__((ext_vector_type(2)));
typedef __bf16 bf16x2_c __attribute__((ext_vector_type(2)));
__device__ __forceinline__ unsigned cvt_pk_bf16(float lo, float hi) { const f32x2 v = {lo, hi}; const bf16x2_c b = __builtin_convertvector(v, bf16x2_c); return __builtin_bit_cast(unsigned, b); }
__device__ __forceinline__ f32x2 gelu_pk(f32x2 v) {
    const f32x2 av = __builtin_elementwise_abs(v), d = av * 0.2316418882f + 1.0f;
    f32x2 t; t.x = __builtin_amdgcn_rcpf(d.x); t.y = __builtin_amdgcn_rcpf(d.y);
    f32x2 q = t * 0.5307027145f + (-0.7265760135f); q = q * t + 0.7107068705f; q = q * t + (-0.142248368f); q = q * t + 0.127414796f; q = q * t;
    const f32x2 s = (v * v) * (-0.72134752044f);
    f32x2 e; e.x = __builtin_amdgcn_exp2f(s.x); e.y = __builtin_amdgcn_exp2f(s.y);
    const f32x2 m = v * (q * e), r = v - m;
    f32x2 o; o.x = v.x < 0.f ? m.x : r.x; o.y = v.y < 0.f ? m.y : r.y; return o;
}

typedef unsigned u32x2 __attribute__((ext_vector_type(2)));
__device__ __forceinline__ float silu_f(float x) { return x * __builtin_amdgcn_rcpf(1.0f + __builtin_amdgcn_exp2f(-1.4426950408889634f * x)); }
__device__ __forceinline__ float sigmoid_neg_f(float x) { return __builtin_amdgcn_rcpf(1.0f + __builtin_amdgcn_exp2f(1.4426950408889634f * x)); }
__device__ __forceinline__ f32x4 act4(f32x4 v, int act) {
    if (act == 1) { v[0] = silu_f(v[0]); v[1] = silu_f(v[1]); v[2] = silu_f(v[2]); v[3] = silu_f(v[3]); }
    else if (act == 2) { const f32x2 a = gelu_pk((f32x2){v[0], v[1]}), b = gelu_pk((f32x2){v[2], v[3]}); v = (f32x4){a.x, a.y, b.x, b.y}; }
    return v;
}
struct EpiF32 {
    static constexpr bool PERM = false, AFTER_DRAIN = false;
    float* C0; int ldc; size_t kstride;
    __device__ __forceinline__ void operator()(const f32x4 (&acc)[2][2][4][2], const Unit& u, int wr, int wc, int fr, int fq) const {
        float* C = C0 + (size_t)u.kc * kstride;
        const int row0 = u.pm * BM + wr * 64 + fr, col0 = u.pn * BM + wc * 32 + 4 * fq;
#pragma unroll
        for (int ai = 0; ai < 2; ++ai)
#pragma unroll
            for (int m = 0; m < 4; ++m) { float* rowp = C + (size_t)(row0 + ai * HALF + m * 16) * ldc + col0;
#pragma unroll
                for (int bj = 0; bj < 2; ++bj)
#pragma unroll
                    for (int n = 0; n < 2; ++n) *(f32x4*)(rowp + bj * HALF + n * 16) = acc[ai][bj][m][n]; }
    }
};
struct EpiBf16P {
    static constexpr bool PERM = true, AFTER_DRAIN = false;
    bf16_t* O; int ldc;
    __device__ __forceinline__ void operator()(const f32x4 (&acc)[2][2][4][2], const Unit& u, int wr, int wc, int fr, int fq) const {
        const int row0 = u.pm * BM + wr * 64 + fr, col0 = u.pn * BM + wc * 32 + 8 * fq;
#pragma unroll
        for (int ai = 0; ai < 2; ++ai)
#pragma unroll
            for (int m = 0; m < 4; ++m) { bf16_t* rowp = O + (size_t)(row0 + ai * HALF + m * 16) * ldc + col0;
#pragma unroll
                for (int bj = 0; bj < 2; ++bj) { const f32x4 v0 = acc[ai][bj][m][0], v1 = acc[ai][bj][m][1];
                    u32x4 w; w.x = cvt_pk_bf16(v0[0], v0[1]); w.y = cvt_pk_bf16(v0[2], v0[3]); w.z = cvt_pk_bf16(v1[0], v1[1]); w.w = cvt_pk_bf16(v1[2], v1[3]);
                    *(u32x4*)(rowp + bj * HALF) = w; } }
    }
};
struct EpiAB1 {
    static constexpr bool PERM = true, AFTER_DRAIN = false;
    bf16_t* O; int ldc;
    __device__ __forceinline__ void operator()(const f32x4 (&acc)[2][2][4][2], const Unit& u, int wr, int wc, int fr, int fq) const {
        const int act = u.pn < 7 ? 0 : ((u.pn < 23 || u.pn >= 55) ? 1 : 2);
        const int row0 = u.pm * BM + wr * 64 + fr, col0 = u.pn * BM + wc * 32 + 8 * fq;
#pragma unroll
        for (int ai = 0; ai < 2; ++ai)
#pragma unroll
            for (int m = 0; m < 4; ++m) { bf16_t* rowp = O + (size_t)(row0 + ai * HALF + m * 16) * ldc + col0;
#pragma unroll
                for (int bj = 0; bj < 2; ++bj) { const f32x4 v0 = act4(acc[ai][bj][m][0], act), v1 = act4(acc[ai][bj][m][1], act);
                    u32x4 w; w.x = cvt_pk_bf16(v0[0], v0[1]); w.y = cvt_pk_bf16(v0[2], v0[3]); w.z = cvt_pk_bf16(v1[0], v1[1]); w.w = cvt_pk_bf16(v1[2], v1[3]);
                    *(u32x4*)(rowp + bj * HALF) = w; } }
    }
};
struct EpiC1 {
    static constexpr bool PERM = true, AFTER_DRAIN = false;
    bf16_t* O; size_t stride; const float* oml;
    __device__ __forceinline__ void operator()(const f32x4 (&acc)[2][2][4][2], const Unit& u, int wr, int wc, int fr, int fq) const {
        const int region = u.pn >> 5; bf16_t* base = O + (size_t)region * stride;
        const int row0 = u.pm * BM + wr * 64 + fr, col0 = (u.pn & 31) * BM + wc * 32 + 8 * fq;
        const bool gate = (region == 1 || region == 2); const int act = (region == 0 || region == 4) ? 1 : 0;
        f32x4 gv[2][2];
#pragma unroll
        for (int bj = 0; bj < 2; ++bj)
#pragma unroll
            for (int n = 0; n < 2; ++n) gv[bj][n] = gate ? *(const f32x4*)(oml + (size_t)(region - 1) * 8192 + col0 + bj * HALF + 4 * n) : (f32x4){1.f, 1.f, 1.f, 1.f};
#pragma unroll
        for (int ai = 0; ai < 2; ++ai)
#pragma unroll
            for (int m = 0; m < 4; ++m) { bf16_t* rowp = base + (size_t)(row0 + ai * HALF + m * 16) * 8192 + col0;
#pragma unroll
                for (int bj = 0; bj < 2; ++bj) { f32x4 v0 = acc[ai][bj][m][0], v1 = acc[ai][bj][m][1];
                    if (gate) {
#pragma unroll
                        for (int j = 0; j < 4; ++j) { v0[j] = gv[bj][0][j] * sigmoid_neg_f(v0[j]); v1[j] = gv[bj][1][j] * sigmoid_neg_f(v1[j]); } }
                    else { v0 = act4(v0, act); v1 = act4(v1, act); }
                    u32x4 w; w.x = cvt_pk_bf16(v0[0], v0[1]); w.y = cvt_pk_bf16(v0[2], v0[3]); w.z = cvt_pk_bf16(v1[0], v1[1]); w.w = cvt_pk_bf16(v1[2], v1[3]);
                    *(u32x4*)(rowp + bj * HALF) = w; } }
    }
};
struct EpiQ {
    static constexpr bool PERM = true, AFTER_DRAIN = false;
    bf16_t* O; const f32x2* rope; int nlat; float qscale;
    __device__ __forceinline__ void operator()(const f32x4 (&acc)[2][2][4][2], const Unit& u, int wr, int wc, int fr, int fq) const {
        const int row0 = u.pm * BM + wr * 64 + fr; const bool upper = fq >= 2;
#pragma unroll
        for (int bj = 0; bj < 2; ++bj) {
            const int G = 8 * u.pn + 4 * bj + wc, hm = G % 6, col = u.pn * BM + bj * HALF + wc * 32 + 8 * fq;
#pragma unroll
            for (int ai = 0; ai < 2; ++ai)
#pragma unroll
                for (int m = 0; m < 4; ++m) { const int row = row0 + ai * HALF + m * 16; f32x4 x0 = acc[ai][bj][m][0], x1 = acc[ai][bj][m][1];
                    if (hm >= 4 && u.pm * BM < nlat) {
                        const int t = row & 8191, pos = (hm == 4) ? (t >> 6) : (t & 63); const f32x2* cs = rope + pos * 16 + 8 * (fq & 1);
#pragma unroll
                        for (int j = 0; j < 4; ++j) {
                            { auto rr = __builtin_amdgcn_permlane32_swap(__float_as_uint(x0[j]), __float_as_uint(x0[j]), false, false); const float pv = __uint_as_float(upper ? rr[0] : rr[1]); const f32x2 c = cs[j];
                              x0[j] = upper ? x0[j] * c.x + pv * c.y : x0[j] * c.x - pv * c.y; }
                            { auto rr = __builtin_amdgcn_permlane32_swap(__float_as_uint(x1[j]), __float_as_uint(x1[j]), false, false); const float pv = __uint_as_float(upper ? rr[0] : rr[1]); const f32x2 c = cs[4 + j];
                              x1[j] = upper ? x1[j] * c.x + pv * c.y : x1[j] * c.x - pv * c.y; } } }
                    x0 = x0 * qscale; x1 = x1 * qscale;
                    u32x4 w; w.x = cvt_pk_bf16(x0[0], x0[1]); w.y = cvt_pk_bf16(x0[2], x0[3]); w.z = cvt_pk_bf16(x1[0], x1[1]); w.w = cvt_pk_bf16(x1[2], x1[3]);
                    *(u32x4*)(O + (size_t)row * 6144 + col) = w; }
        }
    }
};
struct EpiKV {
    static constexpr bool PERM = true, AFTER_DRAIN = false;
    bf16_t* KN; bf16_t* V; int mtot;
    __device__ __forceinline__ void operator()(const f32x4 (&acc)[2][2][4][2], const Unit& u, int wr, int wc, int fr, int fq) const {
        const int row0 = u.pm * BM + wr * 64 + fr, colh = wc * 32 + 8 * fq;
#pragma unroll
        for (int ai = 0; ai < 2; ++ai)
#pragma unroll
            for (int m = 0; m < 4; ++m) { const size_t off = ((size_t)u.pn * mtot + (size_t)(row0 + ai * HALF + m * 16)) * 128 + colh;
#pragma unroll
                for (int bj = 0; bj < 2; ++bj) { const f32x4 v0 = acc[ai][bj][m][0], v1 = acc[ai][bj][m][1];
                    u32x4 w; w.x = cvt_pk_bf16(v0[0], v0[1]); w.y = cvt_pk_bf16(v0[2], v0[3]); w.z = cvt_pk_bf16(v1[0], v1[1]); w.w = cvt_pk_bf16(v1[2], v1[3]);
                    *(u32x4*)((bj ? V : KN) + off) = w; } }
    }
};

template <class Epi, class Sched, bool ALIGN_EPI = false, bool SP2 = false>
__device__ __forceinline__ void gemm_phase(PG8_LAS unsigned char* lds, const Gemm g, const Sched& S, const Epi& E) {
    int tid_l = threadIdx.x; asm volatile("" : "+v"(tid_l)); const int tid = tid_l, wid = __builtin_amdgcn_readfirstlane(tid >> 6), lane = tid & 63, wr = wid >> 2, wc = wid & 3, fr = lane & 15, fq = lane >> 4;
    const int K = g.ld, nt = g.K / BK;
    unsigned voffA[2], voffB[2];
#pragma unroll
    for (int i = 0; i < 2; ++i) { int R, C; stage_rc(tid * 16 + i * 8192, R, C); const int Rb = Epi::PERM ? ((R & ~31) + perm32(R & 31)) : R;
        voffA[i] = (unsigned)(R * K + C) * 2u; voffB[i] = (unsigned)(Rb * K + C) * 2u; }
    const size_t kstep = (size_t)(BK * 2);
    const size_t hstep = (size_t)HALF * K * 2;
    const size_t tstep = 2 * hstep;
    const unsigned ldsw = (unsigned)wid * 1024u;
    const int aoff = lds_byte(wr * 64 + fr, fq * 8), boff = lds_byte(wc * 32 + fr, fq * 8);
#define PG8_SA(b, h) (((b) * 2 + (h)) * HTB)
#define PG8_SB(b, h) ((4 + (b) * 2 + (h)) * HTB)
#define PG8_STAGE(bufoff, gbase, voff) do { const char* gb_ = (const char*)(gbase); asm volatile("" : "+s"(gb_)); _Pragma("unroll") for (int _i = 0; _i < 2; ++_i) { unsigned vo_ = (voff)[_i]; asm volatile("" : "+v"(vo_)); \
        __builtin_amdgcn_global_load_lds((const unsigned*)(gb_ + vo_), (PG8_LAS unsigned*)(lds + (bufoff) + ldsw + _i * 8192), 16, 0, 0); } } while (0)
#define PG8_LDA(dst, b, h) do { _Pragma("unroll") for (int m = 0; m < 4; ++m) _Pragma("unroll") for (int k = 0; k < 2; ++k) dst[m][k] = *(const PG8_LAS bf16x8*)(lds + PG8_SA(b, h) + aoff + m * 2048 + k * 1024); } while (0)
#define PG8_LDB(dst, b, h) do { _Pragma("unroll") for (int n = 0; n < 2; ++n) _Pragma("unroll") for (int k = 0; k < 2; ++k) dst[n][k] = *(const PG8_LAS bf16x8*)(lds + PG8_SB(b, h) + boff + n * 2048 + k * 1024); } while (0)
#define PG8_MMA(ai, bj, At, Bt) do { __builtin_amdgcn_sched_barrier(0); _Pragma("unroll") for (int m = 0; m < 4; ++m) _Pragma("unroll") for (int n = 0; n < 2; ++n) _Pragma("unroll") for (int k = 0; k < 2; ++k) \
        acc[ai][bj][m][n] = __builtin_amdgcn_mfma_f32_16x16x32_bf16(Bt[n][k], At[m][k], acc[ai][bj][m][n], 0, 0, 0); __builtin_amdgcn_sched_barrier(0); } while (0)
#define PG8_WAIT_V(n) asm volatile("s_waitcnt vmcnt(" #n ")" ::: "memory")
#define PG8_WAIT_L(n) asm volatile("s_waitcnt lgkmcnt(" #n ")" ::: "memory")
#define PG8_BAR __builtin_amdgcn_s_barrier()
#define PG8_SCHED __builtin_amdgcn_sched_barrier(0)
    if (wr == 0) __builtin_amdgcn_s_setprio(1);
    Unit cur, nxt; int ui = 0;
    if (!S.next(0, cur)) { __builtin_amdgcn_s_setprio(0); return; }
    f32x4 acc[2][2][4][2];
#pragma unroll
    for (int a = 0; a < 2; ++a)
#pragma unroll
        for (int b = 0; b < 2; ++b)
#pragma unroll
            for (int m = 0; m < 4; ++m)
#pragma unroll
                for (int n = 0; n < 2; ++n) acc[a][b][m][n] = (f32x4){0.f, 0.f, 0.f, 0.f};
    bf16x8 At[4][2], B0[2][2], B1[2][2];
    const size_t kcb = (size_t)g.K * 2;
    const char* cA = (const char*)g.A + (size_t)cur.pm * tstep + cur.kc * kcb; const char* cB = (const char*)g.Bt + (size_t)cur.pn * tstep + cur.kc * kcb;
    S.a_ready(cur);
    if constexpr (SP2) {
        PG8_STAGE(PG8_SB(0, 0), cB, voffB); PG8_STAGE(PG8_SB(0, 1), cB + hstep, voffB); PG8_STAGE(PG8_SA(0, 0), cA, voffA); PG8_STAGE(PG8_SA(0, 1), cA + hstep, voffA);
        if (wr == 1) PG8_BAR;
        PG8_WAIT_V(2); PG8_BAR;
        PG8_STAGE(PG8_SB(1, 0), cB + kstep, voffB); PG8_STAGE(PG8_SA(1, 0), cA + kstep, voffA); PG8_STAGE(PG8_SB(1, 1), cB + hstep + kstep, voffB);
        PG8_WAIT_V(6); PG8_BAR;
    } else {
        PG8_STAGE(PG8_SB(0, 0), cB, voffB); PG8_STAGE(PG8_SA(0, 0), cA, voffA); PG8_STAGE(PG8_SB(0, 1), cB + hstep, voffB); PG8_STAGE(PG8_SA(0, 1), cA + hstep, voffA);
        if (wr == 1) PG8_BAR;
        PG8_WAIT_V(4); PG8_BAR;
        PG8_STAGE(PG8_SB(1, 0), cB + kstep, voffB); PG8_STAGE(PG8_SA(1, 0), cA + kstep, voffA); PG8_STAGE(PG8_SB(1, 1), cB + hstep + kstep, voffB);
        PG8_WAIT_V(6); PG8_BAR;
    }
    for (;;) {
        const bool has_next = S.next(ui + 1, nxt);
        const char* nA = has_next ? (const char*)g.A + (size_t)nxt.pm * tstep + nxt.kc * kcb : cA; const char* nB = has_next ? (const char*)g.Bt + (size_t)nxt.pn * tstep + nxt.kc * kcb : cB;
        for (int t = 0; t < nt; t += 2) {
            const bool last = (t == nt - 2);
            const char* a1 = cA + (size_t)(t + 1) * kstep;
            const char* a2 = last ? nA : cA + (size_t)(t + 2) * kstep; const char* b2 = last ? nB : cB + (size_t)(t + 2) * kstep;
            const char* a3 = a2 + kstep; const char* b3 = b2 + kstep;
            if (last && has_next) S.a_ready(nxt);
            if constexpr (SP2) {
            PG8_LDB(B0, 0, 0); PG8_LDB(B1, 0, 1); PG8_SCHED; PG8_LDA(At, 0, 0); PG8_STAGE(PG8_SA(1, 1), a1 + hstep, voffA);
            PG8_WAIT_V(8); PG8_WAIT_L(0); PG8_BAR; PG8_MMA(0, 0, At, B0); PG8_MMA(0, 1, At, B1); PG8_BAR; PG8_SCHED;
            PG8_LDA(At, 0, 1); PG8_STAGE(PG8_SB(0, 0), b2, voffB); PG8_STAGE(PG8_SB(0, 1), b2 + hstep, voffB); PG8_STAGE(PG8_SA(0, 0), a2, voffA);
            PG8_WAIT_V(8); PG8_WAIT_L(0); PG8_BAR; PG8_MMA(1, 0, At, B0); PG8_MMA(1, 1, At, B1); PG8_BAR; PG8_SCHED;
            PG8_LDB(B0, 1, 0); PG8_LDB(B1, 1, 1); PG8_SCHED; PG8_LDA(At, 1, 0); PG8_STAGE(PG8_SA(0, 1), a2 + hstep, voffA);
            PG8_WAIT_V(8); PG8_WAIT_L(0); PG8_BAR; PG8_MMA(0, 0, At, B0); PG8_MMA(0, 1, At, B1); PG8_BAR; PG8_SCHED;
            PG8_LDA(At, 1, 1); PG8_STAGE(PG8_SB(1, 0), b3, voffB); PG8_STAGE(PG8_SB(1, 1), b3 + hstep, voffB); PG8_STAGE(PG8_SA(1, 0), a3, voffA);
            PG8_WAIT_V(8); PG8_WAIT_L(0); PG8_BAR; PG8_MMA(1, 0, At, B0); PG8_MMA(1, 1, At, B1); PG8_BAR; PG8_SCHED;
            } else {
            PG8_LDB(B0, 0, 0); PG8_SCHED; PG8_LDA(At, 0, 0); PG8_STAGE(PG8_SA(1, 1), a1 + hstep, voffA);
            PG8_WAIT_L(8); PG8_BAR; PG8_WAIT_L(0); PG8_MMA(0, 0, At, B0); PG8_BAR; PG8_SCHED;
            PG8_LDB(B1, 0, 1); PG8_STAGE(PG8_SB(0, 0), b2, voffB);
            PG8_BAR; PG8_WAIT_L(0); PG8_MMA(0, 1, At, B1); PG8_BAR;
            PG8_LDA(At, 0, 1); PG8_STAGE(PG8_SA(0, 0), a2, voffA);
            PG8_BAR; PG8_WAIT_L(0); PG8_MMA(1, 0, At, B0); PG8_BAR; PG8_SCHED;
            PG8_STAGE(PG8_SB(0, 1), b2 + hstep, voffB);
            PG8_WAIT_V(6); PG8_BAR; PG8_MMA(1, 1, At, B1); PG8_BAR;
            PG8_LDB(B0, 1, 0); PG8_SCHED; PG8_LDA(At, 1, 0); PG8_STAGE(PG8_SA(0, 1), a2 + hstep, voffA);
            PG8_WAIT_L(8); PG8_BAR; PG8_WAIT_L(0); PG8_MMA(0, 0, At, B0); PG8_BAR; PG8_SCHED;
            PG8_LDB(B1, 1, 1); PG8_STAGE(PG8_SB(1, 0), b3, voffB);
            PG8_BAR; PG8_WAIT_L(0); PG8_MMA(0, 1, At, B1); PG8_BAR;
            PG8_LDA(At, 1, 1); PG8_STAGE(PG8_SA(1, 0), a3, voffA);
            PG8_BAR; PG8_WAIT_L(0); PG8_MMA(1, 0, At, B0); PG8_BAR; PG8_SCHED;
            PG8_STAGE(PG8_SB(1, 1), b3 + hstep, voffB);
            PG8_WAIT_V(6); PG8_BAR; PG8_MMA(1, 1, At, B1); PG8_BAR;
            }
        }
        if constexpr (ALIGN_EPI) { if (wr == 0) PG8_BAR; }
        if constexpr (!Epi::AFTER_DRAIN) { E(acc, cur, wr, wc, fr, fq); S.done(cur); }
        if (!has_next) break;
#pragma unroll
        for (int a = 0; a < 2; ++a)
#pragma unroll
            for (int b = 0; b < 2; ++b)
#pragma unroll
                for (int m = 0; m < 4; ++m)
#pragma unroll
                    for (int n = 0; n < 2; ++n) acc[a][b][m][n] = (f32x4){0.f, 0.f, 0.f, 0.f};
        cur = nxt; cA = nA; cB = nB; ++ui;
        if constexpr (ALIGN_EPI) { if (wr == 1) PG8_BAR; }
    }
    PG8_WAIT_V(0);
    if constexpr (!ALIGN_EPI) { if (wr == 0) PG8_BAR; }
    PG8_BAR;
    if constexpr (Epi::AFTER_DRAIN) { E.fused(acc, cur, wr, wc, fr, fq, lds, wid, lane); S.done(cur); }
    __builtin_amdgcn_s_setprio(0);
#undef PG8_SA
#undef PG8_SB
#undef PG8_STAGE
#undef PG8_LDA
#undef PG8_LDB
#undef PG8_MMA
#undef PG8_WAIT_V
#undef PG8_WAIT_L
#undef PG8_BAR
#undef PG8_SCHED
}
}
#define GAS __attribute__((address_space(1)))
#define LAS __attribute__((address_space(3)))
typedef unsigned short bf16;
typedef unsigned v4u __attribute__((ext_vector_type(4)));
typedef float f32x4 __attribute__((ext_vector_type(4)));
typedef short bf16x8 __attribute__((ext_vector_type(8)));
typedef GAS unsigned gu32;
typedef GAS unsigned long long gu64;
#define RLX_AGENT __ATOMIC_RELAXED, __HIP_MEMORY_SCOPE_AGENT
#define LDS_WAIT() asm volatile("s_waitcnt lgkmcnt(0)" ::: "memory")
#define VM_WAIT() asm volatile("s_waitcnt vmcnt(0)" ::: "memory")
__device__ __forceinline__ unsigned long long rt() { return __builtin_amdgcn_s_memrealtime(); }
__device__ __forceinline__ unsigned f2bf(float f) { unsigned u = __builtin_bit_cast(unsigned, f); return (u + 0x7fffu + ((u >> 16) & 1u)) >> 16; }
__device__ __forceinline__ unsigned pk2(float lo, float hi) { return f2bf(lo) | (f2bf(hi) << 16); }

typedef unsigned u32x2 __attribute__((ext_vector_type(2)));
typedef float f32x2 __attribute__((ext_vector_type(2)));
#define XB_TMO      128
#define XB_XCNT(j)  (256  + 64 * (j))
#define XB_XSUB(j)  (1280 + 64 * (j))
#define XB_XGEN(j)  (2304 + 64 * (j))
#define XB_TOP      3328
#define XB_TOPGEN   3392
#define XCD_BAR_WORDS 3456
#define XB_SPIN_CAP (1u << 21)

__device__ __forceinline__ unsigned xb_ld(unsigned* p)              { return __hip_atomic_load(p, __ATOMIC_RELAXED, __HIP_MEMORY_SCOPE_AGENT); }
__device__ __forceinline__ unsigned xb_add(unsigned* p, unsigned v) { return __hip_atomic_fetch_add(p, v, __ATOMIC_RELAXED, __HIP_MEMORY_SCOPE_AGENT); }
__device__ __forceinline__ unsigned xb_xcc_id() { return (unsigned)__builtin_amdgcn_s_getreg((3 << 11) | 20) & 0xFu; }
#define XB_SPIN(cond, bar) do { unsigned _sp = 0; while (cond) { __builtin_amdgcn_s_sleep(1); \
    if ((++_sp & 255u) == 0u) { if (xb_ld(&(bar)[XB_TMO])) break; if (_sp > XB_SPIN_CAP) { atomicAdd(&(bar)[XB_TMO], 1u); break; } } } } while (0)

struct XcdBarrier {
    unsigned* bar; unsigned x;
    volatile LAS unsigned* st;
};

__device__ __forceinline__ XcdBarrier xcd_barrier_post(unsigned* bar, volatile LAS unsigned* st) {
    XcdBarrier b; b.bar = bar; b.x = xb_xcc_id(); b.st = st;
    if (threadIdx.x == 0) (void)xb_add(&bar[XB_XCNT(b.x)], 1u);
    return b;
}
__device__ __forceinline__ void xcd_barrier_complete(unsigned* bar, unsigned x, unsigned& nloc, unsigned& nx) {
    const unsigned G = gridDim.x * gridDim.y * gridDim.z;
    unsigned sum, cnt, mine, sp = 0u;
    for (;;) {
        sum = 0u; cnt = 0u; mine = 0u;
#pragma unroll
        for (unsigned j = 0; j < 16; ++j) { const unsigned c = xb_ld(&bar[XB_XCNT(j)]); sum += c; cnt += (c > 0u) ? 1u : 0u; mine = (j == x) ? c : mine; }
        if (sum == G) break;
        __builtin_amdgcn_s_sleep(1);
        if ((++sp & 255u) == 0u) { if (xb_ld(&bar[XB_TMO])) break; if (sp > XB_SPIN_CAP) { atomicAdd(&bar[XB_TMO], 1u); break; } }
    }
    nloc = mine > 0u ? mine : 1u; nx = cnt > 0u ? cnt : 1u;
}

__device__ __forceinline__ void xcd_barrier(const XcdBarrier& b) {
    asm volatile("s_waitcnt vmcnt(0)" ::: "memory");
    __syncthreads();
    if (threadIdx.x == 0) {
        unsigned* bar = b.bar;
        __builtin_amdgcn_s_waitcnt(0);
        unsigned nloc = b.st[0], nx = b.st[1];
        if (nloc == 0u) { xcd_barrier_complete(bar, b.x, nloc, nx); b.st[0] = nloc; b.st[1] = nx; }
        const unsigned old = xb_add(&bar[XB_XSUB(b.x)], 1u);
        const unsigned gen = old / nloc;
        if (old + 1u == (gen + 1u) * nloc) {
            __builtin_amdgcn_fence(__ATOMIC_RELEASE, "agent");
            asm volatile("s_waitcnt vmcnt(0)" ::: "memory");
            const unsigned og = xb_add(&bar[XB_TOP], 1u);
            const unsigned tg = og / nx;
            if (og + 1u == (tg + 1u) * nx) xb_add(&bar[XB_TOPGEN], 1u);
            else XB_SPIN(xb_ld(&bar[XB_TOPGEN]) == tg, bar);
            __builtin_amdgcn_fence(__ATOMIC_ACQUIRE, "agent");
            xb_add(&bar[XB_XGEN(b.x)], 1u);
            asm volatile("s_waitcnt vmcnt(0)" ::: "memory");
        } else {
            XB_SPIN(xb_ld(&bar[XB_XGEN(b.x)]) == gen, bar);
            __builtin_amdgcn_fence(__ATOMIC_ACQUIRE, "agent");
            asm volatile("s_waitcnt vmcnt(0)" ::: "memory");
        }
    }
    __syncthreads();
}


#ifndef NT_STREAMS
#define NT_STREAMS 1
#endif
#if NT_STREAMS
#define LDNT(p) __builtin_nontemporal_load(p)
#define STNT(p, v) __builtin_nontemporal_store((v), (p))
#else
#define LDNT(p) (*(p))
#define STNT(p, v) (*(p) = (v))
#endif
constexpr int NWAVES = 8;
constexpr int DM = 4096, NBATCH = 2, SEQ = 8192, NCTX = 256;
constexpr int MLAT = NBATCH * SEQ;
constexpr int MTOT = MLAT + NBATCH * NCTX;
constexpr int N_AB = 18176;
constexpr int N_ABSRC = 17984, N_C = 40960, MIXW = 8192;
constexpr int QL = 1024, KVL = 512, NQ = 6144, NKV = 8192;
constexpr int G1_CKV = 1024, G1_KR = 1536, G1_ZA = 1792, G1_UB = 5888, G1_VB = 9984, G1_ZB = 14080;
constexpr float EPS = 1e-6f;

constexpr size_t al256(size_t x) { return (x + 255) & ~(size_t)255; }
constexpr size_t WS_CTL = 0, CTL_ZERO_BYTES = 1u << 20;
constexpr size_t WS_MOD  = CTL_ZERO_BYTES;
constexpr size_t WS_OML  = WS_MOD  + al256((size_t)4 * 3 * 12288 * 4);
constexpr size_t WS_ROPE = WS_OML  + al256((size_t)2 * 2 * 8192 * 4);
constexpr size_t WS_STAT = WS_ROPE + al256((size_t)128 * 16 * 8);
constexpr size_t WS_WIN_AB = WS_STAT + al256((size_t)MTOT * 8);
constexpr size_t WS_WIN_C  = WS_WIN_AB + (size_t)2 * N_AB * DM * 2;
constexpr size_t WS_WO_AB  = WS_WIN_C + (size_t)2 * N_C * DM * 2;
constexpr size_t WS_WO_C   = WS_WO_AB + (size_t)2 * DM * MIXW * 2;
constexpr size_t WS_WQ     = WS_WO_C + (size_t)2 * DM * MIXW * 2;
constexpr size_t WS_WKV    = WS_WQ + (size_t)2 * NQ * QL * 2;
constexpr size_t WS_XS     = WS_WKV + (size_t)2 * NKV * KVL * 2;
constexpr size_t WS_H      = WS_XS + (size_t)MTOT * DM * 4;
constexpr size_t WS_Y      = WS_H + (size_t)MTOT * DM * 2;
constexpr size_t WS_G1     = WS_Y + (size_t)MTOT * DM * 4;
constexpr size_t WS_QN     = WS_G1 + (size_t)5 * MTOT * MIXW * 2;
constexpr size_t WS_KVN    = WS_QN + (size_t)MTOT * QL * 2;
constexpr size_t WS_KR     = WS_KVN + (size_t)MTOT * KVL * 2;
constexpr size_t WS_Q      = WS_KR + (size_t)MTOT * 64 * 2;
constexpr size_t WS_KN     = WS_Q + (size_t)MTOT * NQ * 2;
constexpr size_t WS_V      = WS_KN + (size_t)MTOT * DM * 2;
constexpr size_t WS_CC     = WS_V + (size_t)MTOT * DM * 2;
constexpr size_t WS_OF     = WS_CC + (size_t)MTOT * MIXW * 2;
constexpr size_t WS_YP     = WS_OF + (size_t)2 * MTOT * MIXW * 2;
constexpr size_t WS_END    = WS_YP + (size_t)8 * (MTOT - MLAT) * DM * 4;
constexpr int CW_BAR = 4096;

constexpr int RING_BYTES = 135168;
constexpr int LDSCTL_OFF = RING_BYTES, MISC_OFF = LDSCTL_OFF + 64;
constexpr int LDS_BYTES = 147456;

struct Args { const float* in[22]; float* out; unsigned char* ws; int ph_lo, ph_hi; };
typedef const __attribute__((address_space(4))) Args* KArgs;
__device__ __forceinline__ KArgs kargs() { KArgs ap = (KArgs)__builtin_amdgcn_kernarg_segment_ptr(); asm volatile("" : "+s"(ap)); return ap; }

#define GAS __attribute__((address_space(1)))
template <class T> __device__ __forceinline__ T* glob(T* p) { return (T*)(GAS T*)p; }
template <class T> __device__ __forceinline__ T* uni(T* p) {
    const unsigned long long v = (unsigned long long)p; const unsigned lo = __builtin_amdgcn_readfirstlane((unsigned)v), hi = __builtin_amdgcn_readfirstlane((unsigned)(v >> 32));
    return (T*)(GAS T*)(((unsigned long long)hi << 32) | lo); }
#define GWS(a_) glob((a_)->ws)
#define GIN(a_, i_) glob((a_)->in[i_])
#define GOUT(a_) glob((a_)->out)
__device__ __forceinline__ float wave_sum(float v) {
#pragma unroll
    for (int o = 1; o < 64; o <<= 1) v += __shfl_xor(v, o);
    return v;
}
__device__ __forceinline__ float bf_lo(unsigned w) { return __uint_as_float(w << 16); }
__device__ __forceinline__ float bf_hi(unsigned w) { return __uint_as_float(w & 0xffff0000u); }
typedef __bf16 bf16x2_t __attribute__((ext_vector_type(2)));
__device__ __forceinline__ unsigned cvtpk(float lo, float hi) { const f32x2 v = {lo, hi}; const bf16x2_t b = __builtin_convertvector(v, bf16x2_t); return __builtin_bit_cast(unsigned, b); }
__device__ __forceinline__ float silu_acc(float x) { return x / (1.0f + __expf(-x)); }

__device__ __forceinline__ void p0_gemv(KArgs a, LAS unsigned char* lds, int G) {
    int tid_l = threadIdx.x; asm volatile("" : "+v"(tid_l)); const int tid = tid_l, lane = tid & 63, wave = __builtin_amdgcn_readfirstlane(tid >> 6);
    LAS float* sc = (LAS float*)lds;
    LAS float* red = (LAS float*)(lds + 49152);
    const float* c = GIN(a, 1); const float* cctx = GIN(a, 3); const float* w_ada = GIN(a, 4); const float* b_ada = GIN(a, 5);
    float* mod = (float*)(GWS(a) + WS_MOD);
    for (int i = tid; i < 3 * 4096; i += 512) { const int r = i >> 12, k = i & 4095; const float cv = r < 2 ? c[r * 4096 + k] : cctx[k]; sc[i] = silu_acc(cv); }
    __syncthreads();
    const int kr = lane >> 4, c4 = lane & 15;
    for (int item = blockIdx.x; item < 768; item += G) {
        const int l = item / 192, cg = item % 192;
        const float* W = w_ada + (size_t)l * 4096 * 12288 + cg * 64 + c4 * 4;
        float acc[3][4];
#pragma unroll
        for (int r = 0; r < 3; ++r)
#pragma unroll
            for (int j = 0; j < 4; ++j) acc[r][j] = 0.f;
        const int k0 = wave * 512 + kr;
#pragma unroll 8
        for (int i = 0; i < 128; ++i) { const int k = k0 + 4 * i; const f32x4 w = LDNT((const f32x4*)(W + (size_t)k * 12288));
            const float s0 = sc[k], s1 = sc[4096 + k], s2 = sc[8192 + k];
#pragma unroll
            for (int j = 0; j < 4; ++j) { acc[0][j] += s0 * w[j]; acc[1][j] += s1 * w[j]; acc[2][j] += s2 * w[j]; } }
#pragma unroll
        for (int r = 0; r < 3; ++r)
#pragma unroll
            for (int j = 0; j < 4; ++j) { float v = acc[r][j]; v += __shfl_xor(v, 16); v += __shfl_xor(v, 32); acc[r][j] = v; }
        if (lane < 16) {
#pragma unroll
            for (int r = 0; r < 3; ++r)
#pragma unroll
                for (int j = 0; j < 4; ++j) red[(wave * 3 + r) * 64 + lane * 4 + j] = acc[r][j]; }
        __syncthreads();
        if (tid < 192) { const int r = tid >> 6, cc = tid & 63; float s = 0.f;
#pragma unroll
            for (int w = 0; w < 8; ++w) s += red[(w * 3 + r) * 64 + cc];
            const int col = cg * 64 + cc; mod[(size_t)(l * 3 + r) * 12288 + col] = s + b_ada[l * 12288 + col]; }
        __syncthreads();
    }
}
__device__ __forceinline__ void p0_tr_item(const float* W, int N, int K, bf16* WT, int n0s, int n0d, int k0, LAS float* scr, int lane) {
    const int kr = lane >> 4, c4 = lane & 15;
    const float* Wb = uni(W + (size_t)k0 * N + n0s); const unsigned lo = (unsigned)(kr * N + 4 * c4);
    f32x4 w[16];
#pragma unroll
    for (int i = 0; i < 16; ++i) w[i] = LDNT((const f32x4*)(Wb + lo + (unsigned)(4 * i * N)));
#pragma unroll
    for (int i = 0; i < 16; ++i) { const int k = 4 * i + kr;
        scr[(4 * c4 + 0) * 65 + k] = w[i][0]; scr[(4 * c4 + 1) * 65 + k] = w[i][1]; scr[(4 * c4 + 2) * 65 + k] = w[i][2]; scr[(4 * c4 + 3) * 65 + k] = w[i][3]; }
    LDS_WAIT(); asm volatile("" ::: "memory");
    bf16* ob = uni(WT + (size_t)n0d * K + k0); const int nr = lane >> 3, cch = lane & 7;
#pragma unroll
    for (int i = 0; i < 8; ++i) { const int n = 8 * i + nr; const LAS float* s = scr + n * 65 + 8 * cch;
        v4u o; o.x = cvtpk(s[0], s[1]); o.y = cvtpk(s[2], s[3]); o.z = cvtpk(s[4], s[5]); o.w = cvtpk(s[6], s[7]);
        *(v4u*)(ob + (unsigned)(n * K + 8 * cch)) = o; }
    LDS_WAIT(); asm volatile("" ::: "memory");
}
#ifndef P0_DEFER
#define P0_DEFER 1
#endif
constexpr int I_IN_AB = 64 * 281, I_Q = 16 * 96, I_KV = 8 * 128, I_O = 128 * 64, I_IN_C = 64 * 640, PER_J = I_IN_AB + I_Q + I_KV + I_O + I_IN_C + I_O;
__device__ __forceinline__ void p0_item(KArgs a, int j, int r, LAS float* scr, int lane) {
    if (r < I_IN_AB) { const int kb = r / 281, nb = r % 281, n0 = nb * 64;
        p0_tr_item(GIN(a, 8) + (size_t)j * DM * N_ABSRC, N_ABSRC, DM, (bf16*)(GWS(a) + WS_WIN_AB) + (size_t)j * N_AB * DM, n0, n0 + (n0 >= 1600 ? 192 : 0), kb * 64, scr, lane); return; } r -= I_IN_AB;
    if (r < I_Q) { const int kb = r / 96, nb = r % 96;
        p0_tr_item(GIN(a, 11) + (size_t)j * QL * NQ, NQ, QL, (bf16*)(GWS(a) + WS_WQ) + (size_t)j * NQ * QL, nb * 64, nb * 64, kb * 64, scr, lane); return; } r -= I_Q;
    if (r < I_KV) { const int kb = r / 128, nb = r % 128;
        p0_tr_item(GIN(a, 12) + (size_t)j * KVL * NKV, NKV, KVL, (bf16*)(GWS(a) + WS_WKV) + (size_t)j * NKV * KVL, nb * 64, nb * 64, kb * 64, scr, lane); return; } r -= I_KV;
    if (r < I_O) { const int kb = r / 64, nb = r % 64;
        p0_tr_item(GIN(a, 17) + (size_t)j * MIXW * DM, DM, MIXW, (bf16*)(GWS(a) + WS_WO_AB) + (size_t)j * DM * MIXW, nb * 64, nb * 64, kb * 64, scr, lane); return; } r -= I_O;
    if (r < I_IN_C) { const int kb = r / 640, nb = r % 640;
        p0_tr_item(GIN(a, 18) + (size_t)j * DM * N_C, N_C, DM, (bf16*)(GWS(a) + WS_WIN_C) + (size_t)j * N_C * DM, nb * 64, nb * 64, kb * 64, scr, lane); return; } r -= I_IN_C;
    { const int kb = r / 64, nb = r % 64;
        p0_tr_item(GIN(a, 21) + (size_t)j * MIXW * DM, DM, MIXW, (bf16*)(GWS(a) + WS_WO_C) + (size_t)j * DM * MIXW, nb * 64, nb * 64, kb * 64, scr, lane); }
}
constexpr int P0_ND = I_O + PER_J;
#ifndef P0_B1
#define P0_B1 25984
#endif
#ifndef P0_B2
#define P0_B2 51936
#endif
constexpr int P0_B3 = P0_ND - I_O;
static_assert(P0_B1 >= I_O && P0_B1 <= P0_B2 && P0_B2 >= I_O + I_IN_AB && P0_B2 <= P0_B3, "deferred-slot deadlines");
__device__ __forceinline__ bool p0_defer_on(int G) { return P0_DEFER && (G % pg8::NXCD == 0); }
__device__ __forceinline__ void p0_deferred(KArgs a, LAS unsigned char* lds, const pg8::LockstepOrder& S, int slot) {
    const int lenmax = S.PG * pg8::LockstepOrder::LW * S.nN + S.qR + (S.rR > 0 ? 1 : 0), R = (lenmax + S.nk - 1) / S.nk, kcut = lenmax - (R - 1) * S.nk;
    const bool all = kcut >= S.nk;
    if (!all && S.k < kcut) return;
    int tid_l = threadIdx.x; asm volatile("" : "+v"(tid_l)); const int lane = tid_l & 63, wave = __builtin_amdgcn_readfirstlane(tid_l >> 6);
    const int rank = all ? S.c : (S.k - kcut) * pg8::NXCD + S.x, nw = (all ? S.G : pg8::NXCD * (S.nk - kcut)) * NWAVES;
    __syncthreads();
    LAS float* scr = (LAS float*)(lds + wave * 16640);
    const int lo_ = slot == 0 ? 0 : slot == 1 ? P0_B1 : slot == 2 ? P0_B2 : P0_B3, hi_ = slot == 0 ? P0_B1 : slot == 1 ? P0_B2 : slot == 2 ? P0_B3 : P0_ND;
    for (int d = lo_ + rank * NWAVES + wave; d < hi_; d += nw) {
        const int j = d < I_O ? 0 : 1, r = d < I_O ? PER_J - I_O + d : d - I_O; p0_item(a, j, r, scr, lane); }
    __syncthreads();
}
__device__ __forceinline__ void p0_prologue(KArgs a, LAS unsigned char* lds, int G) {
    int tid_l = threadIdx.x; asm volatile("" : "+v"(tid_l)); const int tid = tid_l, lane = tid & 63, wave = __builtin_amdgcn_readfirstlane(tid >> 6);
    __syncthreads();
    p0_gemv(a, lds, G);
    __syncthreads();
    LAS float* scr = (LAS float*)(lds + wave * 16640);
    const int gw = blockIdx.x * NWAVES + wave, NGW = G * NWAVES;
    const bool defer = p0_defer_on(G);
    const int NIT = defer ? PER_J - I_O : 2 * PER_J;
    for (int it = gw; it < NIT; it += NGW) {
        const int j = defer ? (it < PER_J - I_O ? 0 : 1) : it / PER_J, r = defer ? (it < PER_J - I_O ? it : it - (PER_J - I_O)) : it % PER_J;
        p0_item(a, j, r, scr, lane);
    }
    const size_t gt = (size_t)blockIdx.x * 512 + tid, NGT = (size_t)G * 512;
    for (size_t i = gt; i < (size_t)2 * 192 * DM / 8; i += NGT) { const size_t j = i / (192 * DM / 8), e = i % (192 * DM / 8);
        *(v4u*)((bf16*)(GWS(a) + WS_WIN_AB) + j * (size_t)N_AB * DM + (size_t)1600 * DM + e * 8) = (v4u){0u, 0u, 0u, 0u}; }
    { const float* lg = GIN(a, 19); float* oml = (float*)(GWS(a) + WS_OML);
      for (size_t i = gt; i < (size_t)2 * 2 * 8192; i += NGT) { const int jc = (int)(i >> 14), de = (int)(i & 16383);
          const float l0 = lg[0 * 16384 + de], l1 = lg[1 * 16384 + de], l2 = lg[2 * 16384 + de], l3 = lg[3 * 16384 + de];
          const float mx = fmaxf(fmaxf(l0, l1), fmaxf(l2, l3)); const float e0 = __expf(l0 - mx), e1 = __expf(l1 - mx), e2 = __expf(l2 - mx), e3 = __expf(l3 - mx);
          const float inv = 1.0f / (e0 + e1 + e2 + e3); const float lb = (jc == 0) ? e1 * inv : (e1 + e2 + e3) * inv;
          oml[i] = 1.0f - lb; } }
    { f32x2* rope = (f32x2*)(GWS(a) + WS_ROPE);
      for (size_t i = gt; i < 128 * 16; i += NGT) { const int pos = (int)(i >> 4), f = (int)(i & 15); const float inv = powf(10000.0f, -(float)f / 16.0f); const float ang = (float)pos * inv;
          rope[i] = (f32x2){cosf(ang), sinf(ang)}; } }
}

__device__ __forceinline__ void norm_phase(KArgs a, int lpost, int lpre, int G) {
    int tid_l = threadIdx.x; asm volatile("" : "+v"(tid_l)); const int tid = tid_l, lane = tid & 63, wave = __builtin_amdgcn_readfirstlane(tid >> 6);
    const int gw = blockIdx.x * NWAVES + wave, NGW = G * NWAVES;
    const float* mod = (const float*)(GWS(a) + WS_MOD);
    float* XS = (float*)(GWS(a) + WS_XS); const float* Y = (const float*)(GWS(a) + WS_Y); bf16* H = (bf16*)(GWS(a) + WS_H);
    const int nrows = (lpost == 3) ? MLAT : MTOT;
    for (int row = gw; row < nrows; row += NGW) {
        const int rt = row < SEQ ? 0 : (row < MLAT ? 1 : 2);
        const float* xin = uni((lpost <= 0) ? (row < MLAT ? GIN(a, 0) + (size_t)row * DM : GIN(a, 2) + (size_t)(row - MLAT) * DM) : XS + (size_t)row * DM);
        f32x4 xv[16];
#pragma unroll
        for (int j = 0; j < 16; ++j) xv[j] = LDNT((const f32x4*)(xin + lane * 4 + 256 * j));
        if (lpost >= 0) {
            f32x4 yv[16]; float ss = 0.f;
            if (row < MLAT) { const bf16* yr = uni((const bf16*)Y + (size_t)row * DM);
#pragma unroll
                for (int j = 0; j < 16; ++j) { const u32x2 w = LDNT((const u32x2*)(yr + lane * 4 + 256 * j)); yv[j] = (f32x4){bf_lo(w.x), bf_hi(w.x), bf_lo(w.y), bf_hi(w.y)}; } }
            else {
                const float* yr = uni((const float*)(GWS(a) + WS_YP) + (size_t)(row - MLAT) * DM);
#pragma unroll
                for (int j = 0; j < 16; ++j) yv[j] = *(const f32x4*)(yr + lane * 4 + 256 * j);
                for (int kc = 1; kc < 8; ++kc) { const float* yk = uni(yr + (size_t)kc * (MTOT - MLAT) * DM);
#pragma unroll
                    for (int j = 0; j < 16; ++j) { yv[j] = yv[j] + *(const f32x4*)(yk + lane * 4 + 256 * j); if ((j & 3) == 3) asm volatile("" ::: "memory"); } } }
#pragma unroll
            for (int j = 0; j < 16; ++j) ss += (yv[j][0] * yv[j][0] + yv[j][1] * yv[j][1]) + (yv[j][2] * yv[j][2] + yv[j][3] * yv[j][3]);
            const float r = 1.0f / sqrtf(wave_sum(ss) * (1.0f / DM) + EPS);
            const float* gate = uni(mod + (size_t)(lpost * 3 + rt) * 12288 + 8192); const float* pw = uni(GIN(a, 7) + (size_t)lpost * DM);
            float* xout = uni((lpost == 3) ? GOUT(a) + (size_t)row * DM : XS + (size_t)row * DM);
#pragma unroll
            for (int j = 0; j < 16; ++j) { const int col = lane * 4 + 256 * j; const f32x4 g = *(const f32x4*)(gate + col), w = *(const f32x4*)(pw + col);
                xv[j] = xv[j] + g * ((yv[j] * r) * w); STNT((f32x4*)(xout + col), xv[j]);
                if ((j & 3) == 3) asm volatile("" ::: "memory"); }
        }
        if (lpre < 4) {
            float ss = 0.f;
#pragma unroll
            for (int j = 0; j < 16; ++j) ss += (xv[j][0] * xv[j][0] + xv[j][1] * xv[j][1]) + (xv[j][2] * xv[j][2] + xv[j][3] * xv[j][3]);
            const float r = 1.0f / sqrtf(wave_sum(ss) * (1.0f / DM) + EPS);
            const float* shift = uni(mod + (size_t)(lpre * 3 + rt) * 12288); const float* scale = shift + 4096; const float* pw = uni(GIN(a, 6) + (size_t)lpre * DM);
            bf16* hr = uni(H + (size_t)row * DM);
#pragma unroll
            for (int j = 0; j < 16; ++j) { const int col = lane * 4 + 256 * j; const f32x4 sh = *(const f32x4*)(shift + col), sc = *(const f32x4*)(scale + col), w = *(const f32x4*)(pw + col);
                const f32x4 h = ((xv[j] * r) * w) * (sc + 1.0f) + sh; u32x2 o; o.x = cvtpk(h[0], h[1]); o.y = cvtpk(h[2], h[3]); *(u32x2*)(hr + col) = o;
                if ((j & 3) == 3) asm volatile("" ::: "memory"); }
        }
    }
}

__device__ __forceinline__ void a2_rows(KArgs a, int j, int G) {
    int tid_l = threadIdx.x; asm volatile("" : "+v"(tid_l)); const int tid = tid_l, lane = tid & 63, wave = __builtin_amdgcn_readfirstlane(tid >> 6);
    const int gw = blockIdx.x * NWAVES + wave, NGW = G * NWAVES;
    const bf16* G1 = (const bf16*)(GWS(a) + WS_G1); bf16* QN = (bf16*)(GWS(a) + WS_QN); bf16* KVN = (bf16*)(GWS(a) + WS_KVN); bf16* KR = (bf16*)(GWS(a) + WS_KR);
    f32x2* stat = (f32x2*)(GWS(a) + WS_STAT); const f32x2* rope = (const f32x2*)(GWS(a) + WS_ROPE);
    const float* qw = GIN(a, 9) + (size_t)j * QL; const float* kvw = GIN(a, 10) + (size_t)j * KVL;
    for (int row = gw; row < MTOT; row += NGW) {
        const bf16* g = uni(G1 + (size_t)row * N_AB);
        {
            v4u w[2]; float x[16]; float ss = 0.f;
#pragma unroll
            for (int i = 0; i < 2; ++i) { w[i] = LDNT((const v4u*)(g + lane * 8 + 512 * i));
#pragma unroll
                for (int e = 0; e < 4; ++e) { x[8 * i + 2 * e] = bf_lo(w[i][e]); x[8 * i + 2 * e + 1] = bf_hi(w[i][e]); } }
#pragma unroll
            for (int e = 0; e < 16; ++e) ss += x[e] * x[e];
            const float r = 1.0f / sqrtf(wave_sum(ss) * (1.0f / QL) + EPS);
#pragma unroll
            for (int i = 0; i < 2; ++i) { const int col = lane * 8 + 512 * i; const f32x4 w0 = *(const f32x4*)(qw + col), w1 = *(const f32x4*)(qw + col + 4);
                v4u o; o.x = cvtpk(x[8 * i + 0] * r * w0[0], x[8 * i + 1] * r * w0[1]); o.y = cvtpk(x[8 * i + 2] * r * w0[2], x[8 * i + 3] * r * w0[3]);
                o.z = cvtpk(x[8 * i + 4] * r * w1[0], x[8 * i + 5] * r * w1[1]); o.w = cvtpk(x[8 * i + 6] * r * w1[2], x[8 * i + 7] * r * w1[3]);
                *(v4u*)(QN + (size_t)row * QL + col) = o; }
        }
        {
            const v4u w = LDNT((const v4u*)(g + G1_CKV + lane * 8)); float x[8]; float ss = 0.f;
#pragma unroll
            for (int e = 0; e < 4; ++e) { x[2 * e] = bf_lo(w[e]); x[2 * e + 1] = bf_hi(w[e]); }
#pragma unroll
            for (int e = 0; e < 8; ++e) ss += x[e] * x[e];
            const float r = 1.0f / sqrtf(wave_sum(ss) * (1.0f / KVL) + EPS);
            const int col = lane * 8; const f32x4 w0 = *(const f32x4*)(kvw + col), w1 = *(const f32x4*)(kvw + col + 4);
            v4u o; o.x = cvtpk(x[0] * r * w0[0], x[1] * r * w0[1]); o.y = cvtpk(x[2] * r * w0[2], x[3] * r * w0[3]); o.z = cvtpk(x[4] * r * w1[0], x[5] * r * w1[1]); o.w = cvtpk(x[6] * r * w1[2], x[7] * r * w1[3]);
            *(v4u*)(KVN + (size_t)row * KVL + col) = o;
        }
        {
            const float x = __uint_as_float((unsigned)g[G1_KR + lane] << 16); const float xp = __shfl_xor(x, 16); float o = x;
            if (row < MLAT) { const int t = row & (SEQ - 1), ax = lane >> 5, hh = (lane >> 4) & 1, f = lane & 15, pos = ax == 0 ? (t >> 6) : (t & 63); const f32x2 cs = rope[pos * 16 + f];
                o = hh == 0 ? x * cs.x - xp * cs.y : x * cs.x + xp * cs.y; }
            KR[(size_t)row * 64 + lane] = (bf16)(cvtpk(o, 0.f) & 0xffffu);
        }
        {
            float x[64]; float s = 0.f;
#pragma unroll
            for (int i = 0; i < 8; ++i) { const v4u w = *(const v4u*)(g + G1_VB + lane * 8 + 512 * i);
#pragma unroll
                for (int e = 0; e < 4; ++e) { x[8 * i + 2 * e] = bf_lo(w[e]); x[8 * i + 2 * e + 1] = bf_hi(w[e]); } }
#pragma unroll
            for (int e = 0; e < 64; ++e) s += x[e];
            const float mean = wave_sum(s) * (1.0f / 4096.0f); float q = 0.f;
#pragma unroll
            for (int e = 0; e < 64; ++e) { const float d = x[e] - mean; q += d * d; }
            const float rstd = 1.0f / sqrtf(wave_sum(q) * (1.0f / 4096.0f) + EPS);
            if (lane == 0) stat[row] = (f32x2){mean, rstd};
        }
    }
}

typedef short s16x4 __attribute__((ext_vector_type(4)));
typedef float f32x16 __attribute__((ext_vector_type(16)));
#define SBAR() __builtin_amdgcn_sched_barrier(0)
__device__ __forceinline__ f32x4 mfma16(bf16x8 a, bf16x8 b, f32x4 c) { return __builtin_amdgcn_mfma_f32_16x16x32_bf16(a, b, c, 0, 0, 0); }
__device__ __forceinline__ int crow(int r, int hi) { return (r & 3) + 8 * (r >> 2) + 4 * hi; }
__device__ __forceinline__ int v_st(int k, int c) { const int kk = (k & ~0xC) | ((k & 4) << 1) | ((k & 8) >> 1); return ((kk >> 3) * 4 + (c >> 5)) * 512 + ((kk & 7) * 32 + (c & 31)) * 2; }
__device__ __forceinline__ int v_rd_base(int lane) { return ((lane & 3) << 3) | (((lane >> 2) & 3) << 6) | (((lane >> 4) & 1) << 5) | (((lane >> 5) & 1) << 8); }
constexpr int v_rd_off(int d0, int ks, int half) { return d0 * 512 + ks * 4096 + half * 2048; }
template <int OFF> __device__ __forceinline__ s16x4 tr_read(int vb) {
    s16x4 r; asm volatile("ds_read_b64_tr_b16 %0, %1 offset:%2" : "=&v"(r) : "v"(vb), "i"(OFF) : "memory"); return r;
}
template <int D0> __device__ __forceinline__ void pv_one(f32x16& od, int vb, bf16x8 pa0, bf16x8 pa1, bf16x8 pa2, bf16x8 pa3) {
    const s16x4 l0 = tr_read<v_rd_off(D0, 0, 0)>(vb), h0 = tr_read<v_rd_off(D0, 0, 1)>(vb), l1 = tr_read<v_rd_off(D0, 1, 0)>(vb), h1 = tr_read<v_rd_off(D0, 1, 1)>(vb);
    const s16x4 l2 = tr_read<v_rd_off(D0, 2, 0)>(vb), h2 = tr_read<v_rd_off(D0, 2, 1)>(vb), l3 = tr_read<v_rd_off(D0, 3, 0)>(vb), h3 = tr_read<v_rd_off(D0, 3, 1)>(vb);
    asm volatile("s_waitcnt lgkmcnt(0)" ::: "memory"); SBAR();
#define PKV(L, H) (bf16x8){L[0], L[1], L[2], L[3], H[0], H[1], H[2], H[3]}
    od = __builtin_amdgcn_mfma_f32_32x32x16_bf16(pa0, PKV(l0, h0), od, 0, 0, 0);
    od = __builtin_amdgcn_mfma_f32_32x32x16_bf16(pa1, PKV(l1, h1), od, 0, 0, 0);
    od = __builtin_amdgcn_mfma_f32_32x32x16_bf16(pa2, PKV(l2, h2), od, 0, 0, 0);
    od = __builtin_amdgcn_mfma_f32_32x32x16_bf16(pa3, PKV(l3, h3), od, 0, 0, 0);
#undef PKV
}
__device__ __forceinline__ void pv_d0(f32x16* o, int vb, bf16x8 pa0, bf16x8 pa1, bf16x8 pa2, bf16x8 pa3) {
    pv_one<0>(o[0], vb, pa0, pa1, pa2, pa3); pv_one<1>(o[1], vb, pa0, pa1, pa2, pa3); pv_one<2>(o[2], vb, pa0, pa1, pa2, pa3); pv_one<3>(o[3], vb, pa0, pa1, pa2, pa3);
}

template <int I> __device__ __forceinline__ void pv_rd(int vb, s16x4& l0, s16x4& h0, s16x4& l1, s16x4& h1) {
    l0 = tr_read<v_rd_off(I >> 1, 2 * (I & 1), 0)>(vb); h0 = tr_read<v_rd_off(I >> 1, 2 * (I & 1), 1)>(vb); l1 = tr_read<v_rd_off(I >> 1, 2 * (I & 1) + 1, 0)>(vb); h1 = tr_read<v_rd_off(I >> 1, 2 * (I & 1) + 1, 1)>(vb);
}
#define PKV2(L, H) (bf16x8){L[0], L[1], L[2], L[3], H[0], H[1], H[2], H[3]}
#define PV_MM(I, A0, A1, L0, H0, L1, H1) do { o[(I) >> 1] = __builtin_amdgcn_mfma_f32_32x32x16_bf16(A0, PKV2(L0, H0), o[(I) >> 1], 0, 0, 0); o[(I) >> 1] = __builtin_amdgcn_mfma_f32_32x32x16_bf16(A1, PKV2(L1, H1), o[(I) >> 1], 0, 0, 0); } while (0)
#define PV_WAIT4() do { asm volatile("s_waitcnt lgkmcnt(4)" ::: "memory"); SBAR(); } while (0)
#define PV_WAIT0() do { asm volatile("s_waitcnt lgkmcnt(0)" ::: "memory"); SBAR(); } while (0)
__device__ __forceinline__ void pv_pipe(f32x16* o, int vb, bf16x8 pa0, bf16x8 pa1, bf16x8 pa2, bf16x8 pa3) {
    s16x4 al0, ah0, al1, ah1, bl0, bh0, bl1, bh1;
    asm volatile("s_waitcnt lgkmcnt(0)" ::: "memory"); SBAR();
    pv_rd<0>(vb, al0, ah0, al1, ah1); pv_rd<1>(vb, bl0, bh0, bl1, bh1);
    PV_WAIT4(); PV_MM(0, pa0, pa1, al0, ah0, al1, ah1); SBAR(); pv_rd<2>(vb, al0, ah0, al1, ah1);
    PV_WAIT4(); PV_MM(1, pa2, pa3, bl0, bh0, bl1, bh1); SBAR(); pv_rd<3>(vb, bl0, bh0, bl1, bh1);
    PV_WAIT4(); PV_MM(2, pa0, pa1, al0, ah0, al1, ah1); SBAR(); pv_rd<4>(vb, al0, ah0, al1, ah1);
    PV_WAIT4(); PV_MM(3, pa2, pa3, bl0, bh0, bl1, bh1); SBAR(); pv_rd<5>(vb, bl0, bh0, bl1, bh1);
    PV_WAIT4(); PV_MM(4, pa0, pa1, al0, ah0, al1, ah1); SBAR(); pv_rd<6>(vb, al0, ah0, al1, ah1);
    PV_WAIT4(); PV_MM(5, pa2, pa3, bl0, bh0, bl1, bh1); SBAR(); pv_rd<7>(vb, bl0, bh0, bl1, bh1);
    PV_WAIT4(); PV_MM(6, pa0, pa1, al0, ah0, al1, ah1);
    PV_WAIT0(); PV_MM(7, pa2, pa3, bl0, bh0, bl1, bh1);
}

__device__ __forceinline__ void pv_seq(f32x16* o, int vb, bf16x8 pa0, bf16x8 pa1, bf16x8 pa2, bf16x8 pa3) {
    s16x4 al0, ah0, al1, ah1;
    pv_rd<0>(vb, al0, ah0, al1, ah1); PV_WAIT0(); PV_MM(0, pa0, pa1, al0, ah0, al1, ah1); SBAR();
    pv_rd<1>(vb, al0, ah0, al1, ah1); PV_WAIT0(); PV_MM(1, pa2, pa3, al0, ah0, al1, ah1); SBAR();
    pv_rd<2>(vb, al0, ah0, al1, ah1); PV_WAIT0(); PV_MM(2, pa0, pa1, al0, ah0, al1, ah1); SBAR();
    pv_rd<3>(vb, al0, ah0, al1, ah1); PV_WAIT0(); PV_MM(3, pa2, pa3, al0, ah0, al1, ah1); SBAR();
    pv_rd<4>(vb, al0, ah0, al1, ah1); PV_WAIT0(); PV_MM(4, pa0, pa1, al0, ah0, al1, ah1); SBAR();
    pv_rd<5>(vb, al0, ah0, al1, ah1); PV_WAIT0(); PV_MM(5, pa2, pa3, al0, ah0, al1, ah1); SBAR();
    pv_rd<6>(vb, al0, ah0, al1, ah1); PV_WAIT0(); PV_MM(6, pa0, pa1, al0, ah0, al1, ah1); SBAR();
    pv_rd<7>(vb, al0, ah0, al1, ah1); PV_WAIT0(); PV_MM(7, pa2, pa3, al0, ah0, al1, ah1);
}

__device__ __forceinline__ void sgu_phase(KArgs a, int j, LAS unsigned char* lds, int G) {
    int tid_l = threadIdx.x; asm volatile("" : "+v"(tid_l)); const int tid = tid_l, lane = tid & 63, wid = __builtin_amdgcn_readfirstlane(tid >> 6), r32 = lane & 31, hi = lane >> 5;
    const bf16* G1 = (const bf16*)(GWS(a) + WS_G1); bf16* CC = (bf16*)(GWS(a) + WS_CC); const f32x2* stat = (const f32x2*)(GWS(a) + WS_STAT);
    const float* lnw = GIN(a, 13) + (size_t)j * 4096; const float* lnb = GIN(a, 14) + (size_t)j * 4096; const float* ws_all = GIN(a, 15) + (size_t)j * 16 * 128 * 128; const float* bs = GIN(a, 16) + (size_t)j * 16 * 128;
    constexpr int MXP = 272, OFF_ST = 69632;
    LAS float* st_mean = (LAS float*)(lds + OFF_ST); LAS float* st_rstd = st_mean + 128;
    LAS float* m1s = (LAS float*)(lds + OFF_ST + 1024) + wid * 64; LAS float* rss = m1s + 32;
    LAS unsigned char* mx = lds + wid * (32 * MXP);
    const int sr = tid >> 4, sc = (tid & 15) * 8, vst0 = v_st(sr, sc), vst1 = v_st(32 + sr, sc);
    const int tb = wid >> 1, ch = wid & 1;
    const int vb0 = (int)(unsigned)(unsigned long long)lds + v_rd_base(lane);
    v4u vx[8];
#define SGU_LOADV(it_) do { const int ch_ = (it_) >> 4, g_ = (it_) & 15; const bf16* s0_ = uni(G1 + (size_t)(ch_ * 128) * N_AB + G1_VB + g_ * 256); const unsigned lo_ = (unsigned)(sr * N_AB + sc); \
    _Pragma("unroll") for (int st = 0; st < 2; ++st) _Pragma("unroll") for (int c2 = 0; c2 < 2; ++c2) { const unsigned o_ = lo_ + (unsigned)(64 * st * N_AB + c2 * 128); \
        vx[(st * 2 + c2) * 2] = LDNT((const v4u*)(s0_ + o_)); vx[(st * 2 + c2) * 2 + 1] = LDNT((const v4u*)(s0_ + o_ + 32 * N_AB)); } } while (0)
    const int item0 = (int)((blockIdx.x + 128u) % (unsigned)G);
    if (item0 < 132 * 16) SGU_LOADV(item0);
    for (int item = item0; item < 132 * 16; item += G) {
        const int chunk = item >> 4, g = item & 15, row0 = chunk * 128;
        __syncthreads();
#pragma unroll
        for (int q = 0; q < 4; ++q) { *(LAS v4u*)(lds + q * 16384 + vst0) = vx[2 * q]; *(LAS v4u*)(lds + q * 16384 + vst1) = vx[2 * q + 1]; }
        if (tid < 128) { const f32x2 s = stat[row0 + tid]; st_mean[tid] = s.x; st_rstd[tid] = s.y; }
        __syncthreads();
        if (item + G < 132 * 16) SGU_LOADV(item + G);
        const float* wrow = ws_all + ((size_t)g * 128 + 32 * tb + r32) * 128;
        bf16x8 pa[2][4]; float m1 = 0.f, rs = 0.f;
#pragma unroll
        for (int st = 0; st < 2; ++st)
#pragma unroll
            for (int ks = 0; ks < 4; ++ks) { const int s0 = 64 * st + 16 * ks + 8 * hi; const f32x4 w0 = *(const f32x4*)(wrow + s0), w1 = *(const f32x4*)(wrow + s0 + 4);
                const f32x4 r0 = *(const LAS f32x4*)(st_rstd + s0), r1 = *(const LAS f32x4*)(st_rstd + s0 + 4), mu0 = *(const LAS f32x4*)(st_mean + s0), mu1 = *(const LAS f32x4*)(st_mean + s0 + 4);
                rs += (w0[0] + w0[1]) + (w0[2] + w0[3]) + (w1[0] + w1[1]) + (w1[2] + w1[3]);
                v4u p; p.x = cvtpk(w0[0] * r0[0], w0[1] * r0[1]); p.y = cvtpk(w0[2] * r0[2], w0[3] * r0[3]); p.z = cvtpk(w1[0] * r1[0], w1[1] * r1[1]); p.w = cvtpk(w1[2] * r1[2], w1[3] * r1[3]);
                m1 += bf_lo(p.x) * mu0[0] + bf_hi(p.x) * mu0[1] + bf_lo(p.y) * mu0[2] + bf_hi(p.y) * mu0[3] + bf_lo(p.z) * mu1[0] + bf_hi(p.z) * mu1[1] + bf_lo(p.w) * mu1[2] + bf_hi(p.w) * mu1[3];
                pa[st][ks] = __builtin_bit_cast(bf16x8, p); }
        m1 += __shfl_xor(m1, 32); rs += __shfl_xor(rs, 32);
        if (hi == 0) { m1s[r32] = m1; rss[r32] = rs; }
        f32x16 o[4];
#pragma unroll
        for (int d = 0; d < 4; ++d)
#pragma unroll
            for (int r = 0; r < 16; ++r) o[d][r] = 0.f;
#pragma unroll
        for (int st = 0; st < 2; ++st) pv_d0(o, vb0 + (st * 2 + ch) * 16384, pa[st][0], pa[st][1], pa[st][2], pa[st][3]);
        asm volatile("s_waitcnt lgkmcnt(0)" ::: "memory");
        __syncthreads();
        { const int cb = g * 256 + ch * 128;
          const float* lw = uni(lnw + cb); const float* lb = uni(lnb + cb); const float* bsg = uni(bs + g * 128 + 32 * tb);
          int r32e = r32, hie = hi; asm volatile("" : "+v"(r32e), "+v"(hie));
          float lwv[4], lbv[4];
#pragma unroll
          for (int d0 = 0; d0 < 4; ++d0) { lwv[d0] = lw[d0 * 32 + r32e]; lbv[d0] = lb[d0 * 32 + r32e]; }
#pragma unroll
          for (int r = 0; r < 16; ++r) { const int rr = crow(r, hie); const float m1t = m1s[rr], rst = rss[rr], bst = bsg[rr];
#pragma unroll
            for (int d0 = 0; d0 < 4; ++d0) { const float mix = lwv[d0] * (o[d0][r] - m1t) + lbv[d0] * rst + bst;
                *(LAS bf16*)(mx + rr * MXP + (d0 * 32 + r32e) * 2) = (bf16)(cvtpk(mix, 0.f) & 0xffffu); } } }
        asm volatile("s_waitcnt lgkmcnt(0)" ::: "memory");
        { const int cb = g * 256 + ch * 128;
          const bf16* Gu = uni(G1 + (size_t)(row0 + 32 * tb) * N_AB + G1_UB + cb); const bf16* Gzb = uni(G1 + (size_t)(row0 + 32 * tb) * N_AB + G1_ZB + cb); bf16* Co = uni(CC + (size_t)(row0 + 32 * tb) * MIXW + 4096 + cb);
          int le = lane; asm volatile("" : "+v"(le));
#pragma unroll
          for (int i = 0; i < 8; ++i) { const int id = 64 * i + le, row = id >> 4, c8 = (id & 15) * 8;
              const v4u mq = *(const LAS v4u*)(mx + row * MXP + c8 * 2); const v4u uq = LDNT((const v4u*)(Gu + (unsigned)(row * N_AB + c8))), zq = LDNT((const v4u*)(Gzb + (unsigned)(row * N_AB + c8)));
              v4u oq;
#pragma unroll
              for (int e = 0; e < 4; ++e) oq[e] = cvtpk(bf_lo(uq[e]) * bf_lo(mq[e]) * bf_lo(zq[e]), bf_hi(uq[e]) * bf_hi(mq[e]) * bf_hi(zq[e]));
              *(v4u*)(Co + (unsigned)(row * MIXW + c8)) = oq;
              if ((i & 3) == 3) asm volatile("" ::: "memory"); } }
    }
#undef SGU_LOADV
    __syncthreads();
}

namespace att {
constexpr int QBLK = 32, KVBLK = 64;
constexpr float SCALE = 0.07216878364870322f;
constexpr float THR = 8.f;
constexpr int SHM_V = KVBLK * 128 * 2, SHM_K = KVBLK * 192 * 2;
#ifndef STG_SEL
#define STG_SEL 0
#endif
#ifndef ATT_STAGGER
#define ATT_STAGGER 1
#endif
constexpr int NVB = ATT_STAGGER ? 3 : 2;
constexpr int OFF_V = 0, OFF_K = NVB * SHM_V, OFF_WS = OFF_K + 2 * SHM_K, ATT_LDS = OFF_WS + NWAVES * 64 * 4;
#ifndef ATT_QR_LDS
#define ATT_QR_LDS 1
#endif
#ifndef ATT_SDEPTH
#define ATT_SDEPTH 1
#endif
constexpr int SDEPTH = ATT_SDEPTH;
constexpr float THRL = THR * 1.4426950408889634f;
__device__ __forceinline__ void partialSM_first(f32x16& p0, f32x16& p1, float& m_reg, float& alpha) {
    float pmax = p0[0];
#pragma unroll
    for (int r = 1; r < 16; ++r) pmax = fmaxf(pmax, p0[r]);
#pragma unroll
    for (int r = 0; r < 16; ++r) pmax = fmaxf(pmax, p1[r]);
    { auto rr = __builtin_amdgcn_permlane32_swap(__float_as_uint(pmax), __float_as_uint(pmax), false, false);
      pmax = fmaxf(__uint_as_float(rr[0]), __uint_as_float(rr[1])); }
    m_reg = pmax; alpha = 1.f;
#pragma unroll
    for (int r = 0; r < 16; ++r) p0[r] = p0[r] - pmax;
#pragma unroll
    for (int r = 0; r < 16; ++r) p1[r] = p1[r] - pmax;
#pragma unroll
    for (int r = 0; r < 16; ++r) p0[r] = __builtin_amdgcn_exp2f(p0[r]);
}
__device__ __forceinline__ void partialSM(f32x16& p0, f32x16& p1, float& m_reg, float& alpha) {
    float pmax = p0[0];
#pragma unroll
    for (int r = 1; r < 16; ++r) pmax = fmaxf(pmax, p0[r]);
#pragma unroll
    for (int r = 0; r < 16; ++r) pmax = fmaxf(pmax, p1[r]);
    { auto rr = __builtin_amdgcn_permlane32_swap(__float_as_uint(pmax), __float_as_uint(pmax), false, false);
      pmax = fmaxf(__uint_as_float(rr[0]), __uint_as_float(rr[1])); }
    if (__builtin_expect(__all(pmax <= THRL), 1)) { alpha = 1.f; }
    else { const float d = fmaxf(pmax, 0.f); alpha = __builtin_amdgcn_exp2f(-d); m_reg += d;
#pragma unroll
        for (int r = 0; r < 16; ++r) p0[r] = p0[r] - d;
#pragma unroll
        for (int r = 0; r < 16; ++r) p1[r] = p1[r] - d; }
#pragma unroll
    for (int r = 0; r < 16; ++r) p0[r] = __builtin_amdgcn_exp2f(p0[r]);
}
__device__ __forceinline__ void finishSM(f32x16& p0, f32x16& p1, float alpha, float& l_reg, bf16x8& pa0, bf16x8& pa1, bf16x8& pa2, bf16x8& pa3) {
#pragma unroll
    for (int r = 0; r < 16; ++r) p1[r] = __builtin_amdgcn_exp2f(p1[r]);
    float ps = 0;
#pragma unroll
    for (int r = 0; r < 16; ++r) ps += p0[r];
#pragma unroll
    for (int r = 0; r < 16; ++r) ps += p1[r];
    { auto rr = __builtin_amdgcn_permlane32_swap(__float_as_uint(ps), __float_as_uint(ps), false, false);
      ps = __uint_as_float(rr[0]) + __uint_as_float(rr[1]); }
    l_reg = l_reg * alpha + ps;
#define PK4(P, BASE, OUT) do { unsigned a0 = cvtpk(P[BASE + 0], P[BASE + 1]), a1 = cvtpk(P[BASE + 2], P[BASE + 3]);   \
    unsigned b0 = cvtpk(P[BASE + 4], P[BASE + 5]), b1 = cvtpk(P[BASE + 6], P[BASE + 7]);                              \
    auto r0 = __builtin_amdgcn_permlane32_swap(a0, b0, false, false); auto r1 = __builtin_amdgcn_permlane32_swap(a1, b1, false, false); \
    v4u w = {r0[0], r1[0], r0[1], r1[1]}; OUT = __builtin_bit_cast(bf16x8, w); } while (0)
    PK4(p0, 0, pa0); PK4(p0, 8, pa1); PK4(p1, 0, pa2); PK4(p1, 8, pa3);
#undef PK4
}
constexpr int OFF_KR = 16384;
constexpr int OFF_QR = ATT_LDS, ATT_LDS2 = OFF_QR + NWAVES * 4096;
__device__ __forceinline__ void qkt(f32x16& p0, f32x16& p1, const LAS unsigned char* Ks, const bf16x8* qr, const LAS unsigned char* qrl, int r32, int hi, float seed) {
#pragma unroll
    for (int r = 0; r < 16; ++r) { p0[r] = seed; p1[r] = seed; }
    const int swn = (r32 & 15) << 4, swr = ((r32 >> 1) & 7) << 4;
#pragma unroll
    for (int d0 = 0; d0 < 8; ++d0) { const int cb = (d0 * 16 + hi * 8) * 2;
        const bf16x8 b0 = *(const LAS bf16x8*)(Ks + r32 * 256 + (cb ^ swn));
        const bf16x8 b1 = *(const LAS bf16x8*)(Ks + (32 + r32) * 256 + (cb ^ swn));
        p0 = __builtin_amdgcn_mfma_f32_32x32x16_bf16(b0, qr[d0], p0, 0, 0, 0);
        p1 = __builtin_amdgcn_mfma_f32_32x32x16_bf16(b1, qr[d0], p1, 0, 0, 0); }
#pragma unroll
    for (int d0 = 0; d0 < 4; ++d0) { const int cb = (d0 * 16 + hi * 8) * 2;
        const bf16x8 b0 = *(const LAS bf16x8*)(Ks + OFF_KR + r32 * 128 + (cb ^ swr));
        const bf16x8 b1 = *(const LAS bf16x8*)(Ks + OFF_KR + (32 + r32) * 128 + (cb ^ swr));
#if ATT_QR_LDS
        const bf16x8 q = *(const LAS bf16x8*)(qrl + d0 * 1024);
#else
        const bf16x8 q = qr[8 + d0];
#endif
        p0 = __builtin_amdgcn_mfma_f32_32x32x16_bf16(b0, q, p0, 0, 0, 0);
        p1 = __builtin_amdgcn_mfma_f32_32x32x16_bf16(b1, q, p1, 0, 0, 0); }
}
__device__ __forceinline__ void attn_unit(const bf16* __restrict__ Q, const bf16* __restrict__ KN, const bf16* __restrict__ KR, const bf16* __restrict__ V, const bf16* __restrict__ G1, bf16* __restrict__ CC,
                                          int qrow0, int h, int nt_lat, int lat0, int ctx0, LAS unsigned char* lds) {
    int tid_l = threadIdx.x; asm volatile("" : "+v"(tid_l)); const int tid = tid_l, wid = __builtin_amdgcn_readfirstlane(tid >> 6), lane = tid & 63, r32 = lane & 31, hi = lane >> 5;
    LAS unsigned char* V_lds = lds + OFF_V; LAS unsigned char* K_lds = lds + OFF_K;
    LAS float* wsf = (LAS float*)(lds + OFF_WS) + wid * 64; LAS float* li_l = wsf; LAS float* al_l = wsf + 32;
    LAS unsigned char* qrl = lds + OFF_QR + wid * 4096 + lane * 16;
    float m_reg = -1e30f, l_reg = 0;
    f32x16 o[4];
#pragma unroll
    for (int d = 0; d < 4; ++d)
#pragma unroll
        for (int r = 0; r < 16; ++r) o[d][r] = 0.f;
    const unsigned ko = (unsigned)((tid >> 4) * 128 + (((tid & 15) ^ ((tid >> 4) & 15)) * 8));
    const unsigned kro = (unsigned)((tid >> 3) * 64 + (((tid & 7) ^ ((tid >> 4) & 7)) * 8));
    unsigned vo; { const int sub = tid >> 5, kk = (sub >> 2) * 8 + ((tid & 31) >> 2), col = (sub & 3) * 32 + (tid & 3) * 8, key = (kk & ~0xC) | ((kk & 4) << 1) | ((kk & 8) >> 1); vo = (unsigned)(key * 128 + col); }
    const int vb0 = (int)(unsigned)(unsigned long long)lds + OFF_V + v_rd_base(lane);
    const int NT = nt_lat + 4;
#define TROW(jt) ((jt) < nt_lat ? lat0 + 64 * (jt) : ctx0 + 64 * ((jt) - nt_lat))
#define GLDS(gp, lp) __builtin_amdgcn_global_load_lds((const unsigned*)(gp), (LAS unsigned*)(lp), 16, 0, 0)
#define GLDS_S(gbase, boff, lp) do { const char* gb_ = (const char*)(gbase); asm volatile("" : "+s"(gb_)); unsigned bo_ = (boff); asm volatile("" : "+v"(bo_)); GLDS(gb_ + bo_, lp); } while (0)
#define ISSUE_K(jt, b) do { const int R0_ = TROW(jt); const bf16* Kb_ = uni(KN + ((size_t)h * MTOT + R0_) * 128); const bf16* Rb_ = uni(KR + (size_t)R0_ * 64); \
    GLDS_S(Kb_, ko * 2u, K_lds + (b) * SHM_K + wid * 1024); GLDS_S(Kb_ + 32 * 128, ko * 2u, K_lds + (b) * SHM_K + (wid + 8) * 1024); GLDS_S(Rb_, kro * 2u, K_lds + (b) * SHM_K + OFF_KR + wid * 1024); } while (0)
#define ISSUE_V(jt, b) do { const int R0_ = TROW(jt); const bf16* Vb_ = uni(V + ((size_t)h * MTOT + R0_) * 128); \
    GLDS_S(Vb_, vo * 2u, V_lds + (b) * SHM_V + wid * 1024); GLDS_S(Vb_ + 32 * 128, vo * 2u, V_lds + (b) * SHM_V + (wid + 8) * 1024); } while (0)
#define STEP_END() asm volatile("s_waitcnt vmcnt(0) lgkmcnt(0)\n\ts_barrier" ::: "memory")
#define RESC(a_) do { if (__any((a_) < 1.f)) { if (hi == 0) al_l[r32] = (a_); asm volatile("s_waitcnt lgkmcnt(0)" ::: "memory"); \
    _Pragma("unroll") for (int d = 0; d < 4; ++d) _Pragma("unroll") for (int r = 0; r < 16; ++r) o[d][r] *= al_l[crow(r, hi)]; } } while (0)
    STEP_END();
    ISSUE_K(0, 0);
    bf16x8 qr[ATT_QR_LDS ? 8 : 12];
    { const bf16* Qw = uni(Q + (size_t)(qrow0 + wid * QBLK) * NQ + h * 192); const unsigned qo = (unsigned)(r32 * NQ + hi * 8);
#pragma unroll
      for (int d0 = 0; d0 < (ATT_QR_LDS ? 8 : 12); ++d0) qr[d0] = *(const bf16x8*)(Qw + qo + d0 * 16);
#if ATT_QR_LDS
#pragma unroll
      for (int d0 = 8; d0 < 12; ++d0) { const bf16x8 t = *(const bf16x8*)(Qw + qo + d0 * 16); *(LAS bf16x8*)(qrl + (d0 - 8) * 1024) = t; }
#endif
    }
    f32x16 pA0, pA1, pB0, pB1; float alA, alB; bf16x8 pa0, pa1, pa2, pa3;
    STEP_END();
#if !ATT_STAGGER
    ISSUE_K(1, 1); ISSUE_V(0, 0);
    qkt(pA0, pA1, K_lds, qr, qrl, r32, hi, 0.f); partialSM_first(pA0, pA1, m_reg, alA);
    STEP_END();
    for (int j = 1; j + 1 < NT; j += 2) {
        ISSUE_K(j + 1, 0); ISSUE_V(j, 1);
        SBAR(); qkt(pB0, pB1, K_lds + SHM_K, qr, qrl, r32, hi, -m_reg);
        finishSM(pA0, pA1, alA, l_reg, pa0, pa1, pa2, pa3); SBAR();
        pv_pipe(o, vb0, pa0, pa1, pa2, pa3); partialSM(pB0, pB1, m_reg, alB);
        RESC(alB); STEP_END();
        ISSUE_K(j + 2, 1); ISSUE_V(j + 1, 0);
        SBAR(); qkt(pA0, pA1, K_lds, qr, qrl, r32, hi, -m_reg);
        finishSM(pB0, pB1, alB, l_reg, pa0, pa1, pa2, pa3); SBAR();
        pv_pipe(o, vb0 + SHM_V, pa0, pa1, pa2, pa3); partialSM(pA0, pA1, m_reg, alA);
        RESC(alA); STEP_END();
    }
    ISSUE_V(NT - 1, 1);
    SBAR(); qkt(pB0, pB1, K_lds + SHM_K, qr, qrl, r32, hi, -m_reg);
    finishSM(pA0, pA1, alA, l_reg, pa0, pa1, pa2, pa3); SBAR();
    pv_pipe(o, vb0, pa0, pa1, pa2, pa3); partialSM(pB0, pB1, m_reg, alB);
    RESC(alB); STEP_END();
    finishSM(pB0, pB1, alB, l_reg, pa0, pa1, pa2, pa3); SBAR();
    pv_pipe(o, vb0 + SHM_V, pa0, pa1, pa2, pa3);
#else
#define VOFF(t) (__builtin_amdgcn_readfirstlane(((unsigned)(t) % 3u) * (unsigned)SHM_V))
    if (STG_SEL == 0 ? (wid < 4) : (STG_SEL == 1)) {
        ISSUE_K(1, 1); ISSUE_V(0, 0);
        qkt(pA0, pA1, K_lds, qr, qrl, r32, hi, 0.f); partialSM_first(pA0, pA1, m_reg, alA);
        STEP_END();
        for (int j = 1; j + 1 < NT; j += 2) {
            ISSUE_K(j + 1, 0); ISSUE_V(j, j % 3);
            SBAR(); qkt(pB0, pB1, K_lds + SHM_K, qr, qrl, r32, hi, -m_reg); SBAR();
            finishSM(pA0, pA1, alA, l_reg, pa0, pa1, pa2, pa3); SBAR();
            pv_pipe(o, vb0 + VOFF(j - 1), pa0, pa1, pa2, pa3); partialSM(pB0, pB1, m_reg, alB);
            RESC(alB); STEP_END();
            ISSUE_K(j + 2, 1); ISSUE_V(j + 1, (j + 1) % 3);
            SBAR(); qkt(pA0, pA1, K_lds, qr, qrl, r32, hi, -m_reg); SBAR();
            finishSM(pB0, pB1, alB, l_reg, pa0, pa1, pa2, pa3); SBAR();
            pv_pipe(o, vb0 + VOFF(j), pa0, pa1, pa2, pa3); partialSM(pA0, pA1, m_reg, alA);
            RESC(alA); STEP_END();
        }
        ISSUE_V(NT - 1, (NT - 1) % 3);
        SBAR(); qkt(pB0, pB1, K_lds + SHM_K, qr, qrl, r32, hi, -m_reg); SBAR();
        finishSM(pA0, pA1, alA, l_reg, pa0, pa1, pa2, pa3); SBAR();
        pv_pipe(o, vb0 + VOFF(NT - 2), pa0, pa1, pa2, pa3); partialSM(pB0, pB1, m_reg, alB);
        RESC(alB); STEP_END();
        finishSM(pB0, pB1, alB, l_reg, pa0, pa1, pa2, pa3); SBAR();
        pv_pipe(o, vb0 + VOFF(NT - 1), pa0, pa1, pa2, pa3);
        STEP_END();
        STEP_END();
    } else {
#define TR_EVEN(j_) do { finishSM(pA0, pA1, alA, l_reg, pa0, pa1, pa2, pa3); SBAR(); pv_pipe(o, vb0 + VOFF((j_) - 2), pa0, pa1, pa2, pa3); partialSM(pB0, pB1, m_reg, alB); RESC(alB); } while (0)
#define TR_ODD(j_)  do { finishSM(pB0, pB1, alB, l_reg, pa0, pa1, pa2, pa3); SBAR(); pv_pipe(o, vb0 + VOFF((j_) - 2), pa0, pa1, pa2, pa3); partialSM(pA0, pA1, m_reg, alA); RESC(alA); } while (0)
        ISSUE_K(1, 1); ISSUE_V(0, 0);
        qkt(pA0, pA1, K_lds, qr, qrl, r32, hi, 0.f);
        STEP_END();
        ISSUE_K(2, 0); ISSUE_V(1, 1);
        partialSM_first(pA0, pA1, m_reg, alA);
        SBAR(); qkt(pB0, pB1, K_lds + SHM_K, qr, qrl, r32, hi, -m_reg); SBAR();
        STEP_END();
        for (int j = 2; j + 1 < NT - 1; j += 2) {
            ISSUE_K(j + 1, 1); ISSUE_V(j, j % 3);
            TR_EVEN(j); SBAR(); qkt(pA0, pA1, K_lds, qr, qrl, r32, hi, -m_reg); SBAR();
            STEP_END();
            ISSUE_K(j + 2, 0); ISSUE_V(j + 1, (j + 1) % 3);
            TR_ODD(j + 1); SBAR(); qkt(pB0, pB1, K_lds + SHM_K, qr, qrl, r32, hi, -m_reg); SBAR();
            STEP_END();
        }
        ISSUE_K(NT - 1, 1); ISSUE_V(NT - 2, (NT - 2) % 3);
        TR_EVEN(NT - 2); SBAR(); qkt(pA0, pA1, K_lds, qr, qrl, r32, hi, -m_reg); SBAR();
        STEP_END();
        ISSUE_V(NT - 1, (NT - 1) % 3);
        TR_ODD(NT - 1); SBAR(); qkt(pB0, pB1, K_lds + SHM_K, qr, qrl, r32, hi, -m_reg); SBAR();
        STEP_END();
        TR_EVEN(NT);
        STEP_END();
        finishSM(pB0, pB1, alB, l_reg, pa0, pa1, pa2, pa3); SBAR();
        pv_pipe(o, vb0 + VOFF(NT - 1), pa0, pa1, pa2, pa3);
        STEP_END();
#undef TR_EVEN
#undef TR_ODD
    }
#undef VOFF
#endif
    if (hi == 0) li_l[r32] = l_reg;
    STEP_END();
    { LAS unsigned char* mx = lds + wid * (32 * 272);
      int r32e = r32, hie = hi; asm volatile("" : "+v"(r32e), "+v"(hie));
#pragma unroll
      for (int r = 0; r < 16; ++r) { const int rr = crow(r, hie); const float rli = __builtin_amdgcn_rcpf(li_l[rr]);
#pragma unroll
        for (int d0 = 0; d0 < 4; ++d0) *(LAS bf16*)(mx + rr * 272 + (d0 * 32 + r32e) * 2) = (bf16)(cvtpk(o[d0][r] * rli, 0.f) & 0xffffu); }
      asm volatile("s_waitcnt lgkmcnt(0)" ::: "memory");
      const bf16* Gz = uni(G1 + (size_t)(qrow0 + wid * QBLK) * N_AB + G1_ZA + h * 128); bf16* Co = uni(CC + (size_t)(qrow0 + wid * QBLK) * MIXW + h * 128);
      int le = lane; asm volatile("" : "+v"(le));
#pragma unroll
      for (int i = 0; i < 8; ++i) { const int id = 64 * i + le, row = id >> 4, c8 = (id & 15) * 8;
          const v4u oq = *(const LAS v4u*)(mx + row * 272 + c8 * 2); const v4u zq = LDNT((const v4u*)(Gz + (unsigned)(row * N_AB + c8)));
          v4u wq;
#pragma unroll
          for (int e = 0; e < 4; ++e) wq[e] = cvtpk(bf_lo(oq[e]) * bf_lo(zq[e]), bf_hi(oq[e]) * bf_hi(zq[e]));
          *(v4u*)(Co + (unsigned)(row * MIXW + c8)) = wq;
          if ((i & 3) == 3) asm volatile("" ::: "memory"); } }
#undef TROW
#undef GLDS
#undef ISSUE_K
#undef ISSUE_V
#undef STEP_END
#undef RESC
}
}
namespace att2 {
using namespace att;
struct P8 { f32x4 t[2][4]; };
__device__ __forceinline__ float x16(float x) { return __int_as_float(__builtin_amdgcn_ds_swizzle(__float_as_int(x), 0x401F)); }
__device__ __forceinline__ float rmax4(float x) { x = fmaxf(x, x16(x)); auto rr = __builtin_amdgcn_permlane32_swap(__float_as_uint(x), __float_as_uint(x), false, false); return fmaxf(__uint_as_float(rr[0]), __uint_as_float(rr[1])); }
__device__ __forceinline__ float rsum4(float x) { x = x + x16(x); auto rr = __builtin_amdgcn_permlane32_swap(__float_as_uint(x), __float_as_uint(x), false, false); return __uint_as_float(rr[0]) + __uint_as_float(rr[1]); }
__device__ __forceinline__ float tmax(const P8& p, int qt) { float m = p.t[qt][0][0];
#pragma unroll
    for (int kt = 0; kt < 4; ++kt)
#pragma unroll
        for (int r = 0; r < 4; ++r) m = fmaxf(m, p.t[qt][kt][r]);
    return m; }
__device__ __forceinline__ void qkt2(P8& p, const LAS unsigned char* Ks, const bf16x8 (&qf)[2][4], const LAS unsigned char* qrl, int l16, int g4, float seed0, float seed1) {
#pragma unroll
    for (int kt = 0; kt < 4; ++kt) { p.t[0][kt] = (f32x4){seed0, seed0, seed0, seed0}; p.t[1][kt] = (f32x4){seed1, seed1, seed1, seed1}; }
    const int swn = l16 << 4, swr = ((l16 >> 1) & 7) << 4;
#pragma unroll
    for (int ks = 0; ks < 4; ++ks) { const int cb = (32 * ks + 8 * g4) * 2;
#pragma unroll
        for (int kt = 0; kt < 4; ++kt) { const bf16x8 kf = *(const LAS bf16x8*)(Ks + (16 * kt + l16) * 256 + (cb ^ swn));
            p.t[0][kt] = mfma16(kf, qf[0][ks], p.t[0][kt]); p.t[1][kt] = mfma16(kf, qf[1][ks], p.t[1][kt]); } }
#pragma unroll
    for (int ks = 0; ks < 2; ++ks) { const int cb = (32 * ks + 8 * g4) * 2;
        const bf16x8 q0 = *(const LAS bf16x8*)(qrl + ks * 1024), q1 = *(const LAS bf16x8*)(qrl + (2 + ks) * 1024);
#pragma unroll
        for (int kt = 0; kt < 4; ++kt) { const bf16x8 kf = *(const LAS bf16x8*)(Ks + OFF_KR + (16 * kt + l16) * 128 + (cb ^ swr));
            p.t[0][kt] = mfma16(kf, q0, p.t[0][kt]); p.t[1][kt] = mfma16(kf, q1, p.t[1][kt]); } }
}
__device__ __forceinline__ void sub_all(P8& p, float d0, float d1) {
#pragma unroll
    for (int kt = 0; kt < 4; ++kt) { p.t[0][kt] = p.t[0][kt] - d0; p.t[1][kt] = p.t[1][kt] - d1; } }
__device__ __forceinline__ void exp_half(P8& p, int k0) {
#pragma unroll
    for (int qt = 0; qt < 2; ++qt)
#pragma unroll
        for (int kt = 0; kt < 2; ++kt)
#pragma unroll
            for (int r = 0; r < 4; ++r) p.t[qt][k0 + kt][r] = __builtin_amdgcn_exp2f(p.t[qt][k0 + kt][r]); }
__device__ __forceinline__ void partial2_first(P8& p, float& m0, float& m1, float& a0, float& a1) {
    m0 = rmax4(tmax(p, 0)); m1 = rmax4(tmax(p, 1)); a0 = 1.f; a1 = 1.f; sub_all(p, m0, m1); exp_half(p, 0); }
__device__ __forceinline__ void partial2(P8& p, float& m0, float& m1, float& a0, float& a1) {
    const float x0 = rmax4(tmax(p, 0)), x1 = rmax4(tmax(p, 1));
    if (__builtin_expect(__all(fmaxf(x0, x1) <= THRL), 1)) { a0 = 1.f; a1 = 1.f; }
    else { const float d0 = fmaxf(x0, 0.f), d1 = fmaxf(x1, 0.f); a0 = __builtin_amdgcn_exp2f(-d0); a1 = __builtin_amdgcn_exp2f(-d1); m0 += d0; m1 += d1; sub_all(p, d0, d1); }
    exp_half(p, 0); }
__device__ __forceinline__ void finish2(P8& p, float a0, float a1, float& l0, float& l1, bf16x8 (&pb)[2][2]) {
    exp_half(p, 2);
    float s0 = 0.f, s1 = 0.f;
#pragma unroll
    for (int kt = 0; kt < 4; ++kt)
#pragma unroll
        for (int r = 0; r < 4; ++r) { s0 += p.t[0][kt][r]; s1 += p.t[1][kt][r]; }
    l0 = l0 * a0 + rsum4(s0); l1 = l1 * a1 + rsum4(s1);
#pragma unroll
    for (int qt = 0; qt < 2; ++qt)
#pragma unroll
        for (int s2 = 0; s2 < 2; ++s2) { v4u w; w.x = cvtpk(p.t[qt][2 * s2][0], p.t[qt][2 * s2][1]); w.y = cvtpk(p.t[qt][2 * s2][2], p.t[qt][2 * s2][3]);
            w.z = cvtpk(p.t[qt][2 * s2 + 1][0], p.t[qt][2 * s2 + 1][1]); w.w = cvtpk(p.t[qt][2 * s2 + 1][2], p.t[qt][2 * s2 + 1][3]); pb[qt][s2] = __builtin_bit_cast(bf16x8, w); }
}
template <int B, int I> __device__ __forceinline__ void pv2_rd(const int (&vo)[8], s16x4& lo, s16x4& hi) { constexpr int s2 = I >> 3, vt = I & 7;
    lo = tr_read<B * SHM_V + s2 * 8192>(vo[vt]); hi = tr_read<B * SHM_V + s2 * 8192 + 4096>(vo[vt]); }
#define PV2_MM(I, L, H) do { const bf16x8 af_ = (bf16x8){L[0], L[1], L[2], L[3], H[0], H[1], H[2], H[3]}; \
    o[(I) & 7][0] = mfma16(af_, pb[0][(I) >> 3], o[(I) & 7][0]); o[(I) & 7][1] = mfma16(af_, pb[1][(I) >> 3], o[(I) & 7][1]); } while (0)
#define PV2_W(N) do { asm volatile("s_waitcnt lgkmcnt(" #N ")" ::: "memory"); SBAR(); } while (0)
template <int B> __device__ __forceinline__ void pv2(f32x4 (&o)[8][2], const int (&vo)[8], const bf16x8 (&pb)[2][2]) {
    s16x4 l0, h0, l1, h1, l2, h2;
    asm volatile("s_waitcnt lgkmcnt(0)" ::: "memory"); SBAR();
    pv2_rd<B, 0>(vo, l0, h0); pv2_rd<B, 1>(vo, l1, h1); pv2_rd<B, 2>(vo, l2, h2);
    PV2_W(4); PV2_MM(0, l0, h0); SBAR(); pv2_rd<B, 3>(vo, l0, h0);
    PV2_W(4); PV2_MM(1, l1, h1); SBAR(); pv2_rd<B, 4>(vo, l1, h1);
    PV2_W(4); PV2_MM(2, l2, h2); SBAR(); pv2_rd<B, 5>(vo, l2, h2);
    PV2_W(4); PV2_MM(3, l0, h0); SBAR(); pv2_rd<B, 6>(vo, l0, h0);
    PV2_W(4); PV2_MM(4, l1, h1); SBAR(); pv2_rd<B, 7>(vo, l1, h1);
    PV2_W(4); PV2_MM(5, l2, h2); SBAR(); pv2_rd<B, 8>(vo, l2, h2);
    PV2_W(4); PV2_MM(6, l0, h0); SBAR(); pv2_rd<B, 9>(vo, l0, h0);
    PV2_W(4); PV2_MM(7, l1, h1); SBAR(); pv2_rd<B, 10>(vo, l1, h1);
    PV2_W(4); PV2_MM(8, l2, h2); SBAR(); pv2_rd<B, 11>(vo, l2, h2);
    PV2_W(4); PV2_MM(9, l0, h0); SBAR(); pv2_rd<B, 12>(vo, l0, h0);
    PV2_W(4); PV2_MM(10, l1, h1); SBAR(); pv2_rd<B, 13>(vo, l1, h1);
    PV2_W(4); PV2_MM(11, l2, h2); SBAR(); pv2_rd<B, 14>(vo, l2, h2);
    PV2_W(4); PV2_MM(12, l0, h0); SBAR(); pv2_rd<B, 15>(vo, l0, h0);
    PV2_W(4); PV2_MM(13, l1, h1);
    PV2_W(2); PV2_MM(14, l2, h2);
    PV2_W(0); PV2_MM(15, l0, h0);
}
__device__ __forceinline__ void attn_unit2(const bf16* __restrict__ Q, const bf16* __restrict__ KN, const bf16* __restrict__ KR, const bf16* __restrict__ V, const bf16* __restrict__ G1, bf16* __restrict__ CC,
                                           int qrow0, int h, int nt_lat, int lat0, int ctx0, LAS unsigned char* lds) {
    int tid_l = threadIdx.x; asm volatile("" : "+v"(tid_l)); const int tid = tid_l, wid = __builtin_amdgcn_readfirstlane(tid >> 6), lane = tid & 63, l16 = lane & 15, g4 = lane >> 4;
    LAS unsigned char* V_lds = lds + OFF_V; LAS unsigned char* K_lds = lds + OFF_K;
    LAS unsigned char* qrl = lds + OFF_QR + wid * 4096 + lane * 16;
    float m0 = 0.f, m1 = 0.f, l0 = 0.f, l1 = 0.f;
    f32x4 o[8][2];
#pragma unroll
    for (int vt = 0; vt < 8; ++vt) { o[vt][0] = (f32x4){0.f, 0.f, 0.f, 0.f}; o[vt][1] = (f32x4){0.f, 0.f, 0.f, 0.f}; }
    const unsigned ko = (unsigned)((tid >> 4) * 128 + (((tid & 15) ^ ((tid >> 4) & 15)) * 8));
    const unsigned kro = (unsigned)((tid >> 3) * 64 + (((tid & 7) ^ ((tid >> 4) & 7)) * 8));
    const unsigned vo_g = (unsigned)((tid >> 4) * 128 + ((((((tid & 15) >> 1) ^ ((tid >> 4) & 7)) << 1) | (tid & 1)) * 8));
    int vo[8];
    { const int q = l16 >> 2, pp = l16 & 3, rr = 4 * g4 + q, sw = rr & 7, base = (int)(unsigned)(unsigned long long)lds + OFF_V + rr * 256 + 8 * pp;
#pragma unroll
      for (int vt = 0; vt < 8; ++vt) vo[vt] = base + ((vt ^ sw) << 5); }
    const int NT = nt_lat + 4;
#define TROW(jt) ((jt) < nt_lat ? lat0 + 64 * (jt) : ctx0 + 64 * ((jt) - nt_lat))
#define GLDS(gp, lp) __builtin_amdgcn_global_load_lds((const unsigned*)(gp), (LAS unsigned*)(lp), 16, 0, 0)
#define ISSUE_K(jt, b) do { const int R0_ = TROW(jt); const bf16* Kb_ = uni(KN + ((size_t)h * MTOT + R0_) * 128); const bf16* Rb_ = uni(KR + (size_t)R0_ * 64); \
    GLDS(Kb_ + ko, K_lds + (b) * SHM_K + wid * 1024); GLDS(Kb_ + ko + 32 * 128, K_lds + (b) * SHM_K + (wid + 8) * 1024); GLDS(Rb_ + kro, K_lds + (b) * SHM_K + OFF_KR + wid * 1024); } while (0)
#define ISSUE_V(jt, b) do { const int R0_ = TROW(jt); const bf16* Vb_ = uni(V + ((size_t)h * MTOT + R0_) * 128); \
    GLDS(Vb_ + vo_g, V_lds + (b) * SHM_V + wid * 1024); GLDS(Vb_ + vo_g + 32 * 128, V_lds + (b) * SHM_V + (wid + 8) * 1024); } while (0)
#define STEP_END() asm volatile("s_waitcnt vmcnt(0) lgkmcnt(0)\n\ts_barrier" ::: "memory")
#define RESC2(a0_, a1_) do { if (__any(fminf(a0_, a1_) < 1.f)) { _Pragma("unroll") for (int vt = 0; vt < 8; ++vt) { o[vt][0] = o[vt][0] * (a0_); o[vt][1] = o[vt][1] * (a1_); } } } while (0)
    STEP_END();
    ISSUE_K(0, 0);
    bf16x8 qf[2][4];
    { const bf16* Qw = uni(Q + (size_t)(qrow0 + wid * QBLK) * NQ + h * 192); const unsigned qo = (unsigned)(l16 * NQ + g4 * 8);
#pragma unroll
      for (int qt = 0; qt < 2; ++qt) {
#pragma unroll
        for (int ks = 0; ks < 4; ++ks) qf[qt][ks] = *(const bf16x8*)(Qw + qo + (unsigned)(qt * 16 * NQ + ks * 32));
#pragma unroll
        for (int ks = 4; ks < 6; ++ks) { const bf16x8 t = *(const bf16x8*)(Qw + qo + (unsigned)(qt * 16 * NQ + ks * 32)); *(LAS bf16x8*)(qrl + (qt * 2 + ks - 4) * 1024) = t; } } }
    P8 pA, pB; float aA0, aA1, aB0, aB1; bf16x8 pb[2][2];
    STEP_END();
    ISSUE_K(1, 1); ISSUE_V(0, 0);
    qkt2(pA, K_lds, qf, qrl, l16, g4, 0.f, 0.f); partial2_first(pA, m0, m1, aA0, aA1);
    STEP_END();
    for (int j = 1; j + 1 < NT; j += 2) {
        ISSUE_K(j + 1, 0); ISSUE_V(j, 1);
        SBAR(); qkt2(pB, K_lds + SHM_K, qf, qrl, l16, g4, -m0, -m1);
        finish2(pA, aA0, aA1, l0, l1, pb); SBAR();
        pv2<0>(o, vo, pb); partial2(pB, m0, m1, aB0, aB1);
        RESC2(aB0, aB1); STEP_END();
        ISSUE_K(j + 2, 1); ISSUE_V(j + 1, 0);
        SBAR(); qkt2(pA, K_lds, qf, qrl, l16, g4, -m0, -m1);
        finish2(pB, aB0, aB1, l0, l1, pb); SBAR();
        pv2<1>(o, vo, pb); partial2(pA, m0, m1, aA0, aA1);
        RESC2(aA0, aA1); STEP_END();
    }
    ISSUE_V(NT - 1, 1);
    SBAR(); qkt2(pB, K_lds + SHM_K, qf, qrl, l16, g4, -m0, -m1);
    finish2(pA, aA0, aA1, l0, l1, pb); SBAR();
    pv2<0>(o, vo, pb); partial2(pB, m0, m1, aB0, aB1);
    RESC2(aB0, aB1); STEP_END();
    finish2(pB, aB0, aB1, l0, l1, pb); SBAR();
    pv2<1>(o, vo, pb);
    STEP_END();
    { LAS unsigned char* mx = lds + wid * (32 * 272);
      const float r0 = __builtin_amdgcn_rcpf(l0), r1 = __builtin_amdgcn_rcpf(l1);
#pragma unroll
      for (int vt = 0; vt < 8; ++vt) { u32x2 w;
          w.x = cvtpk(o[vt][0][0] * r0, o[vt][0][1] * r0); w.y = cvtpk(o[vt][0][2] * r0, o[vt][0][3] * r0); *(LAS u32x2*)(mx + l16 * 272 + (16 * vt + 4 * g4) * 2) = w;
          w.x = cvtpk(o[vt][1][0] * r1, o[vt][1][1] * r1); w.y = cvtpk(o[vt][1][2] * r1, o[vt][1][3] * r1); *(LAS u32x2*)(mx + (16 + l16) * 272 + (16 * vt + 4 * g4) * 2) = w; }
      asm volatile("s_waitcnt lgkmcnt(0)" ::: "memory");
      const bf16* Gz = uni(G1 + (size_t)(qrow0 + wid * QBLK) * N_AB + G1_ZA + h * 128); bf16* Co = uni(CC + (size_t)(qrow0 + wid * QBLK) * MIXW + h * 128);
      int le = lane; asm volatile("" : "+v"(le));
#pragma unroll
      for (int i = 0; i < 8; ++i) { const int id = 64 * i + le, row = id >> 4, c8 = (id & 15) * 8;
          const v4u oq = *(const LAS v4u*)(mx + row * 272 + c8 * 2); const v4u zq = LDNT((const v4u*)(Gz + (unsigned)(row * N_AB + c8)));
          v4u wq;
#pragma unroll
          for (int e = 0; e < 4; ++e) wq[e] = cvtpk(bf_lo(oq[e]) * bf_lo(zq[e]), bf_hi(oq[e]) * bf_hi(zq[e]));
          *(v4u*)(Co + (unsigned)(row * MIXW + c8)) = wq;
          if ((i & 3) == 3) asm volatile("" ::: "memory"); } }
#undef TROW
#undef GLDS
#undef ISSUE_K
#undef ISSUE_V
#undef STEP_END
#undef RESC2
}
#undef PV2_MM
#undef PV2_W
}
#ifndef ATT_PRIO
#define ATT_PRIO 1
#endif
#ifndef ATT_BODY2
#define ATT_BODY2 0
#endif
__device__ __forceinline__ void attn_phase(KArgs a, LAS unsigned char* lds, int G) {
    const bf16* Q = (const bf16*)(GWS(a) + WS_Q); const bf16* KN = (const bf16*)(GWS(a) + WS_KN); const bf16* KR = (const bf16*)(GWS(a) + WS_KR); const bf16* V = (const bf16*)(GWS(a) + WS_V);
    const bf16* G1 = (const bf16*)(GWS(a) + WS_G1); bf16* CC = (bf16*)(GWS(a) + WS_CC);
    const int bx = blockIdx.x; const int vcu = (G % 8 == 0) ? (bx % 8) * (G / 8) + bx / 8 : bx;
    if (ATT_PRIO && __builtin_amdgcn_readfirstlane(threadIdx.x >> 6) >= 4) __builtin_amdgcn_s_setprio(1);
    for (int u = vcu; u < 2048 + 64; u += G) {
        if (u < 2048) { const int bh = u >> 5, qb = u & 31, b = bh >> 5, h = bh & 31;
            if (ATT_BODY2) att2::attn_unit2(Q, KN, KR, V, G1, CC, b * SEQ + qb * 256, h, 128, b * SEQ, MLAT + b * NCTX, lds); else att::attn_unit(Q, KN, KR, V, G1, CC, b * SEQ + qb * 256, h, 128, b * SEQ, MLAT + b * NCTX, lds); }
        else { const int bh = u - 2048, b = bh >> 5, h = bh & 31;
            if (ATT_BODY2) att2::attn_unit2(Q, KN, KR, V, G1, CC, MLAT + b * NCTX, h, 0, 0, MLAT + b * NCTX, lds); else att::attn_unit(Q, KN, KR, V, G1, CC, MLAT + b * NCTX, h, 0, 0, MLAT + b * NCTX, lds); }
    }
    if (ATT_PRIO) __builtin_amdgcn_s_setprio(0);
    __syncthreads();
}

__device__ __forceinline__ s16x4 tr_read_v(int addr) { s16x4 r; asm volatile("ds_read_b64_tr_b16 %0, %1" : "=&v"(r) : "v"(addr) : "memory"); return r; }
template <int CTRL> __device__ __forceinline__ float dpp_f(float x) { return __int_as_float(__builtin_amdgcn_update_dpp(0, __float_as_int(x), CTRL, 0xf, 0xf, true)); }
constexpr int SC_PITCH = 288;
constexpr int SC_QD = 0, SC_KD = 16 * SC_PITCH, SC_KE = 32 * SC_PITCH, SC_VV = 48 * SC_PITCH, SC_EB = 64 * SC_PITCH, SC_BUF = SC_EB + 512;
constexpr int SC_OST = 2 * SC_BUF;
__device__ __forceinline__ void scan_stage(LAS unsigned char* B, u32x2 rq, u32x2 rk, u32x2 rv, int wid, int lane, int tid) {
    const int t = lane & 15, kq = lane >> 4;
    float q[4], kk[4], x[4], tot[4];
    q[0] = bf_lo(rq.x); q[1] = bf_hi(rq.x); q[2] = bf_lo(rq.y); q[3] = bf_hi(rq.y); kk[0] = bf_lo(rk.x); kk[1] = bf_hi(rk.x); kk[2] = bf_lo(rk.y); kk[3] = bf_hi(rk.y);
#pragma unroll
    for (int e = 0; e < 4; ++e) { float g = __builtin_amdgcn_logf(fmaxf(1.0f - kk[e], 1e-30f)); float s = g;
        g += dpp_f<0x111>(g); g += dpp_f<0x112>(g); g += dpp_f<0x114>(g); g += dpp_f<0x118>(g);
        s += dpp_f<0x128>(s); s += dpp_f<0x124>(s); s += dpp_f<0x122>(s); s += dpp_f<0x121>(s);
        x[e] = g; tot[e] = s; }
    float qd[4], kd[4], ke[4];
#pragma unroll
    for (int e = 0; e < 4; ++e) { qd[e] = q[e] * __builtin_amdgcn_exp2f(x[e]); kd[e] = kk[e] * __builtin_amdgcn_exp2f(fminf(-x[e], 115.0f)); ke[e] = kk[e] * __builtin_amdgcn_exp2f(fminf(tot[e] - x[e], 0.0f)); }
    const int ppos = 32 * (wid >> 1) + 8 * kq + 4 * (wid & 1);
    u32x2 w;
    w.x = cvtpk(qd[0], qd[1]); w.y = cvtpk(qd[2], qd[3]); *(LAS u32x2*)(B + SC_QD + t * SC_PITCH + ppos * 2) = w;
    w.x = cvtpk(kd[0], kd[1]); w.y = cvtpk(kd[2], kd[3]); *(LAS u32x2*)(B + SC_KD + t * SC_PITCH + ppos * 2) = w;
    w.x = cvtpk(ke[0], ke[1]); w.y = cvtpk(ke[2], ke[3]); *(LAS u32x2*)(B + SC_KE + t * SC_PITCH + (16 * wid + 4 * kq) * 2) = w;
    if (t == 0) *(LAS f32x4*)(B + SC_EB + (16 * wid + 4 * kq) * 4) = (f32x4){__builtin_amdgcn_exp2f(tot[0]), __builtin_amdgcn_exp2f(tot[1]), __builtin_amdgcn_exp2f(tot[2]), __builtin_amdgcn_exp2f(tot[3])};
    *(LAS u32x2*)(B + SC_VV + (tid >> 5) * SC_PITCH + (tid & 31) * 8) = rv;
}
__device__ __forceinline__ void scan_phase(KArgs a, LAS unsigned char* lds, int G) {
    int tid_l = threadIdx.x; asm volatile("" : "+v"(tid_l)); const int tid = tid_l, lane = tid & 63, wid = __builtin_amdgcn_readfirstlane(tid >> 6), g4 = lane >> 4, l16 = lane & 15;
    const bf16* G1 = (const bf16*)(GWS(a) + WS_G1); const size_t TS = (size_t)MTOT * MIXW;
    const int ldsb = (int)(unsigned)(unsigned long long)lds;
    const int trq = l16 >> 2, trp = l16 & 3;
    const int st = lane & 15, sk = 16 * wid + 4 * (lane >> 4);
    const int vt_ = tid >> 5, vc = (tid & 31) * 4;
    for (int sq = blockIdx.x; sq < 256; sq += G) {
        const int dir = sq >> 7, b = (sq >> 6) & 1, h = sq & 63;
        const bf16* Tq = G1 + h * 128; const bf16* Tk = G1 + (size_t)(1 + dir) * TS + h * 128; const bf16* Tv = G1 + (size_t)3 * TS + h * 128;
        bf16* Od = (bf16*)(GWS(a) + WS_OF) + (size_t)dir * TS + h * 128;
        const unsigned oq = (unsigned)((dir ? 15 - st : st) * MIXW + sk), ovv = (unsigned)((dir ? 15 - vt_ : vt_) * MIXW + vc);
#define CLOW(c_) ((c_) < 16 ? MLAT + b * NCTX + (dir ? 240 - 16 * (c_) : 16 * (c_)) : b * SEQ + (dir ? 8432 - 16 * (c_) : 16 * (c_) - 256))
#define SLOADC(c_, rq_, rk_, rv_) do { const size_t lo_ = (size_t)CLOW(c_) * MIXW; rq_ = LDNT((const u32x2*)(uni(Tq + lo_) + oq)); rk_ = LDNT((const u32x2*)(uni(Tk + lo_) + oq)); rv_ = LDNT((const u32x2*)(uni(Tv + lo_) + ovv)); } while (0)
#define SBARRIER() do { asm volatile("s_waitcnt lgkmcnt(0)" ::: "memory"); __builtin_amdgcn_s_barrier(); asm volatile("" ::: "memory"); } while (0)
        f32x4 S[8];
#pragma unroll
        for (int i = 0; i < 8; ++i) S[i] = (f32x4){0.f, 0.f, 0.f, 0.f};
        u32x2 rq0, rk0, rv0, rq1, rk1, rv1, rq2, rk2, rv2;
        SBARRIER();
        SLOADC(0, rq0, rk0, rv0); scan_stage(lds, rq0, rk0, rv0, wid, lane, tid); SLOADC(1, rq0, rk0, rv0); SLOADC(2, rq1, rk1, rv1); SLOADC(3, rq2, rk2, rv2);
        SBARRIER();
        auto iter = [&](const int c, u32x2& rq, u32x2& rk, u32x2& rv) __attribute__((always_inline)) {
            LAS unsigned char* Bc = lds + (c & 1) * SC_BUF;
            if (c > 0) { const u32x2 ov = *(const LAS u32x2*)(lds + SC_OST + ((c - 1) & 1) * 4096 + vt_ * 256 + vc * 2); *(u32x2*)(uni(Od + (size_t)CLOW(c - 1) * MIXW) + ovv) = ov; }
            if (c + 1 < 528) { scan_stage(lds + ((c + 1) & 1) * SC_BUF, rq, rk, rv, wid, lane, tid); SLOADC(min(c + 4, 527), rq, rk, rv); }
            bf16x8 qf[4], kf[4]; f32x4 e4[8]; s16x4 kt4[8];
#pragma unroll
            for (int ks = 0; ks < 4; ++ks) { qf[ks] = *(const LAS bf16x8*)(Bc + SC_QD + l16 * SC_PITCH + (32 * ks + 8 * g4) * 2); kf[ks] = *(const LAS bf16x8*)(Bc + SC_KD + l16 * SC_PITCH + (32 * ks + 8 * g4) * 2); }
            const int trb = ldsb + (c & 1) * SC_BUF + (4 * g4 + trq) * SC_PITCH + 8 * trp;
            const s16x4 vt = tr_read_v(trb + SC_VV + 32 * wid);
#pragma unroll
            for (int kt = 0; kt < 8; ++kt) { e4[kt] = *(const LAS f32x4*)(Bc + SC_EB + (16 * kt + 4 * g4) * 4); kt4[kt] = tr_read_v(trb + SC_KE + 32 * kt); }
            f32x4 at = (f32x4){0.f, 0.f, 0.f, 0.f};
#pragma unroll
            for (int ks = 0; ks < 4; ++ks) at = mfma16(kf[ks], qf[ks], at);
#pragma unroll
            for (int r = 0; r < 4; ++r) at[r] = (4 * g4 + r <= l16) ? at[r] : 0.f;
            bf16x8 pa; { v4u w; w.x = cvtpk(at[0], at[1]); w.y = cvtpk(at[2], at[3]); w.z = 0u; w.w = 0u; pa = __builtin_bit_cast(bf16x8, w); }
            f32x4 o = (f32x4){0.f, 0.f, 0.f, 0.f};
#pragma unroll
            for (int ks = 0; ks < 4; ++ks) { v4u w; w.x = cvtpk(S[2 * ks][0], S[2 * ks][1]); w.y = cvtpk(S[2 * ks][2], S[2 * ks][3]); w.z = cvtpk(S[2 * ks + 1][0], S[2 * ks + 1][1]); w.w = cvtpk(S[2 * ks + 1][2], S[2 * ks + 1][3]);
                o = mfma16(qf[ks], __builtin_bit_cast(bf16x8, w), o); }
            asm volatile("s_waitcnt lgkmcnt(0)" ::: "memory"); SBAR();
            const bf16x8 vf = (bf16x8){vt[0], vt[1], vt[2], vt[3], 0, 0, 0, 0};
            o = mfma16(pa, vf, o);
#pragma unroll
            for (int kt = 0; kt < 8; ++kt) { const bf16x8 kef = (bf16x8){kt4[kt][0], kt4[kt][1], kt4[kt][2], kt4[kt][3], 0, 0, 0, 0};
                S[kt] = mfma16(kef, vf, S[kt] * e4[kt]); }
            { LAS bf16* ost = (LAS bf16*)(lds + SC_OST + (c & 1) * 4096);
#pragma unroll
              for (int r = 0; r < 4; ++r) ost[(4 * g4 + r) * 128 + 16 * wid + l16] = (bf16)(cvtpk(o[r], 0.f) & 0xffffu); }
            SBARRIER();
        };
        for (int c = 0; c < 528; c += 3) { iter(c, rq0, rk0, rv0); iter(c + 1, rq1, rk1, rv1); iter(c + 2, rq2, rk2, rv2); }
        { const u32x2 ov = *(const LAS u32x2*)(lds + SC_OST + (527 & 1) * 4096 + vt_ * 256 + vc * 2); *(u32x2*)(uni(Od + (size_t)CLOW(527) * MIXW) + ovv) = ov; }
#undef CLOW
#undef SLOADC
#undef SBARRIER
    }
    asm volatile("s_waitcnt lgkmcnt(0)" ::: "memory"); __builtin_amdgcn_s_barrier(); asm volatile("" ::: "memory");
}

__device__ __forceinline__ void readout_phase(KArgs a, int jc, int nrows, int G) {
    int tid_l = threadIdx.x; asm volatile("" : "+v"(tid_l)); const int tid = tid_l, lane = tid & 63, wave = __builtin_amdgcn_readfirstlane(tid >> 6);
    const int gw = blockIdx.x * NWAVES + wave, NGW = G * NWAVES;
    const size_t TS = (size_t)MTOT * MIXW;
    const bf16* OFp = (const bf16*)(GWS(a) + WS_OF); const bf16* OBp = OFp + TS; const bf16* GS = (const bf16*)(GWS(a) + WS_G1) + 4 * TS; bf16* CC = (bf16*)(GWS(a) + WS_CC);
    const float* gnw = GIN(a, 20) + (size_t)jc * 128 + (lane & 15) * 8;
    const f32x4 w0 = *(const f32x4*)gnw, w1 = *(const f32x4*)(gnw + 4);
    for (int it = gw; it < nrows * 16; it += NGW) {
        const size_t off = (size_t)(it >> 4) * MIXW + (it & 15) * 512 + lane * 8;
        const v4u f = LDNT((const v4u*)(OFp + off)), bq = LDNT((const v4u*)(OBp + off)), gq = LDNT((const v4u*)(GS + off));
        float o[8], gg[8];
#pragma unroll
        for (int e = 0; e < 4; ++e) { o[2 * e] = bf_lo(f[e]) + bf_lo(bq[e]); o[2 * e + 1] = bf_hi(f[e]) + bf_hi(bq[e]); gg[2 * e] = bf_lo(gq[e]); gg[2 * e + 1] = bf_hi(gq[e]); }
        float ss = 0.f;
#pragma unroll
        for (int e = 0; e < 8; ++e) ss += o[e] * o[e];
        ss += __shfl_xor(ss, 1); ss += __shfl_xor(ss, 2); ss += __shfl_xor(ss, 4); ss += __shfl_xor(ss, 8);
        const float r = 1.0f / sqrtf(ss * (1.0f / 128.0f) + EPS);
        v4u w; w.x = cvtpk(o[0] * r * w0[0] * gg[0], o[1] * r * w0[1] * gg[1]); w.y = cvtpk(o[2] * r * w0[2] * gg[2], o[3] * r * w0[3] * gg[3]);
        w.z = cvtpk(o[4] * r * w1[0] * gg[4], o[5] * r * w1[1] * gg[5]); w.w = cvtpk(o[6] * r * w1[2] * gg[6], o[7] * r * w1[3] * gg[7]);
        *(v4u*)(CC + off) = w;
    }
}

#ifndef EN_P0
#define EN_P0 1
#endif
#ifndef EN_NORM
#define EN_NORM 1
#endif
#ifndef EN_A1
#define EN_A1 1
#endif
#ifndef EN_A2
#define EN_A2 1
#endif
#ifndef EN_A3
#define EN_A3 1
#endif
#ifndef EN_ATT
#define EN_ATT 1
#endif
#ifndef EN_A5
#define EN_A5 1
#endif
#ifndef EN_C1
#define EN_C1 1
#endif
#ifndef EN_SCAN
#define EN_SCAN 1
#endif
#ifndef EN_RO
#define EN_RO 1
#endif
#ifndef EN_C4
#define EN_C4 1
#endif
#ifndef EN_SGU
#define EN_SGU 1
#endif
#ifndef EN_QUP
#define EN_QUP 1
#endif
#ifndef EN_KVUP
#define EN_KVUP 1
#endif
#ifndef PG8_ALIGNV
#define PG8_ALIGNV true
#endif
#ifndef PG8_SP2V
#define PG8_SP2V true
#endif
#ifndef PROBE_MASK
#define PROBE_MASK 0u
#endif
#define REPS(k) for (int rep_ = 0; rep_ < ((((PROBE_MASK) >> (k)) & 1u) ? 2 : 1); ++rep_)
#ifndef MK_ONE_LAUNCH
#define MK_ONE_LAUNCH 1
#endif
constexpr int N_PHASES = 28;
#define IN(k) (lo <= (k) && (k) < hi)
#define SEAM(k) do { if (IN(k) && IN((k) + 1)) xcd_barrier(bar); } while (0)
template <int p> __device__ __forceinline__ void layer_pair(LAS unsigned char* lds, const int G, const int lo, const int hi, const XcdBarrier& bar) {

        const int pb = 2 + 13 * p, lab = 2 * p, lc = 2 * p + 1;
        if (EN_A1 && IN(pb + 0)) REPS(pb + 0) {
            KArgs A = kargs(); unsigned char* const wsb = GWS(A);
            pg8::Gemm g{(const pg8::bf16_t*)(wsb + WS_H), (const pg8::bf16_t*)(wsb + WS_WIN_AB) + (size_t)p * N_AB * DM, MTOT, N_AB, DM, DM}; pg8::LockstepOrder S; S.init(MTOT, N_AB, G, (int)blockIdx.x);
            pg8::EpiAB1 E{(pg8::bf16_t*)(wsb + WS_G1), N_AB};
            pg8::gemm_phase<pg8::EpiAB1, pg8::LockstepOrder, PG8_ALIGNV, PG8_SP2V>(lds, g, S, E);
            if (p0_defer_on(G)) { pg8::LockstepOrder S2; S2.init(MTOT, N_AB, G, (int)blockIdx.x); p0_deferred(kargs(), lds, S2, p == 0 ? 0 : 2); }
        } SEAM(pb + 0);
        if (EN_A2 && IN(pb + 1)) REPS(pb + 1) { a2_rows(kargs(), p, G); } SEAM(pb + 1);
        if (EN_SGU && IN(pb + 2)) REPS(pb + 2) { sgu_phase(kargs(), p, lds, G); }
        if (EN_QUP && IN(pb + 3)) REPS(pb + 3) {
            KArgs A = kargs(); unsigned char* const wsb = GWS(A);
            pg8::Gemm g{(const pg8::bf16_t*)(wsb + WS_QN), (const pg8::bf16_t*)(wsb + WS_WQ) + (size_t)p * NQ * QL, MTOT, NQ, QL, QL}; pg8::LockstepOrder S; S.init(MTOT, NQ, G, (int)blockIdx.x);
            pg8::EpiQ E{(pg8::bf16_t*)(wsb + WS_Q), (const pg8::f32x2*)(wsb + WS_ROPE), MLAT, 0.07216878364870322f * 1.4426950408889634f};
            pg8::gemm_phase<pg8::EpiQ, pg8::LockstepOrder, PG8_ALIGNV, PG8_SP2V>(lds, g, S, E);
        }
        if (EN_KVUP && IN(pb + 4)) REPS(pb + 4) {
            KArgs A = kargs(); unsigned char* const wsb = GWS(A);
            pg8::Gemm g{(const pg8::bf16_t*)(wsb + WS_KVN), (const pg8::bf16_t*)(wsb + WS_WKV) + (size_t)p * NKV * KVL, MTOT, NKV, KVL, KVL}; pg8::LockstepOrder S; S.init(MTOT, NKV, G, (int)((blockIdx.x + 64u) % (unsigned)G));
            pg8::EpiKV E{(pg8::bf16_t*)(wsb + WS_KN), (pg8::bf16_t*)(wsb + WS_V), MTOT};
            pg8::gemm_phase<pg8::EpiKV, pg8::LockstepOrder, PG8_ALIGNV, PG8_SP2V>(lds, g, S, E);
        } SEAM(pb + 4);
        if (EN_ATT && IN(pb + 5)) REPS(pb + 5) { attn_phase(kargs(), lds, G); } SEAM(pb + 5);
        if (EN_A5 && IN(pb + 6)) REPS(pb + 6) {
            KArgs A = kargs(); unsigned char* const wsb = GWS(A);
            { pg8::Gemm g{(const pg8::bf16_t*)(wsb + WS_CC), (const pg8::bf16_t*)(wsb + WS_WO_AB) + (size_t)p * DM * MIXW, MLAT, DM, MIXW, MIXW}; pg8::LockstepOrder S; S.init(MLAT, DM, G, (int)blockIdx.x);
              pg8::EpiBf16P E{(pg8::bf16_t*)(wsb + WS_Y), DM};
              pg8::gemm_phase<pg8::EpiBf16P, pg8::LockstepOrder, PG8_ALIGNV, PG8_SP2V>(lds, g, S, E); }
            { pg8::Gemm g{(const pg8::bf16_t*)(wsb + WS_CC) + (size_t)MLAT * MIXW, (const pg8::bf16_t*)(wsb + WS_WO_AB) + (size_t)p * DM * MIXW, MTOT - MLAT, DM, MIXW / 8, MIXW}; pg8::SplitKOrder S; S.init(MTOT - MLAT, DM, 8, G, (int)blockIdx.x);
              pg8::EpiF32 E{(float*)(wsb + WS_YP), DM, (size_t)(MTOT - MLAT) * DM};
              pg8::gemm_phase<pg8::EpiF32, pg8::SplitKOrder, PG8_ALIGNV, PG8_SP2V>(lds, g, S, E); }
        } SEAM(pb + 6);
        if (EN_NORM && IN(pb + 7)) REPS(pb + 7) { norm_phase(kargs(), lab, lc, G); } SEAM(pb + 7);
        if (EN_C1 && IN(pb + 8)) REPS(pb + 8) {
            KArgs A = kargs(); unsigned char* const wsb = GWS(A);
            pg8::Gemm g{(const pg8::bf16_t*)(wsb + WS_H), (const pg8::bf16_t*)(wsb + WS_WIN_C) + (size_t)p * N_C * DM, MTOT, N_C, DM, DM}; pg8::LockstepOrder S; S.init(MTOT, N_C, G, (int)blockIdx.x);
            pg8::EpiC1 E{(pg8::bf16_t*)(wsb + WS_G1), (size_t)MTOT * MIXW, (const float*)(wsb + WS_OML) + (size_t)p * 2 * 8192};
            pg8::gemm_phase<pg8::EpiC1, pg8::LockstepOrder, PG8_ALIGNV, PG8_SP2V>(lds, g, S, E);
            if (p0_defer_on(G)) { pg8::LockstepOrder S2; S2.init(MTOT, N_C, G, (int)blockIdx.x); p0_deferred(kargs(), lds, S2, p == 0 ? 1 : 3); }
        } SEAM(pb + 8);
        if (EN_SCAN && IN(pb + 9)) REPS(pb + 9) { scan_phase(kargs(), lds, G); } SEAM(pb + 9);
        if (EN_RO && IN(pb + 10)) REPS(pb + 10) { readout_phase(kargs(), p, lc == 3 ? MLAT : MTOT, G); } SEAM(pb + 10);
        if (EN_C4 && IN(pb + 11)) REPS(pb + 11) {
            KArgs A = kargs(); unsigned char* const wsb = GWS(A);
            { pg8::Gemm g{(const pg8::bf16_t*)(wsb + WS_CC), (const pg8::bf16_t*)(wsb + WS_WO_C) + (size_t)p * DM * MIXW, MLAT, DM, MIXW, MIXW}; pg8::LockstepOrder S; S.init(MLAT, DM, G, (int)blockIdx.x);
              pg8::EpiBf16P E{(pg8::bf16_t*)(wsb + WS_Y), DM};
              pg8::gemm_phase<pg8::EpiBf16P, pg8::LockstepOrder, PG8_ALIGNV, PG8_SP2V>(lds, g, S, E); }
            if (lc != 3) { pg8::Gemm g{(const pg8::bf16_t*)(wsb + WS_CC) + (size_t)MLAT * MIXW, (const pg8::bf16_t*)(wsb + WS_WO_C) + (size_t)p * DM * MIXW, MTOT - MLAT, DM, MIXW / 8, MIXW}; pg8::SplitKOrder S; S.init(MTOT - MLAT, DM, 8, G, (int)blockIdx.x);
              pg8::EpiF32 E{(float*)(wsb + WS_YP), DM, (size_t)(MTOT - MLAT) * DM};
              pg8::gemm_phase<pg8::EpiF32, pg8::SplitKOrder, PG8_ALIGNV, PG8_SP2V>(lds, g, S, E); }
        } SEAM(pb + 11);
        if (EN_NORM && IN(pb + 12)) REPS(pb + 12) { norm_phase(kargs(), lc, lc + 1, G); } SEAM(pb + 12);
    }
#undef IN
#undef SEAM
__global__ void __launch_bounds__(NWAVES * 64, 2) fwd(Args a) {
    extern __shared__ __attribute__((aligned(16))) unsigned char lds_raw[];
    LAS unsigned char* lds = (LAS unsigned char*)lds_raw;
    int tid_l = threadIdx.x; asm volatile("" : "+v"(tid_l)); const int tid = tid_l, G = gridDim.x;
    for (int u = tid; u < (LDS_BYTES - LDSCTL_OFF) / 4; u += NWAVES * 64) ((LAS unsigned*)(lds + LDSCTL_OFF))[u] = 0u;
    __syncthreads();
    XcdBarrier bar; bar.bar = (unsigned*)(a.ws + WS_CTL) + CW_BAR; bar.x = 0; bar.st = nullptr;
    if (MK_ONE_LAUNCH) bar = xcd_barrier_post((unsigned*)(a.ws + WS_CTL) + CW_BAR, (volatile LAS unsigned*)(lds + MISC_OFF));
    const int lo = a.ph_lo, hi = a.ph_hi;
#define IN(k) (lo <= (k) && (k) < hi)
#define SEAM(k) do { if (IN(k) && IN((k) + 1)) xcd_barrier(bar); } while (0)
    if (EN_P0 && IN(0)) REPS(0) { p0_prologue(kargs(), lds, G); } SEAM(0);
    if (EN_NORM && IN(1)) REPS(1) { norm_phase(kargs(), -1, 0, G); } SEAM(1);
    layer_pair<0>(lds, G, lo, hi, bar);
    layer_pair<1>(lds, G, lo, hi, bar);
#undef IN
#undef SEAM
}

extern "C" void kernel_launch(void* const* d_in, const int* in_sizes, int n_in, void* d_out, int out_size, void* d_ws, size_t ws_size, hipStream_t stream) {
    static int grid = 0;
    if (grid == 0) {
        if (n_in != 22 || out_size != MLAT * DM || ws_size < WS_END) { fprintf(stderr, "kernel_launch: unexpected shapes (n_in %d, out %d, ws %zu, need %zu)\n", n_in, out_size, ws_size, (size_t)WS_END); grid = -1; return; }
        int dev = 0, cus = 0, per_cu = 0;
        if (hipGetDevice(&dev) != hipSuccess || hipDeviceGetAttribute(&cus, hipDeviceAttributeMultiprocessorCount, dev) != hipSuccess) { grid = -1; return; }
        if (hipFuncSetAttribute((const void*)fwd, hipFuncAttributeMaxDynamicSharedMemorySize, LDS_BYTES) != hipSuccess) { fprintf(stderr, "kernel_launch: hipFuncSetAttribute failed\n"); grid = -1; return; }
        if (hipOccupancyMaxActiveBlocksPerMultiprocessor(&per_cu, (const void*)fwd, NWAVES * 64, LDS_BYTES) != hipSuccess || per_cu < 1) fprintf(stderr, "kernel_launch: occupancy query reports %d\n", per_cu);
        (void)hipGetLastError();
        grid = cus;
    }
    if (grid < 0) return;
    (void)hipMemsetAsync((char*)d_ws + WS_CTL, 0, 65536, stream);
    Args a{};
    for (int i = 0; i < 22; ++i) a.in[i] = (const float*)d_in[i];
    a.out = (float*)d_out; a.ws = (unsigned char*)d_ws;
#if MK_ONE_LAUNCH
    a.ph_lo = 0; a.ph_hi = N_PHASES;
    hipLaunchKernelGGL(fwd, dim3(grid), dim3(NWAVES * 64), LDS_BYTES, stream, a);
#else
    for (int p = 0; p < N_PHASES; ++p) { a.ph_lo = p; a.ph_hi = p + 1; hipLaunchKernelGGL(fwd, dim3(grid), dim3(NWAVES * 64), LDS_BYTES, stream, a); }
#endif
}
```

```cpp
#include <hip/hip_runtime.h>
#include <cstdio>
#include <cstdint>
namespace pg8 {
#define PG8_LAS __attribute__((address_space(3)))
typedef unsigned short bf16_t;
typedef short bf16x8 __attribute__((ext_vector_type(8)));
typedef float f32x4 __attribute__((ext_vector_type(4)));
typedef unsigned u32x4 __attribute__((ext_vector_type(4)));
constexpr int BM = 256, BK = 64, HALF = 128, HTB = HALF * BK * 2  , STAGE_BYTES = 8 * HTB, NXCD = 8, WGM = 4;

__host__ __device__ __forceinline__ int lds_byte(int r, int c) { const int st = (r >> 4) * 2 + (c >> 5), rr = r & 15, cc = c & 31, ob = rr * 64 + cc * 2; return st * 1024 + (ob ^ (((ob >> 9) & 1) << 5)); }
__host__ __device__ __forceinline__ void stage_rc(int b, int& R, int& C) { const int st = b / 1024, sb = b % 1024, swz = sb ^ (((sb >> 9) & 1) << 5); R = (st >> 1) * 16 + swz / 64; C = (st & 1) * 32 + (swz % 64) / 2; }
__host__ __device__ __forceinline__ int perm32(int rho) { const int n = rho >> 4, i = rho & 15; return 8 * (i >> 2) + 4 * n + (i & 3); }

struct Unit { int pm, pn, kc; };
struct Gemm { const bf16_t* A; const bf16_t* Bt; int M, N, K, ld; };

struct StaticOrder {
    int nM, nN, nwg, G, c;
    __host__ __device__ void init(int M, int N, int G_, int c_) { nM = M / BM; nN = N / BM; nwg = nM * nN; G = G_; c = c_; }
    __host__ __device__ bool next(int i, Unit& u) const {
        const long L = (long)i * G + c; if (L >= nwg) return false;
        int wgid = (int)L; { const int q = nwg / NXCD, r = nwg % NXCD, xcd = wgid % NXCD, off = wgid / NXCD; wgid = (xcd < r ? xcd * (q + 1) : r * (q + 1) + (xcd - r) * q) + off; }
        const int nig = WGM * nN, gid = wgid / nig, fm = gid * WGM, gsz = (nM - fm) < WGM ? (nM - fm) : WGM;
        u.pm = fm + ((wgid % nig) % gsz); u.pn = (wgid % nig) / gsz; u.kc = 0; return true;
    }
    __device__ __forceinline__ void a_ready(const Unit&) const {}
    __device__ __forceinline__ void done(const Unit&) const {}
};
struct LockstepOrder {
    static constexpr int LW = 4;
    int nM, nN, G, c, x, k, nk, PG, r0, gR, qR, rR, lenx;
    __host__ __device__ void init(int M, int N, int G_, int c_) { nM = M / BM; nN = N / BM; G = G_; c = c_; x = c_ % NXCD; k = c_ / NXCD; nk = G_ / NXCD; PG = (nM / LW) / NXCD; r0 = PG * NXCD * LW; gR = nM - r0;
        const int rem = gR * nN; qR = rem / NXCD; rR = rem % NXCD; lenx = PG * LW * nN + qR + (x < rR ? 1 : 0); }
    __host__ __device__ bool next(int i, Unit& u) const {
        if (G % NXCD != 0) { const long L = (long)i * G + c; if (L >= (long)nM * nN) return false; u.kc = 0; u.pm = (int)(L / nN); u.pn = (int)(L % nN); return true; }
        const int off = i * nk + k; if (off >= lenx) return false; u.kc = 0;
        const int lock = PG * LW * nN;
        if (off < lock) { const int j = off / (LW * nN), o2 = off % (LW * nN); u.pm = (j * NXCD + x) * LW + o2 % LW; u.pn = o2 / LW; }
        else { const int rho = (x < rR ? x * (qR + 1) : rR * (qR + 1) + (x - rR) * qR) + (off - lock); u.pm = r0 + rho % gR; u.pn = rho / gR; }
        return true;
    }
    __device__ __forceinline__ void a_ready(const Unit&) const {}
    __device__ __forceinline__ void done(const Unit&) const {}
};
struct SplitKOrder {
    int nM, nN, KS, nwg, G, c;
    __host__ __device__ void init(int M, int N, int KS_, int G_, int c_) { nM = M / BM; nN = N / BM; KS = KS_; nwg = nM * nN * KS; G = G_; c = c_; }
    __host__ __device__ bool next(int i, Unit& u) const { const long L = (long)i * G + c; if (L >= nwg) return false; const int l = (int)L; u.kc = l % KS; u.pn = (l / KS) % nN; u.pm = l / (KS * nN); return true; }
    __device__ __forceinline__ void a_ready(const Unit&) const {}
    __device__ __forceinline__ void done(const Unit&) const {}
};

typedef float f32x2 __attribute__((ext_vector_type(2)));
typedef __bf16 bf16x2_c __attribute__((ext_vector_type(2)));
__device__ __forceinline__ unsigned cvt_pk_bf16(float lo, float hi) { const f32x2 v = {lo, hi}; const bf16x2_c b = __builtin_convertvector(v, bf16x2_c); return __builtin_bit_cast(unsigned, b); }
__device__ __forceinline__ f32x2 gelu_pk(f32x2 v) {
    const f32x2 av = __builtin_elementwise_abs(v), d = av * 0.2316418882f + 1.0f;
    f32x2 t; t.x = __builtin_amdgcn_rcpf(d.x); t.y = __builtin_amdgcn_rcpf(d.y);
    f32x2 q = t * 0.5307027145f + (-0.7265760135f); q = q * t + 0.7107068705f; q = q * t + (-0.142248368f); q = q * t + 0.127414796f; q = q * t;
    const f32x2 s = (v * v) * (-0.72134752044f);
    f32x2 e; e.x = __builtin_amdgcn_exp2f(s.x); e.y = __builtin_amdgcn_exp2f(s.y);
    const f32x2 m = v * (q * e), r = v - m;
    f32x2 o; o.x = v.x < 0.f ? m.x : r.x; o.y = v.y < 0.f ? m.y : r.y; return o;
}

typedef unsigned u32x2 __attribute__((ext_vector_type(2)));
__device__ __forceinline__ float silu_f(float x) { return x * __builtin_amdgcn_rcpf(1.0f + __builtin_amdgcn_exp2f(-1.4426950408889634f * x)); }
__device__ __forceinline__ float sigmoid_neg_f(float x) { return __builtin_amdgcn_rcpf(1.0f + __builtin_amdgcn_exp2f(1.4426950408889634f * x)); }
__device__ __forceinline__ f32x4 act4(f32x4 v, int act) {
    if (act == 1) { v[0] = silu_f(v[0]); v[1] = silu_f(v[1]); v[2] = silu_f(v[2]); v[3] = silu_f(v[3]); }
    else if (act == 2) { const f32x2 a = gelu_pk((f32x2){v[0], v[1]}), b = gelu_pk((f32x2){v[2], v[3]}); v = (f32x4){a.x, a.y, b.x, b.y}; }
    return v;
}
struct EpiF32 {
    static constexpr bool PERM = false, AFTER_DRAIN = false;
    float* C0; int ldc; size_t kstride;
    __device__ __forceinline__ void operator()(const f32x4 (&acc)[2][2][4][2], const Unit& u, int wr, int wc, int fr, int fq) const {
        float* C = C0 + (size_t)u.kc * kstride;
        const int row0 = u.pm * BM + wr * 64 + fr, col0 = u.pn * BM + wc * 32 + 4 * fq;
#pragma unroll
        for (int ai = 0; ai < 2; ++ai)
#pragma unroll
            for (int m = 0; m < 4; ++m) { float* rowp = C + (size_t)(row0 + ai * HALF + m * 16) * ldc + col0;
#pragma unroll
                for (int bj = 0; bj < 2; ++bj)
#pragma unroll
                    for (int n = 0; n < 2; ++n) *(f32x4*)(rowp + bj * HALF + n * 16) = acc[ai][bj][m][n]; }
    }
};
struct EpiBf16P {
    static constexpr bool PERM = true, AFTER_DRAIN = false;
    bf16_t* O; int ldc;
    __device__ __forceinline__ void operator()(const f32x4 (&acc)[2][2][4][2], const Unit& u, int wr, int wc, int fr, int fq) const {
        const int row0 = u.pm * BM + wr * 64 + fr, col0 = u.pn * BM + wc * 32 + 8 * fq;
#pragma unroll
        for (int ai = 0; ai < 2; ++ai)
#pragma unroll
            for (int m = 0; m < 4; ++m) { bf16_t* rowp = O + (size_t)(row0 + ai * HALF + m * 16) * ldc + col0;
#pragma unroll
                for (int bj = 0; bj < 2; ++bj) { const f32x4 v0 = acc[ai][bj][m][0], v1 = acc[ai][bj][m][1];
                    u32x4 w; w.x = cvt_pk_bf16(v0[0], v0[1]); w.y = cvt_pk_bf16(v0[2], v0[3]); w.z = cvt_pk_bf16(v1[0], v1[1]); w.w = cvt_pk_bf16(v1[2], v1[3]);
                    *(u32x4*)(rowp + bj * HALF) = w; } }
    }
};
struct EpiAB1 {
    static constexpr bool PERM = true, AFTER_DRAIN = false;
    bf16_t* O; int ldc;
    __device__ __forceinline__ void operator()(const f32x4 (&acc)[2][2][4][2], const Unit& u, int wr, int wc, int fr, int fq) const {
        const int act = u.pn < 7 ? 0 : ((u.pn < 23 || u.pn >= 55) ? 1 : 2);
        const int row0 = u.pm * BM + wr * 64 + fr, col0 = u.pn * BM + wc * 32 + 8 * fq;
#pragma unroll
        for (int ai = 0; ai < 2; ++ai)
#pragma unroll
            for (int m = 0; m < 4; ++m) { bf16_t* rowp = O + (size_t)(row0 + ai * HALF + m * 16) * ldc + col0;
#pragma unroll
                for (int bj = 0; bj < 2; ++bj) { const f32x4 v0 = act4(acc[ai][bj][m][0], act), v1 = act4(acc[ai][bj][m][1], act);
                    u32x4 w; w.x = cvt_pk_bf16(v0[0], v0[1]); w.y = cvt_pk_bf16(v0[2], v0[3]); w.z = cvt_pk_bf16(v1[0], v1[1]); w.w = cvt_pk_bf16(v1[2], v1[3]);
                    *(u32x4*)(rowp + bj * HALF) = w; } }
    }
};
struct EpiC1 {
    static constexpr bool PERM = true, AFTER_DRAIN = false;
    bf16_t* O; size_t stride; const float* oml;
    __device__ __forceinline__ void operator()(const f32x4 (&acc)[2][2][4][2], const Unit& u, int wr, int wc, int fr, int fq) const {
        const int region = u.pn >> 5; bf16_t* base = O + (size_t)region * stride;
        const int row0 = u.pm * BM + wr * 64 + fr, col0 = (u.pn & 31) * BM + wc * 32 + 8 * fq;
        const bool gate = (region == 1 || region == 2); const int act = (region == 0 || region == 4) ? 1 : 0;
        f32x4 gv[2][2];
#pragma unroll
        for (int bj = 0; bj < 2; ++bj)
#pragma unroll
            for (int n = 0; n < 2; ++n) gv[bj][n] = gate ? *(const f32x4*)(oml + (size_t)(region - 1) * 8192 + col0 + bj * HALF + 4 * n) : (f32x4){1.f, 1.f, 1.f, 1.f};
#pragma unroll
        for (int ai = 0; ai < 2; ++ai)
#pragma unroll
            for (int m = 0; m < 4; ++m) { bf16_t* rowp = base + (size_t)(row0 + ai * HALF + m * 16) * 8192 + col0;
#pragma unroll
                for (int bj = 0; bj < 2; ++bj) { f32x4 v0 = acc[ai][bj][m][0], v1 = acc[ai][bj][m][1];
                    if (gate) {
#pragma unroll
                        for (int j = 0; j < 4; ++j) { v0[j] = gv[bj][0][j] * sigmoid_neg_f(v0[j]); v1[j] = gv[bj][1][j] * sigmoid_neg_f(v1[j]); } }
                    else { v0 = act4(v0, act); v1 = act4(v1, act); }
                    u32x4 w; w.x = cvt_pk_bf16(v0[0], v0[1]); w.y = cvt_pk_bf16(v0[2], v0[3]); w.z = cvt_pk_bf16(v1[0], v1[1]); w.w = cvt_pk_bf16(v1[2], v1[3]);
                    *(u32x4*)(rowp + bj * HALF) = w; } }
    }
};
struct EpiQ {
    static constexpr bool PERM = true, AFTER_DRAIN = false;
    bf16_t* O; const f32x2* rope; int nlat; float qscale;
    __device__ __forceinline__ void operator()(const f32x4 (&acc)[2][2][4][2], const Unit& u, int wr, int wc, int fr, int fq) const {
        const int row0 = u.pm * BM + wr * 64 + fr; const bool upper = fq >= 2;
#pragma unroll
        for (int bj = 0; bj < 2; ++bj) {
            const int G = 8 * u.pn + 4 * bj + wc, hm = G % 6, col = u.pn * BM + bj * HALF + wc * 32 + 8 * fq;
#pragma unroll
            for (int ai = 0; ai < 2; ++ai)
#pragma unroll
                for (int m = 0; m < 4; ++m) { const int row = row0 + ai * HALF + m * 16; f32x4 x0 = acc[ai][bj][m][0], x1 = acc[ai][bj][m][1];
                    if (hm >= 4 && u.pm * BM < nlat) {
                        const int t = row & 8191, pos = (hm == 4) ? (t >> 6) : (t & 63); const f32x2* cs = rope + pos * 16 + 8 * (fq & 1);
#pragma unroll
                        for (int j = 0; j < 4; ++j) {
                            { auto rr = __builtin_amdgcn_permlane32_swap(__float_as_uint(x0[j]), __float_as_uint(x0[j]), false, false); const float pv = __uint_as_float(upper ? rr[0] : rr[1]); const f32x2 c = cs[j];
                              x0[j] = upper ? x0[j] * c.x + pv * c.y : x0[j] * c.x - pv * c.y; }
                            { auto rr = __builtin_amdgcn_permlane32_swap(__float_as_uint(x1[j]), __float_as_uint(x1[j]), false, false); const float pv = __uint_as_float(upper ? rr[0] : rr[1]); const f32x2 c = cs[4 + j];
                              x1[j] = upper ? x1[j] * c.x + pv * c.y : x1[j] * c.x - pv * c.y; } } }
                    x0 = x0 * qscale; x1 = x1 * qscale;
                    u32x4 w; w.x = cvt_pk_bf16(x0[0], x0[1]); w.y = cvt_pk_bf16(x0[2], x0[3]); w.z = cvt_pk_bf16(x1[0], x1[1]); w.w = cvt_pk_bf16(x1[2], x1[3]);
                    *(u32x4*)(O + (size_t)row * 6144 + col) = w; }
        }
    }
};
struct EpiKV {
    static constexpr bool PERM = true, AFTER_DRAIN = false;
    bf16_t* KN; bf16_t* V; int mtot;
    __device__ __forceinline__ void operator()(const f32x4 (&acc)[2][2][4][2], const Unit& u, int wr, int wc, int fr, int fq) const {
        const int row0 = u.pm * BM + wr * 64 + fr, colh = wc * 32 + 8 * fq;
#pragma unroll
        for (int ai = 0; ai < 2; ++ai)
#pragma unroll
            for (int m = 0; m < 4; ++m) { const size_t off = ((size_t)u.pn * mtot + (size_t)(row0 + ai * HALF + m * 16)) * 128 + colh;
#pragma unroll
                for (int bj = 0; bj < 2; ++bj) { const f32x4 v0 = acc[ai][bj][m][0], v1 = acc[ai][bj][m][1];
                    u32x4 w; w.x = cvt_pk_bf16(v0[0], v0[1]); w.y = cvt_pk_bf16(v0[2], v0[3]); w.z = cvt_pk_bf16(v1[0], v1[1]); w.w = cvt_pk_bf16(v1[2], v1[3]);
                    *(u32x4*)((bj ? V : KN) + off) = w; } }
    }
};

template <class Epi, class Sched, bool ALIGN_EPI = false, bool SP2 = false>
__device__ __forceinline__ void gemm_phase(PG8_LAS unsigned char* lds, const Gemm g, const Sched& S, const Epi& E) {
    int tid_l = threadIdx.x; asm volatile("" : "+v"(tid_l)); const int tid = tid_l, wid = __builtin_amdgcn_readfirstlane(tid >> 6), lane = tid & 63, wr = wid >> 2, wc = wid & 3, fr = lane & 15, fq = lane >> 4;
    const int K = g.ld, nt = g.K / BK;
    unsigned voffA[2], voffB[2];
#pragma unroll
    for (int i = 0; i < 2; ++i) { int R, C; stage_rc(tid * 16 + i * 8192, R, C); const int Rb = Epi::PERM ? ((R & ~31) + perm32(R & 31)) : R;
        voffA[i] = (unsigned)(R * K + C) * 2u; voffB[i] = (unsigned)(Rb * K + C) * 2u; }
    const size_t kstep = (size_t)(BK * 2);
    const size_t hstep = (size_t)HALF * K * 2;
    const size_t tstep = 2 * hstep;
    const unsigned ldsw = (unsigned)wid * 1024u;
    const int aoff = lds_byte(wr * 64 + fr, fq * 8), boff = lds_byte(wc * 32 + fr, fq * 8);
#define PG8_SA(b, h) (((b) * 2 + (h)) * HTB)
#define PG8_SB(b, h) ((4 + (b) * 2 + (h)) * HTB)
#define PG8_STAGE(bufoff, gbase, voff) do { const char* gb_ = (const char*)(gbase); asm volatile("" : "+s"(gb_)); _Pragma("unroll") for (int _i = 0; _i < 2; ++_i) { unsigned vo_ = (voff)[_i]; asm volatile("" : "+v"(vo_)); \
        __builtin_amdgcn_global_load_lds((const unsigned*)(gb_ + vo_), (PG8_LAS unsigned*)(lds + (bufoff) + ldsw + _i * 8192), 16, 0, 0); } } while (0)
#define PG8_LDA(dst, b, h) do { _Pragma("unroll") for (int m = 0; m < 4; ++m) _Pragma("unroll") for (int k = 0; k < 2; ++k) dst[m][k] = *(const PG8_LAS bf16x8*)(lds + PG8_SA(b, h) + aoff + m * 2048 + k * 1024); } while (0)
#define PG8_LDB(dst, b, h) do { _Pragma("unroll") for (int n = 0; n < 2; ++n) _Pragma("unroll") for (int k = 0; k < 2; ++k) dst[n][k] = *(const PG8_LAS bf16x8*)(lds + PG8_SB(b, h) + boff + n * 2048 + k * 1024); } while (0)
#define PG8_MMA(ai, bj, At, Bt) do { __builtin_amdgcn_sched_barrier(0); _Pragma("unroll") for (int m = 0; m < 4; ++m) _Pragma("unroll") for (int n = 0; n < 2; ++n) _Pragma("unroll") for (int k = 0; k < 2; ++k) \
        acc[ai][bj][m][n] = __builtin_amdgcn_mfma_f32_16x16x32_bf16(Bt[n][k], At[m][k], acc[ai][bj][m][n], 0, 0, 0); __builtin_amdgcn_sched_barrier(0); } while (0)
#define PG8_WAIT_V(n) asm volatile("s_waitcnt vmcnt(" #n ")" ::: "memory")
#define PG8_WAIT_L(n) asm volatile("s_waitcnt lgkmcnt(" #n ")" ::: "memory")
#define PG8_BAR __builtin_amdgcn_s_barrier()
#define PG8_SCHED __builtin_amdgcn_sched_barrier(0)
    if (wr == 0) __builtin_amdgcn_s_setprio(1);
    Unit cur, nxt; int ui = 0;
    if (!S.next(0, cur)) { __builtin_amdgcn_s_setprio(0); return; }
    f32x4 acc[2][2][4][2];
#pragma unroll
    for (int a = 0; a < 2; ++a)
#pragma unroll
        for (int b = 0; b < 2; ++b)
#pragma unroll
            for (int m = 0; m < 4; ++m)
#pragma unroll
                for (int n = 0; n < 2; ++n) acc[a][b][m][n] = (f32x4){0.f, 0.f, 0.f, 0.f};
    bf16x8 At[4][2], B0[2][2], B1[2][2];
    const size_t kcb = (size_t)g.K * 2;
    const char* cA = (const char*)g.A + (size_t)cur.pm * tstep + cur.kc * kcb; const char* cB = (const char*)g.Bt + (size_t)cur.pn * tstep + cur.kc * kcb;
    S.a_ready(cur);
    if constexpr (SP2) {
        PG8_STAGE(PG8_SB(0, 0), cB, voffB); PG8_STAGE(PG8_SB(0, 1), cB + hstep, voffB); PG8_STAGE(PG8_SA(0, 0), cA, voffA); PG8_STAGE(PG8_SA(0, 1), cA + hstep, voffA);
        if (wr == 1) PG8_BAR;
        PG8_WAIT_V(2); PG8_BAR;
        PG8_STAGE(PG8_SB(1, 0), cB + kstep, voffB); PG8_STAGE(PG8_SA(1, 0), cA + kstep, voffA); PG8_STAGE(PG8_SB(1, 1), cB + hstep + kstep, voffB);
        PG8_WAIT_V(6); PG8_BAR;
    } else {
        PG8_STAGE(PG8_SB(0, 0), cB, voffB); PG8_STAGE(PG8_SA(0, 0), cA, voffA); PG8_STAGE(PG8_SB(0, 1), cB + hstep, voffB); PG8_STAGE(PG8_SA(0, 1), cA + hstep, voffA);
        if (wr == 1) PG8_BAR;
        PG8_WAIT_V(4); PG8_BAR;
        PG8_STAGE(PG8_SB(1, 0), cB + kstep, voffB); PG8_STAGE(PG8_SA(1, 0), cA + kstep, voffA); PG8_STAGE(PG8_SB(1, 1), cB + hstep + kstep, voffB);
        PG8_WAIT_V(6); PG8_BAR;
    }
    for (;;) {
        const bool has_next = S.next(ui + 1, nxt);
        const char* nA = has_next ? (const char*)g.A + (size_t)nxt.pm * tstep + nxt.kc * kcb : cA; const char* nB = has_next ? (const char*)g.Bt + (size_t)nxt.pn * tstep + nxt.kc * kcb : cB;
        for (int t = 0; t < nt; t += 2) {
            const bool last = (t == nt - 2);
            const char* a1 = cA + (size_t)(t + 1) * kstep;
            const char* a2 = last ? nA : cA + (size_t)(t + 2) * kstep; const char* b2 = last ? nB : cB + (size_t)(t + 2) * kstep;
            const char* a3 = a2 + kstep; const char* b3 = b2 + kstep;
            if (last && has_next) S.a_ready(nxt);
            if constexpr (SP2) {
            PG8_LDB(B0, 0, 0); PG8_LDB(B1, 0, 1); PG8_SCHED; PG8_LDA(At, 0, 0); PG8_STAGE(PG8_SA(1, 1), a1 + hstep, voffA);
            PG8_WAIT_V(8); PG8_WAIT_L(0); PG8_BAR; PG8_MMA(0, 0, At, B0); PG8_MMA(0, 1, At, B1); PG8_BAR; PG8_SCHED;
            PG8_LDA(At, 0, 1); PG8_STAGE(PG8_SB(0, 0), b2, voffB); PG8_STAGE(PG8_SB(0, 1), b2 + hstep, voffB); PG8_STAGE(PG8_SA(0, 0), a2, voffA);
            PG8_WAIT_V(8); PG8_WAIT_L(0); PG8_BAR; PG8_MMA(1, 0, At, B0); PG8_MMA(1, 1, At, B1); PG8_BAR; PG8_SCHED;
            PG8_LDB(B0, 1, 0); PG8_LDB(B1, 1, 1); PG8_SCHED; PG8_LDA(At, 1, 0); PG8_STAGE(PG8_SA(0, 1), a2 + hstep, voffA);
            PG8_WAIT_V(8); PG8_WAIT_L(0); PG8_BAR; PG8_MMA(0, 0, At, B0); PG8_MMA(0, 1, At, B1); PG8_BAR; PG8_SCHED;
            PG8_LDA(At, 1, 1); PG8_STAGE(PG8_SB(1, 0), b3, voffB); PG8_STAGE(PG8_SB(1, 1), b3 + hstep, voffB); PG8_STAGE(PG8_SA(1, 0), a3, voffA);
            PG8_WAIT_V(8); PG8_WAIT_L(0); PG8_BAR; PG8_MMA(1, 0, At, B0); PG8_MMA(1, 1, At, B1); PG8_BAR; PG8_SCHED;
            } else {
            PG8_LDB(B0, 0, 0); PG8_SCHED; PG8_LDA(At, 0, 0); PG8_STAGE(PG8_SA(1, 1), a1 + hstep, voffA);
            PG8_WAIT_L(8); PG8_BAR; PG8_WAIT_L(0); PG8_MMA(0, 0, At, B0); PG8_BAR; PG8_SCHED;
            PG8_LDB(B1, 0, 1); PG8_STAGE(PG8_SB(0, 0), b2, voffB);
            PG8_BAR; PG8_WAIT_L(0); PG8_MMA(0, 1, At, B1); PG8_BAR;
            PG8_LDA(At, 0, 1); PG8_STAGE(PG8_SA(0, 0), a2, voffA);
            PG8_BAR; PG8_WAIT_L(0); PG8_MMA(1, 0, At, B0); PG8_BAR; PG8_SCHED;
            PG8_STAGE(PG8_SB(0, 1), b2 + hstep, voffB);
            PG8_WAIT_V(6); PG8_BAR; PG8_MMA(1, 1, At, B1); PG8_BAR;
            PG8_LDB(B0, 1, 0); PG8_SCHED; PG8_LDA(At, 1, 0); PG8_STAGE(PG8_SA(0, 1), a2 + hstep, voffA);
            PG8_WAIT_L(8); PG8_BAR; PG8_WAIT_L(0); PG8_MMA(0, 0, At, B0); PG8_BAR; PG8_SCHED;
            PG8_LDB(B1, 1, 1); PG8_STAGE(PG8_SB(1, 0), b3, voffB);
            PG8_BAR; PG8_WAIT_L(0); PG8_MMA(0, 1, At, B1); PG8_BAR;
            PG8_LDA(At, 1, 1); PG8_STAGE(PG8_SA(1, 0), a3, voffA);
            PG8_BAR; PG8_WAIT_L(0); PG8_MMA(1, 0, At, B0); PG8_BAR; PG8_SCHED;
            PG8_STAGE(PG8_SB(1, 1), b3 + hstep, voffB);
            PG8_WAIT_V(6); PG8_BAR; PG8_MMA(1, 1, At, B1); PG8_BAR;
            }
        }
        if constexpr (ALIGN_EPI) { if (wr == 0) PG8_BAR; }
        if constexpr (!Epi::AFTER_DRAIN) { E(acc, cur, wr, wc, fr, fq); S.done(cur); }
        if (!has_next) break;
#pragma unroll
        for (int a = 0; a < 2; ++a)
#pragma unroll
            for (int b = 0; b < 2; ++b)
#pragma unroll
                for (int m = 0; m < 4; ++m)
#pragma unroll
                    for (int n = 0; n < 2; ++n) acc[a][b][m][n] = (f32x4){0.f, 0.f, 0.f, 0.f};
        cur = nxt; cA = nA; cB = nB; ++ui;
        if constexpr (ALIGN_EPI) { if (wr == 1) PG8_BAR; }
    }
    PG8_WAIT_V(0);
    if constexpr (!ALIGN_EPI) { if (wr == 0) PG8_BAR; }
    PG8_BAR;
    if constexpr (Epi::AFTER_DRAIN) { E.fused(acc, cur, wr, wc, fr, fq, lds, wid, lane); S.done(cur); }
    __builtin_amdgcn_s_setprio(0);
#undef PG8_SA
#undef PG8_SB
#undef PG8_STAGE
#undef PG8_LDA
#undef PG8_LDB
#undef PG8_MMA
#undef PG8_WAIT_V
#undef PG8_WAIT_L
#undef PG8_BAR
#undef PG8_SCHED
}
}
#define GAS __attribute__((address_space(1)))
#define LAS __attribute__((address_space(3)))
typedef unsigned short bf16;
typedef unsigned v4u __attribute__((ext_vector_type(4)));
typedef float f32x4 __attribute__((ext_vector_type(4)));
typedef short bf16x8 __attribute__((ext_vector_type(8)));
typedef GAS unsigned gu32;
typedef GAS unsigned long long gu64;
#define RLX_AGENT __ATOMIC_RELAXED, __HIP_MEMORY_SCOPE_AGENT
#define LDS_WAIT() asm volatile("s_waitcnt lgkmcnt(0)" ::: "memory")
#define VM_WAIT() asm volatile("s_waitcnt vmcnt(0)" ::: "memory")
__device__ __forceinline__ unsigned long long rt() { return __builtin_amdgcn_s_memrealtime(); }
__device__ __forceinline__ unsigned f2bf(float f) { unsigned u = __builtin_bit_cast(unsigned, f); return (u + 0x7fffu + ((u >> 16) & 1u)) >> 16; }
__device__ __forceinline__ unsigned pk2(float lo, float hi) { return f2bf(lo) | (f2bf(hi) << 16); }

typedef unsigned u32x2 __attribute__((ext_vector_type(2)));
typedef float f32x2 __attribute__((ext_vector_type(2)));
#define XB_TMO      128
#define XB_XCNT(j)  (256  + 64 * (j))
#define XB_XSUB(j)  (1280 + 64 * (j))
#define XB_XGEN(j)  (2304 + 64 * (j))
#define XB_TOP      3328
#define XB_TOPGEN   3392
#define XCD_BAR_WORDS 3456
#define XB_SPIN_CAP (1u << 21)

__device__ __forceinline__ unsigned xb_ld(unsigned* p)              { return __hip_atomic_load(p, __ATOMIC_RELAXED, __HIP_MEMORY_SCOPE_AGENT); }
__device__ __forceinline__ unsigned xb_add(unsigned* p, unsigned v) { return __hip_atomic_fetch_add(p, v, __ATOMIC_RELAXED, __HIP_MEMORY_SCOPE_AGENT); }
__device__ __forceinline__ unsigned xb_xcc_id() { return (unsigned)__builtin_amdgcn_s_getreg((3 << 11) | 20) & 0xFu; }
#define XB_SPIN(cond, bar) do { unsigned _sp = 0; while (cond) { __builtin_amdgcn_s_sleep(1); \
    if ((++_sp & 255u) == 0u) { if (xb_ld(&(bar)[XB_TMO])) break; if (_sp > XB_SPIN_CAP) { atomicAdd(&(bar)[XB_TMO], 1u); break; } } } } while (0)

struct XcdBarrier {
    unsigned* bar; unsigned x;
    volatile LAS unsigned* st;
};

__device__ __forceinline__ XcdBarrier xcd_barrier_post(unsigned* bar, volatile LAS unsigned* st) {
    XcdBarrier b; b.bar = bar; b.x = xb_xcc_id(); b.st = st;
    if (threadIdx.x == 0) (void)xb_add(&bar[XB_XCNT(b.x)], 1u);
    return b;
}
__device__ __forceinline__ void xcd_barrier_complete(unsigned* bar, unsigned x, unsigned& nloc, unsigned& nx) {
    const unsigned G = gridDim.x * gridDim.y * gridDim.z;
    unsigned sum, cnt, mine, sp = 0u;
    for (;;) {
        sum = 0u; cnt = 0u; mine = 0u;
#pragma unroll
        for (unsigned j = 0; j < 16; ++j) { const unsigned c = xb_ld(&bar[XB_XCNT(j)]); sum += c; cnt += (c > 0u) ? 1u : 0u; mine = (j == x) ? c : mine; }
        if (sum == G) break;
        __builtin_amdgcn_s_sleep(1);
        if ((++sp & 255u) == 0u) { if (xb_ld(&bar[XB_TMO])) break; if (sp > XB_SPIN_CAP) { atomicAdd(&bar[XB_TMO], 1u); break; } }
    }
    nloc = mine > 0u ? mine : 1u; nx = cnt > 0u ? cnt : 1u;
}

__device__ __forceinline__ void xcd_barrier(const XcdBarrier& b) {
    asm volatile("s_waitcnt vmcnt(0)" ::: "memory");
    __syncthreads();
    if (threadIdx.x == 0) {
        unsigned* bar = b.bar;
        __builtin_amdgcn_s_waitcnt(0);
        unsigned nloc = b.st[0], nx = b.st[1];
        if (nloc == 0u) { xcd_barrier_complete(bar, b.x, nloc, nx); b.st[0] = nloc; b.st[1] = nx; }
        const unsigned old = xb_add(&bar[XB_XSUB(b.x)], 1u);
        const unsigned gen = old / nloc;
        if (old + 1u == (gen + 1u) * nloc) {
            __builtin_amdgcn_fence(__ATOMIC_RELEASE, "agent");
            asm volatile("s_waitcnt vmcnt(0)" ::: "memory");
            const unsigned og = xb_add(&bar[XB_TOP], 1u);
            const unsigned tg = og / nx;
            if (og + 1u == (tg + 1u) * nx) xb_add(&bar[XB_TOPGEN], 1u);
            else XB_SPIN(xb_ld(&bar[XB_TOPGEN]) == tg, bar);
            __builtin_amdgcn_fence(__ATOMIC_ACQUIRE, "agent");
            xb_add(&bar[XB_XGEN(b.x)], 1u);
            asm volatile("s_waitcnt vmcnt(0)" ::: "memory");
        } else {
            XB_SPIN(xb_ld(&bar[XB_XGEN(b.x)]) == gen, bar);
            __builtin_amdgcn_fence(__ATOMIC_ACQUIRE, "agent");
            asm volatile("s_waitcnt vmcnt(0)" ::: "memory");
        }
    }
    __syncthreads();
}


#ifndef NT_STREAMS
#define NT_STREAMS 1
#endif
#if NT_STREAMS
#define LDNT(p) __builtin_nontemporal_load(p)
#define STNT(p, v) __builtin_nontemporal_store((v), (p))
#else
#define LDNT(p) (*(p))
#define STNT(p, v) (*(p) = (v))
#endif
constexpr int NWAVES = 8;
constexpr int DM = 4096, NBATCH = 2, SEQ = 8192, NCTX = 256;
constexpr int MLAT = NBATCH * SEQ;
constexpr int MTOT = MLAT + NBATCH * NCTX;
constexpr int N_AB = 18176;
constexpr int N_ABSRC = 17984, N_C = 40960, MIXW = 8192;
constexpr int QL = 1024, KVL = 512, NQ = 6144, NKV = 8192;
constexpr int G1_CKV = 1024, G1_KR = 1536, G1_ZA = 1792, G1_UB = 5888, G1_VB = 9984, G1_ZB = 14080;
constexpr float EPS = 1e-6f;

constexpr size_t al256(size_t x) { return (x + 255) & ~(size_t)255; }
constexpr size_t WS_CTL = 0, CTL_ZERO_BYTES = 1u << 20;
constexpr size_t WS_MOD  = CTL_ZERO_BYTES;
constexpr size_t WS_OML  = WS_MOD  + al256((size_t)4 * 3 * 12288 * 4);
constexpr size_t WS_ROPE = WS_OML  + al256((size_t)2 * 2 * 8192 * 4);
constexpr size_t WS_STAT = WS_ROPE + al256((size_t)128 * 16 * 8);
constexpr size_t WS_WIN_AB = WS_STAT + al256((size_t)MTOT * 8);
constexpr size_t WS_WIN_C  = WS_WIN_AB + (size_t)2 * N_AB * DM * 2;
constexpr size_t WS_WO_AB  = WS_WIN_C + (size_t)2 * N_C * DM * 2;
constexpr size_t WS_WO_C   = WS_WO_AB + (size_t)2 * DM * MIXW * 2;
constexpr size_t WS_WQ     = WS_WO_C + (size_t)2 * DM * MIXW * 2;
constexpr size_t WS_WKV    = WS_WQ + (size_t)2 * NQ * QL * 2;
constexpr size_t WS_XS     = WS_WKV + (size_t)2 * NKV * KVL * 2;
constexpr size_t WS_H      = WS_XS + (size_t)MTOT * DM * 4;
constexpr size_t WS_Y      = WS_H + (size_t)MTOT * DM * 2;
constexpr size_t WS_G1     = WS_Y + (size_t)MTOT * DM * 4;
constexpr size_t WS_QN     = WS_G1 + (size_t)5 * MTOT * MIXW * 2;
constexpr size_t WS_KVN    = WS_QN + (size_t)MTOT * QL * 2;
constexpr size_t WS_KR     = WS_KVN + (size_t)MTOT * KVL * 2;
constexpr size_t WS_Q      = WS_KR + (size_t)MTOT * 64 * 2;
constexpr size_t WS_KN     = WS_Q + (size_t)MTOT * NQ * 2;
constexpr size_t WS_V      = WS_KN + (size_t)MTOT * DM * 2;
constexpr size_t WS_CC     = WS_V + (size_t)MTOT * DM * 2;
constexpr size_t WS_OF     = WS_CC + (size_t)MTOT * MIXW * 2;
constexpr size_t WS_YP     = WS_OF + (size_t)2 * MTOT * MIXW * 2;
constexpr size_t WS_END    = WS_YP + (size_t)8 * (MTOT - MLAT) * DM * 4;
constexpr int CW_BAR = 4096;

constexpr int RING_BYTES = 135168;
constexpr int LDSCTL_OFF = RING_BYTES, MISC_OFF = LDSCTL_OFF + 64;
constexpr int LDS_BYTES = 147456;

struct Args { const float* in[22]; float* out; unsigned char* ws; int ph_lo, ph_hi; };
typedef const __attribute__((address_space(4))) Args* KArgs;
__device__ __forceinline__ KArgs kargs() { KArgs ap = (KArgs)__builtin_amdgcn_kernarg_segment_ptr(); asm volatile("" : "+s"(ap)); return ap; }

#define GAS __attribute__((address_space(1)))
template <class T> __device__ __forceinline__ T* glob(T* p) { return (T*)(GAS T*)p; }
template <class T> __device__ __forceinline__ T* uni(T* p) {
    const unsigned long long v = (unsigned long long)p; const unsigned lo = __builtin_amdgcn_readfirstlane((unsigned)v), hi = __builtin_amdgcn_readfirstlane((unsigned)(v >> 32));
    return (T*)(GAS T*)(((unsigned long long)hi << 32) | lo); }
#define GWS(a_) glob((a_)->ws)
#define GIN(a_, i_) glob((a_)->in[i_])
#define GOUT(a_) glob((a_)->out)
__device__ __forceinline__ float wave_sum(float v) {
#pragma unroll
    for (int o = 1; o < 64; o <<= 1) v += __shfl_xor(v, o);
    return v;
}
__device__ __forceinline__ float bf_lo(unsigned w) { return __uint_as_float(w << 16); }
__device__ __forceinline__ float bf_hi(unsigned w) { return __uint_as_float(w & 0xffff0000u); }
typedef __bf16 bf16x2_t __attribute__((ext_vector_type(2)));
__device__ __forceinline__ unsigned cvtpk(float lo, float hi) { const f32x2 v = {lo, hi}; const bf16x2_t b = __builtin_convertvector(v, bf16x2_t); return __builtin_bit_cast(unsigned, b); }
__device__ __forceinline__ float silu_acc(float x) { return x / (1.0f + __expf(-x)); }

__device__ __forceinline__ void p0_gemv(KArgs a, LAS unsigned char* lds, int G) {
    int tid_l = threadIdx.x; asm volatile("" : "+v"(tid_l)); const int tid = tid_l, lane = tid & 63, wave = __builtin_amdgcn_readfirstlane(tid >> 6);
    LAS float* sc = (LAS float*)lds;
    LAS float* red = (LAS float*)(lds + 49152);
    const float* c = GIN(a, 1); const float* cctx = GIN(a, 3); const float* w_ada = GIN(a, 4); const float* b_ada = GIN(a, 5);
    float* mod = (float*)(GWS(a) + WS_MOD);
    for (int i = tid; i < 3 * 4096; i += 512) { const int r = i >> 12, k = i & 4095; const float cv = r < 2 ? c[r * 4096 + k] : cctx[k]; sc[i] = silu_acc(cv); }
    __syncthreads();
    const int kr = lane >> 4, c4 = lane & 15;
    for (int item = blockIdx.x; item < 768; item += G) {
        const int l = item / 192, cg = item % 192;
        const float* W = w_ada + (size_t)l * 4096 * 12288 + cg * 64 + c4 * 4;
        float acc[3][4];
#pragma unroll
        for (int r = 0; r < 3; ++r)
#pragma unroll
            for (int j = 0; j < 4; ++j) acc[r][j] = 0.f;
        const int k0 = wave * 512 + kr;
#pragma unroll 8
        for (int i = 0; i < 128; ++i) { const int k = k0 + 4 * i; const f32x4 w = LDNT((const f32x4*)(W + (size_t)k * 12288));
            const float s0 = sc[k], s1 = sc[4096 + k], s2 = sc[8192 + k];
#pragma unroll
            for (int j = 0; j < 4; ++j) { acc[0][j] += s0 * w[j]; acc[1][j] += s1 * w[j]; acc[2][j] += s2 * w[j]; } }
#pragma unroll
        for (int r = 0; r < 3; ++r)
#pragma unroll
            for (int j = 0; j < 4; ++j) { float v = acc[r][j]; v += __shfl_xor(v, 16); v += __shfl_xor(v, 32); acc[r][j] = v; }
        if (lane < 16) {
#pragma unroll
            for (int r = 0; r < 3; ++r)
#pragma unroll
                for (int j = 0; j < 4; ++j) red[(wave * 3 + r) * 64 + lane * 4 + j] = acc[r][j]; }
        __syncthreads();
        if (tid < 192) { const int r = tid >> 6, cc = tid & 63; float s = 0.f;
#pragma unroll
            for (int w = 0; w < 8; ++w) s += red[(w * 3 + r) * 64 + cc];
            const int col = cg * 64 + cc; mod[(size_t)(l * 3 + r) * 12288 + col] = s + b_ada[l * 12288 + col]; }
        __syncthreads();
    }
}
__device__ __forceinline__ void p0_tr_item(const float* W, int N, int K, bf16* WT, int n0s, int n0d, int k0, LAS float* scr, int lane) {
    const int kr = lane >> 4, c4 = lane & 15;
    const float* Wb = uni(W + (size_t)k0 * N + n0s); const unsigned lo = (unsigned)(kr * N + 4 * c4);
    f32x4 w[16];
#pragma unroll
    for (int i = 0; i < 16; ++i) w[i] = LDNT((const f32x4*)(Wb + lo + (unsigned)(4 * i * N)));
#pragma unroll
    for (int i = 0; i < 16; ++i) { const int k = 4 * i + kr;
        scr[(4 * c4 + 0) * 65 + k] = w[i][0]; scr[(4 * c4 + 1) * 65 + k] = w[i][1]; scr[(4 * c4 + 2) * 65 + k] = w[i][2]; scr[(4 * c4 + 3) * 65 + k] = w[i][3]; }
    LDS_WAIT(); asm volatile("" ::: "memory");
    bf16* ob = uni(WT + (size_t)n0d * K + k0); const int nr = lane >> 3, cch = lane & 7;
#pragma unroll
    for (int i = 0; i < 8; ++i) { const int n = 8 * i + nr; const LAS float* s = scr + n * 65 + 8 * cch;
        v4u o; o.x = cvtpk(s[0], s[1]); o.y = cvtpk(s[2], s[3]); o.z = cvtpk(s[4], s[5]); o.w = cvtpk(s[6], s[7]);
        *(v4u*)(ob + (unsigned)(n * K + 8 * cch)) = o; }
    LDS_WAIT(); asm volatile("" ::: "memory");
}
#ifndef P0_DEFER
#define P0_DEFER 1
#endif
constexpr int I_IN_AB = 64 * 281, I_Q = 16 * 96, I_KV = 8 * 128, I_O = 128 * 64, I_IN_C = 64 * 640, PER_J = I_IN_AB + I_Q + I_KV + I_O + I_IN_C + I_O;
__device__ __forceinline__ void p0_item(KArgs a, int j, int r, LAS float* scr, int lane) {
    if (r < I_IN_AB) { const int kb = r / 281, nb = r % 281, n0 = nb * 64;
        p0_tr_item(GIN(a, 8) + (size_t)j * DM * N_ABSRC, N_ABSRC, DM, (bf16*)(GWS(a) + WS_WIN_AB) + (size_t)j * N_AB * DM, n0, n0 + (n0 >= 1600 ? 192 : 0), kb * 64, scr, lane); return; } r -= I_IN_AB;
    if (r < I_Q) { const int kb = r / 96, nb = r % 96;
        p0_tr_item(GIN(a, 11) + (size_t)j * QL * NQ, NQ, QL, (bf16*)(GWS(a) + WS_WQ) + (size_t)j * NQ * QL, nb * 64, nb * 64, kb * 64, scr, lane); return; } r -= I_Q;
    if (r < I_KV) { const int kb = r / 128, nb = r % 128;
        p0_tr_item(GIN(a, 12) + (size_t)j * KVL * NKV, NKV, KVL, (bf16*)(GWS(a) + WS_WKV) + (size_t)j * NKV * KVL, nb * 64, nb * 64, kb * 64, scr, lane); return; } r -= I_KV;
    if (r < I_O) { const int kb = r / 64, nb = r % 64;
        p0_tr_item(GIN(a, 17) + (size_t)j * MIXW * DM, DM, MIXW, (bf16*)(GWS(a) + WS_WO_AB) + (size_t)j * DM * MIXW, nb * 64, nb * 64, kb * 64, scr, lane); return; } r -= I_O;
    if (r < I_IN_C) { const int kb = r / 640, nb = r % 640;
        p0_tr_item(GIN(a, 18) + (size_t)j * DM * N_C, N_C, DM, (bf16*)(GWS(a) + WS_WIN_C) + (size_t)j * N_C * DM, nb * 64, nb * 64, kb * 64, scr, lane); return; } r -= I_IN_C;
    { const int kb = r / 64, nb = r % 64;
        p0_tr_item(GIN(a, 21) + (size_t)j * MIXW * DM, DM, MIXW, (bf16*)(GWS(a) + WS_WO_C) + (size_t)j * DM * MIXW, nb * 64, nb * 64, kb * 64, scr, lane); }
}
constexpr int P0_ND = I_O + PER_J;
#ifndef P0_B1
#define P0_B1 25984
#endif
#ifndef P0_B2
#define P0_B2 51936
#endif
constexpr int P0_B3 = P0_ND - I_O;
static_assert(P0_B1 >= I_O && P0_B1 <= P0_B2 && P0_B2 >= I_O + I_IN_AB && P0_B2 <= P0_B3, "deferred-slot deadlines");
__device__ __forceinline__ bool p0_defer_on(int G) { return P0_DEFER && (G % pg8::NXCD == 0); }
__device__ __forceinline__ void p0_deferred(KArgs a, LAS unsigned char* lds, const pg8::LockstepOrder& S, int slot) {
    const int lenmax = S.PG * pg8::LockstepOrder::LW * S.nN + S.qR + (S.rR > 0 ? 1 : 0), R = (lenmax + S.nk - 1) / S.nk, kcut = lenmax - (R - 1) * S.nk;
    const bool all = kcut >= S.nk;
    if (!all && S.k < kcut) return;
    int tid_l = threadIdx.x; asm volatile("" : "+v"(tid_l)); const int lane = tid_l & 63, wave = __builtin_amdgcn_readfirstlane(tid_l >> 6);
    const int rank = all ? S.c : (S.k - kcut) * pg8::NXCD + S.x, nw = (all ? S.G : pg8::NXCD * (S.nk - kcut)) * NWAVES;
    __syncthreads();
    LAS float* scr = (LAS float*)(lds + wave * 16640);
    const int lo_ = slot == 0 ? 0 : slot == 1 ? P0_B1 : slot == 2 ? P0_B2 : P0_B3, hi_ = slot == 0 ? P0_B1 : slot == 1 ? P0_B2 : slot == 2 ? P0_B3 : P0_ND;
    for (int d = lo_ + rank * NWAVES + wave; d < hi_; d += nw) {
        const int j = d < I_O ? 0 : 1, r = d < I_O ? PER_J - I_O + d : d - I_O; p0_item(a, j, r, scr, lane); }
    __syncthreads();
}
__device__ __forceinline__ void p0_prologue(KArgs a, LAS unsigned char* lds, int G) {
    int tid_l = threadIdx.x; asm volatile("" : "+v"(tid_l)); const int tid = tid_l, lane = tid & 63, wave = __builtin_amdgcn_readfirstlane(tid >> 6);
    __syncthreads();
    p0_gemv(a, lds, G);
    __syncthreads();
    LAS float* scr = (LAS float*)(lds + wave * 16640);
    const int gw = blockIdx.x * NWAVES + wave, NGW = G * NWAVES;
    const bool defer = p0_defer_on(G);
    const int NIT = defer ? PER_J - I_O : 2 * PER_J;
    for (int it = gw; it < NIT; it += NGW) {
        const int j = defer ? (it < PER_J - I_O ? 0 : 1) : it / PER_J, r = defer ? (it < PER_J - I_O ? it : it - (PER_J - I_O)) : it % PER_J;
        p0_item(a, j, r, scr, lane);
    }
    const size_t gt = (size_t)blockIdx.x * 512 + tid, NGT = (size_t)G * 512;
    for (size_t i = gt; i < (size_t)2 * 192 * DM / 8; i += NGT) { const size_t j = i / (192 * DM / 8), e = i % (192 * DM / 8);
        *(v4u*)((bf16*)(GWS(a) + WS_WIN_AB) + j * (size_t)N_AB * DM + (size_t)1600 * DM + e * 8) = (v4u){0u, 0u, 0u, 0u}; }
    { const float* lg = GIN(a, 19); float* oml = (float*)(GWS(a) + WS_OML);
      for (size_t i = gt; i < (size_t)2 * 2 * 8192; i += NGT) { const int jc = (int)(i >> 14), de = (int)(i & 16383);
          const float l0 = lg[0 * 16384 + de], l1 = lg[1 * 16384 + de], l2 = lg[2 * 16384 + de], l3 = lg[3 * 16384 + de];
          const float mx = fmaxf(fmaxf(l0, l1), fmaxf(l2, l3)); const float e0 = __expf(l0 - mx), e1 = __expf(l1 - mx), e2 = __expf(l2 - mx), e3 = __expf(l3 - mx);
          const float inv = 1.0f / (e0 + e1 + e2 + e3); const float lb = (jc == 0) ? e1 * inv : (e1 + e2 + e3) * inv;
          oml[i] = 1.0f - lb; } }
    { f32x2* rope = (f32x2*)(GWS(a) + WS_ROPE);
      for (size_t i = gt; i < 128 * 16; i += NGT) { const int pos = (int)(i >> 4), f = (int)(i & 15); const float inv = powf(10000.0f, -(float)f / 16.0f); const float ang = (float)pos * inv;
          rope[i] = (f32x2){cosf(ang), sinf(ang)}; } }
}

__device__ __forceinline__ void norm_phase(KArgs a, int lpost, int lpre, int G) {
    int tid_l = threadIdx.x; asm volatile("" : "+v"(tid_l)); const int tid = tid_l, lane = tid & 63, wave = __builtin_amdgcn_readfirstlane(tid >> 6);
    const int gw = blockIdx.x * NWAVES + wave, NGW = G * NWAVES;
    const float* mod = (const float*)(GWS(a) + WS_MOD);
    float* XS = (float*)(GWS(a) + WS_XS); const float* Y = (const float*)(GWS(a) + WS_Y); bf16* H = (bf16*)(GWS(a) + WS_H);
    const int nrows = (lpost == 3) ? MLAT : MTOT;
    for (int row = gw; row < nrows; row += NGW) {
        const int rt = row < SEQ ? 0 : (row < MLAT ? 1 : 2);
        const float* xin = uni((lpost <= 0) ? (row < MLAT ? GIN(a, 0) + (size_t)row * DM : GIN(a, 2) + (size_t)(row - MLAT) * DM) : XS + (size_t)row * DM);
        f32x4 xv[16];
#pragma unroll
        for (int j = 0; j < 16; ++j) xv[j] = LDNT((const f32x4*)(xin + lane * 4 + 256 * j));
        if (lpost >= 0) {
            f32x4 yv[16]; float ss = 0.f;
            if (row < MLAT) { const bf16* yr = uni((const bf16*)Y + (size_t)row * DM);
#pragma unroll
                for (int j = 0; j < 16; ++j) { const u32x2 w = LDNT((const u32x2*)(yr + lane * 4 + 256 * j)); yv[j] = (f32x4){bf_lo(w.x), bf_hi(w.x), bf_lo(w.y), bf_hi(w.y)}; } }
            else {
                const float* yr = uni((const float*)(GWS(a) + WS_YP) + (size_t)(row - MLAT) * DM);
#pragma unroll
                for (int j = 0; j < 16; ++j) yv[j] = *(const f32x4*)(yr + lane * 4 + 256 * j);
                for (int kc = 1; kc < 8; ++kc) { const float* yk = uni(yr + (size_t)kc * (MTOT - MLAT) * DM);
#pragma unroll
                    for (int j = 0; j < 16; ++j) { yv[j] = yv[j] + *(const f32x4*)(yk + lane * 4 + 256 * j); if ((j & 3) == 3) asm volatile("" ::: "memory"); } } }
#pragma unroll
            for (int j = 0; j < 16; ++j) ss += (yv[j][0] * yv[j][0] + yv[j][1] * yv[j][1]) + (yv[j][2] * yv[j][2] + yv[j][3] * yv[j][3]);
            const float r = 1.0f / sqrtf(wave_sum(ss) * (1.0f / DM) + EPS);
            const float* gate = uni(mod + (size_t)(lpost * 3 + rt) * 12288 + 8192); const float* pw = uni(GIN(a, 7) + (size_t)lpost * DM);
            float* xout = uni((lpost == 3) ? GOUT(a) + (size_t)row * DM : XS + (size_t)row * DM);
#pragma unroll
            for (int j = 0; j < 16; ++j) { const int col = lane * 4 + 256 * j; const f32x4 g = *(const f32x4*)(gate + col), w = *(const f32x4*)(pw + col);
                xv[j] = xv[j] + g * ((yv[j] * r) * w); STNT((f32x4*)(xout + col), xv[j]);
                if ((j & 3) == 3) asm volatile("" ::: "memory"); }
        }
        if (lpre < 4) {
            float ss = 0.f;
#pragma unroll
            for (int j = 0; j < 16; ++j) ss += (xv[j][0] * xv[j][0] + xv[j][1] * xv[j][1]) + (xv[j][2] * xv[j][2] + xv[j][3] * xv[j][3]);
            const float r = 1.0f / sqrtf(wave_sum(ss) * (1.0f / DM) + EPS);
            const float* shift = uni(mod + (size_t)(lpre * 3 + rt) * 12288); const float* scale = shift + 4096; const float* pw = uni(GIN(a, 6) + (size_t)lpre * DM);
            bf16* hr = uni(H + (size_t)row * DM);
#pragma unroll
            for (int j = 0; j < 16; ++j) { const int col = lane * 4 + 256 * j; const f32x4 sh = *(const f32x4*)(shift + col), sc = *(const f32x4*)(scale + col), w = *(const f32x4*)(pw + col);
                const f32x4 h = ((xv[j] * r) * w) * (sc + 1.0f) + sh; u32x2 o; o.x = cvtpk(h[0], h[1]); o.y = cvtpk(h[2], h[3]); *(u32x2*)(hr + col) = o;
                if ((j & 3) == 3) asm volatile("" ::: "memory"); }
        }
    }
}

__device__ __forceinline__ void a2_rows(KArgs a, int j, int G) {
    int tid_l = threadIdx.x; asm volatile("" : "+v"(tid_l)); const int tid = tid_l, lane = tid & 63, wave = __builtin_amdgcn_readfirstlane(tid >> 6);
    const int gw = blockIdx.x * NWAVES + wave, NGW = G * NWAVES;
    const bf16* G1 = (const bf16*)(GWS(a) + WS_G1); bf16* QN = (bf16*)(GWS(a) + WS_QN); bf16* KVN = (bf16*)(GWS(a) + WS_KVN); bf16* KR = (bf16*)(GWS(a) + WS_KR);
    f32x2* stat = (f32x2*)(GWS(a) + WS_STAT); const f32x2* rope = (const f32x2*)(GWS(a) + WS_ROPE);
    const float* qw = GIN(a, 9) + (size_t)j * QL; const float* kvw = GIN(a, 10) + (size_t)j * KVL;
    for (int row = gw; row < MTOT; row += NGW) {
        const bf16* g = uni(G1 + (size_t)row * N_AB);
        {
            v4u w[2]; float x[16]; float ss = 0.f;
#pragma unroll
            for (int i = 0; i < 2; ++i) { w[i] = LDNT((const v4u*)(g + lane * 8 + 512 * i));
#pragma unroll
                for (int e = 0; e < 4; ++e) { x[8 * i + 2 * e] = bf_lo(w[i][e]); x[8 * i + 2 * e + 1] = bf_hi(w[i][e]); } }
#pragma unroll
            for (int e = 0; e < 16; ++e) ss += x[e] * x[e];
            const float r = 1.0f / sqrtf(wave_sum(ss) * (1.0f / QL) + EPS);
#pragma unroll
            for (int i = 0; i < 2; ++i) { const int col = lane * 8 + 512 * i; const f32x4 w0 = *(const f32x4*)(qw + col), w1 = *(const f32x4*)(qw + col + 4);
                v4u o; o.x = cvtpk(x[8 * i + 0] * r * w0[0], x[8 * i + 1] * r * w0[1]); o.y = cvtpk(x[8 * i + 2] * r * w0[2], x[8 * i + 3] * r * w0[3]);
                o.z = cvtpk(x[8 * i + 4] * r * w1[0], x[8 * i + 5] * r * w1[1]); o.w = cvtpk(x[8 * i + 6] * r * w1[2], x[8 * i + 7] * r * w1[3]);
                *(v4u*)(QN + (size_t)row * QL + col) = o; }
        }
        {
            const v4u w = LDNT((const v4u*)(g + G1_CKV + lane * 8)); float x[8]; float ss = 0.f;
#pragma unroll
            for (int e = 0; e < 4; ++e) { x[2 * e] = bf_lo(w[e]); x[2 * e + 1] = bf_hi(w[e]); }
#pragma unroll
            for (int e = 0; e < 8; ++e) ss += x[e] * x[e];
            const float r = 1.0f / sqrtf(wave_sum(ss) * (1.0f / KVL) + EPS);
            const int col = lane * 8; const f32x4 w0 = *(const f32x4*)(kvw + col), w1 = *(const f32x4*)(kvw + col + 4);
            v4u o; o.x = cvtpk(x[0] * r * w0[0], x[1] * r * w0[1]); o.y = cvtpk(x[2] * r * w0[2], x[3] * r * w0[3]); o.z = cvtpk(x[4] * r * w1[0], x[5] * r * w1[1]); o.w = cvtpk(x[6] * r * w1[2], x[7] * r * w1[3]);
            *(v4u*)(KVN + (size_t)row * KVL + col) = o;
        }
        {
            const float x = __uint_as_float((unsigned)g[G1_KR + lane] << 16); const float xp = __shfl_xor(x, 16); float o = x;
            if (row < MLAT) { const int t = row & (SEQ - 1), ax = lane >> 5, hh = (lane >> 4) & 1, f = lane & 15, pos = ax == 0 ? (t >> 6) : (t & 63); const f32x2 cs = rope[pos * 16 + f];
                o = hh == 0 ? x * cs.x - xp * cs.y : x * cs.x + xp * cs.y; }
            KR[(size_t)row * 64 + lane] = (bf16)(cvtpk(o, 0.f) & 0xffffu);
        }
        {
            float x[64]; float s = 0.f;
#pragma unroll
            for (int i = 0; i < 8; ++i) { const v4u w = *(const v4u*)(g + G1_VB + lane * 8 + 512 * i);
#pragma unroll
                for (int e = 0; e < 4; ++e) { x[8 * i + 2 * e] = bf_lo(w[e]); x[8 * i + 2 * e + 1] = bf_hi(w[e]); } }
#pragma unroll
            for (int e = 0; e < 64; ++e) s += x[e];
            const float mean = wave_sum(s) * (1.0f / 4096.0f); float q = 0.f;
#pragma unroll
            for (int e = 0; e < 64; ++e) { const float d = x[e] - mean; q += d * d; }
            const float rstd = 1.0f / sqrtf(wave_sum(q) * (1.0f / 4096.0f) + EPS);
            if (lane == 0) stat[row] = (f32x2){mean, rstd};
        }
    }
}

typedef short s16x4 __attribute__((ext_vector_type(4)));
typedef float f32x16 __attribute__((ext_vector_type(16)));
#define SBAR() __builtin_amdgcn_sched_barrier(0)
__device__ __forceinline__ f32x4 mfma16(bf16x8 a, bf16x8 b, f32x4 c) { return __builtin_amdgcn_mfma_f32_16x16x32_bf16(a, b, c, 0, 0, 0); }
__device__ __forceinline__ int crow(int r, int hi) { return (r & 3) + 8 * (r >> 2) + 4 * hi; }
__device__ __forceinline__ int v_st(int k, int c) { const int kk = (k & ~0xC) | ((k & 4) << 1) | ((k & 8) >> 1); return ((kk >> 3) * 4 + (c >> 5)) * 512 + ((kk & 7) * 32 + (c & 31)) * 2; }
__device__ __forceinline__ int v_rd_base(int lane) { return ((lane & 3) << 3) | (((lane >> 2) & 3) << 6) | (((lane >> 4) & 1) << 5) | (((lane >> 5) & 1) << 8); }
constexpr int v_rd_off(int d0, int ks, int half) { return d0 * 512 + ks * 4096 + half * 2048; }
template <int OFF> __device__ __forceinline__ s16x4 tr_read(int vb) {
    s16x4 r; asm volatile("ds_read_b64_tr_b16 %0, %1 offset:%2" : "=&v"(r) : "v"(vb), "i"(OFF) : "memory"); return r;
}
template <int D0> __device__ __forceinline__ void pv_one(f32x16& od, int vb, bf16x8 pa0, bf16x8 pa1, bf16x8 pa2, bf16x8 pa3) {
    const s16x4 l0 = tr_read<v_rd_off(D0, 0, 0)>(vb), h0 = tr_read<v_rd_off(D0, 0, 1)>(vb), l1 = tr_read<v_rd_off(D0, 1, 0)>(vb), h1 = tr_read<v_rd_off(D0, 1, 1)>(vb);
    const s16x4 l2 = tr_read<v_rd_off(D0, 2, 0)>(vb), h2 = tr_read<v_rd_off(D0, 2, 1)>(vb), l3 = tr_read<v_rd_off(D0, 3, 0)>(vb), h3 = tr_read<v_rd_off(D0, 3, 1)>(vb);
    asm volatile("s_waitcnt lgkmcnt(0)" ::: "memory"); SBAR();
#define PKV(L, H) (bf16x8){L[0], L[1], L[2], L[3], H[0], H[1], H[2], H[3]}
    od = __builtin_amdgcn_mfma_f32_32x32x16_bf16(pa0, PKV(l0, h0), od, 0, 0, 0);
    od = __builtin_amdgcn_mfma_f32_32x32x16_bf16(pa1, PKV(l1, h1), od, 0, 0, 0);
    od = __builtin_amdgcn_mfma_f32_32x32x16_bf16(pa2, PKV(l2, h2), od, 0, 0, 0);
    od = __builtin_amdgcn_mfma_f32_32x32x16_bf16(pa3, PKV(l3, h3), od, 0, 0, 0);
#undef PKV
}
__device__ __forceinline__ void pv_d0(f32x16* o, int vb, bf16x8 pa0, bf16x8 pa1, bf16x8 pa2, bf16x8 pa3) {
    pv_one<0>(o[0], vb, pa0, pa1, pa2, pa3); pv_one<1>(o[1], vb, pa0, pa1, pa2, pa3); pv_one<2>(o[2], vb, pa0, pa1, pa2, pa3); pv_one<3>(o[3], vb, pa0, pa1, pa2, pa3);
}

template <int I> __device__ __forceinline__ void pv_rd(int vb, s16x4& l0, s16x4& h0, s16x4& l1, s16x4& h1) {
    l0 = tr_read<v_rd_off(I >> 1, 2 * (I & 1), 0)>(vb); h0 = tr_read<v_rd_off(I >> 1, 2 * (I & 1), 1)>(vb); l1 = tr_read<v_rd_off(I >> 1, 2 * (I & 1) + 1, 0)>(vb); h1 = tr_read<v_rd_off(I >> 1, 2 * (I & 1) + 1, 1)>(vb);
}
#define PKV2(L, H) (bf16x8){L[0], L[1], L[2], L[3], H[0], H[1], H[2], H[3]}
#define PV_MM(I, A0, A1, L0, H0, L1, H1) do { o[(I) >> 1] = __builtin_amdgcn_mfma_f32_32x32x16_bf16(A0, PKV2(L0, H0), o[(I) >> 1], 0, 0, 0); o[(I) >> 1] = __builtin_amdgcn_mfma_f32_32x32x16_bf16(A1, PKV2(L1, H1), o[(I) >> 1], 0, 0, 0); } while (0)
#define PV_WAIT4() do { asm volatile("s_waitcnt lgkmcnt(4)" ::: "memory"); SBAR(); } while (0)
#define PV_WAIT0() do { asm volatile("s_waitcnt lgkmcnt(0)" ::: "memory"); SBAR(); } while (0)
__device__ __forceinline__ void pv_pipe(f32x16* o, int vb, bf16x8 pa0, bf16x8 pa1, bf16x8 pa2, bf16x8 pa3) {
    s16x4 al0, ah0, al1, ah1, bl0, bh0, bl1, bh1;
    asm volatile("s_waitcnt lgkmcnt(0)" ::: "memory"); SBAR();
    pv_rd<0>(vb, al0, ah0, al1, ah1); pv_rd<1>(vb, bl0, bh0, bl1, bh1);
    PV_WAIT4(); PV_MM(0, pa0, pa1, al0, ah0, al1, ah1); SBAR(); pv_rd<2>(vb, al0, ah0, al1, ah1);
    PV_WAIT4(); PV_MM(1, pa2, pa3, bl0, bh0, bl1, bh1); SBAR(); pv_rd<3>(vb, bl0, bh0, bl1, bh1);
    PV_WAIT4(); PV_MM(2, pa0, pa1, al0, ah0, al1, ah1); SBAR(); pv_rd<4>(vb, al0, ah0, al1, ah1);
    PV_WAIT4(); PV_MM(3, pa2, pa3, bl0, bh0, bl1, bh1); SBAR(); pv_rd<5>(vb, bl0, bh0, bl1, bh1);
    PV_WAIT4(); PV_MM(4, pa0, pa1, al0, ah0, al1, ah1); SBAR(); pv_rd<6>(vb, al0, ah0, al1, ah1);
    PV_WAIT4(); PV_MM(5, pa2, pa3, bl0, bh0, bl1, bh1); SBAR(); pv_rd<7>(vb, bl0, bh0, bl1, bh1);
    PV_WAIT4(); PV_MM(6, pa0, pa1, al0, ah0, al1, ah1);
    PV_WAIT0(); PV_MM(7, pa2, pa3, bl0, bh0, bl1, bh1);
}

__device__ __forceinline__ void pv_seq(f32x16* o, int vb, bf16x8 pa0, bf16x8 pa1, bf16x8 pa2, bf16x8 pa3) {
    s16x4 al0, ah0, al1, ah1;
    pv_rd<0>(vb, al0, ah0, al1, ah1); PV_WAIT0(); PV_MM(0, pa0, pa1, al0, ah0, al1, ah1); SBAR();
    pv_rd<1>(vb, al0, ah0, al1, ah1); PV_WAIT0(); PV_MM(1, pa2, pa3, al0, ah0, al1, ah1); SBAR();
    pv_rd<2>(vb, al0, ah0, al1, ah1); PV_WAIT0(); PV_MM(2, pa0, pa1, al0, ah0, al1, ah1); SBAR();
    pv_rd<3>(vb, al0, ah0, al1, ah1); PV_WAIT0(); PV_MM(3, pa2, pa3, al0, ah0, al1, ah1); SBAR();
    pv_rd<4>(vb, al0, ah0, al1, ah1); PV_WAIT0(); PV_MM(4, pa0, pa1, al0, ah0, al1, ah1); SBAR();
    pv_rd<5>(vb, al0, ah0, al1, ah1); PV_WAIT0(); PV_MM(5, pa2, pa3, al0, ah0, al1, ah1); SBAR();
    pv_rd<6>(vb, al0, ah0, al1, ah1); PV_WAIT0(); PV_MM(6, pa0, pa1, al0, ah0, al1, ah1); SBAR();
    pv_rd<7>(vb, al0, ah0, al1, ah1); PV_WAIT0(); PV_MM(7, pa2, pa3, al0, ah0, al1, ah1);
}

__device__ __forceinline__ void sgu_phase(KArgs a, int j, LAS unsigned char* lds, int G) {
    int tid_l = threadIdx.x; asm volatile("" : "+v"(tid_l)); const int tid = tid_l, lane = tid & 63, wid = __builtin_amdgcn_readfirstlane(tid >> 6), r32 = lane & 31, hi = lane >> 5;
    const bf16* G1 = (const bf16*)(GWS(a) + WS_G1); bf16* CC = (bf16*)(GWS(a) + WS_CC); const f32x2* stat = (const f32x2*)(GWS(a) + WS_STAT);
    const float* lnw = GIN(a, 13) + (size_t)j * 4096; const float* lnb = GIN(a, 14) + (size_t)j * 4096; const float* ws_all = GIN(a, 15) + (size_t)j * 16 * 128 * 128; const float* bs = GIN(a, 16) + (size_t)j * 16 * 128;
    constexpr int MXP = 272, OFF_ST = 69632;
    LAS float* st_mean = (LAS float*)(lds + OFF_ST); LAS float* st_rstd = st_mean + 128;
    LAS float* m1s = (LAS float*)(lds + OFF_ST + 1024) + wid * 64; LAS float* rss = m1s + 32;
    LAS unsigned char* mx = lds + wid * (32 * MXP);
    const int sr = tid >> 4, sc = (tid & 15) * 8, vst0 = v_st(sr, sc), vst1 = v_st(32 + sr, sc);
    const int tb = wid >> 1, ch = wid & 1;
    const int vb0 = (int)(unsigned)(unsigned long long)lds + v_rd_base(lane);
    v4u vx[8];
#define SGU_LOADV(it_) do { const int ch_ = (it_) >> 4, g_ = (it_) & 15; const bf16* s0_ = uni(G1 + (size_t)(ch_ * 128) * N_AB + G1_VB + g_ * 256); const unsigned lo_ = (unsigned)(sr * N_AB + sc); \
    _Pragma("unroll") for (int st = 0; st < 2; ++st) _Pragma("unroll") for (int c2 = 0; c2 < 2; ++c2) { const unsigned o_ = lo_ + (unsigned)(64 * st * N_AB + c2 * 128); \
        vx[(st * 2 + c2) * 2] = LDNT((const v4u*)(s0_ + o_)); vx[(st * 2 + c2) * 2 + 1] = LDNT((const v4u*)(s0_ + o_ + 32 * N_AB)); } } while (0)
    const int item0 = (int)((blockIdx.x + 128u) % (unsigned)G);
    if (item0 < 132 * 16) SGU_LOADV(item0);
    for (int item = item0; item < 132 * 16; item += G) {
        const int chunk = item >> 4, g = item & 15, row0 = chunk * 128;
        __syncthreads();
#pragma unroll
        for (int q = 0; q < 4; ++q) { *(LAS v4u*)(lds + q * 16384 + vst0) = vx[2 * q]; *(LAS v4u*)(lds + q * 16384 + vst1) = vx[2 * q + 1]; }
        if (tid < 128) { const f32x2 s = stat[row0 + tid]; st_mean[tid] = s.x; st_rstd[tid] = s.y; }
        __syncthreads();
        if (item + G < 132 * 16) SGU_LOADV(item + G);
        const float* wrow = ws_all + ((size_t)g * 128 + 32 * tb + r32) * 128;
        bf16x8 pa[2][4]; float m1 = 0.f, rs = 0.f;
#pragma unroll
        for (int st = 0; st < 2; ++st)
#pragma unroll
            for (int ks = 0; ks < 4; ++ks) { const int s0 = 64 * st + 16 * ks + 8 * hi; const f32x4 w0 = *(const f32x4*)(wrow + s0), w1 = *(const f32x4*)(wrow + s0 + 4);
                const f32x4 r0 = *(const LAS f32x4*)(st_rstd + s0), r1 = *(const LAS f32x4*)(st_rstd + s0 + 4), mu0 = *(const LAS f32x4*)(st_mean + s0), mu1 = *(const LAS f32x4*)(st_mean + s0 + 4);
                rs += (w0[0] + w0[1]) + (w0[2] + w0[3]) + (w1[0] + w1[1]) + (w1[2] + w1[3]);
                v4u p; p.x = cvtpk(w0[0] * r0[0], w0[1] * r0[1]); p.y = cvtpk(w0[2] * r0[2], w0[3] * r0[3]); p.z = cvtpk(w1[0] * r1[0], w1[1] * r1[1]); p.w = cvtpk(w1[2] * r1[2], w1[3] * r1[3]);
                m1 += bf_lo(p.x) * mu0[0] + bf_hi(p.x) * mu0[1] + bf_lo(p.y) * mu0[2] + bf_hi(p.y) * mu0[3] + bf_lo(p.z) * mu1[0] + bf_hi(p.z) * mu1[1] + bf_lo(p.w) * mu1[2] + bf_hi(p.w) * mu1[3];
                pa[st][ks] = __builtin_bit_cast(bf16x8, p); }
        m1 += __shfl_xor(m1, 32); rs += __shfl_xor(rs, 32);
        if (hi == 0) { m1s[r32] = m1; rss[r32] = rs; }
        f32x16 o[4];
#pragma unroll
        for (int d = 0; d < 4; ++d)
#pragma unroll
            for (int r = 0; r < 16; ++r) o[d][r] = 0.f;
#pragma unroll
        for (int st = 0; st < 2; ++st) pv_d0(o, vb0 + (st * 2 + ch) * 16384, pa[st][0], pa[st][1], pa[st][2], pa[st][3]);
        asm volatile("s_waitcnt lgkmcnt(0)" ::: "memory");
        __syncthreads();
        { const int cb = g * 256 + ch * 128;
          const float* lw = uni(lnw + cb); const float* lb = uni(lnb + cb); const float* bsg = uni(bs + g * 128 + 32 * tb);
          int r32e = r32, hie = hi; asm volatile("" : "+v"(r32e), "+v"(hie));
          float lwv[4], lbv[4];
#pragma unroll
          for (int d0 = 0; d0 < 4; ++d0) { lwv[d0] = lw[d0 * 32 + r32e]; lbv[d0] = lb[d0 * 32 + r32e]; }
#pragma unroll
          for (int r = 0; r < 16; ++r) { const int rr = crow(r, hie); const float m1t = m1s[rr], rst = rss[rr], bst = bsg[rr];
#pragma unroll
            for (int d0 = 0; d0 < 4; ++d0) { const float mix = lwv[d0] * (o[d0][r] - m1t) + lbv[d0] * rst + bst;
                *(LAS bf16*)(mx + rr * MXP + (d0 * 32 + r32e) * 2) = (bf16)(cvtpk(mix, 0.f) & 0xffffu); } } }
        asm volatile("s_waitcnt lgkmcnt(0)" ::: "memory");
        { const int cb = g * 256 + ch * 128;
          const bf16* Gu = uni(G1 + (size_t)(row0 + 32 * tb) * N_AB + G1_UB + cb); const bf16* Gzb = uni(G1 + (size_t)(row0 + 32 * tb) * N_AB + G1_ZB + cb); bf16* Co = uni(CC + (size_t)(row0 + 32 * tb) * MIXW + 4096 + cb);
          int le = lane; asm volatile("" : "+v"(le));
#pragma unroll
          for (int i = 0; i < 8; ++i) { const int id = 64 * i + le, row = id >> 4, c8 = (id & 15) * 8;
              const v4u mq = *(const LAS v4u*)(mx + row * MXP + c8 * 2); const v4u uq = LDNT((const v4u*)(Gu + (unsigned)(row * N_AB + c8))), zq = LDNT((const v4u*)(Gzb + (unsigned)(row * N_AB + c8)));
              v4u oq;
#pragma unroll
              for (int e = 0; e < 4; ++e) oq[e] = cvtpk(bf_lo(uq[e]) * bf_lo(mq[e]) * bf_lo(zq[e]), bf_hi(uq[e]) * bf_hi(mq[e]) * bf_hi(zq[e]));
              *(v4u*)(Co + (unsigned)(row * MIXW + c8)) = oq;
              if ((i & 3) == 3) asm volatile("" ::: "memory"); } }
    }
#undef SGU_LOADV
    __syncthreads();
}

namespace att {
constexpr int QBLK = 32, KVBLK = 64;
constexpr float SCALE = 0.07216878364870322f;
constexpr float THR = 8.f;
constexpr int SHM_V = KVBLK * 128 * 2, SHM_K = KVBLK * 192 * 2;
#ifndef STG_SEL
#define STG_SEL 0
#endif
#ifndef ATT_STAGGER
#define ATT_STAGGER 1
#endif
constexpr int NVB = ATT_STAGGER ? 3 : 2;
constexpr int OFF_V = 0, OFF_K = NVB * SHM_V, OFF_WS = OFF_K + 2 * SHM_K, ATT_LDS = OFF_WS + NWAVES * 64 * 4;
#ifndef ATT_QR_LDS
#define ATT_QR_LDS 1
#endif
#ifndef ATT_SDEPTH
#define ATT_SDEPTH 1
#endif
constexpr int SDEPTH = ATT_SDEPTH;
constexpr float THRL = THR * 1.4426950408889634f;
__device__ __forceinline__ void partialSM_first(f32x16& p0, f32x16& p1, float& m_reg, float& alpha) {
    float pmax = p0[0];
#pragma unroll
    for (int r = 1; r < 16; ++r) pmax = fmaxf(pmax, p0[r]);
#pragma unroll
    for (int r = 0; r < 16; ++r) pmax = fmaxf(pmax, p1[r]);
    { auto rr = __builtin_amdgcn_permlane32_swap(__float_as_uint(pmax), __float_as_uint(pmax), false, false);
      pmax = fmaxf(__uint_as_float(rr[0]), __uint_as_float(rr[1])); }
    m_reg = pmax; alpha = 1.f;
#pragma unroll
    for (int r = 0; r < 16; ++r) p0[r] = p0[r] - pmax;
#pragma unroll
    for (int r = 0; r < 16; ++r) p1[r] = p1[r] - pmax;
#pragma unroll
    for (int r = 0; r < 16; ++r) p0[r] = __builtin_amdgcn_exp2f(p0[r]);
}
__device__ __forceinline__ void partialSM(f32x16& p0, f32x16& p1, float& m_reg, float& alpha) {
    float pmax = p0[0];
#pragma unroll
    for (int r = 1; r < 16; ++r) pmax = fmaxf(pmax, p0[r]);
#pragma unroll
    for (int r = 0; r < 16; ++r) pmax = fmaxf(pmax, p1[r]);
    { auto rr = __builtin_amdgcn_permlane32_swap(__float_as_uint(pmax), __float_as_uint(pmax), false, false);
      pmax = fmaxf(__uint_as_float(rr[0]), __uint_as_float(rr[1])); }
    if (__builtin_expect(__all(pmax <= THRL), 1)) { alpha = 1.f; }
    else { const float d = fmaxf(pmax, 0.f); alpha = __builtin_amdgcn_exp2f(-d); m_reg += d;
#pragma unroll
        for (int r = 0; r < 16; ++r) p0[r] = p0[r] - d;
#pragma unroll
        for (int r = 0; r < 16; ++r) p1[r] = p1[r] - d; }
#pragma unroll
    for (int r = 0; r < 16; ++r) p0[r] = __builtin_amdgcn_exp2f(p0[r]);
}
__device__ __forceinline__ void finishSM(f32x16& p0, f32x16& p1, float alpha, float& l_reg, bf16x8& pa0, bf16x8& pa1, bf16x8& pa2, bf16x8& pa3) {
#pragma unroll
    for (int r = 0; r < 16; ++r) p1[r] = __builtin_amdgcn_exp2f(p1[r]);
    float ps = 0;
#pragma unroll
    for (int r = 0; r < 16; ++r) ps += p0[r];
#pragma unroll
    for (int r = 0; r < 16; ++r) ps += p1[r];
    { auto rr = __builtin_amdgcn_permlane32_swap(__float_as_uint(ps), __float_as_uint(ps), false, false);
      ps = __uint_as_float(rr[0]) + __uint_as_float(rr[1]); }
    l_reg = l_reg * alpha + ps;
#define PK4(P, BASE, OUT) do { unsigned a0 = cvtpk(P[BASE + 0], P[BASE + 1]), a1 = cvtpk(P[BASE + 2], P[BASE + 3]);   \
    unsigned b0 = cvtpk(P[BASE + 4], P[BASE + 5]), b1 = cvtpk(P[BASE + 6], P[BASE + 7]);                              \
    auto r0 = __builtin_amdgcn_permlane32_swap(a0, b0, false, false); auto r1 = __builtin_amdgcn_permlane32_swap(a1, b1, false, false); \
    v4u w = {r0[0], r1[0], r0[1], r1[1]}; OUT = __builtin_bit_cast(bf16x8, w); } while (0)
    PK4(p0, 0, pa0); PK4(p0, 8, pa1); PK4(p1, 0, pa2); PK4(p1, 8, pa3);
#undef PK4
}
constexpr int OFF_KR = 16384;
constexpr int OFF_QR = ATT_LDS, ATT_LDS2 = OFF_QR + NWAVES * 4096;
__device__ __forceinline__ void qkt(f32x16& p0, f32x16& p1, const LAS unsigned char* Ks, const bf16x8* qr, const LAS unsigned char* qrl, int r32, int hi, float seed) {
#pragma unroll
    for (int r = 0; r < 16; ++r) { p0[r] = seed; p1[r] = seed; }
    const int swn = (r32 & 15) << 4, swr = ((r32 >> 1) & 7) << 4;
#pragma unroll
    for (int d0 = 0; d0 < 8; ++d0) { const int cb = (d0 * 16 + hi * 8) * 2;
        const bf16x8 b0 = *(const LAS bf16x8*)(Ks + r32 * 256 + (cb ^ swn));
        const bf16x8 b1 = *(const LAS bf16x8*)(Ks + (32 + r32) * 256 + (cb ^ swn));
        p0 = __builtin_amdgcn_mfma_f32_32x32x16_bf16(b0, qr[d0], p0, 0, 0, 0);
        p1 = __builtin_amdgcn_mfma_f32_32x32x16_bf16(b1, qr[d0], p1, 0, 0, 0); }
#pragma unroll
    for (int d0 = 0; d0 < 4; ++d0) { const int cb = (d0 * 16 + hi * 8) * 2;
        const bf16x8 b0 = *(const LAS bf16x8*)(Ks + OFF_KR + r32 * 128 + (cb ^ swr));
        const bf16x8 b1 = *(const LAS bf16x8*)(Ks + OFF_KR + (32 + r32) * 128 + (cb ^ swr));
#if ATT_QR_LDS
        const bf16x8 q = *(const LAS bf16x8*)(qrl + d0 * 1024);
#else
        const bf16x8 q = qr[8 + d0];
#endif
        p0 = __builtin_amdgcn_mfma_f32_32x32x16_bf16(b0, q, p0, 0, 0, 0);
        p1 = __builtin_amdgcn_mfma_f32_32x32x16_bf16(b1, q, p1, 0, 0, 0); }
}
__device__ __forceinline__ void attn_unit(const bf16* __restrict__ Q, const bf16* __restrict__ KN, const bf16* __restrict__ KR, const bf16* __restrict__ V, const bf16* __restrict__ G1, bf16* __restrict__ CC,
                                          int qrow0, int h, int nt_lat, int lat0, int ctx0, LAS unsigned char* lds) {
    int tid_l = threadIdx.x; asm volatile("" : "+v"(tid_l)); const int tid = tid_l, wid = __builtin_amdgcn_readfirstlane(tid >> 6), lane = tid & 63, r32 = lane & 31, hi = lane >> 5;
    LAS unsigned char* V_lds = lds + OFF_V; LAS unsigned char* K_lds = lds + OFF_K;
    LAS float* wsf = (LAS float*)(lds + OFF_WS) + wid * 64; LAS float* li_l = wsf; LAS float* al_l = wsf + 32;
    LAS unsigned char* qrl = lds + OFF_QR + wid * 4096 + lane * 16;
    float m_reg = -1e30f, l_reg = 0;
    f32x16 o[4];
#pragma unroll
    for (int d = 0; d < 4; ++d)
#pragma unroll
        for (int r = 0; r < 16; ++r) o[d][r] = 0.f;
    const unsigned ko = (unsigned)((tid >> 4) * 128 + (((tid & 15) ^ ((tid >> 4) & 15)) * 8));
    const unsigned kro = (unsigned)((tid >> 3) * 64 + (((tid & 7) ^ ((tid >> 4) & 7)) * 8));
    unsigned vo; { const int sub = tid >> 5, kk = (sub >> 2) * 8 + ((tid & 31) >> 2), col = (sub & 3) * 32 + (tid & 3) * 8, key = (kk & ~0xC) | ((kk & 4) << 1) | ((kk & 8) >> 1); vo = (unsigned)(key * 128 + col); }
    const int vb0 = (int)(unsigned)(unsigned long long)lds + OFF_V + v_rd_base(lane);
    const int NT = nt_lat + 4;
#define TROW(jt) ((jt) < nt_lat ? lat0 + 64 * (jt) : ctx0 + 64 * ((jt) - nt_lat))
#define GLDS(gp, lp) __builtin_amdgcn_global_load_lds((const unsigned*)(gp), (LAS unsigned*)(lp), 16, 0, 0)
#define GLDS_S(gbase, boff, lp) do { const char* gb_ = (const char*)(gbase); asm volatile("" : "+s"(gb_)); unsigned bo_ = (boff); asm volatile("" : "+v"(bo_)); GLDS(gb_ + bo_, lp); } while (0)
#define ISSUE_K(jt, b) do { const int R0_ = TROW(jt); const bf16* Kb_ = uni(KN + ((size_t)h * MTOT + R0_) * 128); const bf16* Rb_ = uni(KR + (size_t)R0_ * 64); \
    GLDS_S(Kb_, ko * 2u, K_lds + (b) * SHM_K + wid * 1024); GLDS_S(Kb_ + 32 * 128, ko * 2u, K_lds + (b) * SHM_K + (wid + 8) * 1024); GLDS_S(Rb_, kro * 2u, K_lds + (b) * SHM_K + OFF_KR + wid * 1024); } while (0)
#define ISSUE_V(jt, b) do { const int R0_ = TROW(jt); const bf16* Vb_ = uni(V + ((size_t)h * MTOT + R0_) * 128); \
    GLDS_S(Vb_, vo * 2u, V_lds + (b) * SHM_V + wid * 1024); GLDS_S(Vb_ + 32 * 128, vo * 2u, V_lds + (b) * SHM_V + (wid + 8) * 1024); } while (0)
#define STEP_END() asm volatile("s_waitcnt vmcnt(0) lgkmcnt(0)\n\ts_barrier" ::: "memory")
#define RESC(a_) do { if (__any((a_) < 1.f)) { if (hi == 0) al_l[r32] = (a_); asm volatile("s_waitcnt lgkmcnt(0)" ::: "memory"); \
    _Pragma("unroll") for (int d = 0; d < 4; ++d) _Pragma("unroll") for (int r = 0; r < 16; ++r) o[d][r] *= al_l[crow(r, hi)]; } } while (0)
    STEP_END();
    ISSUE_K(0, 0);
    bf16x8 qr[ATT_QR_LDS ? 8 : 12];
    { const bf16* Qw = uni(Q + (size_t)(qrow0 + wid * QBLK) * NQ + h * 192); const unsigned qo = (unsigned)(r32 * NQ + hi * 8);
#pragma unroll
      for (int d0 = 0; d0 < (ATT_QR_LDS ? 8 : 12); ++d0) qr[d0] = *(const bf16x8*)(Qw + qo + d0 * 16);
#if ATT_QR_LDS
#pragma unroll
      for (int d0 = 8; d0 < 12; ++d0) { const bf16x8 t = *(const bf16x8*)(Qw + qo + d0 * 16); *(LAS bf16x8*)(qrl + (d0 - 8) * 1024) = t; }
#endif
    }
    f32x16 pA0, pA1, pB0, pB1; float alA, alB; bf16x8 pa0, pa1, pa2, pa3;
    STEP_END();
#if !ATT_STAGGER
    ISSUE_K(1, 1); ISSUE_V(0, 0);
    qkt(pA0, pA1, K_lds, qr, qrl, r32, hi, 0.f); partialSM_first(pA0, pA1, m_reg, alA);
    STEP_END();
    for (int j = 1; j + 1 < NT; j += 2) {
        ISSUE_K(j + 1, 0); ISSUE_V(j, 1);
        SBAR(); qkt(pB0, pB1, K_lds + SHM_K, qr, qrl, r32, hi, -m_reg);
        finishSM(pA0, pA1, alA, l_reg, pa0, pa1, pa2, pa3); SBAR();
        pv_pipe(o, vb0, pa0, pa1, pa2, pa3); partialSM(pB0, pB1, m_reg, alB);
        RESC(alB); STEP_END();
        ISSUE_K(j + 2, 1); ISSUE_V(j + 1, 0);
        SBAR(); qkt(pA0, pA1, K_lds, qr, qrl, r32, hi, -m_reg);
        finishSM(pB0, pB1, alB, l_reg, pa0, pa1, pa2, pa3); SBAR();
        pv_pipe(o, vb0 + SHM_V, pa0, pa1, pa2, pa3); partialSM(pA0, pA1, m_reg, alA);
        RESC(alA); STEP_END();
    }
    ISSUE_V(NT - 1, 1);
    SBAR(); qkt(pB0, pB1, K_lds + SHM_K, qr, qrl, r32, hi, -m_reg);
    finishSM(pA0, pA1, alA, l_reg, pa0, pa1, pa2, pa3); SBAR();
    pv_pipe(o, vb0, pa0, pa1, pa2, pa3); partialSM(pB0, pB1, m_reg, alB);
    RESC(alB); STEP_END();
    finishSM(pB0, pB1, alB, l_reg, pa0, pa1, pa2, pa3); SBAR();
    pv_pipe(o, vb0 + SHM_V, pa0, pa1, pa2, pa3);
#else
#define VOFF(t) (__builtin_amdgcn_readfirstlane(((unsigned)(t) % 3u) * (unsigned)SHM_V))
    if (STG_SEL == 0 ? (wid < 4) : (STG_SEL == 1)) {
        ISSUE_K(1, 1); ISSUE_V(0, 0);
        qkt(pA0, pA1, K_lds, qr, qrl, r32, hi, 0.f); partialSM_first(pA0, pA1, m_reg, alA);
        STEP_END();
        for (int j = 1; j + 1 < NT; j += 2) {
            ISSUE_K(j + 1, 0); ISSUE_V(j, j % 3);
            SBAR(); qkt(pB0, pB1, K_lds + SHM_K, qr, qrl, r32, hi, -m_reg); SBAR();
            finishSM(pA0, pA1, alA, l_reg, pa0, pa1, pa2, pa3); SBAR();
            pv_pipe(o, vb0 + VOFF(j - 1), pa0, pa1, pa2, pa3); partialSM(pB0, pB1, m_reg, alB);
            RESC(alB); STEP_END();
            ISSUE_K(j + 2, 1); ISSUE_V(j + 1, (j + 1) % 3);
            SBAR(); qkt(pA0, pA1, K_lds, qr, qrl, r32, hi, -m_reg); SBAR();
            finishSM(pB0, pB1, alB, l_reg, pa0, pa1, pa2, pa3); SBAR();
            pv_pipe(o, vb0 + VOFF(j), pa0, pa1, pa2, pa3); partialSM(pA0, pA1, m_reg, alA);
            RESC(alA); STEP_END();
        }
        ISSUE_V(NT - 1, (NT - 1) % 3);
        SBAR(); qkt(pB0, pB1, K_lds + SHM_K, qr, qrl, r32, hi, -m_reg); SBAR();
        finishSM(pA0, pA1, alA, l_reg, pa0, pa1, pa2, pa3); SBAR();
        pv_pipe(o, vb0 + VOFF(NT - 2), pa0, pa1, pa2, pa3); partialSM(pB0, pB1, m_reg, alB);
        RESC(alB); STEP_END();
        finishSM(pB0, pB1, alB, l_reg, pa0, pa1, pa2, pa3); SBAR();
        pv_pipe(o, vb0 + VOFF(NT - 1), pa0, pa1, pa2, pa3);
        STEP_END();
        STEP_END();
    } else {
#define TR_EVEN(j_) do { finishSM(pA0, pA1, alA, l_reg, pa0, pa1, pa2, pa3); SBAR(); pv_pipe(o, vb0 + VOFF((j_) - 2), pa0, pa1, pa2, pa3); partialSM(pB0, pB1, m_reg, alB); RESC(alB); } while (0)
#define TR_ODD(j_)  do { finishSM(pB0, pB1, alB, l_reg, pa0, pa1, pa2, pa3); SBAR(); pv_pipe(o, vb0 + VOFF((j_) - 2), pa0, pa1, pa2, pa3); partialSM(pA0, pA1, m_reg, alA); RESC(alA); } while (0)
        ISSUE_K(1, 1); ISSUE_V(0, 0);
        qkt(pA0, pA1, K_lds, qr, qrl, r32, hi, 0.f);
        STEP_END();
        ISSUE_K(2, 0); ISSUE_V(1, 1);
        partialSM_first(pA0, pA1, m_reg, alA);
        SBAR(); qkt(pB0, pB1, K_lds + SHM_K, qr, qrl, r32, hi, -m_reg); SBAR();
        STEP_END();
        for (int j = 2; j + 1 < NT - 1; j += 2) {
            ISSUE_K(j + 1, 1); ISSUE_V(j, j % 3);
            TR_EVEN(j); SBAR(); qkt(pA0, pA1, K_lds, qr, qrl, r32, hi, -m_reg); SBAR();
            STEP_END();
            ISSUE_K(j + 2, 0); ISSUE_V(j + 1, (j + 1) % 3);
            TR_ODD(j + 1); SBAR(); qkt(pB0, pB1, K_lds + SHM_K, qr, qrl, r32, hi, -m_reg); SBAR();
            STEP_END();
        }
        ISSUE_K(NT - 1, 1); ISSUE_V(NT - 2, (NT - 2) % 3);
        TR_EVEN(NT - 2); SBAR(); qkt(pA0, pA1, K_lds, qr, qrl, r32, hi, -m_reg); SBAR();
        STEP_END();
        ISSUE_V(NT - 1, (NT - 1) % 3);
        TR_ODD(NT - 1); SBAR(); qkt(pB0, pB1, K_lds + SHM_K, qr, qrl, r32, hi, -m_reg); SBAR();
        STEP_END();
        TR_EVEN(NT);
        STEP_END();
        finishSM(pB0, pB1, alB, l_reg, pa0, pa1, pa2, pa3); SBAR();
        pv_pipe(o, vb0 + VOFF(NT - 1), pa0, pa1, pa2, pa3);
        STEP_END();
#undef TR_EVEN
#undef TR_ODD
    }
#undef VOFF
#endif
    if (hi == 0) li_l[r32] = l_reg;
    STEP_END();
    { LAS unsigned char* mx = lds + wid * (32 * 272);
      int r32e = r32, hie = hi; asm volatile("" : "+v"(r32e), "+v"(hie));
#pragma unroll
      for (int r = 0; r < 16; ++r) { const int rr = crow(r, hie); const float rli = __builtin_amdgcn_rcpf(li_l[rr]);
#pragma unroll
        for (int d0 = 0; d0 < 4; ++d0) *(LAS bf16*)(mx + rr * 272 + (d0 * 32 + r32e) * 2) = (bf16)(cvtpk(o[d0][r] * rli, 0.f) & 0xffffu); }
      asm volatile("s_waitcnt lgkmcnt(0)" ::: "memory");
      const bf16* Gz = uni(G1 + (size_t)(qrow0 + wid * QBLK) * N_AB + G1_ZA + h * 128); bf16* Co = uni(CC + (size_t)(qrow0 + wid * QBLK) * MIXW + h * 128);
      int le = lane; asm volatile("" : "+v"(le));
#pragma unroll
      for (int i = 0; i < 8; ++i) { const int id = 64 * i + le, row = id >> 4, c8 = (id & 15) * 8;
          const v4u oq = *(const LAS v4u*)(mx + row * 272 + c8 * 2); const v4u zq = LDNT((const v4u*)(Gz + (unsigned)(row * N_AB + c8)));
          v4u wq;
#pragma unroll
          for (int e = 0; e < 4; ++e) wq[e] = cvtpk(bf_lo(oq[e]) * bf_lo(zq[e]), bf_hi(oq[e]) * bf_hi(zq[e]));
          *(v4u*)(Co + (unsigned)(row * MIXW + c8)) = wq;
          if ((i & 3) == 3) asm volatile("" ::: "memory"); } }
#undef TROW
#undef GLDS
#undef ISSUE_K
#undef ISSUE_V
#undef STEP_END
#undef RESC
}
}
namespace att2 {
using namespace att;
struct P8 { f32x4 t[2][4]; };
__device__ __forceinline__ float x16(float x) { return __int_as_float(__builtin_amdgcn_ds_swizzle(__float_as_int(x), 0x401F)); }
__device__ __forceinline__ float rmax4(float x) { x = fmaxf(x, x16(x)); auto rr = __builtin_amdgcn_permlane32_swap(__float_as_uint(x), __float_as_uint(x), false, false); return fmaxf(__uint_as_float(rr[0]), __uint_as_float(rr[1])); }
__device__ __forceinline__ float rsum4(float x) { x = x + x16(x); auto rr = __builtin_amdgcn_permlane32_swap(__float_as_uint(x), __float_as_uint(x), false, false); return __uint_as_float(rr[0]) + __uint_as_float(rr[1]); }
__device__ __forceinline__ float tmax(const P8& p, int qt) { float m = p.t[qt][0][0];
#pragma unroll
    for (int kt = 0; kt < 4; ++kt)
#pragma unroll
        for (int r = 0; r < 4; ++r) m = fmaxf(m, p.t[qt][kt][r]);
    return m; }
__device__ __forceinline__ void qkt2(P8& p, const LAS unsigned char* Ks, const bf16x8 (&qf)[2][4], const LAS unsigned char* qrl, int l16, int g4, float seed0, float seed1) {
#pragma unroll
    for (int kt = 0; kt < 4; ++kt) { p.t[0][kt] = (f32x4){seed0, seed0, seed0, seed0}; p.t[1][kt] = (f32x4){seed1, seed1, seed1, seed1}; }
    const int swn = l16 << 4, swr = ((l16 >> 1) & 7) << 4;
#pragma unroll
    for (int ks = 0; ks < 4; ++ks) { const int cb = (32 * ks + 8 * g4) * 2;
#pragma unroll
        for (int kt = 0; kt < 4; ++kt) { const bf16x8 kf = *(const LAS bf16x8*)(Ks + (16 * kt + l16) * 256 + (cb ^ swn));
            p.t[0][kt] = mfma16(kf, qf[0][ks], p.t[0][kt]); p.t[1][kt] = mfma16(kf, qf[1][ks], p.t[1][kt]); } }
#pragma unroll
    for (int ks = 0; ks < 2; ++ks) { const int cb = (32 * ks + 8 * g4) * 2;
        const bf16x8 q0 = *(const LAS bf16x8*)(qrl + ks * 1024), q1 = *(const LAS bf16x8*)(qrl + (2 + ks) * 1024);
#pragma unroll
        for (int kt = 0; kt < 4; ++kt) { const bf16x8 kf = *(const LAS bf16x8*)(Ks + OFF_KR + (16 * kt + l16) * 128 + (cb ^ swr));
            p.t[0][kt] = mfma16(kf, q0, p.t[0][kt]); p.t[1][kt] = mfma16(kf, q1, p.t[1][kt]); } }
}
__device__ __forceinline__ void sub_all(P8& p, float d0, float d1) {
#pragma unroll
    for (int kt = 0; kt < 4; ++kt) { p.t[0][kt] = p.t[0][kt] - d0; p.t[1][kt] = p.t[1][kt] - d1; } }
__device__ __forceinline__ void exp_half(P8& p, int k0) {
#pragma unroll
    for (int qt = 0; qt < 2; ++qt)
#pragma unroll
        for (int kt = 0; kt < 2; ++kt)
#pragma unroll
            for (int r = 0; r < 4; ++r) p.t[qt][k0 + kt][r] = __builtin_amdgcn_exp2f(p.t[qt][k0 + kt][r]); }
__device__ __forceinline__ void partial2_first(P8& p, float& m0, float& m1, float& a0, float& a1) {
    m0 = rmax4(tmax(p, 0)); m1 = rmax4(tmax(p, 1)); a0 = 1.f; a1 = 1.f; sub_all(p, m0, m1); exp_half(p, 0); }
__device__ __forceinline__ void partial2(P8& p, float& m0, float& m1, float& a0, float& a1) {
    const float x0 = rmax4(tmax(p, 0)), x1 = rmax4(tmax(p, 1));
    if (__builtin_expect(__all(fmaxf(x0, x1) <= THRL), 1)) { a0 = 1.f; a1 = 1.f; }
    else { const float d0 = fmaxf(x0, 0.f), d1 = fmaxf(x1, 0.f); a0 = __builtin_amdgcn_exp2f(-d0); a1 = __builtin_amdgcn_exp2f(-d1); m0 += d0; m1 += d1; sub_all(p, d0, d1); }
    exp_half(p, 0); }
__device__ __forceinline__ void finish2(P8& p, float a0, float a1, float& l0, float& l1, bf16x8 (&pb)[2][2]) {
    exp_half(p, 2);
    float s0 = 0.f, s1 = 0.f;
#pragma unroll
    for (int kt = 0; kt < 4; ++kt)
#pragma unroll
        for (int r = 0; r < 4; ++r) { s0 += p.t[0][kt][r]; s1 += p.t[1][kt][r]; }
    l0 = l0 * a0 + rsum4(s0); l1 = l1 * a1 + rsum4(s1);
#pragma unroll
    for (int qt = 0; qt < 2; ++qt)
#pragma unroll
        for (int s2 = 0; s2 < 2; ++s2) { v4u w; w.x = cvtpk(p.t[qt][2 * s2][0], p.t[qt][2 * s2][1]); w.y = cvtpk(p.t[qt][2 * s2][2], p.t[qt][2 * s2][3]);
            w.z = cvtpk(p.t[qt][2 * s2 + 1][0], p.t[qt][2 * s2 + 1][1]); w.w = cvtpk(p.t[qt][2 * s2 + 1][2], p.t[qt][2 * s2 + 1][3]); pb[qt][s2] = __builtin_bit_cast(bf16x8, w); }
}
template <int B, int I> __device__ __forceinline__ void pv2_rd(const int (&vo)[8], s16x4& lo, s16x4& hi) { constexpr int s2 = I >> 3, vt = I & 7;
    lo = tr_read<B * SHM_V + s2 * 8192>(vo[vt]); hi = tr_read<B * SHM_V + s2 * 8192 + 4096>(vo[vt]); }
#define PV2_MM(I, L, H) do { const bf16x8 af_ = (bf16x8){L[0], L[1], L[2], L[3], H[0], H[1], H[2], H[3]}; \
    o[(I) & 7][0] = mfma16(af_, pb[0][(I) >> 3], o[(I) & 7][0]); o[(I) & 7][1] = mfma16(af_, pb[1][(I) >> 3], o[(I) & 7][1]); } while (0)
#define PV2_W(N) do { asm volatile("s_waitcnt lgkmcnt(" #N ")" ::: "memory"); SBAR(); } while (0)
template <int B> __device__ __forceinline__ void pv2(f32x4 (&o)[8][2], const int (&vo)[8], const bf16x8 (&pb)[2][2]) {
    s16x4 l0, h0, l1, h1, l2, h2;
    asm volatile("s_waitcnt lgkmcnt(0)" ::: "memory"); SBAR();
    pv2_rd<B, 0>(vo, l0, h0); pv2_rd<B, 1>(vo, l1, h1); pv2_rd<B, 2>(vo, l2, h2);
    PV2_W(4); PV2_MM(0, l0, h0); SBAR(); pv2_rd<B, 3>(vo, l0, h0);
    PV2_W(4); PV2_MM(1, l1, h1); SBAR(); pv2_rd<B, 4>(vo, l1, h1);
    PV2_W(4); PV2_MM(2, l2, h2); SBAR(); pv2_rd<B, 5>(vo, l2, h2);
    PV2_W(4); PV2_MM(3, l0, h0); SBAR(); pv2_rd<B, 6>(vo, l0, h0);
    PV2_W(4); PV2_MM(4, l1, h1); SBAR(); pv2_rd<B, 7>(vo, l1, h1);
    PV2_W(4); PV2_MM(5, l2, h2); SBAR(); pv2_rd<B, 8>(vo, l2, h2);
    PV2_W(4); PV2_MM(6, l0, h0); SBAR(); pv2_rd<B, 9>(vo, l0, h0);
    PV2_W(4); PV2_MM(7, l1, h1); SBAR(); pv2_rd<B, 10>(vo, l1, h1);
    PV2_W(4); PV2_MM(8, l2, h2); SBAR(); pv2_rd<B, 11>(vo, l2, h2);
    PV2_W(4); PV2_MM(9, l0, h0); SBAR(); pv2_rd<B, 12>(vo, l0, h0);
    PV2_W(4); PV2_MM(10, l1, h1); SBAR(); pv2_rd<B, 13>(vo, l1, h1);
    PV2_W(4); PV2_MM(11, l2, h2); SBAR(); pv2_rd<B, 14>(vo, l2, h2);
    PV2_W(4); PV2_MM(12, l0, h0); SBAR(); pv2_rd<B, 15>(vo, l0, h0);
    PV2_W(4); PV2_MM(13, l1, h1);
    PV2_W(2); PV2_MM(14, l2, h2);
    PV2_W(0); PV2_MM(15, l0, h0);
}
__device__ __forceinline__ void attn_unit2(const bf16* __restrict__ Q, const bf16* __restrict__ KN, const bf16* __restrict__ KR, const bf16* __restrict__ V, const bf16* __restrict__ G1, bf16* __restrict__ CC,
                                           int qrow0, int h, int nt_lat, int lat0, int ctx0, LAS unsigned char* lds) {
    int tid_l = threadIdx.x; asm volatile("" : "+v"(tid_l)); const int tid = tid_l, wid = __builtin_amdgcn_readfirstlane(tid >> 6), lane = tid & 63, l16 = lane & 15, g4 = lane >> 4;
    LAS unsigned char* V_lds = lds + OFF_V; LAS unsigned char* K_lds = lds + OFF_K;
    LAS unsigned char* qrl = lds + OFF_QR + wid * 4096 + lane * 16;
    float m0 = 0.f, m1 = 0.f, l0 = 0.f, l1 = 0.f;
    f32x4 o[8][2];
#pragma unroll
    for (int vt = 0; vt < 8; ++vt) { o[vt][0] = (f32x4){0.f, 0.f, 0.f, 0.f}; o[vt][1] = (f32x4){0.f, 0.f, 0.f, 0.f}; }
    const unsigned ko = (unsigned)((tid >> 4) * 128 + (((tid & 15) ^ ((tid >> 4) & 15)) * 8));
    const unsigned kro = (unsigned)((tid >> 3) * 64 + (((tid & 7) ^ ((tid >> 4) & 7)) * 8));
    const unsigned vo_g = (unsigned)((tid >> 4) * 128 + ((((((tid & 15) >> 1) ^ ((tid >> 4) & 7)) << 1) | (tid & 1)) * 8));
    int vo[8];
    { const int q = l16 >> 2, pp = l16 & 3, rr = 4 * g4 + q, sw = rr & 7, base = (int)(unsigned)(unsigned long long)lds + OFF_V + rr * 256 + 8 * pp;
#pragma unroll
      for (int vt = 0; vt < 8; ++vt) vo[vt] = base + ((vt ^ sw) << 5); }
    const int NT = nt_lat + 4;
#define TROW(jt) ((jt) < nt_lat ? lat0 + 64 * (jt) : ctx0 + 64 * ((jt) - nt_lat))
#define GLDS(gp, lp) __builtin_amdgcn_global_load_lds((const unsigned*)(gp), (LAS unsigned*)(lp), 16, 0, 0)
#define ISSUE_K(jt, b) do { const int R0_ = TROW(jt); const bf16* Kb_ = uni(KN + ((size_t)h * MTOT + R0_) * 128); const bf16* Rb_ = uni(KR + (size_t)R0_ * 64); \
    GLDS(Kb_ + ko, K_lds + (b) * SHM_K + wid * 1024); GLDS(Kb_ + ko + 32 * 128, K_lds + (b) * SHM_K + (wid + 8) * 1024); GLDS(Rb_ + kro, K_lds + (b) * SHM_K + OFF_KR + wid * 1024); } while (0)
#define ISSUE_V(jt, b) do { const int R0_ = TROW(jt); const bf16* Vb_ = uni(V + ((size_t)h * MTOT + R0_) * 128); \
    GLDS(Vb_ + vo_g, V_lds + (b) * SHM_V + wid * 1024); GLDS(Vb_ + vo_g + 32 * 128, V_lds + (b) * SHM_V + (wid + 8) * 1024); } while (0)
#define STEP_END() asm volatile("s_waitcnt vmcnt(0) lgkmcnt(0)\n\ts_barrier" ::: "memory")
#define RESC2(a0_, a1_) do { if (__any(fminf(a0_, a1_) < 1.f)) { _Pragma("unroll") for (int vt = 0; vt < 8; ++vt) { o[vt][0] = o[vt][0] * (a0_); o[vt][1] = o[vt][1] * (a1_); } } } while (0)
    STEP_END();
    ISSUE_K(0, 0);
    bf16x8 qf[2][4];
    { const bf16* Qw = uni(Q + (size_t)(qrow0 + wid * QBLK) * NQ + h * 192); const unsigned qo = (unsigned)(l16 * NQ + g4 * 8);
#pragma unroll
      for (int qt = 0; qt < 2; ++qt) {
#pragma unroll
        for (int ks = 0; ks < 4; ++ks) qf[qt][ks] = *(const bf16x8*)(Qw + qo + (unsigned)(qt * 16 * NQ + ks * 32));
#pragma unroll
        for (int ks = 4; ks < 6; ++ks) { const bf16x8 t = *(const bf16x8*)(Qw + qo + (unsigned)(qt * 16 * NQ + ks * 32)); *(LAS bf16x8*)(qrl + (qt * 2 + ks - 4) * 1024) = t; } } }
    P8 pA, pB; float aA0, aA1, aB0, aB1; bf16x8 pb[2][2];
    STEP_END();
    ISSUE_K(1, 1); ISSUE_V(0, 0);
    qkt2(pA, K_lds, qf, qrl, l16, g4, 0.f, 0.f); partial2_first(pA, m0, m1, aA0, aA1);
    STEP_END();
    for (int j = 1; j + 1 < NT; j += 2) {
        ISSUE_K(j + 1, 0); ISSUE_V(j, 1);
        SBAR(); qkt2(pB, K_lds + SHM_K, qf, qrl, l16, g4, -m0, -m1);
        finish2(pA, aA0, aA1, l0, l1, pb); SBAR();
        pv2<0>(o, vo, pb); partial2(pB, m0, m1, aB0, aB1);
        RESC2(aB0, aB1); STEP_END();
        ISSUE_K(j + 2, 1); ISSUE_V(j + 1, 0);
        SBAR(); qkt2(pA, K_lds, qf, qrl, l16, g4, -m0, -m1);
        finish2(pB, aB0, aB1, l0, l1, pb); SBAR();
        pv2<1>(o, vo, pb); partial2(pA, m0, m1, aA0, aA1);
        RESC2(aA0, aA1); STEP_END();
    }
    ISSUE_V(NT - 1, 1);
    SBAR(); qkt2(pB, K_lds + SHM_K, qf, qrl, l16, g4, -m0, -m1);
    finish2(pA, aA0, aA1, l0, l1, pb); SBAR();
    pv2<0>(o, vo, pb); partial2(pB, m0, m1, aB0, aB1);
    RESC2(aB0, aB1); STEP_END();
    finish2(pB, aB0, aB1, l0, l1, pb); SBAR();
    pv2<1>(o, vo, pb);
    STEP_END();
    { LAS unsigned char* mx = lds + wid * (32 * 272);
      const float r0 = __builtin_amdgcn_rcpf(l0), r1 = __builtin_amdgcn_rcpf(l1);
#pragma unroll
      for (int vt = 0; vt < 8; ++vt) { u32x2 w;
          w.x = cvtpk(o[vt][0][0] * r0, o[vt][0][1] * r0); w.y = cvtpk(o[vt][0][2] * r0, o[vt][0][3] * r0); *(LAS u32x2*)(mx + l16 * 272 + (16 * vt + 4 * g4) * 2) = w;
          w.x = cvtpk(o[vt][1][0] * r1, o[vt][1][1] * r1); w.y = cvtpk(o[vt][1][2] * r1, o[vt][1][3] * r1); *(LAS u32x2*)(mx + (16 + l16) * 272 + (16 * vt + 4 * g4) * 2) = w; }
      asm volatile("s_waitcnt lgkmcnt(0)" ::: "memory");
      const bf16* Gz = uni(G1 + (size_t)(qrow0 + wid * QBLK) * N_AB + G1_ZA + h * 128); bf16* Co = uni(CC + (size_t)(qrow0 + wid * QBLK) * MIXW + h * 128);
      int le = lane; asm volatile("" : "+v"(le));
#pragma unroll
      for (int i = 0; i < 8; ++i) { const int id = 64 * i + le, row = id >> 4, c8 = (id & 15) * 8;
          const v4u oq = *(const LAS v4u*)(mx + row * 272 + c8 * 2); const v4u zq = LDNT((const v4u*)(Gz + (unsigned)(row * N_AB + c8)));
          v4u wq;
#pragma unroll
          for (int e = 0; e < 4; ++e) wq[e] = cvtpk(bf_lo(oq[e]) * bf_lo(zq[e]), bf_hi(oq[e]) * bf_hi(zq[e]));
          *(v4u*)(Co + (unsigned)(row * MIXW + c8)) = wq;
          if ((i & 3) == 3) asm volatile("" ::: "memory"); } }
#undef TROW
#undef GLDS
#undef ISSUE_K
#undef ISSUE_V
#undef STEP_END
#undef RESC2
}
#undef PV2_MM
#undef PV2_W
}
#ifndef ATT_PRIO
#define ATT_PRIO 1
#endif
#ifndef ATT_BODY2
#define ATT_BODY2 0
#endif
__device__ __forceinline__ void attn_phase(KArgs a, LAS unsigned char* lds, int G) {
    const bf16* Q = (const bf16*)(GWS(a) + WS_Q); const bf16* KN = (const bf16*)(GWS(a) + WS_KN); const bf16* KR = (const bf16*)(GWS(a) + WS_KR); const bf16* V = (const bf16*)(GWS(a) + WS_V);
    const bf16* G1 = (const bf16*)(GWS(a) + WS_G1); bf16* CC = (bf16*)(GWS(a) + WS_CC);
    const int bx = blockIdx.x; const int vcu = (G % 8 == 0) ? (bx % 8) * (G / 8) + bx / 8 : bx;
    if (ATT_PRIO && __builtin_amdgcn_readfirstlane(threadIdx.x >> 6) >= 4) __builtin_amdgcn_s_setprio(1);
    for (int u = vcu; u < 2048 + 64; u += G) {
        if (u < 2048) { const int bh = u >> 5, qb = u & 31, b = bh >> 5, h = bh & 31;
            if (ATT_BODY2) att2::attn_unit2(Q, KN, KR, V, G1, CC, b * SEQ + qb * 256, h, 128, b * SEQ, MLAT + b * NCTX, lds); else att::attn_unit(Q, KN, KR, V, G1, CC, b * SEQ + qb * 256, h, 128, b * SEQ, MLAT + b * NCTX, lds); }
        else { const int bh = u - 2048, b = bh >> 5, h = bh & 31;
            if (ATT_BODY2) att2::attn_unit2(Q, KN, KR, V, G1, CC, MLAT + b * NCTX, h, 0, 0, MLAT + b * NCTX, lds); else att::attn_unit(Q, KN, KR, V, G1, CC, MLAT + b * NCTX, h, 0, 0, MLAT + b * NCTX, lds); }
    }
    if (ATT_PRIO) __builtin_amdgcn_s_setprio(0);
    __syncthreads();
}

__device__ __forceinline__ s16x4 tr_read_v(int addr) { s16x4 r; asm volatile("ds_read_b64_tr_b16 %0, %1" : "=&v"(r) : "v"(addr) : "memory"); return r; }
template <int CTRL> __device__ __forceinline__ float dpp_f(float x) { return __int_as_float(__builtin_amdgcn_update_dpp(0, __float_as_int(x), CTRL, 0xf, 0xf, true)); }
constexpr int SC_PITCH = 288;
constexpr int SC_QD = 0, SC_KD = 16 * SC_PITCH, SC_KE = 32 * SC_PITCH, SC_VV = 48 * SC_PITCH, SC_EB = 64 * SC_PITCH, SC_BUF = SC_EB + 512;
constexpr int SC_OST = 2 * SC_BUF;
__device__ __forceinline__ void scan_stage(LAS unsigned char* B, u32x2 rq, u32x2 rk, u32x2 rv, int wid, int lane, int tid) {
    const int t = lane & 15, kq = lane >> 4;
    float q[4], kk[4], x[4], tot[4];
    q[0] = bf_lo(rq.x); q[1] = bf_hi(rq.x); q[2] = bf_lo(rq.y); q[3] = bf_hi(rq.y); kk[0] = bf_lo(rk.x); kk[1] = bf_hi(rk.x); kk[2] = bf_lo(rk.y); kk[3] = bf_hi(rk.y);
#pragma unroll
    for (int e = 0; e < 4; ++e) { x[e] = __builtin_amdgcn_logf(fmaxf(1.0f - kk[e], 1e-30f)); tot[e] = x[e]; }
#define SC_DPP8(cg_, cs_) \
        "v_add_f32_dpp %0, %0, %0 " cg_ " row_mask:0xf bank_mask:0xf bound_ctrl:0\n\tv_add_f32_dpp %1, %1, %1 " cg_ " row_mask:0xf bank_mask:0xf bound_ctrl:0\n\t" \
        "v_add_f32_dpp %2, %2, %2 " cg_ " row_mask:0xf bank_mask:0xf bound_ctrl:0\n\tv_add_f32_dpp %3, %3, %3 " cg_ " row_mask:0xf bank_mask:0xf bound_ctrl:0\n\t" \
        "v_add_f32_dpp %4, %4, %4 " cs_ " row_mask:0xf bank_mask:0xf\n\tv_add_f32_dpp %5, %5, %5 " cs_ " row_mask:0xf bank_mask:0xf\n\t" \
        "v_add_f32_dpp %6, %6, %6 " cs_ " row_mask:0xf bank_mask:0xf\n\tv_add_f32_dpp %7, %7, %7 " cs_ " row_mask:0xf bank_mask:0xf\n\t"
    asm volatile("s_nop 1\n\t" SC_DPP8("row_shr:1", "row_ror:8") SC_DPP8("row_shr:2", "row_ror:4") SC_DPP8("row_shr:4", "row_ror:2") SC_DPP8("row_shr:8", "row_ror:1")
                 : "+v"(x[0]), "+v"(x[1]), "+v"(x[2]), "+v"(x[3]), "+v"(tot[0]), "+v"(tot[1]), "+v"(tot[2]), "+v"(tot[3]));
#undef SC_DPP8
    float qd[4], kd[4], ke[4];
#pragma unroll
    for (int e = 0; e < 4; ++e) { qd[e] = q[e] * __builtin_amdgcn_exp2f(x[e]); kd[e] = kk[e] * __builtin_amdgcn_exp2f(fminf(-x[e], 115.0f)); ke[e] = kk[e] * __builtin_amdgcn_exp2f(fminf(tot[e] - x[e], 0.0f)); }
    const int ppos = 32 * (wid >> 1) + 8 * kq + 4 * (wid & 1);
    u32x2 w;
    w.x = cvtpk(qd[0], qd[1]); w.y = cvtpk(qd[2], qd[3]); *(LAS u32x2*)(B + SC_QD + t * SC_PITCH + ppos * 2) = w;
    w.x = cvtpk(kd[0], kd[1]); w.y = cvtpk(kd[2], kd[3]); *(LAS u32x2*)(B + SC_KD + t * SC_PITCH + ppos * 2) = w;
    w.x = cvtpk(ke[0], ke[1]); w.y = cvtpk(ke[2], ke[3]); *(LAS u32x2*)(B + SC_KE + t * SC_PITCH + (16 * wid + 4 * kq) * 2) = w;
    if (t == 0) *(LAS f32x4*)(B + SC_EB + (16 * wid + 4 * kq) * 4) = (f32x4){__builtin_amdgcn_exp2f(tot[0]), __builtin_amdgcn_exp2f(tot[1]), __builtin_amdgcn_exp2f(tot[2]), __builtin_amdgcn_exp2f(tot[3])};
    *(LAS u32x2*)(B + SC_VV + (tid >> 5) * SC_PITCH + (tid & 31) * 8) = rv;
}
__device__ __forceinline__ void scan_phase(KArgs a, LAS unsigned char* lds, int G) {
    int tid_l = threadIdx.x; asm volatile("" : "+v"(tid_l)); const int tid = tid_l, lane = tid & 63, wid = __builtin_amdgcn_readfirstlane(tid >> 6), g4 = lane >> 4, l16 = lane & 15;
    const bf16* G1 = (const bf16*)(GWS(a) + WS_G1); const size_t TS = (size_t)MTOT * MIXW;
    const int ldsb = (int)(unsigned)(unsigned long long)lds;
    const int trq = l16 >> 2, trp = l16 & 3;
    const int st = lane & 15, sk = 16 * wid + 4 * (lane >> 4);
    const int vt_ = tid >> 5, vc = (tid & 31) * 4;
    for (int sq = blockIdx.x; sq < 256; sq += G) {
        const int dir = sq >> 7, b = (sq >> 6) & 1, h = sq & 63;
        const bf16* Tq = G1 + h * 128; const bf16* Tk = G1 + (size_t)(1 + dir) * TS + h * 128; const bf16* Tv = G1 + (size_t)3 * TS + h * 128;
        bf16* Od = (bf16*)(GWS(a) + WS_OF) + (size_t)dir * TS + h * 128;
        const unsigned oq = (unsigned)((dir ? 15 - st : st) * MIXW + sk), ovv = (unsigned)((dir ? 15 - vt_ : vt_) * MIXW + vc);
#define CLOW(c_) ((c_) < 16 ? MLAT + b * NCTX + (dir ? 240 - 16 * (c_) : 16 * (c_)) : b * SEQ + (dir ? 8432 - 16 * (c_) : 16 * (c_) - 256))
#define SLOADC(c_, rq_, rk_, rv_) do { const size_t lo_ = (size_t)CLOW(c_) * MIXW; rq_ = LDNT((const u32x2*)(uni(Tq + lo_) + oq)); rk_ = LDNT((const u32x2*)(uni(Tk + lo_) + oq)); rv_ = LDNT((const u32x2*)(uni(Tv + lo_) + ovv)); } while (0)
#define SBARRIER() do { asm volatile("s_waitcnt lgkmcnt(0)" ::: "memory"); __builtin_amdgcn_s_barrier(); asm volatile("" ::: "memory"); } while (0)
        f32x4 S[8];
#pragma unroll
        for (int i = 0; i < 8; ++i) S[i] = (f32x4){0.f, 0.f, 0.f, 0.f};
        u32x2 rq0, rk0, rv0, rq1, rk1, rv1, rq2, rk2, rv2;
        SBARRIER();
        SLOADC(0, rq0, rk0, rv0); scan_stage(lds, rq0, rk0, rv0, wid, lane, tid); SLOADC(1, rq0, rk0, rv0); SLOADC(2, rq1, rk1, rv1); SLOADC(3, rq2, rk2, rv2);
        SBARRIER();
        auto iter = [&](const int c, const int par, u32x2& rq, u32x2& rk, u32x2& rv) __attribute__((always_inline)) {
            LAS unsigned char* Bc = lds + par * SC_BUF;
            if (c > 0) { const u32x2 ov = *(const LAS u32x2*)(lds + SC_OST + (par ^ 1) * 4096 + vt_ * 256 + vc * 2); *(u32x2*)(uni(Od + (size_t)CLOW(c - 1) * MIXW) + ovv) = ov; }
            if (c + 1 < 528) { scan_stage(lds + (par ^ 1) * SC_BUF, rq, rk, rv, wid, lane, tid); SLOADC(min(c + 4, 527), rq, rk, rv); }
            bf16x8 qf[4], kf[4]; f32x4 e4[8]; s16x4 kt4[8];
#pragma unroll
            for (int ks = 0; ks < 4; ++ks) { qf[ks] = *(const LAS bf16x8*)(Bc + SC_QD + l16 * SC_PITCH + (32 * ks + 8 * g4) * 2); kf[ks] = *(const LAS bf16x8*)(Bc + SC_KD + l16 * SC_PITCH + (32 * ks + 8 * g4) * 2); }
            const int trb = ldsb + par * SC_BUF + (4 * g4 + trq) * SC_PITCH + 8 * trp;
            const s16x4 vt = tr_read_v(trb + SC_VV + 32 * wid);
#pragma unroll
            for (int kt = 0; kt < 8; ++kt) { e4[kt] = *(const LAS f32x4*)(Bc + SC_EB + (16 * kt + 4 * g4) * 4); kt4[kt] = tr_read_v(trb + SC_KE + 32 * kt); }
            f32x4 at = (f32x4){0.f, 0.f, 0.f, 0.f};
#pragma unroll
            for (int ks = 0; ks < 4; ++ks) at = mfma16(kf[ks], qf[ks], at);
#pragma unroll
            for (int r = 0; r < 4; ++r) at[r] = (4 * g4 + r <= l16) ? at[r] : 0.f;
            bf16x8 pa; { v4u w; w.x = cvtpk(at[0], at[1]); w.y = cvtpk(at[2], at[3]); w.z = 0u; w.w = 0u; pa = __builtin_bit_cast(bf16x8, w); }
            f32x4 o = (f32x4){0.f, 0.f, 0.f, 0.f};
#pragma unroll
            for (int ks = 0; ks < 4; ++ks) { v4u w; w.x = cvtpk(S[2 * ks][0], S[2 * ks][1]); w.y = cvtpk(S[2 * ks][2], S[2 * ks][3]); w.z = cvtpk(S[2 * ks + 1][0], S[2 * ks + 1][1]); w.w = cvtpk(S[2 * ks + 1][2], S[2 * ks + 1][3]);
                o = mfma16(qf[ks], __builtin_bit_cast(bf16x8, w), o); }
            asm volatile("s_waitcnt lgkmcnt(0)" ::: "memory"); SBAR();
            const bf16x8 vf = (bf16x8){vt[0], vt[1], vt[2], vt[3], 0, 0, 0, 0};
            o = mfma16(pa, vf, o);
#pragma unroll
            for (int kt = 0; kt < 8; ++kt) { const bf16x8 kef = (bf16x8){kt4[kt][0], kt4[kt][1], kt4[kt][2], kt4[kt][3], 0, 0, 0, 0};
                S[kt] = mfma16(kef, vf, S[kt] * e4[kt]); }
            { LAS bf16* ost = (LAS bf16*)(lds + SC_OST + par * 4096);
#pragma unroll
              for (int r = 0; r < 4; ++r) ost[(4 * g4 + r) * 128 + 16 * wid + l16] = (bf16)(cvtpk(o[r], 0.f) & 0xffffu); }
            SBARRIER();
        };
        for (int c = 0; c < 528; c += 6) { iter(c, 0, rq0, rk0, rv0); iter(c + 1, 1, rq1, rk1, rv1); iter(c + 2, 0, rq2, rk2, rv2); iter(c + 3, 1, rq0, rk0, rv0); iter(c + 4, 0, rq1, rk1, rv1); iter(c + 5, 1, rq2, rk2, rv2); }
        { const u32x2 ov = *(const LAS u32x2*)(lds + SC_OST + (527 & 1) * 4096 + vt_ * 256 + vc * 2); *(u32x2*)(uni(Od + (size_t)CLOW(527) * MIXW) + ovv) = ov; }
#undef CLOW
#undef SLOADC
#undef SBARRIER
    }
    asm volatile("s_waitcnt lgkmcnt(0)" ::: "memory"); __builtin_amdgcn_s_barrier(); asm volatile("" ::: "memory");
}

__device__ __forceinline__ void readout_phase(KArgs a, int jc, int nrows, int G) {
    int tid_l = threadIdx.x; asm volatile("" : "+v"(tid_l)); const int tid = tid_l, lane = tid & 63, wave = __builtin_amdgcn_readfirstlane(tid >> 6);
    const int gw = blockIdx.x * NWAVES + wave, NGW = G * NWAVES;
    const size_t TS = (size_t)MTOT * MIXW;
    const bf16* OFp = (const bf16*)(GWS(a) + WS_OF); const bf16* OBp = OFp + TS; const bf16* GS = (const bf16*)(GWS(a) + WS_G1) + 4 * TS; bf16* CC = (bf16*)(GWS(a) + WS_CC);
    const float* gnw = GIN(a, 20) + (size_t)jc * 128 + (lane & 15) * 8;
    const f32x4 w0 = *(const f32x4*)gnw, w1 = *(const f32x4*)(gnw + 4);
    for (int it = gw; it < nrows * 16; it += NGW) {
        const size_t off = (size_t)(it >> 4) * MIXW + (it & 15) * 512 + lane * 8;
        const v4u f = LDNT((const v4u*)(OFp + off)), bq = LDNT((const v4u*)(OBp + off)), gq = LDNT((const v4u*)(GS + off));
        float o[8], gg[8];
#pragma unroll
        for (int e = 0; e < 4; ++e) { o[2 * e] = bf_lo(f[e]) + bf_lo(bq[e]); o[2 * e + 1] = bf_hi(f[e]) + bf_hi(bq[e]); gg[2 * e] = bf_lo(gq[e]); gg[2 * e + 1] = bf_hi(gq[e]); }
        float ss = 0.f;
#pragma unroll
        for (int e = 0; e < 8; ++e) ss += o[e] * o[e];
        ss += __shfl_xor(ss, 1); ss += __shfl_xor(ss, 2); ss += __shfl_xor(ss, 4); ss += __shfl_xor(ss, 8);
        const float r = 1.0f / sqrtf(ss * (1.0f / 128.0f) + EPS);
        v4u w; w.x = cvtpk(o[0] * r * w0[0] * gg[0], o[1] * r * w0[1] * gg[1]); w.y = cvtpk(o[2] * r * w0[2] * gg[2], o[3] * r * w0[3] * gg[3]);
        w.z = cvtpk(o[4] * r * w1[0] * gg[4], o[5] * r * w1[1] * gg[5]); w.w = cvtpk(o[6] * r * w1[2] * gg[6], o[7] * r * w1[3] * gg[7]);
        *(v4u*)(CC + off) = w;
    }
}

#ifndef EN_P0
#define EN_P0 1
#endif
#ifndef EN_NORM
#define EN_NORM 1
#endif
#ifndef EN_A1
#define EN_A1 1
#endif
#ifndef EN_A2
#define EN_A2 1
#endif
#ifndef EN_A3
#define EN_A3 1
#endif
#ifndef EN_ATT
#define EN_ATT 1
#endif
#ifndef EN_A5
#define EN_A5 1
#endif
#ifndef EN_C1
#define EN_C1 1
#endif
#ifndef EN_SCAN
#define EN_SCAN 1
#endif
#ifndef EN_RO
#define EN_RO 1
#endif
#ifndef EN_C4
#define EN_C4 1
#endif
#ifndef EN_SGU
#define EN_SGU 1
#endif
#ifndef EN_QUP
#define EN_QUP 1
#endif
#ifndef EN_KVUP
#define EN_KVUP 1
#endif
#ifndef PG8_ALIGNV
#define PG8_ALIGNV true
#endif
#ifndef PG8_SP2V
#define PG8_SP2V true
#endif
#ifndef PROBE_MASK
#define PROBE_MASK 0u
#endif
#define REPS(k) for (int rep_ = 0; rep_ < ((((PROBE_MASK) >> (k)) & 1u) ? 2 : 1); ++rep_)
#ifndef MK_ONE_LAUNCH
#define MK_ONE_LAUNCH 1
#endif
constexpr int N_PHASES = 28;
#define IN(k) (lo <= (k) && (k) < hi)
#define SEAM(k) do { if (IN(k) && IN((k) + 1)) xcd_barrier(bar); } while (0)
template <int p> __device__ __forceinline__ void layer_pair(LAS unsigned char* lds, const int G, const int lo, const int hi, const XcdBarrier& bar) {

        const int pb = 2 + 13 * p, lab = 2 * p, lc = 2 * p + 1;
        if (EN_A1 && IN(pb + 0)) REPS(pb + 0) {
            KArgs A = kargs(); unsigned char* const wsb = GWS(A);
            pg8::Gemm g{(const pg8::bf16_t*)(wsb + WS_H), (const pg8::bf16_t*)(wsb + WS_WIN_AB) + (size_t)p * N_AB * DM, MTOT, N_AB, DM, DM}; pg8::LockstepOrder S; S.init(MTOT, N_AB, G, (int)blockIdx.x);
            pg8::EpiAB1 E{(pg8::bf16_t*)(wsb + WS_G1), N_AB};
            pg8::gemm_phase<pg8::EpiAB1, pg8::LockstepOrder, PG8_ALIGNV, PG8_SP2V>(lds, g, S, E);
            if (p0_defer_on(G)) { pg8::LockstepOrder S2; S2.init(MTOT, N_AB, G, (int)blockIdx.x); p0_deferred(kargs(), lds, S2, p == 0 ? 0 : 2); }
        } SEAM(pb + 0);
        if (EN_A2 && IN(pb + 1)) REPS(pb + 1) { a2_rows(kargs(), p, G); } SEAM(pb + 1);
        if (EN_SGU && IN(pb + 2)) REPS(pb + 2) { sgu_phase(kargs(), p, lds, G); }
        if (EN_QUP && IN(pb + 3)) REPS(pb + 3) {
            KArgs A = kargs(); unsigned char* const wsb = GWS(A);
            pg8::Gemm g{(const pg8::bf16_t*)(wsb + WS_QN), (const pg8::bf16_t*)(wsb + WS_WQ) + (size_t)p * NQ * QL, MTOT, NQ, QL, QL}; pg8::LockstepOrder S; S.init(MTOT, NQ, G, (int)blockIdx.x);
            pg8::EpiQ E{(pg8::bf16_t*)(wsb + WS_Q), (const pg8::f32x2*)(wsb + WS_ROPE), MLAT, 0.07216878364870322f * 1.4426950408889634f};
            pg8::gemm_phase<pg8::EpiQ, pg8::LockstepOrder, PG8_ALIGNV, PG8_SP2V>(lds, g, S, E);
        }
        if (EN_KVUP && IN(pb + 4)) REPS(pb + 4) {
            KArgs A = kargs(); unsigned char* const wsb = GWS(A);
            pg8::Gemm g{(const pg8::bf16_t*)(wsb + WS_KVN), (const pg8::bf16_t*)(wsb + WS_WKV) + (size_t)p * NKV * KVL, MTOT, NKV, KVL, KVL}; pg8::LockstepOrder S; S.init(MTOT, NKV, G, (int)((blockIdx.x + 64u) % (unsigned)G));
            pg8::EpiKV E{(pg8::bf16_t*)(wsb + WS_KN), (pg8::bf16_t*)(wsb + WS_V), MTOT};
            pg8::gemm_phase<pg8::EpiKV, pg8::LockstepOrder, PG8_ALIGNV, PG8_SP2V>(lds, g, S, E);
        } SEAM(pb + 4);
        if (EN_ATT && IN(pb + 5)) REPS(pb + 5) { attn_phase(kargs(), lds, G); } SEAM(pb + 5);
        if (EN_A5 && IN(pb + 6)) REPS(pb + 6) {
            KArgs A = kargs(); unsigned char* const wsb = GWS(A);
            { pg8::Gemm g{(const pg8::bf16_t*)(wsb + WS_CC), (const pg8::bf16_t*)(wsb + WS_WO_AB) + (size_t)p * DM * MIXW, MLAT, DM, MIXW, MIXW}; pg8::LockstepOrder S; S.init(MLAT, DM, G, (int)blockIdx.x);
              pg8::EpiBf16P E{(pg8::bf16_t*)(wsb + WS_Y), DM};
              pg8::gemm_phase<pg8::EpiBf16P, pg8::LockstepOrder, PG8_ALIGNV, PG8_SP2V>(lds, g, S, E); }
            { pg8::Gemm g{(const pg8::bf16_t*)(wsb + WS_CC) + (size_t)MLAT * MIXW, (const pg8::bf16_t*)(wsb + WS_WO_AB) + (size_t)p * DM * MIXW, MTOT - MLAT, DM, MIXW / 8, MIXW}; pg8::SplitKOrder S; S.init(MTOT - MLAT, DM, 8, G, (int)blockIdx.x);
              pg8::EpiF32 E{(float*)(wsb + WS_YP), DM, (size_t)(MTOT - MLAT) * DM};
              pg8::gemm_phase<pg8::EpiF32, pg8::SplitKOrder, PG8_ALIGNV, PG8_SP2V>(lds, g, S, E); }
        } SEAM(pb + 6);
        if (EN_NORM && IN(pb + 7)) REPS(pb + 7) { norm_phase(kargs(), lab, lc, G); } SEAM(pb + 7);
        if (EN_C1 && IN(pb + 8)) REPS(pb + 8) {
            KArgs A = kargs(); unsigned char* const wsb = GWS(A);
            pg8::Gemm g{(const pg8::bf16_t*)(wsb + WS_H), (const pg8::bf16_t*)(wsb + WS_WIN_C) + (size_t)p * N_C * DM, MTOT, N_C, DM, DM}; pg8::LockstepOrder S; S.init(MTOT, N_C, G, (int)blockIdx.x);
            pg8::EpiC1 E{(pg8::bf16_t*)(wsb + WS_G1), (size_t)MTOT * MIXW, (const float*)(wsb + WS_OML) + (size_t)p * 2 * 8192};
            pg8::gemm_phase<pg8::EpiC1, pg8::LockstepOrder, PG8_ALIGNV, PG8_SP2V>(lds, g, S, E);
            if (p0_defer_on(G)) { pg8::LockstepOrder S2; S2.init(MTOT, N_C, G, (int)blockIdx.x); p0_deferred(kargs(), lds, S2, p == 0 ? 1 : 3); }
        } SEAM(pb + 8);
        if (EN_SCAN && IN(pb + 9)) REPS(pb + 9) { scan_phase(kargs(), lds, G); } SEAM(pb + 9);
        if (EN_RO && IN(pb + 10)) REPS(pb + 10) { readout_phase(kargs(), p, lc == 3 ? MLAT : MTOT, G); } SEAM(pb + 10);
        if (EN_C4 && IN(pb + 11)) REPS(pb + 11) {
            KArgs A = kargs(); unsigned char* const wsb = GWS(A);
            { pg8::Gemm g{(const pg8::bf16_t*)(wsb + WS_CC), (const pg8::bf16_t*)(wsb + WS_WO_C) + (size_t)p * DM * MIXW, MLAT, DM, MIXW, MIXW}; pg8::LockstepOrder S; S.init(MLAT, DM, G, (int)blockIdx.x);
              pg8::EpiBf16P E{(pg8::bf16_t*)(wsb + WS_Y), DM};
              pg8::gemm_phase<pg8::EpiBf16P, pg8::LockstepOrder, PG8_ALIGNV, PG8_SP2V>(lds, g, S, E); }
            if (lc != 3) { pg8::Gemm g{(const pg8::bf16_t*)(wsb + WS_CC) + (size_t)MLAT * MIXW, (const pg8::bf16_t*)(wsb + WS_WO_C) + (size_t)p * DM * MIXW, MTOT - MLAT, DM, MIXW / 8, MIXW}; pg8::SplitKOrder S; S.init(MTOT - MLAT, DM, 8, G, (int)blockIdx.x);
              pg8::EpiF32 E{(float*)(wsb + WS_YP), DM, (size_t)(MTOT - MLAT) * DM};
              pg8::gemm_phase<pg8::EpiF32, pg8::SplitKOrder, PG8_ALIGNV, PG8_SP2V>(lds, g, S, E); }
        } SEAM(pb + 11);
        if (EN_NORM && IN(pb + 12)) REPS(pb + 12) { norm_phase(kargs(), lc, lc + 1, G); } SEAM(pb + 12);
    }
#undef IN
#undef SEAM
__global__ void __launch_bounds__(NWAVES * 64, 2) fwd(Args a) {
    extern __shared__ __attribute__((aligned(16))) unsigned char lds_raw[];
    LAS unsigned char* lds = (LAS unsigned char*)lds_raw;
    int tid_l = threadIdx.x; asm volatile("" : "+v"(tid_l)); const int tid = tid_l, G = gridDim.x;
    for (int u = tid; u < (LDS_BYTES - LDSCTL_OFF) / 4; u += NWAVES * 64) ((LAS unsigned*)(lds + LDSCTL_OFF))[u] = 0u;
    __syncthreads();
    XcdBarrier bar; bar.bar = (unsigned*)(a.ws + WS_CTL) + CW_BAR; bar.x = 0; bar.st = nullptr;
    if (MK_ONE_LAUNCH) bar = xcd_barrier_post((unsigned*)(a.ws + WS_CTL) + CW_BAR, (volatile LAS unsigned*)(lds + MISC_OFF));
    const int lo = a.ph_lo, hi = a.ph_hi;
#define IN(k) (lo <= (k) && (k) < hi)
#define SEAM(k) do { if (IN(k) && IN((k) + 1)) xcd_barrier(bar); } while (0)
    if (EN_P0 && IN(0)) REPS(0) { p0_prologue(kargs(), lds, G); } SEAM(0);
    if (EN_NORM && IN(1)) REPS(1) { norm_phase(kargs(), -1, 0, G); } SEAM(1);
    layer_pair<0>(lds, G, lo, hi, bar);
    layer_pair<1>(lds, G, lo, hi, bar);
#undef IN
#undef SEAM
}

extern "C" void kernel_launch(void* const* d_in, const int* in_sizes, int n_in, void* d_out, int out_size, void* d_ws, size_t ws_size, hipStream_t stream) {
    static int grid = 0;
    if (grid == 0) {
        if (n_in != 22 || out_size != MLAT * DM || ws_size < WS_END) { fprintf(stderr, "kernel_launch: unexpected shapes (n_in %d, out %d, ws %zu, need %zu)\n", n_in, out_size, ws_size, (size_t)WS_END); grid = -1; return; }
        int dev = 0, cus = 0, per_cu = 0;
        if (hipGetDevice(&dev) != hipSuccess || hipDeviceGetAttribute(&cus, hipDeviceAttributeMultiprocessorCount, dev) != hipSuccess) { grid = -1; return; }
        if (hipFuncSetAttribute((const void*)fwd, hipFuncAttributeMaxDynamicSharedMemorySize, LDS_BYTES) != hipSuccess) { fprintf(stderr, "kernel_launch: hipFuncSetAttribute failed\n"); grid = -1; return; }
        if (hipOccupancyMaxActiveBlocksPerMultiprocessor(&per_cu, (const void*)fwd, NWAVES * 64, LDS_BYTES) != hipSuccess || per_cu < 1) fprintf(stderr, "kernel_launch: occupancy query reports %d\n", per_cu);
        (void)hipGetLastError();
        grid = cus;
    }
    if (grid < 0) return;
    (void)hipMemsetAsync((char*)d_ws + WS_CTL, 0, 65536, stream);
    Args a{};
    for (int i = 0; i < 22; ++i) a.in[i] = (const float*)d_in[i];
    a.out = (float*)d_out; a.ws = (unsigned char*)d_ws;
#if MK_ONE_LAUNCH
    a.ph_lo = 0; a.ph_hi = N_PHASES;
    hipLaunchKernelGGL(fwd, dim3(grid), dim3(NWAVES * 64), LDS_BYTES, stream, a);
#else
    for (int p = 0; p < N_PHASES; ++p) { a.ph_lo = p; a.ph_hi = p + 1; hipLaunchKernelGGL(fwd, dim3(grid), dim3(NWAVES * 64), LDS_BYTES, stream, a); }
#endif
}
```

```cpp
#include <hip/hip_runtime.h>
#include <cstdio>
#include <cstdint>
namespace pg8 {
#define PG8_LAS __attribute__((address_space(3)))
typedef unsigned short bf16_t;
typedef short bf16x8 __attribute__((ext_vector_type(8)));
typedef float f32x4 __attribute__((ext_vector_type(4)));
typedef unsigned u32x4 __attribute__((ext_vector_type(4)));
constexpr int BM = 256, BK = 64, HALF = 128, HTB = HALF * BK * 2  , STAGE_BYTES = 8 * HTB, NXCD = 8, WGM = 4;

__host__ __device__ __forceinline__ int lds_byte(int r, int c) { const int st = (r >> 4) * 2 + (c >> 5), rr = r & 15, cc = c & 31, ob = rr * 64 + cc * 2; return st * 1024 + (ob ^ (((ob >> 9) & 1) << 5)); }
__host__ __device__ __forceinline__ void stage_rc(int b, int& R, int& C) { const int st = b / 1024, sb = b % 1024, swz = sb ^ (((sb >> 9) & 1) << 5); R = (st >> 1) * 16 + swz / 64; C = (st & 1) * 32 + (swz % 64) / 2; }
__host__ __device__ __forceinline__ int perm32(int rho) { const int n = rho >> 4, i = rho & 15; return 8 * (i >> 2) + 4 * n + (i & 3); }

struct Unit { int pm, pn, kc; };
struct Gemm { const bf16_t* A; const bf16_t* Bt; int M, N, K, ld; };

struct StaticOrder {
    int nM, nN, nwg, G, c;
    __host__ __device__ void init(int M, int N, int G_, int c_) { nM = M / BM; nN = N / BM; nwg = nM * nN; G = G_; c = c_; }
    __host__ __device__ bool next(int i, Unit& u) const {
        const long L = (long)i * G + c; if (L >= nwg) return false;
        int wgid = (int)L; { const int q = nwg / NXCD, r = nwg % NXCD, xcd = wgid % NXCD, off = wgid / NXCD; wgid = (xcd < r ? xcd * (q + 1) : r * (q + 1) + (xcd - r) * q) + off; }
        const int nig = WGM * nN, gid = wgid / nig, fm = gid * WGM, gsz = (nM - fm) < WGM ? (nM - fm) : WGM;
        u.pm = fm + ((wgid % nig) % gsz); u.pn = (wgid % nig) / gsz; u.kc = 0; return true;
    }
    __device__ __forceinline__ void a_ready(const Unit&) const {}
    __device__ __forceinline__ void done(const Unit&) const {}
};
struct LockstepOrder {
    static constexpr int LW = 4;
    int nM, nN, G, c, x, k, nk, PG, r0, gR, qR, rR, lenx;
    __host__ __device__ void init(int M, int N, int G_, int c_) { nM = M / BM; nN = N / BM; G = G_; c = c_; x = c_ % NXCD; k = c_ / NXCD; nk = G_ / NXCD; PG = (nM / LW) / NXCD; r0 = PG * NXCD * LW; gR = nM - r0;
        const int rem = gR * nN; qR = rem / NXCD; rR = rem % NXCD; lenx = PG * LW * nN + qR + (x < rR ? 1 : 0); }
    __host__ __device__ bool next(int i, Unit& u) const {
        if (G % NXCD != 0) { const long L = (long)i * G + c; if (L >= (long)nM * nN) return false; u.kc = 0; u.pm = (int)(L / nN); u.pn = (int)(L % nN); return true; }
        const int off = i * nk + k; if (off >= lenx) return false; u.kc = 0;
        const int lock = PG * LW * nN;
        if (off < lock) { const int j = off / (LW * nN), o2 = off % (LW * nN); u.pm = (j * NXCD + x) * LW + o2 % LW; u.pn = o2 / LW; }
        else { const int rho = (x < rR ? x * (qR + 1) : rR * (qR + 1) + (x - rR) * qR) + (off - lock); u.pm = r0 + rho % gR; u.pn = rho / gR; }
        return true;
    }
    __device__ __forceinline__ void a_ready(const Unit&) const {}
    __device__ __forceinline__ void done(const Unit&) const {}
};
struct SplitKOrder {
    int nM, nN, KS, nwg, G, c;
    __host__ __device__ void init(int M, int N, int KS_, int G_, int c_) { nM = M / BM; nN = N / BM; KS = KS_; nwg = nM * nN * KS; G = G_; c = c_; }
    __host__ __device__ bool next(int i, Unit& u) const { const long L = (long)i * G + c; if (L >= nwg) return false; const int l = (int)L; u.kc = l % KS; u.pn = (l / KS) % nN; u.pm = l / (KS * nN); return true; }
    __device__ __forceinline__ void a_ready(const Unit&) const {}
    __device__ __forceinline__ void done(const Unit&) const {}
};

typedef float f32x2 __attribute__((ext_vector_type(2)));
typedef __bf16 bf16x2_c __attribute__((ext_vector_type(2)));
__device__ __forceinline__ unsigned cvt_pk_bf16(float lo, float hi) { const f32x2 v = {lo, hi}; const bf16x2_c b = __builtin_convertvector(v, bf16x2_c); return __builtin_bit_cast(unsigned, b); }
__device__ __forceinline__ f32x2 gelu_pk(f32x2 v) {
    const f32x2 av = __builtin_elementwise_abs(v), d = av * 0.2316418882f + 1.0f;
    f32x2 t; t.x = __builtin_amdgcn_rcpf(d.x); t.y = __builtin_amdgcn_rcpf(d.y);
    f32x2 q = t * 0.5307027145f + (-0.7265760135f); q = q * t + 0.7107068705f; q = q * t + (-0.142248368f); q = q * t + 0.127414796f; q = q * t;
    const f32x2 s = (v * v) * (-0.72134752044f);
    f32x2 e; e.x = __builtin_amdgcn_exp2f(s.x); e.y = __builtin_amdgcn_exp2f(s.y);
    const f32x2 m = v * (q * e), r = v - m;
    f32x2 o; o.x = v.x < 0.f ? m.x : r.x; o.y = v.y < 0.f ? m.y : r.y; return o;
}

typedef unsigned u32x2 __attribute__((ext_vector_type(2)));
__device__ __forceinline__ float silu_f(float x) { return x * __builtin_amdgcn_rcpf(1.0f + __builtin_amdgcn_exp2f(-1.4426950408889634f * x)); }
__device__ __forceinline__ float sigmoid_neg_f(float x) { return __builtin_amdgcn_rcpf(1.0f + __builtin_amdgcn_exp2f(1.4426950408889634f * x)); }
__device__ __forceinline__ f32x4 act4(f32x4 v, int act) {
    if (act == 1) { v[0] = silu_f(v[0]); v[1] = silu_f(v[1]); v[2] = silu_f(v[2]); v[3] = silu_f(v[3]); }
    else if (act == 2) { const f32x2 a = gelu_pk((f32x2){v[0], v[1]}), b = gelu_pk((f32x2){v[2], v[3]}); v = (f32x4){a.x, a.y, b.x, b.y}; }
    return v;
}
struct EpiF32 {
    static constexpr bool PERM = false, AFTER_DRAIN = false;
    float* C0; int ldc; size_t kstride;
    __device__ __forceinline__ void operator()(const f32x4 (&acc)[2][2][4][2], const Unit& u, int wr, int wc, int fr, int fq) const {
        float* C = C0 + (size_t)u.kc * kstride;
        const int row0 = u.pm * BM + wr * 64 + fr, col0 = u.pn * BM + wc * 32 + 4 * fq;
#pragma unroll
        for (int ai = 0; ai < 2; ++ai)
#pragma unroll
            for (int m = 0; m < 4; ++m) { float* rowp = C + (size_t)(row0 + ai * HALF + m * 16) * ldc + col0;
#pragma unroll
                for (int bj = 0; bj < 2; ++bj)
#pragma unroll
                    for (int n = 0; n < 2; ++n) *(f32x4*)(rowp + bj * HALF + n * 16) = acc[ai][bj][m][n]; }
    }
};
struct EpiBf16P {
    static constexpr bool PERM = true, AFTER_DRAIN = false;
    bf16_t* O; int ldc;
    __device__ __forceinline__ void operator()(const f32x4 (&acc)[2][2][4][2], const Unit& u, int wr, int wc, int fr, int fq) const {
        const int row0 = u.pm * BM + wr * 64 + fr, col0 = u.pn * BM + wc * 32 + 8 * fq;
#pragma unroll
        for (int ai = 0; ai < 2; ++ai)
#pragma unroll
            for (int m = 0; m < 4; ++m) { bf16_t* rowp = O + (size_t)(row0 + ai * HALF + m * 16) * ldc + col0;
#pragma unroll
                for (int bj = 0; bj < 2; ++bj) { const f32x4 v0 = acc[ai][bj][m][0], v1 = acc[ai][bj][m][1];
                    u32x4 w; w.x = cvt_pk_bf16(v0[0], v0[1]); w.y = cvt_pk_bf16(v0[2], v0[3]); w.z = cvt_pk_bf16(v1[0], v1[1]); w.w = cvt_pk_bf16(v1[2], v1[3]);
                    *(u32x4*)(rowp + bj * HALF) = w; } }
    }
};
struct EpiAB1 {
    static constexpr bool PERM = true, AFTER_DRAIN = false;
    bf16_t* O; int ldc;
    __device__ __forceinline__ void operator()(const f32x4 (&acc)[2][2][4][2], const Unit& u, int wr, int wc, int fr, int fq) const {
        const int act = u.pn < 7 ? 0 : ((u.pn < 23 || u.pn >= 55) ? 1 : 2);
        const int row0 = u.pm * BM + wr * 64 + fr, col0 = u.pn * BM + wc * 32 + 8 * fq;
#pragma unroll
        for (int ai = 0; ai < 2; ++ai)
#pragma unroll
            for (int m = 0; m < 4; ++m) { bf16_t* rowp = O + (size_t)(row0 + ai * HALF + m * 16) * ldc + col0;
#pragma unroll
                for (int bj = 0; bj < 2; ++bj) { const f32x4 v0 = act4(acc[ai][bj][m][0], act), v1 = act4(acc[ai][bj][m][1], act);
                    u32x4 w; w.x = cvt_pk_bf16(v0[0], v0[1]); w.y = cvt_pk_bf16(v0[2], v0[3]); w.z = cvt_pk_bf16(v1[0], v1[1]); w.w = cvt_pk_bf16(v1[2], v1[3]);
                    *(u32x4*)(rowp + bj * HALF) = w; } }
    }
};
struct EpiC1 {
    static constexpr bool PERM = true, AFTER_DRAIN = false;
    bf16_t* O; size_t stride; const float* oml;
    __device__ __forceinline__ void operator()(const f32x4 (&acc)[2][2][4][2], const Unit& u, int wr, int wc, int fr, int fq) const {
        const int region = u.pn >> 5; bf16_t* base = O + (size_t)region * stride;
        const int row0 = u.pm * BM + wr * 64 + fr, col0 = (u.pn & 31) * BM + wc * 32 + 8 * fq;
        const bool gate = (region == 1 || region == 2); const int act = (region == 0 || region == 4) ? 1 : 0;
        f32x4 gv[2][2];
#pragma unroll
        for (int bj = 0; bj < 2; ++bj)
#pragma unroll
            for (int n = 0; n < 2; ++n) gv[bj][n] = gate ? *(const f32x4*)(oml + (size_t)(region - 1) * 8192 + col0 + bj * HALF + 4 * n) : (f32x4){1.f, 1.f, 1.f, 1.f};
#pragma unroll
        for (int ai = 0; ai < 2; ++ai)
#pragma unroll
            for (int m = 0; m < 4; ++m) { bf16_t* rowp = base + (size_t)(row0 + ai * HALF + m * 16) * 8192 + col0;
#pragma unroll
                for (int bj = 0; bj < 2; ++bj) { f32x4 v0 = acc[ai][bj][m][0], v1 = acc[ai][bj][m][1];
                    if (gate) {
#pragma unroll
                        for (int j = 0; j < 4; ++j) { v0[j] = gv[bj][0][j] * sigmoid_neg_f(v0[j]); v1[j] = gv[bj][1][j] * sigmoid_neg_f(v1[j]); } }
                    else { v0 = act4(v0, act); v1 = act4(v1, act); }
                    u32x4 w; w.x = cvt_pk_bf16(v0[0], v0[1]); w.y = cvt_pk_bf16(v0[2], v0[3]); w.z = cvt_pk_bf16(v1[0], v1[1]); w.w = cvt_pk_bf16(v1[2], v1[3]);
                    *(u32x4*)(rowp + bj * HALF) = w; } }
    }
};
struct EpiQ {
    static constexpr bool PERM = true, AFTER_DRAIN = false;
    bf16_t* O; const f32x2* rope; int nlat; float qscale;
    __device__ __forceinline__ void operator()(const f32x4 (&acc)[2][2][4][2], const Unit& u, int wr, int wc, int fr, int fq) const {
        const int row0 = u.pm * BM + wr * 64 + fr; const bool upper = fq >= 2;
#pragma unroll
        for (int bj = 0; bj < 2; ++bj) {
            const int G = 8 * u.pn + 4 * bj + wc, hm = G % 6, col = u.pn * BM + bj * HALF + wc * 32 + 8 * fq;
#pragma unroll
            for (int ai = 0; ai < 2; ++ai)
#pragma unroll
                for (int m = 0; m < 4; ++m) { const int row = row0 + ai * HALF + m * 16; f32x4 x0 = acc[ai][bj][m][0], x1 = acc[ai][bj][m][1];
                    if (hm >= 4 && u.pm * BM < nlat) {
                        const int t = row & 8191, pos = (hm == 4) ? (t >> 6) : (t & 63); const f32x2* cs = rope + pos * 16 + 8 * (fq & 1);
#pragma unroll
                        for (int j = 0; j < 4; ++j) {
                            { auto rr = __builtin_amdgcn_permlane32_swap(__float_as_uint(x0[j]), __float_as_uint(x0[j]), false, false); const float pv = __uint_as_float(upper ? rr[0] : rr[1]); const f32x2 c = cs[j];
                              x0[j] = upper ? x0[j] * c.x + pv * c.y : x0[j] * c.x - pv * c.y; }
                            { auto rr = __builtin_amdgcn_permlane32_swap(__float_as_uint(x1[j]), __float_as_uint(x1[j]), false, false); const float pv = __uint_as_float(upper ? rr[0] : rr[1]); const f32x2 c = cs[4 + j];
                              x1[j] = upper ? x1[j] * c.x + pv * c.y : x1[j] * c.x - pv * c.y; } } }
                    x0 = x0 * qscale; x1 = x1 * qscale;
                    u32x4 w; w.x = cvt_pk_bf16(x0[0], x0[1]); w.y = cvt_pk_bf16(x0[2], x0[3]); w.z = cvt_pk_bf16(x1[0], x1[1]); w.w = cvt_pk_bf16(x1[2], x1[3]);
                    *(u32x4*)(O + (size_t)row * 6144 + col) = w; }
        }
    }
};
struct EpiKV {
    static constexpr bool PERM = true, AFTER_DRAIN = false;
    bf16_t* KN; bf16_t* V; int mtot;
    __device__ __forceinline__ void operator()(const f32x4 (&acc)[2][2][4][2], const Unit& u, int wr, int wc, int fr, int fq) const {
        const int row0 = u.pm * BM + wr * 64 + fr, colh = wc * 32 + 8 * fq;
#pragma unroll
        for (int ai = 0; ai < 2; ++ai)
#pragma unroll
            for (int m = 0; m < 4; ++m) { const size_t off = ((size_t)u.pn * mtot + (size_t)(row0 + ai * HALF + m * 16)) * 128 + colh;
#pragma unroll
                for (int bj = 0; bj < 2; ++bj) { const f32x4 v0 = acc[ai][bj][m][0], v1 = acc[ai][bj][m][1];
                    u32x4 w; w.x = cvt_pk_bf16(v0[0], v0[1]); w.y = cvt_pk_bf16(v0[2], v0[3]); w.z = cvt_pk_bf16(v1[0], v1[1]); w.w = cvt_pk_bf16(v1[2], v1[3]);
                    *(u32x4*)((bj ? V : KN) + off) = w; } }
    }
};

template <class Epi, class Sched, bool ALIGN_EPI = false, bool SP2 = false>
__device__ __forceinline__ void gemm_phase(PG8_LAS unsigned char* lds, const Gemm g, const Sched& S, const Epi& E) {
    int tid_l = threadIdx.x; asm volatile("" : "+v"(tid_l)); const int tid = tid_l, wid = __builtin_amdgcn_readfirstlane(tid >> 6), lane = tid & 63, wr = wid >> 2, wc = wid & 3, fr = lane & 15, fq = lane >> 4;
    const int K = g.ld, nt = g.K / BK;
    unsigned voffA[2], voffB[2];
#pragma unroll
    for (int i = 0; i < 2; ++i) { int R, C; stage_rc(tid * 16 + i * 8192, R, C); const int Rb = Epi::PERM ? ((R & ~31) + perm32(R & 31)) : R;
        voffA[i] = (unsigned)(R * K + C) * 2u; voffB[i] = (unsigned)(Rb * K + C) * 2u; }
    const size_t kstep = (size_t)(BK * 2);
    const size_t hstep = (size_t)HALF * K * 2;
    const size_t tstep = 2 * hstep;
    const unsigned ldsw = (unsigned)wid * 1024u;
    const int aoff = lds_byte(wr * 64 + fr, fq * 8), boff = lds_byte(wc * 32 + fr, fq * 8);
#define PG8_SA(b, h) (((b) * 2 + (h)) * HTB)
#define PG8_SB(b, h) ((4 + (b) * 2 + (h)) * HTB)
#define PG8_STAGE(bufoff, gbase, voff) do { const char* gb_ = (const char*)(gbase); asm volatile("" : "+s"(gb_)); _Pragma("unroll") for (int _i = 0; _i < 2; ++_i) { unsigned vo_ = (voff)[_i]; asm volatile("" : "+v"(vo_)); \
        __builtin_amdgcn_global_load_lds((const unsigned*)(gb_ + vo_), (PG8_LAS unsigned*)(lds + (bufoff) + ldsw + _i * 8192), 16, 0, 0); } } while (0)
#define PG8_LDA(dst, b, h) do { _Pragma("unroll") for (int m = 0; m < 4; ++m) _Pragma("unroll") for (int k = 0; k < 2; ++k) dst[m][k] = *(const PG8_LAS bf16x8*)(lds + PG8_SA(b, h) + aoff + m * 2048 + k * 1024); } while (0)
#define PG8_LDB(dst, b, h) do { _Pragma("unroll") for (int n = 0; n < 2; ++n) _Pragma("unroll") for (int k = 0; k < 2; ++k) dst[n][k] = *(const PG8_LAS bf16x8*)(lds + PG8_SB(b, h) + boff + n * 2048 + k * 1024); } while (0)
#define PG8_MMA(ai, bj, At, Bt) do { __builtin_amdgcn_sched_barrier(0); _Pragma("unroll") for (int m = 0; m < 4; ++m) _Pragma("unroll") for (int n = 0; n < 2; ++n) _Pragma("unroll") for (int k = 0; k < 2; ++k) \
        acc[ai][bj][m][n] = __builtin_amdgcn_mfma_f32_16x16x32_bf16(Bt[n][k], At[m][k], acc[ai][bj][m][n], 0, 0, 0); __builtin_amdgcn_sched_barrier(0); } while (0)
#define PG8_WAIT_V(n) asm volatile("s_waitcnt vmcnt(" #n ")" ::: "memory")
#define PG8_WAIT_L(n) asm volatile("s_waitcnt lgkmcnt(" #n ")" ::: "memory")
#define PG8_BAR __builtin_amdgcn_s_barrier()
#define PG8_SCHED __builtin_amdgcn_sched_barrier(0)
    if (wr == 0) __builtin_amdgcn_s_setprio(1);
    Unit cur, nxt; int ui = 0;
    if (!S.next(0, cur)) { __builtin_amdgcn_s_setprio(0); return; }
    f32x4 acc[2][2][4][2];
#pragma unroll
    for (int a = 0; a < 2; ++a)
#pragma unroll
        for (int b = 0; b < 2; ++b)
#pragma unroll
            for (int m = 0; m < 4; ++m)
#pragma unroll
                for (int n = 0; n < 2; ++n) acc[a][b][m][n] = (f32x4){0.f, 0.f, 0.f, 0.f};
    bf16x8 At[4][2], B0[2][2], B1[2][2];
    const size_t kcb = (size_t)g.K * 2;
    const char* cA = (const char*)g.A + (size_t)cur.pm * tstep + cur.kc * kcb; const char* cB = (const char*)g.Bt + (size_t)cur.pn * tstep + cur.kc * kcb;
    S.a_ready(cur);
    if constexpr (SP2) {
        PG8_STAGE(PG8_SB(0, 0), cB, voffB); PG8_STAGE(PG8_SB(0, 1), cB + hstep, voffB); PG8_STAGE(PG8_SA(0, 0), cA, voffA); PG8_STAGE(PG8_SA(0, 1), cA + hstep, voffA);
        if (wr == 1) PG8_BAR;
        PG8_WAIT_V(2); PG8_BAR;
        PG8_STAGE(PG8_SB(1, 0), cB + kstep, voffB); PG8_STAGE(PG8_SA(1, 0), cA + kstep, voffA); PG8_STAGE(PG8_SB(1, 1), cB + hstep + kstep, voffB);
        PG8_WAIT_V(6); PG8_BAR;
    } else {
        PG8_STAGE(PG8_SB(0, 0), cB, voffB); PG8_STAGE(PG8_SA(0, 0), cA, voffA); PG8_STAGE(PG8_SB(0, 1), cB + hstep, voffB); PG8_STAGE(PG8_SA(0, 1), cA + hstep, voffA);
        if (wr == 1) PG8_BAR;
        PG8_WAIT_V(4); PG8_BAR;
        PG8_STAGE(PG8_SB(1, 0), cB + kstep, voffB); PG8_STAGE(PG8_SA(1, 0), cA + kstep, voffA); PG8_STAGE(PG8_SB(1, 1), cB + hstep + kstep, voffB);
        PG8_WAIT_V(6); PG8_BAR;
    }
    for (;;) {
        const bool has_next = S.next(ui + 1, nxt);
        const char* nA = has_next ? (const char*)g.A + (size_t)nxt.pm * tstep + nxt.kc * kcb : cA; const char* nB = has_next ? (const char*)g.Bt + (size_t)nxt.pn * tstep + nxt.kc * kcb : cB;
        for (int t = 0; t < nt; t += 2) {
            const bool last = (t == nt - 2);
            const char* a1 = cA + (size_t)(t + 1) * kstep;
            const char* a2 = last ? nA : cA + (size_t)(t + 2) * kstep; const char* b2 = last ? nB : cB + (size_t)(t + 2) * kstep;
            const char* a3 = a2 + kstep; const char* b3 = b2 + kstep;
            if (last && has_next) S.a_ready(nxt);
            if constexpr (SP2) {
            PG8_LDB(B0, 0, 0); PG8_LDB(B1, 0, 1); PG8_SCHED; PG8_LDA(At, 0, 0); PG8_STAGE(PG8_SA(1, 1), a1 + hstep, voffA);
            PG8_WAIT_V(8); PG8_WAIT_L(0); PG8_BAR; PG8_MMA(0, 0, At, B0); PG8_MMA(0, 1, At, B1); PG8_BAR; PG8_SCHED;
            PG8_LDA(At, 0, 1); PG8_STAGE(PG8_SB(0, 0), b2, voffB); PG8_STAGE(PG8_SB(0, 1), b2 + hstep, voffB); PG8_STAGE(PG8_SA(0, 0), a2, voffA);
            PG8_WAIT_V(8); PG8_WAIT_L(0); PG8_BAR; PG8_MMA(1, 0, At, B0); PG8_MMA(1, 1, At, B1); PG8_BAR; PG8_SCHED;
            PG8_LDB(B0, 1, 0); PG8_LDB(B1, 1, 1); PG8_SCHED; PG8_LDA(At, 1, 0); PG8_STAGE(PG8_SA(0, 1), a2 + hstep, voffA);
            PG8_WAIT_V(8); PG8_WAIT_L(0); PG8_BAR; PG8_MMA(0, 0, At, B0); PG8_MMA(0, 1, At, B1); PG8_BAR; PG8_SCHED;
            PG8_LDA(At, 1, 1); PG8_STAGE(PG8_SB(1, 0), b3, voffB); PG8_STAGE(PG8_SB(1, 1), b3 + hstep, voffB); PG8_STAGE(PG8_SA(1, 0), a3, voffA);
            PG8_WAIT_V(8); PG8_WAIT_L(0); PG8_BAR; PG8_MMA(1, 0, At, B0); PG8_MMA(1, 1, At, B1); PG8_BAR; PG8_SCHED;
            } else {
            PG8_LDB(B0, 0, 0); PG8_SCHED; PG8_LDA(At, 0, 0); PG8_STAGE(PG8_SA(1, 1), a1 + hstep, voffA);
            PG8_WAIT_L(8); PG8_BAR; PG8_WAIT_L(0); PG8_MMA(0, 0, At, B0); PG8_BAR; PG8_SCHED;
            PG8_LDB(B1, 0, 1); PG8_STAGE(PG8_SB(0, 0), b2, voffB);
            PG8_BAR; PG8_WAIT_L(0); PG8_MMA(0, 1, At, B1); PG8_BAR;
            PG8_LDA(At, 0, 1); PG8_STAGE(PG8_SA(0, 0), a2, voffA);
            PG8_BAR; PG8_WAIT_L(0); PG8_MMA(1, 0, At, B0); PG8_BAR; PG8_SCHED;
            PG8_STAGE(PG8_SB(0, 1), b2 + hstep, voffB);
            PG8_WAIT_V(6); PG8_BAR; PG8_MMA(1, 1, At, B1); PG8_BAR;
            PG8_LDB(B0, 1, 0); PG8_SCHED; PG8_LDA(At, 1, 0); PG8_STAGE(PG8_SA(0, 1), a2 + hstep, voffA);
            PG8_WAIT_L(8); PG8_BAR; PG8_WAIT_L(0); PG8_MMA(0, 0, At, B0); PG8_BAR; PG8_SCHED;
            PG8_LDB(B1, 1, 1); PG8_STAGE(PG8_SB(1, 0), b3, voffB);
            PG8_BAR; PG8_WAIT_L(0); PG8_MMA(0, 1, At, B1); PG8_BAR;
            PG8_LDA(At, 1, 1); PG8_STAGE(PG8_SA(1, 0), a3, voffA);
            PG8_BAR; PG8_WAIT_L(0); PG8_MMA(1, 0, At, B0); PG8_BAR; PG8_SCHED;
            PG8_STAGE(PG8_SB(1, 1), b3 + hstep, voffB);
            PG8_WAIT_V(6); PG8_BAR; PG8_MMA(1, 1, At, B1); PG8_BAR;
            }
        }
        if constexpr (ALIGN_EPI) { if (wr == 0) PG8_BAR; }
        if constexpr (!Epi::AFTER_DRAIN) { E(acc, cur, wr, wc, fr, fq); S.done(cur); }
        if (!has_next) break;
#pragma unroll
        for (int a = 0; a < 2; ++a)
#pragma unroll
            for (int b = 0; b < 2; ++b)
#pragma unroll
                for (int m = 0; m < 4; ++m)
#pragma unroll
                    for (int n = 0; n < 2; ++n) acc[a][b][m][n] = (f32x4){0.f, 0.f, 0.f, 0.f};
        cur = nxt; cA = nA; cB = nB; ++ui;
        if constexpr (ALIGN_EPI) { if (wr == 1) PG8_BAR; }
    }
    PG8_WAIT_V(0);
    if constexpr (!ALIGN_EPI) { if (wr == 0) PG8_BAR; }
    PG8_BAR;
    if constexpr (Epi::AFTER_DRAIN) { E.fused(acc, cur, wr, wc, fr, fq, lds, wid, lane); S.done(cur); }
    __builtin_amdgcn_s_setprio(0);
#undef PG8_SA
#undef PG8_SB
#undef PG8_STAGE
#undef PG8_LDA
#undef PG8_LDB
#undef PG8_MMA
#undef PG8_WAIT_V
#undef PG8_WAIT_L
#undef PG8_BAR
#undef PG8_SCHED
}
}
#define GAS __attribute__((address_space(1)))
#define LAS __attribute__((address_space(3)))
typedef unsigned short bf16;
typedef unsigned v4u __attribute__((ext_vector_type(4)));
typedef float f32x4 __attribute__((ext_vector_type(4)));
typedef short bf16x8 __attribute__((ext_vector_type(8)));
typedef GAS unsigned gu32;
typedef GAS unsigned long long gu64;
#define RLX_AGENT __ATOMIC_RELAXED, __HIP_MEMORY_SCOPE_AGENT
#define LDS_WAIT() asm volatile("s_waitcnt lgkmcnt(0)" ::: "memory")
#define VM_WAIT() asm volatile("s_waitcnt vmcnt(0)" ::: "memory")
__device__ __forceinline__ unsigned long long rt() { return __builtin_amdgcn_s_memrealtime(); }
__device__ __forceinline__ unsigned f2bf(float f) { unsigned u = __builtin_bit_cast(unsigned, f); return (u + 0x7fffu + ((u >> 16) & 1u)) >> 16; }
__device__ __forceinline__ unsigned pk2(float lo, float hi) { return f2bf(lo) | (f2bf(hi) << 16); }

typedef unsigned u32x2 __attribute__((ext_vector_type(2)));
typedef float f32x2 __attribute__((ext_vector_type(2)));
#define XB_TMO      128
#define XB_XCNT(j)  (256  + 64 * (j))
#define XB_XSUB(j)  (1280 + 64 * (j))
#define XB_XGEN(j)  (2304 + 64 * (j))
#define XB_TOP      3328
#define XB_TOPGEN   3392
#define XCD_BAR_WORDS 3456
#define XB_SPIN_CAP (1u << 21)

__device__ __forceinline__ unsigned xb_ld(unsigned* p)              { return __hip_atomic_load(p, __ATOMIC_RELAXED, __HIP_MEMORY_SCOPE_AGENT); }
__device__ __forceinline__ unsigned xb_add(unsigned* p, unsigned v) { return __hip_atomic_fetch_add(p, v, __ATOMIC_RELAXED, __HIP_MEMORY_SCOPE_AGENT); }
__device__ __forceinline__ unsigned xb_xcc_id() { return (unsigned)__builtin_amdgcn_s_getreg((3 << 11) | 20) & 0xFu; }
#define XB_SPIN(cond, bar) do { unsigned _sp = 0; while (cond) { __builtin_amdgcn_s_sleep(1); \
    if ((++_sp & 255u) == 0u) { if (xb_ld(&(bar)[XB_TMO])) break; if (_sp > XB_SPIN_CAP) { atomicAdd(&(bar)[XB_TMO], 1u); break; } } } } while (0)

struct XcdBarrier {
    unsigned* bar; unsigned x;
    volatile LAS unsigned* st;
};

__device__ __forceinline__ XcdBarrier xcd_barrier_post(unsigned* bar, volatile LAS unsigned* st) {
    XcdBarrier b; b.bar = bar; b.x = xb_xcc_id(); b.st = st;
    if (threadIdx.x == 0) (void)xb_add(&bar[XB_XCNT(b.x)], 1u);
    return b;
}
__device__ __forceinline__ void xcd_barrier_complete(unsigned* bar, unsigned x, unsigned& nloc, unsigned& nx) {
    const unsigned G = gridDim.x * gridDim.y * gridDim.z;
    unsigned sum, cnt, mine, sp = 0u;
    for (;;) {
        sum = 0u; cnt = 0u; mine = 0u;
#pragma unroll
        for (unsigned j = 0; j < 16; ++j) { const unsigned c = xb_ld(&bar[XB_XCNT(j)]); sum += c; cnt += (c > 0u) ? 1u : 0u; mine = (j == x) ? c : mine; }
        if (sum == G) break;
        __builtin_amdgcn_s_sleep(1);
        if ((++sp & 255u) == 0u) { if (xb_ld(&bar[XB_TMO])) break; if (sp > XB_SPIN_CAP) { atomicAdd(&bar[XB_TMO], 1u); break; } }
    }
    nloc = mine > 0u ? mine : 1u; nx = cnt > 0u ? cnt : 1u;
}

__device__ __forceinline__ void xcd_barrier(const XcdBarrier& b) {
    asm volatile("s_waitcnt vmcnt(0)" ::: "memory");
    __syncthreads();
    if (threadIdx.x == 0) {
        unsigned* bar = b.bar;
        __builtin_amdgcn_s_waitcnt(0);
        unsigned nloc = b.st[0], nx = b.st[1];
        if (nloc == 0u) { xcd_barrier_complete(bar, b.x, nloc, nx); b.st[0] = nloc; b.st[1] = nx; }
        const unsigned old = xb_add(&bar[XB_XSUB(b.x)], 1u);
        const unsigned gen = old / nloc;
        if (old + 1u == (gen + 1u) * nloc) {
            __builtin_amdgcn_fence(__ATOMIC_RELEASE, "agent");
            asm volatile("s_waitcnt vmcnt(0)" ::: "memory");
            const unsigned og = xb_add(&bar[XB_TOP], 1u);
            const unsigned tg = og / nx;
            if (og + 1u == (tg + 1u) * nx) xb_add(&bar[XB_TOPGEN], 1u);
            else XB_SPIN(xb_ld(&bar[XB_TOPGEN]) == tg, bar);
            __builtin_amdgcn_fence(__ATOMIC_ACQUIRE, "agent");
            xb_add(&bar[XB_XGEN(b.x)], 1u);
            asm volatile("s_waitcnt vmcnt(0)" ::: "memory");
        } else {
            XB_SPIN(xb_ld(&bar[XB_XGEN(b.x)]) == gen, bar);
            __builtin_amdgcn_fence(__ATOMIC_ACQUIRE, "agent");
            asm volatile("s_waitcnt vmcnt(0)" ::: "memory");
        }
    }
    __syncthreads();
}


#ifndef NT_STREAMS
#define NT_STREAMS 1
#endif
#if NT_STREAMS
#define LDNT(p) __builtin_nontemporal_load(p)
#define STNT(p, v) __builtin_nontemporal_store((v), (p))
#else
#define LDNT(p) (*(p))
#define STNT(p, v) (*(p) = (v))
#endif
constexpr int NWAVES = 8;
constexpr int DM = 4096, NBATCH = 2, SEQ = 8192, NCTX = 256;
constexpr int MLAT = NBATCH * SEQ;
constexpr int MTOT = MLAT + NBATCH * NCTX;
constexpr int N_AB = 18176;
constexpr int N_ABSRC = 17984, N_C = 40960, MIXW = 8192;
constexpr int QL = 1024, KVL = 512, NQ = 6144, NKV = 8192;
constexpr int G1_CKV = 1024, G1_KR = 1536, G1_ZA = 1792, G1_UB = 5888, G1_VB = 9984, G1_ZB = 14080;
constexpr float EPS = 1e-6f;

constexpr size_t al256(size_t x) { return (x + 255) & ~(size_t)255; }
constexpr size_t WS_CTL = 0, CTL_ZERO_BYTES = 1u << 20;
constexpr size_t WS_MOD  = CTL_ZERO_BYTES;
constexpr size_t WS_OML  = WS_MOD  + al256((size_t)4 * 3 * 12288 * 4);
constexpr size_t WS_ROPE = WS_OML  + al256((size_t)2 * 2 * 8192 * 4);
constexpr size_t WS_STAT = WS_ROPE + al256((size_t)128 * 16 * 8);
constexpr size_t WS_WIN_AB = WS_STAT + al256((size_t)MTOT * 8);
constexpr size_t WS_WIN_C  = WS_WIN_AB + (size_t)2 * N_AB * DM * 2;
constexpr size_t WS_WO_AB  = WS_WIN_C + (size_t)2 * N_C * DM * 2;
constexpr size_t WS_WO_C   = WS_WO_AB + (size_t)2 * DM * MIXW * 2;
constexpr size_t WS_WQ     = WS_WO_C + (size_t)2 * DM * MIXW * 2;
constexpr size_t WS_WKV    = WS_WQ + (size_t)2 * NQ * QL * 2;
constexpr size_t WS_XS     = WS_WKV + (size_t)2 * NKV * KVL * 2;
constexpr size_t WS_H      = WS_XS + (size_t)MTOT * DM * 4;
constexpr size_t WS_Y      = WS_H + (size_t)MTOT * DM * 2;
constexpr size_t WS_G1     = WS_Y + (size_t)MTOT * DM * 4;
constexpr size_t WS_QN     = WS_G1 + (size_t)5 * MTOT * MIXW * 2;
constexpr size_t WS_KVN    = WS_QN + (size_t)MTOT * QL * 2;
constexpr size_t WS_KR     = WS_KVN + (size_t)MTOT * KVL * 2;
constexpr size_t WS_Q      = WS_KR + (size_t)MTOT * 64 * 2;
constexpr size_t WS_KN     = WS_Q + (size_t)MTOT * NQ * 2;
constexpr size_t WS_V      = WS_KN + (size_t)MTOT * DM * 2;
constexpr size_t WS_CC     = WS_V + (size_t)MTOT * DM * 2;
constexpr size_t WS_OF     = WS_CC + (size_t)MTOT * MIXW * 2;
constexpr size_t WS_YP     = WS_OF + (size_t)2 * MTOT * MIXW * 2;
constexpr size_t WS_END    = WS_YP + (size_t)8 * (MTOT - MLAT) * DM * 4;
constexpr int CW_BAR = 4096;

constexpr int RING_BYTES = 135168;
constexpr int LDSCTL_OFF = RING_BYTES, MISC_OFF = LDSCTL_OFF + 64;
constexpr int LDS_BYTES = 147456;

struct Args { const float* in[22]; float* out; unsigned char* ws; int ph_lo, ph_hi; };
typedef const __attribute__((address_space(4))) Args* KArgs;
__device__ __forceinline__ KArgs kargs() { KArgs ap = (KArgs)__builtin_amdgcn_kernarg_segment_ptr(); asm volatile("" : "+s"(ap)); return ap; }

#define GAS __attribute__((address_space(1)))
template <class T> __device__ __forceinline__ T* glob(T* p) { return (T*)(GAS T*)p; }
template <class T> __device__ __forceinline__ T* uni(T* p) {
    const unsigned long long v = (unsigned long long)p; const unsigned lo = __builtin_amdgcn_readfirstlane((unsigned)v), hi = __builtin_amdgcn_readfirstlane((unsigned)(v >> 32));
    return (T*)(GAS T*)(((unsigned long long)hi << 32) | lo); }
#define GWS(a_) glob((a_)->ws)
#define GIN(a_, i_) glob((a_)->in[i_])
#define GOUT(a_) glob((a_)->out)
__device__ __forceinline__ float wave_sum(float v) {
#pragma unroll
    for (int o = 1; o < 64; o <<= 1) v += __shfl_xor(v, o);
    return v;
}
__device__ __forceinline__ float bf_lo(unsigned w) { return __uint_as_float(w << 16); }
__device__ __forceinline__ float bf_hi(unsigned w) { return __uint_as_float(w & 0xffff0000u); }
typedef __bf16 bf16x2_t __attribute__((ext_vector_type(2)));
__device__ __forceinline__ unsigned cvtpk(float lo, float hi) { const f32x2 v = {lo, hi}; const bf16x2_t b = __builtin_convertvector(v, bf16x2_t); return __builtin_bit_cast(unsigned, b); }
__device__ __forceinline__ float silu_acc(float x) { return x / (1.0f + __expf(-x)); }

__device__ __forceinline__ void p0_gemv(KArgs a, LAS unsigned char* lds, int G) {
    int tid_l = threadIdx.x; asm volatile("" : "+v"(tid_l)); const int tid = tid_l, lane = tid & 63, wave = __builtin_amdgcn_readfirstlane(tid >> 6);
    LAS float* sc = (LAS float*)lds;
    LAS float* red = (LAS float*)(lds + 49152);
    const float* c = GIN(a, 1); const float* cctx = GIN(a, 3); const float* w_ada = GIN(a, 4); const float* b_ada = GIN(a, 5);
    float* mod = (float*)(GWS(a) + WS_MOD);
    for (int i = tid; i < 3 * 4096; i += 512) { const int r = i >> 12, k = i & 4095; const float cv = r < 2 ? c[r * 4096 + k] : cctx[k]; sc[i] = silu_acc(cv); }
    __syncthreads();
    const int kr = lane >> 4, c4 = lane & 15;
    for (int item = blockIdx.x; item < 768; item += G) {
        const int l = item / 192, cg = item % 192;
        const float* W = w_ada + (size_t)l * 4096 * 12288 + cg * 64 + c4 * 4;
        float acc[3][4];
#pragma unroll
        for (int r = 0; r < 3; ++r)
#pragma unroll
            for (int j = 0; j < 4; ++j) acc[r][j] = 0.f;
        const int k0 = wave * 512 + kr;
#pragma unroll 8
        for (int i = 0; i < 128; ++i) { const int k = k0 + 4 * i; const f32x4 w = LDNT((const f32x4*)(W + (size_t)k * 12288));
            const float s0 = sc[k], s1 = sc[4096 + k], s2 = sc[8192 + k];
#pragma unroll
            for (int j = 0; j < 4; ++j) { acc[0][j] += s0 * w[j]; acc[1][j] += s1 * w[j]; acc[2][j] += s2 * w[j]; } }
#pragma unroll
        for (int r = 0; r < 3; ++r)
#pragma unroll
            for (int j = 0; j < 4; ++j) { float v = acc[r][j]; v += __shfl_xor(v, 16); v += __shfl_xor(v, 32); acc[r][j] = v; }
        if (lane < 16) {
#pragma unroll
            for (int r = 0; r < 3; ++r)
#pragma unroll
                for (int j = 0; j < 4; ++j) red[(wave * 3 + r) * 64 + lane * 4 + j] = acc[r][j]; }
        __syncthreads();
        if (tid < 192) { const int r = tid >> 6, cc = tid & 63; float s = 0.f;
#pragma unroll
            for (int w = 0; w < 8; ++w) s += red[(w * 3 + r) * 64 + cc];
            const int col = cg * 64 + cc; mod[(size_t)(l * 3 + r) * 12288 + col] = s + b_ada[l * 12288 + col]; }
        __syncthreads();
    }
}
__device__ __forceinline__ void p0_tr_item(const float* W, int N, int K, bf16* WT, int n0s, int n0d, int k0, LAS float* scr, int lane) {
    const int kr = lane >> 4, c4 = lane & 15;
    const float* Wb = uni(W + (size_t)k0 * N + n0s); const unsigned lo = (unsigned)(kr * N + 4 * c4);
    f32x4 w[16];
#pragma unroll
    for (int i = 0; i < 16; ++i) w[i] = LDNT((const f32x4*)(Wb + lo + (unsigned)(4 * i * N)));
#pragma unroll
    for (int i = 0; i < 16; ++i) { const int k = 4 * i + kr;
        scr[(4 * c4 + 0) * 65 + k] = w[i][0]; scr[(4 * c4 + 1) * 65 + k] = w[i][1]; scr[(4 * c4 + 2) * 65 + k] = w[i][2]; scr[(4 * c4 + 3) * 65 + k] = w[i][3]; }
    LDS_WAIT(); asm volatile("" ::: "memory");
    bf16* ob = uni(WT + (size_t)n0d * K + k0); const int nr = lane >> 3, cch = lane & 7;
#pragma unroll
    for (int i = 0; i < 8; ++i) { const int n = 8 * i + nr; const LAS float* s = scr + n * 65 + 8 * cch;
        v4u o; o.x = cvtpk(s[0], s[1]); o.y = cvtpk(s[2], s[3]); o.z = cvtpk(s[4], s[5]); o.w = cvtpk(s[6], s[7]);
        *(v4u*)(ob + (unsigned)(n * K + 8 * cch)) = o; }
    LDS_WAIT(); asm volatile("" ::: "memory");
}
#ifndef P0_DEFER
#define P0_DEFER 1
#endif
constexpr int I_IN_AB = 64 * 281, I_Q = 16 * 96, I_KV = 8 * 128, I_O = 128 * 64, I_IN_C = 64 * 640, PER_J = I_IN_AB + I_Q + I_KV + I_O + I_IN_C + I_O;
__device__ __forceinline__ void p0_item(KArgs a, int j, int r, LAS float* scr, int lane) {
    if (r < I_IN_AB) { const int kb = r / 281, nb = r % 281, n0 = nb * 64;
        p0_tr_item(GIN(a, 8) + (size_t)j * DM * N_ABSRC, N_ABSRC, DM, (bf16*)(GWS(a) + WS_WIN_AB) + (size_t)j * N_AB * DM, n0, n0 + (n0 >= 1600 ? 192 : 0), kb * 64, scr, lane); return; } r -= I_IN_AB;
    if (r < I_Q) { const int kb = r / 96, nb = r % 96;
        p0_tr_item(GIN(a, 11) + (size_t)j * QL * NQ, NQ, QL, (bf16*)(GWS(a) + WS_WQ) + (size_t)j * NQ * QL, nb * 64, nb * 64, kb * 64, scr, lane); return; } r -= I_Q;
    if (r < I_KV) { const int kb = r / 128, nb = r % 128;
        p0_tr_item(GIN(a, 12) + (size_t)j * KVL * NKV, NKV, KVL, (bf16*)(GWS(a) + WS_WKV) + (size_t)j * NKV * KVL, nb * 64, nb * 64, kb * 64, scr, lane); return; } r -= I_KV;
    if (r < I_O) { const int kb = r / 64, nb = r % 64;
        p0_tr_item(GIN(a, 17) + (size_t)j * MIXW * DM, DM, MIXW, (bf16*)(GWS(a) + WS_WO_AB) + (size_t)j * DM * MIXW, nb * 64, nb * 64, kb * 64, scr, lane); return; } r -= I_O;
    if (r < I_IN_C) { const int kb = r / 640, nb = r % 640;
        p0_tr_item(GIN(a, 18) + (size_t)j * DM * N_C, N_C, DM, (bf16*)(GWS(a) + WS_WIN_C) + (size_t)j * N_C * DM, nb * 64, nb * 64, kb * 64, scr, lane); return; } r -= I_IN_C;
    { const int kb = r / 64, nb = r % 64;
        p0_tr_item(GIN(a, 21) + (size_t)j * MIXW * DM, DM, MIXW, (bf16*)(GWS(a) + WS_WO_C) + (size_t)j * DM * MIXW, nb * 64, nb * 64, kb * 64, scr, lane); }
}
constexpr int P0_ND = I_O + PER_J;
#ifndef P0_B1
#define P0_B1 25984
#endif
#ifndef P0_B2
#define P0_B2 51936
#endif
constexpr int P0_B3 = P0_ND - I_O;
static_assert(P0_B1 >= I_O && P0_B1 <= P0_B2 && P0_B2 >= I_O + I_IN_AB && P0_B2 <= P0_B3, "deferred-slot deadlines");
__device__ __forceinline__ bool p0_defer_on(int G) { return P0_DEFER && (G % pg8::NXCD == 0); }
__device__ __forceinline__ void p0_deferred(KArgs a, LAS unsigned char* lds, const pg8::LockstepOrder& S, int slot) {
    const int lenmax = S.PG * pg8::LockstepOrder::LW * S.nN + S.qR + (S.rR > 0 ? 1 : 0), R = (lenmax + S.nk - 1) / S.nk, kcut = lenmax - (R - 1) * S.nk;
    const bool all = kcut >= S.nk;
    if (!all && S.k < kcut) return;
    int tid_l = threadIdx.x; asm volatile("" : "+v"(tid_l)); const int lane = tid_l & 63, wave = __builtin_amdgcn_readfirstlane(tid_l >> 6);
    const int rank = all ? S.c : (S.k - kcut) * pg8::NXCD + S.x, nw = (all ? S.G : pg8::NXCD * (S.nk - kcut)) * NWAVES;
    __syncthreads();
    LAS float* scr = (LAS float*)(lds + wave * 16640);
    const int lo_ = slot == 0 ? 0 : slot == 1 ? P0_B1 : slot == 2 ? P0_B2 : P0_B3, hi_ = slot == 0 ? P0_B1 : slot == 1 ? P0_B2 : slot == 2 ? P0_B3 : P0_ND;
    for (int d = lo_ + rank * NWAVES + wave; d < hi_; d += nw) {
        const int j = d < I_O ? 0 : 1, r = d < I_O ? PER_J - I_O + d : d - I_O; p0_item(a, j, r, scr, lane); }
    __syncthreads();
}
__device__ __forceinline__ void p0_prologue(KArgs a, LAS unsigned char* lds, int G) {
    int tid_l = threadIdx.x; asm volatile("" : "+v"(tid_l)); const int tid = tid_l, lane = tid & 63, wave = __builtin_amdgcn_readfirstlane(tid >> 6);
    __syncthreads();
    p0_gemv(a, lds, G);
    __syncthreads();
    LAS float* scr = (LAS float*)(lds + wave * 16640);
    const int gw = blockIdx.x * NWAVES + wave, NGW = G * NWAVES;
    const bool defer = p0_defer_on(G);
    const int NIT = defer ? PER_J - I_O : 2 * PER_J;
    for (int it = gw; it < NIT; it += NGW) {
        const int j = defer ? (it < PER_J - I_O ? 0 : 1) : it / PER_J, r = defer ? (it < PER_J - I_O ? it : it - (PER_J - I_O)) : it % PER_J;
        p0_item(a, j, r, scr, lane);
    }
    const size_t gt = (size_t)blockIdx.x * 512 + tid, NGT = (size_t)G * 512;
    for (size_t i = gt; i < (size_t)2 * 192 * DM / 8; i += NGT) { const size_t j = i / (192 * DM / 8), e = i % (192 * DM / 8);
        *(v4u*)((bf16*)(GWS(a) + WS_WIN_AB) + j * (size_t)N_AB * DM + (size_t)1600 * DM + e * 8) = (v4u){0u, 0u, 0u, 0u}; }
    { const float* lg = GIN(a, 19); float* oml = (float*)(GWS(a) + WS_OML);
      for (size_t i = gt; i < (size_t)2 * 2 * 8192; i += NGT) { const int jc = (int)(i >> 14), de = (int)(i & 16383);
          const float l0 = lg[0 * 16384 + de], l1 = lg[1 * 16384 + de], l2 = lg[2 * 16384 + de], l3 = lg[3 * 16384 + de];
          const float mx = fmaxf(fmaxf(l0, l1), fmaxf(l2, l3)); const float e0 = __expf(l0 - mx), e1 = __expf(l1 - mx), e2 = __expf(l2 - mx), e3 = __expf(l3 - mx);
          const float inv = 1.0f / (e0 + e1 + e2 + e3); const float lb = (jc == 0) ? e1 * inv : (e1 + e2 + e3) * inv;
          oml[i] = 1.0f - lb; } }
    { f32x2* rope = (f32x2*)(GWS(a) + WS_ROPE);
      for (size_t i = gt; i < 128 * 16; i += NGT) { const int pos = (int)(i >> 4), f = (int)(i & 15); const float inv = powf(10000.0f, -(float)f / 16.0f); const float ang = (float)pos * inv;
          rope[i] = (f32x2){cosf(ang), sinf(ang)}; } }
}

__device__ __forceinline__ void norm_phase(KArgs a, int lpost, int lpre, int G) {
    int tid_l = threadIdx.x; asm volatile("" : "+v"(tid_l)); const int tid = tid_l, lane = tid & 63, wave = __builtin_amdgcn_readfirstlane(tid >> 6);
    const int gw = blockIdx.x * NWAVES + wave, NGW = G * NWAVES;
    const float* mod = (const float*)(GWS(a) + WS_MOD);
    float* XS = (float*)(GWS(a) + WS_XS); const float* Y = (const float*)(GWS(a) + WS_Y); bf16* H = (bf16*)(GWS(a) + WS_H);
    const int nrows = (lpost == 3) ? MLAT : MTOT;
    for (int row = gw; row < nrows; row += NGW) {
        const int rt = row < SEQ ? 0 : (row < MLAT ? 1 : 2);
        const float* xin = uni((lpost <= 0) ? (row < MLAT ? GIN(a, 0) + (size_t)row * DM : GIN(a, 2) + (size_t)(row - MLAT) * DM) : XS + (size_t)row * DM);
        f32x4 xv[16];
#pragma unroll
        for (int j = 0; j < 16; ++j) xv[j] = LDNT((const f32x4*)(xin + lane * 4 + 256 * j));
        if (lpost >= 0) {
            f32x4 yv[16]; float ss = 0.f;
            if (row < MLAT) { const bf16* yr = uni((const bf16*)Y + (size_t)row * DM);
#pragma unroll
                for (int j = 0; j < 16; ++j) { const u32x2 w = LDNT((const u32x2*)(yr + lane * 4 + 256 * j)); yv[j] = (f32x4){bf_lo(w.x), bf_hi(w.x), bf_lo(w.y), bf_hi(w.y)}; } }
            else {
                const float* yr = uni((const float*)(GWS(a) + WS_YP) + (size_t)(row - MLAT) * DM);
#pragma unroll
                for (int j = 0; j < 16; ++j) yv[j] = *(const f32x4*)(yr + lane * 4 + 256 * j);
                for (int kc = 1; kc < 8; ++kc) { const float* yk = uni(yr + (size_t)kc * (MTOT - MLAT) * DM);
#pragma unroll
                    for (int j = 0; j < 16; ++j) { yv[j] = yv[j] + *(const f32x4*)(yk + lane * 4 + 256 * j); if ((j & 3) == 3) asm volatile("" ::: "memory"); } } }
#pragma unroll
            for (int j = 0; j < 16; ++j) ss += (yv[j][0] * yv[j][0] + yv[j][1] * yv[j][1]) + (yv[j][2] * yv[j][2] + yv[j][3] * yv[j][3]);
            const float r = 1.0f / sqrtf(wave_sum(ss) * (1.0f / DM) + EPS);
            const float* gate = uni(mod + (size_t)(lpost * 3 + rt) * 12288 + 8192); const float* pw = uni(GIN(a, 7) + (size_t)lpost * DM);
            float* xout = uni((lpost == 3) ? GOUT(a) + (size_t)row * DM : XS + (size_t)row * DM);
#pragma unroll
            for (int j = 0; j < 16; ++j) { const int col = lane * 4 + 256 * j; const f32x4 g = *(const f32x4*)(gate + col), w = *(const f32x4*)(pw + col);
                xv[j] = xv[j] + g * ((yv[j] * r) * w); STNT((f32x4*)(xout + col), xv[j]);
                if ((j & 3) == 3) asm volatile("" ::: "memory"); }
        }
        if (lpre < 4) {
            float ss = 0.f;
#pragma unroll
            for (int j = 0; j < 16; ++j) ss += (xv[j][0] * xv[j][0] + xv[j][1] * xv[j][1]) + (xv[j][2] * xv[j][2] + xv[j][3] * xv[j][3]);
            const float r = 1.0f / sqrtf(wave_sum(ss) * (1.0f / DM) + EPS);
            const float* shift = uni(mod + (size_t)(lpre * 3 + rt) * 12288); const float* scale = shift + 4096; const float* pw = uni(GIN(a, 6) + (size_t)lpre * DM);
            bf16* hr = uni(H + (size_t)row * DM);
#pragma unroll
            for (int j = 0; j < 16; ++j) { const int col = lane * 4 + 256 * j; const f32x4 sh = *(const f32x4*)(shift + col), sc = *(const f32x4*)(scale + col), w = *(const f32x4*)(pw + col);
                const f32x4 h = ((xv[j] * r) * w) * (sc + 1.0f) + sh; u32x2 o; o.x = cvtpk(h[0], h[1]); o.y = cvtpk(h[2], h[3]); *(u32x2*)(hr + col) = o;
                if ((j & 3) == 3) asm volatile("" ::: "memory"); }
        }
    }
}

__device__ __forceinline__ void a2_rows(KArgs a, int j, int G) {
    int tid_l = threadIdx.x; asm volatile("" : "+v"(tid_l)); const int tid = tid_l, lane = tid & 63, wave = __builtin_amdgcn_readfirstlane(tid >> 6);
    const int gw = blockIdx.x * NWAVES + wave, NGW = G * NWAVES;
    const bf16* G1 = (const bf16*)(GWS(a) + WS_G1); bf16* QN = (bf16*)(GWS(a) + WS_QN); bf16* KVN = (bf16*)(GWS(a) + WS_KVN); bf16* KR = (bf16*)(GWS(a) + WS_KR);
    f32x2* stat = (f32x2*)(GWS(a) + WS_STAT); const f32x2* rope = (const f32x2*)(GWS(a) + WS_ROPE);
    const float* qw = GIN(a, 9) + (size_t)j * QL; const float* kvw = GIN(a, 10) + (size_t)j * KVL;
    for (int row = gw; row < MTOT; row += NGW) {
        const bf16* g = uni(G1 + (size_t)row * N_AB);
        {
            v4u w[2]; float x[16]; float ss = 0.f;
#pragma unroll
            for (int i = 0; i < 2; ++i) { w[i] = LDNT((const v4u*)(g + lane * 8 + 512 * i));
#pragma unroll
                for (int e = 0; e < 4; ++e) { x[8 * i + 2 * e] = bf_lo(w[i][e]); x[8 * i + 2 * e + 1] = bf_hi(w[i][e]); } }
#pragma unroll
            for (int e = 0; e < 16; ++e) ss += x[e] * x[e];
            const float r = 1.0f / sqrtf(wave_sum(ss) * (1.0f / QL) + EPS);
#pragma unroll
            for (int i = 0; i < 2; ++i) { const int col = lane * 8 + 512 * i; const f32x4 w0 = *(const f32x4*)(qw + col), w1 = *(const f32x4*)(qw + col + 4);
                v4u o; o.x = cvtpk(x[8 * i + 0] * r * w0[0], x[8 * i + 1] * r * w0[1]); o.y = cvtpk(x[8 * i + 2] * r * w0[2], x[8 * i + 3] * r * w0[3]);
                o.z = cvtpk(x[8 * i + 4] * r * w1[0], x[8 * i + 5] * r * w1[1]); o.w = cvtpk(x[8 * i + 6] * r * w1[2], x[8 * i + 7] * r * w1[3]);
                *(v4u*)(QN + (size_t)row * QL + col) = o; }
        }
        {
            const v4u w = LDNT((const v4u*)(g + G1_CKV + lane * 8)); float x[8]; float ss = 0.f;
#pragma unroll
            for (int e = 0; e < 4; ++e) { x[2 * e] = bf_lo(w[e]); x[2 * e + 1] = bf_hi(w[e]); }
#pragma unroll
            for (int e = 0; e < 8; ++e) ss += x[e] * x[e];
            const float r = 1.0f / sqrtf(wave_sum(ss) * (1.0f / KVL) + EPS);
            const int col = lane * 8; const f32x4 w0 = *(const f32x4*)(kvw + col), w1 = *(const f32x4*)(kvw + col + 4);
            v4u o; o.x = cvtpk(x[0] * r * w0[0], x[1] * r * w0[1]); o.y = cvtpk(x[2] * r * w0[2], x[3] * r * w0[3]); o.z = cvtpk(x[4] * r * w1[0], x[5] * r * w1[1]); o.w = cvtpk(x[6] * r * w1[2], x[7] * r * w1[3]);
            *(v4u*)(KVN + (size_t)row * KVL + col) = o;
        }
        {
            const float x = __uint_as_float((unsigned)g[G1_KR + lane] << 16); const float xp = __shfl_xor(x, 16); float o = x;
            if (row < MLAT) { const int t = row & (SEQ - 1), ax = lane >> 5, hh = (lane >> 4) & 1, f = lane & 15, pos = ax == 0 ? (t >> 6) : (t & 63); const f32x2 cs = rope[pos * 16 + f];
                o = hh == 0 ? x * cs.x - xp * cs.y : x * cs.x + xp * cs.y; }
            KR[(size_t)row * 64 + lane] = (bf16)(cvtpk(o, 0.f) & 0xffffu);
        }
        {
            float x[64]; float s = 0.f;
#pragma unroll
            for (int i = 0; i < 8; ++i) { const v4u w = *(const v4u*)(g + G1_VB + lane * 8 + 512 * i);
#pragma unroll
                for (int e = 0; e < 4; ++e) { x[8 * i + 2 * e] = bf_lo(w[e]); x[8 * i + 2 * e + 1] = bf_hi(w[e]); } }
#pragma unroll
            for (int e = 0; e < 64; ++e) s += x[e];
            const float mean = wave_sum(s) * (1.0f / 4096.0f); float q = 0.f;
#pragma unroll
            for (int e = 0; e < 64; ++e) { const float d = x[e] - mean; q += d * d; }
            const float rstd = 1.0f / sqrtf(wave_sum(q) * (1.0f / 4096.0f) + EPS);
            if (lane == 0) stat[row] = (f32x2){mean, rstd};
        }
    }
}

typedef short s16x4 __attribute__((ext_vector_type(4)));
typedef float f32x16 __attribute__((ext_vector_type(16)));
#define SBAR() __builtin_amdgcn_sched_barrier(0)
__device__ __forceinline__ f32x4 mfma16(bf16x8 a, bf16x8 b, f32x4 c) { return __builtin_amdgcn_mfma_f32_16x16x32_bf16(a, b, c, 0, 0, 0); }
__device__ __forceinline__ int crow(int r, int hi) { return (r & 3) + 8 * (r >> 2) + 4 * hi; }
__device__ __forceinline__ int v_st(int k, int c) { const int kk = (k & ~0xC) | ((k & 4) << 1) | ((k & 8) >> 1); return ((kk >> 3) * 4 + (c >> 5)) * 512 + ((kk & 7) * 32 + (c & 31)) * 2; }
__device__ __forceinline__ int v_rd_base(int lane) { return ((lane & 3) << 3) | (((lane >> 2) & 3) << 6) | (((lane >> 4) & 1) << 5) | (((lane >> 5) & 1) << 8); }
constexpr int v_rd_off(int d0, int ks, int half) { return d0 * 512 + ks * 4096 + half * 2048; }
template <int OFF> __device__ __forceinline__ s16x4 tr_read(int vb) {
    s16x4 r; asm volatile("ds_read_b64_tr_b16 %0, %1 offset:%2" : "=&v"(r) : "v"(vb), "i"(OFF) : "memory"); return r;
}
template <int D0> __device__ __forceinline__ void pv_one(f32x16& od, int vb, bf16x8 pa0, bf16x8 pa1, bf16x8 pa2, bf16x8 pa3) {
    const s16x4 l0 = tr_read<v_rd_off(D0, 0, 0)>(vb), h0 = tr_read<v_rd_off(D0, 0, 1)>(vb), l1 = tr_read<v_rd_off(D0, 1, 0)>(vb), h1 = tr_read<v_rd_off(D0, 1, 1)>(vb);
    const s16x4 l2 = tr_read<v_rd_off(D0, 2, 0)>(vb), h2 = tr_read<v_rd_off(D0, 2, 1)>(vb), l3 = tr_read<v_rd_off(D0, 3, 0)>(vb), h3 = tr_read<v_rd_off(D0, 3, 1)>(vb);
    asm volatile("s_waitcnt lgkmcnt(0)" ::: "memory"); SBAR();
#define PKV(L, H) (bf16x8){L[0], L[1], L[2], L[3], H[0], H[1], H[2], H[3]}
    od = __builtin_amdgcn_mfma_f32_32x32x16_bf16(pa0, PKV(l0, h0), od, 0, 0, 0);
    od = __builtin_amdgcn_mfma_f32_32x32x16_bf16(pa1, PKV(l1, h1), od, 0, 0, 0);
    od = __builtin_amdgcn_mfma_f32_32x32x16_bf16(pa2, PKV(l2, h2), od, 0, 0, 0);
    od = __builtin_amdgcn_mfma_f32_32x32x16_bf16(pa3, PKV(l3, h3), od, 0, 0, 0);
#undef PKV
}
__device__ __forceinline__ void pv_d0(f32x16* o, int vb, bf16x8 pa0, bf16x8 pa1, bf16x8 pa2, bf16x8 pa3) {
    pv_one<0>(o[0], vb, pa0, pa1, pa2, pa3); pv_one<1>(o[1], vb, pa0, pa1, pa2, pa3); pv_one<2>(o[2], vb, pa0, pa1, pa2, pa3); pv_one<3>(o[3], vb, pa0, pa1, pa2, pa3);
}

template <int I> __device__ __forceinline__ void pv_rd(int vb, s16x4& l0, s16x4& h0, s16x4& l1, s16x4& h1) {
    l0 = tr_read<v_rd_off(I >> 1, 2 * (I & 1), 0)>(vb); h0 = tr_read<v_rd_off(I >> 1, 2 * (I & 1), 1)>(vb); l1 = tr_read<v_rd_off(I >> 1, 2 * (I & 1) + 1, 0)>(vb); h1 = tr_read<v_rd_off(I >> 1, 2 * (I & 1) + 1, 1)>(vb);
}
#define PKV2(L, H) (bf16x8){L[0], L[1], L[2], L[3], H[0], H[1], H[2], H[3]}
#define PV_MM(I, A0, A1, L0, H0, L1, H1) do { o[(I) >> 1] = __builtin_amdgcn_mfma_f32_32x32x16_bf16(A0, PKV2(L0, H0), o[(I) >> 1], 0, 0, 0); o[(I) >> 1] = __builtin_amdgcn_mfma_f32_32x32x16_bf16(A1, PKV2(L1, H1), o[(I) >> 1], 0, 0, 0); } while (0)
#define PV_WAIT4() do { asm volatile("s_waitcnt lgkmcnt(4)" ::: "memory"); SBAR(); } while (0)
#define PV_WAIT0() do { asm volatile("s_waitcnt lgkmcnt(0)" ::: "memory"); SBAR(); } while (0)
__device__ __forceinline__ void pv_pipe(f32x16* o, int vb, bf16x8 pa0, bf16x8 pa1, bf16x8 pa2, bf16x8 pa3) {
    s16x4 al0, ah0, al1, ah1, bl0, bh0, bl1, bh1;
    asm volatile("s_waitcnt lgkmcnt(0)" ::: "memory"); SBAR();
    pv_rd<0>(vb, al0, ah0, al1, ah1); pv_rd<1>(vb, bl0, bh0, bl1, bh1);
    PV_WAIT4(); PV_MM(0, pa0, pa1, al0, ah0, al1, ah1); SBAR(); pv_rd<2>(vb, al0, ah0, al1, ah1);
    PV_WAIT4(); PV_MM(1, pa2, pa3, bl0, bh0, bl1, bh1); SBAR(); pv_rd<3>(vb, bl0, bh0, bl1, bh1);
    PV_WAIT4(); PV_MM(2, pa0, pa1, al0, ah0, al1, ah1); SBAR(); pv_rd<4>(vb, al0, ah0, al1, ah1);
    PV_WAIT4(); PV_MM(3, pa2, pa3, bl0, bh0, bl1, bh1); SBAR(); pv_rd<5>(vb, bl0, bh0, bl1, bh1);
    PV_WAIT4(); PV_MM(4, pa0, pa1, al0, ah0, al1, ah1); SBAR(); pv_rd<6>(vb, al0, ah0, al1, ah1);
    PV_WAIT4(); PV_MM(5, pa2, pa3, bl0, bh0, bl1, bh1); SBAR(); pv_rd<7>(vb, bl0, bh0, bl1, bh1);
    PV_WAIT4(); PV_MM(6, pa0, pa1, al0, ah0, al1, ah1);
    PV_WAIT0(); PV_MM(7, pa2, pa3, bl0, bh0, bl1, bh1);
}

__device__ __forceinline__ void pv_seq(f32x16* o, int vb, bf16x8 pa0, bf16x8 pa1, bf16x8 pa2, bf16x8 pa3) {
    s16x4 al0, ah0, al1, ah1;
    pv_rd<0>(vb, al0, ah0, al1, ah1); PV_WAIT0(); PV_MM(0, pa0, pa1, al0, ah0, al1, ah1); SBAR();
    pv_rd<1>(vb, al0, ah0, al1, ah1); PV_WAIT0(); PV_MM(1, pa2, pa3, al0, ah0, al1, ah1); SBAR();
    pv_rd<2>(vb, al0, ah0, al1, ah1); PV_WAIT0(); PV_MM(2, pa0, pa1, al0, ah0, al1, ah1); SBAR();
    pv_rd<3>(vb, al0, ah0, al1, ah1); PV_WAIT0(); PV_MM(3, pa2, pa3, al0, ah0, al1, ah1); SBAR();
    pv_rd<4>(vb, al0, ah0, al1, ah1); PV_WAIT0(); PV_MM(4, pa0, pa1, al0, ah0, al1, ah1); SBAR();
    pv_rd<5>(vb, al0, ah0, al1, ah1); PV_WAIT0(); PV_MM(5, pa2, pa3, al0, ah0, al1, ah1); SBAR();
    pv_rd<6>(vb, al0, ah0, al1, ah1); PV_WAIT0(); PV_MM(6, pa0, pa1, al0, ah0, al1, ah1); SBAR();
    pv_rd<7>(vb, al0, ah0, al1, ah1); PV_WAIT0(); PV_MM(7, pa2, pa3, al0, ah0, al1, ah1);
}

__device__ __forceinline__ void sgu_phase(KArgs a, int j, LAS unsigned char* lds, int G) {
    int tid_l = threadIdx.x; asm volatile("" : "+v"(tid_l)); const int tid = tid_l, lane = tid & 63, wid = __builtin_amdgcn_readfirstlane(tid >> 6), r32 = lane & 31, hi = lane >> 5;
    const bf16* G1 = (const bf16*)(GWS(a) + WS_G1); bf16* CC = (bf16*)(GWS(a) + WS_CC); const f32x2* stat = (const f32x2*)(GWS(a) + WS_STAT);
    const float* lnw = GIN(a, 13) + (size_t)j * 4096; const float* lnb = GIN(a, 14) + (size_t)j * 4096; const float* ws_all = GIN(a, 15) + (size_t)j * 16 * 128 * 128; const float* bs = GIN(a, 16) + (size_t)j * 16 * 128;
    constexpr int MXP = 272, OFF_ST = 69632;
    LAS float* st_mean = (LAS float*)(lds + OFF_ST); LAS float* st_rstd = st_mean + 128;
    LAS float* m1s = (LAS float*)(lds + OFF_ST + 1024) + wid * 64; LAS float* rss = m1s + 32;
    LAS unsigned char* mx = lds + wid * (32 * MXP);
    const int sr = tid >> 4, sc = (tid & 15) * 8, vst0 = v_st(sr, sc), vst1 = v_st(32 + sr, sc);
    const int tb = wid >> 1, ch = wid & 1;
    const int vb0 = (int)(unsigned)(unsigned long long)lds + v_rd_base(lane);
    v4u vx[8];
#define SGU_LOADV(it_) do { const int ch_ = (it_) >> 4, g_ = (it_) & 15; const bf16* s0_ = uni(G1 + (size_t)(ch_ * 128) * N_AB + G1_VB + g_ * 256); const unsigned lo_ = (unsigned)(sr * N_AB + sc); \
    _Pragma("unroll") for (int st = 0; st < 2; ++st) _Pragma("unroll") for (int c2 = 0; c2 < 2; ++c2) { const unsigned o_ = lo_ + (unsigned)(64 * st * N_AB + c2 * 128); \
        vx[(st * 2 + c2) * 2] = LDNT((const v4u*)(s0_ + o_)); vx[(st * 2 + c2) * 2 + 1] = LDNT((const v4u*)(s0_ + o_ + 32 * N_AB)); } } while (0)
    const int item0 = (int)((blockIdx.x + 128u) % (unsigned)G);
    if (item0 < 132 * 16) SGU_LOADV(item0);
    for (int item = item0; item < 132 * 16; item += G) {
        const int chunk = item >> 4, g = item & 15, row0 = chunk * 128;
        __syncthreads();
#pragma unroll
        for (int q = 0; q < 4; ++q) { *(LAS v4u*)(lds + q * 16384 + vst0) = vx[2 * q]; *(LAS v4u*)(lds + q * 16384 + vst1) = vx[2 * q + 1]; }
        if (tid < 128) { const f32x2 s = stat[row0 + tid]; st_mean[tid] = s.x; st_rstd[tid] = s.y; }
        __syncthreads();
        if (item + G < 132 * 16) SGU_LOADV(item + G);
        const float* wrow = ws_all + ((size_t)g * 128 + 32 * tb + r32) * 128;
        bf16x8 pa[2][4]; float m1 = 0.f, rs = 0.f;
#pragma unroll
        for (int st = 0; st < 2; ++st)
#pragma unroll
            for (int ks = 0; ks < 4; ++ks) { const int s0 = 64 * st + 16 * ks + 8 * hi; const f32x4 w0 = *(const f32x4*)(wrow + s0), w1 = *(const f32x4*)(wrow + s0 + 4);
                const f32x4 r0 = *(const LAS f32x4*)(st_rstd + s0), r1 = *(const LAS f32x4*)(st_rstd + s0 + 4), mu0 = *(const LAS f32x4*)(st_mean + s0), mu1 = *(const LAS f32x4*)(st_mean + s0 + 4);
                rs += (w0[0] + w0[1]) + (w0[2] + w0[3]) + (w1[0] + w1[1]) + (w1[2] + w1[3]);
                v4u p; p.x = cvtpk(w0[0] * r0[0], w0[1] * r0[1]); p.y = cvtpk(w0[2] * r0[2], w0[3] * r0[3]); p.z = cvtpk(w1[0] * r1[0], w1[1] * r1[1]); p.w = cvtpk(w1[2] * r1[2], w1[3] * r1[3]);
                m1 += bf_lo(p.x) * mu0[0] + bf_hi(p.x) * mu0[1] + bf_lo(p.y) * mu0[2] + bf_hi(p.y) * mu0[3] + bf_lo(p.z) * mu1[0] + bf_hi(p.z) * mu1[1] + bf_lo(p.w) * mu1[2] + bf_hi(p.w) * mu1[3];
                pa[st][ks] = __builtin_bit_cast(bf16x8, p); }
        m1 += __shfl_xor(m1, 32); rs += __shfl_xor(rs, 32);
        if (hi == 0) { m1s[r32] = m1; rss[r32] = rs; }
        f32x16 o[4];
#pragma unroll
        for (int d = 0; d < 4; ++d)
#pragma unroll
            for (int r = 0; r < 16; ++r) o[d][r] = 0.f;
#pragma unroll
        for (int st = 0; st < 2; ++st) pv_d0(o, vb0 + (st * 2 + ch) * 16384, pa[st][0], pa[st][1], pa[st][2], pa[st][3]);
        asm volatile("s_waitcnt lgkmcnt(0)" ::: "memory");
        __syncthreads();
        { const int cb = g * 256 + ch * 128;
          const float* lw = uni(lnw + cb); const float* lb = uni(lnb + cb); const float* bsg = uni(bs + g * 128 + 32 * tb);
          int r32e = r32, hie = hi; asm volatile("" : "+v"(r32e), "+v"(hie));
          float lwv[4], lbv[4];
#pragma unroll
          for (int d0 = 0; d0 < 4; ++d0) { lwv[d0] = lw[d0 * 32 + r32e]; lbv[d0] = lb[d0 * 32 + r32e]; }
#pragma unroll
          for (int r = 0; r < 16; ++r) { const int rr = crow(r, hie); const float m1t = m1s[rr], rst = rss[rr], bst = bsg[rr];
#pragma unroll
            for (int d0 = 0; d0 < 4; ++d0) { const float mix = lwv[d0] * (o[d0][r] - m1t) + lbv[d0] * rst + bst;
                *(LAS bf16*)(mx + rr * MXP + (d0 * 32 + r32e) * 2) = (bf16)(cvtpk(mix, 0.f) & 0xffffu); } } }
        asm volatile("s_waitcnt lgkmcnt(0)" ::: "memory");
        { const int cb = g * 256 + ch * 128;
          const bf16* Gu = uni(G1 + (size_t)(row0 + 32 * tb) * N_AB + G1_UB + cb); const bf16* Gzb = uni(G1 + (size_t)(row0 + 32 * tb) * N_AB + G1_ZB + cb); bf16* Co = uni(CC + (size_t)(row0 + 32 * tb) * MIXW + 4096 + cb);
          int le = lane; asm volatile("" : "+v"(le));
#pragma unroll
          for (int i = 0; i < 8; ++i) { const int id = 64 * i + le, row = id >> 4, c8 = (id & 15) * 8;
              const v4u mq = *(const LAS v4u*)(mx + row * MXP + c8 * 2); const v4u uq = LDNT((const v4u*)(Gu + (unsigned)(row * N_AB + c8))), zq = LDNT((const v4u*)(Gzb + (unsigned)(row * N_AB + c8)));
              v4u oq;
#pragma unroll
              for (int e = 0; e < 4; ++e) oq[e] = cvtpk(bf_lo(uq[e]) * bf_lo(mq[e]) * bf_lo(zq[e]), bf_hi(uq[e]) * bf_hi(mq[e]) * bf_hi(zq[e]));
              *(v4u*)(Co + (unsigned)(row * MIXW + c8)) = oq;
              if ((i & 3) == 3) asm volatile("" ::: "memory"); } }
    }
#undef SGU_LOADV
    __syncthreads();
}

namespace att {
constexpr int QBLK = 32, KVBLK = 64;
constexpr float SCALE = 0.07216878364870322f;
constexpr float THR = 8.f;
constexpr int SHM_V = KVBLK * 128 * 2, SHM_K = KVBLK * 192 * 2;
#ifndef STG_SEL
#define STG_SEL 0
#endif
#ifndef ATT_STAGGER
#define ATT_STAGGER 1
#endif
constexpr int NVB = ATT_STAGGER ? 3 : 2;
constexpr int OFF_V = 0, OFF_K = NVB * SHM_V, OFF_WS = OFF_K + 2 * SHM_K, ATT_LDS = OFF_WS + NWAVES * 64 * 4;
#ifndef ATT_QR_LDS
#define ATT_QR_LDS 1
#endif
#ifndef ATT_SDEPTH
#define ATT_SDEPTH 1
#endif
constexpr int SDEPTH = ATT_SDEPTH;
constexpr float THRL = THR * 1.4426950408889634f;
__device__ __forceinline__ void partialSM_first(f32x16& p0, f32x16& p1, float& m_reg, float& alpha) {
    float pmax = p0[0];
#pragma unroll
    for (int r = 1; r < 16; ++r) pmax = fmaxf(pmax, p0[r]);
#pragma unroll
    for (int r = 0; r < 16; ++r) pmax = fmaxf(pmax, p1[r]);
    { auto rr = __builtin_amdgcn_permlane32_swap(__float_as_uint(pmax), __float_as_uint(pmax), false, false);
      pmax = fmaxf(__uint_as_float(rr[0]), __uint_as_float(rr[1])); }
    m_reg = pmax; alpha = 1.f;
#pragma unroll
    for (int r = 0; r < 16; ++r) p0[r] = p0[r] - pmax;
#pragma unroll
    for (int r = 0; r < 16; ++r) p1[r] = p1[r] - pmax;
#pragma unroll
    for (int r = 0; r < 16; ++r) p0[r] = __builtin_amdgcn_exp2f(p0[r]);
}
__device__ __forceinline__ void partialSM(f32x16& p0, f32x16& p1, float& m_reg, float& alpha) {
    float pmax = p0[0];
#pragma unroll
    for (int r = 1; r < 16; ++r) pmax = fmaxf(pmax, p0[r]);
#pragma unroll
    for (int r = 0; r < 16; ++r) pmax = fmaxf(pmax, p1[r]);
    { auto rr = __builtin_amdgcn_permlane32_swap(__float_as_uint(pmax), __float_as_uint(pmax), false, false);
      pmax = fmaxf(__uint_as_float(rr[0]), __uint_as_float(rr[1])); }
    if (__builtin_expect(__all(pmax <= THRL), 1)) { alpha = 1.f; }
    else { const float d = fmaxf(pmax, 0.f); alpha = __builtin_amdgcn_exp2f(-d); m_reg += d;
#pragma unroll
        for (int r = 0; r < 16; ++r) p0[r] = p0[r] - d;
#pragma unroll
        for (int r = 0; r < 16; ++r) p1[r] = p1[r] - d; }
#pragma unroll
    for (int r = 0; r < 16; ++r) p0[r] = __builtin_amdgcn_exp2f(p0[r]);
}
__device__ __forceinline__ void finishSM(f32x16& p0, f32x16& p1, float alpha, float& l_reg, bf16x8& pa0, bf16x8& pa1, bf16x8& pa2, bf16x8& pa3) {
#pragma unroll
    for (int r = 0; r < 16; ++r) p1[r] = __builtin_amdgcn_exp2f(p1[r]);
    float ps = 0;
#pragma unroll
    for (int r = 0; r < 16; ++r) ps += p0[r];
#pragma unroll
    for (int r = 0; r < 16; ++r) ps += p1[r];
    { auto rr = __builtin_amdgcn_permlane32_swap(__float_as_uint(ps), __float_as_uint(ps), false, false);
      ps = __uint_as_float(rr[0]) + __uint_as_float(rr[1]); }
    l_reg = l_reg * alpha + ps;
#define PK4(P, BASE, OUT) do { unsigned a0 = cvtpk(P[BASE + 0], P[BASE + 1]), a1 = cvtpk(P[BASE + 2], P[BASE + 3]);   \
    unsigned b0 = cvtpk(P[BASE + 4], P[BASE + 5]), b1 = cvtpk(P[BASE + 6], P[BASE + 7]);                              \
    auto r0 = __builtin_amdgcn_permlane32_swap(a0, b0, false, false); auto r1 = __builtin_amdgcn_permlane32_swap(a1, b1, false, false); \
    v4u w = {r0[0], r1[0], r0[1], r1[1]}; OUT = __builtin_bit_cast(bf16x8, w); } while (0)
    PK4(p0, 0, pa0); PK4(p0, 8, pa1); PK4(p1, 0, pa2); PK4(p1, 8, pa3);
#undef PK4
}
constexpr int OFF_KR = 16384;
constexpr int OFF_QR = ATT_LDS, ATT_LDS2 = OFF_QR + NWAVES * 4096;
__device__ __forceinline__ void qkt(f32x16& p0, f32x16& p1, const LAS unsigned char* Ks, const bf16x8* qr, const LAS unsigned char* qrl, int r32, int hi, float seed) {
#pragma unroll
    for (int r = 0; r < 16; ++r) { p0[r] = seed; p1[r] = seed; }
    const int swn = (r32 & 15) << 4, swr = ((r32 >> 1) & 7) << 4;
#pragma unroll
    for (int d0 = 0; d0 < 8; ++d0) { const int cb = (d0 * 16 + hi * 8) * 2;
        const bf16x8 b0 = *(const LAS bf16x8*)(Ks + r32 * 256 + (cb ^ swn));
        const bf16x8 b1 = *(const LAS bf16x8*)(Ks + (32 + r32) * 256 + (cb ^ swn));
        p0 = __builtin_amdgcn_mfma_f32_32x32x16_bf16(b0, qr[d0], p0, 0, 0, 0);
        p1 = __builtin_amdgcn_mfma_f32_32x32x16_bf16(b1, qr[d0], p1, 0, 0, 0); }
#pragma unroll
    for (int d0 = 0; d0 < 4; ++d0) { const int cb = (d0 * 16 + hi * 8) * 2;
        const bf16x8 b0 = *(const LAS bf16x8*)(Ks + OFF_KR + r32 * 128 + (cb ^ swr));
        const bf16x8 b1 = *(const LAS bf16x8*)(Ks + OFF_KR + (32 + r32) * 128 + (cb ^ swr));
#if ATT_QR_LDS
        const bf16x8 q = *(const LAS bf16x8*)(qrl + d0 * 1024);
#else
        const bf16x8 q = qr[8 + d0];
#endif
        p0 = __builtin_amdgcn_mfma_f32_32x32x16_bf16(b0, q, p0, 0, 0, 0);
        p1 = __builtin_amdgcn_mfma_f32_32x32x16_bf16(b1, q, p1, 0, 0, 0); }
}
__device__ __forceinline__ void attn_unit(const bf16* __restrict__ Q, const bf16* __restrict__ KN, const bf16* __restrict__ KR, const bf16* __restrict__ V, const bf16* __restrict__ G1, bf16* __restrict__ CC,
                                          int qrow0, int h, int nt_lat, int lat0, int ctx0, LAS unsigned char* lds) {
    int tid_l = threadIdx.x; asm volatile("" : "+v"(tid_l)); const int tid = tid_l, wid = __builtin_amdgcn_readfirstlane(tid >> 6), lane = tid & 63, r32 = lane & 31, hi = lane >> 5;
    LAS unsigned char* V_lds = lds + OFF_V; LAS unsigned char* K_lds = lds + OFF_K;
    LAS float* wsf = (LAS float*)(lds + OFF_WS) + wid * 64; LAS float* li_l = wsf; LAS float* al_l = wsf + 32;
    LAS unsigned char* qrl = lds + OFF_QR + wid * 4096 + lane * 16;
    float m_reg = -1e30f, l_reg = 0;
    f32x16 o[4];
#pragma unroll
    for (int d = 0; d < 4; ++d)
#pragma unroll
        for (int r = 0; r < 16; ++r) o[d][r] = 0.f;
    const unsigned ko = (unsigned)((tid >> 4) * 128 + (((tid & 15) ^ ((tid >> 4) & 15)) * 8));
    const unsigned kro = (unsigned)((tid >> 3) * 64 + (((tid & 7) ^ ((tid >> 4) & 7)) * 8));
    unsigned vo; { const int sub = tid >> 5, kk = (sub >> 2) * 8 + ((tid & 31) >> 2), col = (sub & 3) * 32 + (tid & 3) * 8, key = (kk & ~0xC) | ((kk & 4) << 1) | ((kk & 8) >> 1); vo = (unsigned)(key * 128 + col); }
    const int vb0 = (int)(unsigned)(unsigned long long)lds + OFF_V + v_rd_base(lane);
    const int NT = nt_lat + 4;
#define TROW(jt) ((jt) < nt_lat ? lat0 + 64 * (jt) : ctx0 + 64 * ((jt) - nt_lat))
#define GLDS(gp, lp) __builtin_amdgcn_global_load_lds((const unsigned*)(gp), (LAS unsigned*)(lp), 16, 0, 0)
#define GLDS_S(gbase, boff, lp) do { const char* gb_ = (const char*)(gbase); asm volatile("" : "+s"(gb_)); unsigned bo_ = (boff); asm volatile("" : "+v"(bo_)); GLDS(gb_ + bo_, lp); } while (0)
#define ISSUE_K(jt, b) do { const int R0_ = TROW(jt); const bf16* Kb_ = uni(KN + ((size_t)h * MTOT + R0_) * 128); const bf16* Rb_ = uni(KR + (size_t)R0_ * 64); \
    GLDS_S(Kb_, ko * 2u, K_lds + (b) * SHM_K + wid * 1024); GLDS_S(Kb_ + 32 * 128, ko * 2u, K_lds + (b) * SHM_K + (wid + 8) * 1024); GLDS_S(Rb_, kro * 2u, K_lds + (b) * SHM_K + OFF_KR + wid * 1024); } while (0)
#define ISSUE_V(jt, b) do { const int R0_ = TROW(jt); const bf16* Vb_ = uni(V + ((size_t)h * MTOT + R0_) * 128); \
    GLDS_S(Vb_, vo * 2u, V_lds + (b) * SHM_V + wid * 1024); GLDS_S(Vb_ + 32 * 128, vo * 2u, V_lds + (b) * SHM_V + (wid + 8) * 1024); } while (0)
#define STEP_END() asm volatile("s_waitcnt vmcnt(0) lgkmcnt(0)\n\ts_barrier" ::: "memory")
#define RESC(a_) do { if (__any((a_) < 1.f)) { if (hi == 0) al_l[r32] = (a_); asm volatile("s_waitcnt lgkmcnt(0)" ::: "memory"); \
    _Pragma("unroll") for (int d = 0; d < 4; ++d) _Pragma("unroll") for (int r = 0; r < 16; ++r) o[d][r] *= al_l[crow(r, hi)]; } } while (0)
    STEP_END();
    ISSUE_K(0, 0);
    bf16x8 qr[ATT_QR_LDS ? 8 : 12];
    { const bf16* Qw = uni(Q + (size_t)(qrow0 + wid * QBLK) * NQ + h * 192); const unsigned qo = (unsigned)(r32 * NQ + hi * 8);
#pragma unroll
      for (int d0 = 0; d0 < (ATT_QR_LDS ? 8 : 12); ++d0) qr[d0] = *(const bf16x8*)(Qw + qo + d0 * 16);
#if ATT_QR_LDS
#pragma unroll
      for (int d0 = 8; d0 < 12; ++d0) { const bf16x8 t = *(const bf16x8*)(Qw + qo + d0 * 16); *(LAS bf16x8*)(qrl + (d0 - 8) * 1024) = t; }
#endif
    }
    f32x16 pA0, pA1, pB0, pB1; float alA, alB; bf16x8 pa0, pa1, pa2, pa3;
    STEP_END();
#if !ATT_STAGGER
    ISSUE_K(1, 1); ISSUE_V(0, 0);
    qkt(pA0, pA1, K_lds, qr, qrl, r32, hi, 0.f); partialSM_first(pA0, pA1, m_reg, alA);
    STEP_END();
    for (int j = 1; j + 1 < NT; j += 2) {
        ISSUE_K(j + 1, 0); ISSUE_V(j, 1);
        SBAR(); qkt(pB0, pB1, K_lds + SHM_K, qr, qrl, r32, hi, -m_reg);
        finishSM(pA0, pA1, alA, l_reg, pa0, pa1, pa2, pa3); SBAR();
        pv_pipe(o, vb0, pa0, pa1, pa2, pa3); partialSM(pB0, pB1, m_reg, alB);
        RESC(alB); STEP_END();
        ISSUE_K(j + 2, 1); ISSUE_V(j + 1, 0);
        SBAR(); qkt(pA0, pA1, K_lds, qr, qrl, r32, hi, -m_reg);
        finishSM(pB0, pB1, alB, l_reg, pa0, pa1, pa2, pa3); SBAR();
        pv_pipe(o, vb0 + SHM_V, pa0, pa1, pa2, pa3); partialSM(pA0, pA1, m_reg, alA);
        RESC(alA); STEP_END();
    }
    ISSUE_V(NT - 1, 1);
    SBAR(); qkt(pB0, pB1, K_lds + SHM_K, qr, qrl, r32, hi, -m_reg);
    finishSM(pA0, pA1, alA, l_reg, pa0, pa1, pa2, pa3); SBAR();
    pv_pipe(o, vb0, pa0, pa1, pa2, pa3); partialSM(pB0, pB1, m_reg, alB);
    RESC(alB); STEP_END();
    finishSM(pB0, pB1, alB, l_reg, pa0, pa1, pa2, pa3); SBAR();
    pv_pipe(o, vb0 + SHM_V, pa0, pa1, pa2, pa3);
#else
#define VOFF(t) (__builtin_amdgcn_readfirstlane(((unsigned)(t) % 3u) * (unsigned)SHM_V))
    if (STG_SEL == 0 ? (wid < 4) : (STG_SEL == 1)) {
        ISSUE_K(1, 1); ISSUE_V(0, 0);
        qkt(pA0, pA1, K_lds, qr, qrl, r32, hi, 0.f); partialSM_first(pA0, pA1, m_reg, alA);
        STEP_END();
        for (int j = 1; j + 1 < NT; j += 2) {
            ISSUE_K(j + 1, 0); ISSUE_V(j, j % 3);
            SBAR(); qkt(pB0, pB1, K_lds + SHM_K, qr, qrl, r32, hi, -m_reg); SBAR();
            finishSM(pA0, pA1, alA, l_reg, pa0, pa1, pa2, pa3); SBAR();
            pv_pipe(o, vb0 + VOFF(j - 1), pa0, pa1, pa2, pa3); partialSM(pB0, pB1, m_reg, alB);
            RESC(alB); STEP_END();
            ISSUE_K(j + 2, 1); ISSUE_V(j + 1, (j + 1) % 3);
            SBAR(); qkt(pA0, pA1, K_lds, qr, qrl, r32, hi, -m_reg); SBAR();
            finishSM(pB0, pB1, alB, l_reg, pa0, pa1, pa2, pa3); SBAR();
            pv_pipe(o, vb0 + VOFF(j), pa0, pa1, pa2, pa3); partialSM(pA0, pA1, m_reg, alA);
            RESC(alA); STEP_END();
        }
        ISSUE_V(NT - 1, (NT - 1) % 3);
        SBAR(); qkt(pB0, pB1, K_lds + SHM_K, qr, qrl, r32, hi, -m_reg); SBAR();
        finishSM(pA0, pA1, alA, l_reg, pa0, pa1, pa2, pa3); SBAR();
        pv_pipe(o, vb0 + VOFF(NT - 2), pa0, pa1, pa2, pa3); partialSM(pB0, pB1, m_reg, alB);
        RESC(alB); STEP_END();
        finishSM(pB0, pB1, alB, l_reg, pa0, pa1, pa2, pa3); SBAR();
        pv_pipe(o, vb0 + VOFF(NT - 1), pa0, pa1, pa2, pa3);
        STEP_END();
        STEP_END();
    } else {
#define TR_EVEN(j_) do { finishSM(pA0, pA1, alA, l_reg, pa0, pa1, pa2, pa3); SBAR(); pv_pipe(o, vb0 + VOFF((j_) - 2), pa0, pa1, pa2, pa3); partialSM(pB0, pB1, m_reg, alB); RESC(alB); } while (0)
#define TR_ODD(j_)  do { finishSM(pB0, pB1, alB, l_reg, pa0, pa1, pa2, pa3); SBAR(); pv_pipe(o, vb0 + VOFF((j_) - 2), pa0, pa1, pa2, pa3); partialSM(pA0, pA1, m_reg, alA); RESC(alA); } while (0)
        ISSUE_K(1, 1); ISSUE_V(0, 0);
        qkt(pA0, pA1, K_lds, qr, qrl, r32, hi, 0.f);
        STEP_END();
        ISSUE_K(2, 0); ISSUE_V(1, 1);
        partialSM_first(pA0, pA1, m_reg, alA);
        SBAR(); qkt(pB0, pB1, K_lds + SHM_K, qr, qrl, r32, hi, -m_reg); SBAR();
        STEP_END();
        for (int j = 2; j + 1 < NT - 1; j += 2) {
            ISSUE_K(j + 1, 1); ISSUE_V(j, j % 3);
            TR_EVEN(j); SBAR(); qkt(pA0, pA1, K_lds, qr, qrl, r32, hi, -m_reg); SBAR();
            STEP_END();
            ISSUE_K(j + 2, 0); ISSUE_V(j + 1, (j + 1) % 3);
            TR_ODD(j + 1); SBAR(); qkt(pB0, pB1, K_lds + SHM_K, qr, qrl, r32, hi, -m_reg); SBAR();
            STEP_END();
        }
        ISSUE_K(NT - 1, 1); ISSUE_V(NT - 2, (NT - 2) % 3);
        TR_EVEN(NT - 2); SBAR(); qkt(pA0, pA1, K_lds, qr, qrl, r32, hi, -m_reg); SBAR();
        STEP_END();
        ISSUE_V(NT - 1, (NT - 1) % 3);
        TR_ODD(NT - 1); SBAR(); qkt(pB0, pB1, K_lds + SHM_K, qr, qrl, r32, hi, -m_reg); SBAR();
        STEP_END();
        TR_EVEN(NT);
        STEP_END();
        finishSM(pB0, pB1, alB, l_reg, pa0, pa1, pa2, pa3); SBAR();
        pv_pipe(o, vb0 + VOFF(NT - 1), pa0, pa1, pa2, pa3);
        STEP_END();
#undef TR_EVEN
#undef TR_ODD
    }
#undef VOFF
#endif
    if (hi == 0) li_l[r32] = l_reg;
    STEP_END();
    { LAS unsigned char* mx = lds + wid * (32 * 272);
      int r32e = r32, hie = hi; asm volatile("" : "+v"(r32e), "+v"(hie));
#pragma unroll
      for (int r = 0; r < 16; ++r) { const int rr = crow(r, hie); const float rli = __builtin_amdgcn_rcpf(li_l[rr]);
#pragma unroll
        for (int d0 = 0; d0 < 4; ++d0) *(LAS bf16*)(mx + rr * 272 + (d0 * 32 + r32e) * 2) = (bf16)(cvtpk(o[d0][r] * rli, 0.f) & 0xffffu); }
      asm volatile("s_waitcnt lgkmcnt(0)" ::: "memory");
      const bf16* Gz = uni(G1 + (size_t)(qrow0 + wid * QBLK) * N_AB + G1_ZA + h * 128); bf16* Co = uni(CC + (size_t)(qrow0 + wid * QBLK) * MIXW + h * 128);
      int le = lane; asm volatile("" : "+v"(le));
#pragma unroll
      for (int i = 0; i < 8; ++i) { const int id = 64 * i + le, row = id >> 4, c8 = (id & 15) * 8;
          const v4u oq = *(const LAS v4u*)(mx + row * 272 + c8 * 2); const v4u zq = LDNT((const v4u*)(Gz + (unsigned)(row * N_AB + c8)));
          v4u wq;
#pragma unroll
          for (int e = 0; e < 4; ++e) wq[e] = cvtpk(bf_lo(oq[e]) * bf_lo(zq[e]), bf_hi(oq[e]) * bf_hi(zq[e]));
          *(v4u*)(Co + (unsigned)(row * MIXW + c8)) = wq;
          if ((i & 3) == 3) asm volatile("" ::: "memory"); } }
#undef TROW
#undef GLDS
#undef ISSUE_K
#undef ISSUE_V
#undef STEP_END
#undef RESC
}
}
namespace att2 {
using namespace att;
struct P8 { f32x4 t[2][4]; };
__device__ __forceinline__ float x16(float x) { return __int_as_float(__builtin_amdgcn_ds_swizzle(__float_as_int(x), 0x401F)); }
__device__ __forceinline__ float rmax4(float x) { x = fmaxf(x, x16(x)); auto rr = __builtin_amdgcn_permlane32_swap(__float_as_uint(x), __float_as_uint(x), false, false); return fmaxf(__uint_as_float(rr[0]), __uint_as_float(rr[1])); }
__device__ __forceinline__ float rsum4(float x) { x = x + x16(x); auto rr = __builtin_amdgcn_permlane32_swap(__float_as_uint(x), __float_as_uint(x), false, false); return __uint_as_float(rr[0]) + __uint_as_float(rr[1]); }
__device__ __forceinline__ float tmax(const P8& p, int qt) { float m = p.t[qt][0][0];
#pragma unroll
    for (int kt = 0; kt < 4; ++kt)
#pragma unroll
        for (int r = 0; r < 4; ++r) m = fmaxf(m, p.t[qt][kt][r]);
    return m; }
__device__ __forceinline__ void qkt2(P8& p, const LAS unsigned char* Ks, const bf16x8 (&qf)[2][4], const LAS unsigned char* qrl, int l16, int g4, float seed0, float seed1) {
#pragma unroll
    for (int kt = 0; kt < 4; ++kt) { p.t[0][kt] = (f32x4){seed0, seed0, seed0, seed0}; p.t[1][kt] = (f32x4){seed1, seed1, seed1, seed1}; }
    const int swn = l16 << 4, swr = ((l16 >> 1) & 7) << 4;
#pragma unroll
    for (int ks = 0; ks < 4; ++ks) { const int cb = (32 * ks + 8 * g4) * 2;
#pragma unroll
        for (int kt = 0; kt < 4; ++kt) { const bf16x8 kf = *(const LAS bf16x8*)(Ks + (16 * kt + l16) * 256 + (cb ^ swn));
            p.t[0][kt] = mfma16(kf, qf[0][ks], p.t[0][kt]); p.t[1][kt] = mfma16(kf, qf[1][ks], p.t[1][kt]); } }
#pragma unroll
    for (int ks = 0; ks < 2; ++ks) { const int cb = (32 * ks + 8 * g4) * 2;
        const bf16x8 q0 = *(const LAS bf16x8*)(qrl + ks * 1024), q1 = *(const LAS bf16x8*)(qrl + (2 + ks) * 1024);
#pragma unroll
        for (int kt = 0; kt < 4; ++kt) { const bf16x8 kf = *(const LAS bf16x8*)(Ks + OFF_KR + (16 * kt + l16) * 128 + (cb ^ swr));
            p.t[0][kt] = mfma16(kf, q0, p.t[0][kt]); p.t[1][kt] = mfma16(kf, q1, p.t[1][kt]); } }
}
__device__ __forceinline__ void sub_all(P8& p, float d0, float d1) {
#pragma unroll
    for (int kt = 0; kt < 4; ++kt) { p.t[0][kt] = p.t[0][kt] - d0; p.t[1][kt] = p.t[1][kt] - d1; } }
__device__ __forceinline__ void exp_half(P8& p, int k0) {
#pragma unroll
    for (int qt = 0; qt < 2; ++qt)
#pragma unroll
        for (int kt = 0; kt < 2; ++kt)
#pragma unroll
            for (int r = 0; r < 4; ++r) p.t[qt][k0 + kt][r] = __builtin_amdgcn_exp2f(p.t[qt][k0 + kt][r]); }
__device__ __forceinline__ void partial2_first(P8& p, float& m0, float& m1, float& a0, float& a1) {
    m0 = rmax4(tmax(p, 0)); m1 = rmax4(tmax(p, 1)); a0 = 1.f; a1 = 1.f; sub_all(p, m0, m1); exp_half(p, 0); }
__device__ __forceinline__ void partial2(P8& p, float& m0, float& m1, float& a0, float& a1) {
    const float x0 = rmax4(tmax(p, 0)), x1 = rmax4(tmax(p, 1));
    if (__builtin_expect(__all(fmaxf(x0, x1) <= THRL), 1)) { a0 = 1.f; a1 = 1.f; }
    else { const float d0 = fmaxf(x0, 0.f), d1 = fmaxf(x1, 0.f); a0 = __builtin_amdgcn_exp2f(-d0); a1 = __builtin_amdgcn_exp2f(-d1); m0 += d0; m1 += d1; sub_all(p, d0, d1); }
    exp_half(p, 0); }
__device__ __forceinline__ void finish2(P8& p, float a0, float a1, float& l0, float& l1, bf16x8 (&pb)[2][2]) {
    exp_half(p, 2);
    float s0 = 0.f, s1 = 0.f;
#pragma unroll
    for (int kt = 0; kt < 4; ++kt)
#pragma unroll
        for (int r = 0; r < 4; ++r) { s0 += p.t[0][kt][r]; s1 += p.t[1][kt][r]; }
    l0 = l0 * a0 + rsum4(s0); l1 = l1 * a1 + rsum4(s1);
#pragma unroll
    for (int qt = 0; qt < 2; ++qt)
#pragma unroll
        for (int s2 = 0; s2 < 2; ++s2) { v4u w; w.x = cvtpk(p.t[qt][2 * s2][0], p.t[qt][2 * s2][1]); w.y = cvtpk(p.t[qt][2 * s2][2], p.t[qt][2 * s2][3]);
            w.z = cvtpk(p.t[qt][2 * s2 + 1][0], p.t[qt][2 * s2 + 1][1]); w.w = cvtpk(p.t[qt][2 * s2 + 1][2], p.t[qt][2 * s2 + 1][3]); pb[qt][s2] = __builtin_bit_cast(bf16x8, w); }
}
template <int B, int I> __device__ __forceinline__ void pv2_rd(const int (&vo)[8], s16x4& lo, s16x4& hi) { constexpr int s2 = I >> 3, vt = I & 7;
    lo = tr_read<B * SHM_V + s2 * 8192>(vo[vt]); hi = tr_read<B * SHM_V + s2 * 8192 + 4096>(vo[vt]); }
#define PV2_MM(I, L, H) do { const bf16x8 af_ = (bf16x8){L[0], L[1], L[2], L[3], H[0], H[1], H[2], H[3]}; \
    o[(I) & 7][0] = mfma16(af_, pb[0][(I) >> 3], o[(I) & 7][0]); o[(I) & 7][1] = mfma16(af_, pb[1][(I) >> 3], o[(I) & 7][1]); } while (0)
#define PV2_W(N) do { asm volatile("s_waitcnt lgkmcnt(" #N ")" ::: "memory"); SBAR(); } while (0)
template <int B> __device__ __forceinline__ void pv2(f32x4 (&o)[8][2], const int (&vo)[8], const bf16x8 (&pb)[2][2]) {
    s16x4 l0, h0, l1, h1, l2, h2;
    asm volatile("s_waitcnt lgkmcnt(0)" ::: "memory"); SBAR();
    pv2_rd<B, 0>(vo, l0, h0); pv2_rd<B, 1>(vo, l1, h1); pv2_rd<B, 2>(vo, l2, h2);
    PV2_W(4); PV2_MM(0, l0, h0); SBAR(); pv2_rd<B, 3>(vo, l0, h0);
    PV2_W(4); PV2_MM(1, l1, h1); SBAR(); pv2_rd<B, 4>(vo, l1, h1);
    PV2_W(4); PV2_MM(2, l2, h2); SBAR(); pv2_rd<B, 5>(vo, l2, h2);
    PV2_W(4); PV2_MM(3, l0, h0); SBAR(); pv2_rd<B, 6>(vo, l0, h0);
    PV2_W(4); PV2_MM(4, l1, h1); SBAR(); pv2_rd<B, 7>(vo, l1, h1);
    PV2_W(4); PV2_MM(5, l2, h2); SBAR(); pv2_rd<B, 8>(vo, l2, h2);
    PV2_W(4); PV2_MM(6, l0, h0); SBAR(); pv2_rd<B, 9>(vo, l0, h0);
    PV2_W(4); PV2_MM(7, l1, h1); SBAR(); pv2_rd<B, 10>(vo, l1, h1);
    PV2_W(4); PV2_MM(8, l2, h2); SBAR(); pv2_rd<B, 11>(vo, l2, h2);
    PV2_W(4); PV2_MM(9, l0, h0); SBAR(); pv2_rd<B, 12>(vo, l0, h0);
    PV2_W(4); PV2_MM(10, l1, h1); SBAR(); pv2_rd<B, 13>(vo, l1, h1);
    PV2_W(4); PV2_MM(11, l2, h2); SBAR(); pv2_rd<B, 14>(vo, l2, h2);
    PV2_W(4); PV2_MM(12, l0, h0); SBAR(); pv2_rd<B, 15>(vo, l0, h0);
    PV2_W(4); PV2_MM(13, l1, h1);
    PV2_W(2); PV2_MM(14, l2, h2);
    PV2_W(0); PV2_MM(15, l0, h0);
}
__device__ __forceinline__ void attn_unit2(const bf16* __restrict__ Q, const bf16* __restrict__ KN, const bf16* __restrict__ KR, const bf16* __restrict__ V, const bf16* __restrict__ G1, bf16* __restrict__ CC,
                                           int qrow0, int h, int nt_lat, int lat0, int ctx0, LAS unsigned char* lds) {
    int tid_l = threadIdx.x; asm volatile("" : "+v"(tid_l)); const int tid = tid_l, wid = __builtin_amdgcn_readfirstlane(tid >> 6), lane = tid & 63, l16 = lane & 15, g4 = lane >> 4;
    LAS unsigned char* V_lds = lds + OFF_V; LAS unsigned char* K_lds = lds + OFF_K;
    LAS unsigned char* qrl = lds + OFF_QR + wid * 4096 + lane * 16;
    float m0 = 0.f, m1 = 0.f, l0 = 0.f, l1 = 0.f;
    f32x4 o[8][2];
#pragma unroll
    for (int vt = 0; vt < 8; ++vt) { o[vt][0] = (f32x4){0.f, 0.f, 0.f, 0.f}; o[vt][1] = (f32x4){0.f, 0.f, 0.f, 0.f}; }
    const unsigned ko = (unsigned)((tid >> 4) * 128 + (((tid & 15) ^ ((tid >> 4) & 15)) * 8));
    const unsigned kro = (unsigned)((tid >> 3) * 64 + (((tid & 7) ^ ((tid >> 4) & 7)) * 8));
    const unsigned vo_g = (unsigned)((tid >> 4) * 128 + ((((((tid & 15) >> 1) ^ ((tid >> 4) & 7)) << 1) | (tid & 1)) * 8));
    int vo[8];
    { const int q = l16 >> 2, pp = l16 & 3, rr = 4 * g4 + q, sw = rr & 7, base = (int)(unsigned)(unsigned long long)lds + OFF_V + rr * 256 + 8 * pp;
#pragma unroll
      for (int vt = 0; vt < 8; ++vt) vo[vt] = base + ((vt ^ sw) << 5); }
    const int NT = nt_lat + 4;
#define TROW(jt) ((jt) < nt_lat ? lat0 + 64 * (jt) : ctx0 + 64 * ((jt) - nt_lat))
#define GLDS(gp, lp) __builtin_amdgcn_global_load_lds((const unsigned*)(gp), (LAS unsigned*)(lp), 16, 0, 0)
#define ISSUE_K(jt, b) do { const int R0_ = TROW(jt); const bf16* Kb_ = uni(KN + ((size_t)h * MTOT + R0_) * 128); const bf16* Rb_ = uni(KR + (size_t)R0_ * 64); \
    GLDS(Kb_ + ko, K_lds + (b) * SHM_K + wid * 1024); GLDS(Kb_ + ko + 32 * 128, K_lds + (b) * SHM_K + (wid + 8) * 1024); GLDS(Rb_ + kro, K_lds + (b) * SHM_K + OFF_KR + wid * 1024); } while (0)
#define ISSUE_V(jt, b) do { const int R0_ = TROW(jt); const bf16* Vb_ = uni(V + ((size_t)h * MTOT + R0_) * 128); \
    GLDS(Vb_ + vo_g, V_lds + (b) * SHM_V + wid * 1024); GLDS(Vb_ + vo_g + 32 * 128, V_lds + (b) * SHM_V + (wid + 8) * 1024); } while (0)
#define STEP_END() asm volatile("s_waitcnt vmcnt(0) lgkmcnt(0)\n\ts_barrier" ::: "memory")
#define RESC2(a0_, a1_) do { if (__any(fminf(a0_, a1_) < 1.f)) { _Pragma("unroll") for (int vt = 0; vt < 8; ++vt) { o[vt][0] = o[vt][0] * (a0_); o[vt][1] = o[vt][1] * (a1_); } } } while (0)
    STEP_END();
    ISSUE_K(0, 0);
    bf16x8 qf[2][4];
    { const bf16* Qw = uni(Q + (size_t)(qrow0 + wid * QBLK) * NQ + h * 192); const unsigned qo = (unsigned)(l16 * NQ + g4 * 8);
#pragma unroll
      for (int qt = 0; qt < 2; ++qt) {
#pragma unroll
        for (int ks = 0; ks < 4; ++ks) qf[qt][ks] = *(const bf16x8*)(Qw + qo + (unsigned)(qt * 16 * NQ + ks * 32));
#pragma unroll
        for (int ks = 4; ks < 6; ++ks) { const bf16x8 t = *(const bf16x8*)(Qw + qo + (unsigned)(qt * 16 * NQ + ks * 32)); *(LAS bf16x8*)(qrl + (qt * 2 + ks - 4) * 1024) = t; } } }
    P8 pA, pB; float aA0, aA1, aB0, aB1; bf16x8 pb[2][2];
    STEP_END();
    ISSUE_K(1, 1); ISSUE_V(0, 0);
    qkt2(pA, K_lds, qf, qrl, l16, g4, 0.f, 0.f); partial2_first(pA, m0, m1, aA0, aA1);
    STEP_END();
    for (int j = 1; j + 1 < NT; j += 2) {
        ISSUE_K(j + 1, 0); ISSUE_V(j, 1);
        SBAR(); qkt2(pB, K_lds + SHM_K, qf, qrl, l16, g4, -m0, -m1);
        finish2(pA, aA0, aA1, l0, l1, pb); SBAR();
        pv2<0>(o, vo, pb); partial2(pB, m0, m1, aB0, aB1);
        RESC2(aB0, aB1); STEP_END();
        ISSUE_K(j + 2, 1); ISSUE_V(j + 1, 0);
        SBAR(); qkt2(pA, K_lds, qf, qrl, l16, g4, -m0, -m1);
        finish2(pB, aB0, aB1, l0, l1, pb); SBAR();
        pv2<1>(o, vo, pb); partial2(pA, m0, m1, aA0, aA1);
        RESC2(aA0, aA1); STEP_END();
    }
    ISSUE_V(NT - 1, 1);
    SBAR(); qkt2(pB, K_lds + SHM_K, qf, qrl, l16, g4, -m0, -m1);
    finish2(pA, aA0, aA1, l0, l1, pb); SBAR();
    pv2<0>(o, vo, pb); partial2(pB, m0, m1, aB0, aB1);
    RESC2(aB0, aB1); STEP_END();
    finish2(pB, aB0, aB1, l0, l1, pb); SBAR();
    pv2<1>(o, vo, pb);
    STEP_END();
    { LAS unsigned char* mx = lds + wid * (32 * 272);
      const float r0 = __builtin_amdgcn_rcpf(l0), r1 = __builtin_amdgcn_rcpf(l1);
#pragma unroll
      for (int vt = 0; vt < 8; ++vt) { u32x2 w;
          w.x = cvtpk(o[vt][0][0] * r0, o[vt][0][1] * r0); w.y = cvtpk(o[vt][0][2] * r0, o[vt][0][3] * r0); *(LAS u32x2*)(mx + l16 * 272 + (16 * vt + 4 * g4) * 2) = w;
          w.x = cvtpk(o[vt][1][0] * r1, o[vt][1][1] * r1); w.y = cvtpk(o[vt][1][2] * r1, o[vt][1][3] * r1); *(LAS u32x2*)(mx + (16 + l16) * 272 + (16 * vt + 4 * g4) * 2) = w; }
      asm volatile("s_waitcnt lgkmcnt(0)" ::: "memory");
      const bf16* Gz = uni(G1 + (size_t)(qrow0 + wid * QBLK) * N_AB + G1_ZA + h * 128); bf16* Co = uni(CC + (size_t)(qrow0 + wid * QBLK) * MIXW + h * 128);
      int le = lane; asm volatile("" : "+v"(le));
#pragma unroll
      for (int i = 0; i < 8; ++i) { const int id = 64 * i + le, row = id >> 4, c8 = (id & 15) * 8;
          const v4u oq = *(const LAS v4u*)(mx + row * 272 + c8 * 2); const v4u zq = LDNT((const v4u*)(Gz + (unsigned)(row * N_AB + c8)));
          v4u wq;
#pragma unroll
          for (int e = 0; e < 4; ++e) wq[e] = cvtpk(bf_lo(oq[e]) * bf_lo(zq[e]), bf_hi(oq[e]) * bf_hi(zq[e]));
          *(v4u*)(Co + (unsigned)(row * MIXW + c8)) = wq;
          if ((i & 3) == 3) asm volatile("" ::: "memory"); } }
#undef TROW
#undef GLDS
#undef ISSUE_K
#undef ISSUE_V
#undef STEP_END
#undef RESC2
}
#undef PV2_MM
#undef PV2_W
}
#ifndef ATT_PRIO
#define ATT_PRIO 1
#endif
#ifndef ATT_BODY2
#define ATT_BODY2 0
#endif
__device__ __forceinline__ void attn_phase(KArgs a, LAS unsigned char* lds, int G) {
    const bf16* Q = (const bf16*)(GWS(a) + WS_Q); const bf16* KN = (const bf16*)(GWS(a) + WS_KN); const bf16* KR = (const bf16*)(GWS(a) + WS_KR); const bf16* V = (const bf16*)(GWS(a) + WS_V);
    const bf16* G1 = (const bf16*)(GWS(a) + WS_G1); bf16* CC = (bf16*)(GWS(a) + WS_CC);
    const int bx = blockIdx.x; const int vcu = (G % 8 == 0) ? (bx % 8) * (G / 8) + bx / 8 : bx;
    if (ATT_PRIO && __builtin_amdgcn_readfirstlane(threadIdx.x >> 6) >= 4) __builtin_amdgcn_s_setprio(1);
    for (int u = vcu; u < 2048 + 64; u += G) {
        if (u < 2048) { const int bh = u >> 5, qb = u & 31, b = bh >> 5, h = bh & 31;
            if (ATT_BODY2) att2::attn_unit2(Q, KN, KR, V, G1, CC, b * SEQ + qb * 256, h, 128, b * SEQ, MLAT + b * NCTX, lds); else att::attn_unit(Q, KN, KR, V, G1, CC, b * SEQ + qb * 256, h, 128, b * SEQ, MLAT + b * NCTX, lds); }
        else { const int bh = u - 2048, b = bh >> 5, h = bh & 31;
            if (ATT_BODY2) att2::attn_unit2(Q, KN, KR, V, G1, CC, MLAT + b * NCTX, h, 0, 0, MLAT + b * NCTX, lds); else att::attn_unit(Q, KN, KR, V, G1, CC, MLAT + b * NCTX, h, 0, 0, MLAT + b * NCTX, lds); }
    }
    if (ATT_PRIO) __builtin_amdgcn_s_setprio(0);
    __syncthreads();
}

__device__ __forceinline__ s16x4 tr_read_v(int addr) { s16x4 r; asm volatile("ds_read_b64_tr_b16 %0, %1" : "=&v"(r) : "v"(addr) : "memory"); return r; }
template <int CTRL> __device__ __forceinline__ float dpp_f(float x) { return __int_as_float(__builtin_amdgcn_update_dpp(0, __float_as_int(x), CTRL, 0xf, 0xf, true)); }
constexpr int SC_PITCH = 288;
constexpr int SC_QD = 0, SC_KD = 16 * SC_PITCH, SC_KE = 32 * SC_PITCH, SC_VV = 48 * SC_PITCH, SC_EB = 64 * SC_PITCH, SC_BUF = SC_EB + 512;
constexpr int SC_OST = 4 * SC_BUF;
__device__ __forceinline__ void scan_stage(LAS unsigned char* B, u32x2 rq, u32x2 rk, u32x2 rv, int wid, int lane, int tid) {
    const int t = lane & 15, kq = lane >> 4;
    float q[4], kk[4], x[4], tot[4];
    q[0] = bf_lo(rq.x); q[1] = bf_hi(rq.x); q[2] = bf_lo(rq.y); q[3] = bf_hi(rq.y); kk[0] = bf_lo(rk.x); kk[1] = bf_hi(rk.x); kk[2] = bf_lo(rk.y); kk[3] = bf_hi(rk.y);
#pragma unroll
    for (int e = 0; e < 4; ++e) { x[e] = __builtin_amdgcn_logf(fmaxf(1.0f - kk[e], 1e-30f)); tot[e] = x[e]; }
#define SC_DPP8(cg_, cs_) \
        "v_add_f32_dpp %0, %0, %0 " cg_ " row_mask:0xf bank_mask:0xf bound_ctrl:0\n\tv_add_f32_dpp %1, %1, %1 " cg_ " row_mask:0xf bank_mask:0xf bound_ctrl:0\n\t" \
        "v_add_f32_dpp %2, %2, %2 " cg_ " row_mask:0xf bank_mask:0xf bound_ctrl:0\n\tv_add_f32_dpp %3, %3, %3 " cg_ " row_mask:0xf bank_mask:0xf bound_ctrl:0\n\t" \
        "v_add_f32_dpp %4, %4, %4 " cs_ " row_mask:0xf bank_mask:0xf\n\tv_add_f32_dpp %5, %5, %5 " cs_ " row_mask:0xf bank_mask:0xf\n\t" \
        "v_add_f32_dpp %6, %6, %6 " cs_ " row_mask:0xf bank_mask:0xf\n\tv_add_f32_dpp %7, %7, %7 " cs_ " row_mask:0xf bank_mask:0xf\n\t"
    asm volatile("s_nop 1\n\t" SC_DPP8("row_shr:1", "row_ror:8") SC_DPP8("row_shr:2", "row_ror:4") SC_DPP8("row_shr:4", "row_ror:2") SC_DPP8("row_shr:8", "row_ror:1")
                 : "+v"(x[0]), "+v"(x[1]), "+v"(x[2]), "+v"(x[3]), "+v"(tot[0]), "+v"(tot[1]), "+v"(tot[2]), "+v"(tot[3]));
#undef SC_DPP8
    float qd[4], kd[4], ke[4];
#pragma unroll
    for (int e = 0; e < 4; ++e) { qd[e] = q[e] * __builtin_amdgcn_exp2f(x[e]); kd[e] = kk[e] * __builtin_amdgcn_exp2f(fminf(-x[e], 115.0f)); ke[e] = kk[e] * __builtin_amdgcn_exp2f(fminf(tot[e] - x[e], 0.0f)); }
    const int ppos = 32 * (wid >> 1) + 8 * kq + 4 * (wid & 1);
    u32x2 w;
    w.x = cvtpk(qd[0], qd[1]); w.y = cvtpk(qd[2], qd[3]); *(LAS u32x2*)(B + SC_QD + t * SC_PITCH + ppos * 2) = w;
    w.x = cvtpk(kd[0], kd[1]); w.y = cvtpk(kd[2], kd[3]); *(LAS u32x2*)(B + SC_KD + t * SC_PITCH + ppos * 2) = w;
    w.x = cvtpk(ke[0], ke[1]); w.y = cvtpk(ke[2], ke[3]); *(LAS u32x2*)(B + SC_KE + t * SC_PITCH + (16 * wid + 4 * kq) * 2) = w;
    if (t == 0) *(LAS f32x4*)(B + SC_EB + (16 * wid + 4 * kq) * 4) = (f32x4){__builtin_amdgcn_exp2f(tot[0]), __builtin_amdgcn_exp2f(tot[1]), __builtin_amdgcn_exp2f(tot[2]), __builtin_amdgcn_exp2f(tot[3])};
    *(LAS u32x2*)(B + SC_VV + (tid >> 5) * SC_PITCH + (tid & 31) * 8) = rv;
}
__device__ __forceinline__ void scan_phase(KArgs a, LAS unsigned char* lds, int G) {
    int tid_l = threadIdx.x; asm volatile("" : "+v"(tid_l)); const int tid = tid_l, lane = tid & 63, wid = __builtin_amdgcn_readfirstlane(tid >> 6), g4 = lane >> 4, l16 = lane & 15;
    const bf16* G1 = (const bf16*)(GWS(a) + WS_G1); const size_t TS = (size_t)MTOT * MIXW;
    const int ldsb = (int)(unsigned)(unsigned long long)lds;
    const int trq = l16 >> 2, trp = l16 & 3;
    const int st = lane & 15, sk = 16 * wid + 4 * (lane >> 4);
    const int vt_ = tid >> 5, vc = (tid & 31) * 4;
    for (int sq = blockIdx.x; sq < 256; sq += G) {
        const int dir = sq >> 7, b = (sq >> 6) & 1, h = sq & 63;
        const bf16* Tq = G1 + h * 128; const bf16* Tk = G1 + (size_t)(1 + dir) * TS + h * 128; const bf16* Tv = G1 + (size_t)3 * TS + h * 128;
        bf16* Od = (bf16*)(GWS(a) + WS_OF) + (size_t)dir * TS + h * 128;
        const unsigned oq = (unsigned)((dir ? 15 - st : st) * MIXW + sk), ovv = (unsigned)((dir ? 15 - vt_ : vt_) * MIXW + vc);
#define CLOW(c_) ((c_) < 16 ? MLAT + b * NCTX + (dir ? 240 - 16 * (c_) : 16 * (c_)) : b * SEQ + (dir ? 8432 - 16 * (c_) : 16 * (c_) - 256))
#define SLOADC(c_, rq_, rk_, rv_) do { const size_t lo_ = (size_t)CLOW(c_) * MIXW; rq_ = LDNT((const u32x2*)(uni(Tq + lo_) + oq)); rk_ = LDNT((const u32x2*)(uni(Tk + lo_) + oq)); rv_ = LDNT((const u32x2*)(uni(Tv + lo_) + ovv)); } while (0)
#define SBARRIER() do { asm volatile("s_waitcnt lgkmcnt(0)" ::: "memory"); __builtin_amdgcn_s_barrier(); asm volatile("" ::: "memory"); } while (0)
        f32x4 S[8];
#pragma unroll
        for (int i = 0; i < 8; ++i) S[i] = (f32x4){0.f, 0.f, 0.f, 0.f};
        u32x2 rq0, rk0, rv0, rq1, rk1, rv1;
        SBARRIER();
        SLOADC(0, rq0, rk0, rv0); SLOADC(1, rq1, rk1, rv1);
        scan_stage(lds, rq0, rk0, rv0, wid, lane, tid); scan_stage(lds + SC_BUF, rq1, rk1, rv1, wid, lane, tid);
        SLOADC(2, rq0, rk0, rv0); SLOADC(3, rq1, rk1, rv1);
        SBARRIER();
        auto mstage = [&](const int bi) __attribute__((always_inline)) {
            LAS unsigned char* Bc = lds + bi * SC_BUF;
            bf16x8 qf[4], kf[4]; f32x4 e4[8]; s16x4 kt4[8];
#pragma unroll
            for (int ks = 0; ks < 4; ++ks) { qf[ks] = *(const LAS bf16x8*)(Bc + SC_QD + l16 * SC_PITCH + (32 * ks + 8 * g4) * 2); kf[ks] = *(const LAS bf16x8*)(Bc + SC_KD + l16 * SC_PITCH + (32 * ks + 8 * g4) * 2); }
            const int trb = ldsb + bi * SC_BUF + (4 * g4 + trq) * SC_PITCH + 8 * trp;
            const s16x4 vt = tr_read_v(trb + SC_VV + 32 * wid);
#pragma unroll
            for (int kt = 0; kt < 8; ++kt) { e4[kt] = *(const LAS f32x4*)(Bc + SC_EB + (16 * kt + 4 * g4) * 4); kt4[kt] = tr_read_v(trb + SC_KE + 32 * kt); }
            f32x4 at = (f32x4){0.f, 0.f, 0.f, 0.f};
#pragma unroll
            for (int ks = 0; ks < 4; ++ks) at = mfma16(kf[ks], qf[ks], at);
#pragma unroll
            for (int r = 0; r < 4; ++r) at[r] = (4 * g4 + r <= l16) ? at[r] : 0.f;
            bf16x8 pa; { v4u w; w.x = cvtpk(at[0], at[1]); w.y = cvtpk(at[2], at[3]); w.z = 0u; w.w = 0u; pa = __builtin_bit_cast(bf16x8, w); }
            f32x4 o = (f32x4){0.f, 0.f, 0.f, 0.f};
#pragma unroll
            for (int ks = 0; ks < 4; ++ks) { v4u w; w.x = cvtpk(S[2 * ks][0], S[2 * ks][1]); w.y = cvtpk(S[2 * ks][2], S[2 * ks][3]); w.z = cvtpk(S[2 * ks + 1][0], S[2 * ks + 1][1]); w.w = cvtpk(S[2 * ks + 1][2], S[2 * ks + 1][3]);
                o = mfma16(qf[ks], __builtin_bit_cast(bf16x8, w), o); }
            asm volatile("s_waitcnt lgkmcnt(0)" ::: "memory"); SBAR();
            const bf16x8 vf = (bf16x8){vt[0], vt[1], vt[2], vt[3], 0, 0, 0, 0};
            o = mfma16(pa, vf, o);
#pragma unroll
            for (int kt = 0; kt < 8; ++kt) { const bf16x8 kef = (bf16x8){kt4[kt][0], kt4[kt][1], kt4[kt][2], kt4[kt][3], 0, 0, 0, 0};
                S[kt] = mfma16(kef, vf, S[kt] * e4[kt]); }
            { LAS bf16* ost = (LAS bf16*)(lds + SC_OST + bi * 4096);
#pragma unroll
              for (int r = 0; r < 4; ++r) ost[(4 * g4 + r) * 128 + 16 * wid + l16] = (bf16)(cvtpk(o[r], 0.f) & 0xffffu); }
        };
        auto ostore = [&](const int c, const int bi) __attribute__((always_inline)) {
            const u32x2 ov = *(const LAS u32x2*)(lds + SC_OST + bi * 4096 + vt_ * 256 + vc * 2); *(u32x2*)(uni(Od + (size_t)CLOW(c) * MIXW) + ovv) = ov; };
        auto pairit = [&](const int pp, const int par) __attribute__((always_inline)) {
            const int c0 = 2 * pp;
            if (pp > 0) { ostore(c0 - 2, 2 * (par ^ 1)); ostore(c0 - 1, 2 * (par ^ 1) + 1); }
            if (pp + 1 < 264) { scan_stage(lds + (2 * (par ^ 1)) * SC_BUF, rq0, rk0, rv0, wid, lane, tid); scan_stage(lds + (2 * (par ^ 1) + 1) * SC_BUF, rq1, rk1, rv1, wid, lane, tid);
                SLOADC(min(c0 + 4, 527), rq0, rk0, rv0); SLOADC(min(c0 + 5, 527), rq1, rk1, rv1); }
            mstage(2 * par); mstage(2 * par + 1);
            SBARRIER();
        };
        for (int pp = 0; pp < 264; pp += 2) { pairit(pp, 0); pairit(pp + 1, 1); }
        ostore(526, 2); ostore(527, 3);
#undef CLOW
#undef SLOADC
#undef SBARRIER
    }
    asm volatile("s_waitcnt lgkmcnt(0)" ::: "memory"); __builtin_amdgcn_s_barrier(); asm volatile("" ::: "memory");
}

__device__ __forceinline__ void readout_phase(KArgs a, int jc, int nrows, int G) {
    int tid_l = threadIdx.x; asm volatile("" : "+v"(tid_l)); const int tid = tid_l, lane = tid & 63, wave = __builtin_amdgcn_readfirstlane(tid >> 6);
    const int gw = blockIdx.x * NWAVES + wave, NGW = G * NWAVES;
    const size_t TS = (size_t)MTOT * MIXW;
    const bf16* OFp = (const bf16*)(GWS(a) + WS_OF); const bf16* OBp = OFp + TS; const bf16* GS = (const bf16*)(GWS(a) + WS_G1) + 4 * TS; bf16* CC = (bf16*)(GWS(a) + WS_CC);
    const float* gnw = GIN(a, 20) + (size_t)jc * 128 + (lane & 15) * 8;
    const f32x4 w0 = *(const f32x4*)gnw, w1 = *(const f32x4*)(gnw + 4);
    for (int it = gw; it < nrows * 16; it += NGW) {
        const size_t off = (size_t)(it >> 4) * MIXW + (it & 15) * 512 + lane * 8;
        const v4u f = LDNT((const v4u*)(OFp + off)), bq = LDNT((const v4u*)(OBp + off)), gq = LDNT((const v4u*)(GS + off));
        float o[8], gg[8];
#pragma unroll
        for (int e = 0; e < 4; ++e) { o[2 * e] = bf_lo(f[e]) + bf_lo(bq[e]); o[2 * e + 1] = bf_hi(f[e]) + bf_hi(bq[e]); gg[2 * e] = bf_lo(gq[e]); gg[2 * e + 1] = bf_hi(gq[e]); }
        float ss = 0.f;
#pragma unroll
        for (int e = 0; e < 8; ++e) ss += o[e] * o[e];
        ss += __shfl_xor(ss, 1); ss += __shfl_xor(ss, 2); ss += __shfl_xor(ss, 4); ss += __shfl_xor(ss, 8);
        const float r = 1.0f / sqrtf(ss * (1.0f / 128.0f) + EPS);
        v4u w; w.x = cvtpk(o[0] * r * w0[0] * gg[0], o[1] * r * w0[1] * gg[1]); w.y = cvtpk(o[2] * r * w0[2] * gg[2], o[3] * r * w0[3] * gg[3]);
        w.z = cvtpk(o[4] * r * w1[0] * gg[4], o[5] * r * w1[1] * gg[5]); w.w = cvtpk(o[6] * r * w1[2] * gg[6], o[7] * r * w1[3] * gg[7]);
        *(v4u*)(CC + off) = w;
    }
}

#ifndef EN_P0
#define EN_P0 1
#endif
#ifndef EN_NORM
#define EN_NORM 1
#endif
#ifndef EN_A1
#define EN_A1 1
#endif
#ifndef EN_A2
#define EN_A2 1
#endif
#ifndef EN_A3
#define EN_A3 1
#endif
#ifndef EN_ATT
#define EN_ATT 1
#endif
#ifndef EN_A5
#define EN_A5 1
#endif
#ifndef EN_C1
#define EN_C1 1
#endif
#ifndef EN_SCAN
#define EN_SCAN 1
#endif
#ifndef EN_RO
#define EN_RO 1
#endif
#ifndef EN_C4
#define EN_C4 1
#endif
#ifndef EN_SGU
#define EN_SGU 1
#endif
#ifndef EN_QUP
#define EN_QUP 1
#endif
#ifndef EN_KVUP
#define EN_KVUP 1
#endif
#ifndef PG8_ALIGNV
#define PG8_ALIGNV true
#endif
#ifndef PG8_SP2V
#define PG8_SP2V true
#endif
#ifndef PROBE_MASK
#define PROBE_MASK 0u
#endif
#define REPS(k) for (int rep_ = 0; rep_ < ((((PROBE_MASK) >> (k)) & 1u) ? 2 : 1); ++rep_)
#ifndef MK_ONE_LAUNCH
#define MK_ONE_LAUNCH 1
#endif
constexpr int N_PHASES = 28;
#define IN(k) (lo <= (k) && (k) < hi)
#define SEAM(k) do { if (IN(k) && IN((k) + 1)) xcd_barrier(bar); } while (0)
template <int p> __device__ __forceinline__ void layer_pair(LAS unsigned char* lds, const int G, const int lo, const int hi, const XcdBarrier& bar) {

        const int pb = 2 + 13 * p, lab = 2 * p, lc = 2 * p + 1;
        if (EN_A1 && IN(pb + 0)) REPS(pb + 0) {
            KArgs A = kargs(); unsigned char* const wsb = GWS(A);
            pg8::Gemm g{(const pg8::bf16_t*)(wsb + WS_H), (const pg8::bf16_t*)(wsb + WS_WIN_AB) + (size_t)p * N_AB * DM, MTOT, N_AB, DM, DM}; pg8::LockstepOrder S; S.init(MTOT, N_AB, G, (int)blockIdx.x);
            pg8::EpiAB1 E{(pg8::bf16_t*)(wsb + WS_G1), N_AB};
            pg8::gemm_phase<pg8::EpiAB1, pg8::LockstepOrder, PG8_ALIGNV, PG8_SP2V>(lds, g, S, E);
            if (p0_defer_on(G)) { pg8::LockstepOrder S2; S2.init(MTOT, N_AB, G, (int)blockIdx.x); p0_deferred(kargs(), lds, S2, p == 0 ? 0 : 2); }
        } SEAM(pb + 0);
        if (EN_A2 && IN(pb + 1)) REPS(pb + 1) { a2_rows(kargs(), p, G); } SEAM(pb + 1);
        if (EN_SGU && IN(pb + 2)) REPS(pb + 2) { sgu_phase(kargs(), p, lds, G); }
        if (EN_QUP && IN(pb + 3)) REPS(pb + 3) {
            KArgs A = kargs(); unsigned char* const wsb = GWS(A);
            pg8::Gemm g{(const pg8::bf16_t*)(wsb + WS_QN), (const pg8::bf16_t*)(wsb + WS_WQ) + (size_t)p * NQ * QL, MTOT, NQ, QL, QL}; pg8::LockstepOrder S; S.init(MTOT, NQ, G, (int)blockIdx.x);
            pg8::EpiQ E{(pg8::bf16_t*)(wsb + WS_Q), (const pg8::f32x2*)(wsb + WS_ROPE), MLAT, 0.07216878364870322f * 1.4426950408889634f};
            pg8::gemm_phase<pg8::EpiQ, pg8::LockstepOrder, PG8_ALIGNV, PG8_SP2V>(lds, g, S, E);
        }
        if (EN_KVUP && IN(pb + 4)) REPS(pb + 4) {
            KArgs A = kargs(); unsigned char* const wsb = GWS(A);
            pg8::Gemm g{(const pg8::bf16_t*)(wsb + WS_KVN), (const pg8::bf16_t*)(wsb + WS_WKV) + (size_t)p * NKV * KVL, MTOT, NKV, KVL, KVL}; pg8::LockstepOrder S; S.init(MTOT, NKV, G, (int)((blockIdx.x + 64u) % (unsigned)G));
            pg8::EpiKV E{(pg8::bf16_t*)(wsb + WS_KN), (pg8::bf16_t*)(wsb + WS_V), MTOT};
            pg8::gemm_phase<pg8::EpiKV, pg8::LockstepOrder, PG8_ALIGNV, PG8_SP2V>(lds, g, S, E);
        } SEAM(pb + 4);
        if (EN_ATT && IN(pb + 5)) REPS(pb + 5) { attn_phase(kargs(), lds, G); } SEAM(pb + 5);
        if (EN_A5 && IN(pb + 6)) REPS(pb + 6) {
            KArgs A = kargs(); unsigned char* const wsb = GWS(A);
            { pg8::Gemm g{(const pg8::bf16_t*)(wsb + WS_CC), (const pg8::bf16_t*)(wsb + WS_WO_AB) + (size_t)p * DM * MIXW, MLAT, DM, MIXW, MIXW}; pg8::LockstepOrder S; S.init(MLAT, DM, G, (int)blockIdx.x);
              pg8::EpiBf16P E{(pg8::bf16_t*)(wsb + WS_Y), DM};
              pg8::gemm_phase<pg8::EpiBf16P, pg8::LockstepOrder, PG8_ALIGNV, PG8_SP2V>(lds, g, S, E); }
            { pg8::Gemm g{(const pg8::bf16_t*)(wsb + WS_CC) + (size_t)MLAT * MIXW, (const pg8::bf16_t*)(wsb + WS_WO_AB) + (size_t)p * DM * MIXW, MTOT - MLAT, DM, MIXW / 8, MIXW}; pg8::SplitKOrder S; S.init(MTOT - MLAT, DM, 8, G, (int)blockIdx.x);
              pg8::EpiF32 E{(float*)(wsb + WS_YP), DM, (size_t)(MTOT - MLAT) * DM};
              pg8::gemm_phase<pg8::EpiF32, pg8::SplitKOrder, PG8_ALIGNV, PG8_SP2V>(lds, g, S, E); }
        } SEAM(pb + 6);
        if (EN_NORM && IN(pb + 7)) REPS(pb + 7) { norm_phase(kargs(), lab, lc, G); } SEAM(pb + 7);
        if (EN_C1 && IN(pb + 8)) REPS(pb + 8) {
            KArgs A = kargs(); unsigned char* const wsb = GWS(A);
            pg8::Gemm g{(const pg8::bf16_t*)(wsb + WS_H), (const pg8::bf16_t*)(wsb + WS_WIN_C) + (size_t)p * N_C * DM, MTOT, N_C, DM, DM}; pg8::LockstepOrder S; S.init(MTOT, N_C, G, (int)blockIdx.x);
            pg8::EpiC1 E{(pg8::bf16_t*)(wsb + WS_G1), (size_t)MTOT * MIXW, (const float*)(wsb + WS_OML) + (size_t)p * 2 * 8192};
            pg8::gemm_phase<pg8::EpiC1, pg8::LockstepOrder, PG8_ALIGNV, PG8_SP2V>(lds, g, S, E);
            if (p0_defer_on(G)) { pg8::LockstepOrder S2; S2.init(MTOT, N_C, G, (int)blockIdx.x); p0_deferred(kargs(), lds, S2, p == 0 ? 1 : 3); }
        } SEAM(pb + 8);
        if (EN_SCAN && IN(pb + 9)) REPS(pb + 9) { scan_phase(kargs(), lds, G); } SEAM(pb + 9);
        if (EN_RO && IN(pb + 10)) REPS(pb + 10) { readout_phase(kargs(), p, lc == 3 ? MLAT : MTOT, G); } SEAM(pb + 10);
        if (EN_C4 && IN(pb + 11)) REPS(pb + 11) {
            KArgs A = kargs(); unsigned char* const wsb = GWS(A);
            { pg8::Gemm g{(const pg8::bf16_t*)(wsb + WS_CC), (const pg8::bf16_t*)(wsb + WS_WO_C) + (size_t)p * DM * MIXW, MLAT, DM, MIXW, MIXW}; pg8::LockstepOrder S; S.init(MLAT, DM, G, (int)blockIdx.x);
              pg8::EpiBf16P E{(pg8::bf16_t*)(wsb + WS_Y), DM};
              pg8::gemm_phase<pg8::EpiBf16P, pg8::LockstepOrder, PG8_ALIGNV, PG8_SP2V>(lds, g, S, E); }
            if (lc != 3) { pg8::Gemm g{(const pg8::bf16_t*)(wsb + WS_CC) + (size_t)MLAT * MIXW, (const pg8::bf16_t*)(wsb + WS_WO_C) + (size_t)p * DM * MIXW, MTOT - MLAT, DM, MIXW / 8, MIXW}; pg8::SplitKOrder S; S.init(MTOT - MLAT, DM, 8, G, (int)blockIdx.x);
              pg8::EpiF32 E{(float*)(wsb + WS_YP), DM, (size_t)(MTOT - MLAT) * DM};
              pg8::gemm_phase<pg8::EpiF32, pg8::SplitKOrder, PG8_ALIGNV, PG8_SP2V>(lds, g, S, E); }
        } SEAM(pb + 11);
        if (EN_NORM && IN(pb + 12)) REPS(pb + 12) { norm_phase(kargs(), lc, lc + 1, G); } SEAM(pb + 12);
    }
#undef IN
#undef SEAM
__global__ void __launch_bounds__(NWAVES * 64, 2) fwd(Args a) {
    extern __shared__ __attribute__((aligned(16))) unsigned char lds_raw[];
    LAS unsigned char* lds = (LAS unsigned char*)lds_raw;
    int tid_l = threadIdx.x; asm volatile("" : "+v"(tid_l)); const int tid = tid_l, G = gridDim.x;
    for (int u = tid; u < (LDS_BYTES - LDSCTL_OFF) / 4; u += NWAVES * 64) ((LAS unsigned*)(lds + LDSCTL_OFF))[u] = 0u;
    __syncthreads();
    XcdBarrier bar; bar.bar = (unsigned*)(a.ws + WS_CTL) + CW_BAR; bar.x = 0; bar.st = nullptr;
    if (MK_ONE_LAUNCH) bar = xcd_barrier_post((unsigned*)(a.ws + WS_CTL) + CW_BAR, (volatile LAS unsigned*)(lds + MISC_OFF));
    const int lo = a.ph_lo, hi = a.ph_hi;
#define IN(k) (lo <= (k) && (k) < hi)
#define SEAM(k) do { if (IN(k) && IN((k) + 1)) xcd_barrier(bar); } while (0)
    if (EN_P0 && IN(0)) REPS(0) { p0_prologue(kargs(), lds, G); } SEAM(0);
    if (EN_NORM && IN(1)) REPS(1) { norm_phase(kargs(), -1, 0, G); } SEAM(1);
    layer_pair<0>(lds, G, lo, hi, bar);
    layer_pair<1>(lds, G, lo, hi, bar);
#undef IN
#undef SEAM
}

extern "C" void kernel_launch(void* const* d_in, const int* in_sizes, int n_in, void* d_out, int out_size, void* d_ws, size_t ws_size, hipStream_t stream) {
    static int grid = 0;
    if (grid == 0) {
        if (n_in != 22 || out_size != MLAT * DM || ws_size < WS_END) { fprintf(stderr, "kernel_launch: unexpected shapes (n_in %d, out %d, ws %zu, need %zu)\n", n_in, out_size, ws_size, (size_t)WS_END); grid = -1; return; }
        int dev = 0, cus = 0, per_cu = 0;
        if (hipGetDevice(&dev) != hipSuccess || hipDeviceGetAttribute(&cus, hipDeviceAttributeMultiprocessorCount, dev) != hipSuccess) { grid = -1; return; }
        if (hipFuncSetAttribute((const void*)fwd, hipFuncAttributeMaxDynamicSharedMemorySize, LDS_BYTES) != hipSuccess) { fprintf(stderr, "kernel_launch: hipFuncSetAttribute failed\n"); grid = -1; return; }
        if (hipOccupancyMaxActiveBlocksPerMultiprocessor(&per_cu, (const void*)fwd, NWAVES * 64, LDS_BYTES) != hipSuccess || per_cu < 1) fprintf(stderr, "kernel_launch: occupancy query reports %d\n", per_cu);
        (void)hipGetLastError();
        grid = cus;
    }
    if (grid < 0) return;
    (void)hipMemsetAsync((char*)d_ws + WS_CTL, 0, 65536, stream);
    Args a{};
    for (int i = 0; i < 22; ++i) a.in[i] = (const float*)d_in[i];
    a.out = (float*)d_out; a.ws = (unsigned char*)d_ws;
#if MK_ONE_LAUNCH
    a.ph_lo = 0; a.ph_hi = N_PHASES;
    hipLaunchKernelGGL(fwd, dim3(grid), dim3(NWAVES * 64), LDS_BYTES, stream, a);
#else
    for (int p = 0; p < N_PHASES; ++p) { a.ph_lo = p; a.ph_hi = p + 1; hipLaunchKernelGGL(fwd, dim3(grid), dim3(NWAVES * 64), LDS_BYTES, stream, a); }
#endif
}
```

```cpp
#include <hip/hip_runtime.h>
#include <cstdio>
#include <cstdint>
namespace pg8 {
#define PG8_LAS __attribute__((address_space(3)))
typedef unsigned short bf16_t;
typedef short bf16x8 __attribute__((ext_vector_type(8)));
typedef float f32x4 __attribute__((ext_vector_type(4)));
typedef unsigned u32x4 __attribute__((ext_vector_type(4)));
constexpr int BM = 256, BK = 64, HALF = 128, HTB = HALF * BK * 2  , STAGE_BYTES = 8 * HTB, NXCD = 8, WGM = 4;

__host__ __device__ __forceinline__ int lds_byte(int r, int c) { const int st = (r >> 4) * 2 + (c >> 5), rr = r & 15, cc = c & 31, ob = rr * 64 + cc * 2; return st * 1024 + (ob ^ (((ob >> 9) & 1) << 5)); }
__host__ __device__ __forceinline__ void stage_rc(int b, int& R, int& C) { const int st = b / 1024, sb = b % 1024, swz = sb ^ (((sb >> 9) & 1) << 5); R = (st >> 1) * 16 + swz / 64; C = (st & 1) * 32 + (swz % 64) / 2; }
__host__ __device__ __forceinline__ int perm32(int rho) { const int n = rho >> 4, i = rho & 15; return 8 * (i >> 2) + 4 * n + (i & 3); }

struct Unit { int pm, pn, kc; };
struct Gemm { const bf16_t* A; const bf16_t* Bt; int M, N, K, ld; };

struct StaticOrder {
    int nM, nN, nwg, G, c;
    __host__ __device__ void init(int M, int N, int G_, int c_) { nM = M / BM; nN = N / BM; nwg = nM * nN; G = G_; c = c_; }
    __host__ __device__ bool next(int i, Unit& u) const {
        const long L = (long)i * G + c; if (L >= nwg) return false;
        int wgid = (int)L; { const int q = nwg / NXCD, r = nwg % NXCD, xcd = wgid % NXCD, off = wgid / NXCD; wgid = (xcd < r ? xcd * (q + 1) : r * (q + 1) + (xcd - r) * q) + off; }
        const int nig = WGM * nN, gid = wgid / nig, fm = gid * WGM, gsz = (nM - fm) < WGM ? (nM - fm) : WGM;
        u.pm = fm + ((wgid % nig) % gsz); u.pn = (wgid % nig) / gsz; u.kc = 0; return true;
    }
    __device__ __forceinline__ void a_ready(const Unit&) const {}
    __device__ __forceinline__ void done(const Unit&) const {}
};
struct LockstepOrder {
    static constexpr int LW = 4;
    int nM, nN, G, c, x, k, nk, PG, r0, gR, qR, rR, lenx;
    __host__ __device__ void init(int M, int N, int G_, int c_) { nM = M / BM; nN = N / BM; G = G_; c = c_; x = c_ % NXCD; k = c_ / NXCD; nk = G_ / NXCD; PG = (nM / LW) / NXCD; r0 = PG * NXCD * LW; gR = nM - r0;
        const int rem = gR * nN; qR = rem / NXCD; rR = rem % NXCD; lenx = PG * LW * nN + qR + (x < rR ? 1 : 0); }
    __host__ __device__ bool next(int i, Unit& u) const {
        if (G % NXCD != 0) { const long L = (long)i * G + c; if (L >= (long)nM * nN) return false; u.kc = 0; u.pm = (int)(L / nN); u.pn = (int)(L % nN); return true; }
        const int off = i * nk + k; if (off >= lenx) return false; u.kc = 0;
        const int lock = PG * LW * nN;
        if (off < lock) { const int j = off / (LW * nN), o2 = off % (LW * nN); u.pm = (j * NXCD + x) * LW + o2 % LW; u.pn = o2 / LW; }
        else { const int rho = (x < rR ? x * (qR + 1) : rR * (qR + 1) + (x - rR) * qR) + (off - lock); u.pm = r0 + rho % gR; u.pn = rho / gR; }
        return true;
    }
    __device__ __forceinline__ void a_ready(const Unit&) const {}
    __device__ __forceinline__ void done(const Unit&) const {}
};
struct SplitKOrder {
    int nM, nN, KS, nwg, G, c;
    __host__ __device__ void init(int M, int N, int KS_, int G_, int c_) { nM = M / BM; nN = N / BM; KS = KS_; nwg = nM * nN * KS; G = G_; c = c_; }
    __host__ __device__ bool next(int i, Unit& u) const { const long L = (long)i * G + c; if (L >= nwg) return false; const int l = (int)L; u.kc = l % KS; u.pn = (l / KS) % nN; u.pm = l / (KS * nN); return true; }
    __device__ __forceinline__ void a_ready(const Unit&) const {}
    __device__ __forceinline__ void done(const Unit&) const {}
};

typedef float f32x2 __attribute__((ext_vector_type(2)));
typedef __bf16 bf16x2_c __attribute__((ext_vector_type(2)));
__device__ __forceinline__ unsigned cvt_pk_bf16(float lo, float hi) { const f32x2 v = {lo, hi}; const bf16x2_c b = __builtin_convertvector(v, bf16x2_c); return __builtin_bit_cast(unsigned, b); }
__device__ __forceinline__ f32x2 gelu_pk(f32x2 v) {
    const f32x2 av = __builtin_elementwise_abs(v), d = av * 0.2316418882f + 1.0f;
    f32x2 t; t.x = __builtin_amdgcn_rcpf(d.x); t.y = __builtin_amdgcn_rcpf(d.y);
    f32x2 q = t * 0.5307027145f + (-0.7265760135f); q = q * t + 0.7107068705f; q = q * t + (-0.142248368f); q = q * t + 0.127414796f; q = q * t;
    const f32x2 s = (v * v) * (-0.72134752044f);
    f32x2 e; e.x = __builtin_amdgcn_exp2f(s.x); e.y = __builtin_amdgcn_exp2f(s.y);
    const f32x2 m = v * (q * e), r = v - m;
    f32x2 o; o.x = v.x < 0.f ? m.x : r.x; o.y = v.y < 0.f ? m.y : r.y; return o;
}

typedef unsigned u32x2 __attribute__((ext_vector_type(2)));
__device__ __forceinline__ float silu_f(float x) { return x * __builtin_amdgcn_rcpf(1.0f + __builtin_amdgcn_exp2f(-1.4426950408889634f * x)); }
__device__ __forceinline__ float sigmoid_neg_f(float x) { return __builtin_amdgcn_rcpf(1.0f + __builtin_amdgcn_exp2f(1.4426950408889634f * x)); }
__device__ __forceinline__ f32x2 sig_pk(f32x2 x, float k) { const f32x2 t = x * k; f32x2 e; e.x = __builtin_amdgcn_exp2f(t.x); e.y = __builtin_amdgcn_exp2f(t.y); const f32x2 d = e + 1.0f;
    f32x2 r; r.x = __builtin_amdgcn_rcpf(d.x); r.y = __builtin_amdgcn_rcpf(d.y); return r; }
__device__ __forceinline__ f32x4 act4(f32x4 v, int act) {
    if (act == 1) { const f32x2 a = (f32x2){v[0], v[1]}, b = (f32x2){v[2], v[3]}; const f32x2 ra = a * sig_pk(a, -1.4426950408889634f), rb = b * sig_pk(b, -1.4426950408889634f); v = (f32x4){ra.x, ra.y, rb.x, rb.y}; }
    else if (act == 2) { const f32x2 a = gelu_pk((f32x2){v[0], v[1]}), b = gelu_pk((f32x2){v[2], v[3]}); v = (f32x4){a.x, a.y, b.x, b.y}; }
    return v;
}
struct EpiF32 {
    static constexpr bool PERM = false, AFTER_DRAIN = false;
    float* C0; int ldc; size_t kstride;
    __device__ __forceinline__ void operator()(const f32x4 (&acc)[2][2][4][2], const Unit& u, int wr, int wc, int fr, int fq) const {
        float* C = C0 + (size_t)u.kc * kstride;
        const int row0 = u.pm * BM + wr * 64 + fr, col0 = u.pn * BM + wc * 32 + 4 * fq;
#pragma unroll
        for (int ai = 0; ai < 2; ++ai)
#pragma unroll
            for (int m = 0; m < 4; ++m) { float* rowp = C + (size_t)(row0 + ai * HALF + m * 16) * ldc + col0;
#pragma unroll
                for (int bj = 0; bj < 2; ++bj)
#pragma unroll
                    for (int n = 0; n < 2; ++n) *(f32x4*)(rowp + bj * HALF + n * 16) = acc[ai][bj][m][n]; }
    }
};
struct EpiBf16P {
    static constexpr bool PERM = true, AFTER_DRAIN = false;
    bf16_t* O; int ldc;
    __device__ __forceinline__ void operator()(const f32x4 (&acc)[2][2][4][2], const Unit& u, int wr, int wc, int fr, int fq) const {
        const int row0 = u.pm * BM + wr * 64 + fr, col0 = u.pn * BM + wc * 32 + 8 * fq;
#pragma unroll
        for (int ai = 0; ai < 2; ++ai)
#pragma unroll
            for (int m = 0; m < 4; ++m) { bf16_t* rowp = O + (size_t)(row0 + ai * HALF + m * 16) * ldc + col0;
#pragma unroll
                for (int bj = 0; bj < 2; ++bj) { const f32x4 v0 = acc[ai][bj][m][0], v1 = acc[ai][bj][m][1];
                    u32x4 w; w.x = cvt_pk_bf16(v0[0], v0[1]); w.y = cvt_pk_bf16(v0[2], v0[3]); w.z = cvt_pk_bf16(v1[0], v1[1]); w.w = cvt_pk_bf16(v1[2], v1[3]);
                    *(u32x4*)(rowp + bj * HALF) = w; } }
    }
};
struct EpiAB1 {
    static constexpr bool PERM = true, AFTER_DRAIN = false;
    bf16_t* O; int ldc;
    __device__ __forceinline__ void operator()(const f32x4 (&acc)[2][2][4][2], const Unit& u, int wr, int wc, int fr, int fq) const {
        const int act = u.pn < 7 ? 0 : ((u.pn < 23 || u.pn >= 55) ? 1 : 2);
        const int row0 = u.pm * BM + wr * 64 + fr, col0 = u.pn * BM + wc * 32 + 8 * fq;
#pragma unroll
        for (int ai = 0; ai < 2; ++ai)
#pragma unroll
            for (int m = 0; m < 4; ++m) { bf16_t* rowp = O + (size_t)(row0 + ai * HALF + m * 16) * ldc + col0;
#pragma unroll
                for (int bj = 0; bj < 2; ++bj) { const f32x4 v0 = act4(acc[ai][bj][m][0], act), v1 = act4(acc[ai][bj][m][1], act);
                    u32x4 w; w.x = cvt_pk_bf16(v0[0], v0[1]); w.y = cvt_pk_bf16(v0[2], v0[3]); w.z = cvt_pk_bf16(v1[0], v1[1]); w.w = cvt_pk_bf16(v1[2], v1[3]);
                    *(u32x4*)(rowp + bj * HALF) = w; } }
    }
};
struct EpiC1 {
    static constexpr bool PERM = true, AFTER_DRAIN = false;
    bf16_t* O; size_t stride; const float* oml;
    __device__ __forceinline__ void operator()(const f32x4 (&acc)[2][2][4][2], const Unit& u, int wr, int wc, int fr, int fq) const {
        const int region = u.pn >> 5; bf16_t* base = O + (size_t)region * stride;
        const int row0 = u.pm * BM + wr * 64 + fr, col0 = (u.pn & 31) * BM + wc * 32 + 8 * fq;
        const bool gate = (region == 1 || region == 2); const int act = (region == 0 || region == 4) ? 1 : 0;
        f32x4 gv[2][2];
#pragma unroll
        for (int bj = 0; bj < 2; ++bj)
#pragma unroll
            for (int n = 0; n < 2; ++n) gv[bj][n] = gate ? *(const f32x4*)(oml + (size_t)(region - 1) * 8192 + col0 + bj * HALF + 4 * n) : (f32x4){1.f, 1.f, 1.f, 1.f};
#pragma unroll
        for (int ai = 0; ai < 2; ++ai)
#pragma unroll
            for (int m = 0; m < 4; ++m) { bf16_t* rowp = base + (size_t)(row0 + ai * HALF + m * 16) * 8192 + col0;
#pragma unroll
                for (int bj = 0; bj < 2; ++bj) { f32x4 v0 = acc[ai][bj][m][0], v1 = acc[ai][bj][m][1];
                    if (gate) {
                        const f32x2 a0 = sig_pk((f32x2){v0[0], v0[1]}, 1.4426950408889634f), a1 = sig_pk((f32x2){v0[2], v0[3]}, 1.4426950408889634f), b0 = sig_pk((f32x2){v1[0], v1[1]}, 1.4426950408889634f), b1 = sig_pk((f32x2){v1[2], v1[3]}, 1.4426950408889634f);
                        v0 = gv[bj][0] * (f32x4){a0.x, a0.y, a1.x, a1.y}; v1 = gv[bj][1] * (f32x4){b0.x, b0.y, b1.x, b1.y}; }
                    else { v0 = act4(v0, act); v1 = act4(v1, act); }
                    u32x4 w; w.x = cvt_pk_bf16(v0[0], v0[1]); w.y = cvt_pk_bf16(v0[2], v0[3]); w.z = cvt_pk_bf16(v1[0], v1[1]); w.w = cvt_pk_bf16(v1[2], v1[3]);
                    *(u32x4*)(rowp + bj * HALF) = w; } }
    }
};
struct EpiQ {
    static constexpr bool PERM = true, AFTER_DRAIN = false;
    bf16_t* O; const f32x2* rope; int nlat; float qscale;
    __device__ __forceinline__ void operator()(const f32x4 (&acc)[2][2][4][2], const Unit& u, int wr, int wc, int fr, int fq) const {
        const int row0 = u.pm * BM + wr * 64 + fr; const bool upper = fq >= 2;
#pragma unroll
        for (int bj = 0; bj < 2; ++bj) {
            const int G = 8 * u.pn + 4 * bj + wc, hm = G % 6, col = u.pn * BM + bj * HALF + wc * 32 + 8 * fq;
#pragma unroll
            for (int ai = 0; ai < 2; ++ai)
#pragma unroll
                for (int m = 0; m < 4; ++m) { const int row = row0 + ai * HALF + m * 16; f32x4 x0 = acc[ai][bj][m][0], x1 = acc[ai][bj][m][1];
                    if (hm >= 4 && u.pm * BM < nlat) {
                        const int t = row & 8191, pos = (hm == 4) ? (t >> 6) : (t & 63); const f32x2* cs = rope + pos * 16 + 8 * (fq & 1);
#pragma unroll
                        for (int j = 0; j < 4; ++j) {
                            { auto rr = __builtin_amdgcn_permlane32_swap(__float_as_uint(x0[j]), __float_as_uint(x0[j]), false, false); const float pv = __uint_as_float(upper ? rr[0] : rr[1]); const f32x2 c = cs[j];
                              x0[j] = upper ? x0[j] * c.x + pv * c.y : x0[j] * c.x - pv * c.y; }
                            { auto rr = __builtin_amdgcn_permlane32_swap(__float_as_uint(x1[j]), __float_as_uint(x1[j]), false, false); const float pv = __uint_as_float(upper ? rr[0] : rr[1]); const f32x2 c = cs[4 + j];
                              x1[j] = upper ? x1[j] * c.x + pv * c.y : x1[j] * c.x - pv * c.y; } } }
                    x0 = x0 * qscale; x1 = x1 * qscale;
                    u32x4 w; w.x = cvt_pk_bf16(x0[0], x0[1]); w.y = cvt_pk_bf16(x0[2], x0[3]); w.z = cvt_pk_bf16(x1[0], x1[1]); w.w = cvt_pk_bf16(x1[2], x1[3]);
                    *(u32x4*)(O + (size_t)row * 6144 + col) = w; }
        }
    }
};
struct EpiKV {
    static constexpr bool PERM = true, AFTER_DRAIN = false;
    bf16_t* KN; bf16_t* V; int mtot;
    __device__ __forceinline__ void operator()(const f32x4 (&acc)[2][2][4][2], const Unit& u, int wr, int wc, int fr, int fq) const {
        const int row0 = u.pm * BM + wr * 64 + fr, colh = wc * 32 + 8 * fq;
#pragma unroll
        for (int ai = 0; ai < 2; ++ai)
#pragma unroll
            for (int m = 0; m < 4; ++m) { const size_t off = ((size_t)u.pn * mtot + (size_t)(row0 + ai * HALF + m * 16)) * 128 + colh;
#pragma unroll
                for (int bj = 0; bj < 2; ++bj) { const f32x4 v0 = acc[ai][bj][m][0], v1 = acc[ai][bj][m][1];
                    u32x4 w; w.x = cvt_pk_bf16(v0[0], v0[1]); w.y = cvt_pk_bf16(v0[2], v0[3]); w.z = cvt_pk_bf16(v1[0], v1[1]); w.w = cvt_pk_bf16(v1[2], v1[3]);
                    *(u32x4*)((bj ? V : KN) + off) = w; } }
    }
};

template <class Epi, class Sched, bool ALIGN_EPI = false, bool SP2 = false>
__device__ __forceinline__ void gemm_phase(PG8_LAS unsigned char* lds, const Gemm g, const Sched& S, const Epi& E) {
    int tid_l = threadIdx.x; asm volatile("" : "+v"(tid_l)); const int tid = tid_l, wid = __builtin_amdgcn_readfirstlane(tid >> 6), lane = tid & 63, wr = wid >> 2, wc = wid & 3, fr = lane & 15, fq = lane >> 4;
    const int K = g.ld, nt = g.K / BK;
    unsigned voffA[2], voffB[2];
#pragma unroll
    for (int i = 0; i < 2; ++i) { int R, C; stage_rc(tid * 16 + i * 8192, R, C); const int Rb = Epi::PERM ? ((R & ~31) + perm32(R & 31)) : R;
        voffA[i] = (unsigned)(R * K + C) * 2u; voffB[i] = (unsigned)(Rb * K + C) * 2u; }
    const size_t kstep = (size_t)(BK * 2);
    const size_t hstep = (size_t)HALF * K * 2;
    const size_t tstep = 2 * hstep;
    const unsigned ldsw = (unsigned)wid * 1024u;
    const int aoff = lds_byte(wr * 64 + fr, fq * 8), boff = lds_byte(wc * 32 + fr, fq * 8);
#define PG8_SA(b, h) (((b) * 2 + (h)) * HTB)
#define PG8_SB(b, h) ((4 + (b) * 2 + (h)) * HTB)
#define PG8_STAGE(bufoff, gbase, voff) do { const char* gb_ = (const char*)(gbase); asm volatile("" : "+s"(gb_)); _Pragma("unroll") for (int _i = 0; _i < 2; ++_i) { unsigned vo_ = (voff)[_i]; asm volatile("" : "+v"(vo_)); \
        __builtin_amdgcn_global_load_lds((const unsigned*)(gb_ + vo_), (PG8_LAS unsigned*)(lds + (bufoff) + ldsw + _i * 8192), 16, 0, 0); } } while (0)
#define PG8_LDA(dst, b, h) do { _Pragma("unroll") for (int m = 0; m < 4; ++m) _Pragma("unroll") for (int k = 0; k < 2; ++k) dst[m][k] = *(const PG8_LAS bf16x8*)(lds + PG8_SA(b, h) + aoff + m * 2048 + k * 1024); } while (0)
#define PG8_LDB(dst, b, h) do { _Pragma("unroll") for (int n = 0; n < 2; ++n) _Pragma("unroll") for (int k = 0; k < 2; ++k) dst[n][k] = *(const PG8_LAS bf16x8*)(lds + PG8_SB(b, h) + boff + n * 2048 + k * 1024); } while (0)
#define PG8_MMA(ai, bj, At, Bt) do { __builtin_amdgcn_sched_barrier(0); _Pragma("unroll") for (int m = 0; m < 4; ++m) _Pragma("unroll") for (int n = 0; n < 2; ++n) _Pragma("unroll") for (int k = 0; k < 2; ++k) \
        acc[ai][bj][m][n] = __builtin_amdgcn_mfma_f32_16x16x32_bf16(Bt[n][k], At[m][k], acc[ai][bj][m][n], 0, 0, 0); __builtin_amdgcn_sched_barrier(0); } while (0)
#define PG8_WAIT_V(n) asm volatile("s_waitcnt vmcnt(" #n ")" ::: "memory")
#define PG8_WAIT_L(n) asm volatile("s_waitcnt lgkmcnt(" #n ")" ::: "memory")
#define PG8_BAR __builtin_amdgcn_s_barrier()
#define PG8_SCHED __builtin_amdgcn_sched_barrier(0)
    if (wr == 0) __builtin_amdgcn_s_setprio(1);
    Unit cur, nxt; int ui = 0;
    if (!S.next(0, cur)) { __builtin_amdgcn_s_setprio(0); return; }
    f32x4 acc[2][2][4][2];
#pragma unroll
    for (int a = 0; a < 2; ++a)
#pragma unroll
        for (int b = 0; b < 2; ++b)
#pragma unroll
            for (int m = 0; m < 4; ++m)
#pragma unroll
                for (int n = 0; n < 2; ++n) acc[a][b][m][n] = (f32x4){0.f, 0.f, 0.f, 0.f};
    bf16x8 At[4][2], B0[2][2], B1[2][2];
    const size_t kcb = (size_t)g.K * 2;
    const char* cA = (const char*)g.A + (size_t)cur.pm * tstep + cur.kc * kcb; const char* cB = (const char*)g.Bt + (size_t)cur.pn * tstep + cur.kc * kcb;
    S.a_ready(cur);
    if constexpr (SP2) {
        PG8_STAGE(PG8_SB(0, 0), cB, voffB); PG8_STAGE(PG8_SB(0, 1), cB + hstep, voffB); PG8_STAGE(PG8_SA(0, 0), cA, voffA); PG8_STAGE(PG8_SA(0, 1), cA + hstep, voffA);
        if (wr == 1) PG8_BAR;
        PG8_WAIT_V(2); PG8_BAR;
        PG8_STAGE(PG8_SB(1, 0), cB + kstep, voffB); PG8_STAGE(PG8_SA(1, 0), cA + kstep, voffA); PG8_STAGE(PG8_SB(1, 1), cB + hstep + kstep, voffB);
        PG8_WAIT_V(6); PG8_BAR;
    } else {
        PG8_STAGE(PG8_SB(0, 0), cB, voffB); PG8_STAGE(PG8_SA(0, 0), cA, voffA); PG8_STAGE(PG8_SB(0, 1), cB + hstep, voffB); PG8_STAGE(PG8_SA(0, 1), cA + hstep, voffA);
        if (wr == 1) PG8_BAR;
        PG8_WAIT_V(4); PG8_BAR;
        PG8_STAGE(PG8_SB(1, 0), cB + kstep, voffB); PG8_STAGE(PG8_SA(1, 0), cA + kstep, voffA); PG8_STAGE(PG8_SB(1, 1), cB + hstep + kstep, voffB);
        PG8_WAIT_V(6); PG8_BAR;
    }
    for (;;) {
        const bool has_next = S.next(ui + 1, nxt);
        const char* nA = has_next ? (const char*)g.A + (size_t)nxt.pm * tstep + nxt.kc * kcb : cA; const char* nB = has_next ? (const char*)g.Bt + (size_t)nxt.pn * tstep + nxt.kc * kcb : cB;
        for (int t = 0; t < nt; t += 2) {
            const bool last = (t == nt - 2);
            const char* a1 = cA + (size_t)(t + 1) * kstep;
            const char* a2 = last ? nA : cA + (size_t)(t + 2) * kstep; const char* b2 = last ? nB : cB + (size_t)(t + 2) * kstep;
            const char* a3 = a2 + kstep; const char* b3 = b2 + kstep;
            if (last && has_next) S.a_ready(nxt);
            if constexpr (SP2) {
            PG8_LDB(B0, 0, 0); PG8_LDB(B1, 0, 1); PG8_SCHED; PG8_LDA(At, 0, 0); PG8_STAGE(PG8_SA(1, 1), a1 + hstep, voffA);
            PG8_WAIT_V(8); PG8_WAIT_L(0); PG8_BAR; PG8_MMA(0, 0, At, B0); PG8_MMA(0, 1, At, B1); PG8_BAR; PG8_SCHED;
            PG8_LDA(At, 0, 1); PG8_STAGE(PG8_SB(0, 0), b2, voffB); PG8_STAGE(PG8_SB(0, 1), b2 + hstep, voffB); PG8_STAGE(PG8_SA(0, 0), a2, voffA);
            PG8_WAIT_V(8); PG8_WAIT_L(0); PG8_BAR; PG8_MMA(1, 0, At, B0); PG8_MMA(1, 1, At, B1); PG8_BAR; PG8_SCHED;
            PG8_LDB(B0, 1, 0); PG8_LDB(B1, 1, 1); PG8_SCHED; PG8_LDA(At, 1, 0); PG8_STAGE(PG8_SA(0, 1), a2 + hstep, voffA);
            PG8_WAIT_V(8); PG8_WAIT_L(0); PG8_BAR; PG8_MMA(0, 0, At, B0); PG8_MMA(0, 1, At, B1); PG8_BAR; PG8_SCHED;
            PG8_LDA(At, 1, 1); PG8_STAGE(PG8_SB(1, 0), b3, voffB); PG8_STAGE(PG8_SB(1, 1), b3 + hstep, voffB); PG8_STAGE(PG8_SA(1, 0), a3, voffA);
            PG8_WAIT_V(8); PG8_WAIT_L(0); PG8_BAR; PG8_MMA(1, 0, At, B0); PG8_MMA(1, 1, At, B1); PG8_BAR; PG8_SCHED;
            } else {
            PG8_LDB(B0, 0, 0); PG8_SCHED; PG8_LDA(At, 0, 0); PG8_STAGE(PG8_SA(1, 1), a1 + hstep, voffA);
            PG8_WAIT_L(8); PG8_BAR; PG8_WAIT_L(0); PG8_MMA(0, 0, At, B0); PG8_BAR; PG8_SCHED;
            PG8_LDB(B1, 0, 1); PG8_STAGE(PG8_SB(0, 0), b2, voffB);
            PG8_BAR; PG8_WAIT_L(0); PG8_MMA(0, 1, At, B1); PG8_BAR;
            PG8_LDA(At, 0, 1); PG8_STAGE(PG8_SA(0, 0), a2, voffA);
            PG8_BAR; PG8_WAIT_L(0); PG8_MMA(1, 0, At, B0); PG8_BAR; PG8_SCHED;
            PG8_STAGE(PG8_SB(0, 1), b2 + hstep, voffB);
            PG8_WAIT_V(6); PG8_BAR; PG8_MMA(1, 1, At, B1); PG8_BAR;
            PG8_LDB(B0, 1, 0); PG8_SCHED; PG8_LDA(At, 1, 0); PG8_STAGE(PG8_SA(0, 1), a2 + hstep, voffA);
            PG8_WAIT_L(8); PG8_BAR; PG8_WAIT_L(0); PG8_MMA(0, 0, At, B0); PG8_BAR; PG8_SCHED;
            PG8_LDB(B1, 1, 1); PG8_STAGE(PG8_SB(1, 0), b3, voffB);
            PG8_BAR; PG8_WAIT_L(0); PG8_MMA(0, 1, At, B1); PG8_BAR;
            PG8_LDA(At, 1, 1); PG8_STAGE(PG8_SA(1, 0), a3, voffA);
            PG8_BAR; PG8_WAIT_L(0); PG8_MMA(1, 0, At, B0); PG8_BAR; PG8_SCHED;
            PG8_STAGE(PG8_SB(1, 1), b3 + hstep, voffB);
            PG8_WAIT_V(6); PG8_BAR; PG8_MMA(1, 1, At, B1); PG8_BAR;
            }
        }
        if constexpr (ALIGN_EPI) { if (wr == 0) PG8_BAR; }
        if constexpr (!Epi::AFTER_DRAIN) { E(acc, cur, wr, wc, fr, fq); S.done(cur); }
        if (!has_next) break;
#pragma unroll
        for (int a = 0; a < 2; ++a)
#pragma unroll
            for (int b = 0; b < 2; ++b)
#pragma unroll
                for (int m = 0; m < 4; ++m)
#pragma unroll
                    for (int n = 0; n < 2; ++n) acc[a][b][m][n] = (f32x4){0.f, 0.f, 0.f, 0.f};
        cur = nxt; cA = nA; cB = nB; ++ui;
        if constexpr (ALIGN_EPI) { if (wr == 1) PG8_BAR; }
    }
    PG8_WAIT_V(0);
    if constexpr (!ALIGN_EPI) { if (wr == 0) PG8_BAR; }
    PG8_BAR;
    if constexpr (Epi::AFTER_DRAIN) { E.fused(acc, cur, wr, wc, fr, fq, lds, wid, lane); S.done(cur); }
    __builtin_amdgcn_s_setprio(0);
#undef PG8_SA
#undef PG8_SB
#undef PG8_STAGE
#undef PG8_LDA
#undef PG8_LDB
#undef PG8_MMA
#undef PG8_WAIT_V
#undef PG8_WAIT_L
#undef PG8_BAR
#undef PG8_SCHED
}
}
#define GAS __attribute__((address_space(1)))
#define LAS __attribute__((address_space(3)))
typedef unsigned short bf16;
typedef unsigned v4u __attribute__((ext_vector_type(4)));
typedef float f32x4 __attribute__((ext_vector_type(4)));
typedef short bf16x8 __attribute__((ext_vector_type(8)));
typedef GAS unsigned gu32;
typedef GAS unsigned long long gu64;
#define RLX_AGENT __ATOMIC_RELAXED, __HIP_MEMORY_SCOPE_AGENT
#define LDS_WAIT() asm volatile("s_waitcnt lgkmcnt(0)" ::: "memory")
#define VM_WAIT() asm volatile("s_waitcnt vmcnt(0)" ::: "memory")
__device__ __forceinline__ unsigned long long rt() { return __builtin_amdgcn_s_memrealtime(); }
__device__ __forceinline__ unsigned f2bf(float f) { unsigned u = __builtin_bit_cast(unsigned, f); return (u + 0x7fffu + ((u >> 16) & 1u)) >> 16; }
__device__ __forceinline__ unsigned pk2(float lo, float hi) { return f2bf(lo) | (f2bf(hi) << 16); }

typedef unsigned u32x2 __attribute__((ext_vector_type(2)));
typedef float f32x2 __attribute__((ext_vector_type(2)));
#define XB_TMO      128
#define XB_XCNT(j)  (256  + 64 * (j))
#define XB_XSUB(j)  (1280 + 64 * (j))
#define XB_XGEN(j)  (2304 + 64 * (j))
#define XB_TOP      3328
#define XB_TOPGEN   3392
#define XCD_BAR_WORDS 3456
#define XB_SPIN_CAP (1u << 21)

__device__ __forceinline__ unsigned xb_ld(unsigned* p)              { return __hip_atomic_load(p, __ATOMIC_RELAXED, __HIP_MEMORY_SCOPE_AGENT); }
__device__ __forceinline__ unsigned xb_add(unsigned* p, unsigned v) { return __hip_atomic_fetch_add(p, v, __ATOMIC_RELAXED, __HIP_MEMORY_SCOPE_AGENT); }
__device__ __forceinline__ unsigned xb_xcc_id() { return (unsigned)__builtin_amdgcn_s_getreg((3 << 11) | 20) & 0xFu; }
#define XB_SPIN(cond, bar) do { unsigned _sp = 0; while (cond) { __builtin_amdgcn_s_sleep(1); \
    if ((++_sp & 255u) == 0u) { if (xb_ld(&(bar)[XB_TMO])) break; if (_sp > XB_SPIN_CAP) { atomicAdd(&(bar)[XB_TMO], 1u); break; } } } } while (0)

struct XcdBarrier {
    unsigned* bar; unsigned x;
    volatile LAS unsigned* st;
};

__device__ __forceinline__ XcdBarrier xcd_barrier_post(unsigned* bar, volatile LAS unsigned* st) {
    XcdBarrier b; b.bar = bar; b.x = xb_xcc_id(); b.st = st;
    if (threadIdx.x == 0) (void)xb_add(&bar[XB_XCNT(b.x)], 1u);
    return b;
}
__device__ __forceinline__ void xcd_barrier_complete(unsigned* bar, unsigned x, unsigned& nloc, unsigned& nx) {
    const unsigned G = gridDim.x * gridDim.y * gridDim.z;
    unsigned sum, cnt, mine, sp = 0u;
    for (;;) {
        sum = 0u; cnt = 0u; mine = 0u;
#pragma unroll
        for (unsigned j = 0; j < 16; ++j) { const unsigned c = xb_ld(&bar[XB_XCNT(j)]); sum += c; cnt += (c > 0u) ? 1u : 0u; mine = (j == x) ? c : mine; }
        if (sum == G) break;
        __builtin_amdgcn_s_sleep(1);
        if ((++sp & 255u) == 0u) { if (xb_ld(&bar[XB_TMO])) break; if (sp > XB_SPIN_CAP) { atomicAdd(&bar[XB_TMO], 1u); break; } }
    }
    nloc = mine > 0u ? mine : 1u; nx = cnt > 0u ? cnt : 1u;
}

__device__ __forceinline__ void xcd_barrier(const XcdBarrier& b) {
    asm volatile("s_waitcnt vmcnt(0)" ::: "memory");
    __syncthreads();
    if (threadIdx.x == 0) {
        unsigned* bar = b.bar;
        __builtin_amdgcn_s_waitcnt(0);
        unsigned nloc = b.st[0], nx = b.st[1];
        if (nloc == 0u) { xcd_barrier_complete(bar, b.x, nloc, nx); b.st[0] = nloc; b.st[1] = nx; }
        const unsigned old = xb_add(&bar[XB_XSUB(b.x)], 1u);
        const unsigned gen = old / nloc;
        if (old + 1u == (gen + 1u) * nloc) {
            __builtin_amdgcn_fence(__ATOMIC_RELEASE, "agent");
            asm volatile("s_waitcnt vmcnt(0)" ::: "memory");
            const unsigned og = xb_add(&bar[XB_TOP], 1u);
            const unsigned tg = og / nx;
            if (og + 1u == (tg + 1u) * nx) xb_add(&bar[XB_TOPGEN], 1u);
            else XB_SPIN(xb_ld(&bar[XB_TOPGEN]) == tg, bar);
            __builtin_amdgcn_fence(__ATOMIC_ACQUIRE, "agent");
            xb_add(&bar[XB_XGEN(b.x)], 1u);
            asm volatile("s_waitcnt vmcnt(0)" ::: "memory");
        } else {
            XB_SPIN(xb_ld(&bar[XB_XGEN(b.x)]) == gen, bar);
            __builtin_amdgcn_fence(__ATOMIC_ACQUIRE, "agent");
            asm volatile("s_waitcnt vmcnt(0)" ::: "memory");
        }
    }
    __syncthreads();
}


#ifndef NT_STREAMS
#define NT_STREAMS 1
#endif
#if NT_STREAMS
#define LDNT(p) __builtin_nontemporal_load(p)
#define STNT(p, v) __builtin_nontemporal_store((v), (p))
#else
#define LDNT(p) (*(p))
#define STNT(p, v) (*(p) = (v))
#endif
constexpr int NWAVES = 8;
constexpr int DM = 4096, NBATCH = 2, SEQ = 8192, NCTX = 256;
constexpr int MLAT = NBATCH * SEQ;
constexpr int MTOT = MLAT + NBATCH * NCTX;
constexpr int N_AB = 18176;
constexpr int N_ABSRC = 17984, N_C = 40960, MIXW = 8192;
constexpr int QL = 1024, KVL = 512, NQ = 6144, NKV = 8192;
constexpr int G1_CKV = 1024, G1_KR = 1536, G1_ZA = 1792, G1_UB = 5888, G1_VB = 9984, G1_ZB = 14080;
constexpr float EPS = 1e-6f;

constexpr size_t al256(size_t x) { return (x + 255) & ~(size_t)255; }
constexpr size_t WS_CTL = 0, CTL_ZERO_BYTES = 1u << 20;
constexpr size_t WS_MOD  = CTL_ZERO_BYTES;
constexpr size_t WS_OML  = WS_MOD  + al256((size_t)4 * 3 * 12288 * 4);
constexpr size_t WS_ROPE = WS_OML  + al256((size_t)2 * 2 * 8192 * 4);
constexpr size_t WS_STAT = WS_ROPE + al256((size_t)128 * 16 * 8);
constexpr size_t WS_WIN_AB = WS_STAT + al256((size_t)MTOT * 8);
constexpr size_t WS_WIN_C  = WS_WIN_AB + (size_t)2 * N_AB * DM * 2;
constexpr size_t WS_WO_AB  = WS_WIN_C + (size_t)2 * N_C * DM * 2;
constexpr size_t WS_WO_C   = WS_WO_AB + (size_t)2 * DM * MIXW * 2;
constexpr size_t WS_WQ     = WS_WO_C + (size_t)2 * DM * MIXW * 2;
constexpr size_t WS_WKV    = WS_WQ + (size_t)2 * NQ * QL * 2;
constexpr size_t WS_XS     = WS_WKV + (size_t)2 * NKV * KVL * 2;
constexpr size_t WS_H      = WS_XS + (size_t)MTOT * DM * 4;
constexpr size_t WS_Y      = WS_H + (size_t)MTOT * DM * 2;
constexpr size_t WS_G1     = WS_Y + (size_t)MTOT * DM * 4;
constexpr size_t WS_QN     = WS_G1 + (size_t)5 * MTOT * MIXW * 2;
constexpr size_t WS_KVN    = WS_QN + (size_t)MTOT * QL * 2;
constexpr size_t WS_KR     = WS_KVN + (size_t)MTOT * KVL * 2;
constexpr size_t WS_Q      = WS_KR + (size_t)MTOT * 64 * 2;
constexpr size_t WS_KN     = WS_Q + (size_t)MTOT * NQ * 2;
constexpr size_t WS_V      = WS_KN + (size_t)MTOT * DM * 2;
constexpr size_t WS_CC     = WS_V + (size_t)MTOT * DM * 2;
constexpr size_t WS_OF     = WS_CC + (size_t)MTOT * MIXW * 2;
constexpr size_t WS_YP     = WS_OF + (size_t)2 * MTOT * MIXW * 2;
constexpr size_t WS_END    = WS_YP + (size_t)8 * (MTOT - MLAT) * DM * 4;
constexpr int CW_BAR = 4096;

constexpr int RING_BYTES = 135168;
constexpr int LDSCTL_OFF = RING_BYTES, MISC_OFF = LDSCTL_OFF + 64;
constexpr int LDS_BYTES = 147456;

struct Args { const float* in[22]; float* out; unsigned char* ws; int ph_lo, ph_hi; };
typedef const __attribute__((address_space(4))) Args* KArgs;
__device__ __forceinline__ KArgs kargs() { KArgs ap = (KArgs)__builtin_amdgcn_kernarg_segment_ptr(); asm volatile("" : "+s"(ap)); return ap; }

#define GAS __attribute__((address_space(1)))
template <class T> __device__ __forceinline__ T* glob(T* p) { return (T*)(GAS T*)p; }
template <class T> __device__ __forceinline__ T* uni(T* p) {
    const unsigned long long v = (unsigned long long)p; const unsigned lo = __builtin_amdgcn_readfirstlane((unsigned)v), hi = __builtin_amdgcn_readfirstlane((unsigned)(v >> 32));
    return (T*)(GAS T*)(((unsigned long long)hi << 32) | lo); }
#define GWS(a_) glob((a_)->ws)
#define GIN(a_, i_) glob((a_)->in[i_])
#define GOUT(a_) glob((a_)->out)
__device__ __forceinline__ float wave_sum(float v) {
#pragma unroll
    for (int o = 1; o < 64; o <<= 1) v += __shfl_xor(v, o);
    return v;
}
__device__ __forceinline__ float bf_lo(unsigned w) { return __uint_as_float(w << 16); }
__device__ __forceinline__ float bf_hi(unsigned w) { return __uint_as_float(w & 0xffff0000u); }
typedef __bf16 bf16x2_t __attribute__((ext_vector_type(2)));
__device__ __forceinline__ unsigned cvtpk(float lo, float hi) { const f32x2 v = {lo, hi}; const bf16x2_t b = __builtin_convertvector(v, bf16x2_t); return __builtin_bit_cast(unsigned, b); }
__device__ __forceinline__ float silu_acc(float x) { return x / (1.0f + __expf(-x)); }

__device__ __forceinline__ void p0_gemv(KArgs a, LAS unsigned char* lds, int G) {
    int tid_l = threadIdx.x; asm volatile("" : "+v"(tid_l)); const int tid = tid_l, lane = tid & 63, wave = __builtin_amdgcn_readfirstlane(tid >> 6);
    LAS float* sc = (LAS float*)lds;
    LAS float* red = (LAS float*)(lds + 49152);
    const float* c = GIN(a, 1); const float* cctx = GIN(a, 3); const float* w_ada = GIN(a, 4); const float* b_ada = GIN(a, 5);
    float* mod = (float*)(GWS(a) + WS_MOD);
    for (int i = tid; i < 3 * 4096; i += 512) { const int r = i >> 12, k = i & 4095; const float cv = r < 2 ? c[r * 4096 + k] : cctx[k]; sc[i] = silu_acc(cv); }
    __syncthreads();
    const int kr = lane >> 4, c4 = lane & 15;
    for (int item = blockIdx.x; item < 768; item += G) {
        const int l = item / 192, cg = item % 192;
        const float* W = w_ada + (size_t)l * 4096 * 12288 + cg * 64 + c4 * 4;
        float acc[3][4];
#pragma unroll
        for (int r = 0; r < 3; ++r)
#pragma unroll
            for (int j = 0; j < 4; ++j) acc[r][j] = 0.f;
        const int k0 = wave * 512 + kr;
#pragma unroll 8
        for (int i = 0; i < 128; ++i) { const int k = k0 + 4 * i; const f32x4 w = LDNT((const f32x4*)(W + (size_t)k * 12288));
            const float s0 = sc[k], s1 = sc[4096 + k], s2 = sc[8192 + k];
#pragma unroll
            for (int j = 0; j < 4; ++j) { acc[0][j] += s0 * w[j]; acc[1][j] += s1 * w[j]; acc[2][j] += s2 * w[j]; } }
#pragma unroll
        for (int r = 0; r < 3; ++r)
#pragma unroll
            for (int j = 0; j < 4; ++j) { float v = acc[r][j]; v += __shfl_xor(v, 16); v += __shfl_xor(v, 32); acc[r][j] = v; }
        if (lane < 16) {
#pragma unroll
            for (int r = 0; r < 3; ++r)
#pragma unroll
                for (int j = 0; j < 4; ++j) red[(wave * 3 + r) * 64 + lane * 4 + j] = acc[r][j]; }
        __syncthreads();
        if (tid < 192) { const int r = tid >> 6, cc = tid & 63; float s = 0.f;
#pragma unroll
            for (int w = 0; w < 8; ++w) s += red[(w * 3 + r) * 64 + cc];
            const int col = cg * 64 + cc; mod[(size_t)(l * 3 + r) * 12288 + col] = s + b_ada[l * 12288 + col]; }
        __syncthreads();
    }
}
__device__ __forceinline__ void p0_tr_item(const float* W, int N, int K, bf16* WT, int n0s, int n0d, int k0, LAS float* scr, int lane) {
    const int kr = lane >> 4, c4 = lane & 15;
    const float* Wb = uni(W + (size_t)k0 * N + n0s); const unsigned lo = (unsigned)(kr * N + 4 * c4);
    f32x4 w[16];
#pragma unroll
    for (int i = 0; i < 16; ++i) w[i] = LDNT((const f32x4*)(Wb + lo + (unsigned)(4 * i * N)));
#pragma unroll
    for (int i = 0; i < 16; ++i) { const int k = 4 * i + kr;
        scr[(4 * c4 + 0) * 65 + k] = w[i][0]; scr[(4 * c4 + 1) * 65 + k] = w[i][1]; scr[(4 * c4 + 2) * 65 + k] = w[i][2]; scr[(4 * c4 + 3) * 65 + k] = w[i][3]; }
    LDS_WAIT(); asm volatile("" ::: "memory");
    bf16* ob = uni(WT + (size_t)n0d * K + k0); const int nr = lane >> 3, cch = lane & 7;
#pragma unroll
    for (int i = 0; i < 8; ++i) { const int n = 8 * i + nr; const LAS float* s = scr + n * 65 + 8 * cch;
        v4u o; o.x = cvtpk(s[0], s[1]); o.y = cvtpk(s[2], s[3]); o.z = cvtpk(s[4], s[5]); o.w = cvtpk(s[6], s[7]);
        *(v4u*)(ob + (unsigned)(n * K + 8 * cch)) = o; }
    LDS_WAIT(); asm volatile("" ::: "memory");
}
#ifndef P0_DEFER
#define P0_DEFER 1
#endif
constexpr int I_IN_AB = 64 * 281, I_Q = 16 * 96, I_KV = 8 * 128, I_O = 128 * 64, I_IN_C = 64 * 640, PER_J = I_IN_AB + I_Q + I_KV + I_O + I_IN_C + I_O;
__device__ __forceinline__ void p0_item(KArgs a, int j, int r, LAS float* scr, int lane) {
    if (r < I_IN_AB) { const int kb = r / 281, nb = r % 281, n0 = nb * 64;
        p0_tr_item(GIN(a, 8) + (size_t)j * DM * N_ABSRC, N_ABSRC, DM, (bf16*)(GWS(a) + WS_WIN_AB) + (size_t)j * N_AB * DM, n0, n0 + (n0 >= 1600 ? 192 : 0), kb * 64, scr, lane); return; } r -= I_IN_AB;
    if (r < I_Q) { const int kb = r / 96, nb = r % 96;
        p0_tr_item(GIN(a, 11) + (size_t)j * QL * NQ, NQ, QL, (bf16*)(GWS(a) + WS_WQ) + (size_t)j * NQ * QL, nb * 64, nb * 64, kb * 64, scr, lane); return; } r -= I_Q;
    if (r < I_KV) { const int kb = r / 128, nb = r % 128;
        p0_tr_item(GIN(a, 12) + (size_t)j * KVL * NKV, NKV, KVL, (bf16*)(GWS(a) + WS_WKV) + (size_t)j * NKV * KVL, nb * 64, nb * 64, kb * 64, scr, lane); return; } r -= I_KV;
    if (r < I_O) { const int kb = r / 64, nb = r % 64;
        p0_tr_item(GIN(a, 17) + (size_t)j * MIXW * DM, DM, MIXW, (bf16*)(GWS(a) + WS_WO_AB) + (size_t)j * DM * MIXW, nb * 64, nb * 64, kb * 64, scr, lane); return; } r -= I_O;
    if (r < I_IN_C) { const int kb = r / 640, nb = r % 640;
        p0_tr_item(GIN(a, 18) + (size_t)j * DM * N_C, N_C, DM, (bf16*)(GWS(a) + WS_WIN_C) + (size_t)j * N_C * DM, nb * 64, nb * 64, kb * 64, scr, lane); return; } r -= I_IN_C;
    { const int kb = r / 64, nb = r % 64;
        p0_tr_item(GIN(a, 21) + (size_t)j * MIXW * DM, DM, MIXW, (bf16*)(GWS(a) + WS_WO_C) + (size_t)j * DM * MIXW, nb * 64, nb * 64, kb * 64, scr, lane); }
}
constexpr int P0_ND = I_O + PER_J;
#ifndef P0_B1
#define P0_B1 25984
#endif
#ifndef P0_B2
#define P0_B2 51936
#endif
constexpr int P0_B3 = P0_ND - I_O;
static_assert(P0_B1 >= I_O && P0_B1 <= P0_B2 && P0_B2 >= I_O + I_IN_AB && P0_B2 <= P0_B3, "deferred-slot deadlines");
__device__ __forceinline__ bool p0_defer_on(int G) { return P0_DEFER && (G % pg8::NXCD == 0); }
__device__ __forceinline__ void p0_deferred(KArgs a, LAS unsigned char* lds, const pg8::LockstepOrder& S, int slot) {
    const int lenmax = S.PG * pg8::LockstepOrder::LW * S.nN + S.qR + (S.rR > 0 ? 1 : 0), R = (lenmax + S.nk - 1) / S.nk, kcut = lenmax - (R - 1) * S.nk;
    const bool all = kcut >= S.nk;
    if (!all && S.k < kcut) return;
    int tid_l = threadIdx.x; asm volatile("" : "+v"(tid_l)); const int lane = tid_l & 63, wave = __builtin_amdgcn_readfirstlane(tid_l >> 6);
    const int rank = all ? S.c : (S.k - kcut) * pg8::NXCD + S.x, nw = (all ? S.G : pg8::NXCD * (S.nk - kcut)) * NWAVES;
    __syncthreads();
    LAS float* scr = (LAS float*)(lds + wave * 16640);
    const int lo_ = slot == 0 ? 0 : slot == 1 ? P0_B1 : slot == 2 ? P0_B2 : P0_B3, hi_ = slot == 0 ? P0_B1 : slot == 1 ? P0_B2 : slot == 2 ? P0_B3 : P0_ND;
    for (int d = lo_ + rank * NWAVES + wave; d < hi_; d += nw) {
        const int j = d < I_O ? 0 : 1, r = d < I_O ? PER_J - I_O + d : d - I_O; p0_item(a, j, r, scr, lane); }
    __syncthreads();
}
__device__ __forceinline__ void p0_prologue(KArgs a, LAS unsigned char* lds, int G) {
    int tid_l = threadIdx.x; asm volatile("" : "+v"(tid_l)); const int tid = tid_l, lane = tid & 63, wave = __builtin_amdgcn_readfirstlane(tid >> 6);
    __syncthreads();
    p0_gemv(a, lds, G);
    __syncthreads();
    LAS float* scr = (LAS float*)(lds + wave * 16640);
    const int gw = blockIdx.x * NWAVES + wave, NGW = G * NWAVES;
    const bool defer = p0_defer_on(G);
    const int NIT = defer ? PER_J - I_O : 2 * PER_J;
    for (int it = gw; it < NIT; it += NGW) {
        const int j = defer ? (it < PER_J - I_O ? 0 : 1) : it / PER_J, r = defer ? (it < PER_J - I_O ? it : it - (PER_J - I_O)) : it % PER_J;
        p0_item(a, j, r, scr, lane);
    }
    const size_t gt = (size_t)blockIdx.x * 512 + tid, NGT = (size_t)G * 512;
    for (size_t i = gt; i < (size_t)2 * 192 * DM / 8; i += NGT) { const size_t j = i / (192 * DM / 8), e = i % (192 * DM / 8);
        *(v4u*)((bf16*)(GWS(a) + WS_WIN_AB) + j * (size_t)N_AB * DM + (size_t)1600 * DM + e * 8) = (v4u){0u, 0u, 0u, 0u}; }
    { const float* lg = GIN(a, 19); float* oml = (float*)(GWS(a) + WS_OML);
      for (size_t i = gt; i < (size_t)2 * 2 * 8192; i += NGT) { const int jc = (int)(i >> 14), de = (int)(i & 16383);
          const float l0 = lg[0 * 16384 + de], l1 = lg[1 * 16384 + de], l2 = lg[2 * 16384 + de], l3 = lg[3 * 16384 + de];
          const float mx = fmaxf(fmaxf(l0, l1), fmaxf(l2, l3)); const float e0 = __expf(l0 - mx), e1 = __expf(l1 - mx), e2 = __expf(l2 - mx), e3 = __expf(l3 - mx);
          const float inv = 1.0f / (e0 + e1 + e2 + e3); const float lb = (jc == 0) ? e1 * inv : (e1 + e2 + e3) * inv;
          oml[i] = 1.0f - lb; } }
    { f32x2* rope = (f32x2*)(GWS(a) + WS_ROPE);
      for (size_t i = gt; i < 128 * 16; i += NGT) { const int pos = (int)(i >> 4), f = (int)(i & 15); const float inv = powf(10000.0f, -(float)f / 16.0f); const float ang = (float)pos * inv;
          rope[i] = (f32x2){cosf(ang), sinf(ang)}; } }
}

__device__ __forceinline__ void norm_phase(KArgs a, int lpost, int lpre, int G) {
    int tid_l = threadIdx.x; asm volatile("" : "+v"(tid_l)); const int tid = tid_l, lane = tid & 63, wave = __builtin_amdgcn_readfirstlane(tid >> 6);
    const int gw = blockIdx.x * NWAVES + wave, NGW = G * NWAVES;
    const float* mod = (const float*)(GWS(a) + WS_MOD);
    float* XS = (float*)(GWS(a) + WS_XS); const float* Y = (const float*)(GWS(a) + WS_Y); bf16* H = (bf16*)(GWS(a) + WS_H);
    const int nrows = (lpost == 3) ? MLAT : MTOT;
    for (int row = gw; row < nrows; row += NGW) {
        const int rt = row < SEQ ? 0 : (row < MLAT ? 1 : 2);
        const float* xin = uni((lpost <= 0) ? (row < MLAT ? GIN(a, 0) + (size_t)row * DM : GIN(a, 2) + (size_t)(row - MLAT) * DM) : XS + (size_t)row * DM);
        f32x4 xv[16];
#pragma unroll
        for (int j = 0; j < 16; ++j) xv[j] = LDNT((const f32x4*)(xin + lane * 4 + 256 * j));
        if (lpost >= 0) {
            f32x4 yv[16]; float ss = 0.f;
            if (row < MLAT) { const bf16* yr = uni((const bf16*)Y + (size_t)row * DM);
#pragma unroll
                for (int j = 0; j < 16; ++j) { const u32x2 w = LDNT((const u32x2*)(yr + lane * 4 + 256 * j)); yv[j] = (f32x4){bf_lo(w.x), bf_hi(w.x), bf_lo(w.y), bf_hi(w.y)}; } }
            else {
                const float* yr = uni((const float*)(GWS(a) + WS_YP) + (size_t)(row - MLAT) * DM);
#pragma unroll
                for (int j = 0; j < 16; ++j) yv[j] = *(const f32x4*)(yr + lane * 4 + 256 * j);
                for (int kc = 1; kc < 8; ++kc) { const float* yk = uni(yr + (size_t)kc * (MTOT - MLAT) * DM);
#pragma unroll
                    for (int j = 0; j < 16; ++j) { yv[j] = yv[j] + *(const f32x4*)(yk + lane * 4 + 256 * j); if ((j & 3) == 3) asm volatile("" ::: "memory"); } } }
#pragma unroll
            for (int j = 0; j < 16; ++j) ss += (yv[j][0] * yv[j][0] + yv[j][1] * yv[j][1]) + (yv[j][2] * yv[j][2] + yv[j][3] * yv[j][3]);
            const float r = 1.0f / sqrtf(wave_sum(ss) * (1.0f / DM) + EPS);
            const float* gate = uni(mod + (size_t)(lpost * 3 + rt) * 12288 + 8192); const float* pw = uni(GIN(a, 7) + (size_t)lpost * DM);
            float* xout = uni((lpost == 3) ? GOUT(a) + (size_t)row * DM : XS + (size_t)row * DM);
#pragma unroll
            for (int j = 0; j < 16; ++j) { const int col = lane * 4 + 256 * j; const f32x4 g = *(const f32x4*)(gate + col), w = *(const f32x4*)(pw + col);
                xv[j] = xv[j] + g * ((yv[j] * r) * w); STNT((f32x4*)(xout + col), xv[j]);
                if ((j & 3) == 3) asm volatile("" ::: "memory"); }
        }
        if (lpre < 4) {
            float ss = 0.f;
#pragma unroll
            for (int j = 0; j < 16; ++j) ss += (xv[j][0] * xv[j][0] + xv[j][1] * xv[j][1]) + (xv[j][2] * xv[j][2] + xv[j][3] * xv[j][3]);
            const float r = 1.0f / sqrtf(wave_sum(ss) * (1.0f / DM) + EPS);
            const float* shift = uni(mod + (size_t)(lpre * 3 + rt) * 12288); const float* scale = shift + 4096; const float* pw = uni(GIN(a, 6) + (size_t)lpre * DM);
            bf16* hr = uni(H + (size_t)row * DM);
#pragma unroll
            for (int j = 0; j < 16; ++j) { const int col = lane * 4 + 256 * j; const f32x4 sh = *(const f32x4*)(shift + col), sc = *(const f32x4*)(scale + col), w = *(const f32x4*)(pw + col);
                const f32x4 h = ((xv[j] * r) * w) * (sc + 1.0f) + sh; u32x2 o; o.x = cvtpk(h[0], h[1]); o.y = cvtpk(h[2], h[3]); *(u32x2*)(hr + col) = o;
                if ((j & 3) == 3) asm volatile("" ::: "memory"); }
        }
    }
}

__device__ __forceinline__ void a2_rows(KArgs a, int j, int G) {
    int tid_l = threadIdx.x; asm volatile("" : "+v"(tid_l)); const int tid = tid_l, lane = tid & 63, wave = __builtin_amdgcn_readfirstlane(tid >> 6);
    const int gw = blockIdx.x * NWAVES + wave, NGW = G * NWAVES;
    const bf16* G1 = (const bf16*)(GWS(a) + WS_G1); bf16* QN = (bf16*)(GWS(a) + WS_QN); bf16* KVN = (bf16*)(GWS(a) + WS_KVN); bf16* KR = (bf16*)(GWS(a) + WS_KR);
    f32x2* stat = (f32x2*)(GWS(a) + WS_STAT); const f32x2* rope = (const f32x2*)(GWS(a) + WS_ROPE);
    const float* qw = GIN(a, 9) + (size_t)j * QL; const float* kvw = GIN(a, 10) + (size_t)j * KVL;
    for (int row = gw; row < MTOT; row += NGW) {
        const bf16* g = uni(G1 + (size_t)row * N_AB);
        {
            v4u w[2]; float x[16]; float ss = 0.f;
#pragma unroll
            for (int i = 0; i < 2; ++i) { w[i] = LDNT((const v4u*)(g + lane * 8 + 512 * i));
#pragma unroll
                for (int e = 0; e < 4; ++e) { x[8 * i + 2 * e] = bf_lo(w[i][e]); x[8 * i + 2 * e + 1] = bf_hi(w[i][e]); } }
#pragma unroll
            for (int e = 0; e < 16; ++e) ss += x[e] * x[e];
            const float r = 1.0f / sqrtf(wave_sum(ss) * (1.0f / QL) + EPS);
#pragma unroll
            for (int i = 0; i < 2; ++i) { const int col = lane * 8 + 512 * i; const f32x4 w0 = *(const f32x4*)(qw + col), w1 = *(const f32x4*)(qw + col + 4);
                v4u o; o.x = cvtpk(x[8 * i + 0] * r * w0[0], x[8 * i + 1] * r * w0[1]); o.y = cvtpk(x[8 * i + 2] * r * w0[2], x[8 * i + 3] * r * w0[3]);
                o.z = cvtpk(x[8 * i + 4] * r * w1[0], x[8 * i + 5] * r * w1[1]); o.w = cvtpk(x[8 * i + 6] * r * w1[2], x[8 * i + 7] * r * w1[3]);
                *(v4u*)(QN + (size_t)row * QL + col) = o; }
        }
        {
            const v4u w = LDNT((const v4u*)(g + G1_CKV + lane * 8)); float x[8]; float ss = 0.f;
#pragma unroll
            for (int e = 0; e < 4; ++e) { x[2 * e] = bf_lo(w[e]); x[2 * e + 1] = bf_hi(w[e]); }
#pragma unroll
            for (int e = 0; e < 8; ++e) ss += x[e] * x[e];
            const float r = 1.0f / sqrtf(wave_sum(ss) * (1.0f / KVL) + EPS);
            const int col = lane * 8; const f32x4 w0 = *(const f32x4*)(kvw + col), w1 = *(const f32x4*)(kvw + col + 4);
            v4u o; o.x = cvtpk(x[0] * r * w0[0], x[1] * r * w0[1]); o.y = cvtpk(x[2] * r * w0[2], x[3] * r * w0[3]); o.z = cvtpk(x[4] * r * w1[0], x[5] * r * w1[1]); o.w = cvtpk(x[6] * r * w1[2], x[7] * r * w1[3]);
            *(v4u*)(KVN + (size_t)row * KVL + col) = o;
        }
        {
            const float x = __uint_as_float((unsigned)g[G1_KR + lane] << 16); const float xp = __shfl_xor(x, 16); float o = x;
            if (row < MLAT) { const int t = row & (SEQ - 1), ax = lane >> 5, hh = (lane >> 4) & 1, f = lane & 15, pos = ax == 0 ? (t >> 6) : (t & 63); const f32x2 cs = rope[pos * 16 + f];
                o = hh == 0 ? x * cs.x - xp * cs.y : x * cs.x + xp * cs.y; }
            KR[(size_t)row * 64 + lane] = (bf16)(cvtpk(o, 0.f) & 0xffffu);
        }
        {
            float x[64]; float s = 0.f;
#pragma unroll
            for (int i = 0; i < 8; ++i) { const v4u w = *(const v4u*)(g + G1_VB + lane * 8 + 512 * i);
#pragma unroll
                for (int e = 0; e < 4; ++e) { x[8 * i + 2 * e] = bf_lo(w[e]); x[8 * i + 2 * e + 1] = bf_hi(w[e]); } }
#pragma unroll
            for (int e = 0; e < 64; ++e) s += x[e];
            const float mean = wave_sum(s) * (1.0f / 4096.0f); float q = 0.f;
#pragma unroll
            for (int e = 0; e < 64; ++e) { const float d = x[e] - mean; q += d * d; }
            const float rstd = 1.0f / sqrtf(wave_sum(q) * (1.0f / 4096.0f) + EPS);
            if (lane == 0) stat[row] = (f32x2){mean, rstd};
        }
    }
}

typedef short s16x4 __attribute__((ext_vector_type(4)));
typedef float f32x16 __attribute__((ext_vector_type(16)));
#define SBAR() __builtin_amdgcn_sched_barrier(0)
__device__ __forceinline__ f32x4 mfma16(bf16x8 a, bf16x8 b, f32x4 c) { return __builtin_amdgcn_mfma_f32_16x16x32_bf16(a, b, c, 0, 0, 0); }
__device__ __forceinline__ int crow(int r, int hi) { return (r & 3) + 8 * (r >> 2) + 4 * hi; }
__device__ __forceinline__ int v_st(int k, int c) { const int kk = (k & ~0xC) | ((k & 4) << 1) | ((k & 8) >> 1); return ((kk >> 3) * 4 + (c >> 5)) * 512 + ((kk & 7) * 32 + (c & 31)) * 2; }
__device__ __forceinline__ int v_rd_base(int lane) { return ((lane & 3) << 3) | (((lane >> 2) & 3) << 6) | (((lane >> 4) & 1) << 5) | (((lane >> 5) & 1) << 8); }
constexpr int v_rd_off(int d0, int ks, int half) { return d0 * 512 + ks * 4096 + half * 2048; }
template <int OFF> __device__ __forceinline__ s16x4 tr_read(int vb) {
    s16x4 r; asm volatile("ds_read_b64_tr_b16 %0, %1 offset:%2" : "=&v"(r) : "v"(vb), "i"(OFF) : "memory"); return r;
}
template <int D0> __device__ __forceinline__ void pv_one(f32x16& od, int vb, bf16x8 pa0, bf16x8 pa1, bf16x8 pa2, bf16x8 pa3) {
    const s16x4 l0 = tr_read<v_rd_off(D0, 0, 0)>(vb), h0 = tr_read<v_rd_off(D0, 0, 1)>(vb), l1 = tr_read<v_rd_off(D0, 1, 0)>(vb), h1 = tr_read<v_rd_off(D0, 1, 1)>(vb);
    const s16x4 l2 = tr_read<v_rd_off(D0, 2, 0)>(vb), h2 = tr_read<v_rd_off(D0, 2, 1)>(vb), l3 = tr_read<v_rd_off(D0, 3, 0)>(vb), h3 = tr_read<v_rd_off(D0, 3, 1)>(vb);
    asm volatile("s_waitcnt lgkmcnt(0)" ::: "memory"); SBAR();
#define PKV(L, H) (bf16x8){L[0], L[1], L[2], L[3], H[0], H[1], H[2], H[3]}
    od = __builtin_amdgcn_mfma_f32_32x32x16_bf16(pa0, PKV(l0, h0), od, 0, 0, 0);
    od = __builtin_amdgcn_mfma_f32_32x32x16_bf16(pa1, PKV(l1, h1), od, 0, 0, 0);
    od = __builtin_amdgcn_mfma_f32_32x32x16_bf16(pa2, PKV(l2, h2), od, 0, 0, 0);
    od = __builtin_amdgcn_mfma_f32_32x32x16_bf16(pa3, PKV(l3, h3), od, 0, 0, 0);
#undef PKV
}
__device__ __forceinline__ void pv_d0(f32x16* o, int vb, bf16x8 pa0, bf16x8 pa1, bf16x8 pa2, bf16x8 pa3) {
    pv_one<0>(o[0], vb, pa0, pa1, pa2, pa3); pv_one<1>(o[1], vb, pa0, pa1, pa2, pa3); pv_one<2>(o[2], vb, pa0, pa1, pa2, pa3); pv_one<3>(o[3], vb, pa0, pa1, pa2, pa3);
}

template <int I> __device__ __forceinline__ void pv_rd(int vb, s16x4& l0, s16x4& h0, s16x4& l1, s16x4& h1) {
    l0 = tr_read<v_rd_off(I >> 1, 2 * (I & 1), 0)>(vb); h0 = tr_read<v_rd_off(I >> 1, 2 * (I & 1), 1)>(vb); l1 = tr_read<v_rd_off(I >> 1, 2 * (I & 1) + 1, 0)>(vb); h1 = tr_read<v_rd_off(I >> 1, 2 * (I & 1) + 1, 1)>(vb);
}
#define PKV2(L, H) (bf16x8){L[0], L[1], L[2], L[3], H[0], H[1], H[2], H[3]}
#define PV_MM(I, A0, A1, L0, H0, L1, H1) do { o[(I) >> 1] = __builtin_amdgcn_mfma_f32_32x32x16_bf16(A0, PKV2(L0, H0), o[(I) >> 1], 0, 0, 0); o[(I) >> 1] = __builtin_amdgcn_mfma_f32_32x32x16_bf16(A1, PKV2(L1, H1), o[(I) >> 1], 0, 0, 0); } while (0)
#define PV_WAIT4() do { asm volatile("s_waitcnt lgkmcnt(4)" ::: "memory"); SBAR(); } while (0)
#define PV_WAIT0() do { asm volatile("s_waitcnt lgkmcnt(0)" ::: "memory"); SBAR(); } while (0)
__device__ __forceinline__ void pv_pipe(f32x16* o, int vb, bf16x8 pa0, bf16x8 pa1, bf16x8 pa2, bf16x8 pa3) {
    s16x4 al0, ah0, al1, ah1, bl0, bh0, bl1, bh1;
    asm volatile("s_waitcnt lgkmcnt(0)" ::: "memory"); SBAR();
    pv_rd<0>(vb, al0, ah0, al1, ah1); pv_rd<1>(vb, bl0, bh0, bl1, bh1);
    PV_WAIT4(); PV_MM(0, pa0, pa1, al0, ah0, al1, ah1); SBAR(); pv_rd<2>(vb, al0, ah0, al1, ah1);
    PV_WAIT4(); PV_MM(1, pa2, pa3, bl0, bh0, bl1, bh1); SBAR(); pv_rd<3>(vb, bl0, bh0, bl1, bh1);
    PV_WAIT4(); PV_MM(2, pa0, pa1, al0, ah0, al1, ah1); SBAR(); pv_rd<4>(vb, al0, ah0, al1, ah1);
    PV_WAIT4(); PV_MM(3, pa2, pa3, bl0, bh0, bl1, bh1); SBAR(); pv_rd<5>(vb, bl0, bh0, bl1, bh1);
    PV_WAIT4(); PV_MM(4, pa0, pa1, al0, ah0, al1, ah1); SBAR(); pv_rd<6>(vb, al0, ah0, al1, ah1);
    PV_WAIT4(); PV_MM(5, pa2, pa3, bl0, bh0, bl1, bh1); SBAR(); pv_rd<7>(vb, bl0, bh0, bl1, bh1);
    PV_WAIT4(); PV_MM(6, pa0, pa1, al0, ah0, al1, ah1);
    PV_WAIT0(); PV_MM(7, pa2, pa3, bl0, bh0, bl1, bh1);
}

__device__ __forceinline__ void pv_seq(f32x16* o, int vb, bf16x8 pa0, bf16x8 pa1, bf16x8 pa2, bf16x8 pa3) {
    s16x4 al0, ah0, al1, ah1;
    pv_rd<0>(vb, al0, ah0, al1, ah1); PV_WAIT0(); PV_MM(0, pa0, pa1, al0, ah0, al1, ah1); SBAR();
    pv_rd<1>(vb, al0, ah0, al1, ah1); PV_WAIT0(); PV_MM(1, pa2, pa3, al0, ah0, al1, ah1); SBAR();
    pv_rd<2>(vb, al0, ah0, al1, ah1); PV_WAIT0(); PV_MM(2, pa0, pa1, al0, ah0, al1, ah1); SBAR();
    pv_rd<3>(vb, al0, ah0, al1, ah1); PV_WAIT0(); PV_MM(3, pa2, pa3, al0, ah0, al1, ah1); SBAR();
    pv_rd<4>(vb, al0, ah0, al1, ah1); PV_WAIT0(); PV_MM(4, pa0, pa1, al0, ah0, al1, ah1); SBAR();
    pv_rd<5>(vb, al0, ah0, al1, ah1); PV_WAIT0(); PV_MM(5, pa2, pa3, al0, ah0, al1, ah1); SBAR();
    pv_rd<6>(vb, al0, ah0, al1, ah1); PV_WAIT0(); PV_MM(6, pa0, pa1, al0, ah0, al1, ah1); SBAR();
    pv_rd<7>(vb, al0, ah0, al1, ah1); PV_WAIT0(); PV_MM(7, pa2, pa3, al0, ah0, al1, ah1);
}

__device__ __forceinline__ void sgu_phase(KArgs a, int j, LAS unsigned char* lds, int G) {
    int tid_l = threadIdx.x; asm volatile("" : "+v"(tid_l)); const int tid = tid_l, lane = tid & 63, wid = __builtin_amdgcn_readfirstlane(tid >> 6), r32 = lane & 31, hi = lane >> 5;
    const bf16* G1 = (const bf16*)(GWS(a) + WS_G1); bf16* CC = (bf16*)(GWS(a) + WS_CC); const f32x2* stat = (const f32x2*)(GWS(a) + WS_STAT);
    const float* lnw = GIN(a, 13) + (size_t)j * 4096; const float* lnb = GIN(a, 14) + (size_t)j * 4096; const float* ws_all = GIN(a, 15) + (size_t)j * 16 * 128 * 128; const float* bs = GIN(a, 16) + (size_t)j * 16 * 128;
    constexpr int MXP = 272, OFF_ST = 69632;
    LAS float* st_mean = (LAS float*)(lds + OFF_ST); LAS float* st_rstd = st_mean + 128;
    LAS float* m1s = (LAS float*)(lds + OFF_ST + 1024) + wid * 64; LAS float* rss = m1s + 32;
    LAS unsigned char* mx = lds + wid * (32 * MXP);
    const int sr = tid >> 4, sc = (tid & 15) * 8, vst0 = v_st(sr, sc), vst1 = v_st(32 + sr, sc);
    const int tb = wid >> 1, ch = wid & 1;
    const int vb0 = (int)(unsigned)(unsigned long long)lds + v_rd_base(lane);
    v4u vx[8];
#define SGU_LOADV(it_) do { const int ch_ = (it_) >> 4, g_ = (it_) & 15; const bf16* s0_ = uni(G1 + (size_t)(ch_ * 128) * N_AB + G1_VB + g_ * 256); const unsigned lo_ = (unsigned)(sr * N_AB + sc); \
    _Pragma("unroll") for (int st = 0; st < 2; ++st) _Pragma("unroll") for (int c2 = 0; c2 < 2; ++c2) { const unsigned o_ = lo_ + (unsigned)(64 * st * N_AB + c2 * 128); \
        vx[(st * 2 + c2) * 2] = LDNT((const v4u*)(s0_ + o_)); vx[(st * 2 + c2) * 2 + 1] = LDNT((const v4u*)(s0_ + o_ + 32 * N_AB)); } } while (0)
    const int item0 = (int)((blockIdx.x + 128u) % (unsigned)G);
    if (item0 < 132 * 16) SGU_LOADV(item0);
    for (int item = item0; item < 132 * 16; item += G) {
        const int chunk = item >> 4, g = item & 15, row0 = chunk * 128;
        __syncthreads();
#pragma unroll
        for (int q = 0; q < 4; ++q) { *(LAS v4u*)(lds + q * 16384 + vst0) = vx[2 * q]; *(LAS v4u*)(lds + q * 16384 + vst1) = vx[2 * q + 1]; }
        if (tid < 128) { const f32x2 s = stat[row0 + tid]; st_mean[tid] = s.x; st_rstd[tid] = s.y; }
        __syncthreads();
        if (item + G < 132 * 16) SGU_LOADV(item + G);
        const float* wrow = ws_all + ((size_t)g * 128 + 32 * tb + r32) * 128;
        bf16x8 pa[2][4]; float m1 = 0.f, rs = 0.f;
#pragma unroll
        for (int st = 0; st < 2; ++st)
#pragma unroll
            for (int ks = 0; ks < 4; ++ks) { const int s0 = 64 * st + 16 * ks + 8 * hi; const f32x4 w0 = *(const f32x4*)(wrow + s0), w1 = *(const f32x4*)(wrow + s0 + 4);
                const f32x4 r0 = *(const LAS f32x4*)(st_rstd + s0), r1 = *(const LAS f32x4*)(st_rstd + s0 + 4), mu0 = *(const LAS f32x4*)(st_mean + s0), mu1 = *(const LAS f32x4*)(st_mean + s0 + 4);
                rs += (w0[0] + w0[1]) + (w0[2] + w0[3]) + (w1[0] + w1[1]) + (w1[2] + w1[3]);
                v4u p; p.x = cvtpk(w0[0] * r0[0], w0[1] * r0[1]); p.y = cvtpk(w0[2] * r0[2], w0[3] * r0[3]); p.z = cvtpk(w1[0] * r1[0], w1[1] * r1[1]); p.w = cvtpk(w1[2] * r1[2], w1[3] * r1[3]);
                m1 += bf_lo(p.x) * mu0[0] + bf_hi(p.x) * mu0[1] + bf_lo(p.y) * mu0[2] + bf_hi(p.y) * mu0[3] + bf_lo(p.z) * mu1[0] + bf_hi(p.z) * mu1[1] + bf_lo(p.w) * mu1[2] + bf_hi(p.w) * mu1[3];
                pa[st][ks] = __builtin_bit_cast(bf16x8, p); }
        m1 += __shfl_xor(m1, 32); rs += __shfl_xor(rs, 32);
        if (hi == 0) { m1s[r32] = m1; rss[r32] = rs; }
        f32x16 o[4];
#pragma unroll
        for (int d = 0; d < 4; ++d)
#pragma unroll
            for (int r = 0; r < 16; ++r) o[d][r] = 0.f;
#pragma unroll
        for (int st = 0; st < 2; ++st) pv_d0(o, vb0 + (st * 2 + ch) * 16384, pa[st][0], pa[st][1], pa[st][2], pa[st][3]);
        asm volatile("s_waitcnt lgkmcnt(0)" ::: "memory");
        __syncthreads();
        { const int cb = g * 256 + ch * 128;
          const float* lw = uni(lnw + cb); const float* lb = uni(lnb + cb); const float* bsg = uni(bs + g * 128 + 32 * tb);
          int r32e = r32, hie = hi; asm volatile("" : "+v"(r32e), "+v"(hie));
          float lwv[4], lbv[4];
#pragma unroll
          for (int d0 = 0; d0 < 4; ++d0) { lwv[d0] = lw[d0 * 32 + r32e]; lbv[d0] = lb[d0 * 32 + r32e]; }
#pragma unroll
          for (int r = 0; r < 16; ++r) { const int rr = crow(r, hie); const float m1t = m1s[rr], rst = rss[rr], bst = bsg[rr];
#pragma unroll
            for (int d0 = 0; d0 < 4; ++d0) { const float mix = lwv[d0] * (o[d0][r] - m1t) + lbv[d0] * rst + bst;
                *(LAS bf16*)(mx + rr * MXP + (d0 * 32 + r32e) * 2) = (bf16)(cvtpk(mix, 0.f) & 0xffffu); } } }
        asm volatile("s_waitcnt lgkmcnt(0)" ::: "memory");
        { const int cb = g * 256 + ch * 128;
          const bf16* Gu = uni(G1 + (size_t)(row0 + 32 * tb) * N_AB + G1_UB + cb); const bf16* Gzb = uni(G1 + (size_t)(row0 + 32 * tb) * N_AB + G1_ZB + cb); bf16* Co = uni(CC + (size_t)(row0 + 32 * tb) * MIXW + 4096 + cb);
          int le = lane; asm volatile("" : "+v"(le));
#pragma unroll
          for (int i = 0; i < 8; ++i) { const int id = 64 * i + le, row = id >> 4, c8 = (id & 15) * 8;
              const v4u mq = *(const LAS v4u*)(mx + row * MXP + c8 * 2); const v4u uq = LDNT((const v4u*)(Gu + (unsigned)(row * N_AB + c8))), zq = LDNT((const v4u*)(Gzb + (unsigned)(row * N_AB + c8)));
              v4u oq;
#pragma unroll
              for (int e = 0; e < 4; ++e) oq[e] = cvtpk(bf_lo(uq[e]) * bf_lo(mq[e]) * bf_lo(zq[e]), bf_hi(uq[e]) * bf_hi(mq[e]) * bf_hi(zq[e]));
              *(v4u*)(Co + (unsigned)(row * MIXW + c8)) = oq;
              if ((i & 3) == 3) asm volatile("" ::: "memory"); } }
    }
#undef SGU_LOADV
    __syncthreads();
}

namespace att {
constexpr int QBLK = 32, KVBLK = 64;
constexpr float SCALE = 0.07216878364870322f;
constexpr float THR = 8.f;
constexpr int SHM_V = KVBLK * 128 * 2, SHM_K = KVBLK * 192 * 2;
#ifndef STG_SEL
#define STG_SEL 0
#endif
#ifndef ATT_STAGGER
#define ATT_STAGGER 1
#endif
constexpr int NVB = ATT_STAGGER ? 3 : 2;
constexpr int OFF_V = 0, OFF_K = NVB * SHM_V, OFF_WS = OFF_K + 2 * SHM_K, ATT_LDS = OFF_WS + NWAVES * 64 * 4;
#ifndef ATT_QR_LDS
#define ATT_QR_LDS 1
#endif
#ifndef ATT_SDEPTH
#define ATT_SDEPTH 1
#endif
constexpr int SDEPTH = ATT_SDEPTH;
constexpr float THRL = THR * 1.4426950408889634f;
__device__ __forceinline__ void partialSM_first(f32x16& p0, f32x16& p1, float& m_reg, float& alpha) {
    float pmax = p0[0];
#pragma unroll
    for (int r = 1; r < 16; ++r) pmax = fmaxf(pmax, p0[r]);
#pragma unroll
    for (int r = 0; r < 16; ++r) pmax = fmaxf(pmax, p1[r]);
    { auto rr = __builtin_amdgcn_permlane32_swap(__float_as_uint(pmax), __float_as_uint(pmax), false, false);
      pmax = fmaxf(__uint_as_float(rr[0]), __uint_as_float(rr[1])); }
    m_reg = pmax; alpha = 1.f;
#pragma unroll
    for (int r = 0; r < 16; ++r) p0[r] = p0[r] - pmax;
#pragma unroll
    for (int r = 0; r < 16; ++r) p1[r] = p1[r] - pmax;
#pragma unroll
    for (int r = 0; r < 16; ++r) p0[r] = __builtin_amdgcn_exp2f(p0[r]);
}
__device__ __forceinline__ void partialSM(f32x16& p0, f32x16& p1, float& m_reg, float& alpha) {
    float pmax = p0[0];
#pragma unroll
    for (int r = 1; r < 16; ++r) pmax = fmaxf(pmax, p0[r]);
#pragma unroll
    for (int r = 0; r < 16; ++r) pmax = fmaxf(pmax, p1[r]);
    { auto rr = __builtin_amdgcn_permlane32_swap(__float_as_uint(pmax), __float_as_uint(pmax), false, false);
      pmax = fmaxf(__uint_as_float(rr[0]), __uint_as_float(rr[1])); }
    if (__builtin_expect(__all(pmax <= THRL), 1)) { alpha = 1.f; }
    else { const float d = fmaxf(pmax, 0.f); alpha = __builtin_amdgcn_exp2f(-d); m_reg += d;
#pragma unroll
        for (int r = 0; r < 16; ++r) p0[r] = p0[r] - d;
#pragma unroll
        for (int r = 0; r < 16; ++r) p1[r] = p1[r] - d; }
#pragma unroll
    for (int r = 0; r < 16; ++r) p0[r] = __builtin_amdgcn_exp2f(p0[r]);
}
__device__ __forceinline__ void finishSM(f32x16& p0, f32x16& p1, float alpha, float& l_reg, bf16x8& pa0, bf16x8& pa1, bf16x8& pa2, bf16x8& pa3) {
#pragma unroll
    for (int r = 0; r < 16; ++r) p1[r] = __builtin_amdgcn_exp2f(p1[r]);
    float ps = 0;
#pragma unroll
    for (int r = 0; r < 16; ++r) ps += p0[r];
#pragma unroll
    for (int r = 0; r < 16; ++r) ps += p1[r];
    { auto rr = __builtin_amdgcn_permlane32_swap(__float_as_uint(ps), __float_as_uint(ps), false, false);
      ps = __uint_as_float(rr[0]) + __uint_as_float(rr[1]); }
    l_reg = l_reg * alpha + ps;
#define PK4(P, BASE, OUT) do { unsigned a0 = cvtpk(P[BASE + 0], P[BASE + 1]), a1 = cvtpk(P[BASE + 2], P[BASE + 3]);   \
    unsigned b0 = cvtpk(P[BASE + 4], P[BASE + 5]), b1 = cvtpk(P[BASE + 6], P[BASE + 7]);                              \
    auto r0 = __builtin_amdgcn_permlane32_swap(a0, b0, false, false); auto r1 = __builtin_amdgcn_permlane32_swap(a1, b1, false, false); \
    v4u w = {r0[0], r1[0], r0[1], r1[1]}; OUT = __builtin_bit_cast(bf16x8, w); } while (0)
    PK4(p0, 0, pa0); PK4(p0, 8, pa1); PK4(p1, 0, pa2); PK4(p1, 8, pa3);
#undef PK4
}
constexpr int OFF_KR = 16384;
constexpr int OFF_QR = ATT_LDS, ATT_LDS2 = OFF_QR + NWAVES * 4096;
__device__ __forceinline__ void qkt(f32x16& p0, f32x16& p1, const LAS unsigned char* Ks, const bf16x8* qr, const LAS unsigned char* qrl, int r32, int hi, float seed) {
#pragma unroll
    for (int r = 0; r < 16; ++r) { p0[r] = seed; p1[r] = seed; }
    const int swn = (r32 & 15) << 4, swr = ((r32 >> 1) & 7) << 4;
#pragma unroll
    for (int d0 = 0; d0 < 8; ++d0) { const int cb = (d0 * 16 + hi * 8) * 2;
        const bf16x8 b0 = *(const LAS bf16x8*)(Ks + r32 * 256 + (cb ^ swn));
        const bf16x8 b1 = *(const LAS bf16x8*)(Ks + (32 + r32) * 256 + (cb ^ swn));
        p0 = __builtin_amdgcn_mfma_f32_32x32x16_bf16(b0, qr[d0], p0, 0, 0, 0);
        p1 = __builtin_amdgcn_mfma_f32_32x32x16_bf16(b1, qr[d0], p1, 0, 0, 0); }
#pragma unroll
    for (int d0 = 0; d0 < 4; ++d0) { const int cb = (d0 * 16 + hi * 8) * 2;
        const bf16x8 b0 = *(const LAS bf16x8*)(Ks + OFF_KR + r32 * 128 + (cb ^ swr));
        const bf16x8 b1 = *(const LAS bf16x8*)(Ks + OFF_KR + (32 + r32) * 128 + (cb ^ swr));
#if ATT_QR_LDS
        const bf16x8 q = *(const LAS bf16x8*)(qrl + d0 * 1024);
#else
        const bf16x8 q = qr[8 + d0];
#endif
        p0 = __builtin_amdgcn_mfma_f32_32x32x16_bf16(b0, q, p0, 0, 0, 0);
        p1 = __builtin_amdgcn_mfma_f32_32x32x16_bf16(b1, q, p1, 0, 0, 0); }
}
__device__ __forceinline__ void attn_unit(const bf16* __restrict__ Q, const bf16* __restrict__ KN, const bf16* __restrict__ KR, const bf16* __restrict__ V, const bf16* __restrict__ G1, bf16* __restrict__ CC,
                                          int qrow0, int h, int nt_lat, int lat0, int ctx0, LAS unsigned char* lds) {
    int tid_l = threadIdx.x; asm volatile("" : "+v"(tid_l)); const int tid = tid_l, wid = __builtin_amdgcn_readfirstlane(tid >> 6), lane = tid & 63, r32 = lane & 31, hi = lane >> 5;
    LAS unsigned char* V_lds = lds + OFF_V; LAS unsigned char* K_lds = lds + OFF_K;
    LAS float* wsf = (LAS float*)(lds + OFF_WS) + wid * 64; LAS float* li_l = wsf; LAS float* al_l = wsf + 32;
    LAS unsigned char* qrl = lds + OFF_QR + wid * 4096 + lane * 16;
    float m_reg = -1e30f, l_reg = 0;
    f32x16 o[4];
#pragma unroll
    for (int d = 0; d < 4; ++d)
#pragma unroll
        for (int r = 0; r < 16; ++r) o[d][r] = 0.f;
    const unsigned ko = (unsigned)((tid >> 4) * 128 + (((tid & 15) ^ ((tid >> 4) & 15)) * 8));
    const unsigned kro = (unsigned)((tid >> 3) * 64 + (((tid & 7) ^ ((tid >> 4) & 7)) * 8));
    unsigned vo; { const int sub = tid >> 5, kk = (sub >> 2) * 8 + ((tid & 31) >> 2), col = (sub & 3) * 32 + (tid & 3) * 8, key = (kk & ~0xC) | ((kk & 4) << 1) | ((kk & 8) >> 1); vo = (unsigned)(key * 128 + col); }
    const int vb0 = (int)(unsigned)(unsigned long long)lds + OFF_V + v_rd_base(lane);
    const int NT = nt_lat + 4;
#define TROW(jt) ((jt) < nt_lat ? lat0 + 64 * (jt) : ctx0 + 64 * ((jt) - nt_lat))
#define GLDS(gp, lp) __builtin_amdgcn_global_load_lds((const unsigned*)(gp), (LAS unsigned*)(lp), 16, 0, 0)
#define GLDS_S(gbase, boff, lp) do { const char* gb_ = (const char*)(gbase); asm volatile("" : "+s"(gb_)); unsigned bo_ = (boff); asm volatile("" : "+v"(bo_)); GLDS(gb_ + bo_, lp); } while (0)
#define ISSUE_K(jt, b) do { const int R0_ = TROW(jt); const bf16* Kb_ = uni(KN + ((size_t)h * MTOT + R0_) * 128); const bf16* Rb_ = uni(KR + (size_t)R0_ * 64); \
    GLDS_S(Kb_, ko * 2u, K_lds + (b) * SHM_K + wid * 1024); GLDS_S(Kb_ + 32 * 128, ko * 2u, K_lds + (b) * SHM_K + (wid + 8) * 1024); GLDS_S(Rb_, kro * 2u, K_lds + (b) * SHM_K + OFF_KR + wid * 1024); } while (0)
#define ISSUE_V(jt, b) do { const int R0_ = TROW(jt); const bf16* Vb_ = uni(V + ((size_t)h * MTOT + R0_) * 128); \
    GLDS_S(Vb_, vo * 2u, V_lds + (b) * SHM_V + wid * 1024); GLDS_S(Vb_ + 32 * 128, vo * 2u, V_lds + (b) * SHM_V + (wid + 8) * 1024); } while (0)
#define STEP_END() asm volatile("s_waitcnt vmcnt(0) lgkmcnt(0)\n\ts_barrier" ::: "memory")
#define RESC(a_) do { if (__any((a_) < 1.f)) { if (hi == 0) al_l[r32] = (a_); asm volatile("s_waitcnt lgkmcnt(0)" ::: "memory"); \
    _Pragma("unroll") for (int d = 0; d < 4; ++d) _Pragma("unroll") for (int r = 0; r < 16; ++r) o[d][r] *= al_l[crow(r, hi)]; } } while (0)
    STEP_END();
    ISSUE_K(0, 0);
    bf16x8 qr[ATT_QR_LDS ? 8 : 12];
    { const bf16* Qw = uni(Q + (size_t)(qrow0 + wid * QBLK) * NQ + h * 192); const unsigned qo = (unsigned)(r32 * NQ + hi * 8);
#pragma unroll
      for (int d0 = 0; d0 < (ATT_QR_LDS ? 8 : 12); ++d0) qr[d0] = *(const bf16x8*)(Qw + qo + d0 * 16);
#if ATT_QR_LDS
#pragma unroll
      for (int d0 = 8; d0 < 12; ++d0) { const bf16x8 t = *(const bf16x8*)(Qw + qo + d0 * 16); *(LAS bf16x8*)(qrl + (d0 - 8) * 1024) = t; }
#endif
    }
    f32x16 pA0, pA1, pB0, pB1; float alA, alB; bf16x8 pa0, pa1, pa2, pa3;
    STEP_END();
#if !ATT_STAGGER
    ISSUE_K(1, 1); ISSUE_V(0, 0);
    qkt(pA0, pA1, K_lds, qr, qrl, r32, hi, 0.f); partialSM_first(pA0, pA1, m_reg, alA);
    STEP_END();
    for (int j = 1; j + 1 < NT; j += 2) {
        ISSUE_K(j + 1, 0); ISSUE_V(j, 1);
        SBAR(); qkt(pB0, pB1, K_lds + SHM_K, qr, qrl, r32, hi, -m_reg);
        finishSM(pA0, pA1, alA, l_reg, pa0, pa1, pa2, pa3); SBAR();
        pv_pipe(o, vb0, pa0, pa1, pa2, pa3); partialSM(pB0, pB1, m_reg, alB);
        RESC(alB); STEP_END();
        ISSUE_K(j + 2, 1); ISSUE_V(j + 1, 0);
        SBAR(); qkt(pA0, pA1, K_lds, qr, qrl, r32, hi, -m_reg);
        finishSM(pB0, pB1, alB, l_reg, pa0, pa1, pa2, pa3); SBAR();
        pv_pipe(o, vb0 + SHM_V, pa0, pa1, pa2, pa3); partialSM(pA0, pA1, m_reg, alA);
        RESC(alA); STEP_END();
    }
    ISSUE_V(NT - 1, 1);
    SBAR(); qkt(pB0, pB1, K_lds + SHM_K, qr, qrl, r32, hi, -m_reg);
    finishSM(pA0, pA1, alA, l_reg, pa0, pa1, pa2, pa3); SBAR();
    pv_pipe(o, vb0, pa0, pa1, pa2, pa3); partialSM(pB0, pB1, m_reg, alB);
    RESC(alB); STEP_END();
    finishSM(pB0, pB1, alB, l_reg, pa0, pa1, pa2, pa3); SBAR();
    pv_pipe(o, vb0 + SHM_V, pa0, pa1, pa2, pa3);
#else
#define VOFF(t) (__builtin_amdgcn_readfirstlane(((unsigned)(t) % 3u) * (unsigned)SHM_V))
    if (STG_SEL == 0 ? (wid < 4) : (STG_SEL == 1)) {
        ISSUE_K(1, 1); ISSUE_V(0, 0);
        qkt(pA0, pA1, K_lds, qr, qrl, r32, hi, 0.f); partialSM_first(pA0, pA1, m_reg, alA);
        STEP_END();
        for (int j = 1; j + 1 < NT; j += 2) {
            ISSUE_K(j + 1, 0); ISSUE_V(j, j % 3);
            SBAR(); qkt(pB0, pB1, K_lds + SHM_K, qr, qrl, r32, hi, -m_reg); SBAR();
            finishSM(pA0, pA1, alA, l_reg, pa0, pa1, pa2, pa3); SBAR();
            pv_pipe(o, vb0 + VOFF(j - 1), pa0, pa1, pa2, pa3); partialSM(pB0, pB1, m_reg, alB);
            RESC(alB); STEP_END();
            ISSUE_K(j + 2, 1); ISSUE_V(j + 1, (j + 1) % 3);
            SBAR(); qkt(pA0, pA1, K_lds, qr, qrl, r32, hi, -m_reg); SBAR();
            finishSM(pB0, pB1, alB, l_reg, pa0, pa1, pa2, pa3); SBAR();
            pv_pipe(o, vb0 + VOFF(j), pa0, pa1, pa2, pa3); partialSM(pA0, pA1, m_reg, alA);
            RESC(alA); STEP_END();
        }
        ISSUE_V(NT - 1, (NT - 1) % 3);
        SBAR(); qkt(pB0, pB1, K_lds + SHM_K, qr, qrl, r32, hi, -m_reg); SBAR();
        finishSM(pA0, pA1, alA, l_reg, pa0, pa1, pa2, pa3); SBAR();
        pv_pipe(o, vb0 + VOFF(NT - 2), pa0, pa1, pa2, pa3); partialSM(pB0, pB1, m_reg, alB);
        RESC(alB); STEP_END();
        finishSM(pB0, pB1, alB, l_reg, pa0, pa1, pa2, pa3); SBAR();
        pv_pipe(o, vb0 + VOFF(NT - 1), pa0, pa1, pa2, pa3);
        STEP_END();
        STEP_END();
    } else {
#define TR_EVEN(j_) do { finishSM(pA0, pA1, alA, l_reg, pa0, pa1, pa2, pa3); SBAR(); pv_pipe(o, vb0 + VOFF((j_) - 2), pa0, pa1, pa2, pa3); partialSM(pB0, pB1, m_reg, alB); RESC(alB); } while (0)
#define TR_ODD(j_)  do { finishSM(pB0, pB1, alB, l_reg, pa0, pa1, pa2, pa3); SBAR(); pv_pipe(o, vb0 + VOFF((j_) - 2), pa0, pa1, pa2, pa3); partialSM(pA0, pA1, m_reg, alA); RESC(alA); } while (0)
        ISSUE_K(1, 1); ISSUE_V(0, 0);
        qkt(pA0, pA1, K_lds, qr, qrl, r32, hi, 0.f);
        STEP_END();
        ISSUE_K(2, 0); ISSUE_V(1, 1);
        partialSM_first(pA0, pA1, m_reg, alA);
        SBAR(); qkt(pB0, pB1, K_lds + SHM_K, qr, qrl, r32, hi, -m_reg); SBAR();
        STEP_END();
        for (int j = 2; j + 1 < NT - 1; j += 2) {
            ISSUE_K(j + 1, 1); ISSUE_V(j, j % 3);
            TR_EVEN(j); SBAR(); qkt(pA0, pA1, K_lds, qr, qrl, r32, hi, -m_reg); SBAR();
            STEP_END();
            ISSUE_K(j + 2, 0); ISSUE_V(j + 1, (j + 1) % 3);
            TR_ODD(j + 1); SBAR(); qkt(pB0, pB1, K_lds + SHM_K, qr, qrl, r32, hi, -m_reg); SBAR();
            STEP_END();
        }
        ISSUE_K(NT - 1, 1); ISSUE_V(NT - 2, (NT - 2) % 3);
        TR_EVEN(NT - 2); SBAR(); qkt(pA0, pA1, K_lds, qr, qrl, r32, hi, -m_reg); SBAR();
        STEP_END();
        ISSUE_V(NT - 1, (NT - 1) % 3);
        TR_ODD(NT - 1); SBAR(); qkt(pB0, pB1, K_lds + SHM_K, qr, qrl, r32, hi, -m_reg); SBAR();
        STEP_END();
        TR_EVEN(NT);
        STEP_END();
        finishSM(pB0, pB1, alB, l_reg, pa0, pa1, pa2, pa3); SBAR();
        pv_pipe(o, vb0 + VOFF(NT - 1), pa0, pa1, pa2, pa3);
        STEP_END();
#undef TR_EVEN
#undef TR_ODD
    }
#undef VOFF
#endif
    if (hi == 0) li_l[r32] = l_reg;
    STEP_END();
    { LAS unsigned char* mx = lds + wid * (32 * 272);
      int r32e = r32, hie = hi; asm volatile("" : "+v"(r32e), "+v"(hie));
#pragma unroll
      for (int r = 0; r < 16; ++r) { const int rr = crow(r, hie); const float rli = __builtin_amdgcn_rcpf(li_l[rr]);
#pragma unroll
        for (int d0 = 0; d0 < 4; ++d0) *(LAS bf16*)(mx + rr * 272 + (d0 * 32 + r32e) * 2) = (bf16)(cvtpk(o[d0][r] * rli, 0.f) & 0xffffu); }
      asm volatile("s_waitcnt lgkmcnt(0)" ::: "memory");
      const bf16* Gz = uni(G1 + (size_t)(qrow0 + wid * QBLK) * N_AB + G1_ZA + h * 128); bf16* Co = uni(CC + (size_t)(qrow0 + wid * QBLK) * MIXW + h * 128);
      int le = lane; asm volatile("" : "+v"(le));
#pragma unroll
      for (int i = 0; i < 8; ++i) { const int id = 64 * i + le, row = id >> 4, c8 = (id & 15) * 8;
          const v4u oq = *(const LAS v4u*)(mx + row * 272 + c8 * 2); const v4u zq = LDNT((const v4u*)(Gz + (unsigned)(row * N_AB + c8)));
          v4u wq;
#pragma unroll
          for (int e = 0; e < 4; ++e) wq[e] = cvtpk(bf_lo(oq[e]) * bf_lo(zq[e]), bf_hi(oq[e]) * bf_hi(zq[e]));
          *(v4u*)(Co + (unsigned)(row * MIXW + c8)) = wq;
          if ((i & 3) == 3) asm volatile("" ::: "memory"); } }
#undef TROW
#undef GLDS
#undef ISSUE_K
#undef ISSUE_V
#undef STEP_END
#undef RESC
}
}
namespace att2 {
using namespace att;
struct P8 { f32x4 t[2][4]; };
__device__ __forceinline__ float x16(float x) { return __int_as_float(__builtin_amdgcn_ds_swizzle(__float_as_int(x), 0x401F)); }
__device__ __forceinline__ float rmax4(float x) { x = fmaxf(x, x16(x)); auto rr = __builtin_amdgcn_permlane32_swap(__float_as_uint(x), __float_as_uint(x), false, false); return fmaxf(__uint_as_float(rr[0]), __uint_as_float(rr[1])); }
__device__ __forceinline__ float rsum4(float x) { x = x + x16(x); auto rr = __builtin_amdgcn_permlane32_swap(__float_as_uint(x), __float_as_uint(x), false, false); return __uint_as_float(rr[0]) + __uint_as_float(rr[1]); }
__device__ __forceinline__ float tmax(const P8& p, int qt) { float m = p.t[qt][0][0];
#pragma unroll
    for (int kt = 0; kt < 4; ++kt)
#pragma unroll
        for (int r = 0; r < 4; ++r) m = fmaxf(m, p.t[qt][kt][r]);
    return m; }
__device__ __forceinline__ void qkt2(P8& p, const LAS unsigned char* Ks, const bf16x8 (&qf)[2][4], const LAS unsigned char* qrl, int l16, int g4, float seed0, float seed1) {
#pragma unroll
    for (int kt = 0; kt < 4; ++kt) { p.t[0][kt] = (f32x4){seed0, seed0, seed0, seed0}; p.t[1][kt] = (f32x4){seed1, seed1, seed1, seed1}; }
    const int swn = l16 << 4, swr = ((l16 >> 1) & 7) << 4;
#pragma unroll
    for (int ks = 0; ks < 4; ++ks) { const int cb = (32 * ks + 8 * g4) * 2;
#pragma unroll
        for (int kt = 0; kt < 4; ++kt) { const bf16x8 kf = *(const LAS bf16x8*)(Ks + (16 * kt + l16) * 256 + (cb ^ swn));
            p.t[0][kt] = mfma16(kf, qf[0][ks], p.t[0][kt]); p.t[1][kt] = mfma16(kf, qf[1][ks], p.t[1][kt]); } }
#pragma unroll
    for (int ks = 0; ks < 2; ++ks) { const int cb = (32 * ks + 8 * g4) * 2;
        const bf16x8 q0 = *(const LAS bf16x8*)(qrl + ks * 1024), q1 = *(const LAS bf16x8*)(qrl + (2 + ks) * 1024);
#pragma unroll
        for (int kt = 0; kt < 4; ++kt) { const bf16x8 kf = *(const LAS bf16x8*)(Ks + OFF_KR + (16 * kt + l16) * 128 + (cb ^ swr));
            p.t[0][kt] = mfma16(kf, q0, p.t[0][kt]); p.t[1][kt] = mfma16(kf, q1, p.t[1][kt]); } }
}
__device__ __forceinline__ void sub_all(P8& p, float d0, float d1) {
#pragma unroll
    for (int kt = 0; kt < 4; ++kt) { p.t[0][kt] = p.t[0][kt] - d0; p.t[1][kt] = p.t[1][kt] - d1; } }
__device__ __forceinline__ void exp_half(P8& p, int k0) {
#pragma unroll
    for (int qt = 0; qt < 2; ++qt)
#pragma unroll
        for (int kt = 0; kt < 2; ++kt)
#pragma unroll
            for (int r = 0; r < 4; ++r) p.t[qt][k0 + kt][r] = __builtin_amdgcn_exp2f(p.t[qt][k0 + kt][r]); }
__device__ __forceinline__ void partial2_first(P8& p, float& m0, float& m1, float& a0, float& a1) {
    m0 = rmax4(tmax(p, 0)); m1 = rmax4(tmax(p, 1)); a0 = 1.f; a1 = 1.f; sub_all(p, m0, m1); exp_half(p, 0); }
__device__ __forceinline__ void partial2(P8& p, float& m0, float& m1, float& a0, float& a1) {
    const float x0 = rmax4(tmax(p, 0)), x1 = rmax4(tmax(p, 1));
    if (__builtin_expect(__all(fmaxf(x0, x1) <= THRL), 1)) { a0 = 1.f; a1 = 1.f; }
    else { const float d0 = fmaxf(x0, 0.f), d1 = fmaxf(x1, 0.f); a0 = __builtin_amdgcn_exp2f(-d0); a1 = __builtin_amdgcn_exp2f(-d1); m0 += d0; m1 += d1; sub_all(p, d0, d1); }
    exp_half(p, 0); }
__device__ __forceinline__ void finish2(P8& p, float a0, float a1, float& l0, float& l1, bf16x8 (&pb)[2][2]) {
    exp_half(p, 2);
    float s0 = 0.f, s1 = 0.f;
#pragma unroll
    for (int kt = 0; kt < 4; ++kt)
#pragma unroll
        for (int r = 0; r < 4; ++r) { s0 += p.t[0][kt][r]; s1 += p.t[1][kt][r]; }
    l0 = l0 * a0 + rsum4(s0); l1 = l1 * a1 + rsum4(s1);
#pragma unroll
    for (int qt = 0; qt < 2; ++qt)
#pragma unroll
        for (int s2 = 0; s2 < 2; ++s2) { v4u w; w.x = cvtpk(p.t[qt][2 * s2][0], p.t[qt][2 * s2][1]); w.y = cvtpk(p.t[qt][2 * s2][2], p.t[qt][2 * s2][3]);
            w.z = cvtpk(p.t[qt][2 * s2 + 1][0], p.t[qt][2 * s2 + 1][1]); w.w = cvtpk(p.t[qt][2 * s2 + 1][2], p.t[qt][2 * s2 + 1][3]); pb[qt][s2] = __builtin_bit_cast(bf16x8, w); }
}
template <int B, int I> __device__ __forceinline__ void pv2_rd(const int (&vo)[8], s16x4& lo, s16x4& hi) { constexpr int s2 = I >> 3, vt = I & 7;
    lo = tr_read<B * SHM_V + s2 * 8192>(vo[vt]); hi = tr_read<B * SHM_V + s2 * 8192 + 4096>(vo[vt]); }
#define PV2_MM(I, L, H) do { const bf16x8 af_ = (bf16x8){L[0], L[1], L[2], L[3], H[0], H[1], H[2], H[3]}; \
    o[(I) & 7][0] = mfma16(af_, pb[0][(I) >> 3], o[(I) & 7][0]); o[(I) & 7][1] = mfma16(af_, pb[1][(I) >> 3], o[(I) & 7][1]); } while (0)
#define PV2_W(N) do { asm volatile("s_waitcnt lgkmcnt(" #N ")" ::: "memory"); SBAR(); } while (0)
template <int B> __device__ __forceinline__ void pv2(f32x4 (&o)[8][2], const int (&vo)[8], const bf16x8 (&pb)[2][2]) {
    s16x4 l0, h0, l1, h1, l2, h2;
    asm volatile("s_waitcnt lgkmcnt(0)" ::: "memory"); SBAR();
    pv2_rd<B, 0>(vo, l0, h0); pv2_rd<B, 1>(vo, l1, h1); pv2_rd<B, 2>(vo, l2, h2);
    PV2_W(4); PV2_MM(0, l0, h0); SBAR(); pv2_rd<B, 3>(vo, l0, h0);
    PV2_W(4); PV2_MM(1, l1, h1); SBAR(); pv2_rd<B, 4>(vo, l1, h1);
    PV2_W(4); PV2_MM(2, l2, h2); SBAR(); pv2_rd<B, 5>(vo, l2, h2);
    PV2_W(4); PV2_MM(3, l0, h0); SBAR(); pv2_rd<B, 6>(vo, l0, h0);
    PV2_W(4); PV2_MM(4, l1, h1); SBAR(); pv2_rd<B, 7>(vo, l1, h1);
    PV2_W(4); PV2_MM(5, l2, h2); SBAR(); pv2_rd<B, 8>(vo, l2, h2);
    PV2_W(4); PV2_MM(6, l0, h0); SBAR(); pv2_rd<B, 9>(vo, l0, h0);
    PV2_W(4); PV2_MM(7, l1, h1); SBAR(); pv2_rd<B, 10>(vo, l1, h1);
    PV2_W(4); PV2_MM(8, l2, h2); SBAR(); pv2_rd<B, 11>(vo, l2, h2);
    PV2_W(4); PV2_MM(9, l0, h0); SBAR(); pv2_rd<B, 12>(vo, l0, h0);
    PV2_W(4); PV2_MM(10, l1, h1); SBAR(); pv2_rd<B, 13>(vo, l1, h1);
    PV2_W(4); PV2_MM(11, l2, h2); SBAR(); pv2_rd<B, 14>(vo, l2, h2);
    PV2_W(4); PV2_MM(12, l0, h0); SBAR(); pv2_rd<B, 15>(vo, l0, h0);
    PV2_W(4); PV2_MM(13, l1, h1);
    PV2_W(2); PV2_MM(14, l2, h2);
    PV2_W(0); PV2_MM(15, l0, h0);
}
__device__ __forceinline__ void attn_unit2(const bf16* __restrict__ Q, const bf16* __restrict__ KN, const bf16* __restrict__ KR, const bf16* __restrict__ V, const bf16* __restrict__ G1, bf16* __restrict__ CC,
                                           int qrow0, int h, int nt_lat, int lat0, int ctx0, LAS unsigned char* lds) {
    int tid_l = threadIdx.x; asm volatile("" : "+v"(tid_l)); const int tid = tid_l, wid = __builtin_amdgcn_readfirstlane(tid >> 6), lane = tid & 63, l16 = lane & 15, g4 = lane >> 4;
    LAS unsigned char* V_lds = lds + OFF_V; LAS unsigned char* K_lds = lds + OFF_K;
    LAS unsigned char* qrl = lds + OFF_QR + wid * 4096 + lane * 16;
    float m0 = 0.f, m1 = 0.f, l0 = 0.f, l1 = 0.f;
    f32x4 o[8][2];
#pragma unroll
    for (int vt = 0; vt < 8; ++vt) { o[vt][0] = (f32x4){0.f, 0.f, 0.f, 0.f}; o[vt][1] = (f32x4){0.f, 0.f, 0.f, 0.f}; }
    const unsigned ko = (unsigned)((tid >> 4) * 128 + (((tid & 15) ^ ((tid >> 4) & 15)) * 8));
    const unsigned kro = (unsigned)((tid >> 3) * 64 + (((tid & 7) ^ ((tid >> 4) & 7)) * 8));
    const unsigned vo_g = (unsigned)((tid >> 4) * 128 + ((((((tid & 15) >> 1) ^ ((tid >> 4) & 7)) << 1) | (tid & 1)) * 8));
    int vo[8];
    { const int q = l16 >> 2, pp = l16 & 3, rr = 4 * g4 + q, sw = rr & 7, base = (int)(unsigned)(unsigned long long)lds + OFF_V + rr * 256 + 8 * pp;
#pragma unroll
      for (int vt = 0; vt < 8; ++vt) vo[vt] = base + ((vt ^ sw) << 5); }
    const int NT = nt_lat + 4;
#define TROW(jt) ((jt) < nt_lat ? lat0 + 64 * (jt) : ctx0 + 64 * ((jt) - nt_lat))
#define GLDS(gp, lp) __builtin_amdgcn_global_load_lds((const unsigned*)(gp), (LAS unsigned*)(lp), 16, 0, 0)
#define ISSUE_K(jt, b) do { const int R0_ = TROW(jt); const bf16* Kb_ = uni(KN + ((size_t)h * MTOT + R0_) * 128); const bf16* Rb_ = uni(KR + (size_t)R0_ * 64); \
    GLDS(Kb_ + ko, K_lds + (b) * SHM_K + wid * 1024); GLDS(Kb_ + ko + 32 * 128, K_lds + (b) * SHM_K + (wid + 8) * 1024); GLDS(Rb_ + kro, K_lds + (b) * SHM_K + OFF_KR + wid * 1024); } while (0)
#define ISSUE_V(jt, b) do { const int R0_ = TROW(jt); const bf16* Vb_ = uni(V + ((size_t)h * MTOT + R0_) * 128); \
    GLDS(Vb_ + vo_g, V_lds + (b) * SHM_V + wid * 1024); GLDS(Vb_ + vo_g + 32 * 128, V_lds + (b) * SHM_V + (wid + 8) * 1024); } while (0)
#define STEP_END() asm volatile("s_waitcnt vmcnt(0) lgkmcnt(0)\n\ts_barrier" ::: "memory")
#define RESC2(a0_, a1_) do { if (__any(fminf(a0_, a1_) < 1.f)) { _Pragma("unroll") for (int vt = 0; vt < 8; ++vt) { o[vt][0] = o[vt][0] * (a0_); o[vt][1] = o[vt][1] * (a1_); } } } while (0)
    STEP_END();
    ISSUE_K(0, 0);
    bf16x8 qf[2][4];
    { const bf16* Qw = uni(Q + (size_t)(qrow0 + wid * QBLK) * NQ + h * 192); const unsigned qo = (unsigned)(l16 * NQ + g4 * 8);
#pragma unroll
      for (int qt = 0; qt < 2; ++qt) {
#pragma unroll
        for (int ks = 0; ks < 4; ++ks) qf[qt][ks] = *(const bf16x8*)(Qw + qo + (unsigned)(qt * 16 * NQ + ks * 32));
#pragma unroll
        for (int ks = 4; ks < 6; ++ks) { const bf16x8 t = *(const bf16x8*)(Qw + qo + (unsigned)(qt * 16 * NQ + ks * 32)); *(LAS bf16x8*)(qrl + (qt * 2 + ks - 4) * 1024) = t; } } }
    P8 pA, pB; float aA0, aA1, aB0, aB1; bf16x8 pb[2][2];
    STEP_END();
    ISSUE_K(1, 1); ISSUE_V(0, 0);
    qkt2(pA, K_lds, qf, qrl, l16, g4, 0.f, 0.f); partial2_first(pA, m0, m1, aA0, aA1);
    STEP_END();
    for (int j = 1; j + 1 < NT; j += 2) {
        ISSUE_K(j + 1, 0); ISSUE_V(j, 1);
        SBAR(); qkt2(pB, K_lds + SHM_K, qf, qrl, l16, g4, -m0, -m1);
        finish2(pA, aA0, aA1, l0, l1, pb); SBAR();
        pv2<0>(o, vo, pb); partial2(pB, m0, m1, aB0, aB1);
        RESC2(aB0, aB1); STEP_END();
        ISSUE_K(j + 2, 1); ISSUE_V(j + 1, 0);
        SBAR(); qkt2(pA, K_lds, qf, qrl, l16, g4, -m0, -m1);
        finish2(pB, aB0, aB1, l0, l1, pb); SBAR();
        pv2<1>(o, vo, pb); partial2(pA, m0, m1, aA0, aA1);
        RESC2(aA0, aA1); STEP_END();
    }
    ISSUE_V(NT - 1, 1);
    SBAR(); qkt2(pB, K_lds + SHM_K, qf, qrl, l16, g4, -m0, -m1);
    finish2(pA, aA0, aA1, l0, l1, pb); SBAR();
    pv2<0>(o, vo, pb); partial2(pB, m0, m1, aB0, aB1);
    RESC2(aB0, aB1); STEP_END();
    finish2(pB, aB0, aB1, l0, l1, pb); SBAR();
    pv2<1>(o, vo, pb);
    STEP_END();
    { LAS unsigned char* mx = lds + wid * (32 * 272);
      const float r0 = __builtin_amdgcn_rcpf(l0), r1 = __builtin_amdgcn_rcpf(l1);
#pragma unroll
      for (int vt = 0; vt < 8; ++vt) { u32x2 w;
          w.x = cvtpk(o[vt][0][0] * r0, o[vt][0][1] * r0); w.y = cvtpk(o[vt][0][2] * r0, o[vt][0][3] * r0); *(LAS u32x2*)(mx + l16 * 272 + (16 * vt + 4 * g4) * 2) = w;
          w.x = cvtpk(o[vt][1][0] * r1, o[vt][1][1] * r1); w.y = cvtpk(o[vt][1][2] * r1, o[vt][1][3] * r1); *(LAS u32x2*)(mx + (16 + l16) * 272 + (16 * vt + 4 * g4) * 2) = w; }
      asm volatile("s_waitcnt lgkmcnt(0)" ::: "memory");
      const bf16* Gz = uni(G1 + (size_t)(qrow0 + wid * QBLK) * N_AB + G1_ZA + h * 128); bf16* Co = uni(CC + (size_t)(qrow0 + wid * QBLK) * MIXW + h * 128);
      int le = lane; asm volatile("" : "+v"(le));
#pragma unroll
      for (int i = 0; i < 8; ++i) { const int id = 64 * i + le, row = id >> 4, c8 = (id & 15) * 8;
          const v4u oq = *(const LAS v4u*)(mx + row * 272 + c8 * 2); const v4u zq = LDNT((const v4u*)(Gz + (unsigned)(row * N_AB + c8)));
          v4u wq;
#pragma unroll
          for (int e = 0; e < 4; ++e) wq[e] = cvtpk(bf_lo(oq[e]) * bf_lo(zq[e]), bf_hi(oq[e]) * bf_hi(zq[e]));
          *(v4u*)(Co + (unsigned)(row * MIXW + c8)) = wq;
          if ((i & 3) == 3) asm volatile("" ::: "memory"); } }
#undef TROW
#undef GLDS
#undef ISSUE_K
#undef ISSUE_V
#undef STEP_END
#undef RESC2
}
#undef PV2_MM
#undef PV2_W
}
#ifndef ATT_PRIO
#define ATT_PRIO 1
#endif
#ifndef ATT_BODY2
#define ATT_BODY2 0
#endif
__device__ __forceinline__ void attn_phase(KArgs a, LAS unsigned char* lds, int G) {
    const bf16* Q = (const bf16*)(GWS(a) + WS_Q); const bf16* KN = (const bf16*)(GWS(a) + WS_KN); const bf16* KR = (const bf16*)(GWS(a) + WS_KR); const bf16* V = (const bf16*)(GWS(a) + WS_V);
    const bf16* G1 = (const bf16*)(GWS(a) + WS_G1); bf16* CC = (bf16*)(GWS(a) + WS_CC);
    const int bx = blockIdx.x; const int vcu = (G % 8 == 0) ? (bx % 8) * (G / 8) + bx / 8 : bx;
    if (ATT_PRIO && __builtin_amdgcn_readfirstlane(threadIdx.x >> 6) >= 4) __builtin_amdgcn_s_setprio(1);
    for (int u = vcu; u < 2048 + 64; u += G) {
        if (u < 2048) { const int bh = u >> 5, qb = u & 31, b = bh >> 5, h = bh & 31;
            if (ATT_BODY2) att2::attn_unit2(Q, KN, KR, V, G1, CC, b * SEQ + qb * 256, h, 128, b * SEQ, MLAT + b * NCTX, lds); else att::attn_unit(Q, KN, KR, V, G1, CC, b * SEQ + qb * 256, h, 128, b * SEQ, MLAT + b * NCTX, lds); }
        else { const int bh = u - 2048, b = bh >> 5, h = bh & 31;
            if (ATT_BODY2) att2::attn_unit2(Q, KN, KR, V, G1, CC, MLAT + b * NCTX, h, 0, 0, MLAT + b * NCTX, lds); else att::attn_unit(Q, KN, KR, V, G1, CC, MLAT + b * NCTX, h, 0, 0, MLAT + b * NCTX, lds); }
    }
    if (ATT_PRIO) __builtin_amdgcn_s_setprio(0);
    __syncthreads();
}

__device__ __forceinline__ s16x4 tr_read_v(int addr) { s16x4 r; asm volatile("ds_read_b64_tr_b16 %0, %1" : "=&v"(r) : "v"(addr) : "memory"); return r; }
template <int CTRL> __device__ __forceinline__ float dpp_f(float x) { return __int_as_float(__builtin_amdgcn_update_dpp(0, __float_as_int(x), CTRL, 0xf, 0xf, true)); }
constexpr int SC_PITCH = 288;
constexpr int SC_QD = 0, SC_KD = 16 * SC_PITCH, SC_KE = 32 * SC_PITCH, SC_VV = 48 * SC_PITCH, SC_EB = 64 * SC_PITCH, SC_BUF = SC_EB + 512;
constexpr int SC_OST = 4 * SC_BUF;
__device__ __forceinline__ void scan_stage(LAS unsigned char* B, u32x2 rq, u32x2 rk, u32x2 rv, int wid, int lane, int tid) {
    const int t = lane & 15, kq = lane >> 4;
    float q[4], kk[4], x[4], tot[4];
    q[0] = bf_lo(rq.x); q[1] = bf_hi(rq.x); q[2] = bf_lo(rq.y); q[3] = bf_hi(rq.y); kk[0] = bf_lo(rk.x); kk[1] = bf_hi(rk.x); kk[2] = bf_lo(rk.y); kk[3] = bf_hi(rk.y);
#pragma unroll
    for (int e = 0; e < 4; ++e) { x[e] = __builtin_amdgcn_logf(fmaxf(1.0f - kk[e], 1e-30f)); tot[e] = x[e]; }
#define SC_DPP8(cg_, cs_) \
        "v_add_f32_dpp %0, %0, %0 " cg_ " row_mask:0xf bank_mask:0xf bound_ctrl:0\n\tv_add_f32_dpp %1, %1, %1 " cg_ " row_mask:0xf bank_mask:0xf bound_ctrl:0\n\t" \
        "v_add_f32_dpp %2, %2, %2 " cg_ " row_mask:0xf bank_mask:0xf bound_ctrl:0\n\tv_add_f32_dpp %3, %3, %3 " cg_ " row_mask:0xf bank_mask:0xf bound_ctrl:0\n\t" \
        "v_add_f32_dpp %4, %4, %4 " cs_ " row_mask:0xf bank_mask:0xf\n\tv_add_f32_dpp %5, %5, %5 " cs_ " row_mask:0xf bank_mask:0xf\n\t" \
        "v_add_f32_dpp %6, %6, %6 " cs_ " row_mask:0xf bank_mask:0xf\n\tv_add_f32_dpp %7, %7, %7 " cs_ " row_mask:0xf bank_mask:0xf\n\t"
    asm volatile("s_nop 1\n\t" SC_DPP8("row_shr:1", "row_ror:8") SC_DPP8("row_shr:2", "row_ror:4") SC_DPP8("row_shr:4", "row_ror:2") SC_DPP8("row_shr:8", "row_ror:1")
                 : "+v"(x[0]), "+v"(x[1]), "+v"(x[2]), "+v"(x[3]), "+v"(tot[0]), "+v"(tot[1]), "+v"(tot[2]), "+v"(tot[3]));
#undef SC_DPP8
    float qd[4], kd[4], ke[4];
#pragma unroll
    for (int e = 0; e < 4; ++e) { qd[e] = q[e] * __builtin_amdgcn_exp2f(x[e]); kd[e] = kk[e] * __builtin_amdgcn_exp2f(fminf(-x[e], 115.0f)); ke[e] = kk[e] * __builtin_amdgcn_exp2f(fminf(tot[e] - x[e], 0.0f)); }
    const int ppos = 32 * (wid >> 1) + 8 * kq + 4 * (wid & 1);
    u32x2 w;
    w.x = cvtpk(qd[0], qd[1]); w.y = cvtpk(qd[2], qd[3]); *(LAS u32x2*)(B + SC_QD + t * SC_PITCH + ppos * 2) = w;
    w.x = cvtpk(kd[0], kd[1]); w.y = cvtpk(kd[2], kd[3]); *(LAS u32x2*)(B + SC_KD + t * SC_PITCH + ppos * 2) = w;
    w.x = cvtpk(ke[0], ke[1]); w.y = cvtpk(ke[2], ke[3]); *(LAS u32x2*)(B + SC_KE + t * SC_PITCH + (16 * wid + 4 * kq) * 2) = w;
    if (t == 0) *(LAS f32x4*)(B + SC_EB + (16 * wid + 4 * kq) * 4) = (f32x4){__builtin_amdgcn_exp2f(tot[0]), __builtin_amdgcn_exp2f(tot[1]), __builtin_amdgcn_exp2f(tot[2]), __builtin_amdgcn_exp2f(tot[3])};
    *(LAS u32x2*)(B + SC_VV + (tid >> 5) * SC_PITCH + (tid & 31) * 8) = rv;
}
__device__ __forceinline__ void scan_phase(KArgs a, LAS unsigned char* lds, int G) {
    int tid_l = threadIdx.x; asm volatile("" : "+v"(tid_l)); const int tid = tid_l, lane = tid & 63, wid = __builtin_amdgcn_readfirstlane(tid >> 6), g4 = lane >> 4, l16 = lane & 15;
    const bf16* G1 = (const bf16*)(GWS(a) + WS_G1); const size_t TS = (size_t)MTOT * MIXW;
    const int ldsb = (int)(unsigned)(unsigned long long)lds;
    const int trq = l16 >> 2, trp = l16 & 3;
    const int st = lane & 15, sk = 16 * wid + 4 * (lane >> 4);
    const int vt_ = tid >> 5, vc = (tid & 31) * 4;
    for (int sq = blockIdx.x; sq < 256; sq += G) {
        const int dir = sq >> 7, b = (sq >> 6) & 1, h = sq & 63;
        const bf16* Tq = G1 + h * 128; const bf16* Tk = G1 + (size_t)(1 + dir) * TS + h * 128; const bf16* Tv = G1 + (size_t)3 * TS + h * 128;
        bf16* Od = (bf16*)(GWS(a) + WS_OF) + (size_t)dir * TS + h * 128;
        const unsigned oq = (unsigned)((dir ? 15 - st : st) * MIXW + sk), ovv = (unsigned)((dir ? 15 - vt_ : vt_) * MIXW + vc);
#define CLOW(c_) ((c_) < 16 ? MLAT + b * NCTX + (dir ? 240 - 16 * (c_) : 16 * (c_)) : b * SEQ + (dir ? 8432 - 16 * (c_) : 16 * (c_) - 256))
#define SLOADC(c_, rq_, rk_, rv_) do { const size_t lo_ = (size_t)CLOW(c_) * MIXW; rq_ = LDNT((const u32x2*)(uni(Tq + lo_) + oq)); rk_ = LDNT((const u32x2*)(uni(Tk + lo_) + oq)); rv_ = LDNT((const u32x2*)(uni(Tv + lo_) + ovv)); } while (0)
#define SBARRIER() do { asm volatile("s_waitcnt lgkmcnt(0)" ::: "memory"); __builtin_amdgcn_s_barrier(); asm volatile("" ::: "memory"); } while (0)
        f32x4 S[8];
#pragma unroll
        for (int i = 0; i < 8; ++i) S[i] = (f32x4){0.f, 0.f, 0.f, 0.f};
        u32x2 rq0, rk0, rv0, rq1, rk1, rv1;
        SBARRIER();
        SLOADC(0, rq0, rk0, rv0); SLOADC(1, rq1, rk1, rv1);
        scan_stage(lds, rq0, rk0, rv0, wid, lane, tid); scan_stage(lds + SC_BUF, rq1, rk1, rv1, wid, lane, tid);
        SLOADC(2, rq0, rk0, rv0); SLOADC(3, rq1, rk1, rv1);
        SBARRIER();
        auto mstage = [&](const int bi) __attribute__((always_inline)) {
            LAS unsigned char* Bc = lds + bi * SC_BUF;
            bf16x8 qf[4], kf[4]; f32x4 e4[8]; s16x4 kt4[8];
#pragma unroll
            for (int ks = 0; ks < 4; ++ks) { qf[ks] = *(const LAS bf16x8*)(Bc + SC_QD + l16 * SC_PITCH + (32 * ks + 8 * g4) * 2); kf[ks] = *(const LAS bf16x8*)(Bc + SC_KD + l16 * SC_PITCH + (32 * ks + 8 * g4) * 2); }
            const int trb = ldsb + bi * SC_BUF + (4 * g4 + trq) * SC_PITCH + 8 * trp;
            const s16x4 vt = tr_read_v(trb + SC_VV + 32 * wid);
#pragma unroll
            for (int kt = 0; kt < 8; ++kt) { e4[kt] = *(const LAS f32x4*)(Bc + SC_EB + (16 * kt + 4 * g4) * 4); kt4[kt] = tr_read_v(trb + SC_KE + 32 * kt); }
            f32x4 at = (f32x4){0.f, 0.f, 0.f, 0.f};
#pragma unroll
            for (int ks = 0; ks < 4; ++ks) at = mfma16(kf[ks], qf[ks], at);
#pragma unroll
            for (int r = 0; r < 4; ++r) at[r] = (4 * g4 + r <= l16) ? at[r] : 0.f;
            bf16x8 pa; { v4u w; w.x = cvtpk(at[0], at[1]); w.y = cvtpk(at[2], at[3]); w.z = 0u; w.w = 0u; pa = __builtin_bit_cast(bf16x8, w); }
            f32x4 o = (f32x4){0.f, 0.f, 0.f, 0.f};
#pragma unroll
            for (int ks = 0; ks < 4; ++ks) { v4u w; w.x = cvtpk(S[2 * ks][0], S[2 * ks][1]); w.y = cvtpk(S[2 * ks][2], S[2 * ks][3]); w.z = cvtpk(S[2 * ks + 1][0], S[2 * ks + 1][1]); w.w = cvtpk(S[2 * ks + 1][2], S[2 * ks + 1][3]);
                o = mfma16(qf[ks], __builtin_bit_cast(bf16x8, w), o); }
            asm volatile("s_waitcnt lgkmcnt(0)" ::: "memory"); SBAR();
            const bf16x8 vf = (bf16x8){vt[0], vt[1], vt[2], vt[3], 0, 0, 0, 0};
            o = mfma16(pa, vf, o);
#pragma unroll
            for (int kt = 0; kt < 8; ++kt) { const bf16x8 kef = (bf16x8){kt4[kt][0], kt4[kt][1], kt4[kt][2], kt4[kt][3], 0, 0, 0, 0};
                S[kt] = mfma16(kef, vf, S[kt] * e4[kt]); }
            { LAS bf16* ost = (LAS bf16*)(lds + SC_OST + bi * 4096);
#pragma unroll
              for (int r = 0; r < 4; ++r) ost[(4 * g4 + r) * 128 + 16 * wid + l16] = (bf16)(cvtpk(o[r], 0.f) & 0xffffu); }
        };
        auto ostore = [&](const int c, const int bi) __attribute__((always_inline)) {
            const u32x2 ov = *(const LAS u32x2*)(lds + SC_OST + bi * 4096 + vt_ * 256 + vc * 2); *(u32x2*)(uni(Od + (size_t)CLOW(c) * MIXW) + ovv) = ov; };
        auto pairit = [&](const int pp, const int par) __attribute__((always_inline)) {
            const int c0 = 2 * pp;
            if (pp > 0) { ostore(c0 - 2, 2 * (par ^ 1)); ostore(c0 - 1, 2 * (par ^ 1) + 1); }
            if (pp + 1 < 264) { scan_stage(lds + (2 * (par ^ 1)) * SC_BUF, rq0, rk0, rv0, wid, lane, tid); scan_stage(lds + (2 * (par ^ 1) + 1) * SC_BUF, rq1, rk1, rv1, wid, lane, tid);
                SLOADC(min(c0 + 4, 527), rq0, rk0, rv0); SLOADC(min(c0 + 5, 527), rq1, rk1, rv1); }
            mstage(2 * par); mstage(2 * par + 1);
            SBARRIER();
        };
        for (int pp = 0; pp < 264; pp += 2) { pairit(pp, 0); pairit(pp + 1, 1); }
        ostore(526, 2); ostore(527, 3);
#undef CLOW
#undef SLOADC
#undef SBARRIER
    }
    asm volatile("s_waitcnt lgkmcnt(0)" ::: "memory"); __builtin_amdgcn_s_barrier(); asm volatile("" ::: "memory");
}

__device__ __forceinline__ void readout_phase(KArgs a, int jc, int nrows, int G) {
    int tid_l = threadIdx.x; asm volatile("" : "+v"(tid_l)); const int tid = tid_l, lane = tid & 63, wave = __builtin_amdgcn_readfirstlane(tid >> 6);
    const int gw = blockIdx.x * NWAVES + wave, NGW = G * NWAVES;
    const size_t TS = (size_t)MTOT * MIXW;
    const bf16* OFp = (const bf16*)(GWS(a) + WS_OF); const bf16* OBp = OFp + TS; const bf16* GS = (const bf16*)(GWS(a) + WS_G1) + 4 * TS; bf16* CC = (bf16*)(GWS(a) + WS_CC);
    const float* gnw = GIN(a, 20) + (size_t)jc * 128 + (lane & 15) * 8;
    const f32x4 w0 = *(const f32x4*)gnw, w1 = *(const f32x4*)(gnw + 4);
    for (int it = gw; it < nrows * 16; it += NGW) {
        const size_t off = (size_t)(it >> 4) * MIXW + (it & 15) * 512 + lane * 8;
        const v4u f = LDNT((const v4u*)(OFp + off)), bq = LDNT((const v4u*)(OBp + off)), gq = LDNT((const v4u*)(GS + off));
        float o[8], gg[8];
#pragma unroll
        for (int e = 0; e < 4; ++e) { o[2 * e] = bf_lo(f[e]) + bf_lo(bq[e]); o[2 * e + 1] = bf_hi(f[e]) + bf_hi(bq[e]); gg[2 * e] = bf_lo(gq[e]); gg[2 * e + 1] = bf_hi(gq[e]); }
        float ss = 0.f;
#pragma unroll
        for (int e = 0; e < 8; ++e) ss += o[e] * o[e];
        ss += __shfl_xor(ss, 1); ss += __shfl_xor(ss, 2); ss += __shfl_xor(ss, 4); ss += __shfl_xor(ss, 8);
        const float r = 1.0f / sqrtf(ss * (1.0f / 128.0f) + EPS);
        v4u w; w.x = cvtpk(o[0] * r * w0[0] * gg[0], o[1] * r * w0[1] * gg[1]); w.y = cvtpk(o[2] * r * w0[2] * gg[2], o[3] * r * w0[3] * gg[3]);
        w.z = cvtpk(o[4] * r * w1[0] * gg[4], o[5] * r * w1[1] * gg[5]); w.w = cvtpk(o[6] * r * w1[2] * gg[6], o[7] * r * w1[3] * gg[7]);
        *(v4u*)(CC + off) = w;
    }
}

#ifndef EN_P0
#define EN_P0 1
#endif
#ifndef EN_NORM
#define EN_NORM 1
#endif
#ifndef EN_A1
#define EN_A1 1
#endif
#ifndef EN_A2
#define EN_A2 1
#endif
#ifndef EN_A3
#define EN_A3 1
#endif
#ifndef EN_ATT
#define EN_ATT 1
#endif
#ifndef EN_A5
#define EN_A5 1
#endif
#ifndef EN_C1
#define EN_C1 1
#endif
#ifndef EN_SCAN
#define EN_SCAN 1
#endif
#ifndef EN_RO
#define EN_RO 1
#endif
#ifndef EN_C4
#define EN_C4 1
#endif
#ifndef EN_SGU
#define EN_SGU 1
#endif
#ifndef EN_QUP
#define EN_QUP 1
#endif
#ifndef EN_KVUP
#define EN_KVUP 1
#endif
#ifndef PG8_ALIGNV
#define PG8_ALIGNV true
#endif
#ifndef PG8_SP2V
#define PG8_SP2V true
#endif
#ifndef PROBE_MASK
#define PROBE_MASK 0u
#endif
#define REPS(k) for (int rep_ = 0; rep_ < ((((PROBE_MASK) >> (k)) & 1u) ? 2 : 1); ++rep_)
#ifndef MK_ONE_LAUNCH
#define MK_ONE_LAUNCH 1
#endif
constexpr int N_PHASES = 28;
#define IN(k) (lo <= (k) && (k) < hi)
#define SEAM(k) do { if (IN(k) && IN((k) + 1)) xcd_barrier(bar); } while (0)
template <int p> __device__ __forceinline__ void layer_pair(LAS unsigned char* lds, const int G, const int lo, const int hi, const XcdBarrier& bar) {

        const int pb = 2 + 13 * p, lab = 2 * p, lc = 2 * p + 1;
        if (EN_A1 && IN(pb + 0)) REPS(pb + 0) {
            KArgs A = kargs(); unsigned char* const wsb = GWS(A);
            pg8::Gemm g{(const pg8::bf16_t*)(wsb + WS_H), (const pg8::bf16_t*)(wsb + WS_WIN_AB) + (size_t)p * N_AB * DM, MTOT, N_AB, DM, DM}; pg8::LockstepOrder S; S.init(MTOT, N_AB, G, (int)blockIdx.x);
            pg8::EpiAB1 E{(pg8::bf16_t*)(wsb + WS_G1), N_AB};
            pg8::gemm_phase<pg8::EpiAB1, pg8::LockstepOrder, PG8_ALIGNV, PG8_SP2V>(lds, g, S, E);
            if (p0_defer_on(G)) { pg8::LockstepOrder S2; S2.init(MTOT, N_AB, G, (int)blockIdx.x); p0_deferred(kargs(), lds, S2, p == 0 ? 0 : 2); }
        } SEAM(pb + 0);
        if (EN_A2 && IN(pb + 1)) REPS(pb + 1) { a2_rows(kargs(), p, G); } SEAM(pb + 1);
        if (EN_SGU && IN(pb + 2)) REPS(pb + 2) { sgu_phase(kargs(), p, lds, G); }
        if (EN_QUP && IN(pb + 3)) REPS(pb + 3) {
            KArgs A = kargs(); unsigned char* const wsb = GWS(A);
            pg8::Gemm g{(const pg8::bf16_t*)(wsb + WS_QN), (const pg8::bf16_t*)(wsb + WS_WQ) + (size_t)p * NQ * QL, MTOT, NQ, QL, QL}; pg8::LockstepOrder S; S.init(MTOT, NQ, G, (int)blockIdx.x);
            pg8::EpiQ E{(pg8::bf16_t*)(wsb + WS_Q), (const pg8::f32x2*)(wsb + WS_ROPE), MLAT, 0.07216878364870322f * 1.4426950408889634f};
            pg8::gemm_phase<pg8::EpiQ, pg8::LockstepOrder, PG8_ALIGNV, PG8_SP2V>(lds, g, S, E);
        }
        if (EN_KVUP && IN(pb + 4)) REPS(pb + 4) {
            KArgs A = kargs(); unsigned char* const wsb = GWS(A);
            pg8::Gemm g{(const pg8::bf16_t*)(wsb + WS_KVN), (const pg8::bf16_t*)(wsb + WS_WKV) + (size_t)p * NKV * KVL, MTOT, NKV, KVL, KVL}; pg8::LockstepOrder S; S.init(MTOT, NKV, G, (int)((blockIdx.x + 64u) % (unsigned)G));
            pg8::EpiKV E{(pg8::bf16_t*)(wsb + WS_KN), (pg8::bf16_t*)(wsb + WS_V), MTOT};
            pg8::gemm_phase<pg8::EpiKV, pg8::LockstepOrder, PG8_ALIGNV, PG8_SP2V>(lds, g, S, E);
        } SEAM(pb + 4);
        if (EN_ATT && IN(pb + 5)) REPS(pb + 5) { attn_phase(kargs(), lds, G); } SEAM(pb + 5);
        if (EN_A5 && IN(pb + 6)) REPS(pb + 6) {
            KArgs A = kargs(); unsigned char* const wsb = GWS(A);
            { pg8::Gemm g{(const pg8::bf16_t*)(wsb + WS_CC), (const pg8::bf16_t*)(wsb + WS_WO_AB) + (size_t)p * DM * MIXW, MLAT, DM, MIXW, MIXW}; pg8::LockstepOrder S; S.init(MLAT, DM, G, (int)blockIdx.x);
              pg8::EpiBf16P E{(pg8::bf16_t*)(wsb + WS_Y), DM};
              pg8::gemm_phase<pg8::EpiBf16P, pg8::LockstepOrder, PG8_ALIGNV, PG8_SP2V>(lds, g, S, E); }
            { pg8::Gemm g{(const pg8::bf16_t*)(wsb + WS_CC) + (size_t)MLAT * MIXW, (const pg8::bf16_t*)(wsb + WS_WO_AB) + (size_t)p * DM * MIXW, MTOT - MLAT, DM, MIXW / 8, MIXW}; pg8::SplitKOrder S; S.init(MTOT - MLAT, DM, 8, G, (int)blockIdx.x);
              pg8::EpiF32 E{(float*)(wsb + WS_YP), DM, (size_t)(MTOT - MLAT) * DM};
              pg8::gemm_phase<pg8::EpiF32, pg8::SplitKOrder, PG8_ALIGNV, PG8_SP2V>(lds, g, S, E); }
        } SEAM(pb + 6);
        if (EN_NORM && IN(pb + 7)) REPS(pb + 7) { norm_phase(kargs(), lab, lc, G); } SEAM(pb + 7);
        if (EN_C1 && IN(pb + 8)) REPS(pb + 8) {
            KArgs A = kargs(); unsigned char* const wsb = GWS(A);
            pg8::Gemm g{(const pg8::bf16_t*)(wsb + WS_H), (const pg8::bf16_t*)(wsb + WS_WIN_C) + (size_t)p * N_C * DM, MTOT, N_C, DM, DM}; pg8::LockstepOrder S; S.init(MTOT, N_C, G, (int)blockIdx.x);
            pg8::EpiC1 E{(pg8::bf16_t*)(wsb + WS_G1), (size_t)MTOT * MIXW, (const float*)(wsb + WS_OML) + (size_t)p * 2 * 8192};
            pg8::gemm_phase<pg8::EpiC1, pg8::LockstepOrder, PG8_ALIGNV, PG8_SP2V>(lds, g, S, E);
            if (p0_defer_on(G)) { pg8::LockstepOrder S2; S2.init(MTOT, N_C, G, (int)blockIdx.x); p0_deferred(kargs(), lds, S2, p == 0 ? 1 : 3); }
        } SEAM(pb + 8);
        if (EN_SCAN && IN(pb + 9)) REPS(pb + 9) { scan_phase(kargs(), lds, G); } SEAM(pb + 9);
        if (EN_RO && IN(pb + 10)) REPS(pb + 10) { readout_phase(kargs(), p, lc == 3 ? MLAT : MTOT, G); } SEAM(pb + 10);
        if (EN_C4 && IN(pb + 11)) REPS(pb + 11) {
            KArgs A = kargs(); unsigned char* const wsb = GWS(A);
            { pg8::Gemm g{(const pg8::bf16_t*)(wsb + WS_CC), (const pg8::bf16_t*)(wsb + WS_WO_C) + (size_t)p * DM * MIXW, MLAT, DM, MIXW, MIXW}; pg8::LockstepOrder S; S.init(MLAT, DM, G, (int)blockIdx.x);
              pg8::EpiBf16P E{(pg8::bf16_t*)(wsb + WS_Y), DM};
              pg8::gemm_phase<pg8::EpiBf16P, pg8::LockstepOrder, PG8_ALIGNV, PG8_SP2V>(lds, g, S, E); }
            if (lc != 3) { pg8::Gemm g{(const pg8::bf16_t*)(wsb + WS_CC) + (size_t)MLAT * MIXW, (const pg8::bf16_t*)(wsb + WS_WO_C) + (size_t)p * DM * MIXW, MTOT - MLAT, DM, MIXW / 8, MIXW}; pg8::SplitKOrder S; S.init(MTOT - MLAT, DM, 8, G, (int)blockIdx.x);
              pg8::EpiF32 E{(float*)(wsb + WS_YP), DM, (size_t)(MTOT - MLAT) * DM};
              pg8::gemm_phase<pg8::EpiF32, pg8::SplitKOrder, PG8_ALIGNV, PG8_SP2V>(lds, g, S, E); }
        } SEAM(pb + 11);
        if (EN_NORM && IN(pb + 12)) REPS(pb + 12) { norm_phase(kargs(), lc, lc + 1, G); } SEAM(pb + 12);
    }
#undef IN
#undef SEAM
__global__ void __launch_bounds__(NWAVES * 64, 2) fwd(Args a) {
    extern __shared__ __attribute__((aligned(16))) unsigned char lds_raw[];
    LAS unsigned char* lds = (LAS unsigned char*)lds_raw;
    int tid_l = threadIdx.x; asm volatile("" : "+v"(tid_l)); const int tid = tid_l, G = gridDim.x;
    for (int u = tid; u < (LDS_BYTES - LDSCTL_OFF) / 4; u += NWAVES * 64) ((LAS unsigned*)(lds + LDSCTL_OFF))[u] = 0u;
    __syncthreads();
    XcdBarrier bar; bar.bar = (unsigned*)(a.ws + WS_CTL) + CW_BAR; bar.x = 0; bar.st = nullptr;
    if (MK_ONE_LAUNCH) bar = xcd_barrier_post((unsigned*)(a.ws + WS_CTL) + CW_BAR, (volatile LAS unsigned*)(lds + MISC_OFF));
    const int lo = a.ph_lo, hi = a.ph_hi;
#define IN(k) (lo <= (k) && (k) < hi)
#define SEAM(k) do { if (IN(k) && IN((k) + 1)) xcd_barrier(bar); } while (0)
    if (EN_P0 && IN(0)) REPS(0) { p0_prologue(kargs(), lds, G); } SEAM(0);
    if (EN_NORM && IN(1)) REPS(1) { norm_phase(kargs(), -1, 0, G); } SEAM(1);
    layer_pair<0>(lds, G, lo, hi, bar);
    layer_pair<1>(lds, G, lo, hi, bar);
#undef IN
#undef SEAM
}

extern "C" void kernel_launch(void* const* d_in, const int* in_sizes, int n_in, void* d_out, int out_size, void* d_ws, size_t ws_size, hipStream_t stream) {
    static int grid = 0;
    if (grid == 0) {
        if (n_in != 22 || out_size != MLAT * DM || ws_size < WS_END) { fprintf(stderr, "kernel_launch: unexpected shapes (n_in %d, out %d, ws %zu, need %zu)\n", n_in, out_size, ws_size, (size_t)WS_END); grid = -1; return; }
        int dev = 0, cus = 0, per_cu = 0;
        if (hipGetDevice(&dev) != hipSuccess || hipDeviceGetAttribute(&cus, hipDeviceAttributeMultiprocessorCount, dev) != hipSuccess) { grid = -1; return; }
        if (hipFuncSetAttribute((const void*)fwd, hipFuncAttributeMaxDynamicSharedMemorySize, LDS_BYTES) != hipSuccess) { fprintf(stderr, "kernel_launch: hipFuncSetAttribute failed\n"); grid = -1; return; }
        if (hipOccupancyMaxActiveBlocksPerMultiprocessor(&per_cu, (const void*)fwd, NWAVES * 64, LDS_BYTES) != hipSuccess || per_cu < 1) fprintf(stderr, "kernel_launch: occupancy query reports %d\n", per_cu);
        (void)hipGetLastError();
        grid = cus;
    }
    if (grid < 0) return;
    (void)hipMemsetAsync((char*)d_ws + WS_CTL, 0, 65536, stream);
    Args a{};
    for (int i = 0; i < 22; ++i) a.in[i] = (const float*)d_in[i];
    a.out = (float*)d_out; a.ws = (unsigned char*)d_ws;
#if MK_ONE_LAUNCH
    a.ph_lo = 0; a.ph_hi = N_PHASES;
    hipLaunchKernelGGL(fwd, dim3(grid), dim3(NWAVES * 64), LDS_BYTES, stream, a);
#else
    for (int p = 0; p < N_PHASES; ++p) { a.ph_lo = p; a.ph_hi = p + 1; hipLaunchKernelGGL(fwd, dim3(grid), dim3(NWAVES * 64), LDS_BYTES, stream, a); }
#endif
}
```

```cpp
#include <hip/hip_runtime.h>
#include <cstdio>
#include <cstdint>
namespace pg8 {
#define PG8_LAS __attribute__((address_space(3)))
typedef unsigned short bf16_t;
typedef short bf16x8 __attribute__((ext_vector_type(8)));
typedef float f32x4 __attribute__((ext_vector_type(4)));
typedef unsigned u32x4 __attribute__((ext_vector_type(4)));
constexpr int BM = 256, BK = 64, HALF = 128, HTB = HALF * BK * 2  , STAGE_BYTES = 8 * HTB, NXCD = 8, WGM = 4;

__host__ __device__ __forceinline__ int lds_byte(int r, int c) { const int st = (r >> 4) * 2 + (c >> 5), rr = r & 15, cc = c & 31, ob = rr * 64 + cc * 2; return st * 1024 + (ob ^ (((ob >> 9) & 1) << 5)); }
__host__ __device__ __forceinline__ void stage_rc(int b, int& R, int& C) { const int st = b / 1024, sb = b % 1024, swz = sb ^ (((sb >> 9) & 1) << 5); R = (st >> 1) * 16 + swz / 64; C = (st & 1) * 32 + (swz % 64) / 2; }
__host__ __device__ __forceinline__ int perm32(int rho) { const int n = rho >> 4, i = rho & 15; return 8 * (i >> 2) + 4 * n + (i & 3); }

struct Unit { int pm, pn, kc; };
struct Gemm { const bf16_t* A; const bf16_t* Bt; int M, N, K, ld; };

struct StaticOrder {
    int nM, nN, nwg, G, c;
    __host__ __device__ void init(int M, int N, int G_, int c_) { nM = M / BM; nN = N / BM; nwg = nM * nN; G = G_; c = c_; }
    __host__ __device__ bool next(int i, Unit& u) const {
        const long L = (long)i * G + c; if (L >= nwg) return false;
        int wgid = (int)L; { const int q = nwg / NXCD, r = nwg % NXCD, xcd = wgid % NXCD, off = wgid / NXCD; wgid = (xcd < r ? xcd * (q + 1) : r * (q + 1) + (xcd - r) * q) + off; }
        const int nig = WGM * nN, gid = wgid / nig, fm = gid * WGM, gsz = (nM - fm) < WGM ? (nM - fm) : WGM;
        u.pm = fm + ((wgid % nig) % gsz); u.pn = (wgid % nig) / gsz; u.kc = 0; return true;
    }
    __device__ __forceinline__ void a_ready(const Unit&) const {}
    __device__ __forceinline__ void done(const Unit&) const {}
};
struct LockstepOrder {
    static constexpr int LW = 4;
    int nM, nN, G, c, x, k, nk, PG, r0, gR, qR, rR, lenx;
    __host__ __device__ void init(int M, int N, int G_, int c_) { nM = M / BM; nN = N / BM; G = G_; c = c_; x = c_ % NXCD; k = c_ / NXCD; nk = G_ / NXCD; PG = (nM / LW) / NXCD; r0 = PG * NXCD * LW; gR = nM - r0;
        const int rem = gR * nN; qR = rem / NXCD; rR = rem % NXCD; lenx = PG * LW * nN + qR + (x < rR ? 1 : 0); }
    __host__ __device__ bool next(int i, Unit& u) const {
        if (G % NXCD != 0) { const long L = (long)i * G + c; if (L >= (long)nM * nN) return false; u.kc = 0; u.pm = (int)(L / nN); u.pn = (int)(L % nN); return true; }
        const int off = i * nk + k; if (off >= lenx) return false; u.kc = 0;
        const int lock = PG * LW * nN;
        if (off < lock) { const int j = off / (LW * nN), o2 = off % (LW * nN); u.pm = (j * NXCD + x) * LW + o2 % LW; u.pn = o2 / LW; }
        else { const int rho = (x < rR ? x * (qR + 1) : rR * (qR + 1) + (x - rR) * qR) + (off - lock); u.pm = r0 + rho % gR; u.pn = rho / gR; }
        return true;
    }
    __device__ __forceinline__ void a_ready(const Unit&) const {}
    __device__ __forceinline__ void done(const Unit&) const {}
};
struct SplitKOrder {
    int nM, nN, KS, nwg, G, c;
    __host__ __device__ void init(int M, int N, int KS_, int G_, int c_) { nM = M / BM; nN = N / BM; KS = KS_; nwg = nM * nN * KS; G = G_; c = c_; }
    __host__ __device__ bool next(int i, Unit& u) const { const long L = (long)i * G + c; if (L >= nwg) return false; const int l = (int)L; u.kc = l % KS; u.pn = (l / KS) % nN; u.pm = l / (KS * nN); return true; }
    __device__ __forceinline__ void a_ready(const Unit&) const {}
    __device__ __forceinline__ void done(const Unit&) const {}
};

typedef float f32x2 __attribute__((ext_vector_type(2)));
typedef __bf16 bf16x2_c __attribute__((ext_vector_type(2)));
__device__ __forceinline__ unsigned cvt_pk_bf16(float lo, float hi) { const f32x2 v = {lo, hi}; const bf16x2_c b = __builtin_convertvector(v, bf16x2_c); return __builtin_bit_cast(unsigned, b); }
__device__ __forceinline__ f32x2 gelu_pk(f32x2 v) {
    const f32x2 av = __builtin_elementwise_abs(v), d = av * 0.2316418882f + 1.0f;
    f32x2 t; t.x = __builtin_amdgcn_rcpf(d.x); t.y = __builtin_amdgcn_rcpf(d.y);
    f32x2 q = t * 0.5307027145f + (-0.7265760135f); q = q * t + 0.7107068705f; q = q * t + (-0.142248368f); q = q * t + 0.127414796f; q = q * t;
    const f32x2 s = (v * v) * (-0.72134752044f);
    f32x2 e; e.x = __builtin_amdgcn_exp2f(s.x); e.y = __builtin_amdgcn_exp2f(s.y);
    const f32x2 m = v * (q * e), r = v - m;
    f32x2 o; o.x = v.x < 0.f ? m.x : r.x; o.y = v.y < 0.f ? m.y : r.y; return o;
}

typedef unsigned u32x2 __attribute__((ext_vector_type(2)));
__device__ __forceinline__ float silu_f(float x) { return x * __builtin_amdgcn_rcpf(1.0f + __builtin_amdgcn_exp2f(-1.4426950408889634f * x)); }
__device__ __forceinline__ float sigmoid_neg_f(float x) { return __builtin_amdgcn_rcpf(1.0f + __builtin_amdgcn_exp2f(1.4426950408889634f * x)); }
__device__ __forceinline__ f32x2 sig_pk(f32x2 x, float k) { const f32x2 t = x * k; f32x2 e; e.x = __builtin_amdgcn_exp2f(t.x); e.y = __builtin_amdgcn_exp2f(t.y); const f32x2 d = e + 1.0f;
    f32x2 r; r.x = __builtin_amdgcn_rcpf(d.x); r.y = __builtin_amdgcn_rcpf(d.y); return r; }
__device__ __forceinline__ f32x4 act4(f32x4 v, int act) {
    if (act == 1) { const f32x2 a = (f32x2){v[0], v[1]}, b = (f32x2){v[2], v[3]}; const f32x2 ra = a * sig_pk(a, -1.4426950408889634f), rb = b * sig_pk(b, -1.4426950408889634f); v = (f32x4){ra.x, ra.y, rb.x, rb.y}; }
    else if (act == 2) { const f32x2 a = gelu_pk((f32x2){v[0], v[1]}), b = gelu_pk((f32x2){v[2], v[3]}); v = (f32x4){a.x, a.y, b.x, b.y}; }
    return v;
}
struct EpiF32 {
    static constexpr bool PERM = false, AFTER_DRAIN = false;
    float* C0; int ldc; size_t kstride;
    __device__ __forceinline__ void operator()(const f32x4 (&acc)[2][2][4][2], const Unit& u, int wr, int wc, int fr, int fq) const {
        float* C = C0 + (size_t)u.kc * kstride;
        const int row0 = u.pm * BM + wr * 64 + fr, col0 = u.pn * BM + wc * 32 + 4 * fq;
#pragma unroll
        for (int ai = 0; ai < 2; ++ai)
#pragma unroll
            for (int m = 0; m < 4; ++m) { float* rowp = C + (size_t)(row0 + ai * HALF + m * 16) * ldc + col0;
#pragma unroll
                for (int bj = 0; bj < 2; ++bj)
#pragma unroll
                    for (int n = 0; n < 2; ++n) *(f32x4*)(rowp + bj * HALF + n * 16) = acc[ai][bj][m][n]; }
    }
};
struct EpiBf16P {
    static constexpr bool PERM = true, AFTER_DRAIN = false;
    bf16_t* O; int ldc;
    __device__ __forceinline__ void operator()(const f32x4 (&acc)[2][2][4][2], const Unit& u, int wr, int wc, int fr, int fq) const {
        const int row0 = u.pm * BM + wr * 64 + fr, col0 = u.pn * BM + wc * 32 + 8 * fq;
#pragma unroll
        for (int ai = 0; ai < 2; ++ai)
#pragma unroll
            for (int m = 0; m < 4; ++m) { bf16_t* rowp = O + (size_t)(row0 + ai * HALF + m * 16) * ldc + col0;
#pragma unroll
                for (int bj = 0; bj < 2; ++bj) { const f32x4 v0 = acc[ai][bj][m][0], v1 = acc[ai][bj][m][1];
                    u32x4 w; w.x = cvt_pk_bf16(v0[0], v0[1]); w.y = cvt_pk_bf16(v0[2], v0[3]); w.z = cvt_pk_bf16(v1[0], v1[1]); w.w = cvt_pk_bf16(v1[2], v1[3]);
                    *(u32x4*)(rowp + bj * HALF) = w; } }
    }
};
struct EpiAB1 {
    static constexpr bool PERM = true, AFTER_DRAIN = false;
    bf16_t* O; int ldc;
    __device__ __forceinline__ void operator()(const f32x4 (&acc)[2][2][4][2], const Unit& u, int wr, int wc, int fr, int fq) const {
        const int act = u.pn < 7 ? 0 : ((u.pn < 23 || u.pn >= 55) ? 1 : 2);
        const int row0 = u.pm * BM + wr * 64 + fr, col0 = u.pn * BM + wc * 32 + 8 * fq;
#pragma unroll
        for (int ai = 0; ai < 2; ++ai)
#pragma unroll
            for (int m = 0; m < 4; ++m) { bf16_t* rowp = O + (size_t)(row0 + ai * HALF + m * 16) * ldc + col0;
#pragma unroll
                for (int bj = 0; bj < 2; ++bj) { const f32x4 v0 = act4(acc[ai][bj][m][0], act), v1 = act4(acc[ai][bj][m][1], act);
                    u32x4 w; w.x = cvt_pk_bf16(v0[0], v0[1]); w.y = cvt_pk_bf16(v0[2], v0[3]); w.z = cvt_pk_bf16(v1[0], v1[1]); w.w = cvt_pk_bf16(v1[2], v1[3]);
                    *(u32x4*)(rowp + bj * HALF) = w; } }
    }
};
struct EpiC1 {
    static constexpr bool PERM = true, AFTER_DRAIN = false;
    bf16_t* O; size_t stride; const float* oml;
    __device__ __forceinline__ void operator()(const f32x4 (&acc)[2][2][4][2], const Unit& u, int wr, int wc, int fr, int fq) const {
        const int region = u.pn >> 5; bf16_t* base = O + (size_t)region * stride;
        const int row0 = u.pm * BM + wr * 64 + fr, col0 = (u.pn & 31) * BM + wc * 32 + 8 * fq;
        const bool gate = (region == 1 || region == 2); const int act = (region == 0 || region == 4) ? 1 : 0;
        f32x4 gv[2][2];
#pragma unroll
        for (int bj = 0; bj < 2; ++bj)
#pragma unroll
            for (int n = 0; n < 2; ++n) gv[bj][n] = gate ? *(const f32x4*)(oml + (size_t)(region - 1) * 8192 + col0 + bj * HALF + 4 * n) : (f32x4){1.f, 1.f, 1.f, 1.f};
#pragma unroll
        for (int ai = 0; ai < 2; ++ai)
#pragma unroll
            for (int m = 0; m < 4; ++m) { bf16_t* rowp = base + (size_t)(row0 + ai * HALF + m * 16) * 8192 + col0;
#pragma unroll
                for (int bj = 0; bj < 2; ++bj) { f32x4 v0 = acc[ai][bj][m][0], v1 = acc[ai][bj][m][1];
                    if (gate) {
                        const f32x2 a0 = sig_pk((f32x2){v0[0], v0[1]}, 1.4426950408889634f), a1 = sig_pk((f32x2){v0[2], v0[3]}, 1.4426950408889634f), b0 = sig_pk((f32x2){v1[0], v1[1]}, 1.4426950408889634f), b1 = sig_pk((f32x2){v1[2], v1[3]}, 1.4426950408889634f);
                        v0 = gv[bj][0] * (f32x4){a0.x, a0.y, a1.x, a1.y}; v1 = gv[bj][1] * (f32x4){b0.x, b0.y, b1.x, b1.y}; }
                    else { v0 = act4(v0, act); v1 = act4(v1, act); }
                    u32x4 w; w.x = cvt_pk_bf16(v0[0], v0[1]); w.y = cvt_pk_bf16(v0[2], v0[3]); w.z = cvt_pk_bf16(v1[0], v1[1]); w.w = cvt_pk_bf16(v1[2], v1[3]);
                    *(u32x4*)(rowp + bj * HALF) = w; } }
    }
};
struct EpiQ {
    static constexpr bool PERM = true, AFTER_DRAIN = false;
    bf16_t* O; const f32x2* rope; int nlat; float qscale;
    __device__ __forceinline__ void operator()(const f32x4 (&acc)[2][2][4][2], const Unit& u, int wr, int wc, int fr, int fq) const {
        const int row0 = u.pm * BM + wr * 64 + fr; const bool upper = fq >= 2;
#pragma unroll
        for (int bj = 0; bj < 2; ++bj) {
            const int G = 8 * u.pn + 4 * bj + wc, hm = G % 6, col = u.pn * BM + bj * HALF + wc * 32 + 8 * fq;
#pragma unroll
            for (int ai = 0; ai < 2; ++ai)
#pragma unroll
                for (int m = 0; m < 4; ++m) { const int row = row0 + ai * HALF + m * 16; f32x4 x0 = acc[ai][bj][m][0], x1 = acc[ai][bj][m][1];
                    if (hm >= 4 && u.pm * BM < nlat) {
                        const int t = row & 8191, pos = (hm == 4) ? (t >> 6) : (t & 63); const f32x2* cs = rope + pos * 16 + 8 * (fq & 1);
#pragma unroll
                        for (int j = 0; j < 4; ++j) {
                            { auto rr = __builtin_amdgcn_permlane32_swap(__float_as_uint(x0[j]), __float_as_uint(x0[j]), false, false); const float pv = __uint_as_float(upper ? rr[0] : rr[1]); const f32x2 c = cs[j];
                              x0[j] = upper ? x0[j] * c.x + pv * c.y : x0[j] * c.x - pv * c.y; }
                            { auto rr = __builtin_amdgcn_permlane32_swap(__float_as_uint(x1[j]), __float_as_uint(x1[j]), false, false); const float pv = __uint_as_float(upper ? rr[0] : rr[1]); const f32x2 c = cs[4 + j];
                              x1[j] = upper ? x1[j] * c.x + pv * c.y : x1[j] * c.x - pv * c.y; } } }
                    x0 = x0 * qscale; x1 = x1 * qscale;
                    u32x4 w; w.x = cvt_pk_bf16(x0[0], x0[1]); w.y = cvt_pk_bf16(x0[2], x0[3]); w.z = cvt_pk_bf16(x1[0], x1[1]); w.w = cvt_pk_bf16(x1[2], x1[3]);
                    *(u32x4*)(O + (size_t)row * 6144 + col) = w; }
        }
    }
};
struct EpiKV {
    static constexpr bool PERM = true, AFTER_DRAIN = false;
    bf16_t* KN; bf16_t* V; int mtot;
    __device__ __forceinline__ void operator()(const f32x4 (&acc)[2][2][4][2], const Unit& u, int wr, int wc, int fr, int fq) const {
        const int row0 = u.pm * BM + wr * 64 + fr, colh = wc * 32 + 8 * fq;
#pragma unroll
        for (int ai = 0; ai < 2; ++ai)
#pragma unroll
            for (int m = 0; m < 4; ++m) { const size_t off = ((size_t)u.pn * mtot + (size_t)(row0 + ai * HALF + m * 16)) * 128 + colh;
#pragma unroll
                for (int bj = 0; bj < 2; ++bj) { const f32x4 v0 = acc[ai][bj][m][0], v1 = acc[ai][bj][m][1];
                    u32x4 w; w.x = cvt_pk_bf16(v0[0], v0[1]); w.y = cvt_pk_bf16(v0[2], v0[3]); w.z = cvt_pk_bf16(v1[0], v1[1]); w.w = cvt_pk_bf16(v1[2], v1[3]);
                    *(u32x4*)((bj ? V : KN) + off) = w; } }
    }
};

template <class Epi, class Sched, bool ALIGN_EPI = false, bool SP2 = false>
__device__ __forceinline__ void gemm_phase(PG8_LAS unsigned char* lds, const Gemm g, const Sched& S, const Epi& E) {
    int tid_l = threadIdx.x; asm volatile("" : "+v"(tid_l)); const int tid = tid_l, wid = __builtin_amdgcn_readfirstlane(tid >> 6), lane = tid & 63, wr = wid >> 2, wc = wid & 3, fr = lane & 15, fq = lane >> 4;
    const int K = g.ld, nt = g.K / BK;
    unsigned voffA[2], voffB[2];
#pragma unroll
    for (int i = 0; i < 2; ++i) { int R, C; stage_rc(tid * 16 + i * 8192, R, C); const int Rb = Epi::PERM ? ((R & ~31) + perm32(R & 31)) : R;
        voffA[i] = (unsigned)(R * K + C) * 2u; voffB[i] = (unsigned)(Rb * K + C) * 2u; }
    const size_t kstep = (size_t)(BK * 2);
    const size_t hstep = (size_t)HALF * K * 2;
    const size_t tstep = 2 * hstep;
    const unsigned ldsw = (unsigned)wid * 1024u;
    const int aoff = lds_byte(wr * 64 + fr, fq * 8), boff = lds_byte(wc * 32 + fr, fq * 8);
#define PG8_SA(b, h) (((b) * 2 + (h)) * HTB)
#define PG8_SB(b, h) ((4 + (b) * 2 + (h)) * HTB)
#define PG8_STAGE(bufoff, gbase, voff) do { const char* gb_ = (const char*)(gbase); asm volatile("" : "+s"(gb_)); _Pragma("unroll") for (int _i = 0; _i < 2; ++_i) { unsigned vo_ = (voff)[_i]; asm volatile("" : "+v"(vo_)); \
        __builtin_amdgcn_global_load_lds((const unsigned*)(gb_ + vo_), (PG8_LAS unsigned*)(lds + (bufoff) + ldsw + _i * 8192), 16, 0, 0); } } while (0)
#define PG8_LDA(dst, b, h) do { _Pragma("unroll") for (int m = 0; m < 4; ++m) _Pragma("unroll") for (int k = 0; k < 2; ++k) dst[m][k] = *(const PG8_LAS bf16x8*)(lds + PG8_SA(b, h) + aoff + m * 2048 + k * 1024); } while (0)
#define PG8_LDB(dst, b, h) do { _Pragma("unroll") for (int n = 0; n < 2; ++n) _Pragma("unroll") for (int k = 0; k < 2; ++k) dst[n][k] = *(const PG8_LAS bf16x8*)(lds + PG8_SB(b, h) + boff + n * 2048 + k * 1024); } while (0)
#define PG8_MMA(ai, bj, At, Bt) do { __builtin_amdgcn_sched_barrier(0); _Pragma("unroll") for (int m = 0; m < 4; ++m) _Pragma("unroll") for (int n = 0; n < 2; ++n) _Pragma("unroll") for (int k = 0; k < 2; ++k) \
        acc[ai][bj][m][n] = __builtin_amdgcn_mfma_f32_16x16x32_bf16(Bt[n][k], At[m][k], acc[ai][bj][m][n], 0, 0, 0); __builtin_amdgcn_sched_barrier(0); } while (0)
#define PG8_WAIT_V(n) asm volatile("s_waitcnt vmcnt(" #n ")" ::: "memory")
#define PG8_WAIT_L(n) asm volatile("s_waitcnt lgkmcnt(" #n ")" ::: "memory")
#define PG8_BAR __builtin_amdgcn_s_barrier()
#define PG8_SCHED __builtin_amdgcn_sched_barrier(0)
    if (wr == 0) __builtin_amdgcn_s_setprio(1);
    Unit cur, nxt; int ui = 0;
    if (!S.next(0, cur)) { __builtin_amdgcn_s_setprio(0); return; }
    f32x4 acc[2][2][4][2];
#pragma unroll
    for (int a = 0; a < 2; ++a)
#pragma unroll
        for (int b = 0; b < 2; ++b)
#pragma unroll
            for (int m = 0; m < 4; ++m)
#pragma unroll
                for (int n = 0; n < 2; ++n) acc[a][b][m][n] = (f32x4){0.f, 0.f, 0.f, 0.f};
    bf16x8 At[4][2], B0[2][2], B1[2][2];
    const size_t kcb = (size_t)g.K * 2;
    const char* cA = (const char*)g.A + (size_t)cur.pm * tstep + cur.kc * kcb; const char* cB = (const char*)g.Bt + (size_t)cur.pn * tstep + cur.kc * kcb;
    S.a_ready(cur);
    if constexpr (SP2) {
        PG8_STAGE(PG8_SB(0, 0), cB, voffB); PG8_STAGE(PG8_SB(0, 1), cB + hstep, voffB); PG8_STAGE(PG8_SA(0, 0), cA, voffA); PG8_STAGE(PG8_SA(0, 1), cA + hstep, voffA);
        if (wr == 1) PG8_BAR;
        PG8_WAIT_V(2); PG8_BAR;
        PG8_STAGE(PG8_SB(1, 0), cB + kstep, voffB); PG8_STAGE(PG8_SA(1, 0), cA + kstep, voffA); PG8_STAGE(PG8_SB(1, 1), cB + hstep + kstep, voffB);
        PG8_WAIT_V(6); PG8_BAR;
    } else {
        PG8_STAGE(PG8_SB(0, 0), cB, voffB); PG8_STAGE(PG8_SA(0, 0), cA, voffA); PG8_STAGE(PG8_SB(0, 1), cB + hstep, voffB); PG8_STAGE(PG8_SA(0, 1), cA + hstep, voffA);
        if (wr == 1) PG8_BAR;
        PG8_WAIT_V(4); PG8_BAR;
        PG8_STAGE(PG8_SB(1, 0), cB + kstep, voffB); PG8_STAGE(PG8_SA(1, 0), cA + kstep, voffA); PG8_STAGE(PG8_SB(1, 1), cB + hstep + kstep, voffB);
        PG8_WAIT_V(6); PG8_BAR;
    }
    for (;;) {
        const bool has_next = S.next(ui + 1, nxt);
        const char* nA = has_next ? (const char*)g.A + (size_t)nxt.pm * tstep + nxt.kc * kcb : cA; const char* nB = has_next ? (const char*)g.Bt + (size_t)nxt.pn * tstep + nxt.kc * kcb : cB;
        for (int t = 0; t < nt; t += 2) {
            const bool last = (t == nt - 2);
            const char* a1 = cA + (size_t)(t + 1) * kstep;
            const char* a2 = last ? nA : cA + (size_t)(t + 2) * kstep; const char* b2 = last ? nB : cB + (size_t)(t + 2) * kstep;
            const char* a3 = a2 + kstep; const char* b3 = b2 + kstep;
            if (last && has_next) S.a_ready(nxt);
            if constexpr (SP2) {
            PG8_LDB(B0, 0, 0); PG8_LDB(B1, 0, 1); PG8_SCHED; PG8_LDA(At, 0, 0); PG8_STAGE(PG8_SA(1, 1), a1 + hstep, voffA);
            PG8_WAIT_V(8); PG8_WAIT_L(0); PG8_BAR; PG8_MMA(0, 0, At, B0); PG8_MMA(0, 1, At, B1); PG8_BAR; PG8_SCHED;
            PG8_LDA(At, 0, 1); PG8_STAGE(PG8_SB(0, 0), b2, voffB); PG8_STAGE(PG8_SB(0, 1), b2 + hstep, voffB); PG8_STAGE(PG8_SA(0, 0), a2, voffA);
            PG8_WAIT_V(8); PG8_WAIT_L(0); PG8_BAR; PG8_MMA(1, 0, At, B0); PG8_MMA(1, 1, At, B1); PG8_BAR; PG8_SCHED;
            PG8_LDB(B0, 1, 0); PG8_LDB(B1, 1, 1); PG8_SCHED; PG8_LDA(At, 1, 0); PG8_STAGE(PG8_SA(0, 1), a2 + hstep, voffA);
            PG8_WAIT_V(8); PG8_WAIT_L(0); PG8_BAR; PG8_MMA(0, 0, At, B0); PG8_MMA(0, 1, At, B1); PG8_BAR; PG8_SCHED;
            PG8_LDA(At, 1, 1); PG8_STAGE(PG8_SB(1, 0), b3, voffB); PG8_STAGE(PG8_SB(1, 1), b3 + hstep, voffB); PG8_STAGE(PG8_SA(1, 0), a3, voffA);
            PG8_WAIT_V(8); PG8_WAIT_L(0); PG8_BAR; PG8_MMA(1, 0, At, B0); PG8_MMA(1, 1, At, B1); PG8_BAR; PG8_SCHED;
            } else {
            PG8_LDB(B0, 0, 0); PG8_SCHED; PG8_LDA(At, 0, 0); PG8_STAGE(PG8_SA(1, 1), a1 + hstep, voffA);
            PG8_WAIT_L(8); PG8_BAR; PG8_WAIT_L(0); PG8_MMA(0, 0, At, B0); PG8_BAR; PG8_SCHED;
            PG8_LDB(B1, 0, 1); PG8_STAGE(PG8_SB(0, 0), b2, voffB);
            PG8_BAR; PG8_WAIT_L(0); PG8_MMA(0, 1, At, B1); PG8_BAR;
            PG8_LDA(At, 0, 1); PG8_STAGE(PG8_SA(0, 0), a2, voffA);
            PG8_BAR; PG8_WAIT_L(0); PG8_MMA(1, 0, At, B0); PG8_BAR; PG8_SCHED;
            PG8_STAGE(PG8_SB(0, 1), b2 + hstep, voffB);
            PG8_WAIT_V(6); PG8_BAR; PG8_MMA(1, 1, At, B1); PG8_BAR;
            PG8_LDB(B0, 1, 0); PG8_SCHED; PG8_LDA(At, 1, 0); PG8_STAGE(PG8_SA(0, 1), a2 + hstep, voffA);
            PG8_WAIT_L(8); PG8_BAR; PG8_WAIT_L(0); PG8_MMA(0, 0, At, B0); PG8_BAR; PG8_SCHED;
            PG8_LDB(B1, 1, 1); PG8_STAGE(PG8_SB(1, 0), b3, voffB);
            PG8_BAR; PG8_WAIT_L(0); PG8_MMA(0, 1, At, B1); PG8_BAR;
            PG8_LDA(At, 1, 1); PG8_STAGE(PG8_SA(1, 0), a3, voffA);
            PG8_BAR; PG8_WAIT_L(0); PG8_MMA(1, 0, At, B0); PG8_BAR; PG8_SCHED;
            PG8_STAGE(PG8_SB(1, 1), b3 + hstep, voffB);
            PG8_WAIT_V(6); PG8_BAR; PG8_MMA(1, 1, At, B1); PG8_BAR;
            }
        }
        if constexpr (ALIGN_EPI) { if (wr == 0) PG8_BAR; }
        if constexpr (!Epi::AFTER_DRAIN) { E(acc, cur, wr, wc, fr, fq); S.done(cur); }
        if (!has_next) break;
#pragma unroll
        for (int a = 0; a < 2; ++a)
#pragma unroll
            for (int b = 0; b < 2; ++b)
#pragma unroll
                for (int m = 0; m < 4; ++m)
#pragma unroll
                    for (int n = 0; n < 2; ++n) acc[a][b][m][n] = (f32x4){0.f, 0.f, 0.f, 0.f};
        cur = nxt; cA = nA; cB = nB; ++ui;
        if constexpr (ALIGN_EPI) { if (wr == 1) PG8_BAR; }
    }
    PG8_WAIT_V(0);
    if constexpr (!ALIGN_EPI) { if (wr == 0) PG8_BAR; }
    PG8_BAR;
    if constexpr (Epi::AFTER_DRAIN) { E.fused(acc, cur, wr, wc, fr, fq, lds, wid, lane); S.done(cur); }
    __builtin_amdgcn_s_setprio(0);
#undef PG8_SA
#undef PG8_SB
#undef PG8_STAGE
#undef PG8_LDA
#undef PG8_LDB
#undef PG8_MMA
#undef PG8_WAIT_V
#undef PG8_WAIT_L
#undef PG8_BAR
#undef PG8_SCHED
}
}
#define GAS __attribute__((address_space(1)))
#define LAS __attribute__((address_space(3)))
typedef unsigned short bf16;
typedef unsigned v4u __attribute__((ext_vector_type(4)));
typedef float f32x4 __attribute__((ext_vector_type(4)));
typedef short bf16x8 __attribute__((ext_vector_type(8)));
typedef GAS unsigned gu32;
typedef GAS unsigned long long gu64;
#define RLX_AGENT __ATOMIC_RELAXED, __HIP_MEMORY_SCOPE_AGENT
#define LDS_WAIT() asm volatile("s_waitcnt lgkmcnt(0)" ::: "memory")
#define VM_WAIT() asm volatile("s_waitcnt vmcnt(0)" ::: "memory")
__device__ __forceinline__ unsigned long long rt() { return __builtin_amdgcn_s_memrealtime(); }
__device__ __forceinline__ unsigned f2bf(float f) { unsigned u = __builtin_bit_cast(unsigned, f); return (u + 0x7fffu + ((u >> 16) & 1u)) >> 16; }
__device__ __forceinline__ unsigned pk2(float lo, float hi) { return f2bf(lo) | (f2bf(hi) << 16); }

typedef unsigned u32x2 __attribute__((ext_vector_type(2)));
typedef float f32x2 __attribute__((ext_vector_type(2)));
#define XB_TMO      128
#define XB_XCNT(j)  (256  + 64 * (j))
#define XB_XSUB(j)  (1280 + 64 * (j))
#define XB_XGEN(j)  (2304 + 64 * (j))
#define XB_TOP      3328
#define XB_TOPGEN   3392
#define XCD_BAR_WORDS 3456
#define XB_SPIN_CAP (1u << 21)

__device__ __forceinline__ unsigned xb_ld(unsigned* p)              { return __hip_atomic_load(p, __ATOMIC_RELAXED, __HIP_MEMORY_SCOPE_AGENT); }
__device__ __forceinline__ unsigned xb_add(unsigned* p, unsigned v) { return __hip_atomic_fetch_add(p, v, __ATOMIC_RELAXED, __HIP_MEMORY_SCOPE_AGENT); }
__device__ __forceinline__ unsigned xb_xcc_id() { return (unsigned)__builtin_amdgcn_s_getreg((3 << 11) | 20) & 0xFu; }
#define XB_SPIN(cond, bar) do { unsigned _sp = 0; while (cond) { __builtin_amdgcn_s_sleep(1); \
    if ((++_sp & 255u) == 0u) { if (xb_ld(&(bar)[XB_TMO])) break; if (_sp > XB_SPIN_CAP) { atomicAdd(&(bar)[XB_TMO], 1u); break; } } } } while (0)

struct XcdBarrier {
    unsigned* bar; unsigned x;
    volatile LAS unsigned* st;
};

__device__ __forceinline__ XcdBarrier xcd_barrier_post(unsigned* bar, volatile LAS unsigned* st) {
    XcdBarrier b; b.bar = bar; b.x = xb_xcc_id(); b.st = st;
    if (threadIdx.x == 0) (void)xb_add(&bar[XB_XCNT(b.x)], 1u);
    return b;
}
__device__ __forceinline__ void xcd_barrier_complete(unsigned* bar, unsigned x, unsigned& nloc, unsigned& nx) {
    const unsigned G = gridDim.x * gridDim.y * gridDim.z;
    unsigned sum, cnt, mine, sp = 0u;
    for (;;) {
        sum = 0u; cnt = 0u; mine = 0u;
#pragma unroll
        for (unsigned j = 0; j < 16; ++j) { const unsigned c = xb_ld(&bar[XB_XCNT(j)]); sum += c; cnt += (c > 0u) ? 1u : 0u; mine = (j == x) ? c : mine; }
        if (sum == G) break;
        __builtin_amdgcn_s_sleep(1);
        if ((++sp & 255u) == 0u) { if (xb_ld(&bar[XB_TMO])) break; if (sp > XB_SPIN_CAP) { atomicAdd(&bar[XB_TMO], 1u); break; } }
    }
    nloc = mine > 0u ? mine : 1u; nx = cnt > 0u ? cnt : 1u;
}

__device__ __forceinline__ void xcd_barrier(const XcdBarrier& b) {
    asm volatile("s_waitcnt vmcnt(0)" ::: "memory");
    __syncthreads();
    if (threadIdx.x == 0) {
        unsigned* bar = b.bar;
        __builtin_amdgcn_s_waitcnt(0);
        unsigned nloc = b.st[0], nx = b.st[1];
        if (nloc == 0u) { xcd_barrier_complete(bar, b.x, nloc, nx); b.st[0] = nloc; b.st[1] = nx; }
        const unsigned old = xb_add(&bar[XB_XSUB(b.x)], 1u);
        const unsigned gen = old / nloc;
        if (old + 1u == (gen + 1u) * nloc) {
            __builtin_amdgcn_fence(__ATOMIC_RELEASE, "agent");
            asm volatile("s_waitcnt vmcnt(0)" ::: "memory");
            const unsigned og = xb_add(&bar[XB_TOP], 1u);
            const unsigned tg = og / nx;
            if (og + 1u == (tg + 1u) * nx) xb_add(&bar[XB_TOPGEN], 1u);
            else XB_SPIN(xb_ld(&bar[XB_TOPGEN]) == tg, bar);
            __builtin_amdgcn_fence(__ATOMIC_ACQUIRE, "agent");
            xb_add(&bar[XB_XGEN(b.x)], 1u);
            asm volatile("s_waitcnt vmcnt(0)" ::: "memory");
        } else {
            XB_SPIN(xb_ld(&bar[XB_XGEN(b.x)]) == gen, bar);
            __builtin_amdgcn_fence(__ATOMIC_ACQUIRE, "agent");
            asm volatile("s_waitcnt vmcnt(0)" ::: "memory");
        }
    }
    __syncthreads();
}


#ifndef NT_STREAMS
#define NT_STREAMS 1
#endif
#if NT_STREAMS
#define LDNT(p) __builtin_nontemporal_load(p)
#define STNT(p, v) __builtin_nontemporal_store((v), (p))
#else
#define LDNT(p) (*(p))
#define STNT(p, v) (*(p) = (v))
#endif
constexpr int NWAVES = 8;
constexpr int DM = 4096, NBATCH = 2, SEQ = 8192, NCTX = 256;
constexpr int MLAT = NBATCH * SEQ;
constexpr int MTOT = MLAT + NBATCH * NCTX;
constexpr int N_AB = 18176;
constexpr int N_ABSRC = 17984, N_C = 40960, MIXW = 8192;
constexpr int QL = 1024, KVL = 512, NQ = 6144, NKV = 8192;
constexpr int G1_CKV = 1024, G1_KR = 1536, G1_ZA = 1792, G1_UB = 5888, G1_VB = 9984, G1_ZB = 14080;
constexpr float EPS = 1e-6f;

constexpr size_t al256(size_t x) { return (x + 255) & ~(size_t)255; }
constexpr size_t WS_CTL = 0, CTL_ZERO_BYTES = 1u << 20;
constexpr size_t WS_MOD  = CTL_ZERO_BYTES;
constexpr size_t WS_OML  = WS_MOD  + al256((size_t)4 * 3 * 12288 * 4);
constexpr size_t WS_ROPE = WS_OML  + al256((size_t)2 * 2 * 8192 * 4);
constexpr size_t WS_STAT = WS_ROPE + al256((size_t)128 * 16 * 8);
constexpr size_t WS_WIN_AB = WS_STAT + al256((size_t)MTOT * 8);
constexpr size_t WS_WIN_C  = WS_WIN_AB + (size_t)2 * N_AB * DM * 2;
constexpr size_t WS_WO_AB  = WS_WIN_C + (size_t)2 * N_C * DM * 2;
constexpr size_t WS_WO_C   = WS_WO_AB + (size_t)2 * DM * MIXW * 2;
constexpr size_t WS_WQ     = WS_WO_C + (size_t)2 * DM * MIXW * 2;
constexpr size_t WS_WKV    = WS_WQ + (size_t)2 * NQ * QL * 2;
constexpr size_t WS_XS     = WS_WKV + (size_t)2 * NKV * KVL * 2;
constexpr size_t WS_H      = WS_XS + (size_t)MTOT * DM * 4;
constexpr size_t WS_Y      = WS_H + (size_t)MTOT * DM * 2;
constexpr size_t WS_G1     = WS_Y + (size_t)MTOT * DM * 4;
constexpr size_t WS_QN     = WS_G1 + (size_t)5 * MTOT * MIXW * 2;
constexpr size_t WS_KVN    = WS_QN + (size_t)MTOT * QL * 2;
constexpr size_t WS_KR     = WS_KVN + (size_t)MTOT * KVL * 2;
constexpr size_t WS_Q      = WS_KR + (size_t)MTOT * 64 * 2;
constexpr size_t WS_KN     = WS_Q + (size_t)MTOT * NQ * 2;
constexpr size_t WS_V      = WS_KN + (size_t)MTOT * DM * 2;
constexpr size_t WS_CC     = WS_V + (size_t)MTOT * DM * 2;
constexpr size_t WS_OF     = WS_CC + (size_t)MTOT * MIXW * 2;
constexpr size_t WS_YP     = WS_OF + (size_t)2 * MTOT * MIXW * 2;
constexpr size_t WS_END    = WS_YP + (size_t)8 * (MTOT - MLAT) * DM * 4;
constexpr int CW_BAR = 4096;

constexpr int RING_BYTES = 135168;
constexpr int LDSCTL_OFF = RING_BYTES, MISC_OFF = LDSCTL_OFF + 64;
constexpr int LDS_BYTES = 147456;

struct Args { const float* in[22]; float* out; unsigned char* ws; int ph_lo, ph_hi; };
typedef const __attribute__((address_space(4))) Args* KArgs;
__device__ __forceinline__ KArgs kargs() { KArgs ap = (KArgs)__builtin_amdgcn_kernarg_segment_ptr(); asm volatile("" : "+s"(ap)); return ap; }

#define GAS __attribute__((address_space(1)))
template <class T> __device__ __forceinline__ T* glob(T* p) { return (T*)(GAS T*)p; }
template <class T> __device__ __forceinline__ T* uni(T* p) {
    const unsigned long long v = (unsigned long long)p; const unsigned lo = __builtin_amdgcn_readfirstlane((unsigned)v), hi = __builtin_amdgcn_readfirstlane((unsigned)(v >> 32));
    return (T*)(GAS T*)(((unsigned long long)hi << 32) | lo); }
#define GWS(a_) glob((a_)->ws)
#define GIN(a_, i_) glob((a_)->in[i_])
#define GOUT(a_) glob((a_)->out)
__device__ __forceinline__ float wave_sum(float v) {
#pragma unroll
    for (int o = 1; o < 64; o <<= 1) v += __shfl_xor(v, o);
    return v;
}
__device__ __forceinline__ float bf_lo(unsigned w) { return __uint_as_float(w << 16); }
__device__ __forceinline__ float bf_hi(unsigned w) { return __uint_as_float(w & 0xffff0000u); }
typedef __bf16 bf16x2_t __attribute__((ext_vector_type(2)));
__device__ __forceinline__ unsigned cvtpk(float lo, float hi) { const f32x2 v = {lo, hi}; const bf16x2_t b = __builtin_convertvector(v, bf16x2_t); return __builtin_bit_cast(unsigned, b); }
__device__ __forceinline__ float silu_acc(float x) { return x / (1.0f + __expf(-x)); }

__device__ __forceinline__ void p0_gemv(KArgs a, LAS unsigned char* lds, int G) {
    int tid_l = threadIdx.x; asm volatile("" : "+v"(tid_l)); const int tid = tid_l, lane = tid & 63, wave = __builtin_amdgcn_readfirstlane(tid >> 6);
    LAS float* sc = (LAS float*)lds;
    LAS float* red = (LAS float*)(lds + 49152);
    const float* c = GIN(a, 1); const float* cctx = GIN(a, 3); const float* w_ada = GIN(a, 4); const float* b_ada = GIN(a, 5);
    float* mod = (float*)(GWS(a) + WS_MOD);
    for (int i = tid; i < 3 * 4096; i += 512) { const int r = i >> 12, k = i & 4095; const float cv = r < 2 ? c[r * 4096 + k] : cctx[k]; sc[i] = silu_acc(cv); }
    __syncthreads();
    const int kr = lane >> 4, c4 = lane & 15;
    for (int item = blockIdx.x; item < 768; item += G) {
        const int l = item / 192, cg = item % 192;
        const float* W = w_ada + (size_t)l * 4096 * 12288 + cg * 64 + c4 * 4;
        float acc[3][4];
#pragma unroll
        for (int r = 0; r < 3; ++r)
#pragma unroll
            for (int j = 0; j < 4; ++j) acc[r][j] = 0.f;
        const int k0 = wave * 512 + kr;
#pragma unroll 8
        for (int i = 0; i < 128; ++i) { const int k = k0 + 4 * i; const f32x4 w = LDNT((const f32x4*)(W + (size_t)k * 12288));
            const float s0 = sc[k], s1 = sc[4096 + k], s2 = sc[8192 + k];
#pragma unroll
            for (int j = 0; j < 4; ++j) { acc[0][j] += s0 * w[j]; acc[1][j] += s1 * w[j]; acc[2][j] += s2 * w[j]; } }
#pragma unroll
        for (int r = 0; r < 3; ++r)
#pragma unroll
            for (int j = 0; j < 4; ++j) { float v = acc[r][j]; v += __shfl_xor(v, 16); v += __shfl_xor(v, 32); acc[r][j] = v; }
        if (lane < 16) {
#pragma unroll
            for (int r = 0; r < 3; ++r)
#pragma unroll
                for (int j = 0; j < 4; ++j) red[(wave * 3 + r) * 64 + lane * 4 + j] = acc[r][j]; }
        __syncthreads();
        if (tid < 192) { const int r = tid >> 6, cc = tid & 63; float s = 0.f;
#pragma unroll
            for (int w = 0; w < 8; ++w) s += red[(w * 3 + r) * 64 + cc];
            const int col = cg * 64 + cc; mod[(size_t)(l * 3 + r) * 12288 + col] = s + b_ada[l * 12288 + col]; }
        __syncthreads();
    }
}
__device__ __forceinline__ void p0_tr_item(const float* W, int N, int K, bf16* WT, int n0s, int n0d, int k0, LAS float* scr, int lane) {
    const int kr = lane >> 4, c4 = lane & 15;
    const float* Wb = uni(W + (size_t)k0 * N + n0s); const unsigned lo = (unsigned)(kr * N + 4 * c4);
    f32x4 w[16];
#pragma unroll
    for (int i = 0; i < 16; ++i) w[i] = LDNT((const f32x4*)(Wb + lo + (unsigned)(4 * i * N)));
#pragma unroll
    for (int i = 0; i < 16; ++i) { const int k = 4 * i + kr;
        scr[(4 * c4 + 0) * 65 + k] = w[i][0]; scr[(4 * c4 + 1) * 65 + k] = w[i][1]; scr[(4 * c4 + 2) * 65 + k] = w[i][2]; scr[(4 * c4 + 3) * 65 + k] = w[i][3]; }
    LDS_WAIT(); asm volatile("" ::: "memory");
    bf16* ob = uni(WT + (size_t)n0d * K + k0); const int nr = lane >> 3, cch = lane & 7;
#pragma unroll
    for (int i = 0; i < 8; ++i) { const int n = 8 * i + nr; const LAS float* s = scr + n * 65 + 8 * cch;
        v4u o; o.x = cvtpk(s[0], s[1]); o.y = cvtpk(s[2], s[3]); o.z = cvtpk(s[4], s[5]); o.w = cvtpk(s[6], s[7]);
        *(v4u*)(ob + (unsigned)(n * K + 8 * cch)) = o; }
    LDS_WAIT(); asm volatile("" ::: "memory");
}
#ifndef P0_DEFER
#define P0_DEFER 1
#endif
constexpr int I_IN_AB = 64 * 281, I_Q = 16 * 96, I_KV = 8 * 128, I_O = 128 * 64, I_IN_C = 64 * 640, PER_J = I_IN_AB + I_Q + I_KV + I_O + I_IN_C + I_O;
__device__ __forceinline__ void p0_item(KArgs a, int j, int r, LAS float* scr, int lane) {
    if (r < I_IN_AB) { const int kb = r / 281, nb = r % 281, n0 = nb * 64;
        p0_tr_item(GIN(a, 8) + (size_t)j * DM * N_ABSRC, N_ABSRC, DM, (bf16*)(GWS(a) + WS_WIN_AB) + (size_t)j * N_AB * DM, n0, n0 + (n0 >= 1600 ? 192 : 0), kb * 64, scr, lane); return; } r -= I_IN_AB;
    if (r < I_Q) { const int kb = r / 96, nb = r % 96;
        p0_tr_item(GIN(a, 11) + (size_t)j * QL * NQ, NQ, QL, (bf16*)(GWS(a) + WS_WQ) + (size_t)j * NQ * QL, nb * 64, nb * 64, kb * 64, scr, lane); return; } r -= I_Q;
    if (r < I_KV) { const int kb = r / 128, nb = r % 128;
        p0_tr_item(GIN(a, 12) + (size_t)j * KVL * NKV, NKV, KVL, (bf16*)(GWS(a) + WS_WKV) + (size_t)j * NKV * KVL, nb * 64, nb * 64, kb * 64, scr, lane); return; } r -= I_KV;
    if (r < I_O) { const int kb = r / 64, nb = r % 64;
        p0_tr_item(GIN(a, 17) + (size_t)j * MIXW * DM, DM, MIXW, (bf16*)(GWS(a) + WS_WO_AB) + (size_t)j * DM * MIXW, nb * 64, nb * 64, kb * 64, scr, lane); return; } r -= I_O;
    if (r < I_IN_C) { const int kb = r / 640, nb = r % 640;
        p0_tr_item(GIN(a, 18) + (size_t)j * DM * N_C, N_C, DM, (bf16*)(GWS(a) + WS_WIN_C) + (size_t)j * N_C * DM, nb * 64, nb * 64, kb * 64, scr, lane); return; } r -= I_IN_C;
    { const int kb = r / 64, nb = r % 64;
        p0_tr_item(GIN(a, 21) + (size_t)j * MIXW * DM, DM, MIXW, (bf16*)(GWS(a) + WS_WO_C) + (size_t)j * DM * MIXW, nb * 64, nb * 64, kb * 64, scr, lane); }
}
constexpr int P0_ND = I_O + PER_J;
#ifndef P0_B1
#define P0_B1 25984
#endif
#ifndef P0_B2
#define P0_B2 51936
#endif
constexpr int P0_B3 = P0_ND - I_O;
static_assert(P0_B1 >= I_O && P0_B1 <= P0_B2 && P0_B2 >= I_O + I_IN_AB && P0_B2 <= P0_B3, "deferred-slot deadlines");
__device__ __forceinline__ bool p0_defer_on(int G) { return P0_DEFER && (G % pg8::NXCD == 0); }
__device__ __forceinline__ void p0_deferred(KArgs a, LAS unsigned char* lds, const pg8::LockstepOrder& S, int slot) {
    const int lenmax = S.PG * pg8::LockstepOrder::LW * S.nN + S.qR + (S.rR > 0 ? 1 : 0), R = (lenmax + S.nk - 1) / S.nk, kcut = lenmax - (R - 1) * S.nk;
    const bool all = kcut >= S.nk;
    if (!all && S.k < kcut) return;
    int tid_l = threadIdx.x; asm volatile("" : "+v"(tid_l)); const int lane = tid_l & 63, wave = __builtin_amdgcn_readfirstlane(tid_l >> 6);
    const int rank = all ? S.c : (S.k - kcut) * pg8::NXCD + S.x, nw = (all ? S.G : pg8::NXCD * (S.nk - kcut)) * NWAVES;
    __syncthreads();
    LAS float* scr = (LAS float*)(lds + wave * 16640);
    const int lo_ = slot == 0 ? 0 : slot == 1 ? P0_B1 : slot == 2 ? P0_B2 : P0_B3, hi_ = slot == 0 ? P0_B1 : slot == 1 ? P0_B2 : slot == 2 ? P0_B3 : P0_ND;
    for (int d = lo_ + rank * NWAVES + wave; d < hi_; d += nw) {
        const int j = d < I_O ? 0 : 1, r = d < I_O ? PER_J - I_O + d : d - I_O; p0_item(a, j, r, scr, lane); }
    __syncthreads();
}
__device__ __forceinline__ void p0_prologue(KArgs a, LAS unsigned char* lds, int G) {
    int tid_l = threadIdx.x; asm volatile("" : "+v"(tid_l)); const int tid = tid_l, lane = tid & 63, wave = __builtin_amdgcn_readfirstlane(tid >> 6);
    __syncthreads();
    p0_gemv(a, lds, G);
    __syncthreads();
    LAS float* scr = (LAS float*)(lds + wave * 16640);
    const int gw = blockIdx.x * NWAVES + wave, NGW = G * NWAVES;
    const bool defer = p0_defer_on(G);
    const int NIT = defer ? PER_J - I_O : 2 * PER_J;
    for (int it = gw; it < NIT; it += NGW) {
        const int j = defer ? (it < PER_J - I_O ? 0 : 1) : it / PER_J, r = defer ? (it < PER_J - I_O ? it : it - (PER_J - I_O)) : it % PER_J;
        p0_item(a, j, r, scr, lane);
    }
    const size_t gt = (size_t)blockIdx.x * 512 + tid, NGT = (size_t)G * 512;
    for (size_t i = gt; i < (size_t)2 * 192 * DM / 8; i += NGT) { const size_t j = i / (192 * DM / 8), e = i % (192 * DM / 8);
        *(v4u*)((bf16*)(GWS(a) + WS_WIN_AB) + j * (size_t)N_AB * DM + (size_t)1600 * DM + e * 8) = (v4u){0u, 0u, 0u, 0u}; }
    { const float* lg = GIN(a, 19); float* oml = (float*)(GWS(a) + WS_OML);
      for (size_t i = gt; i < (size_t)2 * 2 * 8192; i += NGT) { const int jc = (int)(i >> 14), de = (int)(i & 16383);
          const float l0 = lg[0 * 16384 + de], l1 = lg[1 * 16384 + de], l2 = lg[2 * 16384 + de], l3 = lg[3 * 16384 + de];
          const float mx = fmaxf(fmaxf(l0, l1), fmaxf(l2, l3)); const float e0 = __expf(l0 - mx), e1 = __expf(l1 - mx), e2 = __expf(l2 - mx), e3 = __expf(l3 - mx);
          const float inv = 1.0f / (e0 + e1 + e2 + e3); const float lb = (jc == 0) ? e1 * inv : (e1 + e2 + e3) * inv;
          oml[i] = 1.0f - lb; } }
    { f32x2* rope = (f32x2*)(GWS(a) + WS_ROPE);
      for (size_t i = gt; i < 128 * 16; i += NGT) { const int pos = (int)(i >> 4), f = (int)(i & 15); const float inv = powf(10000.0f, -(float)f / 16.0f); const float ang = (float)pos * inv;
          rope[i] = (f32x2){cosf(ang), sinf(ang)}; } }
}

__device__ __forceinline__ void norm_phase(KArgs a, int lpost, int lpre, int G) {
    int tid_l = threadIdx.x; asm volatile("" : "+v"(tid_l)); const int tid = tid_l, lane = tid & 63, wave = __builtin_amdgcn_readfirstlane(tid >> 6);
    const int gw = blockIdx.x * NWAVES + wave, NGW = G * NWAVES;
    const float* mod = (const float*)(GWS(a) + WS_MOD);
    float* XS = (float*)(GWS(a) + WS_XS); const float* Y = (const float*)(GWS(a) + WS_Y); bf16* H = (bf16*)(GWS(a) + WS_H);
    const int nrows = (lpost == 3) ? MLAT : MTOT;
    for (int row = gw; row < nrows; row += NGW) {
        const int rt = row < SEQ ? 0 : (row < MLAT ? 1 : 2);
        const float* xin = uni((lpost <= 0) ? (row < MLAT ? GIN(a, 0) + (size_t)row * DM : GIN(a, 2) + (size_t)(row - MLAT) * DM) : XS + (size_t)row * DM);
        f32x4 xv[16];
#pragma unroll
        for (int j = 0; j < 16; ++j) xv[j] = LDNT((const f32x4*)(xin + lane * 4 + 256 * j));
        if (lpost >= 0) {
            f32x4 yv[16]; float ss = 0.f;
            if (row < MLAT) { const bf16* yr = uni((const bf16*)Y + (size_t)row * DM);
#pragma unroll
                for (int j = 0; j < 16; ++j) { const u32x2 w = LDNT((const u32x2*)(yr + lane * 4 + 256 * j)); yv[j] = (f32x4){bf_lo(w.x), bf_hi(w.x), bf_lo(w.y), bf_hi(w.y)}; } }
            else {
                const float* yr = uni((const float*)(GWS(a) + WS_YP) + (size_t)(row - MLAT) * DM);
#pragma unroll
                for (int j = 0; j < 16; ++j) yv[j] = *(const f32x4*)(yr + lane * 4 + 256 * j);
                for (int kc = 1; kc < 8; ++kc) { const float* yk = uni(yr + (size_t)kc * (MTOT - MLAT) * DM);
#pragma unroll
                    for (int j = 0; j < 16; ++j) { yv[j] = yv[j] + *(const f32x4*)(yk + lane * 4 + 256 * j); if ((j & 3) == 3) asm volatile("" ::: "memory"); } } }
#pragma unroll
            for (int j = 0; j < 16; ++j) ss += (yv[j][0] * yv[j][0] + yv[j][1] * yv[j][1]) + (yv[j][2] * yv[j][2] + yv[j][3] * yv[j][3]);
            const float r = 1.0f / sqrtf(wave_sum(ss) * (1.0f / DM) + EPS);
            const float* gate = uni(mod + (size_t)(lpost * 3 + rt) * 12288 + 8192); const float* pw = uni(GIN(a, 7) + (size_t)lpost * DM);
            float* xout = uni((lpost == 3) ? GOUT(a) + (size_t)row * DM : XS + (size_t)row * DM);
#pragma unroll
            for (int j = 0; j < 16; ++j) { const int col = lane * 4 + 256 * j; const f32x4 g = *(const f32x4*)(gate + col), w = *(const f32x4*)(pw + col);
                xv[j] = xv[j] + g * ((yv[j] * r) * w); STNT((f32x4*)(xout + col), xv[j]);
                if ((j & 3) == 3) asm volatile("" ::: "memory"); }
        }
        if (lpre < 4) {
            float ss = 0.f;
#pragma unroll
            for (int j = 0; j < 16; ++j) ss += (xv[j][0] * xv[j][0] + xv[j][1] * xv[j][1]) + (xv[j][2] * xv[j][2] + xv[j][3] * xv[j][3]);
            const float r = 1.0f / sqrtf(wave_sum(ss) * (1.0f / DM) + EPS);
            const float* shift = uni(mod + (size_t)(lpre * 3 + rt) * 12288); const float* scale = shift + 4096; const float* pw = uni(GIN(a, 6) + (size_t)lpre * DM);
            bf16* hr = uni(H + (size_t)row * DM);
#pragma unroll
            for (int j = 0; j < 16; ++j) { const int col = lane * 4 + 256 * j; const f32x4 sh = *(const f32x4*)(shift + col), sc = *(const f32x4*)(scale + col), w = *(const f32x4*)(pw + col);
                const f32x4 h = ((xv[j] * r) * w) * (sc + 1.0f) + sh; u32x2 o; o.x = cvtpk(h[0], h[1]); o.y = cvtpk(h[2], h[3]); *(u32x2*)(hr + col) = o;
                if ((j & 3) == 3) asm volatile("" ::: "memory"); }
        }
    }
}

__device__ __forceinline__ void a2_rows(KArgs a, int j, int G) {
    int tid_l = threadIdx.x; asm volatile("" : "+v"(tid_l)); const int tid = tid_l, lane = tid & 63, wave = __builtin_amdgcn_readfirstlane(tid >> 6);
    const int gw = blockIdx.x * NWAVES + wave, NGW = G * NWAVES;
    const bf16* G1 = (const bf16*)(GWS(a) + WS_G1); bf16* QN = (bf16*)(GWS(a) + WS_QN); bf16* KVN = (bf16*)(GWS(a) + WS_KVN); bf16* KR = (bf16*)(GWS(a) + WS_KR);
    f32x2* stat = (f32x2*)(GWS(a) + WS_STAT); const f32x2* rope = (const f32x2*)(GWS(a) + WS_ROPE);
    const float* qw = GIN(a, 9) + (size_t)j * QL; const float* kvw = GIN(a, 10) + (size_t)j * KVL;
    for (int row = gw; row < MTOT; row += NGW) {
        const bf16* g = uni(G1 + (size_t)row * N_AB);
        {
            v4u w[2]; float x[16]; float ss = 0.f;
#pragma unroll
            for (int i = 0; i < 2; ++i) { w[i] = LDNT((const v4u*)(g + lane * 8 + 512 * i));
#pragma unroll
                for (int e = 0; e < 4; ++e) { x[8 * i + 2 * e] = bf_lo(w[i][e]); x[8 * i + 2 * e + 1] = bf_hi(w[i][e]); } }
#pragma unroll
            for (int e = 0; e < 16; ++e) ss += x[e] * x[e];
            const float r = 1.0f / sqrtf(wave_sum(ss) * (1.0f / QL) + EPS);
#pragma unroll
            for (int i = 0; i < 2; ++i) { const int col = lane * 8 + 512 * i; const f32x4 w0 = *(const f32x4*)(qw + col), w1 = *(const f32x4*)(qw + col + 4);
                v4u o; o.x = cvtpk(x[8 * i + 0] * r * w0[0], x[8 * i + 1] * r * w0[1]); o.y = cvtpk(x[8 * i + 2] * r * w0[2], x[8 * i + 3] * r * w0[3]);
                o.z = cvtpk(x[8 * i + 4] * r * w1[0], x[8 * i + 5] * r * w1[1]); o.w = cvtpk(x[8 * i + 6] * r * w1[2], x[8 * i + 7] * r * w1[3]);
                *(v4u*)(QN + (size_t)row * QL + col) = o; }
        }
        {
            const v4u w = LDNT((const v4u*)(g + G1_CKV + lane * 8)); float x[8]; float ss = 0.f;
#pragma unroll
            for (int e = 0; e < 4; ++e) { x[2 * e] = bf_lo(w[e]); x[2 * e + 1] = bf_hi(w[e]); }
#pragma unroll
            for (int e = 0; e < 8; ++e) ss += x[e] * x[e];
            const float r = 1.0f / sqrtf(wave_sum(ss) * (1.0f / KVL) + EPS);
            const int col = lane * 8; const f32x4 w0 = *(const f32x4*)(kvw + col), w1 = *(const f32x4*)(kvw + col + 4);
            v4u o; o.x = cvtpk(x[0] * r * w0[0], x[1] * r * w0[1]); o.y = cvtpk(x[2] * r * w0[2], x[3] * r * w0[3]); o.z = cvtpk(x[4] * r * w1[0], x[5] * r * w1[1]); o.w = cvtpk(x[6] * r * w1[2], x[7] * r * w1[3]);
            *(v4u*)(KVN + (size_t)row * KVL + col) = o;
        }
        {
            const float x = __uint_as_float((unsigned)g[G1_KR + lane] << 16); const float xp = __shfl_xor(x, 16); float o = x;
            if (row < MLAT) { const int t = row & (SEQ - 1), ax = lane >> 5, hh = (lane >> 4) & 1, f = lane & 15, pos = ax == 0 ? (t >> 6) : (t & 63); const f32x2 cs = rope[pos * 16 + f];
                o = hh == 0 ? x * cs.x - xp * cs.y : x * cs.x + xp * cs.y; }
            KR[(size_t)row * 64 + lane] = (bf16)(cvtpk(o, 0.f) & 0xffffu);
        }
        {
            float x[64]; float s = 0.f;
#pragma unroll
            for (int i = 0; i < 8; ++i) { const v4u w = *(const v4u*)(g + G1_VB + lane * 8 + 512 * i);
#pragma unroll
                for (int e = 0; e < 4; ++e) { x[8 * i + 2 * e] = bf_lo(w[e]); x[8 * i + 2 * e + 1] = bf_hi(w[e]); } }
#pragma unroll
            for (int e = 0; e < 64; ++e) s += x[e];
            const float mean = wave_sum(s) * (1.0f / 4096.0f); float q = 0.f;
#pragma unroll
            for (int e = 0; e < 64; ++e) { const float d = x[e] - mean; q += d * d; }
            const float rstd = 1.0f / sqrtf(wave_sum(q) * (1.0f / 4096.0f) + EPS);
            if (lane == 0) stat[row] = (f32x2){mean, rstd};
        }
    }
}

typedef short s16x4 __attribute__((ext_vector_type(4)));
typedef float f32x16 __attribute__((ext_vector_type(16)));
#define SBAR() __builtin_amdgcn_sched_barrier(0)
__device__ __forceinline__ f32x4 mfma16(bf16x8 a, bf16x8 b, f32x4 c) { return __builtin_amdgcn_mfma_f32_16x16x32_bf16(a, b, c, 0, 0, 0); }
__device__ __forceinline__ int crow(int r, int hi) { return (r & 3) + 8 * (r >> 2) + 4 * hi; }
__device__ __forceinline__ int v_st(int k, int c) { const int kk = (k & ~0xC) | ((k & 4) << 1) | ((k & 8) >> 1); return ((kk >> 3) * 4 + (c >> 5)) * 512 + ((kk & 7) * 32 + (c & 31)) * 2; }
__device__ __forceinline__ int v_rd_base(int lane) { return ((lane & 3) << 3) | (((lane >> 2) & 3) << 6) | (((lane >> 4) & 1) << 5) | (((lane >> 5) & 1) << 8); }
constexpr int v_rd_off(int d0, int ks, int half) { return d0 * 512 + ks * 4096 + half * 2048; }
template <int OFF> __device__ __forceinline__ s16x4 tr_read(int vb) {
    s16x4 r; asm volatile("ds_read_b64_tr_b16 %0, %1 offset:%2" : "=&v"(r) : "v"(vb), "i"(OFF) : "memory"); return r;
}
template <int D0> __device__ __forceinline__ void pv_one(f32x16& od, int vb, bf16x8 pa0, bf16x8 pa1, bf16x8 pa2, bf16x8 pa3) {
    const s16x4 l0 = tr_read<v_rd_off(D0, 0, 0)>(vb), h0 = tr_read<v_rd_off(D0, 0, 1)>(vb), l1 = tr_read<v_rd_off(D0, 1, 0)>(vb), h1 = tr_read<v_rd_off(D0, 1, 1)>(vb);
    const s16x4 l2 = tr_read<v_rd_off(D0, 2, 0)>(vb), h2 = tr_read<v_rd_off(D0, 2, 1)>(vb), l3 = tr_read<v_rd_off(D0, 3, 0)>(vb), h3 = tr_read<v_rd_off(D0, 3, 1)>(vb);
    asm volatile("s_waitcnt lgkmcnt(0)" ::: "memory"); SBAR();
#define PKV(L, H) (bf16x8){L[0], L[1], L[2], L[3], H[0], H[1], H[2], H[3]}
    od = __builtin_amdgcn_mfma_f32_32x32x16_bf16(pa0, PKV(l0, h0), od, 0, 0, 0);
    od = __builtin_amdgcn_mfma_f32_32x32x16_bf16(pa1, PKV(l1, h1), od, 0, 0, 0);
    od = __builtin_amdgcn_mfma_f32_32x32x16_bf16(pa2, PKV(l2, h2), od, 0, 0, 0);
    od = __builtin_amdgcn_mfma_f32_32x32x16_bf16(pa3, PKV(l3, h3), od, 0, 0, 0);
#undef PKV
}
__device__ __forceinline__ void pv_d0(f32x16* o, int vb, bf16x8 pa0, bf16x8 pa1, bf16x8 pa2, bf16x8 pa3) {
    pv_one<0>(o[0], vb, pa0, pa1, pa2, pa3); pv_one<1>(o[1], vb, pa0, pa1, pa2, pa3); pv_one<2>(o[2], vb, pa0, pa1, pa2, pa3); pv_one<3>(o[3], vb, pa0, pa1, pa2, pa3);
}

template <int I> __device__ __forceinline__ void pv_rd(int vb, s16x4& l0, s16x4& h0, s16x4& l1, s16x4& h1) {
    l0 = tr_read<v_rd_off(I >> 1, 2 * (I & 1), 0)>(vb); h0 = tr_read<v_rd_off(I >> 1, 2 * (I & 1), 1)>(vb); l1 = tr_read<v_rd_off(I >> 1, 2 * (I & 1) + 1, 0)>(vb); h1 = tr_read<v_rd_off(I >> 1, 2 * (I & 1) + 1, 1)>(vb);
}
#define PKV2(L, H) (bf16x8){L[0], L[1], L[2], L[3], H[0], H[1], H[2], H[3]}
#define PV_MM(I, A0, A1, L0, H0, L1, H1) do { o[(I) >> 1] = __builtin_amdgcn_mfma_f32_32x32x16_bf16(A0, PKV2(L0, H0), o[(I) >> 1], 0, 0, 0); o[(I) >> 1] = __builtin_amdgcn_mfma_f32_32x32x16_bf16(A1, PKV2(L1, H1), o[(I) >> 1], 0, 0, 0); } while (0)
#define PV_WAIT4() do { asm volatile("s_waitcnt lgkmcnt(4)" ::: "memory"); SBAR(); } while (0)
#define PV_WAIT0() do { asm volatile("s_waitcnt lgkmcnt(0)" ::: "memory"); SBAR(); } while (0)
__device__ __forceinline__ void pv_pipe(f32x16* o, int vb, bf16x8 pa0, bf16x8 pa1, bf16x8 pa2, bf16x8 pa3) {
    s16x4 al0, ah0, al1, ah1, bl0, bh0, bl1, bh1;
    asm volatile("s_waitcnt lgkmcnt(0)" ::: "memory"); SBAR();
    pv_rd<0>(vb, al0, ah0, al1, ah1); pv_rd<1>(vb, bl0, bh0, bl1, bh1);
    PV_WAIT4(); PV_MM(0, pa0, pa1, al0, ah0, al1, ah1); SBAR(); pv_rd<2>(vb, al0, ah0, al1, ah1);
    PV_WAIT4(); PV_MM(1, pa2, pa3, bl0, bh0, bl1, bh1); SBAR(); pv_rd<3>(vb, bl0, bh0, bl1, bh1);
    PV_WAIT4(); PV_MM(2, pa0, pa1, al0, ah0, al1, ah1); SBAR(); pv_rd<4>(vb, al0, ah0, al1, ah1);
    PV_WAIT4(); PV_MM(3, pa2, pa3, bl0, bh0, bl1, bh1); SBAR(); pv_rd<5>(vb, bl0, bh0, bl1, bh1);
    PV_WAIT4(); PV_MM(4, pa0, pa1, al0, ah0, al1, ah1); SBAR(); pv_rd<6>(vb, al0, ah0, al1, ah1);
    PV_WAIT4(); PV_MM(5, pa2, pa3, bl0, bh0, bl1, bh1); SBAR(); pv_rd<7>(vb, bl0, bh0, bl1, bh1);
    PV_WAIT4(); PV_MM(6, pa0, pa1, al0, ah0, al1, ah1);
    PV_WAIT0(); PV_MM(7, pa2, pa3, bl0, bh0, bl1, bh1);
}

__device__ __forceinline__ void pv_seq(f32x16* o, int vb, bf16x8 pa0, bf16x8 pa1, bf16x8 pa2, bf16x8 pa3) {
    s16x4 al0, ah0, al1, ah1;
    pv_rd<0>(vb, al0, ah0, al1, ah1); PV_WAIT0(); PV_MM(0, pa0, pa1, al0, ah0, al1, ah1); SBAR();
    pv_rd<1>(vb, al0, ah0, al1, ah1); PV_WAIT0(); PV_MM(1, pa2, pa3, al0, ah0, al1, ah1); SBAR();
    pv_rd<2>(vb, al0, ah0, al1, ah1); PV_WAIT0(); PV_MM(2, pa0, pa1, al0, ah0, al1, ah1); SBAR();
    pv_rd<3>(vb, al0, ah0, al1, ah1); PV_WAIT0(); PV_MM(3, pa2, pa3, al0, ah0, al1, ah1); SBAR();
    pv_rd<4>(vb, al0, ah0, al1, ah1); PV_WAIT0(); PV_MM(4, pa0, pa1, al0, ah0, al1, ah1); SBAR();
    pv_rd<5>(vb, al0, ah0, al1, ah1); PV_WAIT0(); PV_MM(5, pa2, pa3, al0, ah0, al1, ah1); SBAR();
    pv_rd<6>(vb, al0, ah0, al1, ah1); PV_WAIT0(); PV_MM(6, pa0, pa1, al0, ah0, al1, ah1); SBAR();
    pv_rd<7>(vb, al0, ah0, al1, ah1); PV_WAIT0(); PV_MM(7, pa2, pa3, al0, ah0, al1, ah1);
}

__device__ __forceinline__ void sgu_phase(KArgs a, int j, LAS unsigned char* lds, int G) {
    int tid_l = threadIdx.x; asm volatile("" : "+v"(tid_l)); const int tid = tid_l, lane = tid & 63, wid = __builtin_amdgcn_readfirstlane(tid >> 6), r32 = lane & 31, hi = lane >> 5;
    const bf16* G1 = (const bf16*)(GWS(a) + WS_G1); bf16* CC = (bf16*)(GWS(a) + WS_CC); const f32x2* stat = (const f32x2*)(GWS(a) + WS_STAT);
    const float* lnw = GIN(a, 13) + (size_t)j * 4096; const float* lnb = GIN(a, 14) + (size_t)j * 4096; const float* ws_all = GIN(a, 15) + (size_t)j * 16 * 128 * 128; const float* bs = GIN(a, 16) + (size_t)j * 16 * 128;
    constexpr int MXP = 272, OFF_ST = 69632;
    LAS float* st_mean = (LAS float*)(lds + OFF_ST); LAS float* st_rstd = st_mean + 128;
    LAS float* m1s = (LAS float*)(lds + OFF_ST + 1024) + wid * 64; LAS float* rss = m1s + 32;
    LAS unsigned char* mx = lds + wid * (32 * MXP);
    const int sr = tid >> 4, sc = (tid & 15) * 8, vst0 = v_st(sr, sc), vst1 = v_st(32 + sr, sc);
    const int tb = wid >> 1, ch = wid & 1;
    const int vb0 = (int)(unsigned)(unsigned long long)lds + v_rd_base(lane);
    v4u vx[8];
#define SGU_LOADV(it_) do { const int ch_ = (it_) >> 4, g_ = (it_) & 15; const bf16* s0_ = uni(G1 + (size_t)(ch_ * 128) * N_AB + G1_VB + g_ * 256); const unsigned lo_ = (unsigned)(sr * N_AB + sc); \
    _Pragma("unroll") for (int st = 0; st < 2; ++st) _Pragma("unroll") for (int c2 = 0; c2 < 2; ++c2) { const unsigned o_ = lo_ + (unsigned)(64 * st * N_AB + c2 * 128); \
        vx[(st * 2 + c2) * 2] = LDNT((const v4u*)(s0_ + o_)); vx[(st * 2 + c2) * 2 + 1] = LDNT((const v4u*)(s0_ + o_ + 32 * N_AB)); } } while (0)
    const int item0 = (int)((blockIdx.x + 128u) % (unsigned)G);
    if (item0 < 132 * 16) SGU_LOADV(item0);
    for (int item = item0; item < 132 * 16; item += G) {
        const int chunk = item >> 4, g = item & 15, row0 = chunk * 128;
        __syncthreads();
#pragma unroll
        for (int q = 0; q < 4; ++q) { *(LAS v4u*)(lds + q * 16384 + vst0) = vx[2 * q]; *(LAS v4u*)(lds + q * 16384 + vst1) = vx[2 * q + 1]; }
        if (tid < 128) { const f32x2 s = stat[row0 + tid]; st_mean[tid] = s.x; st_rstd[tid] = s.y; }
        __syncthreads();
        if (item + G < 132 * 16) SGU_LOADV(item + G);
        const float* wrow = ws_all + ((size_t)g * 128 + 32 * tb + r32) * 128;
        bf16x8 pa[2][4]; float m1 = 0.f, rs = 0.f;
#pragma unroll
        for (int st = 0; st < 2; ++st)
#pragma unroll
            for (int ks = 0; ks < 4; ++ks) { const int s0 = 64 * st + 16 * ks + 8 * hi; const f32x4 w0 = *(const f32x4*)(wrow + s0), w1 = *(const f32x4*)(wrow + s0 + 4);
                const f32x4 r0 = *(const LAS f32x4*)(st_rstd + s0), r1 = *(const LAS f32x4*)(st_rstd + s0 + 4), mu0 = *(const LAS f32x4*)(st_mean + s0), mu1 = *(const LAS f32x4*)(st_mean + s0 + 4);
                rs += (w0[0] + w0[1]) + (w0[2] + w0[3]) + (w1[0] + w1[1]) + (w1[2] + w1[3]);
                v4u p; p.x = cvtpk(w0[0] * r0[0], w0[1] * r0[1]); p.y = cvtpk(w0[2] * r0[2], w0[3] * r0[3]); p.z = cvtpk(w1[0] * r1[0], w1[1] * r1[1]); p.w = cvtpk(w1[2] * r1[2], w1[3] * r1[3]);
                m1 += bf_lo(p.x) * mu0[0] + bf_hi(p.x) * mu0[1] + bf_lo(p.y) * mu0[2] + bf_hi(p.y) * mu0[3] + bf_lo(p.z) * mu1[0] + bf_hi(p.z) * mu1[1] + bf_lo(p.w) * mu1[2] + bf_hi(p.w) * mu1[3];
                pa[st][ks] = __builtin_bit_cast(bf16x8, p); }
        m1 += __shfl_xor(m1, 32); rs += __shfl_xor(rs, 32);
        if (hi == 0) { m1s[r32] = m1; rss[r32] = rs; }
        f32x16 o[4];
#pragma unroll
        for (int d = 0; d < 4; ++d)
#pragma unroll
            for (int r = 0; r < 16; ++r) o[d][r] = 0.f;
#pragma unroll
        for (int st = 0; st < 2; ++st) pv_d0(o, vb0 + (st * 2 + ch) * 16384, pa[st][0], pa[st][1], pa[st][2], pa[st][3]);
        asm volatile("s_waitcnt lgkmcnt(0)" ::: "memory");
        __syncthreads();
        { const int cb = g * 256 + ch * 128;
          const float* lw = uni(lnw + cb); const float* lb = uni(lnb + cb); const float* bsg = uni(bs + g * 128 + 32 * tb);
          int r32e = r32, hie = hi; asm volatile("" : "+v"(r32e), "+v"(hie));
          float lwv[4], lbv[4];
#pragma unroll
          for (int d0 = 0; d0 < 4; ++d0) { lwv[d0] = lw[d0 * 32 + r32e]; lbv[d0] = lb[d0 * 32 + r32e]; }
#pragma unroll
          for (int r = 0; r < 16; ++r) { const int rr = crow(r, hie); const float m1t = m1s[rr], rst = rss[rr], bst = bsg[rr];
#pragma unroll
            for (int d0 = 0; d0 < 4; ++d0) { const float mix = lwv[d0] * (o[d0][r] - m1t) + lbv[d0] * rst + bst;
                *(LAS bf16*)(mx + rr * MXP + (d0 * 32 + r32e) * 2) = (bf16)(cvtpk(mix, 0.f) & 0xffffu); } } }
        asm volatile("s_waitcnt lgkmcnt(0)" ::: "memory");
        { const int cb = g * 256 + ch * 128;
          const bf16* Gu = uni(G1 + (size_t)(row0 + 32 * tb) * N_AB + G1_UB + cb); const bf16* Gzb = uni(G1 + (size_t)(row0 + 32 * tb) * N_AB + G1_ZB + cb); bf16* Co = uni(CC + (size_t)(row0 + 32 * tb) * MIXW + 4096 + cb);
          int le = lane; asm volatile("" : "+v"(le));
#pragma unroll
          for (int i = 0; i < 8; ++i) { const int id = 64 * i + le, row = id >> 4, c8 = (id & 15) * 8;
              const v4u mq = *(const LAS v4u*)(mx + row * MXP + c8 * 2); const v4u uq = LDNT((const v4u*)(Gu + (unsigned)(row * N_AB + c8))), zq = LDNT((const v4u*)(Gzb + (unsigned)(row * N_AB + c8)));
              v4u oq;
#pragma unroll
              for (int e = 0; e < 4; ++e) oq[e] = cvtpk(bf_lo(uq[e]) * bf_lo(mq[e]) * bf_lo(zq[e]), bf_hi(uq[e]) * bf_hi(mq[e]) * bf_hi(zq[e]));
              *(v4u*)(Co + (unsigned)(row * MIXW + c8)) = oq;
              if ((i & 3) == 3) asm volatile("" ::: "memory"); } }
    }
#undef SGU_LOADV
    __syncthreads();
}

namespace att {
constexpr int QBLK = 32, KVBLK = 64;
constexpr float SCALE = 0.07216878364870322f;
constexpr float THR = 8.f;
constexpr int SHM_V = KVBLK * 128 * 2, SHM_K = KVBLK * 192 * 2;
#ifndef STG_SEL
#define STG_SEL 0
#endif
#ifndef ATT_STAGGER
#define ATT_STAGGER 1
#endif
constexpr int NVB = ATT_STAGGER ? 3 : 2;
constexpr int OFF_V = 0, OFF_K = NVB * SHM_V, OFF_WS = OFF_K + 2 * SHM_K, ATT_LDS = OFF_WS + NWAVES * 64 * 4;
#ifndef ATT_QR_LDS
#define ATT_QR_LDS 1
#endif
#ifndef ATT_SDEPTH
#define ATT_SDEPTH 1
#endif
constexpr int SDEPTH = ATT_SDEPTH;
constexpr float THRL = THR * 1.4426950408889634f;
__device__ __forceinline__ void partialSM_first(f32x16& p0, f32x16& p1, float& m_reg, float& alpha) {
    float pmax = p0[0];
#pragma unroll
    for (int r = 1; r < 16; ++r) pmax = fmaxf(pmax, p0[r]);
#pragma unroll
    for (int r = 0; r < 16; ++r) pmax = fmaxf(pmax, p1[r]);
    { auto rr = __builtin_amdgcn_permlane32_swap(__float_as_uint(pmax), __float_as_uint(pmax), false, false);
      pmax = fmaxf(__uint_as_float(rr[0]), __uint_as_float(rr[1])); }
    m_reg = pmax; alpha = 1.f;
#pragma unroll
    for (int r = 0; r < 16; ++r) p0[r] = p0[r] - pmax;
#pragma unroll
    for (int r = 0; r < 16; ++r) p1[r] = p1[r] - pmax;
#pragma unroll
    for (int r = 0; r < 16; ++r) p0[r] = __builtin_amdgcn_exp2f(p0[r]);
}
__device__ __forceinline__ void partialSM(f32x16& p0, f32x16& p1, float& m_reg, float& alpha) {
    float pmax = p0[0];
#pragma unroll
    for (int r = 1; r < 16; ++r) pmax = fmaxf(pmax, p0[r]);
#pragma unroll
    for (int r = 0; r < 16; ++r) pmax = fmaxf(pmax, p1[r]);
    { auto rr = __builtin_amdgcn_permlane32_swap(__float_as_uint(pmax), __float_as_uint(pmax), false, false);
      pmax = fmaxf(__uint_as_float(rr[0]), __uint_as_float(rr[1])); }
    if (__builtin_expect(__all(pmax <= THRL), 1)) { alpha = 1.f; }
    else { const float d = fmaxf(pmax, 0.f); alpha = __builtin_amdgcn_exp2f(-d); m_reg += d;
#pragma unroll
        for (int r = 0; r < 16; ++r) p0[r] = p0[r] - d;
#pragma unroll
        for (int r = 0; r < 16; ++r) p1[r] = p1[r] - d; }
#pragma unroll
    for (int r = 0; r < 16; ++r) p0[r] = __builtin_amdgcn_exp2f(p0[r]);
}
__device__ __forceinline__ void finishSM(f32x16& p0, f32x16& p1, float alpha, float& l_reg, bf16x8& pa0, bf16x8& pa1, bf16x8& pa2, bf16x8& pa3) {
#pragma unroll
    for (int r = 0; r < 16; ++r) p1[r] = __builtin_amdgcn_exp2f(p1[r]);
    float ps = 0;
#pragma unroll
    for (int r = 0; r < 16; ++r) ps += p0[r];
#pragma unroll
    for (int r = 0; r < 16; ++r) ps += p1[r];
    { auto rr = __builtin_amdgcn_permlane32_swap(__float_as_uint(ps), __float_as_uint(ps), false, false);
      ps = __uint_as_float(rr[0]) + __uint_as_float(rr[1]); }
    l_reg = l_reg * alpha + ps;
#define PK4(P, BASE, OUT) do { unsigned a0 = cvtpk(P[BASE + 0], P[BASE + 1]), a1 = cvtpk(P[BASE + 2], P[BASE + 3]);   \
    unsigned b0 = cvtpk(P[BASE + 4], P[BASE + 5]), b1 = cvtpk(P[BASE + 6], P[BASE + 7]);                              \
    auto r0 = __builtin_amdgcn_permlane32_swap(a0, b0, false, false); auto r1 = __builtin_amdgcn_permlane32_swap(a1, b1, false, false); \
    v4u w = {r0[0], r1[0], r0[1], r1[1]}; OUT = __builtin_bit_cast(bf16x8, w); } while (0)
    PK4(p0, 0, pa0); PK4(p0, 8, pa1); PK4(p1, 0, pa2); PK4(p1, 8, pa3);
#undef PK4
}
constexpr int OFF_KR = 16384;
constexpr int OFF_QR = ATT_LDS, ATT_LDS2 = OFF_QR + NWAVES * 4096;
__device__ __forceinline__ void qkt(f32x16& p0, f32x16& p1, const LAS unsigned char* Ks, const bf16x8* qr, const LAS unsigned char* qrl, int r32, int hi, float seed) {
#pragma unroll
    for (int r = 0; r < 16; ++r) { p0[r] = seed; p1[r] = seed; }
    const int swn = (r32 & 15) << 4, swr = ((r32 >> 1) & 7) << 4;
#pragma unroll
    for (int d0 = 0; d0 < 8; ++d0) { const int cb = (d0 * 16 + hi * 8) * 2;
        const bf16x8 b0 = *(const LAS bf16x8*)(Ks + r32 * 256 + (cb ^ swn));
        const bf16x8 b1 = *(const LAS bf16x8*)(Ks + (32 + r32) * 256 + (cb ^ swn));
        p0 = __builtin_amdgcn_mfma_f32_32x32x16_bf16(b0, qr[d0], p0, 0, 0, 0);
        p1 = __builtin_amdgcn_mfma_f32_32x32x16_bf16(b1, qr[d0], p1, 0, 0, 0); }
#pragma unroll
    for (int d0 = 0; d0 < 4; ++d0) { const int cb = (d0 * 16 + hi * 8) * 2;
        const bf16x8 b0 = *(const LAS bf16x8*)(Ks + OFF_KR + r32 * 128 + (cb ^ swr));
        const bf16x8 b1 = *(const LAS bf16x8*)(Ks + OFF_KR + (32 + r32) * 128 + (cb ^ swr));
#if ATT_QR_LDS
        const bf16x8 q = *(const LAS bf16x8*)(qrl + d0 * 1024);
#else
        const bf16x8 q = qr[8 + d0];
#endif
        p0 = __builtin_amdgcn_mfma_f32_32x32x16_bf16(b0, q, p0, 0, 0, 0);
        p1 = __builtin_amdgcn_mfma_f32_32x32x16_bf16(b1, q, p1, 0, 0, 0); }
}
__device__ __forceinline__ void attn_unit(const bf16* __restrict__ Q, const bf16* __restrict__ KN, const bf16* __restrict__ KR, const bf16* __restrict__ V, const bf16* __restrict__ G1, bf16* __restrict__ CC,
                                          int qrow0, int h, int nt_lat, int lat0, int ctx0, LAS unsigned char* lds) {
    int tid_l = threadIdx.x; asm volatile("" : "+v"(tid_l)); const int tid = tid_l, wid = __builtin_amdgcn_readfirstlane(tid >> 6), lane = tid & 63, r32 = lane & 31, hi = lane >> 5;
    LAS unsigned char* V_lds = lds + OFF_V; LAS unsigned char* K_lds = lds + OFF_K;
    LAS float* wsf = (LAS float*)(lds + OFF_WS) + wid * 64; LAS float* li_l = wsf; LAS float* al_l = wsf + 32;
    LAS unsigned char* qrl = lds + OFF_QR + wid * 4096 + lane * 16;
    float m_reg = -1e30f, l_reg = 0;
    f32x16 o[4];
#pragma unroll
    for (int d = 0; d < 4; ++d)
#pragma unroll
        for (int r = 0; r < 16; ++r) o[d][r] = 0.f;
    const unsigned ko = (unsigned)((tid >> 4) * 128 + (((tid & 15) ^ ((tid >> 4) & 15)) * 8));
    const unsigned kro = (unsigned)((tid >> 3) * 64 + (((tid & 7) ^ ((tid >> 4) & 7)) * 8));
    unsigned vo; { const int sub = tid >> 5, kk = (sub >> 2) * 8 + ((tid & 31) >> 2), col = (sub & 3) * 32 + (tid & 3) * 8, key = (kk & ~0xC) | ((kk & 4) << 1) | ((kk & 8) >> 1); vo = (unsigned)(key * 128 + col); }
    const int vb0 = (int)(unsigned)(unsigned long long)lds + OFF_V + v_rd_base(lane);
    const int NT = nt_lat + 4;
#define TROW(jt) ((jt) < nt_lat ? lat0 + 64 * (jt) : ctx0 + 64 * ((jt) - nt_lat))
#define GLDS(gp, lp) __builtin_amdgcn_global_load_lds((const unsigned*)(gp), (LAS unsigned*)(lp), 16, 0, 0)
#define GLDS_S(gbase, boff, lp) do { const char* gb_ = (const char*)(gbase); asm volatile("" : "+s"(gb_)); unsigned bo_ = (boff); asm volatile("" : "+v"(bo_)); GLDS(gb_ + bo_, lp); } while (0)
#define ISSUE_K(jt, b) do { const int R0_ = TROW(jt); const bf16* Kb_ = uni(KN + ((size_t)h * MTOT + R0_) * 128); const bf16* Rb_ = uni(KR + (size_t)R0_ * 64); \
    GLDS_S(Kb_, ko * 2u, K_lds + (b) * SHM_K + wid * 1024); GLDS_S(Kb_ + 32 * 128, ko * 2u, K_lds + (b) * SHM_K + (wid + 8) * 1024); GLDS_S(Rb_, kro * 2u, K_lds + (b) * SHM_K + OFF_KR + wid * 1024); } while (0)
#define ISSUE_V(jt, b) do { const int R0_ = TROW(jt); const bf16* Vb_ = uni(V + ((size_t)h * MTOT + R0_) * 128); \
    GLDS_S(Vb_, vo * 2u, V_lds + (b) * SHM_V + wid * 1024); GLDS_S(Vb_ + 32 * 128, vo * 2u, V_lds + (b) * SHM_V + (wid + 8) * 1024); } while (0)
#define STEP_END() asm volatile("s_waitcnt vmcnt(0) lgkmcnt(0)\n\ts_barrier" ::: "memory")
#define RESC(a_) do { if (__any((a_) < 1.f)) { if (hi == 0) al_l[r32] = (a_); asm volatile("s_waitcnt lgkmcnt(0)" ::: "memory"); \
    _Pragma("unroll") for (int d = 0; d < 4; ++d) _Pragma("unroll") for (int r = 0; r < 16; ++r) o[d][r] *= al_l[crow(r, hi)]; } } while (0)
    STEP_END();
    ISSUE_K(0, 0);
    bf16x8 qr[ATT_QR_LDS ? 8 : 12];
    { const bf16* Qw = uni(Q + (size_t)(qrow0 + wid * QBLK) * NQ + h * 192); const unsigned qo = (unsigned)(r32 * NQ + hi * 8);
#pragma unroll
      for (int d0 = 0; d0 < (ATT_QR_LDS ? 8 : 12); ++d0) qr[d0] = *(const bf16x8*)(Qw + qo + d0 * 16);
#if ATT_QR_LDS
#pragma unroll
      for (int d0 = 8; d0 < 12; ++d0) { const bf16x8 t = *(const bf16x8*)(Qw + qo + d0 * 16); *(LAS bf16x8*)(qrl + (d0 - 8) * 1024) = t; }
#endif
    }
    f32x16 pA0, pA1, pB0, pB1; float alA, alB; bf16x8 pa0, pa1, pa2, pa3;
    STEP_END();
#if !ATT_STAGGER
    ISSUE_K(1, 1); ISSUE_V(0, 0);
    qkt(pA0, pA1, K_lds, qr, qrl, r32, hi, 0.f); partialSM_first(pA0, pA1, m_reg, alA);
    STEP_END();
    for (int j = 1; j + 1 < NT; j += 2) {
        ISSUE_K(j + 1, 0); ISSUE_V(j, 1);
        SBAR(); qkt(pB0, pB1, K_lds + SHM_K, qr, qrl, r32, hi, -m_reg);
        finishSM(pA0, pA1, alA, l_reg, pa0, pa1, pa2, pa3); SBAR();
        pv_pipe(o, vb0, pa0, pa1, pa2, pa3); partialSM(pB0, pB1, m_reg, alB);
        RESC(alB); STEP_END();
        ISSUE_K(j + 2, 1); ISSUE_V(j + 1, 0);
        SBAR(); qkt(pA0, pA1, K_lds, qr, qrl, r32, hi, -m_reg);
        finishSM(pB0, pB1, alB, l_reg, pa0, pa1, pa2, pa3); SBAR();
        pv_pipe(o, vb0 + SHM_V, pa0, pa1, pa2, pa3); partialSM(pA0, pA1, m_reg, alA);
        RESC(alA); STEP_END();
    }
    ISSUE_V(NT - 1, 1);
    SBAR(); qkt(pB0, pB1, K_lds + SHM_K, qr, qrl, r32, hi, -m_reg);
    finishSM(pA0, pA1, alA, l_reg, pa0, pa1, pa2, pa3); SBAR();
    pv_pipe(o, vb0, pa0, pa1, pa2, pa3); partialSM(pB0, pB1, m_reg, alB);
    RESC(alB); STEP_END();
    finishSM(pB0, pB1, alB, l_reg, pa0, pa1, pa2, pa3); SBAR();
    pv_pipe(o, vb0 + SHM_V, pa0, pa1, pa2, pa3);
#else
#define VOFF(t) (__builtin_amdgcn_readfirstlane(((unsigned)(t) % 3u) * (unsigned)SHM_V))
    if (STG_SEL == 0 ? (wid < 4) : (STG_SEL == 1)) {
        ISSUE_K(1, 1); ISSUE_V(0, 0);
        qkt(pA0, pA1, K_lds, qr, qrl, r32, hi, 0.f); partialSM_first(pA0, pA1, m_reg, alA);
        STEP_END();
        for (int j = 1; j + 1 < NT; j += 2) {
            ISSUE_K(j + 1, 0); ISSUE_V(j, j % 3);
            SBAR(); qkt(pB0, pB1, K_lds + SHM_K, qr, qrl, r32, hi, -m_reg); SBAR();
            finishSM(pA0, pA1, alA, l_reg, pa0, pa1, pa2, pa3); SBAR();
            pv_pipe(o, vb0 + VOFF(j - 1), pa0, pa1, pa2, pa3); partialSM(pB0, pB1, m_reg, alB);
            RESC(alB); STEP_END();
            ISSUE_K(j + 2, 1); ISSUE_V(j + 1, (j + 1) % 3);
            SBAR(); qkt(pA0, pA1, K_lds, qr, qrl, r32, hi, -m_reg); SBAR();
            finishSM(pB0, pB1, alB, l_reg, pa0, pa1, pa2, pa3); SBAR();
            pv_pipe(o, vb0 + VOFF(j), pa0, pa1, pa2, pa3); partialSM(pA0, pA1, m_reg, alA);
            RESC(alA); STEP_END();
        }
        ISSUE_V(NT - 1, (NT - 1) % 3);
        SBAR(); qkt(pB0, pB1, K_lds + SHM_K, qr, qrl, r32, hi, -m_reg); SBAR();
        finishSM(pA0, pA1, alA, l_reg, pa0, pa1, pa2, pa3); SBAR();
        pv_pipe(o, vb0 + VOFF(NT - 2), pa0, pa1, pa2, pa3); partialSM(pB0, pB1, m_reg, alB);
        RESC(alB); STEP_END();
        finishSM(pB0, pB1, alB, l_reg, pa0, pa1, pa2, pa3); SBAR();
        pv_pipe(o, vb0 + VOFF(NT - 1), pa0, pa1, pa2, pa3);
        STEP_END();
        STEP_END();
    } else {
#define TR_EVEN(j_) do { finishSM(pA0, pA1, alA, l_reg, pa0, pa1, pa2, pa3); SBAR(); pv_pipe(o, vb0 + VOFF((j_) - 2), pa0, pa1, pa2, pa3); partialSM(pB0, pB1, m_reg, alB); RESC(alB); } while (0)
#define TR_ODD(j_)  do { finishSM(pB0, pB1, alB, l_reg, pa0, pa1, pa2, pa3); SBAR(); pv_pipe(o, vb0 + VOFF((j_) - 2), pa0, pa1, pa2, pa3); partialSM(pA0, pA1, m_reg, alA); RESC(alA); } while (0)
        ISSUE_K(1, 1); ISSUE_V(0, 0);
        qkt(pA0, pA1, K_lds, qr, qrl, r32, hi, 0.f);
        STEP_END();
        ISSUE_K(2, 0); ISSUE_V(1, 1);
        partialSM_first(pA0, pA1, m_reg, alA);
        SBAR(); qkt(pB0, pB1, K_lds + SHM_K, qr, qrl, r32, hi, -m_reg); SBAR();
        STEP_END();
        for (int j = 2; j + 1 < NT - 1; j += 2) {
            ISSUE_K(j + 1, 1); ISSUE_V(j, j % 3);
            TR_EVEN(j); SBAR(); qkt(pA0, pA1, K_lds, qr, qrl, r32, hi, -m_reg); SBAR();
            STEP_END();
            ISSUE_K(j + 2, 0); ISSUE_V(j + 1, (j + 1) % 3);
            TR_ODD(j + 1); SBAR(); qkt(pB0, pB1, K_lds + SHM_K, qr, qrl, r32, hi, -m_reg); SBAR();
            STEP_END();
        }
        ISSUE_K(NT - 1, 1); ISSUE_V(NT - 2, (NT - 2) % 3);
        TR_EVEN(NT - 2); SBAR(); qkt(pA0, pA1, K_lds, qr, qrl, r32, hi, -m_reg); SBAR();
        STEP_END();
        ISSUE_V(NT - 1, (NT - 1) % 3);
        TR_ODD(NT - 1); SBAR(); qkt(pB0, pB1, K_lds + SHM_K, qr, qrl, r32, hi, -m_reg); SBAR();
        STEP_END();
        TR_EVEN(NT);
        STEP_END();
        finishSM(pB0, pB1, alB, l_reg, pa0, pa1, pa2, pa3); SBAR();
        pv_pipe(o, vb0 + VOFF(NT - 1), pa0, pa1, pa2, pa3);
        STEP_END();
#undef TR_EVEN
#undef TR_ODD
    }
#undef VOFF
#endif
    if (hi == 0) li_l[r32] = l_reg;
    STEP_END();
    { LAS unsigned char* mx = lds + wid * (32 * 272);
      int r32e = r32, hie = hi; asm volatile("" : "+v"(r32e), "+v"(hie));
#pragma unroll
      for (int r = 0; r < 16; ++r) { const int rr = crow(r, hie); const float rli = __builtin_amdgcn_rcpf(li_l[rr]);
#pragma unroll
        for (int d0 = 0; d0 < 4; ++d0) *(LAS bf16*)(mx + rr * 272 + (d0 * 32 + r32e) * 2) = (bf16)(cvtpk(o[d0][r] * rli, 0.f) & 0xffffu); }
      asm volatile("s_waitcnt lgkmcnt(0)" ::: "memory");
      const bf16* Gz = uni(G1 + (size_t)(qrow0 + wid * QBLK) * N_AB + G1_ZA + h * 128); bf16* Co = uni(CC + (size_t)(qrow0 + wid * QBLK) * MIXW + h * 128);
      int le = lane; asm volatile("" : "+v"(le));
#pragma unroll
      for (int i = 0; i < 8; ++i) { const int id = 64 * i + le, row = id >> 4, c8 = (id & 15) * 8;
          const v4u oq = *(const LAS v4u*)(mx + row * 272 + c8 * 2); const v4u zq = LDNT((const v4u*)(Gz + (unsigned)(row * N_AB + c8)));
          v4u wq;
#pragma unroll
          for (int e = 0; e < 4; ++e) wq[e] = cvtpk(bf_lo(oq[e]) * bf_lo(zq[e]), bf_hi(oq[e]) * bf_hi(zq[e]));
          *(v4u*)(Co + (unsigned)(row * MIXW + c8)) = wq;
          if ((i & 3) == 3) asm volatile("" ::: "memory"); } }
#undef TROW
#undef GLDS
#undef ISSUE_K
#undef ISSUE_V
#undef STEP_END
#undef RESC
}
}
namespace att2 {
using namespace att;
struct P8 { f32x4 t[2][4]; };
__device__ __forceinline__ float x16(float x) { return __int_as_float(__builtin_amdgcn_ds_swizzle(__float_as_int(x), 0x401F)); }
__device__ __forceinline__ float rmax4(float x) { x = fmaxf(x, x16(x)); auto rr = __builtin_amdgcn_permlane32_swap(__float_as_uint(x), __float_as_uint(x), false, false); return fmaxf(__uint_as_float(rr[0]), __uint_as_float(rr[1])); }
__device__ __forceinline__ float rsum4(float x) { x = x + x16(x); auto rr = __builtin_amdgcn_permlane32_swap(__float_as_uint(x), __float_as_uint(x), false, false); return __uint_as_float(rr[0]) + __uint_as_float(rr[1]); }
__device__ __forceinline__ float tmax(const P8& p, int qt) { float m = p.t[qt][0][0];
#pragma unroll
    for (int kt = 0; kt < 4; ++kt)
#pragma unroll
        for (int r = 0; r < 4; ++r) m = fmaxf(m, p.t[qt][kt][r]);
    return m; }
__device__ __forceinline__ void qkt2(P8& p, const LAS unsigned char* Ks, const bf16x8 (&qf)[2][4], const LAS unsigned char* qrl, int l16, int g4, float seed0, float seed1) {
#pragma unroll
    for (int kt = 0; kt < 4; ++kt) { p.t[0][kt] = (f32x4){seed0, seed0, seed0, seed0}; p.t[1][kt] = (f32x4){seed1, seed1, seed1, seed1}; }
    const int swn = l16 << 4, swr = ((l16 >> 1) & 7) << 4;
#pragma unroll
    for (int ks = 0; ks < 4; ++ks) { const int cb = (32 * ks + 8 * g4) * 2;
#pragma unroll
        for (int kt = 0; kt < 4; ++kt) { const bf16x8 kf = *(const LAS bf16x8*)(Ks + (16 * kt + l16) * 256 + (cb ^ swn));
            p.t[0][kt] = mfma16(kf, qf[0][ks], p.t[0][kt]); p.t[1][kt] = mfma16(kf, qf[1][ks], p.t[1][kt]); } }
#pragma unroll
    for (int ks = 0; ks < 2; ++ks) { const int cb = (32 * ks + 8 * g4) * 2;
        const bf16x8 q0 = *(const LAS bf16x8*)(qrl + ks * 1024), q1 = *(const LAS bf16x8*)(qrl + (2 + ks) * 1024);
#pragma unroll
        for (int kt = 0; kt < 4; ++kt) { const bf16x8 kf = *(const LAS bf16x8*)(Ks + OFF_KR + (16 * kt + l16) * 128 + (cb ^ swr));
            p.t[0][kt] = mfma16(kf, q0, p.t[0][kt]); p.t[1][kt] = mfma16(kf, q1, p.t[1][kt]); } }
}
__device__ __forceinline__ void sub_all(P8& p, float d0, float d1) {
#pragma unroll
    for (int kt = 0; kt < 4; ++kt) { p.t[0][kt] = p.t[0][kt] - d0; p.t[1][kt] = p.t[1][kt] - d1; } }
__device__ __forceinline__ void exp_half(P8& p, int k0) {
#pragma unroll
    for (int qt = 0; qt < 2; ++qt)
#pragma unroll
        for (int kt = 0; kt < 2; ++kt)
#pragma unroll
            for (int r = 0; r < 4; ++r) p.t[qt][k0 + kt][r] = __builtin_amdgcn_exp2f(p.t[qt][k0 + kt][r]); }
__device__ __forceinline__ void partial2_first(P8& p, float& m0, float& m1, float& a0, float& a1) {
    m0 = rmax4(tmax(p, 0)); m1 = rmax4(tmax(p, 1)); a0 = 1.f; a1 = 1.f; sub_all(p, m0, m1); exp_half(p, 0); }
__device__ __forceinline__ void partial2(P8& p, float& m0, float& m1, float& a0, float& a1) {
    const float x0 = rmax4(tmax(p, 0)), x1 = rmax4(tmax(p, 1));
    if (__builtin_expect(__all(fmaxf(x0, x1) <= THRL), 1)) { a0 = 1.f; a1 = 1.f; }
    else { const float d0 = fmaxf(x0, 0.f), d1 = fmaxf(x1, 0.f); a0 = __builtin_amdgcn_exp2f(-d0); a1 = __builtin_amdgcn_exp2f(-d1); m0 += d0; m1 += d1; sub_all(p, d0, d1); }
    exp_half(p, 0); }
__device__ __forceinline__ void finish2(P8& p, float a0, float a1, float& l0, float& l1, bf16x8 (&pb)[2][2]) {
    exp_half(p, 2);
    float s0 = 0.f, s1 = 0.f;
#pragma unroll
    for (int kt = 0; kt < 4; ++kt)
#pragma unroll
        for (int r = 0; r < 4; ++r) { s0 += p.t[0][kt][r]; s1 += p.t[1][kt][r]; }
    l0 = l0 * a0 + rsum4(s0); l1 = l1 * a1 + rsum4(s1);
#pragma unroll
    for (int qt = 0; qt < 2; ++qt)
#pragma unroll
        for (int s2 = 0; s2 < 2; ++s2) { v4u w; w.x = cvtpk(p.t[qt][2 * s2][0], p.t[qt][2 * s2][1]); w.y = cvtpk(p.t[qt][2 * s2][2], p.t[qt][2 * s2][3]);
            w.z = cvtpk(p.t[qt][2 * s2 + 1][0], p.t[qt][2 * s2 + 1][1]); w.w = cvtpk(p.t[qt][2 * s2 + 1][2], p.t[qt][2 * s2 + 1][3]); pb[qt][s2] = __builtin_bit_cast(bf16x8, w); }
}
template <int B, int I> __device__ __forceinline__ void pv2_rd(const int (&vo)[8], s16x4& lo, s16x4& hi) { constexpr int s2 = I >> 3, vt = I & 7;
    lo = tr_read<B * SHM_V + s2 * 8192>(vo[vt]); hi = tr_read<B * SHM_V + s2 * 8192 + 4096>(vo[vt]); }
#define PV2_MM(I, L, H) do { const bf16x8 af_ = (bf16x8){L[0], L[1], L[2], L[3], H[0], H[1], H[2], H[3]}; \
    o[(I) & 7][0] = mfma16(af_, pb[0][(I) >> 3], o[(I) & 7][0]); o[(I) & 7][1] = mfma16(af_, pb[1][(I) >> 3], o[(I) & 7][1]); } while (0)
#define PV2_W(N) do { asm volatile("s_waitcnt lgkmcnt(" #N ")" ::: "memory"); SBAR(); } while (0)
template <int B> __device__ __forceinline__ void pv2(f32x4 (&o)[8][2], const int (&vo)[8], const bf16x8 (&pb)[2][2]) {
    s16x4 l0, h0, l1, h1, l2, h2;
    asm volatile("s_waitcnt lgkmcnt(0)" ::: "memory"); SBAR();
    pv2_rd<B, 0>(vo, l0, h0); pv2_rd<B, 1>(vo, l1, h1); pv2_rd<B, 2>(vo, l2, h2);
    PV2_W(4); PV2_MM(0, l0, h0); SBAR(); pv2_rd<B, 3>(vo, l0, h0);
    PV2_W(4); PV2_MM(1, l1, h1); SBAR(); pv2_rd<B, 4>(vo, l1, h1);
    PV2_W(4); PV2_MM(2, l2, h2); SBAR(); pv2_rd<B, 5>(vo, l2, h2);
    PV2_W(4); PV2_MM(3, l0, h0); SBAR(); pv2_rd<B, 6>(vo, l0, h0);
    PV2_W(4); PV2_MM(4, l1, h1); SBAR(); pv2_rd<B, 7>(vo, l1, h1);
    PV2_W(4); PV2_MM(5, l2, h2); SBAR(); pv2_rd<B, 8>(vo, l2, h2);
    PV2_W(4); PV2_MM(6, l0, h0); SBAR(); pv2_rd<B, 9>(vo, l0, h0);
    PV2_W(4); PV2_MM(7, l1, h1); SBAR(); pv2_rd<B, 10>(vo, l1, h1);
    PV2_W(4); PV2_MM(8, l2, h2); SBAR(); pv2_rd<B, 11>(vo, l2, h2);
    PV2_W(4); PV2_MM(9, l0, h0); SBAR(); pv2_rd<B, 12>(vo, l0, h0);
    PV2_W(4); PV2_MM(10, l1, h1); SBAR(); pv2_rd<B, 13>(vo, l1, h1);
    PV2_W(4); PV2_MM(11, l2, h2); SBAR(); pv2_rd<B, 14>(vo, l2, h2);
    PV2_W(4); PV2_MM(12, l0, h0); SBAR(); pv2_rd<B, 15>(vo, l0, h0);
    PV2_W(4); PV2_MM(13, l1, h1);
    PV2_W(2); PV2_MM(14, l2, h2);
    PV2_W(0); PV2_MM(15, l0, h0);
}
__device__ __forceinline__ void attn_unit2(const bf16* __restrict__ Q, const bf16* __restrict__ KN, const bf16* __restrict__ KR, const bf16* __restrict__ V, const bf16* __restrict__ G1, bf16* __restrict__ CC,
                                           int qrow0, int h, int nt_lat, int lat0, int ctx0, LAS unsigned char* lds) {
    int tid_l = threadIdx.x; asm volatile("" : "+v"(tid_l)); const int tid = tid_l, wid = __builtin_amdgcn_readfirstlane(tid >> 6), lane = tid & 63, l16 = lane & 15, g4 = lane >> 4;
    LAS unsigned char* V_lds = lds + OFF_V; LAS unsigned char* K_lds = lds + OFF_K;
    LAS unsigned char* qrl = lds + OFF_QR + wid * 4096 + lane * 16;
    float m0 = 0.f, m1 = 0.f, l0 = 0.f, l1 = 0.f;
    f32x4 o[8][2];
#pragma unroll
    for (int vt = 0; vt < 8; ++vt) { o[vt][0] = (f32x4){0.f, 0.f, 0.f, 0.f}; o[vt][1] = (f32x4){0.f, 0.f, 0.f, 0.f}; }
    const unsigned ko = (unsigned)((tid >> 4) * 128 + (((tid & 15) ^ ((tid >> 4) & 15)) * 8));
    const unsigned kro = (unsigned)((tid >> 3) * 64 + (((tid & 7) ^ ((tid >> 4) & 7)) * 8));
    const unsigned vo_g = (unsigned)((tid >> 4) * 128 + ((((((tid & 15) >> 1) ^ ((tid >> 4) & 7)) << 1) | (tid & 1)) * 8));
    int vo[8];
    { const int q = l16 >> 2, pp = l16 & 3, rr = 4 * g4 + q, sw = rr & 7, base = (int)(unsigned)(unsigned long long)lds + OFF_V + rr * 256 + 8 * pp;
#pragma unroll
      for (int vt = 0; vt < 8; ++vt) vo[vt] = base + ((vt ^ sw) << 5); }
    const int NT = nt_lat + 4;
#define TROW(jt) ((jt) < nt_lat ? lat0 + 64 * (jt) : ctx0 + 64 * ((jt) - nt_lat))
#define GLDS(gp, lp) __builtin_amdgcn_global_load_lds((const unsigned*)(gp), (LAS unsigned*)(lp), 16, 0, 0)
#define ISSUE_K(jt, b) do { const int R0_ = TROW(jt); const bf16* Kb_ = uni(KN + ((size_t)h * MTOT + R0_) * 128); const bf16* Rb_ = uni(KR + (size_t)R0_ * 64); \
    GLDS(Kb_ + ko, K_lds + (b) * SHM_K + wid * 1024); GLDS(Kb_ + ko + 32 * 128, K_lds + (b) * SHM_K + (wid + 8) * 1024); GLDS(Rb_ + kro, K_lds + (b) * SHM_K + OFF_KR + wid * 1024); } while (0)
#define ISSUE_V(jt, b) do { const int R0_ = TROW(jt); const bf16* Vb_ = uni(V + ((size_t)h * MTOT + R0_) * 128); \
    GLDS(Vb_ + vo_g, V_lds + (b) * SHM_V + wid * 1024); GLDS(Vb_ + vo_g + 32 * 128, V_lds + (b) * SHM_V + (wid + 8) * 1024); } while (0)
#define STEP_END() asm volatile("s_waitcnt vmcnt(0) lgkmcnt(0)\n\ts_barrier" ::: "memory")
#define RESC2(a0_, a1_) do { if (__any(fminf(a0_, a1_) < 1.f)) { _Pragma("unroll") for (int vt = 0; vt < 8; ++vt) { o[vt][0] = o[vt][0] * (a0_); o[vt][1] = o[vt][1] * (a1_); } } } while (0)
    STEP_END();
    ISSUE_K(0, 0);
    bf16x8 qf[2][4];
    { const bf16* Qw = uni(Q + (size_t)(qrow0 + wid * QBLK) * NQ + h * 192); const unsigned qo = (unsigned)(l16 * NQ + g4 * 8);
#pragma unroll
      for (int qt = 0; qt < 2; ++qt) {
#pragma unroll
        for (int ks = 0; ks < 4; ++ks) qf[qt][ks] = *(const bf16x8*)(Qw + qo + (unsigned)(qt * 16 * NQ + ks * 32));
#pragma unroll
        for (int ks = 4; ks < 6; ++ks) { const bf16x8 t = *(const bf16x8*)(Qw + qo + (unsigned)(qt * 16 * NQ + ks * 32)); *(LAS bf16x8*)(qrl + (qt * 2 + ks - 4) * 1024) = t; } } }
    P8 pA, pB; float aA0, aA1, aB0, aB1; bf16x8 pb[2][2];
    STEP_END();
    ISSUE_K(1, 1); ISSUE_V(0, 0);
    qkt2(pA, K_lds, qf, qrl, l16, g4, 0.f, 0.f); partial2_first(pA, m0, m1, aA0, aA1);
    STEP_END();
    for (int j = 1; j + 1 < NT; j += 2) {
        ISSUE_K(j + 1, 0); ISSUE_V(j, 1);
        SBAR(); qkt2(pB, K_lds + SHM_K, qf, qrl, l16, g4, -m0, -m1);
        finish2(pA, aA0, aA1, l0, l1, pb); SBAR();
        pv2<0>(o, vo, pb); partial2(pB, m0, m1, aB0, aB1);
        RESC2(aB0, aB1); STEP_END();
        ISSUE_K(j + 2, 1); ISSUE_V(j + 1, 0);
        SBAR(); qkt2(pA, K_lds, qf, qrl, l16, g4, -m0, -m1);
        finish2(pB, aB0, aB1, l0, l1, pb); SBAR();
        pv2<1>(o, vo, pb); partial2(pA, m0, m1, aA0, aA1);
        RESC2(aA0, aA1); STEP_END();
    }
    ISSUE_V(NT - 1, 1);
    SBAR(); qkt2(pB, K_lds + SHM_K, qf, qrl, l16, g4, -m0, -m1);
    finish2(pA, aA0, aA1, l0, l1, pb); SBAR();
    pv2<0>(o, vo, pb); partial2(pB, m0, m1, aB0, aB1);
    RESC2(aB0, aB1); STEP_END();
    finish2(pB, aB0, aB1, l0, l1, pb); SBAR();
    pv2<1>(o, vo, pb);
    STEP_END();
    { LAS unsigned char* mx = lds + wid * (32 * 272);
      const float r0 = __builtin_amdgcn_rcpf(l0), r1 = __builtin_amdgcn_rcpf(l1);
#pragma unroll
      for (int vt = 0; vt < 8; ++vt) { u32x2 w;
          w.x = cvtpk(o[vt][0][0] * r0, o[vt][0][1] * r0); w.y = cvtpk(o[vt][0][2] * r0, o[vt][0][3] * r0); *(LAS u32x2*)(mx + l16 * 272 + (16 * vt + 4 * g4) * 2) = w;
          w.x = cvtpk(o[vt][1][0] * r1, o[vt][1][1] * r1); w.y = cvtpk(o[vt][1][2] * r1, o[vt][1][3] * r1); *(LAS u32x2*)(mx + (16 + l16) * 272 + (16 * vt + 4 * g4) * 2) = w; }
      asm volatile("s_waitcnt lgkmcnt(0)" ::: "memory");
      const bf16* Gz = uni(G1 + (size_t)(qrow0 + wid * QBLK) * N_AB + G1_ZA + h * 128); bf16* Co = uni(CC + (size_t)(qrow0 + wid * QBLK) * MIXW + h * 128);
      int le = lane; asm volatile("" : "+v"(le));
#pragma unroll
      for (int i = 0; i < 8; ++i) { const int id = 64 * i + le, row = id >> 4, c8 = (id & 15) * 8;
          const v4u oq = *(const LAS v4u*)(mx + row * 272 + c8 * 2); const v4u zq = LDNT((const v4u*)(Gz + (unsigned)(row * N_AB + c8)));
          v4u wq;
#pragma unroll
          for (int e = 0; e < 4; ++e) wq[e] = cvtpk(bf_lo(oq[e]) * bf_lo(zq[e]), bf_hi(oq[e]) * bf_hi(zq[e]));
          *(v4u*)(Co + (unsigned)(row * MIXW + c8)) = wq;
          if ((i & 3) == 3) asm volatile("" ::: "memory"); } }
#undef TROW
#undef GLDS
#undef ISSUE_K
#undef ISSUE_V
#undef STEP_END
#undef RESC2
}
#undef PV2_MM
#undef PV2_W
}
#ifndef ATT_PRIO
#define ATT_PRIO 1
#endif
#ifndef ATT_BODY2
#define ATT_BODY2 0
#endif
__device__ __forceinline__ void attn_phase(KArgs a, LAS unsigned char* lds, int G) {
    const bf16* Q = (const bf16*)(GWS(a) + WS_Q); const bf16* KN = (const bf16*)(GWS(a) + WS_KN); const bf16* KR = (const bf16*)(GWS(a) + WS_KR); const bf16* V = (const bf16*)(GWS(a) + WS_V);
    const bf16* G1 = (const bf16*)(GWS(a) + WS_G1); bf16* CC = (bf16*)(GWS(a) + WS_CC);
    const int bx = blockIdx.x; const int vcu = (G % 8 == 0) ? (bx % 8) * (G / 8) + bx / 8 : bx;
    if (ATT_PRIO && __builtin_amdgcn_readfirstlane(threadIdx.x >> 6) >= 4) __builtin_amdgcn_s_setprio(1);
    for (int u = vcu; u < 2048 + 64; u += G) {
        if (u < 2048) { const int bh = u >> 5, qb = u & 31, b = bh >> 5, h = bh & 31;
            if (ATT_BODY2) att2::attn_unit2(Q, KN, KR, V, G1, CC, b * SEQ + qb * 256, h, 128, b * SEQ, MLAT + b * NCTX, lds); else att::attn_unit(Q, KN, KR, V, G1, CC, b * SEQ + qb * 256, h, 128, b * SEQ, MLAT + b * NCTX, lds); }
        else { const int bh = u - 2048, b = bh >> 5, h = bh & 31;
            if (ATT_BODY2) att2::attn_unit2(Q, KN, KR, V, G1, CC, MLAT + b * NCTX, h, 0, 0, MLAT + b * NCTX, lds); else att::attn_unit(Q, KN, KR, V, G1, CC, MLAT + b * NCTX, h, 0, 0, MLAT + b * NCTX, lds); }
    }
    if (ATT_PRIO) __builtin_amdgcn_s_setprio(0);
    __syncthreads();
}

__device__ __forceinline__ s16x4 tr_read_v(int addr) { s16x4 r; asm volatile("ds_read_b64_tr_b16 %0, %1" : "=&v"(r) : "v"(addr) : "memory"); return r; }
template <int CTRL> __device__ __forceinline__ float dpp_f(float x) { return __int_as_float(__builtin_amdgcn_update_dpp(0, __float_as_int(x), CTRL, 0xf, 0xf, true)); }
constexpr int SC_PITCH = 288;
constexpr int SC_QD = 0, SC_KD = 16 * SC_PITCH, SC_KE = 32 * SC_PITCH, SC_VV = 48 * SC_PITCH, SC_EB = 64 * SC_PITCH, SC_BUF = SC_EB + 512;
constexpr int SC_OST = 4 * SC_BUF;
__device__ __forceinline__ void scan_stage(LAS unsigned char* B, u32x2 rq, u32x2 rk, u32x2 rv, int wid, int lane, int tid) {
    const int t = lane & 15, kq = lane >> 4;
    float q[4], kk[4], x[4], tot[4];
    q[0] = bf_lo(rq.x); q[1] = bf_hi(rq.x); q[2] = bf_lo(rq.y); q[3] = bf_hi(rq.y); kk[0] = bf_lo(rk.x); kk[1] = bf_hi(rk.x); kk[2] = bf_lo(rk.y); kk[3] = bf_hi(rk.y);
#pragma unroll
    for (int e = 0; e < 4; ++e) { x[e] = __builtin_amdgcn_logf(fmaxf(1.0f - kk[e], 1e-30f)); tot[e] = x[e]; }
#define SC_DPP8(cg_, cs_) \
        "v_add_f32_dpp %0, %0, %0 " cg_ " row_mask:0xf bank_mask:0xf bound_ctrl:0\n\tv_add_f32_dpp %1, %1, %1 " cg_ " row_mask:0xf bank_mask:0xf bound_ctrl:0\n\t" \
        "v_add_f32_dpp %2, %2, %2 " cg_ " row_mask:0xf bank_mask:0xf bound_ctrl:0\n\tv_add_f32_dpp %3, %3, %3 " cg_ " row_mask:0xf bank_mask:0xf bound_ctrl:0\n\t" \
        "v_add_f32_dpp %4, %4, %4 " cs_ " row_mask:0xf bank_mask:0xf\n\tv_add_f32_dpp %5, %5, %5 " cs_ " row_mask:0xf bank_mask:0xf\n\t" \
        "v_add_f32_dpp %6, %6, %6 " cs_ " row_mask:0xf bank_mask:0xf\n\tv_add_f32_dpp %7, %7, %7 " cs_ " row_mask:0xf bank_mask:0xf\n\t"
    asm volatile("s_nop 1\n\t" SC_DPP8("row_shr:1", "row_ror:8") SC_DPP8("row_shr:2", "row_ror:4") SC_DPP8("row_shr:4", "row_ror:2") SC_DPP8("row_shr:8", "row_ror:1")
                 : "+v"(x[0]), "+v"(x[1]), "+v"(x[2]), "+v"(x[3]), "+v"(tot[0]), "+v"(tot[1]), "+v"(tot[2]), "+v"(tot[3]));
#undef SC_DPP8
    float qd[4], kd[4], ke[4];
#pragma unroll
    for (int e = 0; e < 4; ++e) { qd[e] = q[e] * __builtin_amdgcn_exp2f(x[e]); kd[e] = kk[e] * __builtin_amdgcn_exp2f(fminf(-x[e], 115.0f)); ke[e] = kk[e] * __builtin_amdgcn_exp2f(fminf(tot[e] - x[e], 0.0f)); }
    const int ppos = 32 * (wid >> 1) + 8 * kq + 4 * (wid & 1);
    u32x2 w;
    w.x = cvtpk(qd[0], qd[1]); w.y = cvtpk(qd[2], qd[3]); *(LAS u32x2*)(B + SC_QD + t * SC_PITCH + ppos * 2) = w;
    w.x = cvtpk(kd[0], kd[1]); w.y = cvtpk(kd[2], kd[3]); *(LAS u32x2*)(B + SC_KD + t * SC_PITCH + ppos * 2) = w;
    w.x = cvtpk(ke[0], ke[1]); w.y = cvtpk(ke[2], ke[3]); *(LAS u32x2*)(B + SC_KE + t * SC_PITCH + (16 * wid + 4 * kq) * 2) = w;
    if (t == 0) *(LAS f32x4*)(B + SC_EB + (16 * wid + 4 * kq) * 4) = (f32x4){__builtin_amdgcn_exp2f(tot[0]), __builtin_amdgcn_exp2f(tot[1]), __builtin_amdgcn_exp2f(tot[2]), __builtin_amdgcn_exp2f(tot[3])};
    *(LAS u32x2*)(B + SC_VV + (tid >> 5) * SC_PITCH + (tid & 31) * 8) = rv;
}
__device__ __forceinline__ void scan_phase(KArgs a, LAS unsigned char* lds, int G) {
    int tid_l = threadIdx.x; asm volatile("" : "+v"(tid_l)); const int tid = tid_l, lane = tid & 63, wid = __builtin_amdgcn_readfirstlane(tid >> 6), g4 = lane >> 4, l16 = lane & 15;
    const bf16* G1 = (const bf16*)(GWS(a) + WS_G1); const size_t TS = (size_t)MTOT * MIXW;
    const int ldsb = (int)(unsigned)(unsigned long long)lds;
    const int trq = l16 >> 2, trp = l16 & 3;
    const int st = lane & 15, sk = 16 * wid + 4 * (lane >> 4);
    const int vt_ = tid >> 5, vc = (tid & 31) * 4;
    for (int sq = blockIdx.x; sq < 256; sq += G) {
        const int dir = sq >> 7, b = (sq >> 6) & 1, h = sq & 63;
        const bf16* Tq = G1 + h * 128; const bf16* Tk = G1 + (size_t)(1 + dir) * TS + h * 128; const bf16* Tv = G1 + (size_t)3 * TS + h * 128;
        bf16* Od = (bf16*)(GWS(a) + WS_OF) + (size_t)dir * TS + h * 128;
        const unsigned oq = (unsigned)((dir ? 15 - st : st) * MIXW + sk), ovv = (unsigned)((dir ? 15 - vt_ : vt_) * MIXW + vc);
#define CLOW(c_) ((c_) < 16 ? MLAT + b * NCTX + (dir ? 240 - 16 * (c_) : 16 * (c_)) : b * SEQ + (dir ? 8432 - 16 * (c_) : 16 * (c_) - 256))
#define SLOADC(c_, rq_, rk_, rv_) do { const size_t lo_ = (size_t)CLOW(c_) * MIXW; rq_ = LDNT((const u32x2*)(uni(Tq + lo_) + oq)); rk_ = LDNT((const u32x2*)(uni(Tk + lo_) + oq)); rv_ = LDNT((const u32x2*)(uni(Tv + lo_) + ovv)); } while (0)
#define SBARRIER() do { asm volatile("s_waitcnt lgkmcnt(0)" ::: "memory"); __builtin_amdgcn_s_barrier(); asm volatile("" ::: "memory"); } while (0)
        f32x4 S[8];
#pragma unroll
        for (int i = 0; i < 8; ++i) S[i] = (f32x4){0.f, 0.f, 0.f, 0.f};
        u32x2 rq0, rk0, rv0, rq1, rk1, rv1;
        SBARRIER();
        SLOADC(0, rq0, rk0, rv0); SLOADC(1, rq1, rk1, rv1);
        scan_stage(lds, rq0, rk0, rv0, wid, lane, tid); scan_stage(lds + SC_BUF, rq1, rk1, rv1, wid, lane, tid);
        SLOADC(2, rq0, rk0, rv0); SLOADC(3, rq1, rk1, rv1);
        SBARRIER();
        auto mstage = [&](const int bi) __attribute__((always_inline)) {
            LAS unsigned char* Bc = lds + bi * SC_BUF;
            bf16x8 qf[4], kf[4]; f32x4 e4[8]; s16x4 kt4[8];
#pragma unroll
            for (int ks = 0; ks < 4; ++ks) { qf[ks] = *(const LAS bf16x8*)(Bc + SC_QD + l16 * SC_PITCH + (32 * ks + 8 * g4) * 2); kf[ks] = *(const LAS bf16x8*)(Bc + SC_KD + l16 * SC_PITCH + (32 * ks + 8 * g4) * 2); }
            const int trb = ldsb + bi * SC_BUF + (4 * g4 + trq) * SC_PITCH + 8 * trp;
            const s16x4 vt = tr_read_v(trb + SC_VV + 32 * wid);
#pragma unroll
            for (int kt = 0; kt < 8; ++kt) { e4[kt] = *(const LAS f32x4*)(Bc + SC_EB + (16 * kt + 4 * g4) * 4); kt4[kt] = tr_read_v(trb + SC_KE + 32 * kt); }
            f32x4 at = (f32x4){0.f, 0.f, 0.f, 0.f};
#pragma unroll
            for (int ks = 0; ks < 4; ++ks) at = mfma16(kf[ks], qf[ks], at);
#pragma unroll
            for (int r = 0; r < 4; ++r) at[r] = (4 * g4 + r <= l16) ? at[r] : 0.f;
            bf16x8 pa; { v4u w; w.x = cvtpk(at[0], at[1]); w.y = cvtpk(at[2], at[3]); w.z = 0u; w.w = 0u; pa = __builtin_bit_cast(bf16x8, w); }
            f32x4 o = (f32x4){0.f, 0.f, 0.f, 0.f};
#pragma unroll
            for (int ks = 0; ks < 4; ++ks) { v4u w; w.x = cvtpk(S[2 * ks][0], S[2 * ks][1]); w.y = cvtpk(S[2 * ks][2], S[2 * ks][3]); w.z = cvtpk(S[2 * ks + 1][0], S[2 * ks + 1][1]); w.w = cvtpk(S[2 * ks + 1][2], S[2 * ks + 1][3]);
                o = mfma16(qf[ks], __builtin_bit_cast(bf16x8, w), o); }
            asm volatile("s_waitcnt lgkmcnt(0)" ::: "memory"); SBAR();
            const bf16x8 vf = (bf16x8){vt[0], vt[1], vt[2], vt[3], 0, 0, 0, 0};
            o = mfma16(pa, vf, o);
#pragma unroll
            for (int kt = 0; kt < 8; ++kt) { const bf16x8 kef = (bf16x8){kt4[kt][0], kt4[kt][1], kt4[kt][2], kt4[kt][3], 0, 0, 0, 0};
                S[kt] = mfma16(kef, vf, S[kt] * e4[kt]); }
            { LAS bf16* ost = (LAS bf16*)(lds + SC_OST + bi * 4096);
#pragma unroll
              for (int r = 0; r < 4; ++r) ost[(4 * g4 + r) * 128 + 16 * wid + l16] = (bf16)(cvtpk(o[r], 0.f) & 0xffffu); }
        };
        auto ostore = [&](const int c, const int bi) __attribute__((always_inline)) {
            const u32x2 ov = *(const LAS u32x2*)(lds + SC_OST + bi * 4096 + vt_ * 256 + vc * 2); *(u32x2*)(uni(Od + (size_t)CLOW(c) * MIXW) + ovv) = ov; };
        auto pairit = [&](const int pp, const int par) __attribute__((always_inline)) {
            const int c0 = 2 * pp;
            if (pp > 0) { ostore(c0 - 2, 2 * (par ^ 1)); ostore(c0 - 1, 2 * (par ^ 1) + 1); }
            if (pp + 1 < 264) { scan_stage(lds + (2 * (par ^ 1)) * SC_BUF, rq0, rk0, rv0, wid, lane, tid); scan_stage(lds + (2 * (par ^ 1) + 1) * SC_BUF, rq1, rk1, rv1, wid, lane, tid);
                SLOADC(min(c0 + 4, 527), rq0, rk0, rv0); SLOADC(min(c0 + 5, 527), rq1, rk1, rv1); }
            mstage(2 * par); mstage(2 * par + 1);
            SBARRIER();
        };
        for (int pp = 0; pp < 264; pp += 2) { pairit(pp, 0); pairit(pp + 1, 1); }
        ostore(526, 2); ostore(527, 3);
#undef CLOW
#undef SLOADC
#undef SBARRIER
    }
    asm volatile("s_waitcnt lgkmcnt(0)" ::: "memory"); __builtin_amdgcn_s_barrier(); asm volatile("" ::: "memory");
}

__device__ __forceinline__ void readout_phase(KArgs a, int jc, int nrows, int G) {
    int tid_l = threadIdx.x; asm volatile("" : "+v"(tid_l)); const int tid = tid_l, lane = tid & 63, wave = __builtin_amdgcn_readfirstlane(tid >> 6);
    const int gw = blockIdx.x * NWAVES + wave, NGW = G * NWAVES;
    const size_t TS = (size_t)MTOT * MIXW;
    const bf16* OFp = (const bf16*)(GWS(a) + WS_OF); const bf16* OBp = OFp + TS; const bf16* GS = (const bf16*)(GWS(a) + WS_G1) + 4 * TS; bf16* CC = (bf16*)(GWS(a) + WS_CC);
    const float* gnw = GIN(a, 20) + (size_t)jc * 128 + (lane & 15) * 8;
    const f32x4 w0 = *(const f32x4*)gnw, w1 = *(const f32x4*)(gnw + 4);
    const int N = nrows * 16;
    for (int it = gw; it < N; it += 4 * NGW) {
        v4u f4[4], b4[4], g4v[4];
#pragma unroll
        for (int k = 0; k < 4; ++k) { const int i2 = min(it + k * NGW, N - 1); const size_t off = (size_t)(i2 >> 4) * MIXW + (i2 & 15) * 512 + lane * 8;
            f4[k] = LDNT((const v4u*)(OFp + off)); b4[k] = LDNT((const v4u*)(OBp + off)); g4v[k] = LDNT((const v4u*)(GS + off)); }
#pragma unroll
        for (int k = 0; k < 4; ++k) { const int i2 = it + k * NGW; if (i2 >= N) break;
            const size_t off = (size_t)(i2 >> 4) * MIXW + (i2 & 15) * 512 + lane * 8;
            const v4u f = f4[k], bq = b4[k], gq = g4v[k];
            float o[8], gg[8];
#pragma unroll
            for (int e = 0; e < 4; ++e) { o[2 * e] = bf_lo(f[e]) + bf_lo(bq[e]); o[2 * e + 1] = bf_hi(f[e]) + bf_hi(bq[e]); gg[2 * e] = bf_lo(gq[e]); gg[2 * e + 1] = bf_hi(gq[e]); }
            float ss = 0.f;
#pragma unroll
            for (int e = 0; e < 8; ++e) ss += o[e] * o[e];
            ss += __shfl_xor(ss, 1); ss += __shfl_xor(ss, 2); ss += __shfl_xor(ss, 4); ss += __shfl_xor(ss, 8);
            const float r = 1.0f / sqrtf(ss * (1.0f / 128.0f) + EPS);
            v4u w; w.x = cvtpk(o[0] * r * w0[0] * gg[0], o[1] * r * w0[1] * gg[1]); w.y = cvtpk(o[2] * r * w0[2] * gg[2], o[3] * r * w0[3] * gg[3]);
            w.z = cvtpk(o[4] * r * w1[0] * gg[4], o[5] * r * w1[1] * gg[5]); w.w = cvtpk(o[6] * r * w1[2] * gg[6], o[7] * r * w1[3] * gg[7]);
            *(v4u*)(CC + off) = w; }
    }
}

#ifndef EN_P0
#define EN_P0 1
#endif
#ifndef EN_NORM
#define EN_NORM 1
#endif
#ifndef EN_A1
#define EN_A1 1
#endif
#ifndef EN_A2
#define EN_A2 1
#endif
#ifndef EN_A3
#define EN_A3 1
#endif
#ifndef EN_ATT
#define EN_ATT 1
#endif
#ifndef EN_A5
#define EN_A5 1
#endif
#ifndef EN_C1
#define EN_C1 1
#endif
#ifndef EN_SCAN
#define EN_SCAN 1
#endif
#ifndef EN_RO
#define EN_RO 1
#endif
#ifndef EN_C4
#define EN_C4 1
#endif
#ifndef EN_SGU
#define EN_SGU 1
#endif
#ifndef EN_QUP
#define EN_QUP 1
#endif
#ifndef EN_KVUP
#define EN_KVUP 1
#endif
#ifndef PG8_ALIGNV
#define PG8_ALIGNV true
#endif
#ifndef PG8_SP2V
#define PG8_SP2V true
#endif
#ifndef PROBE_MASK
#define PROBE_MASK 0u
#endif
#define REPS(k) for (int rep_ = 0; rep_ < ((((PROBE_MASK) >> (k)) & 1u) ? 2 : 1); ++rep_)
#ifndef MK_ONE_LAUNCH
#define MK_ONE_LAUNCH 1
#endif
constexpr int N_PHASES = 28;
#define IN(k) (lo <= (k) && (k) < hi)
#define SEAM(k) do { if (IN(k) && IN((k) + 1)) xcd_barrier(bar); } while (0)
template <int p> __device__ __forceinline__ void layer_pair(LAS unsigned char* lds, const int G, const int lo, const int hi, const XcdBarrier& bar) {

        const int pb = 2 + 13 * p, lab = 2 * p, lc = 2 * p + 1;
        if (EN_A1 && IN(pb + 0)) REPS(pb + 0) {
            KArgs A = kargs(); unsigned char* const wsb = GWS(A);
            pg8::Gemm g{(const pg8::bf16_t*)(wsb + WS_H), (const pg8::bf16_t*)(wsb + WS_WIN_AB) + (size_t)p * N_AB * DM, MTOT, N_AB, DM, DM}; pg8::LockstepOrder S; S.init(MTOT, N_AB, G, (int)blockIdx.x);
            pg8::EpiAB1 E{(pg8::bf16_t*)(wsb + WS_G1), N_AB};
            pg8::gemm_phase<pg8::EpiAB1, pg8::LockstepOrder, PG8_ALIGNV, PG8_SP2V>(lds, g, S, E);
            if (p0_defer_on(G)) { pg8::LockstepOrder S2; S2.init(MTOT, N_AB, G, (int)blockIdx.x); p0_deferred(kargs(), lds, S2, p == 0 ? 0 : 2); }
        } SEAM(pb + 0);
        if (EN_A2 && IN(pb + 1)) REPS(pb + 1) { a2_rows(kargs(), p, G); } SEAM(pb + 1);
        if (EN_SGU && IN(pb + 2)) REPS(pb + 2) { sgu_phase(kargs(), p, lds, G); }
        if (EN_QUP && IN(pb + 3)) REPS(pb + 3) {
            KArgs A = kargs(); unsigned char* const wsb = GWS(A);
            pg8::Gemm g{(const pg8::bf16_t*)(wsb + WS_QN), (const pg8::bf16_t*)(wsb + WS_WQ) + (size_t)p * NQ * QL, MTOT, NQ, QL, QL}; pg8::LockstepOrder S; S.init(MTOT, NQ, G, (int)blockIdx.x);
            pg8::EpiQ E{(pg8::bf16_t*)(wsb + WS_Q), (const pg8::f32x2*)(wsb + WS_ROPE), MLAT, 0.07216878364870322f * 1.4426950408889634f};
            pg8::gemm_phase<pg8::EpiQ, pg8::LockstepOrder, PG8_ALIGNV, PG8_SP2V>(lds, g, S, E);
        }
        if (EN_KVUP && IN(pb + 4)) REPS(pb + 4) {
            KArgs A = kargs(); unsigned char* const wsb = GWS(A);
            pg8::Gemm g{(const pg8::bf16_t*)(wsb + WS_KVN), (const pg8::bf16_t*)(wsb + WS_WKV) + (size_t)p * NKV * KVL, MTOT, NKV, KVL, KVL}; pg8::LockstepOrder S; S.init(MTOT, NKV, G, (int)((blockIdx.x + 64u) % (unsigned)G));
            pg8::EpiKV E{(pg8::bf16_t*)(wsb + WS_KN), (pg8::bf16_t*)(wsb + WS_V), MTOT};
            pg8::gemm_phase<pg8::EpiKV, pg8::LockstepOrder, PG8_ALIGNV, PG8_SP2V>(lds, g, S, E);
        } SEAM(pb + 4);
        if (EN_ATT && IN(pb + 5)) REPS(pb + 5) { attn_phase(kargs(), lds, G); } SEAM(pb + 5);
        if (EN_A5 && IN(pb + 6)) REPS(pb + 6) {
            KArgs A = kargs(); unsigned char* const wsb = GWS(A);
            { pg8::Gemm g{(const pg8::bf16_t*)(wsb + WS_CC), (const pg8::bf16_t*)(wsb + WS_WO_AB) + (size_t)p * DM * MIXW, MLAT, DM, MIXW, MIXW}; pg8::LockstepOrder S; S.init(MLAT, DM, G, (int)blockIdx.x);
              pg8::EpiBf16P E{(pg8::bf16_t*)(wsb + WS_Y), DM};
              pg8::gemm_phase<pg8::EpiBf16P, pg8::LockstepOrder, PG8_ALIGNV, PG8_SP2V>(lds, g, S, E); }
            { pg8::Gemm g{(const pg8::bf16_t*)(wsb + WS_CC) + (size_t)MLAT * MIXW, (const pg8::bf16_t*)(wsb + WS_WO_AB) + (size_t)p * DM * MIXW, MTOT - MLAT, DM, MIXW / 8, MIXW}; pg8::SplitKOrder S; S.init(MTOT - MLAT, DM, 8, G, (int)blockIdx.x);
              pg8::EpiF32 E{(float*)(wsb + WS_YP), DM, (size_t)(MTOT - MLAT) * DM};
              pg8::gemm_phase<pg8::EpiF32, pg8::SplitKOrder, PG8_ALIGNV, PG8_SP2V>(lds, g, S, E); }
        } SEAM(pb + 6);
        if (EN_NORM && IN(pb + 7)) REPS(pb + 7) { norm_phase(kargs(), lab, lc, G); } SEAM(pb + 7);
        if (EN_C1 && IN(pb + 8)) REPS(pb + 8) {
            KArgs A = kargs(); unsigned char* const wsb = GWS(A);
            pg8::Gemm g{(const pg8::bf16_t*)(wsb + WS_H), (const pg8::bf16_t*)(wsb + WS_WIN_C) + (size_t)p * N_C * DM, MTOT, N_C, DM, DM}; pg8::LockstepOrder S; S.init(MTOT, N_C, G, (int)blockIdx.x);
            pg8::EpiC1 E{(pg8::bf16_t*)(wsb + WS_G1), (size_t)MTOT * MIXW, (const float*)(wsb + WS_OML) + (size_t)p * 2 * 8192};
            pg8::gemm_phase<pg8::EpiC1, pg8::LockstepOrder, PG8_ALIGNV, PG8_SP2V>(lds, g, S, E);
            if (p0_defer_on(G)) { pg8::LockstepOrder S2; S2.init(MTOT, N_C, G, (int)blockIdx.x); p0_deferred(kargs(), lds, S2, p == 0 ? 1 : 3); }
        } SEAM(pb + 8);
        if (EN_SCAN && IN(pb + 9)) REPS(pb + 9) { scan_phase(kargs(), lds, G); } SEAM(pb + 9);
        if (EN_RO && IN(pb + 10)) REPS(pb + 10) { readout_phase(kargs(), p, lc == 3 ? MLAT : MTOT, G); } SEAM(pb + 10);
        if (EN_C4 && IN(pb + 11)) REPS(pb + 11) {
            KArgs A = kargs(); unsigned char* const wsb = GWS(A);
            { pg8::Gemm g{(const pg8::bf16_t*)(wsb + WS_CC), (const pg8::bf16_t*)(wsb + WS_WO_C) + (size_t)p * DM * MIXW, MLAT, DM, MIXW, MIXW}; pg8::LockstepOrder S; S.init(MLAT, DM, G, (int)blockIdx.x);
              pg8::EpiBf16P E{(pg8::bf16_t*)(wsb + WS_Y), DM};
              pg8::gemm_phase<pg8::EpiBf16P, pg8::LockstepOrder, PG8_ALIGNV, PG8_SP2V>(lds, g, S, E); }
            if (lc != 3) { pg8::Gemm g{(const pg8::bf16_t*)(wsb + WS_CC) + (size_t)MLAT * MIXW, (const pg8::bf16_t*)(wsb + WS_WO_C) + (size_t)p * DM * MIXW, MTOT - MLAT, DM, MIXW / 8, MIXW}; pg8::SplitKOrder S; S.init(MTOT - MLAT, DM, 8, G, (int)blockIdx.x);
              pg8::EpiF32 E{(float*)(wsb + WS_YP), DM, (size_t)(MTOT - MLAT) * DM};
              pg8::gemm_phase<pg8::EpiF32, pg8::SplitKOrder, PG8_ALIGNV, PG8_SP2V>(lds, g, S, E); }
        } SEAM(pb + 11);
        if (EN_NORM && IN(pb + 12)) REPS(pb + 12) { norm_phase(kargs(), lc, lc + 1, G); } SEAM(pb + 12);
    }
#undef IN
#undef SEAM
__global__ void __launch_bounds__(NWAVES * 64, 2) fwd(Args a) {
    extern __shared__ __attribute__((aligned(16))) unsigned char lds_raw[];
    LAS unsigned char* lds = (LAS unsigned char*)lds_raw;
    int tid_l = threadIdx.x; asm volatile("" : "+v"(tid_l)); const int tid = tid_l, G = gridDim.x;
    for (int u = tid; u < (LDS_BYTES - LDSCTL_OFF) / 4; u += NWAVES * 64) ((LAS unsigned*)(lds + LDSCTL_OFF))[u] = 0u;
    __syncthreads();
    XcdBarrier bar; bar.bar = (unsigned*)(a.ws + WS_CTL) + CW_BAR; bar.x = 0; bar.st = nullptr;
    if (MK_ONE_LAUNCH) bar = xcd_barrier_post((unsigned*)(a.ws + WS_CTL) + CW_BAR, (volatile LAS unsigned*)(lds + MISC_OFF));
    const int lo = a.ph_lo, hi = a.ph_hi;
#define IN(k) (lo <= (k) && (k) < hi)
#define SEAM(k) do { if (IN(k) && IN((k) + 1)) xcd_barrier(bar); } while (0)
    if (EN_P0 && IN(0)) REPS(0) { p0_prologue(kargs(), lds, G); } SEAM(0);
    if (EN_NORM && IN(1)) REPS(1) { norm_phase(kargs(), -1, 0, G); } SEAM(1);
    layer_pair<0>(lds, G, lo, hi, bar);
    layer_pair<1>(lds, G, lo, hi, bar);
#undef IN
#undef SEAM
}

extern "C" void kernel_launch(void* const* d_in, const int* in_sizes, int n_in, void* d_out, int out_size, void* d_ws, size_t ws_size, hipStream_t stream) {
    static int grid = 0;
    if (grid == 0) {
        if (n_in != 22 || out_size != MLAT * DM || ws_size < WS_END) { fprintf(stderr, "kernel_launch: unexpected shapes (n_in %d, out %d, ws %zu, need %zu)\n", n_in, out_size, ws_size, (size_t)WS_END); grid = -1; return; }
        int dev = 0, cus = 0, per_cu = 0;
        if (hipGetDevice(&dev) != hipSuccess || hipDeviceGetAttribute(&cus, hipDeviceAttributeMultiprocessorCount, dev) != hipSuccess) { grid = -1; return; }
        if (hipFuncSetAttribute((const void*)fwd, hipFuncAttributeMaxDynamicSharedMemorySize, LDS_BYTES) != hipSuccess) { fprintf(stderr, "kernel_launch: hipFuncSetAttribute failed\n"); grid = -1; return; }
        if (hipOccupancyMaxActiveBlocksPerMultiprocessor(&per_cu, (const void*)fwd, NWAVES * 64, LDS_BYTES) != hipSuccess || per_cu < 1) fprintf(stderr, "kernel_launch: occupancy query reports %d\n", per_cu);
        (void)hipGetLastError();
        grid = cus;
    }
    if (grid < 0) return;
    (void)hipMemsetAsync((char*)d_ws + WS_CTL, 0, 65536, stream);
    Args a{};
    for (int i = 0; i < 22; ++i) a.in[i] = (const float*)d_in[i];
    a.out = (float*)d_out; a.ws = (unsigned char*)d_ws;
#if MK_ONE_LAUNCH
    a.ph_lo = 0; a.ph_hi = N_PHASES;
    hipLaunchKernelGGL(fwd, dim3(grid), dim3(NWAVES * 64), LDS_BYTES, stream, a);
#else
    for (int p = 0; p < N_PHASES; ++p) { a.ph_lo = p; a.ph_hi = p + 1; hipLaunchKernelGGL(fwd, dim3(grid), dim3(NWAVES * 64), LDS_BYTES, stream, a); }
#endif
}
```
